# Optimizing an MI355X kernel written in HIP

```python
import jax, jax.numpy as jnp
from jax import lax
import numpy as np

D_MODEL = 1024
BATCH = 2
SEQ = 8192
DEPTH = 1

GDN_HEADS = 4
GDN_DK = 128
GDN_DV = 128
HG_HEADS = 4
HG_DK = 128
HG_DV = 128
GDN_QK = GDN_HEADS * GDN_DK
GDN_V = GDN_HEADS * GDN_DV
HG_K = HG_HEADS * HG_DK
HG_V = HG_HEADS * HG_DV
D_MIX = GDN_V + HG_V
D_IN = 2 * GDN_QK + 2 * GDN_V + 2 * GDN_HEADS + 2 * HG_K + 2 * HG_V
CONV_K = 4
CHUNK = 64
N_EXPERTS = 64
N_GROUPS = 8
TOPK_GROUPS = 4
TOP_K = 8
D_EXPERT = 256
D_SHARED = 256
ROUTE_SCALE = 2.5
MOE_BLOCK = 128
EPS = 1e-6

kernel_name = "hybrid_gdn_hgrn2_moe_adaln"


def rms_norm(x, w):
    xf = x.astype(jnp.float32)
    y = xf * lax.rsqrt(jnp.mean(xf * xf, axis=-1, keepdims=True) + EPS)
    return (y * w.astype(jnp.float32)).astype(x.dtype)


def l2_normalize(x):
    return x * lax.rsqrt(jnp.sum(x * x, axis=-1, keepdims=True) + EPS)


def causal_short_conv(x, w):
    T = x.shape[1]
    xp = jnp.pad(x, ((0, 0), (CONV_K - 1, 0), (0, 0)))
    y = sum(xp[:, j:j + T, :] * w[j] for j in range(CONV_K))
    return jax.nn.silu(y)


def to_chunks(t):
    B, T, H, D = t.shape
    return t.reshape(B, T // CHUNK, CHUNK, H, D).transpose(0, 3, 1, 2, 4)


def from_chunks(o):
    N, B, H, C, D = o.shape
    return o.transpose(1, 0, 3, 2, 4).reshape(B, N * C, H, D)


def gated_delta_chunked(q, k, v, g, beta):
    B, T, H, DK = q.shape
    DV = v.shape[-1]
    N = T // CHUNK
    qc, kc, vc = to_chunks(q), to_chunks(k), to_chunks(v)
    gc = jnp.cumsum(g.reshape(B, N, CHUNK, H).transpose(0, 3, 1, 2), axis=-1)
    bc = beta.reshape(B, N, CHUNK, H).transpose(0, 3, 1, 2)
    idx = jnp.arange(CHUNK)
    causal = idx[:, None] >= idx[None, :]
    strict = idx[:, None] > idx[None, :]
    decay = jnp.exp(jnp.where(causal, gc[..., :, None] - gc[..., None, :], -jnp.inf))
    kb = kc * bc[..., None]
    L = jnp.where(strict, jnp.einsum('bhncd,bhnsd->bhncs', kb, kc) * decay, 0.0)
    rhs = jnp.concatenate([vc * bc[..., None], kb * jnp.exp(gc)[..., None]], axis=-1)
    sol = lax.linalg.triangular_solve(L + jnp.eye(CHUNK, dtype=L.dtype), rhs,
                                      left_side=True, lower=True, unit_diagonal=True)
    u, w = sol[..., :DV], sol[..., DV:]
    attn = jnp.einsum('bhncd,bhnsd->bhncs', qc, kc) * decay
    q_dec = qc * jnp.exp(gc)[..., None]
    g_last = gc[..., -1]
    k_tail = kc * jnp.exp(g_last[..., None] - gc)[..., None]

    def step(S, xs):
        u_n, w_n, a_n, qd_n, kt_n, gl_n = xs
        v_new = u_n - jnp.einsum('bhcd,bhdv->bhcv', w_n, S)
        o = jnp.einsum('bhcd,bhdv->bhcv', qd_n, S) + jnp.einsum('bhcs,bhsv->bhcv', a_n, v_new)
        S = S * jnp.exp(gl_n)[..., None, None] + jnp.einsum('bhcd,bhcv->bhdv', kt_n, v_new)
        return S, o

    xs = tuple(jnp.moveaxis(t, 2, 0) for t in (u, w, attn, q_dec, k_tail, g_last))
    S0 = jnp.zeros((B, H, DK, DV), q.dtype)
    _, o = lax.scan(step, S0, xs)
    return from_chunks(o)


def hgrn2_chunked(q, k, v, logf):
    B, T, H, DK = q.shape
    DV = v.shape[-1]
    qc, kc, vc = to_chunks(q), to_chunks(k), to_chunks(v)
    bc = jnp.cumsum(to_chunks(logf), axis=3)
    idx = jnp.arange(CHUNK)
    causal = (idx[:, None] >= idx[None, :])[:, :, None]

    def step(S, xs):
        q_n, k_n, v_n, b_n = xs
        decay = jnp.exp(jnp.where(causal, b_n[..., :, None, :] - b_n[..., None, :, :], -jnp.inf))
        A = jnp.einsum('bhtd,bhsd,bhtsd->bhts', q_n, k_n, decay)
        b_last = b_n[..., -1:, :]
        o = jnp.einsum('bhts,bhsv->bhtv', A, v_n) + jnp.einsum('bhtd,bhdv->bhtv', q_n * jnp.exp(b_n), S)
        S = jnp.exp(b_last[..., 0, :])[..., :, None] * S + jnp.einsum('bhsd,bhsv->bhdv', k_n * jnp.exp(b_last - b_n), v_n)
        return S, o

    xs = tuple(jnp.moveaxis(t, 2, 0) for t in (qc, kc, vc, bc))
    S0 = jnp.zeros((B, H, DK, DV), q.dtype)
    _, o = lax.scan(step, S0, xs)
    return from_chunks(o)


def token_mixer(h, w_in, conv_w, a_log, dt_bias, gdn_norm_w, lb, hg_norm_w, w_out):
    B, T, _ = h.shape
    f32 = jnp.float32
    proj = jnp.einsum('btd,de->bte', h, w_in).astype(f32)
    qkv_w = 2 * GDN_QK + GDN_V
    qkv = causal_short_conv(proj[..., :qkv_w], conv_w.astype(f32))
    qA, kA, vA = jnp.split(qkv, [GDN_QK, 2 * GDN_QK], axis=-1)
    sizes = (GDN_V, GDN_HEADS, GDN_HEADS, HG_K, HG_V, HG_K, HG_V)
    cuts = np.cumsum(sizes)[:-1].tolist()
    gateA, beta_raw, a_raw, f_raw, iB, qB, gateB = jnp.split(proj[..., qkv_w:], cuts, axis=-1)

    qA = l2_normalize(qA.reshape(B, T, GDN_HEADS, GDN_DK)) * (GDN_DK ** -0.5)
    kA = l2_normalize(kA.reshape(B, T, GDN_HEADS, GDN_DK))
    vA = vA.reshape(B, T, GDN_HEADS, GDN_DV)
    beta = jax.nn.sigmoid(beta_raw)
    g_log = -jnp.exp(a_log.astype(f32)) * jax.nn.softplus(a_raw + dt_bias.astype(f32))
    oA = gated_delta_chunked(qA, kA, vA, g_log, beta)
    oA = rms_norm(oA, gdn_norm_w) * jax.nn.silu(gateA.reshape(B, T, GDN_HEADS, GDN_DV))
    oA = oA.reshape(B, T, GDN_V)

    lb = lb.reshape(HG_HEADS, HG_DK)
    f_raw = f_raw.reshape(B, T, HG_HEADS, HG_DK)
    logf = jnp.log(lb + (1.0 - lb) * jax.nn.sigmoid(f_raw))
    kB = (1.0 - lb) * jax.nn.sigmoid(-f_raw)
    qB = jax.nn.silu(qB.reshape(B, T, HG_HEADS, HG_DK))
    oB = hgrn2_chunked(qB, kB, iB.reshape(B, T, HG_HEADS, HG_DV), logf).reshape(B, T, HG_V)
    oB = rms_norm(oB, hg_norm_w) * jax.nn.silu(gateB)

    o = jnp.concatenate([oA, oB], axis=-1).astype(h.dtype)
    return jnp.einsum('bte,ed->btd', o, w_out)


def moe(h, w_router, router_bias, w_gate, w_up, w_down, ws_gate, ws_up, ws_down):
    B, T, D = h.shape
    xt = h.reshape(-1, D)
    M = xt.shape[0]
    scores = jax.nn.sigmoid(xt.astype(jnp.float32) @ w_router.astype(jnp.float32))
    sel = scores + router_bias.astype(jnp.float32)
    group_score = lax.top_k(sel.reshape(M, N_GROUPS, N_EXPERTS // N_GROUPS), 2)[0].sum(-1)
    _, gidx = lax.top_k(group_score, TOPK_GROUPS)
    gmask = jax.nn.one_hot(gidx, N_GROUPS, dtype=jnp.float32).sum(-2) > 0
    emask = jnp.repeat(gmask, N_EXPERTS // N_GROUPS, axis=-1)
    _, eidx = lax.top_k(jnp.where(emask, sel, -jnp.inf), TOP_K)
    wts = jnp.take_along_axis(scores, eidx, axis=-1)
    wts = wts / jnp.sum(wts, axis=-1, keepdims=True) * ROUTE_SCALE
    gates = jnp.einsum('mk,mke->me', wts, jax.nn.one_hot(eidx, N_EXPERTS, dtype=wts.dtype)).astype(h.dtype)

    def expert_block(args):
        x_b, g_b = args
        hg = jnp.einsum('td,edf->tef', x_b, w_gate)
        hu = jnp.einsum('td,edf->tef', x_b, w_up)
        return jnp.einsum('tef,efd->td', jax.nn.silu(hg) * hu * g_b[..., None], w_down)

    routed = lax.map(expert_block, (xt.reshape(-1, MOE_BLOCK, D), gates.reshape(-1, MOE_BLOCK, N_EXPERTS)))
    shared = (jax.nn.silu(xt @ ws_gate) * (xt @ ws_up)) @ ws_down
    return (routed.reshape(M, D) + shared).reshape(B, T, D)


def setup_inputs(seed: int = 0) -> dict:
    key = jax.random.key(seed)
    ks = jax.random.split(key, 24)
    f32 = jnp.float32
    nrm = lambda k, s, sc: jax.random.normal(k, s, f32) * sc
    dt = jnp.exp(jax.random.uniform(ks[8], (DEPTH, GDN_HEADS), f32, np.log(1e-3), np.log(1e-1)))
    return {
        "x": nrm(ks[0], (BATCH, SEQ, D_MODEL), 1.0),
        "c": nrm(ks[1], (BATCH, D_MODEL), 1.0),
        "w_ada": nrm(ks[2], (DEPTH, D_MODEL, 6 * D_MODEL), 0.5 * D_MODEL ** -0.5),
        "b_ada": nrm(ks[3], (DEPTH, 6 * D_MODEL), 0.01),
        "norm1_w": 1.0 + nrm(ks[4], (DEPTH, D_MODEL), 0.02),
        "w_in": nrm(ks[5], (DEPTH, D_MODEL, D_IN), D_MODEL ** -0.5),
        "conv_w": nrm(ks[6], (DEPTH, CONV_K, 2 * GDN_QK + GDN_V), CONV_K ** -0.5),
        "gdn_a_log": jnp.log(jax.random.uniform(ks[7], (DEPTH, GDN_HEADS), f32, 1.0, 16.0)),
        "gdn_dt_bias": dt + jnp.log(-jnp.expm1(-dt)),
        "gdn_norm_w": 1.0 + nrm(ks[9], (DEPTH, GDN_DV), 0.02),
        "hg_lb": nrm(ks[10], (DEPTH + 1, HG_K), 0.1),
        "hg_norm_w": 1.0 + nrm(ks[11], (DEPTH, HG_V), 0.02),
        "w_out": nrm(ks[12], (DEPTH, D_MIX, D_MODEL), D_MIX ** -0.5),
        "norm2_w": 1.0 + nrm(ks[13], (DEPTH, D_MODEL), 0.02),
        "w_router": nrm(ks[14], (DEPTH, D_MODEL, N_EXPERTS), D_MODEL ** -0.5),
        "router_bias": nrm(ks[15], (DEPTH, N_EXPERTS), 0.01),
        "w_gate": nrm(ks[16], (DEPTH, N_EXPERTS, D_MODEL, D_EXPERT), D_MODEL ** -0.5),
        "w_up": nrm(ks[17], (DEPTH, N_EXPERTS, D_MODEL, D_EXPERT), D_MODEL ** -0.5),
        "w_down": nrm(ks[18], (DEPTH, N_EXPERTS, D_EXPERT, D_MODEL), D_EXPERT ** -0.5),
        "ws_gate": nrm(ks[19], (DEPTH, D_MODEL, D_SHARED), D_MODEL ** -0.5),
        "ws_up": nrm(ks[20], (DEPTH, D_MODEL, D_SHARED), D_MODEL ** -0.5),
        "ws_down": nrm(ks[21], (DEPTH, D_SHARED, D_MODEL), D_SHARED ** -0.5),
        "final_norm_w": 1.0 + nrm(ks[22], (D_MODEL,), 0.02),
    }


def reference(x, c, w_ada, b_ada, norm1_w, w_in, conv_w, gdn_a_log, gdn_dt_bias, gdn_norm_w,
              hg_lb, hg_norm_w, w_out, norm2_w, w_router, router_bias, w_gate, w_up, w_down,
              ws_gate, ws_up, ws_down, final_norm_w):
    lb_all = jnp.cumsum(jax.nn.softmax(hg_lb.astype(jnp.float32), axis=0), axis=0)
    c_act = jax.nn.silu(c)
    for l in range(DEPTH):
        mod = jnp.einsum('bd,de->be', c_act, w_ada[l]) + b_ada[l]
        sh1, sc1, g1, sh2, sc2, g2 = jnp.split(mod, 6, axis=-1)
        h = rms_norm(x, norm1_w[l]) * (1.0 + sc1[:, None]) + sh1[:, None]
        x = x + g1[:, None] * token_mixer(h, w_in[l], conv_w[l], gdn_a_log[l], gdn_dt_bias[l],
                                          gdn_norm_w[l], lb_all[l], hg_norm_w[l], w_out[l])
        h = rms_norm(x, norm2_w[l]) * (1.0 + sc2[:, None]) + sh2[:, None]
        x = x + g2[:, None] * moe(h, w_router[l], router_bias[l], w_gate[l], w_up[l], w_down[l],
                                  ws_gate[l], ws_up[l], ws_down[l])
    return rms_norm(x, final_norm_w)
```

```cpp
#include <hip/hip_runtime.h>
#include <cstdint>
#include <cstdio>

typedef unsigned short bf16;
__device__ __forceinline__ float bf2f(bf16 v) { return __uint_as_float(((unsigned)v) << 16); }
__device__ __forceinline__ bf16 f2bf(float f) { unsigned u = __float_as_uint(f); return (bf16)((u + 0x7fffu + ((u >> 16) & 1u)) >> 16); }
__device__ __forceinline__ float sigmoidf_(float x) { return 1.f / (1.f + __expf(-x)); }
__device__ __forceinline__ float siluf_(float x) { return x / (1.f + __expf(-x)); }
__device__ __forceinline__ float softplusf_(float x) { return x > 20.f ? x : log1pf(expf(x)); }

constexpr int BATCH = 2, T = 8192, D = 1024, M = BATCH * T, DIN = 4104, PITCH = 4352;
constexpr int NE = 64, NEX = 65, DE = 256, TOPK = 8;
__host__ __device__ __forceinline__ int proj_orig_col(int nc) { return nc < 2048 ? nc : (nc < 4096 ? nc + 8 : (nc < 4104 ? nc - 2048 : -1)); }

constexpr size_t MiB = 1u << 20;
constexpr size_t WS_CTL = 0, WS_MOD = 1 * MiB, WS_H1 = 2 * MiB, WS_H2 = 34 * MiB, WS_PROJ = 66 * MiB, WS_OA = 202 * MiB, WS_OB = 234 * MiB, WS_OMIX = 266 * MiB;
constexpr size_t WS_ACT = 66 * MiB, WS_ACC = 138 * MiB, WS_LIST = 202 * MiB, WS_LISTW = 208 * MiB;

__global__ __launch_bounds__(64) void k_mod(const float* c, const float* w_ada, const float* b_ada, float* mod) {
    const int e = blockIdx.x * 64 + threadIdx.x;
    float a0 = 0.f, a1 = 0.f;
    for (int d = 0; d < D; ++d) { const float w = w_ada[(size_t)d * 6144 + e]; a0 += siluf_(c[d]) * w; a1 += siluf_(c[D + d]) * w; }
    mod[e] = a0 + b_ada[e]; mod[6144 + e] = a1 + b_ada[e];
}
__global__ __launch_bounds__(256) void k_norm1(const float* x, const float* nw, const float* mod, bf16* h1) {
    const int row = blockIdx.x * 4 + (threadIdx.x >> 6), lane = threadIdx.x & 63, b = row / T;
    const float* xr = x + (size_t)row * D; float v[16]; float ss = 0.f;
    for (int j = 0; j < 16; ++j) { v[j] = xr[lane + 64 * j]; ss += v[j] * v[j]; }
    for (int o = 1; o < 64; o <<= 1) ss += __shfl_xor(ss, o);
    const float rstd = rsqrtf(ss * (1.f / D) + 1e-6f);
    const float* sh = mod + b * 6144; const float* sc = sh + 1024;
    for (int j = 0; j < 16; ++j) { const int d = lane + 64 * j; h1[(size_t)row * D + d] = f2bf(v[j] * rstd * nw[d] * (1.f + sc[d]) + sh[d]); }
}
template <class P> __global__ __launch_bounds__(256) void k_gemm(P p) {
    const int z = blockIdx.z, nr = p.nrows(z), r0 = blockIdx.y * 64, c0 = blockIdx.x * 64;
    if (r0 >= nr) return;
    __shared__ float As[16][65]; __shared__ float Bs[P::NB][16][65];
    const int t = threadIdx.x, ty = t >> 4, tx = t & 15;
    float acc[P::NB][4][4];
    for (int n = 0; n < P::NB; ++n) for (int i = 0; i < 4; ++i) for (int j = 0; j < 4; ++j) acc[n][i][j] = 0.f;
    const int ar = t >> 2, ak = (t & 3) * 4;
    const bf16* ap = (r0 + ar < nr) ? p.arow(z, r0 + ar) : nullptr;
    const int bk = t >> 4, bc = (t & 15) * 4;
    const int K = p.K();
    for (int k0 = 0; k0 < K; k0 += 16) {
        for (int i = 0; i < 4; ++i) As[ak + i][ar] = ap ? bf2f(ap[k0 + ak + i]) : 0.f;
        for (int n = 0; n < P::NB; ++n) for (int j = 0; j < 4; ++j) Bs[n][bk][bc + j] = p.b(z, n, k0 + bk, c0 + bc + j);
        __syncthreads();
#pragma unroll
        for (int k = 0; k < 16; ++k) {
            float a[4]; for (int i = 0; i < 4; ++i) a[i] = As[k][ty * 4 + i];
            for (int n = 0; n < P::NB; ++n) { float bb[4]; for (int j = 0; j < 4; ++j) bb[j] = Bs[n][k][tx * 4 + j];
                for (int i = 0; i < 4; ++i) for (int j = 0; j < 4; ++j) acc[n][i][j] += a[i] * bb[j]; }
        }
        __syncthreads();
    }
    for (int i = 0; i < 4; ++i) { const int r = r0 + ty * 4 + i; if (r >= nr) continue;
        for (int j = 0; j < 4; ++j) { const int c = c0 + tx * 4 + j; if (P::NB == 2) p.store(z, r, c, acc[0][i][j], acc[P::NB - 1][i][j]); else p.store(z, r, c, acc[0][i][j], 0.f); } }
}
struct PProj { static constexpr int NB = 1; const bf16* h1; const float* w_in; bf16* proj;
    __device__ int nrows(int) const { return M; } __device__ int K() const { return D; }
    __device__ const bf16* arow(int, int r) const { return h1 + (size_t)r * D; }
    __device__ float b(int, int, int k, int c) const { const int oc = proj_orig_col(c); return oc >= 0 ? w_in[(size_t)k * DIN + oc] : 0.f; }
    __device__ void store(int, int r, int c, float v, float) const { proj[(size_t)r * PITCH + c] = f2bf(v); } };
struct PWout { static constexpr int NB = 1; const bf16* omix; const float* w_out; const float* x; const float* mod; float* x2;
    __device__ int nrows(int) const { return M; } __device__ int K() const { return D; }
    __device__ const bf16* arow(int, int r) const { return omix + (size_t)r * D; }
    __device__ float b(int, int, int k, int c) const { return w_out[(size_t)k * D + c]; }
    __device__ void store(int, int r, int c, float v, float) const { const int bb = r / T; x2[(size_t)r * D + c] = x[(size_t)r * D + c] + mod[bb * 6144 + 2048 + c] * v; } };
struct PMoe1 { static constexpr int NB = 2; const bf16* h2; const float *wg, *wu, *wsg, *wsu; const unsigned* ctl; const int* list; const float* listw; bf16* act;
    __device__ int nrows(int z) const { return (int)ctl[z]; } __device__ int K() const { return D; }
    __device__ const bf16* arow(int z, int r) const { return h2 + (size_t)list[(size_t)z * M + r] * D; }
    __device__ float b(int z, int n, int k, int c) const { const float* w = z < NE ? (n == 0 ? wg : wu) + (size_t)z * D * DE : (n == 0 ? wsg : wsu); return w[(size_t)k * DE + c]; }
    __device__ void store(int z, int r, int c, float g, float u) const { act[((size_t)ctl[128 + z] + r) * DE + c] = f2bf(siluf_(g) * u * listw[(size_t)z * M + r]); } };
struct PMoe2 { static constexpr int NB = 1; const bf16* act; const float *wd, *wsd; const unsigned* ctl; const int* list; float* accb;
    __device__ int nrows(int z) const { return (int)ctl[z]; } __device__ int K() const { return DE; }
    __device__ const bf16* arow(int z, int r) const { return act + ((size_t)ctl[128 + z] + r) * DE; }
    __device__ float b(int z, int, int k, int c) const { const float* w = z < NE ? wd + (size_t)z * DE * D : wsd; return w[(size_t)k * D + c]; }
    __device__ void store(int z, int r, int c, float v, float) const { atomicAdd(&accb[(size_t)list[(size_t)z * M + r] * D + c], v); } };

__global__ __launch_bounds__(128) void k_gdn(const bf16* proj, const float* conv_w, const float* a_log, const float* dt_bias, float* oA) {
    const int b = blockIdx.x >> 2, h = blockIdx.x & 3, j = threadIdx.x;
    __shared__ float sq[128], sk[128], red[2][2];
    float S[128];
#pragma unroll
    for (int d = 0; d < 128; ++d) S[d] = 0.f;
    float cq[4], ck[4], cv[4];
    for (int i = 0; i < 4; ++i) { cq[i] = conv_w[i * 1536 + h * 128 + j]; ck[i] = conv_w[i * 1536 + 512 + h * 128 + j]; cv[i] = conv_w[i * 1536 + 1024 + h * 128 + j]; }
    const float A = expf(a_log[h]), dtb = dt_bias[h];
    float pq0 = 0, pq1 = 0, pq2 = 0, pk0 = 0, pk1 = 0, pk2 = 0, pv0 = 0, pv1 = 0, pv2 = 0;
    for (int t = 0; t < T; ++t) {
        const size_t row = (size_t)b * T + t; const bf16* pr = proj + row * PITCH;
        const float xq = bf2f(pr[h * 128 + j]), xk = bf2f(pr[512 + h * 128 + j]), xv = bf2f(pr[1024 + h * 128 + j]);
        const float q = siluf_(cq[0] * pq0 + cq[1] * pq1 + cq[2] * pq2 + cq[3] * xq);
        const float k = siluf_(ck[0] * pk0 + ck[1] * pk1 + ck[2] * pk2 + ck[3] * xk);
        const float v = siluf_(cv[0] * pv0 + cv[1] * pv1 + cv[2] * pv2 + cv[3] * xv);
        pq0 = pq1; pq1 = pq2; pq2 = xq; pk0 = pk1; pk1 = pk2; pk2 = xk; pv0 = pv1; pv1 = pv2; pv2 = xv;
        float s1 = q * q, s2 = k * k;
        for (int o = 1; o < 64; o <<= 1) { s1 += __shfl_xor(s1, o); s2 += __shfl_xor(s2, o); }
        if ((j & 63) == 0) { red[j >> 6][0] = s1; red[j >> 6][1] = s2; }
        __syncthreads();
        s1 = red[0][0] + red[1][0]; s2 = red[0][1] + red[1][1];
        sq[j] = q * rsqrtf(s1 + 1e-6f) * 0.08838834764831845f; sk[j] = k * rsqrtf(s2 + 1e-6f);
        __syncthreads();
        const float beta = sigmoidf_(bf2f(pr[4096 + h])); const float g = -A * softplusf_(bf2f(pr[4100 + h]) + dtb); const float a = expf(g);
        float kS = 0.f;
#pragma unroll
        for (int d = 0; d < 128; ++d) kS += sk[d] * S[d];
        const float vn = beta * (v - a * kS);
        float o = 0.f;
#pragma unroll
        for (int d = 0; d < 128; ++d) { S[d] = a * S[d] + sk[d] * vn; o += sq[d] * S[d]; }
        oA[row * 512 + h * 128 + j] = o;
        __syncthreads();
    }
}
__global__ __launch_bounds__(128) void k_hgrn(const bf16* proj, const float* hg_lb, float* oB) {
    const int b = blockIdx.x >> 2, h = blockIdx.x & 3, j = threadIdx.x;
    __shared__ float sf[128], sk[128], sq[128];
    float S[128];
#pragma unroll
    for (int d = 0; d < 128; ++d) S[d] = 0.f;
    const float l0 = hg_lb[h * 128 + j], l1 = hg_lb[512 + h * 128 + j]; const float mx = fmaxf(l0, l1);
    const float e0 = expf(l0 - mx), e1 = expf(l1 - mx); const float lb = e0 / (e0 + e1);
    for (int t = 0; t < T; ++t) {
        const size_t row = (size_t)b * T + t; const bf16* pr = proj + row * PITCH;
        const float fr = bf2f(pr[2048 + h * 128 + j]), iv = bf2f(pr[2560 + h * 128 + j]), qr = bf2f(pr[3072 + h * 128 + j]);
        const float sg = sigmoidf_(fr);
        sf[j] = lb + (1.f - lb) * sg; sk[j] = (1.f - lb) * (1.f - sg); sq[j] = siluf_(qr);
        __syncthreads();
        float o = 0.f;
#pragma unroll
        for (int d = 0; d < 128; ++d) { S[d] = sf[d] * S[d] + sk[d] * iv; o += sq[d] * S[d]; }
        oB[row * 512 + h * 128 + j] = o;
        __syncthreads();
    }
}
__global__ __launch_bounds__(256) void k_mixout(const float* oA, const float* oB, const bf16* proj, const float* gdn_w, const float* hg_w, bf16* omix) {
    const int row = blockIdx.x * 4 + (threadIdx.x >> 6), lane = threadIdx.x & 63;
    const float* a = oA + (size_t)row * 512 + lane * 8; const float* bq = oB + (size_t)row * 512 + lane * 8; const bf16* pr = proj + (size_t)row * PITCH;
    float va[8], vb[8]; float sa = 0.f, sb = 0.f;
    for (int i = 0; i < 8; ++i) { va[i] = a[i]; vb[i] = bq[i]; sa += va[i] * va[i]; sb += vb[i] * vb[i]; }
    for (int o = 1; o < 16; o <<= 1) sa += __shfl_xor(sa, o);
    for (int o = 1; o < 64; o <<= 1) sb += __shfl_xor(sb, o);
    const float ra = rsqrtf(sa * (1.f / 128.f) + 1e-6f), rb = rsqrtf(sb * (1.f / 512.f) + 1e-6f);
    for (int i = 0; i < 8; ++i) { const int c = lane * 8 + i;
        omix[(size_t)row * D + c] = f2bf(va[i] * ra * gdn_w[c & 127] * siluf_(bf2f(pr[1536 + c])));
        omix[(size_t)row * D + 512 + c] = f2bf(vb[i] * rb * hg_w[c] * siluf_(bf2f(pr[3584 + c]))); }
}
__global__ __launch_bounds__(256) void k_route(const float* x2, const float* nw, const float* mod, const float* w_router, const float* rbias, bf16* h2, unsigned* ctl, int* list, float* listw) {
    __shared__ float hs[4][1024]; __shared__ float ssel[4][64], ssc[4][64];
    const int w = threadIdx.x >> 6, row = blockIdx.x * 4 + w, lane = threadIdx.x & 63, b = row / T;
    const float* xr = x2 + (size_t)row * D; float v[16]; float ss = 0.f;
    for (int j = 0; j < 16; ++j) { v[j] = xr[lane + 64 * j]; ss += v[j] * v[j]; }
    for (int o = 1; o < 64; o <<= 1) ss += __shfl_xor(ss, o);
    const float rstd = rsqrtf(ss * (1.f / D) + 1e-6f);
    const float* sh = mod + b * 6144 + 3072; const float* sc = sh + 1024;
    for (int j = 0; j < 16; ++j) { const int d = lane + 64 * j; const float hv = v[j] * rstd * nw[d] * (1.f + sc[d]) + sh[d]; hs[w][d] = hv; h2[(size_t)row * D + d] = f2bf(hv); }
    __syncthreads();
    float acc = 0.f;
    for (int d = 0; d < D; ++d) acc += hs[w][d] * w_router[d * 64 + lane];
    const float score = sigmoidf_(acc);
    ssc[w][lane] = score; ssel[w][lane] = score + rbias[lane];
    __syncthreads();
    if (lane == 0) {
        float gs[8];
        for (int g = 0; g < 8; ++g) { float m1 = -INFINITY, m2 = -INFINITY; for (int i = 0; i < 8; ++i) { const float s = ssel[w][g * 8 + i]; if (s > m1) { m2 = m1; m1 = s; } else if (s > m2) m2 = s; } gs[g] = m1 + m2; }
        unsigned gmask = 0;
        for (int r = 0; r < 4; ++r) { int best = -1; float bv = -INFINITY; for (int g = 0; g < 8; ++g) if (!((gmask >> g) & 1) && (best < 0 || gs[g] > bv)) { best = g; bv = gs[g]; } gmask |= 1u << best; }
        unsigned long long chosen = 0ull; int ei[8]; float ew[8]; float wsum = 0.f;
        for (int r = 0; r < 8; ++r) { int best = -1; float bv = -INFINITY;
            for (int e = 0; e < 64; ++e) if (((gmask >> (e >> 3)) & 1) && !((chosen >> e) & 1ull) && (best < 0 || ssel[w][e] > bv)) { best = e; bv = ssel[w][e]; }
            chosen |= 1ull << best; ei[r] = best; ew[r] = ssc[w][best]; wsum += ew[r]; }
        for (int r = 0; r < 8; ++r) { const unsigned pos = atomicAdd(&ctl[ei[r]], 1u); list[(size_t)ei[r] * M + pos] = row; listw[(size_t)ei[r] * M + pos] = ew[r] / wsum * 2.5f; }
        list[(size_t)NE * M + row] = row; listw[(size_t)NE * M + row] = 1.f;
    }
}
__global__ void k_offsets(unsigned* ctl) { if (threadIdx.x == 0) { ctl[NE] = M; unsigned run = 0; for (int e = 0; e < NEX; ++e) { ctl[128 + e] = run; run += ctl[e]; } } }
__global__ __launch_bounds__(256) void k_final(float* xo, const float* accb, const float* mod, const float* fw) {
    const int row = blockIdx.x * 4 + (threadIdx.x >> 6), lane = threadIdx.x & 63, b = row / T;
    float* xr = xo + (size_t)row * D; const float* ar = accb + (size_t)row * D; const float* g2 = mod + b * 6144 + 5120;
    float v[16]; float ss = 0.f;
    for (int j = 0; j < 16; ++j) { const int d = lane + 64 * j; v[j] = xr[d] + g2[d] * ar[d]; ss += v[j] * v[j]; }
    for (int o = 1; o < 64; o <<= 1) ss += __shfl_xor(ss, o);
    const float rstd = rsqrtf(ss * (1.f / D) + 1e-6f);
    for (int j = 0; j < 16; ++j) { const int d = lane + 64 * j; xr[d] = v[j] * rstd * fw[d]; }
}

extern "C" void kernel_launch(void* const* d_in, const int* in_sizes, int n_in, void* d_out, int out_size, void* d_ws, size_t ws_size, hipStream_t stream) {
    const float* x = (const float*)d_in[0]; const float* c = (const float*)d_in[1]; const float* w_ada = (const float*)d_in[2]; const float* b_ada = (const float*)d_in[3];
    const float* norm1_w = (const float*)d_in[4]; const float* w_in = (const float*)d_in[5]; const float* conv_w = (const float*)d_in[6]; const float* a_log = (const float*)d_in[7];
    const float* dt_bias = (const float*)d_in[8]; const float* gdn_norm_w = (const float*)d_in[9]; const float* hg_lb = (const float*)d_in[10]; const float* hg_norm_w = (const float*)d_in[11];
    const float* w_out = (const float*)d_in[12]; const float* norm2_w = (const float*)d_in[13]; const float* w_router = (const float*)d_in[14]; const float* router_bias = (const float*)d_in[15];
    const float* w_gate = (const float*)d_in[16]; const float* w_up = (const float*)d_in[17]; const float* w_down = (const float*)d_in[18];
    const float* ws_gate = (const float*)d_in[19]; const float* ws_up = (const float*)d_in[20]; const float* ws_down = (const float*)d_in[21]; const float* final_w = (const float*)d_in[22];
    unsigned char* ws = (unsigned char*)d_ws; float* out = (float*)d_out;
    unsigned* ctl = (unsigned*)(ws + WS_CTL); float* mod = (float*)(ws + WS_MOD); bf16* h1 = (bf16*)(ws + WS_H1); bf16* h2 = (bf16*)(ws + WS_H2); bf16* proj = (bf16*)(ws + WS_PROJ);
    float* oA = (float*)(ws + WS_OA); float* oB = (float*)(ws + WS_OB); bf16* omix = (bf16*)(ws + WS_OMIX);
    bf16* act = (bf16*)(ws + WS_ACT); float* accb = (float*)(ws + WS_ACC); int* list = (int*)(ws + WS_LIST); float* listw = (float*)(ws + WS_LISTW);
    hipMemsetAsync(ctl, 0, 4096, stream);
    k_mod<<<6144 / 64, 64, 0, stream>>>(c, w_ada, b_ada, mod);
    k_norm1<<<M / 4, 256, 0, stream>>>(x, norm1_w, mod, h1);
    { PProj p{h1, w_in, proj}; k_gemm<PProj><<<dim3(PITCH / 64, M / 64, 1), 256, 0, stream>>>(p); }
    k_gdn<<<8, 128, 0, stream>>>(proj, conv_w, a_log, dt_bias, oA);
    k_hgrn<<<8, 128, 0, stream>>>(proj, hg_lb, oB);
    k_mixout<<<M / 4, 256, 0, stream>>>(oA, oB, proj, gdn_norm_w, hg_norm_w, omix);
    { PWout p{omix, w_out, x, mod, out}; k_gemm<PWout><<<dim3(D / 64, M / 64, 1), 256, 0, stream>>>(p); }
    k_route<<<M / 4, 256, 0, stream>>>(out, norm2_w, mod, w_router, router_bias, h2, ctl, list, listw);
    k_offsets<<<1, 64, 0, stream>>>(ctl);
    hipMemsetAsync(accb, 0, (size_t)M * D * 4, stream);
    { PMoe1 p{h2, w_gate, w_up, ws_gate, ws_up, ctl, list, listw, act}; k_gemm<PMoe1><<<dim3(DE / 64, M / 64, NEX), 256, 0, stream>>>(p); }
    { PMoe2 p{act, w_down, ws_down, ctl, list, accb}; k_gemm<PMoe2><<<dim3(D / 64, M / 64, NEX), 256, 0, stream>>>(p); }
    k_final<<<M / 4, 256, 0, stream>>>(out, accb, mod, final_w);
}
```

```cpp
#define REP_PHASE 4
#define REP_N 3
#include <hip/hip_runtime.h>
#include <cstdio>
#include <cstdint>
namespace pg8 {
#define PG8_LAS __attribute__((address_space(3)))
typedef unsigned short bf16_t;
typedef short bf16x8 __attribute__((ext_vector_type(8)));
typedef float f32x4 __attribute__((ext_vector_type(4)));
typedef unsigned u32x4 __attribute__((ext_vector_type(4)));
constexpr int BM = 256, BK = 64, HALF = 128, HTB = HALF * BK * 2  , STAGE_BYTES = 8 * HTB, NXCD = 8, WGM = 8;

__host__ __device__ __forceinline__ int lds_byte(int r, int c) { const int st = (r >> 4) * 2 + (c >> 5), rr = r & 15, cc = c & 31, ob = rr * 64 + cc * 2; return st * 1024 + (ob ^ (((ob >> 9) & 1) << 5)); }
__host__ __device__ __forceinline__ void stage_rc(int b, int& R, int& C) { const int st = b / 1024, sb = b % 1024, swz = sb ^ (((sb >> 9) & 1) << 5); R = (st >> 1) * 16 + swz / 64; C = (st & 1) * 32 + (swz % 64) / 2; }
__host__ __device__ __forceinline__ int perm32(int rho) { const int n = rho >> 4, i = rho & 15; return 8 * (i >> 2) + 4 * n + (i & 3); }

struct Unit { int pm, pn; };
struct Gemm { const bf16_t* A; const bf16_t* Bt; int M, N, K; };

struct StaticOrder {
    int nM, nN, nwg, G, c;
    __host__ __device__ void init(int M, int N, int G_, int c_) { nM = M / BM; nN = N / BM; nwg = nM * nN; G = G_; c = c_; }
    __host__ __device__ bool next(int i, Unit& u) const {
        const long L = (long)i * G + c; if (L >= nwg) return false;
        int wgid = (int)L; { const int q = nwg / NXCD, r = nwg % NXCD, xcd = wgid % NXCD, off = wgid / NXCD; wgid = (xcd < r ? xcd * (q + 1) : r * (q + 1) + (xcd - r) * q) + off; }
        const int nig = WGM * nN, gid = wgid / nig, fm = gid * WGM, gsz = (nM - fm) < WGM ? (nM - fm) : WGM;
        u.pm = fm + ((wgid % nig) % gsz); u.pn = (wgid % nig) / gsz; return true;
    }
    __device__ __forceinline__ void a_ready(const Unit&) const {}
    __device__ __forceinline__ void done(const Unit&) const {}
};
__device__ __forceinline__ unsigned cvt_pk_bf16(float lo, float hi) { unsigned r; asm volatile("v_cvt_pk_bf16_f32 %0, %1, %2" : "=v"(r) : "v"(lo), "v"(hi)); return r; }
template <class Epi, class Sched, bool ALIGN_EPI = false, bool SP2 = false>
__device__ __forceinline__ void gemm_phase(PG8_LAS unsigned char* lds, const Gemm g, const Sched& S, const Epi& E) {
    const int tid = threadIdx.x, wid = __builtin_amdgcn_readfirstlane(tid >> 6), lane = tid & 63, wr = wid >> 2, wc = wid & 3, fr = lane & 15, fq = lane >> 4;
    const int K = g.K, nt = K / BK;
    unsigned voffA[2], voffB[2];
#pragma unroll
    for (int i = 0; i < 2; ++i) { int R, C; stage_rc(tid * 16 + i * 8192, R, C); const int Rb = Epi::PERM ? ((R & ~31) + perm32(R & 31)) : R;
        voffA[i] = (unsigned)(R * K + C) * 2u; voffB[i] = (unsigned)(Rb * K + C) * 2u; }
    const size_t kstep = (size_t)(BK * 2);
    const size_t hstep = (size_t)HALF * K * 2;
    const size_t tstep = 2 * hstep;
    const unsigned ldsw = (unsigned)wid * 1024u;
    const int aoff = lds_byte(wr * 64 + fr, fq * 8), boff = lds_byte(wc * 32 + fr, fq * 8);
#define PG8_SA(b, h) (((b) * 2 + (h)) * HTB)
#define PG8_SB(b, h) ((4 + (b) * 2 + (h)) * HTB)
#define PG8_STAGE(bufoff, gbase, voff) do { _Pragma("unroll") for (int _i = 0; _i < 2; ++_i) \
        __builtin_amdgcn_global_load_lds((const unsigned*)((const char*)(gbase) + (voff)[_i]), (PG8_LAS unsigned*)(lds + (bufoff) + ldsw + _i * 8192), 16, 0, 0); } while (0)
#define PG8_LDA(dst, b, h) do { _Pragma("unroll") for (int m = 0; m < 4; ++m) _Pragma("unroll") for (int k = 0; k < 2; ++k) dst[m][k] = *(const PG8_LAS bf16x8*)(lds + PG8_SA(b, h) + aoff + m * 2048 + k * 1024); } while (0)
#define PG8_LDB(dst, b, h) do { _Pragma("unroll") for (int n = 0; n < 2; ++n) _Pragma("unroll") for (int k = 0; k < 2; ++k) dst[n][k] = *(const PG8_LAS bf16x8*)(lds + PG8_SB(b, h) + boff + n * 2048 + k * 1024); } while (0)
#define PG8_MMA(ai, bj, At, Bt) do { __builtin_amdgcn_s_setprio(1); _Pragma("unroll") for (int m = 0; m < 4; ++m) _Pragma("unroll") for (int n = 0; n < 2; ++n) _Pragma("unroll") for (int k = 0; k < 2; ++k) \
        acc[ai][bj][m][n] = __builtin_amdgcn_mfma_f32_16x16x32_bf16(Bt[n][k], At[m][k], acc[ai][bj][m][n], 0, 0, 0); __builtin_amdgcn_s_setprio(0); } while (0)
#define PG8_WAIT_V(n) asm volatile("s_waitcnt vmcnt(" #n ")" ::: "memory")
#define PG8_WAIT_L(n) asm volatile("s_waitcnt lgkmcnt(" #n ")" ::: "memory")
#define PG8_BAR __builtin_amdgcn_s_barrier()
#define PG8_SCHED __builtin_amdgcn_sched_barrier(0)
    Unit cur, nxt; int ui = 0;
    if (!S.next(0, cur)) return;
    f32x4 acc[2][2][4][2];
#pragma unroll
    for (int a = 0; a < 2; ++a)
#pragma unroll
        for (int b = 0; b < 2; ++b)
#pragma unroll
            for (int m = 0; m < 4; ++m)
#pragma unroll
                for (int n = 0; n < 2; ++n) acc[a][b][m][n] = (f32x4){0.f, 0.f, 0.f, 0.f};
    bf16x8 At[4][2], B0[2][2], B1[2][2];
    const char* cA = (const char*)g.A + (size_t)cur.pm * tstep; const char* cB = (const char*)g.Bt + (size_t)cur.pn * tstep;
    S.a_ready(cur);
    if constexpr (SP2) {
        PG8_STAGE(PG8_SB(0, 0), cB, voffB); PG8_STAGE(PG8_SB(0, 1), cB + hstep, voffB); PG8_STAGE(PG8_SA(0, 0), cA, voffA); PG8_STAGE(PG8_SA(0, 1), cA + hstep, voffA);
        if (wr == 1) PG8_BAR;
        PG8_WAIT_V(2); PG8_BAR;
        PG8_STAGE(PG8_SB(1, 0), cB + kstep, voffB); PG8_STAGE(PG8_SA(1, 0), cA + kstep, voffA); PG8_STAGE(PG8_SB(1, 1), cB + hstep + kstep, voffB);
        PG8_WAIT_V(6); PG8_BAR;
    } else {
        PG8_STAGE(PG8_SB(0, 0), cB, voffB); PG8_STAGE(PG8_SA(0, 0), cA, voffA); PG8_STAGE(PG8_SB(0, 1), cB + hstep, voffB); PG8_STAGE(PG8_SA(0, 1), cA + hstep, voffA);
        if (wr == 1) PG8_BAR;
        PG8_WAIT_V(4); PG8_BAR;
        PG8_STAGE(PG8_SB(1, 0), cB + kstep, voffB); PG8_STAGE(PG8_SA(1, 0), cA + kstep, voffA); PG8_STAGE(PG8_SB(1, 1), cB + hstep + kstep, voffB);
        PG8_WAIT_V(6); PG8_BAR;
    }
    for (;;) {
        const bool has_next = S.next(ui + 1, nxt);
        const char* nA = has_next ? (const char*)g.A + (size_t)nxt.pm * tstep : cA; const char* nB = has_next ? (const char*)g.Bt + (size_t)nxt.pn * tstep : cB;
        for (int t = 0; t < nt; t += 2) {
            const bool last = (t == nt - 2);
            const char* a1 = cA + (size_t)(t + 1) * kstep;
            const char* a2 = last ? nA : cA + (size_t)(t + 2) * kstep; const char* b2 = last ? nB : cB + (size_t)(t + 2) * kstep;
            const char* a3 = a2 + kstep; const char* b3 = b2 + kstep;
            if (last && has_next) S.a_ready(nxt);
            if constexpr (SP2) {
            PG8_LDB(B0, 0, 0); PG8_LDB(B1, 0, 1); PG8_SCHED; PG8_LDA(At, 0, 0); PG8_STAGE(PG8_SA(1, 1), a1 + hstep, voffA);
            PG8_WAIT_V(8); PG8_WAIT_L(0); PG8_BAR; PG8_MMA(0, 0, At, B0); PG8_MMA(0, 1, At, B1); PG8_BAR; PG8_SCHED;
            PG8_LDA(At, 0, 1); PG8_STAGE(PG8_SB(0, 0), b2, voffB); PG8_STAGE(PG8_SB(0, 1), b2 + hstep, voffB); PG8_STAGE(PG8_SA(0, 0), a2, voffA);
            PG8_WAIT_V(8); PG8_WAIT_L(0); PG8_BAR; PG8_MMA(1, 0, At, B0); PG8_MMA(1, 1, At, B1); PG8_BAR; PG8_SCHED;
            PG8_LDB(B0, 1, 0); PG8_LDB(B1, 1, 1); PG8_SCHED; PG8_LDA(At, 1, 0); PG8_STAGE(PG8_SA(0, 1), a2 + hstep, voffA);
            PG8_WAIT_V(8); PG8_WAIT_L(0); PG8_BAR; PG8_MMA(0, 0, At, B0); PG8_MMA(0, 1, At, B1); PG8_BAR; PG8_SCHED;
            PG8_LDA(At, 1, 1); PG8_STAGE(PG8_SB(1, 0), b3, voffB); PG8_STAGE(PG8_SB(1, 1), b3 + hstep, voffB); PG8_STAGE(PG8_SA(1, 0), a3, voffA);
            PG8_WAIT_V(8); PG8_WAIT_L(0); PG8_BAR; PG8_MMA(1, 0, At, B0); PG8_MMA(1, 1, At, B1); PG8_BAR; PG8_SCHED;
            } else {
            PG8_LDB(B0, 0, 0); PG8_SCHED; PG8_LDA(At, 0, 0); PG8_STAGE(PG8_SA(1, 1), a1 + hstep, voffA);
            PG8_WAIT_L(8); PG8_BAR; PG8_WAIT_L(0); PG8_MMA(0, 0, At, B0); PG8_BAR; PG8_SCHED;
            PG8_LDB(B1, 0, 1); PG8_STAGE(PG8_SB(0, 0), b2, voffB);
            PG8_BAR; PG8_WAIT_L(0); PG8_MMA(0, 1, At, B1); PG8_BAR;
            PG8_LDA(At, 0, 1); PG8_STAGE(PG8_SA(0, 0), a2, voffA);
            PG8_BAR; PG8_WAIT_L(0); PG8_MMA(1, 0, At, B0); PG8_BAR; PG8_SCHED;
            PG8_STAGE(PG8_SB(0, 1), b2 + hstep, voffB);
            PG8_WAIT_V(6); PG8_BAR; PG8_MMA(1, 1, At, B1); PG8_BAR;
            PG8_LDB(B0, 1, 0); PG8_SCHED; PG8_LDA(At, 1, 0); PG8_STAGE(PG8_SA(0, 1), a2 + hstep, voffA);
            PG8_WAIT_L(8); PG8_BAR; PG8_WAIT_L(0); PG8_MMA(0, 0, At, B0); PG8_BAR; PG8_SCHED;
            PG8_LDB(B1, 1, 1); PG8_STAGE(PG8_SB(1, 0), b3, voffB);
            PG8_BAR; PG8_WAIT_L(0); PG8_MMA(0, 1, At, B1); PG8_BAR;
            PG8_LDA(At, 1, 1); PG8_STAGE(PG8_SA(1, 0), a3, voffA);
            PG8_BAR; PG8_WAIT_L(0); PG8_MMA(1, 0, At, B0); PG8_BAR; PG8_SCHED;
            PG8_STAGE(PG8_SB(1, 1), b3 + hstep, voffB);
            PG8_WAIT_V(6); PG8_BAR; PG8_MMA(1, 1, At, B1); PG8_BAR;
            }
        }
        if constexpr (ALIGN_EPI) { if (wr == 0) PG8_BAR; }
        if constexpr (!Epi::AFTER_DRAIN) { E(acc, cur, wr, wc, fr, fq); S.done(cur); }
        if (!has_next) break;
#pragma unroll
        for (int a = 0; a < 2; ++a)
#pragma unroll
            for (int b = 0; b < 2; ++b)
#pragma unroll
                for (int m = 0; m < 4; ++m)
#pragma unroll
                    for (int n = 0; n < 2; ++n) acc[a][b][m][n] = (f32x4){0.f, 0.f, 0.f, 0.f};
        cur = nxt; cA = nA; cB = nB; ++ui;
        if constexpr (ALIGN_EPI) { if (wr == 1) PG8_BAR; }
    }
    PG8_WAIT_V(0);
    if constexpr (!ALIGN_EPI) { if (wr == 0) PG8_BAR; }
    PG8_BAR;
    if constexpr (Epi::AFTER_DRAIN) { E.fused(acc, cur, wr, wc, fr, fq, lds, wid, lane); S.done(cur); }
#undef PG8_SA
#undef PG8_SB
#undef PG8_STAGE
#undef PG8_LDA
#undef PG8_LDB
#undef PG8_MMA
#undef PG8_WAIT_V
#undef PG8_WAIT_L
#undef PG8_BAR
#undef PG8_SCHED
}
}
#define GAS __attribute__((address_space(1)))
#define LAS __attribute__((address_space(3)))
typedef unsigned short bf16;
typedef unsigned v4u __attribute__((ext_vector_type(4)));
typedef float f32x4 __attribute__((ext_vector_type(4)));
typedef short bf16x8 __attribute__((ext_vector_type(8)));
typedef GAS unsigned gu32;
typedef GAS unsigned long long gu64;
#define RLX_AGENT __ATOMIC_RELAXED, __HIP_MEMORY_SCOPE_AGENT
#define LDS_WAIT() asm volatile("s_waitcnt lgkmcnt(0)" ::: "memory")
#define VM_WAIT() asm volatile("s_waitcnt vmcnt(0)" ::: "memory")
__device__ __forceinline__ unsigned long long rt() { return __builtin_amdgcn_s_memrealtime(); }
__device__ __forceinline__ unsigned f2bf(float f) { unsigned u = __builtin_bit_cast(unsigned, f); return (u + 0x7fffu + ((u >> 16) & 1u)) >> 16; }
__device__ __forceinline__ unsigned pk2(float lo, float hi) { return f2bf(lo) | (f2bf(hi) << 16); }
#define XB_TMO      128
#define XB_XCNT(j)  (256  + 64 * (j))
#define XB_XSUB(j)  (1280 + 64 * (j))
#define XB_XGEN(j)  (2304 + 64 * (j))
#define XB_TOP      3328
#define XB_TOPGEN   3392
#define XCD_BAR_WORDS 3456
#define XB_SPIN_CAP (1u << 18)

__device__ __forceinline__ unsigned xb_ld(unsigned* p)              { return __hip_atomic_load(p, __ATOMIC_RELAXED, __HIP_MEMORY_SCOPE_AGENT); }
__device__ __forceinline__ unsigned xb_add(unsigned* p, unsigned v) { return __hip_atomic_fetch_add(p, v, __ATOMIC_RELAXED, __HIP_MEMORY_SCOPE_AGENT); }
__device__ __forceinline__ unsigned xb_xcc_id() { return (unsigned)__builtin_amdgcn_s_getreg((3 << 11) | 20) & 0xFu; }
#define XB_SPIN(cond, bar) do { unsigned _sp = 0; while (cond) { __builtin_amdgcn_s_sleep(1); \
    if ((++_sp & 255u) == 0u) { if (xb_ld(&(bar)[XB_TMO])) break; if (_sp > XB_SPIN_CAP) { atomicAdd(&(bar)[XB_TMO], 1u); break; } } } } while (0)

struct XcdBarrier {
    unsigned* bar; unsigned x;
    volatile LAS unsigned* st;
};

__device__ __forceinline__ XcdBarrier xcd_barrier_post(unsigned* bar, volatile LAS unsigned* st) {
    XcdBarrier b; b.bar = bar; b.x = xb_xcc_id(); b.st = st;
    if (threadIdx.x == 0) (void)xb_add(&bar[XB_XCNT(b.x)], 1u);
    return b;
}
__device__ __forceinline__ void xcd_barrier_complete(unsigned* bar, unsigned x, unsigned& nloc, unsigned& nx) {
    const unsigned G = gridDim.x * gridDim.y * gridDim.z;
    unsigned sum, cnt, mine, sp = 0u;
    for (;;) {
        sum = 0u; cnt = 0u; mine = 0u;
#pragma unroll
        for (unsigned j = 0; j < 16; ++j) { const unsigned c = xb_ld(&bar[XB_XCNT(j)]); sum += c; cnt += (c > 0u) ? 1u : 0u; mine = (j == x) ? c : mine; }
        if (sum == G) break;
        __builtin_amdgcn_s_sleep(1);
        if ((++sp & 255u) == 0u) { if (xb_ld(&bar[XB_TMO])) break; if (sp > XB_SPIN_CAP) { atomicAdd(&bar[XB_TMO], 1u); break; } }
    }
    nloc = mine > 0u ? mine : 1u; nx = cnt > 0u ? cnt : 1u;
}

__device__ __forceinline__ void xcd_barrier(const XcdBarrier& b) {
    asm volatile("s_waitcnt vmcnt(0)" ::: "memory");
    __syncthreads();
    if (threadIdx.x == 0) {
        unsigned* bar = b.bar;
        __builtin_amdgcn_s_waitcnt(0);
        unsigned nloc = b.st[0], nx = b.st[1];
        if (nloc == 0u) { xcd_barrier_complete(bar, b.x, nloc, nx); b.st[0] = nloc; b.st[1] = nx; }
        const unsigned old = xb_add(&bar[XB_XSUB(b.x)], 1u);
        const unsigned gen = old / nloc;
        if (old + 1u == (gen + 1u) * nloc) {
            __builtin_amdgcn_fence(__ATOMIC_RELEASE, "agent");
            asm volatile("s_waitcnt vmcnt(0)" ::: "memory");
            const unsigned og = xb_add(&bar[XB_TOP], 1u);
            const unsigned tg = og / nx;
            if (og + 1u == (tg + 1u) * nx) xb_add(&bar[XB_TOPGEN], 1u);
            else XB_SPIN(xb_ld(&bar[XB_TOPGEN]) == tg, bar);
            __builtin_amdgcn_fence(__ATOMIC_ACQUIRE, "agent");
            xb_add(&bar[XB_XGEN(b.x)], 1u);
            asm volatile("s_waitcnt vmcnt(0)" ::: "memory");
        } else {
            XB_SPIN(xb_ld(&bar[XB_XGEN(b.x)]) == gen, bar);
            __builtin_amdgcn_fence(__ATOMIC_ACQUIRE, "agent");
            asm volatile("s_waitcnt vmcnt(0)" ::: "memory");
        }
    }
    __syncthreads();
}

namespace pg8 {
struct UnitG { int seg, mt, nt; };
template <class Prob, class Epi>
__device__ __forceinline__ void gemm_phase_g(PG8_LAS unsigned char* lds, const Prob& P, const Epi& E) {
    const int tid = threadIdx.x, wid = __builtin_amdgcn_readfirstlane(tid >> 6), lane = tid & 63, wr = wid >> 2, wc = wid & 3, fr = lane & 15, fq = lane >> 4;
    const int K = P.K, nt = K / BK;
    int sR[2], sC[2]; unsigned voffB[2];
#pragma unroll
    for (int i = 0; i < 2; ++i) { int R, C; stage_rc(tid * 16 + i * 8192, R, C); const int Rb = Epi::PERM ? ((R & ~31) + perm32(R & 31)) : R; sR[i] = R; sC[i] = C; voffB[i] = (unsigned)(Rb * K + C) * 2u; }
    const size_t kstep = (size_t)(BK * 2);
    const size_t hstep = (size_t)HALF * K * 2;
    const unsigned ldsw = (unsigned)wid * 1024u;
    const int aoff = lds_byte(wr * 64 + fr, fq * 8), boff = lds_byte(wc * 32 + fr, fq * 8);
#define PG8_SA(b, h) (((b) * 2 + (h)) * HTB)
#define PG8_SB(b, h) ((4 + (b) * 2 + (h)) * HTB)
#define PG8_STAGE(bufoff, gbase, voff) do { _Pragma("unroll") for (int _i = 0; _i < 2; ++_i) \
        __builtin_amdgcn_global_load_lds((const unsigned*)((const char*)(gbase) + (voff)[_i]), (PG8_LAS unsigned*)(lds + (bufoff) + ldsw + _i * 8192), 16, 0, 0); } while (0)
#define PG8_LDA(dst, b, h) do { _Pragma("unroll") for (int m = 0; m < 4; ++m) _Pragma("unroll") for (int k = 0; k < 2; ++k) dst[m][k] = *(const PG8_LAS bf16x8*)(lds + PG8_SA(b, h) + aoff + m * 2048 + k * 1024); } while (0)
#define PG8_LDB(dst, b, h) do { _Pragma("unroll") for (int n = 0; n < 2; ++n) _Pragma("unroll") for (int k = 0; k < 2; ++k) dst[n][k] = *(const PG8_LAS bf16x8*)(lds + PG8_SB(b, h) + boff + n * 2048 + k * 1024); } while (0)
#define PG8_MMA(ai, bj, At, Bt) do { __builtin_amdgcn_s_setprio(1); _Pragma("unroll") for (int m = 0; m < 4; ++m) _Pragma("unroll") for (int n = 0; n < 2; ++n) _Pragma("unroll") for (int k = 0; k < 2; ++k) \
        acc[ai][bj][m][n] = __builtin_amdgcn_mfma_f32_16x16x32_bf16(Bt[n][k], At[m][k], acc[ai][bj][m][n], 0, 0, 0); __builtin_amdgcn_s_setprio(0); } while (0)
#define PG8_WAIT_V(n) asm volatile("s_waitcnt vmcnt(" #n ")" ::: "memory")
#define PG8_WAIT_L(n) asm volatile("s_waitcnt lgkmcnt(" #n ")" ::: "memory")
#define PG8_BAR __builtin_amdgcn_s_barrier()
#define PG8_SCHED __builtin_amdgcn_sched_barrier(0)
    UnitG cur, nxt; int ui = 0;
    if (!P.next(0, cur)) return;
    f32x4 acc[2][2][4][2];
#pragma unroll
    for (int a = 0; a < 2; ++a)
#pragma unroll
        for (int b = 0; b < 2; ++b)
#pragma unroll
            for (int m = 0; m < 4; ++m)
#pragma unroll
                for (int n = 0; n < 2; ++n) acc[a][b][m][n] = (f32x4){0.f, 0.f, 0.f, 0.f};
    bf16x8 At[4][2], B0[2][2], B1[2][2];
    unsigned offA[2][2], offAn[2][2];
    const char* cA; const char* cB;
    P.setup(cur, sR, sC, cA, offA, cB);
    PG8_STAGE(PG8_SB(0, 0), cB, voffB); PG8_STAGE(PG8_SB(0, 1), cB + hstep, voffB); PG8_STAGE(PG8_SA(0, 0), cA, offA[0]); PG8_STAGE(PG8_SA(0, 1), cA, offA[1]);
    if (wr == 1) PG8_BAR;
    PG8_WAIT_V(2); PG8_BAR;
    PG8_STAGE(PG8_SB(1, 0), cB + kstep, voffB); PG8_STAGE(PG8_SA(1, 0), cA + kstep, offA[0]); PG8_STAGE(PG8_SB(1, 1), cB + hstep + kstep, voffB);
    PG8_WAIT_V(6); PG8_BAR;
    for (;;) {
        const bool has_next = P.next(ui + 1, nxt);
        const char* nA = cA; const char* nB = cB;
#pragma unroll
        for (int h = 0; h < 2; ++h)
#pragma unroll
            for (int i = 0; i < 2; ++i) offAn[h][i] = offA[h][i];
        if (has_next) P.setup(nxt, sR, sC, nA, offAn, nB);
        for (int t = 0; t < nt; t += 2) {
            const bool last = (t == nt - 2);
            const char* a1 = cA + (size_t)(t + 1) * kstep;
            const char* a2 = last ? nA : cA + (size_t)(t + 2) * kstep; const char* b2 = last ? nB : cB + (size_t)(t + 2) * kstep;
            const char* a3 = a2 + kstep; const char* b3 = b2 + kstep;
            unsigned o2[2][2];
#pragma unroll
            for (int h = 0; h < 2; ++h)
#pragma unroll
                for (int i = 0; i < 2; ++i) o2[h][i] = last ? offAn[h][i] : offA[h][i];
            PG8_LDB(B0, 0, 0); PG8_LDB(B1, 0, 1); PG8_SCHED; PG8_LDA(At, 0, 0); PG8_STAGE(PG8_SA(1, 1), a1, offA[1]);
            PG8_WAIT_V(8); PG8_WAIT_L(0); PG8_BAR; PG8_MMA(0, 0, At, B0); PG8_MMA(0, 1, At, B1); PG8_BAR; PG8_SCHED;
            PG8_LDA(At, 0, 1); PG8_STAGE(PG8_SB(0, 0), b2, voffB); PG8_STAGE(PG8_SB(0, 1), b2 + hstep, voffB); PG8_STAGE(PG8_SA(0, 0), a2, o2[0]);
            PG8_WAIT_V(8); PG8_WAIT_L(0); PG8_BAR; PG8_MMA(1, 0, At, B0); PG8_MMA(1, 1, At, B1); PG8_BAR; PG8_SCHED;
            PG8_LDB(B0, 1, 0); PG8_LDB(B1, 1, 1); PG8_SCHED; PG8_LDA(At, 1, 0); PG8_STAGE(PG8_SA(0, 1), a2, o2[1]);
            PG8_WAIT_V(8); PG8_WAIT_L(0); PG8_BAR; PG8_MMA(0, 0, At, B0); PG8_MMA(0, 1, At, B1); PG8_BAR; PG8_SCHED;
            PG8_LDA(At, 1, 1); PG8_STAGE(PG8_SB(1, 0), b3, voffB); PG8_STAGE(PG8_SB(1, 1), b3 + hstep, voffB); PG8_STAGE(PG8_SA(1, 0), a3, o2[0]);
            PG8_WAIT_V(8); PG8_WAIT_L(0); PG8_BAR; PG8_MMA(1, 0, At, B0); PG8_MMA(1, 1, At, B1); PG8_BAR; PG8_SCHED;
        }
        if (wr == 0) PG8_BAR;
        E(acc, cur, wr, wc, fr, fq);
        if (!has_next) break;
#pragma unroll
        for (int a = 0; a < 2; ++a)
#pragma unroll
            for (int b = 0; b < 2; ++b)
#pragma unroll
                for (int m = 0; m < 4; ++m)
#pragma unroll
                    for (int n = 0; n < 2; ++n) acc[a][b][m][n] = (f32x4){0.f, 0.f, 0.f, 0.f};
        cur = nxt; cA = nA; cB = nB; ++ui;
#pragma unroll
        for (int h = 0; h < 2; ++h)
#pragma unroll
            for (int i = 0; i < 2; ++i) offA[h][i] = offAn[h][i];
        if (wr == 1) PG8_BAR;
    }
    PG8_WAIT_V(0);
    PG8_BAR;
#undef PG8_SA
#undef PG8_SB
#undef PG8_STAGE
#undef PG8_LDA
#undef PG8_LDB
#undef PG8_MMA
#undef PG8_WAIT_V
#undef PG8_WAIT_L
#undef PG8_BAR
#undef PG8_SCHED
}
}

constexpr int NWAVES = 8;
constexpr int BATCH = 2, T = 8192, D = 1024, M = BATCH * T, DIN = 4104, PA = 3072;
constexpr int NE = 64, NEX = 65, DE = 256;
constexpr size_t MiB = 1u << 20;
constexpr size_t WS_CTL = 0, CTL_ZERO_BYTES = 256 * 1024;
constexpr size_t WS_WRHI = 512 * 1024, WS_WRLO = 640 * 1024;
constexpr size_t WS_MOD = 1 * MiB, WS_WAB = 1 * MiB + 256 * 1024, WS_AB = 1 * MiB + 512 * 1024;
constexpr size_t WS_WOUT_T = 2 * MiB, WS_WIN_T = 4 * MiB, WS_H1 = 12 * MiB, WS_PROJA = 44 * MiB, WS_GATES = 142 * MiB;
constexpr size_t WS_QP = 4 * MiB, WS_OI = 20 * MiB, WS_AH = 36 * MiB, WS_GL = 36 * MiB + 512 * 1024, WS_PG = 174 * MiB, WS_BG = 206 * MiB, WS_BH = 238 * MiB, WS_QE = 270 * MiB, WS_OIH = 286 * MiB;
constexpr size_t WS_OMIX = 174 * MiB;
constexpr size_t WS_H2 = 12 * MiB, WS_W1T = 44 * MiB, WS_W2T = 109 * MiB, WS_ACT = 142 * MiB, WS_LIST = 215 * MiB, WS_LISTW = 217 * MiB, WS_Y0 = 12 * MiB, WS_Y1 = 219 * MiB;
constexpr size_t WS_TOP = 302 * MiB;
constexpr int CAP = 4096;
constexpr int TB_PRE = 0, TB_CNT = 132, TB_OFF = 264;
constexpr int CW_CNT = 16384;
constexpr int CW_BAR = 4096;
constexpr int RING_BYTES = 131072, LDS_BYTES = 147456, LDSCTL_OFF = LDS_BYTES - 1024, MISC_OFF = LDSCTL_OFF + 320, SCR2_OFF = LDS_BYTES - 3072;

__device__ __forceinline__ float bf2f(bf16 v) { return __uint_as_float(((unsigned)v) << 16); }
__device__ __forceinline__ float sigmoidf_(float x) { return 1.f / (1.f + __expf(-x)); }
__device__ __forceinline__ float siluf_(float x) { return x / (1.f + __expf(-x)); }
__device__ __forceinline__ float softplusf_(float x) { return x > 20.f ? x : log1pf(expf(x)); }
__device__ __forceinline__ float wave_sum(float v) {
#pragma unroll
    for (int o = 1; o < 64; o <<= 1) v += __shfl_xor(v, o);
    return v;
}

namespace pg8 {
struct EpiProj {
    static constexpr bool PERM = true, AFTER_DRAIN = false;
    bf16_t* projA; bf16_t* gates;
    __device__ __forceinline__ void operator()(const f32x4 (&acc)[2][2][4][2], const Unit& u, int wr, int wc, int fr, int fq) const {
        const int row0 = u.pm * BM + wr * 64 + fr;
        bf16_t* base; int ldc, colt;
        if (u.pn < 12) { base = projA; ldc = 3072; colt = u.pn * BM; } else { base = gates; ldc = 1024; colt = (u.pn - 12) * BM; }
        const int col0 = colt + wc * 32 + 8 * fq;
#pragma unroll
        for (int ai = 0; ai < 2; ++ai)
#pragma unroll
            for (int m = 0; m < 4; ++m) { bf16_t* rowp = base + (size_t)(row0 + ai * HALF + m * 16) * ldc + col0;
#pragma unroll
                for (int bj = 0; bj < 2; ++bj) { const f32x4 v0 = acc[ai][bj][m][0], v1 = acc[ai][bj][m][1];
                    u32x4 w; w.x = cvt_pk_bf16(v0[0], v0[1]); w.y = cvt_pk_bf16(v0[2], v0[3]); w.z = cvt_pk_bf16(v1[0], v1[1]); w.w = cvt_pk_bf16(v1[2], v1[3]);
                    *(u32x4*)(rowp + bj * HALF) = w; } }
    }
};
struct EpiResid {
    static constexpr bool PERM = false, AFTER_DRAIN = false;
    const float* x; const float* mod; float* out;
    __device__ __forceinline__ void operator()(const f32x4 (&acc)[2][2][4][2], const Unit& u, int wr, int wc, int fr, int fq) const {
        const int col0 = u.pn * BM + wc * 32 + 4 * fq;
#pragma unroll
        for (int ai = 0; ai < 2; ++ai)
#pragma unroll
            for (int m = 0; m < 4; ++m) { const int r = u.pm * BM + ai * HALF + wr * 64 + m * 16 + fr; const float* g1 = mod + (r >= 8192 ? 6144 : 0) + 2048; const size_t off = (size_t)r * 1024 + col0;
#pragma unroll
                for (int bj = 0; bj < 2; ++bj)
#pragma unroll
                    for (int n = 0; n < 2; ++n) { const f32x4 gv = *(const f32x4*)(g1 + col0 + bj * HALF + n * 16); const f32x4 xv = *(const f32x4*)(x + off + bj * HALF + n * 16);
                        *(f32x4*)(out + off + bj * HALF + n * 16) = xv + gv * acc[ai][bj][m][n]; } }
    }
};

struct MoeSched {
    const LAS unsigned* tb; int lo, hi, NT, G, c;
    __device__ __forceinline__ bool next(int i, UnitG& u) const {
        const unsigned L = (unsigned)(i * G + c); if (L >= tb[TB_PRE + hi]) return false;
        int s = lo; while (L >= tb[TB_PRE + s + 1]) ++s;
        const unsigned loc = L - tb[TB_PRE + s], tiles = (tb[TB_CNT + s] + 255u) >> 8;
        u.seg = __builtin_amdgcn_readfirstlane(s); u.mt = __builtin_amdgcn_readfirstlane((int)(loc % tiles)); u.nt = __builtin_amdgcn_readfirstlane((int)(loc / tiles)); return true;
    }
};
struct Moe1Prob {
    int K; MoeSched S; const bf16_t* h2; const bf16_t* w1t; const int* list;
    __device__ __forceinline__ bool next(int i, UnitG& u) const { return S.next(i, u); }
    __device__ __forceinline__ void setup(const UnitG& u, const int (&sR)[2], const int (&sC)[2], const char*& cA, unsigned (&offA)[2][2], const char*& cB) const {
        const int hf = u.seg >= 65 ? 1 : 0, e = u.seg - 65 * hf; const int cnt = (int)S.tb[TB_CNT + u.seg];
#pragma unroll
        for (int h = 0; h < 2; ++h)
#pragma unroll
            for (int i = 0; i < 2; ++i) { const int r = 256 * u.mt + 128 * h + sR[i]; unsigned tok;
                if (e < 64) { const int rr = r < cnt ? r : cnt - 1; tok = (unsigned)list[(size_t)(hf * 64 + e) * CAP + rr] >> 3; } else tok = (unsigned)(hf * 8192 + (r < 8192 ? r : 8191));
                offA[h][i] = tok * 2048u + (unsigned)sC[i] * 2u; }
        cA = (const char*)h2; cB = (const char*)(w1t + ((size_t)e * 512 + (size_t)u.nt * 256) * 1024);
    }
};
struct Moe2Prob {
    int K; MoeSched S; const bf16_t* act; const bf16_t* w2t; int hf;
    __device__ __forceinline__ bool next(int i, UnitG& u) const { return S.next(i, u); }
    __device__ __forceinline__ void setup(const UnitG& u, const int (&sR)[2], const int (&sC)[2], const char*& cA, unsigned (&offA)[2][2], const char*& cB) const {
        const int e = u.seg - 65 * hf; const size_t rowbase = (size_t)S.tb[TB_OFF + u.seg] + 256u * (unsigned)u.mt;
#pragma unroll
        for (int h = 0; h < 2; ++h)
#pragma unroll
            for (int i = 0; i < 2; ++i) offA[h][i] = (unsigned)((128 * h + sR[i]) * 256 + sC[i]) * 2u;
        cA = (const char*)(act + rowbase * 256); cB = (const char*)(w2t + ((size_t)e * 1024 + (size_t)u.nt * 256) * 256);
    }
};
struct EpiMoe1 {
    static constexpr bool PERM = true;
    bf16_t* act; const LAS unsigned* tb;
    __device__ __forceinline__ void operator()(const f32x4 (&acc)[2][2][4][2], const UnitG& u, int wr, int wc, int fr, int fq) const {
        const int cnt = (int)tb[TB_CNT + u.seg]; const size_t rowbase = tb[TB_OFF + u.seg];
#pragma unroll
        for (int ai = 0; ai < 2; ++ai)
#pragma unroll
            for (int m = 0; m < 4; ++m) { const int r = 256 * u.mt + ai * HALF + wr * 64 + m * 16 + fr;
                if (r < cnt) { bf16_t* p = act + (rowbase + (size_t)r) * 256 + u.nt * 128 + wc * 32 + 8 * fq;
                    const f32x4 g0 = acc[ai][0][m][0], g1 = acc[ai][0][m][1], u0 = acc[ai][1][m][0], u1 = acc[ai][1][m][1]; f32x4 v0, v1;
#pragma unroll
                    for (int i = 0; i < 4; ++i) { v0[i] = g0[i] / (1.f + __expf(-g0[i])) * u0[i]; v1[i] = g1[i] / (1.f + __expf(-g1[i])) * u1[i]; }
                    u32x4 w; w.x = cvt_pk_bf16(v0[0], v0[1]); w.y = cvt_pk_bf16(v0[2], v0[3]); w.z = cvt_pk_bf16(v1[0], v1[1]); w.w = cvt_pk_bf16(v1[2], v1[3]);
                    *(u32x4*)p = w; } }
    }
};
struct EpiMoe2 {
    static constexpr bool PERM = true;
    bf16_t* y0; bf16_t* y1; float* x2; const float* mod; const int* list; const float* listw; const LAS unsigned* tb; int hf; int do_shared;
    __device__ __forceinline__ void operator()(const f32x4 (&acc)[2][2][4][2], const UnitG& u, int wr, int wc, int fr, int fq) const {
        const int cnt = (int)tb[TB_CNT + u.seg]; const int e = u.seg - 65 * hf; const int colt = u.nt * 256 + wc * 32 + 8 * fq;
#pragma unroll
        for (int ai = 0; ai < 2; ++ai)
#pragma unroll
            for (int m = 0; m < 4; ++m) { const int r = 256 * u.mt + ai * HALF + wr * 64 + m * 16 + fr;
                if (r < cnt) {
                    if (e < 64) { const size_t li = (size_t)(hf * 64 + e) * CAP + r; const int slot = list[li]; const float w = listw[li];
                        const int yr = slot - hf * 65536; bf16_t* p = (yr < 32768 ? y0 + (size_t)yr * 1024 : y1 + (size_t)(yr - 32768) * 1024) + colt;
#pragma unroll
                        for (int bj = 0; bj < 2; ++bj) { const f32x4 v0 = acc[ai][bj][m][0] * w, v1 = acc[ai][bj][m][1] * w;
                            u32x4 o; o.x = cvt_pk_bf16(v0[0], v0[1]); o.y = cvt_pk_bf16(v0[2], v0[3]); o.z = cvt_pk_bf16(v1[0], v1[1]); o.w = cvt_pk_bf16(v1[2], v1[3]);
                            *(u32x4*)(p + bj * HALF) = o; }
                    } else if (do_shared) { float* p = x2 + (size_t)(hf * 8192 + r) * 1024 + colt; const float* g2 = mod + hf * 6144 + 5120 + colt;
#pragma unroll
                        for (int bj = 0; bj < 2; ++bj)
#pragma unroll
                            for (int n = 0; n < 2; ++n) { f32x4* q = (f32x4*)(p + bj * HALF + 4 * n); *q = *q + *(const f32x4*)(g2 + bj * HALF + 4 * n) * acc[ai][bj][m][n]; } }
                } }
    }
};
}

struct TrItem { const float* W; int ldw, src_col; bf16* WT; int K, dst_row, k0; };
__device__ __forceinline__ void tr_load(const TrItem& t, int lane, f32x4 (&v)[8]) {
#pragma unroll
    for (int i = 0; i < 8; ++i) v[i] = *(const GAS f32x4*)(t.W + (size_t)(t.k0 + 8 * i + (lane >> 3)) * t.ldw + t.src_col + 4 * (lane & 7));
}
__device__ __forceinline__ void tr_finish(const TrItem& t, int lane, const f32x4 (&v)[8], LAS float* scr) {
#pragma unroll
    for (int i = 0; i < 8; ++i) { LAS float* p = scr + (8 * i + (lane >> 3)) * 33 + 4 * (lane & 7); p[0] = v[i][0]; p[1] = v[i][1]; p[2] = v[i][2]; p[3] = v[i][3]; }
    LDS_WAIT(); asm volatile("" ::: "memory");
    const int c = lane & 7;
#pragma unroll
    for (int j = 0; j < 4; ++j) { const int n = (lane >> 3) + 8 * j; const LAS float* s = scr + (8 * c) * 33 + n;
        v4u o; o.x = pk2(s[0 * 33], s[1 * 33]); o.y = pk2(s[2 * 33], s[3 * 33]); o.z = pk2(s[4 * 33], s[5 * 33]); o.w = pk2(s[6 * 33], s[7 * 33]);
        *(GAS v4u*)(t.WT + (size_t)(t.dst_row + n) * t.K + t.k0 + 8 * c) = o; }
    LDS_WAIT(); asm volatile("" ::: "memory");
}
#define TR_LOOP(it0, stride, nitems, MAKE) do { int it_ = (it0); if (it_ < (nitems)) { TrItem cur_ = MAKE(it_); f32x4 va_[8], vb_[8]; tr_load(cur_, lane, va_); \
    for (;;) { const int nx_ = it_ + (stride); const bool hn_ = nx_ < (nitems); TrItem nxt_ = cur_; if (hn_) { nxt_ = MAKE(nx_); tr_load(nxt_, lane, vb_); } \
        tr_finish(cur_, lane, va_, scr); if (!hn_) break; _Pragma("unroll") for (int q_ = 0; q_ < 8; ++q_) va_[q_] = vb_[q_]; cur_ = nxt_; it_ = nx_; } } } while (0)

#ifndef REP_PHASE
#define REP_PHASE -1
#endif
#ifndef REP_N
#define REP_N 1
#endif
#define REPN(k) ((k) == REP_PHASE ? REP_N : 1)

constexpr int UNITS = BATCH * 128 * 4;
constexpr int L_QN = 0, L_KN = 17408, L_VV = 34816, L_LM = 52224, L_ATT = 68608, L_UT = 77824, L_WT = 96256, L_KTT = 114688, L_GCS = 133120, L_EGS = 133376, L_BET = 133632, L_SCW = 133888;
constexpr int H_FR = 0, H_QR = 17408, H_QE = 34816, H_KD = 52224, H_KTT = 69632, H_VT = 88064, H_AM = 106496;
constexpr int RS = 272, TS = 144;

typedef unsigned v2u __attribute__((ext_vector_type(2)));
__device__ __forceinline__ f32x4 mfma16(bf16x8 a, bf16x8 b, f32x4 c) { return __builtin_amdgcn_mfma_f32_16x16x32_bf16(a, b, c, 0, 0, 0); }
__device__ __forceinline__ bf16x8 ldsfrag(const LAS unsigned char* base, int row, int stride, int kbyte) { return *(const LAS bf16x8*)(base + row * stride + kbyte); }
__device__ __forceinline__ void unpack8(const v4u q, float (&f)[8]) {
    f[0] = __uint_as_float(q.x << 16); f[1] = __uint_as_float(q.x & 0xffff0000u); f[2] = __uint_as_float(q.y << 16); f[3] = __uint_as_float(q.y & 0xffff0000u);
    f[4] = __uint_as_float(q.z << 16); f[5] = __uint_as_float(q.z & 0xffff0000u); f[6] = __uint_as_float(q.w << 16); f[7] = __uint_as_float(q.w & 0xffff0000u); }
__device__ __forceinline__ f32x4 unpack4(const v2u q) { return (f32x4){__uint_as_float(q.x << 16), __uint_as_float(q.x & 0xffff0000u), __uint_as_float(q.y << 16), __uint_as_float(q.y & 0xffff0000u)}; }
__device__ __forceinline__ v2u pack4(const f32x4 v) { v2u o; o.x = pk2(v[0], v[1]); o.y = pk2(v[2], v[3]); return o; }
__device__ __forceinline__ float ldsbf(const LAS unsigned char* base, int row, int stride, int col) { return __uint_as_float(((unsigned)*(const LAS unsigned short*)(base + row * stride + col * 2)) << 16); }

struct MixPtrs {
    const bf16* projA; const bf16* gates; const float* ab; const float* conv_w; const float* a_log; const float* dt_bias; const float* hg_lb; const float* gdn_nw; const float* hg_nw;
    bf16 *PG, *BG, *QP, *OI, *BH, *QE, *OIH, *SG, *SH, *omix; float *GL, *AH;
};

__device__ __forceinline__ void p3_gdn_unit(LAS unsigned char* lds, const MixPtrs& X, int unit, int tid, int lane, int wave) {
    const int h = unit & 3, n = (unit >> 2) & 127, b = unit >> 9, r = lane & 15, g = lane >> 4;
    const size_t tok0 = (size_t)b * T + (size_t)n * 64;
    LAS float* gcs = (LAS float*)(lds + L_GCS); LAS float* egs = (LAS float*)(lds + L_EGS); LAS float* bet = (LAS float*)(lds + L_BET);
#pragma unroll 2
    for (int i = 0; i < 6; ++i) {
        const int pair = (tid >> 4) + 32 * i, tz = pair >> 6, c = pair & 63, ch = tid & 15, col = tz * 512 + h * 128 + ch * 8;
        float y[8];
#pragma unroll
        for (int e = 0; e < 8; ++e) y[e] = 0.f;
#pragma unroll
        for (int j = 0; j < 4; ++j) { const int tl = n * 64 + c - 3 + j;
            if (tl >= 0) { const v4u q = *(const GAS v4u*)(X.projA + ((size_t)b * T + tl) * PA + col); float xf[8]; unpack8(q, xf);
                const f32x4 w0 = *(const GAS f32x4*)(X.conv_w + j * 1536 + col), w1 = *(const GAS f32x4*)(X.conv_w + j * 1536 + col + 4);
#pragma unroll
                for (int e = 0; e < 4; ++e) { y[e] += w0[e] * xf[e]; y[4 + e] += w1[e] * xf[4 + e]; } } }
        float ss = 0.f;
#pragma unroll
        for (int e = 0; e < 8; ++e) { y[e] = siluf_(y[e]); ss += y[e] * y[e]; }
        ss += __shfl_xor(ss, 1); ss += __shfl_xor(ss, 2); ss += __shfl_xor(ss, 4); ss += __shfl_xor(ss, 8);
        const float rn = tz == 2 ? 1.f : rsqrtf(ss + 1e-6f) * (tz == 0 ? 0.08838834764831845f : 1.f);
        v4u o; o.x = pk2(y[0] * rn, y[1] * rn); o.y = pk2(y[2] * rn, y[3] * rn); o.z = pk2(y[4] * rn, y[5] * rn); o.w = pk2(y[6] * rn, y[7] * rn);
        *(LAS v4u*)(lds + (tz == 0 ? L_QN : (tz == 1 ? L_KN : L_VV)) + c * RS + ch * 16) = o;
    }
    if (wave == 0) {
        const float araw = X.ab[(tok0 + lane) * 8 + 4 + h], braw = X.ab[(tok0 + lane) * 8 + h];
        float gv = -expf(X.a_log[h]) * softplusf_(araw + X.dt_bias[h]);
#pragma unroll
        for (int o = 1; o < 64; o <<= 1) { const float t = __shfl_up(gv, o); if (lane >= o) gv += t; }
        { const float eg_ = __expf(gv), be_ = sigmoidf_(braw); gcs[lane] = gv; egs[lane] = eg_; bet[lane] = be_; *(LAS float*)(lds + L_SCW + lane * 4) = be_ * eg_; }
        if (lane == 63) X.GL[unit] = gv;
    }
    __syncthreads();
    {
        const int mt = wave >> 1;
#pragma unroll
        for (int q = 0; q < 2; ++q) { const int ntc = 2 * (wave & 1) + q; f32x4 akk = {0.f, 0.f, 0.f, 0.f}, aqk = {0.f, 0.f, 0.f, 0.f};
#pragma unroll
            for (int ks = 0; ks < 4; ++ks) { const bf16x8 ka = ldsfrag(lds + L_KN, 16 * mt + r, RS, 64 * ks + 16 * g), qa = ldsfrag(lds + L_QN, 16 * mt + r, RS, 64 * ks + 16 * g), kb = ldsfrag(lds + L_KN, 16 * ntc + r, RS, 64 * ks + 16 * g);
                akk = mfma16(ka, kb, akk); aqk = mfma16(qa, kb, aqk); }
            const int j = 16 * ntc + r; const float gj = gcs[j];
#pragma unroll
            for (int ii = 0; ii < 4; ++ii) { const int i = 16 * mt + 4 * g + ii; const float dec = (i >= j) ? __expf(gcs[i] - gj) : 0.f;
                *(LAS float*)(lds + L_LM + (i * 64 + j) * 4) = (i > j) ? bet[i] * akk[ii] * dec : 0.f;
                *(LAS unsigned short*)(lds + L_ATT + i * TS + j * 2) = (unsigned short)f2bf(aqk[ii] * dec); } }
    }
    __syncthreads();
    if (tid < 256) {
        const int c = tid & 127, which = tid >> 7;
        const LAS unsigned char* src = lds + (which ? L_KN : L_VV) + c * 2;
        const LAS float* scl = (const LAS float*)(lds + (which ? L_SCW : L_BET));
        float xs[64];
#pragma unroll
        for (int i = 0; i < 64; ++i) {
            float rr = scl[i] * __uint_as_float(((unsigned)*(const LAS unsigned short*)(src + i * RS)) << 16);
#pragma unroll
            for (int jb = 0; jb < (i + 3) / 4; ++jb) { const f32x4 l = *(const LAS f32x4*)(lds + L_LM + (i * 64 + 4 * jb) * 4);
#pragma unroll
                for (int e = 0; e < 4; ++e) if (4 * jb + e < i) rr -= l[e] * xs[4 * jb + e]; }
            asm volatile("" : "+v"(rr) :: "memory");
            xs[i] = rr;
        }
        LAS unsigned char* dst = lds + (which ? L_WT : L_UT) + c * TS;
#pragma unroll
        for (int q = 0; q < 8; ++q) { v4u o; o.x = pk2(xs[8 * q], xs[8 * q + 1]); o.y = pk2(xs[8 * q + 2], xs[8 * q + 3]); o.z = pk2(xs[8 * q + 4], xs[8 * q + 5]); o.w = pk2(xs[8 * q + 6], xs[8 * q + 7]); *(LAS v4u*)(dst + 16 * q) = o; }
    } else {
        const int xq = tid - 256, d = xq & 127, hh = xq >> 7; const float gl = gcs[63];
#pragma unroll
        for (int q = 0; q < 4; ++q) { float kv[8];
#pragma unroll
            for (int e = 0; e < 8; ++e) { const int c = 32 * hh + 8 * q + e; kv[e] = ldsbf(lds + L_KN, c, RS, d) * __expf(gl - gcs[c]); }
            v4u o; o.x = pk2(kv[0], kv[1]); o.y = pk2(kv[2], kv[3]); o.z = pk2(kv[4], kv[5]); o.w = pk2(kv[6], kv[7]);
            *(LAS v4u*)(lds + L_KTT + d * TS + (32 * hh + 8 * q) * 2) = o; }
    }
    __syncthreads();
    {
        const size_t u16 = (size_t)unit * 16384, u8 = (size_t)unit * 8192;
        { const int kk = wave >> 1;
          bf16x8 af[2][2];
#pragma unroll
          for (int t2 = 0; t2 < 2; ++t2)
#pragma unroll
              for (int ks = 0; ks < 2; ++ks) af[t2][ks] = ldsfrag(lds + L_WT, 16 * (2 * kk + t2) + r, TS, 64 * ks + 16 * g);
#pragma unroll
          for (int q = 0; q < 4; ++q) { const int nt = 4 * (wave & 1) + q; f32x4 a0 = {0.f, 0.f, 0.f, 0.f}, a1 = {0.f, 0.f, 0.f, 0.f};
#pragma unroll
              for (int ks = 0; ks < 2; ++ks) { const bf16x8 bfr = ldsfrag(lds + L_KTT, 16 * nt + r, TS, 64 * ks + 16 * g); a0 = mfma16(af[0][ks], bfr, a0); a1 = mfma16(af[1][ks], bfr, a1); }
              v4u o; o.x = pk2(-a0[0], -a0[1]); o.y = pk2(-a0[2], -a0[3]); o.z = pk2(-a1[0], -a1[1]); o.w = pk2(-a1[2], -a1[3]);
              *(GAS v4u*)(X.PG + u16 + ((size_t)(nt * 4 + kk) * 64 + lane) * 8) = o; } }
        { const int mt = wave; bf16x8 af[2];
#pragma unroll
          for (int ks = 0; ks < 2; ++ks) af[ks] = ldsfrag(lds + L_KTT, 16 * mt + r, TS, 64 * ks + 16 * g);
#pragma unroll
          for (int nt = 0; nt < 8; ++nt) { f32x4 a0 = {0.f, 0.f, 0.f, 0.f};
#pragma unroll
              for (int ks = 0; ks < 2; ++ks) a0 = mfma16(af[ks], ldsfrag(lds + L_UT, 16 * nt + r, TS, 64 * ks + 16 * g), a0);
              *(GAS v2u*)(X.BG + u16 + ((size_t)(nt * 8 + mt) * 64 + lane) * 4) = pack4(a0); } }
        { const int kk = wave >> 1;
#pragma unroll
          for (int q = 0; q < 2; ++q) { const int ct = 2 * (wave & 1) + q; f32x4 a0 = {0.f, 0.f, 0.f, 0.f}, a1 = {0.f, 0.f, 0.f, 0.f};
#pragma unroll
              for (int ks = 0; ks < 2; ++ks) { const bf16x8 bfr = ldsfrag(lds + L_ATT, 16 * ct + r, TS, 64 * ks + 16 * g);
                  a0 = mfma16(ldsfrag(lds + L_WT, 16 * (2 * kk) + r, TS, 64 * ks + 16 * g), bfr, a0); a1 = mfma16(ldsfrag(lds + L_WT, 16 * (2 * kk + 1) + r, TS, 64 * ks + 16 * g), bfr, a1); }
              const int c = 16 * ct + r; const float eg = egs[c];
              const f32x4 q0 = unpack4(*(const LAS v2u*)(lds + L_QN + c * RS + (32 * kk + 4 * g) * 2)), q1 = unpack4(*(const LAS v2u*)(lds + L_QN + c * RS + (32 * kk + 16 + 4 * g) * 2));
              v4u o; o.x = pk2(q0[0] * eg - a0[0], q0[1] * eg - a0[1]); o.y = pk2(q0[2] * eg - a0[2], q0[3] * eg - a0[3]); o.z = pk2(q1[0] * eg - a1[0], q1[1] * eg - a1[1]); o.w = pk2(q1[2] * eg - a1[2], q1[3] * eg - a1[3]);
              *(GAS v4u*)(X.QP + u8 + ((size_t)(ct * 4 + kk) * 64 + lane) * 8) = o; } }
        { const int vt = wave; bf16x8 af[2];
#pragma unroll
          for (int ks = 0; ks < 2; ++ks) af[ks] = ldsfrag(lds + L_UT, 16 * vt + r, TS, 64 * ks + 16 * g);
#pragma unroll
          for (int ct = 0; ct < 4; ++ct) { f32x4 a0 = {0.f, 0.f, 0.f, 0.f};
#pragma unroll
              for (int ks = 0; ks < 2; ++ks) a0 = mfma16(af[ks], ldsfrag(lds + L_ATT, 16 * ct + r, TS, 64 * ks + 16 * g), a0);
              *(GAS v2u*)(X.OI + u8 + ((size_t)(vt * 4 + ct) * 64 + lane) * 4) = pack4(a0); } }
    }
    __syncthreads();
}

__device__ __forceinline__ void p3_hgrn_unit(LAS unsigned char* lds, const MixPtrs& X, int unit, int tid, int lane, int wave) {
    const int h = unit & 3, n = (unit >> 2) & 127, b = unit >> 9, r = lane & 15, g = lane >> 4;
    const size_t tok0 = (size_t)b * T + (size_t)n * 64;
#pragma unroll
    for (int i = 0; i < 4; ++i) { const int pair = (tid >> 4) + 32 * i, tz = pair >> 6, c = pair & 63, ch = tid & 15;
        const v4u q = *(const GAS v4u*)(X.projA + (tok0 + c) * PA + (tz ? 2560 : 1536) + h * 128 + ch * 8);
        *(LAS v4u*)(lds + (tz ? H_QR : H_FR) + c * RS + ch * 16) = q; }
    if (tid >= 256) { const int xq = tid - 256, v = xq & 127, hh = xq >> 7; const GAS unsigned short* src = (const GAS unsigned short*)X.projA + (tok0 + 32 * hh) * PA + 2048 + h * 128 + v;
#pragma unroll
        for (int q = 0; q < 4; ++q) { unsigned w[4];
#pragma unroll
            for (int e = 0; e < 4; ++e) { const unsigned lo = src[(size_t)(8 * q + 2 * e) * PA], hi = src[(size_t)(8 * q + 2 * e + 1) * PA]; w[e] = lo | (hi << 16); }
            v4u o; o.x = w[0]; o.y = w[1]; o.z = w[2]; o.w = w[3]; *(LAS v4u*)(lds + H_VT + v * TS + (32 * hh + 8 * q) * 2) = o; } }
    __syncthreads();
    if (tid < 128) {
        const int d = tid; const float l0 = X.hg_lb[h * 128 + d], l1 = X.hg_lb[512 + h * 128 + d]; const float mx = fmaxf(l0, l1); const float e0 = __expf(l0 - mx), e1 = __expf(l1 - mx); const float lb = e0 / (e0 + e1);
        float bs[64]; float bacc = 0.f;
#pragma unroll
        for (int c = 0; c < 64; ++c) { const float fr = ldsbf(lds + H_FR, c, RS, d); const float sg = sigmoidf_(fr); const float f = lb + (1.f - lb) * sg; const float k = (1.f - lb) * (1.f - sg);
            bacc += __logf(f); bs[c] = bacc;
            *(LAS unsigned short*)(lds + H_QE + c * RS + d * 2) = (unsigned short)f2bf(siluf_(ldsbf(lds + H_QR, c, RS, d)) * __expf(bacc));
            *(LAS unsigned short*)(lds + H_KD + c * RS + d * 2) = (unsigned short)f2bf(k * __expf(-bacc)); }
        X.AH[(size_t)unit * 128 + d] = __expf(bacc);
#pragma unroll
        for (int q = 0; q < 8; ++q) { float kv[8];
#pragma unroll
            for (int e = 0; e < 8; ++e) { const float sg = sigmoidf_(ldsbf(lds + H_FR, 8 * q + e, RS, d)); kv[e] = (1.f - lb) * (1.f - sg) * __expf(bacc - bs[8 * q + e]); }
            v4u o; o.x = pk2(kv[0], kv[1]); o.y = pk2(kv[2], kv[3]); o.z = pk2(kv[4], kv[5]); o.w = pk2(kv[6], kv[7]); *(LAS v4u*)(lds + H_KTT + d * TS + 16 * q) = o; }
    }
    __syncthreads();
    {
        const int mt = wave >> 1;
#pragma unroll
        for (int q = 0; q < 2; ++q) { const int ntc = 2 * (wave & 1) + q; f32x4 a0 = {0.f, 0.f, 0.f, 0.f};
#pragma unroll
            for (int ks = 0; ks < 4; ++ks) a0 = mfma16(ldsfrag(lds + H_QE, 16 * mt + r, RS, 64 * ks + 16 * g), ldsfrag(lds + H_KD, 16 * ntc + r, RS, 64 * ks + 16 * g), a0);
            const int j = 16 * ntc + r;
#pragma unroll
            for (int ii = 0; ii < 4; ++ii) { const int i = 16 * mt + 4 * g + ii; *(LAS unsigned short*)(lds + H_AM + i * TS + j * 2) = (unsigned short)f2bf((i >= j) ? a0[ii] : 0.f); } }
    }
    __syncthreads();
    {
        const size_t u16 = (size_t)unit * 16384, u8 = (size_t)unit * 8192;
        { const int mt = wave; bf16x8 af[2];
#pragma unroll
          for (int ks = 0; ks < 2; ++ks) af[ks] = ldsfrag(lds + H_KTT, 16 * mt + r, TS, 64 * ks + 16 * g);
#pragma unroll
          for (int nt = 0; nt < 8; ++nt) { f32x4 a0 = {0.f, 0.f, 0.f, 0.f};
#pragma unroll
              for (int ks = 0; ks < 2; ++ks) a0 = mfma16(af[ks], ldsfrag(lds + H_VT, 16 * nt + r, TS, 64 * ks + 16 * g), a0);
              *(GAS v2u*)(X.BH + u16 + ((size_t)(nt * 8 + mt) * 64 + lane) * 4) = pack4(a0); } }
        { const int vt = wave; bf16x8 af[2];
#pragma unroll
          for (int ks = 0; ks < 2; ++ks) af[ks] = ldsfrag(lds + H_VT, 16 * vt + r, TS, 64 * ks + 16 * g);
#pragma unroll
          for (int ct = 0; ct < 4; ++ct) { f32x4 a0 = {0.f, 0.f, 0.f, 0.f};
#pragma unroll
              for (int ks = 0; ks < 2; ++ks) a0 = mfma16(af[ks], ldsfrag(lds + H_AM, 16 * ct + r, TS, 64 * ks + 16 * g), a0);
              *(GAS v2u*)(X.OIH + u8 + ((size_t)(vt * 4 + ct) * 64 + lane) * 4) = pack4(a0); } }
#pragma unroll
        for (int q = 0; q < 2; ++q) { const int idx = wave * 2 + q, ct = idx >> 2, kk = idx & 3, c = 16 * ct + r;
            const v2u q0 = *(const LAS v2u*)(lds + H_QE + c * RS + (32 * kk + 4 * g) * 2), q1 = *(const LAS v2u*)(lds + H_QE + c * RS + (32 * kk + 16 + 4 * g) * 2);
            v4u o; o.x = q0.x; o.y = q0.y; o.z = q1.x; o.w = q1.y;
            *(GAS v4u*)(X.QE + u8 + ((size_t)(ct * 4 + kk) * 64 + lane) * 8) = o; }
    }
    __syncthreads();
}

__device__ __forceinline__ void p4_gdn_scan(LAS unsigned char* lds, const MixPtrs& X, int job, int lane, int wave) {
    const int s = job & 7, h = (job >> 3) & 3, b = job >> 5;
    const int unit0 = (b * 128) * 4 + h;
    if (wave >= 4) {
        const int lw = wave - 4;
        const char* src0 = (const char*)(X.PG + (size_t)unit0 * 16384) + lw * 8192 + lane * 16;
#define P4_ISSUE(n_) do { const char* s_ = src0 + (size_t)(n_) * (4 * 32768); _Pragma("unroll") for (int i_ = 0; i_ < 8; ++i_) \
        __builtin_amdgcn_global_load_lds((const unsigned*)(s_ + i_ * 1024), (LAS unsigned*)(lds + ((n_) & 3) * 32768 + lw * 8192 + i_ * 1024), 16, 0, 0); } while (0)
        P4_ISSUE(0); P4_ISSUE(1); P4_ISSUE(2);
#pragma unroll 1
        for (int n = 0; n < 128; ++n) {
            if (n + 2 < 128) asm volatile("s_waitcnt vmcnt(16)" ::: "memory"); else if (n + 1 < 128) asm volatile("s_waitcnt vmcnt(8)" ::: "memory"); else asm volatile("s_waitcnt vmcnt(0)" ::: "memory");
            __builtin_amdgcn_s_barrier();
            asm volatile("" ::: "memory");
            if (n + 3 < 128) P4_ISSUE(n + 3);
        }
#undef P4_ISSUE
    } else if (wave == 0) {
        f32x4 S[8]; bf16x8 sb[4];
#pragma unroll
        for (int mt = 0; mt < 8; ++mt) S[mt] = (f32x4){0.f, 0.f, 0.f, 0.f};
#pragma unroll
        for (int kk = 0; kk < 4; ++kk) { sb[kk] = (bf16x8){0, 0, 0, 0, 0, 0, 0, 0}; *(GAS bf16x8*)(X.SG + (size_t)unit0 * 16384 + ((size_t)(s * 4 + kk) * 64 + lane) * 8) = sb[kk]; }
        v2u bq[4][8]; float gl[4];
        const GAS v2u* bsrc = (const GAS v2u*)(X.BG + (size_t)unit0 * 16384 + ((size_t)(s * 8) * 64 + lane) * 4);
#pragma unroll
        for (int j = 0; j < 3; ++j) {
#pragma unroll
            for (int mt = 0; mt < 8; ++mt) bq[j][mt] = bsrc[(size_t)j * 16384 + mt * 64];
            gl[j] = X.GL[unit0 + 4 * j]; }
#pragma unroll 1
        for (int n0 = 0; n0 < 128; n0 += 4) {
#pragma unroll
            for (int j = 0; j < 4; ++j) {
                const int n = n0 + j, unit = unit0 + 4 * n;
                __builtin_amdgcn_s_barrier();
                asm volatile("" ::: "memory");
                if (n + 3 < 128) {
#pragma unroll
                    for (int mt = 0; mt < 8; ++mt) bq[(j + 3) & 3][mt] = bsrc[(size_t)(n + 3) * 16384 + mt * 64];
                    gl[(j + 3) & 3] = X.GL[unit + 12]; }
                const float e = __expf(gl[j]);
                f32x4 acc[8];
#pragma unroll
                for (int mt = 0; mt < 8; ++mt) acc[mt] = S[mt] * e + unpack4(bq[j][mt]);
                const LAS unsigned char* pb = lds + (n & 3) * 32768 + lane * 16;
#pragma unroll
                for (int kk = 0; kk < 4; ++kk)
#pragma unroll
                    for (int mt = 0; mt < 8; ++mt) acc[mt] = mfma16(*(const LAS bf16x8*)(pb + (mt * 4 + kk) * 1024), sb[kk], acc[mt]);
#pragma unroll
                for (int mt = 0; mt < 8; ++mt) S[mt] = acc[mt];
#pragma unroll
                for (int kk = 0; kk < 4; ++kk) { const v2u lo = pack4(S[2 * kk]), hi = pack4(S[2 * kk + 1]); v4u o; o.x = lo.x; o.y = lo.y; o.z = hi.x; o.w = hi.y; sb[kk] = __builtin_bit_cast(bf16x8, o);
                    if (n < 127) *(GAS v4u*)(X.SG + (size_t)(unit + 4) * 16384 + ((size_t)(s * 4 + kk) * 64 + lane) * 8) = o; }
            }
        }
    } else {
#pragma unroll 1
        for (int n = 0; n < 128; ++n) { __builtin_amdgcn_s_barrier(); asm volatile("" ::: "memory"); }
    }
}
__device__ __forceinline__ void p4_hgrn_scan(const MixPtrs& X, int task, int lane) {
    const int mt = task & 7, s = (task >> 3) & 7, h = (task >> 6) & 3, b = task >> 8, g = lane >> 4;
    const int unit0 = (b * 128) * 4 + h;
    f32x4 s0 = {0.f, 0.f, 0.f, 0.f};
    const GAS f32x4* ap = (const GAS f32x4*)(X.AH + (size_t)unit0 * 128 + 16 * mt + 4 * g);
    const GAS v2u* bp = (const GAS v2u*)(X.BH + (size_t)unit0 * 16384 + ((size_t)(s * 8 + mt) * 64 + lane) * 4);
    GAS v2u* sp = (GAS v2u*)(X.SH + (size_t)unit0 * 16384 + ((size_t)(s * 4 + (mt >> 1)) * 64 + lane) * 8 + 4 * (mt & 1));
    { v2u z; z.x = 0; z.y = 0; sp[0] = z; }
    f32x4 ra[8]; v2u rb[8];
#pragma unroll
    for (int j = 0; j < 8; ++j) { ra[j] = ap[(size_t)j * 128]; rb[j] = bp[(size_t)j * 16384]; }
#pragma unroll 1
    for (int n0 = 0; n0 < 128; n0 += 8) {
#pragma unroll
        for (int j = 0; j < 8; ++j) { const int n = n0 + j;
            s0 = ra[j] * s0 + unpack4(rb[j]);
            if (n + 8 < 128) { ra[j] = ap[(size_t)(n + 8) * 128]; rb[j] = bp[(size_t)(n + 8) * 16384]; }
            if (n < 127) sp[(size_t)(n + 1) * 16384] = pack4(s0); }
    }
}
__device__ __forceinline__ void p5_unit(LAS unsigned char* lds, const MixPtrs& X, int bn, int lane, int wave) {
    const int hd = wave & 3, type = wave >> 2, r = lane & 15, g = lane >> 4;
    const int unit = bn * 4 + hd; const size_t tok0 = (size_t)bn * 64;
    const bf16* SX = type ? X.SH : X.SG; const bf16* QX = type ? X.QE : X.QP; const bf16* OX = type ? X.OIH : X.OI;
    const size_t u16 = (size_t)unit * 16384, u8 = (size_t)unit * 8192;
    LAS float* exch = (LAS float*)lds;
    const float* nw = type ? X.hg_nw + hd * 128 : X.gdn_nw;
#pragma unroll 1
    for (int cp = 0; cp < 2; ++cp) {
        f32x4 acc[8][2];
#pragma unroll
        for (int vt = 0; vt < 8; ++vt)
#pragma unroll
            for (int cc = 0; cc < 2; ++cc) acc[vt][cc] = unpack4(*(const GAS v2u*)(OX + u8 + ((size_t)(vt * 4 + 2 * cp + cc) * 64 + lane) * 4));
#pragma unroll
        for (int kk = 0; kk < 4; ++kk) {
            bf16x8 af[8], bfr[2];
#pragma unroll
            for (int vt = 0; vt < 8; ++vt) af[vt] = *(const GAS bf16x8*)(SX + u16 + ((size_t)(vt * 4 + kk) * 64 + lane) * 8);
#pragma unroll
            for (int cc = 0; cc < 2; ++cc) bfr[cc] = *(const GAS bf16x8*)(QX + u8 + ((size_t)((2 * cp + cc) * 4 + kk) * 64 + lane) * 8);
#pragma unroll
            for (int vt = 0; vt < 8; ++vt)
#pragma unroll
                for (int cc = 0; cc < 2; ++cc) acc[vt][cc] = mfma16(af[vt], bfr[cc], acc[vt][cc]);
        }
        float ssq[2];
#pragma unroll
        for (int cc = 0; cc < 2; ++cc) { float s = 0.f;
#pragma unroll
            for (int vt = 0; vt < 8; ++vt) s += (acc[vt][cc][0] * acc[vt][cc][0] + acc[vt][cc][1] * acc[vt][cc][1]) + (acc[vt][cc][2] * acc[vt][cc][2] + acc[vt][cc][3] * acc[vt][cc][3]);
            s += __shfl_xor(s, 16); s += __shfl_xor(s, 32); ssq[cc] = s; }
        if (type == 1 && g == 0) {
#pragma unroll
            for (int cc = 0; cc < 2; ++cc) exch[hd * 32 + 16 * cc + r] = ssq[cc]; }
        __syncthreads();
        float rstd[2];
#pragma unroll
        for (int cc = 0; cc < 2; ++cc) { if (type == 1) { const int c = 16 * cc + r; rstd[cc] = rsqrtf(((exch[c] + exch[32 + c]) + (exch[64 + c] + exch[96 + c])) * (1.f / 512.f) + 1e-6f); } else rstd[cc] = rsqrtf(ssq[cc] * (1.f / 128.f) + 1e-6f); }
#pragma unroll
        for (int vt = 0; vt < 8; ++vt) { const f32x4 w4 = *(const GAS f32x4*)(nw + 16 * vt + 4 * g);
#pragma unroll
            for (int cc = 0; cc < 2; ++cc) { const size_t off = (tok0 + 16 * (2 * cp + cc) + r) * 1024 + type * 512 + hd * 128 + 16 * vt + 4 * g;
                const f32x4 gt = unpack4(*(const GAS v2u*)(X.gates + off)); f32x4 o;
#pragma unroll
                for (int e = 0; e < 4; ++e) o[e] = acc[vt][cc][e] * rstd[cc] * w4[e] * siluf_(gt[e]);
                *(GAS v2u*)(X.omix + off) = pack4(o); } }
        __syncthreads();
    }
}

struct Args { const float* in[23]; float* out; unsigned char* ws; int ph_lo, ph_hi, li, pad; };

__global__ void __launch_bounds__(NWAVES * 64, 2) mk_fwd(Args args) {
    extern __shared__ __attribute__((aligned(16))) unsigned char lds_raw[];
    LAS unsigned char* lds = (LAS unsigned char*)lds_raw;
    volatile LAS unsigned* MISC = (volatile LAS unsigned*)(lds + MISC_OFF);
    const int tid = threadIdx.x, lane = tid & 63, wave = __builtin_amdgcn_readfirstlane(tid >> 6);
    const int G = gridDim.x, bx = blockIdx.x, vcu = (G % 8 == 0) ? (bx % 8) * (G / 8) + bx / 8 : bx;
    const int gw = vcu * NWAVES + wave, NGW = G * NWAVES;
    unsigned char* ws = args.ws;
    gu32* ctl = (gu32*)(ws + WS_CTL);
    const float* x = args.in[0]; const float* cvec = args.in[1]; const float* w_ada = args.in[2]; const float* b_ada = args.in[3]; const float* norm1_w = args.in[4];
    const float* w_in = args.in[5]; const float* w_out = args.in[12];
    float* mod = (float*)(ws + WS_MOD); float* wab = (float*)(ws + WS_WAB); float* ab = (float*)(ws + WS_AB);
    bf16* wout_t = (bf16*)(ws + WS_WOUT_T); bf16* win_t = (bf16*)(ws + WS_WIN_T); bf16* h1 = (bf16*)(ws + WS_H1); bf16* projA = (bf16*)(ws + WS_PROJA); bf16* gates = (bf16*)(ws + WS_GATES);
    bf16* omix = (bf16*)(ws + WS_OMIX);
    bf16* h2 = (bf16*)(ws + WS_H2); bf16* w1t = (bf16*)(ws + WS_W1T); bf16* w2t = (bf16*)(ws + WS_W2T); bf16* act = (bf16*)(ws + WS_ACT); bf16* y0 = (bf16*)(ws + WS_Y0); bf16* y1 = (bf16*)(ws + WS_Y1);
    MixPtrs X; X.projA = projA; X.gates = gates; X.ab = ab; X.conv_w = args.in[6]; X.a_log = args.in[7]; X.dt_bias = args.in[8]; X.hg_lb = args.in[10]; X.gdn_nw = args.in[9]; X.hg_nw = args.in[11];
    X.PG = (bf16*)(ws + WS_PG); X.BG = (bf16*)(ws + WS_BG); X.QP = (bf16*)(ws + WS_QP); X.OI = (bf16*)(ws + WS_OI); X.BH = (bf16*)(ws + WS_BH); X.QE = (bf16*)(ws + WS_QE); X.OIH = (bf16*)(ws + WS_OIH);
    X.SG = (bf16*)args.out; X.SH = (bf16*)args.out + (size_t)UNITS * 16384; X.omix = omix; X.GL = (float*)(ws + WS_GL); X.AH = (float*)(ws + WS_AH);
    const int* list = (const int*)(ws + WS_LIST); const float* listw = (const float*)(ws + WS_LISTW);
    LAS unsigned* tb = (LAS unsigned*)(lds + SCR2_OFF);

    for (int u = tid; u < (LDS_BYTES - LDSCTL_OFF) / 4; u += NWAVES * 64) ((LAS unsigned*)(lds + LDSCTL_OFF))[u] = 0u;
    __syncthreads();
    XcdBarrier bar = xcd_barrier_post((unsigned*)(ctl + CW_BAR) + args.li * XCD_BAR_WORDS, MISC + 8);
    const int lo = args.ph_lo, hi = args.ph_hi;
#define IN(k) (lo <= (k) && (k) < hi)
#define BOTH(k) (IN(k) && IN((k) + 1))

    if (IN(0)) {
#define PH_BODY do { \
        if (bx < 96) { \
            LAS float* part = (LAS float*)(lds + RING_BYTES); \
            const int e = bx * 64 + lane; float a0 = 0.f, a1 = 0.f; \
_Pragma("unroll 8") \
            for (int d = wave * 128; d < wave * 128 + 128; ++d) { const float w = w_ada[(size_t)d * 6144 + e]; a0 += siluf_(cvec[d]) * w; a1 += siluf_(cvec[D + d]) * w; } \
            part[(wave * 2 + 0) * 64 + lane] = a0; part[(wave * 2 + 1) * 64 + lane] = a1; \
            __syncthreads(); \
            if (tid < 128) { const int bb = tid >> 6, l = tid & 63; float s = 0.f; \
_Pragma("unroll") \
                for (int w = 0; w < 8; ++w) s += part[(w * 2 + bb) * 64 + l]; \
                mod[bb * 6144 + bx * 64 + l] = s + b_ada[bx * 64 + l]; } \
        } else if (bx == 96) { \
            for (int idx = tid; idx < 8192; idx += NWAVES * 64) wab[idx] = w_in[(size_t)(idx >> 3) * DIN + 2048 + (idx & 7)]; \
        } else if (bx == 97) { \
            const float* w_router = args.in[14]; bf16* wrhi = (bf16*)(ws + WS_WRHI); bf16* wrlo = (bf16*)(ws + WS_WRLO); \
            for (int idx = tid; idx < 65536; idx += NWAVES * 64) { const int e = idx >> 10, k = idx & 1023; const float w = w_router[k * 64 + e]; const unsigned hi = f2bf(w); \
                wrhi[idx] = (bf16)hi; wrlo[idx] = (bf16)f2bf(w - __uint_as_float(hi << 16)); } \
        } \
        LAS float* scr = (LAS float*)(lds + wave * 16384); \
        constexpr int I_IN = 16 * 128, I_OUT = 16 * 32; \
        auto mk0 = [&](int it) { TrItem t; if (it < I_IN) { const int kb = it / 128, n0 = 32 * (it % 128); const int sc_ = n0 < 1536 ? n0 : (n0 < 3072 ? n0 + 520 : (n0 < 3584 ? n0 - 1536 : n0 + 8)); \
                t.W = w_in; t.ldw = DIN; t.src_col = sc_; t.WT = win_t; t.K = D; t.dst_row = n0; t.k0 = 64 * kb; } \
            else { const int r = it - I_IN, kb = r / 32, n0 = 32 * (r % 32); t.W = w_out; t.ldw = D; t.src_col = n0; t.WT = wout_t; t.K = D; t.dst_row = n0; t.k0 = 64 * kb; } return t; }; \
        TR_LOOP(gw, NGW, I_IN + I_OUT, mk0); \
        if (BOTH(0)) xcd_barrier(bar); \
    } while (0)
        PH_BODY; if (REPN(0) > 1) { PH_BODY; PH_BODY; }
#undef PH_BODY
    }
    if (IN(1)) {
#define PH_BODY do { \
        { \
            const GAS f32x4* wab4 = (const GAS f32x4*)wab; \
            for (int idx = tid; idx < 2048; idx += NWAVES * 64) { const int d = idx >> 1, qh = idx & 1; *(LAS f32x4*)(lds + (((qh * 4 + (d & 3)) * 256 + (d >> 2)) * 16)) = wab4[idx]; } \
            __syncthreads(); \
            const int nrows = (M - gw + NGW - 1) / NGW; \
            f32x4 vn[2][4]; \
_Pragma("unroll") \
            for (int q = 0; q < 2; ++q) { const int m = gw + q * NGW; \
_Pragma("unroll") \
                for (int j = 0; j < 4; ++j) vn[q][j] = (q < nrows) ? ((const GAS f32x4*)(x + (size_t)m * D) + lane)[64 * j] : (f32x4){0.f, 0.f, 0.f, 0.f}; } \
_Pragma("unroll 1") \
            for (int p = 0; p < nrows; p += 2) { \
                f32x4 v[2][4]; \
_Pragma("unroll") \
                for (int q = 0; q < 2; ++q) \
_Pragma("unroll") \
                    for (int j = 0; j < 4; ++j) v[q][j] = vn[q][j]; \
_Pragma("unroll") \
                for (int q = 0; q < 2; ++q) { const int m = gw + (p + 2 + q) * NGW; \
                    if (p + 2 + q < nrows) { \
_Pragma("unroll") \
                        for (int j = 0; j < 4; ++j) vn[q][j] = ((const GAS f32x4*)(x + (size_t)m * D) + lane)[64 * j]; } } \
_Pragma("unroll") \
                for (int q = 0; q < 2; ++q) { const int m = gw + (p + q) * NGW; \
                    if (p + q < nrows) { \
                        float ss = 0.f; \
_Pragma("unroll") \
                        for (int j = 0; j < 4; ++j) ss += (v[q][j].x * v[q][j].x + v[q][j].y * v[q][j].y) + (v[q][j].z * v[q][j].z + v[q][j].w * v[q][j].w); \
                        const float rstd = rsqrtf(wave_sum(ss) * (1.f / D) + 1e-6f); \
                        const GAS f32x4* nw4 = (const GAS f32x4*)norm1_w + lane; const GAS f32x4* sh4 = (const GAS f32x4*)(mod + (m >= T ? 6144 : 0)) + lane; const GAS f32x4* sc4 = sh4 + 256; \
                        GAS unsigned long long* o8 = (GAS unsigned long long*)(h1 + (size_t)m * D) + lane; \
                        f32x4 a0 = {0.f, 0.f, 0.f, 0.f}, a1 = {0.f, 0.f, 0.f, 0.f}; \
_Pragma("unroll") \
                        for (int j = 0; j < 4; ++j) { const f32x4 h = v[q][j] * rstd * nw4[64 * j] * (sc4[64 * j] + 1.0f) + sh4[64 * j]; \
                            o8[64 * j] = (unsigned long long)pk2(h.x, h.y) | ((unsigned long long)pk2(h.z, h.w) << 32); \
_Pragma("unroll") \
                            for (int i = 0; i < 4; ++i) { a0 += *(const LAS f32x4*)(lds + ((i * 256 + lane + 64 * j) * 16)) * h[i]; a1 += *(const LAS f32x4*)(lds + (((4 + i) * 256 + lane + 64 * j) * 16)) * h[i]; } } \
 \
                        const bool up5 = (lane & 32) != 0, up4 = (lane & 16) != 0, up3 = (lane & 8) != 0; \
                        f32x4 k4; \
_Pragma("unroll") \
                        for (int e = 0; e < 4; ++e) { const float snd = up5 ? a0[e] : a1[e]; k4[e] = (up5 ? a1[e] : a0[e]) + __shfl_xor(snd, 32); } \
                        float k2[2]; \
_Pragma("unroll") \
                        for (int e = 0; e < 2; ++e) { const float snd = up4 ? k4[e] : k4[2 + e]; k2[e] = (up4 ? k4[2 + e] : k4[e]) + __shfl_xor(snd, 16); } \
                        float k1; { const float snd = up3 ? k2[0] : k2[1]; k1 = (up3 ? k2[1] : k2[0]) + __shfl_xor(snd, 8); } \
                        k1 += __shfl_xor(k1, 4); k1 += __shfl_xor(k1, 2); k1 += __shfl_xor(k1, 1); \
                        if ((lane & 7) == 0) ab[(size_t)m * 8 + 4 * (lane >> 5) + 2 * ((lane >> 4) & 1) + ((lane >> 3) & 1)] = k1; \
                    } } \
            } \
            __syncthreads(); \
        } \
        if (BOTH(1)) xcd_barrier(bar); \
    } while (0)
        PH_BODY; if (REPN(1) > 1) { PH_BODY; PH_BODY; }
#undef PH_BODY
    }
    if (IN(2)) {
#define PH_BODY do { \
        pg8::Gemm g{h1, win_t, M, 4096, D}; pg8::StaticOrder S; S.init(M, 4096, G, (int)blockIdx.x); \
        pg8::EpiProj E{projA, gates}; \
        pg8::gemm_phase<pg8::EpiProj, pg8::StaticOrder, true, true>(lds, g, S, E); \
        if (BOTH(2)) xcd_barrier(bar); \
    } while (0)
        PH_BODY; if (REPN(2) > 1) { PH_BODY; PH_BODY; }
#undef PH_BODY
    }

    if (IN(3)) {
#define PH_BODY do { \
        for (int u = vcu; u < UNITS; u += G) p3_gdn_unit(lds, X, u, tid, lane, wave); \
        for (int u = vcu; u < UNITS; u += G) p3_hgrn_unit(lds, X, u, tid, lane, wave); \
        if (BOTH(3)) xcd_barrier(bar); \
    } while (0)
        PH_BODY; if (REPN(3) > 1) { PH_BODY; PH_BODY; }
#undef PH_BODY
    }
    if (IN(4)) {
#define PH_BODY do { \
        if (bx < 64) p4_gdn_scan(lds, X, bx, lane, wave); \
        else { \
            if (wave < 3 && (bx - 64) * 3 + wave < 512) p4_hgrn_scan(X, (bx - 64) * 3 + wave, lane); \
            LAS float* scr = (LAS float*)(lds + wave * 16384); \
            const float* w_gate = args.in[16]; const float* w_up = args.in[17]; const float* w_down = args.in[18]; const float* ws_gate = args.in[19]; const float* ws_up = args.in[20]; const float* ws_down = args.in[21]; \
            auto mk4 = [&](int it) { TrItem t; const int e = it / 384, r = it % 384; \
                if (r < 256) { const int up = r >> 7, q = r & 127, kb = q >> 3, n0 = 32 * (q & 7); \
                    t.W = e < NE ? (up ? w_up : w_gate) + (size_t)e * D * DE : (up ? ws_up : ws_gate); t.ldw = DE; t.src_col = n0; t.WT = w1t + (size_t)e * 512 * 1024; t.K = D; t.dst_row = (n0 >> 7) * 256 + up * 128 + (n0 & 127); t.k0 = 64 * kb; } \
                else { const int q = r - 256, kb = q >> 5, n0 = 32 * (q & 31); \
                    t.W = e < NE ? w_down + (size_t)e * DE * D : ws_down; t.ldw = D; t.src_col = n0; t.WT = w2t + (size_t)e * 1024 * 256; t.K = DE; t.dst_row = n0; t.k0 = 64 * kb; } return t; }; \
            TR_LOOP((bx - 64) * NWAVES + wave, (G - 64) * NWAVES, NEX * 384, mk4); \
        } \
        if (BOTH(4)) xcd_barrier(bar); \
    } while (0)
        PH_BODY; if (REPN(4) > 1) { PH_BODY; PH_BODY; }
#undef PH_BODY
    }
    if (IN(5)) {
#define PH_BODY do { \
        for (int bn = vcu; bn < BATCH * 128; bn += G) p5_unit(lds, X, bn, lane, wave); \
        if (BOTH(5)) xcd_barrier(bar); \
    } while (0)
        PH_BODY; if (REPN(5) > 1) { PH_BODY; PH_BODY; }
#undef PH_BODY
    }
    if (IN(6)) {
#define PH_BODY do { \
        pg8::Gemm g{omix, wout_t, M, D, D}; pg8::StaticOrder S; S.init(M, D, G, (int)blockIdx.x); \
        pg8::EpiResid E{x, mod, args.out}; \
        pg8::gemm_phase<pg8::EpiResid, pg8::StaticOrder, true, true>(lds, g, S, E); \
        if (BOTH(6)) xcd_barrier(bar); \
    } while (0)
        PH_BODY; if (REPN(6) > 1) { PH_BODY; PH_BODY; }
#undef PH_BODY
    }


    if (IN(7)) {
        constexpr int HS = 2064;
        constexpr int R_HI = 0, R_LO = 33024, R_PART = 66048, R_SC = 98816, R_SEL = 102912, R_CNT = 107008, R_BASE = 107520, R_ESE = 108032, R_ESL = 110080, R_EW = 112128, R_ELP = 114176;
        if (tid < 128) *(LAS unsigned*)(lds + R_CNT + tid * 4) = 0u;
        __syncthreads();
        int nu = 0;
        const float* norm2_w = args.in[13]; const float* rbias = args.in[15]; const bf16* wrhi = (const bf16*)(ws + WS_WRHI); const bf16* wrlo = (const bf16*)(ws + WS_WRLO);
        int* listo = (int*)(ws + WS_LIST); float* listwo = (float*)(ws + WS_LISTW);
        const int r = lane & 15, g = lane >> 4;
#pragma unroll 1
        for (int u = vcu; u < M / 16; u += G, ++nu) {
#pragma unroll 1
            for (int q = 0; q < 2; ++q) { const int rl = 2 * wave + q, m = 16 * u + rl;
                const GAS f32x4* xr = (const GAS f32x4*)(args.out + (size_t)m * D) + lane;
                f32x4 v[4]; float ss = 0.f;
#pragma unroll
                for (int j = 0; j < 4; ++j) { v[j] = xr[64 * j]; ss += (v[j].x * v[j].x + v[j].y * v[j].y) + (v[j].z * v[j].z + v[j].w * v[j].w); }
                const float rstd = rsqrtf(wave_sum(ss) * (1.f / D) + 1e-6f);
                const GAS f32x4* nw4 = (const GAS f32x4*)norm2_w + lane; const GAS f32x4* sh4 = (const GAS f32x4*)(mod + (m >= T ? 6144 : 0) + 3072) + lane; const GAS f32x4* sc4 = sh4 + 256;
                GAS unsigned long long* o8 = (GAS unsigned long long*)(h2 + (size_t)m * D) + lane;
#pragma unroll
                for (int j = 0; j < 4; ++j) { const f32x4 hv = v[j] * rstd * nw4[64 * j] * (sc4[64 * j] + 1.0f) + sh4[64 * j];
                    const unsigned h0 = f2bf(hv.x), h1_ = f2bf(hv.y), h2_ = f2bf(hv.z), h3 = f2bf(hv.w);
                    const unsigned long long hi = (unsigned long long)(h0 | (h1_ << 16)) | ((unsigned long long)(h2_ | (h3 << 16)) << 32);
                    o8[64 * j] = hi;
                    const unsigned long long lo = (unsigned long long)pk2(hv.x - __uint_as_float(h0 << 16), hv.y - __uint_as_float(h1_ << 16)) | ((unsigned long long)pk2(hv.z - __uint_as_float(h2_ << 16), hv.w - __uint_as_float(h3 << 16)) << 32);
                    *(LAS unsigned long long*)(lds + R_HI + rl * HS + (lane + 64 * j) * 8) = hi; *(LAS unsigned long long*)(lds + R_LO + rl * HS + (lane + 64 * j) * 8) = lo; } }
            __syncthreads();
            { f32x4 acc[4];
#pragma unroll
              for (int nt = 0; nt < 4; ++nt) acc[nt] = (f32x4){0.f, 0.f, 0.f, 0.f};
#pragma unroll
              for (int ks = 0; ks < 4; ++ks) { const int kb = (128 * wave + 32 * ks + 8 * g) * 2;
                  const bf16x8 ahi = *(const LAS bf16x8*)(lds + R_HI + r * HS + kb), alo = *(const LAS bf16x8*)(lds + R_LO + r * HS + kb);
#pragma unroll
                  for (int nt = 0; nt < 4; ++nt) { const size_t o = (size_t)(16 * nt + r) * 1024 + 128 * wave + 32 * ks + 8 * g; const bf16x8 bh = *(const GAS bf16x8*)(wrhi + o), bl = *(const GAS bf16x8*)(wrlo + o);
                      acc[nt] = mfma16(ahi, bh, acc[nt]); acc[nt] = mfma16(ahi, bl, acc[nt]); acc[nt] = mfma16(alo, bh, acc[nt]); } }
#pragma unroll
              for (int nt = 0; nt < 4; ++nt)
#pragma unroll
                  for (int ii = 0; ii < 4; ++ii) *(LAS float*)(lds + R_PART + ((wave * 16 + 4 * g + ii) * 64 + 16 * nt + r) * 4) = acc[nt][ii]; }
            __syncthreads();
#pragma unroll
            for (int q = 0; q < 2; ++q) { const int idx = tid + 512 * q; float s = 0.f;
#pragma unroll
                for (int w = 0; w < 8; ++w) s += *(const LAS float*)(lds + R_PART + (w * 1024 + idx) * 4);
                const float sc = sigmoidf_(s); *(LAS float*)(lds + R_SC + idx * 4) = sc; *(LAS float*)(lds + R_SEL + idx * 4) = sc + rbias[idx & 63]; }
            __syncthreads();
#pragma unroll 1
            for (int q = 0; q < 2; ++q) { const int rl = 2 * wave + q, m = 16 * u + rl;
                const float sel = *(const LAS float*)(lds + R_SEL + (rl * 64 + lane) * 4), score = *(const LAS float*)(lds + R_SC + (rl * 64 + lane) * 4);
                float m1 = sel; m1 = fmaxf(m1, __shfl_xor(m1, 1)); m1 = fmaxf(m1, __shfl_xor(m1, 2)); m1 = fmaxf(m1, __shfl_xor(m1, 4));
                const unsigned long long eq = __ballot(sel == m1) & (0xFFull << (lane & 56)); const int first = __ffsll((long long)eq) - 1;
                float m2 = (lane == first) ? -INFINITY : sel; m2 = fmaxf(m2, __shfl_xor(m2, 1)); m2 = fmaxf(m2, __shfl_xor(m2, 2)); m2 = fmaxf(m2, __shfl_xor(m2, 4));
                const float gs = m1 + m2; const int mygrp = lane >> 3; int grank = 0;
#pragma unroll
                for (int gg = 0; gg < 8; ++gg) { const float o = __shfl(gs, 8 * gg); grank += (o > gs || (o == gs && gg < mygrp)) ? 1 : 0; }
                const float msel = grank < 4 ? sel : -INFINITY; int erank = 0;
#pragma unroll
                for (int e2 = 0; e2 < 64; ++e2) { const float o = __shfl(msel, e2); erank += (o > msel || (o == msel && e2 < lane)) ? 1 : 0; }
                const bool chosen = grank < 4 && erank < 8;
                const float wsum = wave_sum(chosen ? score : 0.f);
                if (chosen && nu < 4) { const int se = (m >= T ? 64 : 0) + lane; const unsigned lp = __hip_atomic_fetch_add((LAS unsigned*)(lds + R_CNT + se * 4), 1u, __ATOMIC_RELAXED, __HIP_MEMORY_SCOPE_WORKGROUP);
                    const int ei = ((nu * 16 + rl) * 8 + erank) * 4;
                    *(LAS int*)(lds + R_ESE + ei) = se; *(LAS int*)(lds + R_ESL + ei) = m * 8 + erank; *(LAS float*)(lds + R_EW + ei) = score / wsum * 2.5f; *(LAS unsigned*)(lds + R_ELP + ei) = lp; } }
            __syncthreads();
            if (nu == 3 || u + G >= M / 16) {
                if (tid < 128) { const unsigned c = *(LAS unsigned*)(lds + R_CNT + tid * 4); *(LAS unsigned*)(lds + R_BASE + tid * 4) = c ? __hip_atomic_fetch_add(ctl + CW_CNT + 64 * tid, c, RLX_AGENT) : 0u; }
                __syncthreads();
                for (int idx = tid; idx < (nu + 1) * 128; idx += NWAVES * 64) { const int se = *(LAS int*)(lds + R_ESE + idx * 4); const unsigned pos = *(LAS unsigned*)(lds + R_BASE + se * 4) + *(LAS unsigned*)(lds + R_ELP + idx * 4);
                    if (pos < (unsigned)CAP) { listo[(size_t)se * CAP + pos] = *(LAS int*)(lds + R_ESL + idx * 4); listwo[(size_t)se * CAP + pos] = *(LAS float*)(lds + R_EW + idx * 4); } }
                __syncthreads();
                if (tid < 128) *(LAS unsigned*)(lds + R_CNT + tid * 4) = 0u;
                __syncthreads();
                nu = -1;
            }
        }
        if (BOTH(7)) xcd_barrier(bar);
    }
    if (lo <= 12 && hi > 8) {
        if (tid < 130) { const int hf = tid >= 65 ? 1 : 0, e = tid - 65 * hf; unsigned c = 8192u;
            if (e < 64) { c = __hip_atomic_load(ctl + CW_CNT + 64 * (hf * 64 + e), RLX_AGENT); c = c < (unsigned)CAP ? c : (unsigned)CAP; }
            tb[TB_CNT + tid] = c; }
        __syncthreads();
        if (tid == 0) { unsigned ro = 0; for (int s = 0; s < 130; ++s) { tb[TB_OFF + s] = ro; ro += tb[TB_CNT + s]; } }
        __syncthreads();
    }
#define MOE_PREFIX(lo_, hi_, NT_) do { __syncthreads(); if (tid == 0) { unsigned up = 0; for (int s = (lo_); s < (hi_); ++s) { tb[TB_PRE + s] = up; up += ((tb[TB_CNT + s] + 255u) >> 8) * (NT_); } tb[TB_PRE + (hi_)] = up; } __syncthreads(); } while (0)
    if (IN(8)) {
#define PH_BODY do { \
        MOE_PREFIX(0, 130, 2); \
        pg8::Moe1Prob P{D, pg8::MoeSched{tb, 0, 130, 2, G, (int)blockIdx.x}, h2, w1t, list}; \
        pg8::EpiMoe1 E{act, tb}; \
        pg8::gemm_phase_g<pg8::Moe1Prob, pg8::EpiMoe1>(lds, P, E); \
        if (BOTH(8)) xcd_barrier(bar); \
    } while (0)
        PH_BODY; if (REPN(8) > 1) { PH_BODY; PH_BODY; }
#undef PH_BODY
    }
#pragma unroll 1
    for (int hf = 0; hf < 2; ++hf) {
        if (IN(9 + 2 * hf)) for (int rep_ = 0; rep_ < REPN(9 + 2 * hf); ++rep_) {
            MOE_PREFIX(65 * hf, 65 * hf + 65, 4);
            pg8::Moe2Prob P{DE, pg8::MoeSched{tb, 65 * hf, 65 * hf + 65, 4, G, (int)blockIdx.x}, act, w2t, hf};
            pg8::EpiMoe2 E{y0, y1, args.out, mod, list, listw, tb, hf, rep_ == 0};
            pg8::gemm_phase_g<pg8::Moe2Prob, pg8::EpiMoe2>(lds, P, E);
            if (BOTH(9 + 2 * hf)) xcd_barrier(bar);
        }
        if (IN(10 + 2 * hf)) {
            const float* fw = args.in[22];
            for (int m = hf * 8192 + gw; m < (hf + 1) * 8192; m += NGW) {
                GAS f32x4* xr = (GAS f32x4*)(args.out + (size_t)m * D) + lane;
                const int tl = m - hf * 8192; const GAS unsigned long long* yr = (const GAS unsigned long long*)(tl < 4096 ? y0 + (size_t)tl * 8 * D : y1 + (size_t)(tl - 4096) * 8 * D) + lane;
                const GAS f32x4* g24 = (const GAS f32x4*)(mod + hf * 6144 + 5120) + lane; const GAS f32x4* fw4 = (const GAS f32x4*)fw + lane;
                f32x4 v[4]; float ss = 0.f;
#pragma unroll
                for (int j = 0; j < 4; ++j) { f32x4 s = {0.f, 0.f, 0.f, 0.f};
#pragma unroll
                    for (int k = 0; k < 8; ++k) { const unsigned long long q = yr[k * 256 + 64 * j]; const unsigned a = (unsigned)q, b = (unsigned)(q >> 32);
                        s.x += __uint_as_float(a << 16); s.y += __uint_as_float(a & 0xffff0000u); s.z += __uint_as_float(b << 16); s.w += __uint_as_float(b & 0xffff0000u); }
                    v[j] = xr[64 * j] + g24[64 * j] * s; ss += (v[j].x * v[j].x + v[j].y * v[j].y) + (v[j].z * v[j].z + v[j].w * v[j].w); }
                const float rstd = rsqrtf(wave_sum(ss) * (1.f / D) + 1e-6f);
#pragma unroll
                for (int j = 0; j < 4; ++j) xr[64 * j] = v[j] * rstd * fw4[64 * j];
            }
            if (BOTH(10 + 2 * hf)) xcd_barrier(bar);
        }
    }
#undef MOE_PREFIX
#undef IN
#undef BOTH
}

static void launch_mk(Args a, int lo, int hi, int li, int grid, hipStream_t stream) {
    a.ph_lo = lo; a.ph_hi = hi; a.li = li;
    hipLaunchKernelGGL(mk_fwd, dim3(grid), dim3(NWAVES * 64), LDS_BYTES, stream, a);
}
extern "C" void kernel_launch(void* const* d_in, const int* in_sizes, int n_in, void* d_out, int out_size, void* d_ws, size_t ws_size, hipStream_t stream) {
    static int grid = 0;
    if (grid == 0) {
        int dev = 0, cus = 0;
        if (hipGetDevice(&dev) != hipSuccess || hipDeviceGetAttribute(&cus, hipDeviceAttributeMultiprocessorCount, dev) != hipSuccess) { grid = -1; return; }
        if (hipFuncSetAttribute((const void*)mk_fwd, hipFuncAttributeMaxDynamicSharedMemorySize, LDS_BYTES) != hipSuccess) { grid = -1; return; }
        grid = cus;
    }
    if (grid < 0) return;
    unsigned char* ws = (unsigned char*)d_ws; float* out = (float*)d_out;
    (void)hipMemsetAsync(ws + WS_CTL, 0, CTL_ZERO_BYTES, stream);
    Args a{};
    for (int i = 0; i < 23; ++i) a.in[i] = (const float*)d_in[i];
    a.out = out; a.ws = ws;
    launch_mk(a, 0, 13, 0, grid, stream);
}
```

```cpp
#include <hip/hip_runtime.h>
#include <cstdio>
#include <cstdint>
namespace pg8 {
#define PG8_LAS __attribute__((address_space(3)))
typedef unsigned short bf16_t;
typedef short bf16x8 __attribute__((ext_vector_type(8)));
typedef float f32x4 __attribute__((ext_vector_type(4)));
typedef unsigned u32x4 __attribute__((ext_vector_type(4)));
constexpr int BM = 256, BK = 64, HALF = 128, HTB = HALF * BK * 2  , STAGE_BYTES = 8 * HTB, NXCD = 8, WGM = 8;

__host__ __device__ __forceinline__ int lds_byte(int r, int c) { const int st = (r >> 4) * 2 + (c >> 5), rr = r & 15, cc = c & 31, ob = rr * 64 + cc * 2; return st * 1024 + (ob ^ (((ob >> 9) & 1) << 5)); }
__host__ __device__ __forceinline__ void stage_rc(int b, int& R, int& C) { const int st = b / 1024, sb = b % 1024, swz = sb ^ (((sb >> 9) & 1) << 5); R = (st >> 1) * 16 + swz / 64; C = (st & 1) * 32 + (swz % 64) / 2; }
__host__ __device__ __forceinline__ int perm32(int rho) { const int n = rho >> 4, i = rho & 15; return 8 * (i >> 2) + 4 * n + (i & 3); }

struct Unit { int pm, pn; };
struct Gemm { const bf16_t* A; const bf16_t* Bt; int M, N, K; };

struct StaticOrder {
    int nM, nN, nwg, G, c;
    __host__ __device__ void init(int M, int N, int G_, int c_) { nM = M / BM; nN = N / BM; nwg = nM * nN; G = G_; c = c_; }
    __host__ __device__ bool next(int i, Unit& u) const {
        const long L = (long)i * G + c; if (L >= nwg) return false;
        int wgid = (int)L; { const int q = nwg / NXCD, r = nwg % NXCD, xcd = wgid % NXCD, off = wgid / NXCD; wgid = (xcd < r ? xcd * (q + 1) : r * (q + 1) + (xcd - r) * q) + off; }
        const int nig = WGM * nN, gid = wgid / nig, fm = gid * WGM, gsz = (nM - fm) < WGM ? (nM - fm) : WGM;
        u.pm = fm + ((wgid % nig) % gsz); u.pn = (wgid % nig) / gsz; return true;
    }
    __device__ __forceinline__ void a_ready(const Unit&) const {}
    __device__ __forceinline__ void done(const Unit&) const {}
};
__device__ __forceinline__ unsigned cvt_pk_bf16(float lo, float hi) { unsigned r; asm volatile("v_cvt_pk_bf16_f32 %0, %1, %2" : "=v"(r) : "v"(lo), "v"(hi)); return r; }
template <class Epi, class Sched, bool ALIGN_EPI = false, bool SP2 = false>
__device__ __forceinline__ void gemm_phase(PG8_LAS unsigned char* lds, const Gemm g, const Sched& S, const Epi& E) {
    const int tid = threadIdx.x, wid = __builtin_amdgcn_readfirstlane(tid >> 6), lane = tid & 63, wr = wid >> 2, wc = wid & 3, fr = lane & 15, fq = lane >> 4;
    const int K = g.K, nt = K / BK;
    unsigned voffA[2], voffB[2];
#pragma unroll
    for (int i = 0; i < 2; ++i) { int R, C; stage_rc(tid * 16 + i * 8192, R, C); const int Rb = Epi::PERM ? ((R & ~31) + perm32(R & 31)) : R;
        voffA[i] = (unsigned)(R * K + C) * 2u; voffB[i] = (unsigned)(Rb * K + C) * 2u; }
    const size_t kstep = (size_t)(BK * 2);
    const size_t hstep = (size_t)HALF * K * 2;
    const size_t tstep = 2 * hstep;
    const unsigned ldsw = (unsigned)wid * 1024u;
    const int aoff = lds_byte(wr * 64 + fr, fq * 8), boff = lds_byte(wc * 32 + fr, fq * 8);
#define PG8_SA(b, h) (((b) * 2 + (h)) * HTB)
#define PG8_SB(b, h) ((4 + (b) * 2 + (h)) * HTB)
#define PG8_STAGE(bufoff, gbase, voff) do { _Pragma("unroll") for (int _i = 0; _i < 2; ++_i) \
        __builtin_amdgcn_global_load_lds((const unsigned*)((const char*)(gbase) + (voff)[_i]), (PG8_LAS unsigned*)(lds + (bufoff) + ldsw + _i * 8192), 16, 0, 0); } while (0)
#define PG8_LDA(dst, b, h) do { _Pragma("unroll") for (int m = 0; m < 4; ++m) _Pragma("unroll") for (int k = 0; k < 2; ++k) dst[m][k] = *(const PG8_LAS bf16x8*)(lds + PG8_SA(b, h) + aoff + m * 2048 + k * 1024); } while (0)
#define PG8_LDB(dst, b, h) do { _Pragma("unroll") for (int n = 0; n < 2; ++n) _Pragma("unroll") for (int k = 0; k < 2; ++k) dst[n][k] = *(const PG8_LAS bf16x8*)(lds + PG8_SB(b, h) + boff + n * 2048 + k * 1024); } while (0)
#define PG8_MMA(ai, bj, At, Bt) do { __builtin_amdgcn_s_setprio(1); _Pragma("unroll") for (int m = 0; m < 4; ++m) _Pragma("unroll") for (int n = 0; n < 2; ++n) _Pragma("unroll") for (int k = 0; k < 2; ++k) \
        acc[ai][bj][m][n] = __builtin_amdgcn_mfma_f32_16x16x32_bf16(Bt[n][k], At[m][k], acc[ai][bj][m][n], 0, 0, 0); __builtin_amdgcn_s_setprio(0); } while (0)
#define PG8_WAIT_V(n) asm volatile("s_waitcnt vmcnt(" #n ")" ::: "memory")
#define PG8_WAIT_L(n) asm volatile("s_waitcnt lgkmcnt(" #n ")" ::: "memory")
#define PG8_BAR __builtin_amdgcn_s_barrier()
#define PG8_SCHED __builtin_amdgcn_sched_barrier(0)
    Unit cur, nxt; int ui = 0;
    if (!S.next(0, cur)) return;
    f32x4 acc[2][2][4][2];
#pragma unroll
    for (int a = 0; a < 2; ++a)
#pragma unroll
        for (int b = 0; b < 2; ++b)
#pragma unroll
            for (int m = 0; m < 4; ++m)
#pragma unroll
                for (int n = 0; n < 2; ++n) acc[a][b][m][n] = (f32x4){0.f, 0.f, 0.f, 0.f};
    bf16x8 At[4][2], B0[2][2], B1[2][2];
    const char* cA = (const char*)g.A + (size_t)cur.pm * tstep; const char* cB = (const char*)g.Bt + (size_t)cur.pn * tstep;
    S.a_ready(cur);
    if constexpr (SP2) {
        PG8_STAGE(PG8_SB(0, 0), cB, voffB); PG8_STAGE(PG8_SB(0, 1), cB + hstep, voffB); PG8_STAGE(PG8_SA(0, 0), cA, voffA); PG8_STAGE(PG8_SA(0, 1), cA + hstep, voffA);
        if (wr == 1) PG8_BAR;
        PG8_WAIT_V(2); PG8_BAR;
        PG8_STAGE(PG8_SB(1, 0), cB + kstep, voffB); PG8_STAGE(PG8_SA(1, 0), cA + kstep, voffA); PG8_STAGE(PG8_SB(1, 1), cB + hstep + kstep, voffB);
        PG8_WAIT_V(6); PG8_BAR;
    } else {
        PG8_STAGE(PG8_SB(0, 0), cB, voffB); PG8_STAGE(PG8_SA(0, 0), cA, voffA); PG8_STAGE(PG8_SB(0, 1), cB + hstep, voffB); PG8_STAGE(PG8_SA(0, 1), cA + hstep, voffA);
        if (wr == 1) PG8_BAR;
        PG8_WAIT_V(4); PG8_BAR;
        PG8_STAGE(PG8_SB(1, 0), cB + kstep, voffB); PG8_STAGE(PG8_SA(1, 0), cA + kstep, voffA); PG8_STAGE(PG8_SB(1, 1), cB + hstep + kstep, voffB);
        PG8_WAIT_V(6); PG8_BAR;
    }
    for (;;) {
        const bool has_next = S.next(ui + 1, nxt);
        const char* nA = has_next ? (const char*)g.A + (size_t)nxt.pm * tstep : cA; const char* nB = has_next ? (const char*)g.Bt + (size_t)nxt.pn * tstep : cB;
        for (int t = 0; t < nt; t += 2) {
            const bool last = (t == nt - 2);
            const char* a1 = cA + (size_t)(t + 1) * kstep;
            const char* a2 = last ? nA : cA + (size_t)(t + 2) * kstep; const char* b2 = last ? nB : cB + (size_t)(t + 2) * kstep;
            const char* a3 = a2 + kstep; const char* b3 = b2 + kstep;
            if (last && has_next) S.a_ready(nxt);
            if constexpr (SP2) {
            PG8_LDB(B0, 0, 0); PG8_LDB(B1, 0, 1); PG8_SCHED; PG8_LDA(At, 0, 0); PG8_STAGE(PG8_SA(1, 1), a1 + hstep, voffA);
            PG8_WAIT_V(8); PG8_WAIT_L(0); PG8_BAR; PG8_MMA(0, 0, At, B0); PG8_MMA(0, 1, At, B1); PG8_BAR; PG8_SCHED;
            PG8_LDA(At, 0, 1); PG8_STAGE(PG8_SB(0, 0), b2, voffB); PG8_STAGE(PG8_SB(0, 1), b2 + hstep, voffB); PG8_STAGE(PG8_SA(0, 0), a2, voffA);
            PG8_WAIT_V(8); PG8_WAIT_L(0); PG8_BAR; PG8_MMA(1, 0, At, B0); PG8_MMA(1, 1, At, B1); PG8_BAR; PG8_SCHED;
            PG8_LDB(B0, 1, 0); PG8_LDB(B1, 1, 1); PG8_SCHED; PG8_LDA(At, 1, 0); PG8_STAGE(PG8_SA(0, 1), a2 + hstep, voffA);
            PG8_WAIT_V(8); PG8_WAIT_L(0); PG8_BAR; PG8_MMA(0, 0, At, B0); PG8_MMA(0, 1, At, B1); PG8_BAR; PG8_SCHED;
            PG8_LDA(At, 1, 1); PG8_STAGE(PG8_SB(1, 0), b3, voffB); PG8_STAGE(PG8_SB(1, 1), b3 + hstep, voffB); PG8_STAGE(PG8_SA(1, 0), a3, voffA);
            PG8_WAIT_V(8); PG8_WAIT_L(0); PG8_BAR; PG8_MMA(1, 0, At, B0); PG8_MMA(1, 1, At, B1); PG8_BAR; PG8_SCHED;
            } else {
            PG8_LDB(B0, 0, 0); PG8_SCHED; PG8_LDA(At, 0, 0); PG8_STAGE(PG8_SA(1, 1), a1 + hstep, voffA);
            PG8_WAIT_L(8); PG8_BAR; PG8_WAIT_L(0); PG8_MMA(0, 0, At, B0); PG8_BAR; PG8_SCHED;
            PG8_LDB(B1, 0, 1); PG8_STAGE(PG8_SB(0, 0), b2, voffB);
            PG8_BAR; PG8_WAIT_L(0); PG8_MMA(0, 1, At, B1); PG8_BAR;
            PG8_LDA(At, 0, 1); PG8_STAGE(PG8_SA(0, 0), a2, voffA);
            PG8_BAR; PG8_WAIT_L(0); PG8_MMA(1, 0, At, B0); PG8_BAR; PG8_SCHED;
            PG8_STAGE(PG8_SB(0, 1), b2 + hstep, voffB);
            PG8_WAIT_V(6); PG8_BAR; PG8_MMA(1, 1, At, B1); PG8_BAR;
            PG8_LDB(B0, 1, 0); PG8_SCHED; PG8_LDA(At, 1, 0); PG8_STAGE(PG8_SA(0, 1), a2 + hstep, voffA);
            PG8_WAIT_L(8); PG8_BAR; PG8_WAIT_L(0); PG8_MMA(0, 0, At, B0); PG8_BAR; PG8_SCHED;
            PG8_LDB(B1, 1, 1); PG8_STAGE(PG8_SB(1, 0), b3, voffB);
            PG8_BAR; PG8_WAIT_L(0); PG8_MMA(0, 1, At, B1); PG8_BAR;
            PG8_LDA(At, 1, 1); PG8_STAGE(PG8_SA(1, 0), a3, voffA);
            PG8_BAR; PG8_WAIT_L(0); PG8_MMA(1, 0, At, B0); PG8_BAR; PG8_SCHED;
            PG8_STAGE(PG8_SB(1, 1), b3 + hstep, voffB);
            PG8_WAIT_V(6); PG8_BAR; PG8_MMA(1, 1, At, B1); PG8_BAR;
            }
        }
        if constexpr (ALIGN_EPI) { if (wr == 0) PG8_BAR; }
        if constexpr (!Epi::AFTER_DRAIN) { E(acc, cur, wr, wc, fr, fq); S.done(cur); }
        if (!has_next) break;
#pragma unroll
        for (int a = 0; a < 2; ++a)
#pragma unroll
            for (int b = 0; b < 2; ++b)
#pragma unroll
                for (int m = 0; m < 4; ++m)
#pragma unroll
                    for (int n = 0; n < 2; ++n) acc[a][b][m][n] = (f32x4){0.f, 0.f, 0.f, 0.f};
        cur = nxt; cA = nA; cB = nB; ++ui;
        if constexpr (ALIGN_EPI) { if (wr == 1) PG8_BAR; }
    }
    PG8_WAIT_V(0);
    if constexpr (!ALIGN_EPI) { if (wr == 0) PG8_BAR; }
    PG8_BAR;
    if constexpr (Epi::AFTER_DRAIN) { E.fused(acc, cur, wr, wc, fr, fq, lds, wid, lane); S.done(cur); }
#undef PG8_SA
#undef PG8_SB
#undef PG8_STAGE
#undef PG8_LDA
#undef PG8_LDB
#undef PG8_MMA
#undef PG8_WAIT_V
#undef PG8_WAIT_L
#undef PG8_BAR
#undef PG8_SCHED
}
}
#define GAS __attribute__((address_space(1)))
#define LAS __attribute__((address_space(3)))
typedef unsigned short bf16;
typedef unsigned v4u __attribute__((ext_vector_type(4)));
typedef float f32x4 __attribute__((ext_vector_type(4)));
typedef short bf16x8 __attribute__((ext_vector_type(8)));
typedef GAS unsigned gu32;
typedef GAS unsigned long long gu64;
#define RLX_AGENT __ATOMIC_RELAXED, __HIP_MEMORY_SCOPE_AGENT
#define LDS_WAIT() asm volatile("s_waitcnt lgkmcnt(0)" ::: "memory")
#define VM_WAIT() asm volatile("s_waitcnt vmcnt(0)" ::: "memory")
__device__ __forceinline__ unsigned long long rt() { return __builtin_amdgcn_s_memrealtime(); }
__device__ __forceinline__ unsigned f2bf(float f) { unsigned u = __builtin_bit_cast(unsigned, f); return (u + 0x7fffu + ((u >> 16) & 1u)) >> 16; }
__device__ __forceinline__ unsigned pk2(float lo, float hi) { return f2bf(lo) | (f2bf(hi) << 16); }
#define XB_TMO      128
#define XB_XCNT(j)  (256  + 64 * (j))
#define XB_XSUB(j)  (1280 + 64 * (j))
#define XB_XGEN(j)  (2304 + 64 * (j))
#define XB_TOP      3328
#define XB_TOPGEN   3392
#define XCD_BAR_WORDS 3456
#define XB_SPIN_CAP (1u << 18)

__device__ __forceinline__ unsigned xb_ld(unsigned* p)              { return __hip_atomic_load(p, __ATOMIC_RELAXED, __HIP_MEMORY_SCOPE_AGENT); }
__device__ __forceinline__ unsigned xb_add(unsigned* p, unsigned v) { return __hip_atomic_fetch_add(p, v, __ATOMIC_RELAXED, __HIP_MEMORY_SCOPE_AGENT); }
__device__ __forceinline__ unsigned xb_xcc_id() { return (unsigned)__builtin_amdgcn_s_getreg((3 << 11) | 20) & 0xFu; }
#define XB_SPIN(cond, bar) do { unsigned _sp = 0; while (cond) { __builtin_amdgcn_s_sleep(1); \
    if ((++_sp & 255u) == 0u) { if (xb_ld(&(bar)[XB_TMO])) break; if (_sp > XB_SPIN_CAP) { atomicAdd(&(bar)[XB_TMO], 1u); break; } } } } while (0)

struct XcdBarrier {
    unsigned* bar; unsigned x;
    volatile LAS unsigned* st;
};

__device__ __forceinline__ XcdBarrier xcd_barrier_post(unsigned* bar, volatile LAS unsigned* st) {
    XcdBarrier b; b.bar = bar; b.x = xb_xcc_id(); b.st = st;
    if (threadIdx.x == 0) (void)xb_add(&bar[XB_XCNT(b.x)], 1u);
    return b;
}
__device__ __forceinline__ void xcd_barrier_complete(unsigned* bar, unsigned x, unsigned& nloc, unsigned& nx) {
    const unsigned G = gridDim.x * gridDim.y * gridDim.z;
    unsigned sum, cnt, mine, sp = 0u;
    for (;;) {
        sum = 0u; cnt = 0u; mine = 0u;
#pragma unroll
        for (unsigned j = 0; j < 16; ++j) { const unsigned c = xb_ld(&bar[XB_XCNT(j)]); sum += c; cnt += (c > 0u) ? 1u : 0u; mine = (j == x) ? c : mine; }
        if (sum == G) break;
        __builtin_amdgcn_s_sleep(1);
        if ((++sp & 255u) == 0u) { if (xb_ld(&bar[XB_TMO])) break; if (sp > XB_SPIN_CAP) { atomicAdd(&bar[XB_TMO], 1u); break; } }
    }
    nloc = mine > 0u ? mine : 1u; nx = cnt > 0u ? cnt : 1u;
}

__device__ __forceinline__ void xcd_barrier(const XcdBarrier& b) {
    asm volatile("s_waitcnt vmcnt(0)" ::: "memory");
    __syncthreads();
    if (threadIdx.x == 0) {
        unsigned* bar = b.bar;
        __builtin_amdgcn_s_waitcnt(0);
        unsigned nloc = b.st[0], nx = b.st[1];
        if (nloc == 0u) { xcd_barrier_complete(bar, b.x, nloc, nx); b.st[0] = nloc; b.st[1] = nx; }
        const unsigned old = xb_add(&bar[XB_XSUB(b.x)], 1u);
        const unsigned gen = old / nloc;
        if (old + 1u == (gen + 1u) * nloc) {
            __builtin_amdgcn_fence(__ATOMIC_RELEASE, "agent");
            asm volatile("s_waitcnt vmcnt(0)" ::: "memory");
            const unsigned og = xb_add(&bar[XB_TOP], 1u);
            const unsigned tg = og / nx;
            if (og + 1u == (tg + 1u) * nx) xb_add(&bar[XB_TOPGEN], 1u);
            else XB_SPIN(xb_ld(&bar[XB_TOPGEN]) == tg, bar);
            __builtin_amdgcn_fence(__ATOMIC_ACQUIRE, "agent");
            xb_add(&bar[XB_XGEN(b.x)], 1u);
            asm volatile("s_waitcnt vmcnt(0)" ::: "memory");
        } else {
            XB_SPIN(xb_ld(&bar[XB_XGEN(b.x)]) == gen, bar);
            __builtin_amdgcn_fence(__ATOMIC_ACQUIRE, "agent");
            asm volatile("s_waitcnt vmcnt(0)" ::: "memory");
        }
    }
    __syncthreads();
}

namespace pg8 {
struct UnitG { int seg, mt, nt; };
template <class Prob, class Epi>
__device__ __forceinline__ void gemm_phase_g(PG8_LAS unsigned char* lds, const Prob& P, const Epi& E) {
    const int tid = threadIdx.x, wid = __builtin_amdgcn_readfirstlane(tid >> 6), lane = tid & 63, wr = wid >> 2, wc = wid & 3, fr = lane & 15, fq = lane >> 4;
    const int K = P.K, nt = K / BK;
    int sR[2], sC[2]; unsigned voffB[2];
#pragma unroll
    for (int i = 0; i < 2; ++i) { int R, C; stage_rc(tid * 16 + i * 8192, R, C); const int Rb = Epi::PERM ? ((R & ~31) + perm32(R & 31)) : R; sR[i] = R; sC[i] = C; voffB[i] = (unsigned)(Rb * K + C) * 2u; }
    const size_t kstep = (size_t)(BK * 2);
    const size_t hstep = (size_t)HALF * K * 2;
    const unsigned ldsw = (unsigned)wid * 1024u;
    const int aoff = lds_byte(wr * 64 + fr, fq * 8), boff = lds_byte(wc * 32 + fr, fq * 8);
#define PG8_SA(b, h) (((b) * 2 + (h)) * HTB)
#define PG8_SB(b, h) ((4 + (b) * 2 + (h)) * HTB)
#define PG8_STAGE(bufoff, gbase, voff) do { _Pragma("unroll") for (int _i = 0; _i < 2; ++_i) \
        __builtin_amdgcn_global_load_lds((const unsigned*)((const char*)(gbase) + (voff)[_i]), (PG8_LAS unsigned*)(lds + (bufoff) + ldsw + _i * 8192), 16, 0, 0); } while (0)
#define PG8_LDA(dst, b, h) do { _Pragma("unroll") for (int m = 0; m < 4; ++m) _Pragma("unroll") for (int k = 0; k < 2; ++k) dst[m][k] = *(const PG8_LAS bf16x8*)(lds + PG8_SA(b, h) + aoff + m * 2048 + k * 1024); } while (0)
#define PG8_LDB(dst, b, h) do { _Pragma("unroll") for (int n = 0; n < 2; ++n) _Pragma("unroll") for (int k = 0; k < 2; ++k) dst[n][k] = *(const PG8_LAS bf16x8*)(lds + PG8_SB(b, h) + boff + n * 2048 + k * 1024); } while (0)
#define PG8_MMA(ai, bj, At, Bt) do { __builtin_amdgcn_s_setprio(1); _Pragma("unroll") for (int m = 0; m < 4; ++m) _Pragma("unroll") for (int n = 0; n < 2; ++n) _Pragma("unroll") for (int k = 0; k < 2; ++k) \
        acc[ai][bj][m][n] = __builtin_amdgcn_mfma_f32_16x16x32_bf16(Bt[n][k], At[m][k], acc[ai][bj][m][n], 0, 0, 0); __builtin_amdgcn_s_setprio(0); } while (0)
#define PG8_WAIT_V(n) asm volatile("s_waitcnt vmcnt(" #n ")" ::: "memory")
#define PG8_WAIT_L(n) asm volatile("s_waitcnt lgkmcnt(" #n ")" ::: "memory")
#define PG8_BAR __builtin_amdgcn_s_barrier()
#define PG8_SCHED __builtin_amdgcn_sched_barrier(0)
    UnitG cur, nxt; int ui = 0;
    if (!P.next(0, cur)) return;
    f32x4 acc[2][2][4][2];
#pragma unroll
    for (int a = 0; a < 2; ++a)
#pragma unroll
        for (int b = 0; b < 2; ++b)
#pragma unroll
            for (int m = 0; m < 4; ++m)
#pragma unroll
                for (int n = 0; n < 2; ++n) acc[a][b][m][n] = (f32x4){0.f, 0.f, 0.f, 0.f};
    bf16x8 At[4][2], B0[2][2], B1[2][2];
    unsigned offA[2][2], offAn[2][2];
    const char* cA; const char* cB;
    P.setup(cur, sR, sC, cA, offA, cB);
    PG8_STAGE(PG8_SB(0, 0), cB, voffB); PG8_STAGE(PG8_SB(0, 1), cB + hstep, voffB); PG8_STAGE(PG8_SA(0, 0), cA, offA[0]); PG8_STAGE(PG8_SA(0, 1), cA, offA[1]);
    if (wr == 1) PG8_BAR;
    PG8_WAIT_V(2); PG8_BAR;
    PG8_STAGE(PG8_SB(1, 0), cB + kstep, voffB); PG8_STAGE(PG8_SA(1, 0), cA + kstep, offA[0]); PG8_STAGE(PG8_SB(1, 1), cB + hstep + kstep, voffB);
    PG8_WAIT_V(6); PG8_BAR;
    for (;;) {
        const bool has_next = P.next(ui + 1, nxt);
        const char* nA = cA; const char* nB = cB;
#pragma unroll
        for (int h = 0; h < 2; ++h)
#pragma unroll
            for (int i = 0; i < 2; ++i) offAn[h][i] = offA[h][i];
        if (has_next) P.setup(nxt, sR, sC, nA, offAn, nB);
        for (int t = 0; t < nt; t += 2) {
            const bool last = (t == nt - 2);
            const char* a1 = cA + (size_t)(t + 1) * kstep;
            const char* a2 = last ? nA : cA + (size_t)(t + 2) * kstep; const char* b2 = last ? nB : cB + (size_t)(t + 2) * kstep;
            const char* a3 = a2 + kstep; const char* b3 = b2 + kstep;
            unsigned o2[2][2];
#pragma unroll
            for (int h = 0; h < 2; ++h)
#pragma unroll
                for (int i = 0; i < 2; ++i) o2[h][i] = last ? offAn[h][i] : offA[h][i];
            PG8_LDB(B0, 0, 0); PG8_LDB(B1, 0, 1); PG8_SCHED; PG8_LDA(At, 0, 0); PG8_STAGE(PG8_SA(1, 1), a1, offA[1]);
            PG8_WAIT_V(8); PG8_WAIT_L(0); PG8_BAR; PG8_MMA(0, 0, At, B0); PG8_MMA(0, 1, At, B1); PG8_BAR; PG8_SCHED;
            PG8_LDA(At, 0, 1); PG8_STAGE(PG8_SB(0, 0), b2, voffB); PG8_STAGE(PG8_SB(0, 1), b2 + hstep, voffB); PG8_STAGE(PG8_SA(0, 0), a2, o2[0]);
            PG8_WAIT_V(8); PG8_WAIT_L(0); PG8_BAR; PG8_MMA(1, 0, At, B0); PG8_MMA(1, 1, At, B1); PG8_BAR; PG8_SCHED;
            PG8_LDB(B0, 1, 0); PG8_LDB(B1, 1, 1); PG8_SCHED; PG8_LDA(At, 1, 0); PG8_STAGE(PG8_SA(0, 1), a2, o2[1]);
            PG8_WAIT_V(8); PG8_WAIT_L(0); PG8_BAR; PG8_MMA(0, 0, At, B0); PG8_MMA(0, 1, At, B1); PG8_BAR; PG8_SCHED;
            PG8_LDA(At, 1, 1); PG8_STAGE(PG8_SB(1, 0), b3, voffB); PG8_STAGE(PG8_SB(1, 1), b3 + hstep, voffB); PG8_STAGE(PG8_SA(1, 0), a3, o2[0]);
            PG8_WAIT_V(8); PG8_WAIT_L(0); PG8_BAR; PG8_MMA(1, 0, At, B0); PG8_MMA(1, 1, At, B1); PG8_BAR; PG8_SCHED;
        }
        if (wr == 0) PG8_BAR;
        E(acc, cur, wr, wc, fr, fq);
        if (!has_next) break;
#pragma unroll
        for (int a = 0; a < 2; ++a)
#pragma unroll
            for (int b = 0; b < 2; ++b)
#pragma unroll
                for (int m = 0; m < 4; ++m)
#pragma unroll
                    for (int n = 0; n < 2; ++n) acc[a][b][m][n] = (f32x4){0.f, 0.f, 0.f, 0.f};
        cur = nxt; cA = nA; cB = nB; ++ui;
#pragma unroll
        for (int h = 0; h < 2; ++h)
#pragma unroll
            for (int i = 0; i < 2; ++i) offA[h][i] = offAn[h][i];
        if (wr == 1) PG8_BAR;
    }
    PG8_WAIT_V(0);
    PG8_BAR;
#undef PG8_SA
#undef PG8_SB
#undef PG8_STAGE
#undef PG8_LDA
#undef PG8_LDB
#undef PG8_MMA
#undef PG8_WAIT_V
#undef PG8_WAIT_L
#undef PG8_BAR
#undef PG8_SCHED
}
}

constexpr int NWAVES = 8;
constexpr int BATCH = 2, T = 8192, D = 1024, M = BATCH * T, DIN = 4104, PA = 3072;
constexpr int NE = 64, NEX = 65, DE = 256;
constexpr size_t MiB = 1u << 20;
constexpr size_t WS_CTL = 0, CTL_ZERO_BYTES = 256 * 1024;
constexpr size_t WS_WRHI = 512 * 1024, WS_WRLO = 640 * 1024;
constexpr size_t WS_MOD = 1 * MiB, WS_WAB = 1 * MiB + 256 * 1024, WS_AB = 1 * MiB + 512 * 1024;
constexpr size_t WS_WOUT_T = 2 * MiB, WS_WIN_T = 4 * MiB, WS_H1 = 12 * MiB, WS_PROJA = 44 * MiB, WS_GATES = 142 * MiB;
constexpr size_t WS_QP = 4 * MiB, WS_OI = 20 * MiB, WS_AH = 36 * MiB, WS_GL = 36 * MiB + 512 * 1024, WS_PG = 174 * MiB, WS_BG = 206 * MiB, WS_BH = 238 * MiB, WS_QE = 270 * MiB, WS_OIH = 286 * MiB;
constexpr size_t WS_OMIX = 174 * MiB;
constexpr size_t WS_H2 = 12 * MiB, WS_W1T = 44 * MiB, WS_W2T = 109 * MiB, WS_ACT = 142 * MiB, WS_LIST = 215 * MiB, WS_LISTW = 217 * MiB, WS_Y0 = 12 * MiB, WS_Y1 = 219 * MiB;
constexpr size_t WS_TOP = 302 * MiB;
constexpr int CAP = 4096;
constexpr int TB_PRE = 0, TB_CNT = 132, TB_OFF = 264;
constexpr int CW_CNT = 16384;
constexpr int CW_BAR = 4096;
constexpr int RING_BYTES = 131072, LDS_BYTES = 147456, LDSCTL_OFF = LDS_BYTES - 1024, MISC_OFF = LDSCTL_OFF + 320, SCR2_OFF = LDS_BYTES - 3072;

__device__ __forceinline__ float bf2f(bf16 v) { return __uint_as_float(((unsigned)v) << 16); }
__device__ __forceinline__ float sigmoidf_(float x) { return 1.f / (1.f + __expf(-x)); }
__device__ __forceinline__ float siluf_(float x) { return x / (1.f + __expf(-x)); }
__device__ __forceinline__ float softplusf_(float x) { return x > 20.f ? x : log1pf(expf(x)); }
__device__ __forceinline__ float wave_sum(float v) {
#pragma unroll
    for (int o = 1; o < 64; o <<= 1) v += __shfl_xor(v, o);
    return v;
}

namespace pg8 {
struct EpiProj {
    static constexpr bool PERM = true, AFTER_DRAIN = false;
    bf16_t* projA; bf16_t* gates;
    __device__ __forceinline__ void operator()(const f32x4 (&acc)[2][2][4][2], const Unit& u, int wr, int wc, int fr, int fq) const {
        const int row0 = u.pm * BM + wr * 64 + fr;
        bf16_t* base; int ldc, colt;
        if (u.pn < 12) { base = projA; ldc = 3072; colt = u.pn * BM; } else { base = gates; ldc = 1024; colt = (u.pn - 12) * BM; }
        const int col0 = colt + wc * 32 + 8 * fq;
#pragma unroll
        for (int ai = 0; ai < 2; ++ai)
#pragma unroll
            for (int m = 0; m < 4; ++m) { bf16_t* rowp = base + (size_t)(row0 + ai * HALF + m * 16) * ldc + col0;
#pragma unroll
                for (int bj = 0; bj < 2; ++bj) { const f32x4 v0 = acc[ai][bj][m][0], v1 = acc[ai][bj][m][1];
                    u32x4 w; w.x = cvt_pk_bf16(v0[0], v0[1]); w.y = cvt_pk_bf16(v0[2], v0[3]); w.z = cvt_pk_bf16(v1[0], v1[1]); w.w = cvt_pk_bf16(v1[2], v1[3]);
                    *(u32x4*)(rowp + bj * HALF) = w; } }
    }
};
struct EpiResid {
    static constexpr bool PERM = false, AFTER_DRAIN = false;
    const float* x; const float* mod; float* out;
    __device__ __forceinline__ void operator()(const f32x4 (&acc)[2][2][4][2], const Unit& u, int wr, int wc, int fr, int fq) const {
        const int col0 = u.pn * BM + wc * 32 + 4 * fq;
#pragma unroll
        for (int ai = 0; ai < 2; ++ai)
#pragma unroll
            for (int m = 0; m < 4; ++m) { const int r = u.pm * BM + ai * HALF + wr * 64 + m * 16 + fr; const float* g1 = mod + (r >= 8192 ? 6144 : 0) + 2048; const size_t off = (size_t)r * 1024 + col0;
#pragma unroll
                for (int bj = 0; bj < 2; ++bj)
#pragma unroll
                    for (int n = 0; n < 2; ++n) { const f32x4 gv = *(const f32x4*)(g1 + col0 + bj * HALF + n * 16); const f32x4 xv = *(const f32x4*)(x + off + bj * HALF + n * 16);
                        *(f32x4*)(out + off + bj * HALF + n * 16) = xv + gv * acc[ai][bj][m][n]; } }
    }
};

struct MoeSched {
    const LAS unsigned* tb; int lo, hi, NT, G, c;
    __device__ __forceinline__ bool next(int i, UnitG& u) const {
        const unsigned L = (unsigned)(i * G + c); if (L >= tb[TB_PRE + hi]) return false;
        int s = lo; while (L >= tb[TB_PRE + s + 1]) ++s;
        const unsigned loc = L - tb[TB_PRE + s], tiles = (tb[TB_CNT + s] + 255u) >> 8;
        u.seg = __builtin_amdgcn_readfirstlane(s); u.mt = __builtin_amdgcn_readfirstlane((int)(loc % tiles)); u.nt = __builtin_amdgcn_readfirstlane((int)(loc / tiles)); return true;
    }
};
struct Moe1Prob {
    int K; MoeSched S; const bf16_t* h2; const bf16_t* w1t; const int* list;
    __device__ __forceinline__ bool next(int i, UnitG& u) const { return S.next(i, u); }
    __device__ __forceinline__ void setup(const UnitG& u, const int (&sR)[2], const int (&sC)[2], const char*& cA, unsigned (&offA)[2][2], const char*& cB) const {
        const int hf = u.seg >= 65 ? 1 : 0, e = u.seg - 65 * hf; const int cnt = (int)S.tb[TB_CNT + u.seg];
#pragma unroll
        for (int h = 0; h < 2; ++h)
#pragma unroll
            for (int i = 0; i < 2; ++i) { const int r = 256 * u.mt + 128 * h + sR[i]; unsigned tok;
                if (e < 64) { const int rr = r < cnt ? r : cnt - 1; tok = (unsigned)list[(size_t)(hf * 64 + e) * CAP + rr] >> 3; } else tok = (unsigned)(hf * 8192 + (r < 8192 ? r : 8191));
                offA[h][i] = tok * 2048u + (unsigned)sC[i] * 2u; }
        cA = (const char*)h2; cB = (const char*)(w1t + ((size_t)e * 512 + (size_t)u.nt * 256) * 1024);
    }
};
struct Moe2Prob {
    int K; MoeSched S; const bf16_t* act; const bf16_t* w2t; int hf;
    __device__ __forceinline__ bool next(int i, UnitG& u) const { return S.next(i, u); }
    __device__ __forceinline__ void setup(const UnitG& u, const int (&sR)[2], const int (&sC)[2], const char*& cA, unsigned (&offA)[2][2], const char*& cB) const {
        const int e = u.seg - 65 * hf; const size_t rowbase = (size_t)S.tb[TB_OFF + u.seg] + 256u * (unsigned)u.mt;
#pragma unroll
        for (int h = 0; h < 2; ++h)
#pragma unroll
            for (int i = 0; i < 2; ++i) offA[h][i] = (unsigned)((128 * h + sR[i]) * 256 + sC[i]) * 2u;
        cA = (const char*)(act + rowbase * 256); cB = (const char*)(w2t + ((size_t)e * 1024 + (size_t)u.nt * 256) * 256);
    }
};
struct EpiMoe1 {
    static constexpr bool PERM = true;
    bf16_t* act; const LAS unsigned* tb;
    __device__ __forceinline__ void operator()(const f32x4 (&acc)[2][2][4][2], const UnitG& u, int wr, int wc, int fr, int fq) const {
        const int cnt = (int)tb[TB_CNT + u.seg]; const size_t rowbase = tb[TB_OFF + u.seg];
#pragma unroll
        for (int ai = 0; ai < 2; ++ai)
#pragma unroll
            for (int m = 0; m < 4; ++m) { const int r = 256 * u.mt + ai * HALF + wr * 64 + m * 16 + fr;
                if (r < cnt) { bf16_t* p = act + (rowbase + (size_t)r) * 256 + u.nt * 128 + wc * 32 + 8 * fq;
                    const f32x4 g0 = acc[ai][0][m][0], g1 = acc[ai][0][m][1], u0 = acc[ai][1][m][0], u1 = acc[ai][1][m][1]; f32x4 v0, v1;
#pragma unroll
                    for (int i = 0; i < 4; ++i) { v0[i] = g0[i] / (1.f + __expf(-g0[i])) * u0[i]; v1[i] = g1[i] / (1.f + __expf(-g1[i])) * u1[i]; }
                    u32x4 w; w.x = cvt_pk_bf16(v0[0], v0[1]); w.y = cvt_pk_bf16(v0[2], v0[3]); w.z = cvt_pk_bf16(v1[0], v1[1]); w.w = cvt_pk_bf16(v1[2], v1[3]);
                    *(u32x4*)p = w; } }
    }
};
struct EpiMoe2 {
    static constexpr bool PERM = true;
    bf16_t* y0; bf16_t* y1; float* x2; const float* mod; const int* list; const float* listw; const LAS unsigned* tb; int hf; int do_shared;
    __device__ __forceinline__ void operator()(const f32x4 (&acc)[2][2][4][2], const UnitG& u, int wr, int wc, int fr, int fq) const {
        const int cnt = (int)tb[TB_CNT + u.seg]; const int e = u.seg - 65 * hf; const int colt = u.nt * 256 + wc * 32 + 8 * fq;
#pragma unroll
        for (int ai = 0; ai < 2; ++ai)
#pragma unroll
            for (int m = 0; m < 4; ++m) { const int r = 256 * u.mt + ai * HALF + wr * 64 + m * 16 + fr;
                if (r < cnt) {
                    if (e < 64) { const size_t li = (size_t)(hf * 64 + e) * CAP + r; const int slot = list[li]; const float w = listw[li];
                        const int yr = slot - hf * 65536; bf16_t* p = (yr < 32768 ? y0 + (size_t)yr * 1024 : y1 + (size_t)(yr - 32768) * 1024) + colt;
#pragma unroll
                        for (int bj = 0; bj < 2; ++bj) { const f32x4 v0 = acc[ai][bj][m][0] * w, v1 = acc[ai][bj][m][1] * w;
                            u32x4 o; o.x = cvt_pk_bf16(v0[0], v0[1]); o.y = cvt_pk_bf16(v0[2], v0[3]); o.z = cvt_pk_bf16(v1[0], v1[1]); o.w = cvt_pk_bf16(v1[2], v1[3]);
                            *(u32x4*)(p + bj * HALF) = o; }
                    } else if (do_shared) { float* p = x2 + (size_t)(hf * 8192 + r) * 1024 + colt; const float* g2 = mod + hf * 6144 + 5120 + colt;
#pragma unroll
                        for (int bj = 0; bj < 2; ++bj)
#pragma unroll
                            for (int n = 0; n < 2; ++n) { f32x4* q = (f32x4*)(p + bj * HALF + 4 * n); *q = *q + *(const f32x4*)(g2 + bj * HALF + 4 * n) * acc[ai][bj][m][n]; } }
                } }
    }
};
}

struct TrItem { const float* W; int ldw, src_col; bf16* WT; int K, dst_row, k0; };
__device__ __forceinline__ void tr_load(const TrItem& t, int lane, f32x4 (&v)[8]) {
#pragma unroll
    for (int i = 0; i < 8; ++i) v[i] = *(const GAS f32x4*)(t.W + (size_t)(t.k0 + 8 * i + (lane >> 3)) * t.ldw + t.src_col + 4 * (lane & 7));
}
__device__ __forceinline__ void tr_finish(const TrItem& t, int lane, const f32x4 (&v)[8], LAS float* scr) {
#pragma unroll
    for (int i = 0; i < 8; ++i) { LAS float* p = scr + (8 * i + (lane >> 3)) * 33 + 4 * (lane & 7); p[0] = v[i][0]; p[1] = v[i][1]; p[2] = v[i][2]; p[3] = v[i][3]; }
    LDS_WAIT(); asm volatile("" ::: "memory");
    const int c = lane & 7;
#pragma unroll
    for (int j = 0; j < 4; ++j) { const int n = (lane >> 3) + 8 * j; const LAS float* s = scr + (8 * c) * 33 + n;
        v4u o; o.x = pk2(s[0 * 33], s[1 * 33]); o.y = pk2(s[2 * 33], s[3 * 33]); o.z = pk2(s[4 * 33], s[5 * 33]); o.w = pk2(s[6 * 33], s[7 * 33]);
        *(GAS v4u*)(t.WT + (size_t)(t.dst_row + n) * t.K + t.k0 + 8 * c) = o; }
    LDS_WAIT(); asm volatile("" ::: "memory");
}
#define TR_LOOP(it0, stride, nitems, MAKE) do { int it_ = (it0); if (it_ < (nitems)) { TrItem cur_ = MAKE(it_); f32x4 va_[8], vb_[8]; tr_load(cur_, lane, va_); \
    for (;;) { const int nx_ = it_ + (stride); const bool hn_ = nx_ < (nitems); TrItem nxt_ = cur_; if (hn_) { nxt_ = MAKE(nx_); tr_load(nxt_, lane, vb_); } \
        tr_finish(cur_, lane, va_, scr); if (!hn_) break; _Pragma("unroll") for (int q_ = 0; q_ < 8; ++q_) va_[q_] = vb_[q_]; cur_ = nxt_; it_ = nx_; } } } while (0)

#ifndef REP_PHASE
#define REP_PHASE -1
#endif
#ifndef REP_N
#define REP_N 1
#endif
#define REPN(k) ((k) == REP_PHASE ? REP_N : 1)

constexpr int UNITS = BATCH * 128 * 4;
constexpr int L_QN = 0, L_KN = 17408, L_VV = 34816, L_LM = 52224, L_ATT = 68608, L_UT = 77824, L_WT = 96256, L_KTT = 114688, L_GCS = 133120, L_EGS = 133376, L_BET = 133632, L_SCW = 133888, L_SKT = 134144, L_TM = L_KN, L_TB = L_VV;
constexpr int H_FR = 0, H_QR = 17408, H_QE = 34816, H_KD = 52224, H_KTT = 69632, H_VT = 88064, H_AM = 106496;
constexpr int RS = 272, TS = 144;

typedef unsigned v2u __attribute__((ext_vector_type(2)));
__device__ __forceinline__ f32x4 mfma16(bf16x8 a, bf16x8 b, f32x4 c) { return __builtin_amdgcn_mfma_f32_16x16x32_bf16(a, b, c, 0, 0, 0); }
__device__ __forceinline__ bf16x8 ldsfrag(const LAS unsigned char* base, int row, int stride, int kbyte) { return *(const LAS bf16x8*)(base + row * stride + kbyte); }
__device__ __forceinline__ void unpack8(const v4u q, float (&f)[8]) {
    f[0] = __uint_as_float(q.x << 16); f[1] = __uint_as_float(q.x & 0xffff0000u); f[2] = __uint_as_float(q.y << 16); f[3] = __uint_as_float(q.y & 0xffff0000u);
    f[4] = __uint_as_float(q.z << 16); f[5] = __uint_as_float(q.z & 0xffff0000u); f[6] = __uint_as_float(q.w << 16); f[7] = __uint_as_float(q.w & 0xffff0000u); }
__device__ __forceinline__ f32x4 unpack4(const v2u q) { return (f32x4){__uint_as_float(q.x << 16), __uint_as_float(q.x & 0xffff0000u), __uint_as_float(q.y << 16), __uint_as_float(q.y & 0xffff0000u)}; }
__device__ __forceinline__ v2u pack4(const f32x4 v) { v2u o; o.x = pk2(v[0], v[1]); o.y = pk2(v[2], v[3]); return o; }
__device__ __forceinline__ float ldsbf(const LAS unsigned char* base, int row, int stride, int col) { return __uint_as_float(((unsigned)*(const LAS unsigned short*)(base + row * stride + col * 2)) << 16); }

struct MixPtrs {
    const bf16* projA; const bf16* gates; const float* ab; const float* conv_w; const float* a_log; const float* dt_bias; const float* hg_lb; const float* gdn_nw; const float* hg_nw;
    bf16 *PG, *BG, *QP, *OI, *BH, *QE, *OIH, *SG, *SH, *omix; float *GL, *AH;
};

__device__ __forceinline__ void p3_gdn_unit(LAS unsigned char* lds, const MixPtrs& X, int unit, int tid, int lane, int wave) {
    const int h = unit & 3, n = (unit >> 2) & 127, b = unit >> 9, r = lane & 15, g = lane >> 4;
    const size_t tok0 = (size_t)b * T + (size_t)n * 64;
    LAS float* gcs = (LAS float*)(lds + L_GCS); LAS float* egs = (LAS float*)(lds + L_EGS); LAS float* bet = (LAS float*)(lds + L_BET);
#pragma unroll 2
    for (int i = 0; i < 6; ++i) {
        const int pair = (tid >> 4) + 32 * i, tz = pair >> 6, c = pair & 63, ch = tid & 15, col = tz * 512 + h * 128 + ch * 8;
        float y[8];
#pragma unroll
        for (int e = 0; e < 8; ++e) y[e] = 0.f;
#pragma unroll
        for (int j = 0; j < 4; ++j) { const int tl = n * 64 + c - 3 + j;
            if (tl >= 0) { const v4u q = *(const GAS v4u*)(X.projA + ((size_t)b * T + tl) * PA + col); float xf[8]; unpack8(q, xf);
                const f32x4 w0 = *(const GAS f32x4*)(X.conv_w + j * 1536 + col), w1 = *(const GAS f32x4*)(X.conv_w + j * 1536 + col + 4);
#pragma unroll
                for (int e = 0; e < 4; ++e) { y[e] += w0[e] * xf[e]; y[4 + e] += w1[e] * xf[4 + e]; } } }
        float ss = 0.f;
#pragma unroll
        for (int e = 0; e < 8; ++e) { y[e] = siluf_(y[e]); ss += y[e] * y[e]; }
        ss += __shfl_xor(ss, 1); ss += __shfl_xor(ss, 2); ss += __shfl_xor(ss, 4); ss += __shfl_xor(ss, 8);
        const float rn = tz == 2 ? 1.f : rsqrtf(ss + 1e-6f) * (tz == 0 ? 0.08838834764831845f : 1.f);
        v4u o; o.x = pk2(y[0] * rn, y[1] * rn); o.y = pk2(y[2] * rn, y[3] * rn); o.z = pk2(y[4] * rn, y[5] * rn); o.w = pk2(y[6] * rn, y[7] * rn);
        *(LAS v4u*)(lds + (tz == 0 ? L_QN : (tz == 1 ? L_KN : L_VV)) + c * RS + ch * 16) = o;
    }
    if (wave == 0) {
        const float araw = X.ab[(tok0 + lane) * 8 + 4 + h], braw = X.ab[(tok0 + lane) * 8 + h];
        float gv = -expf(X.a_log[h]) * softplusf_(araw + X.dt_bias[h]);
#pragma unroll
        for (int o = 1; o < 64; o <<= 1) { const float t = __shfl_up(gv, o); if (lane >= o) gv += t; }
        { const float eg_ = __expf(gv), be_ = sigmoidf_(braw); gcs[lane] = gv; egs[lane] = eg_; bet[lane] = be_; *(LAS float*)(lds + L_SCW + lane * 4) = be_ * eg_; *(LAS float*)(lds + L_SKT + lane * 4) = __expf(__shfl(gv, 63) - gv); }
        if (lane == 63) X.GL[unit] = gv;
    }
    __syncthreads();
    {
        const int mt = wave >> 1;
#pragma unroll
        for (int q = 0; q < 2; ++q) { const int ntc = 2 * (wave & 1) + q; f32x4 akk = {0.f, 0.f, 0.f, 0.f}, aqk = {0.f, 0.f, 0.f, 0.f};
#pragma unroll
            for (int ks = 0; ks < 4; ++ks) { const bf16x8 ka = ldsfrag(lds + L_KN, 16 * mt + r, RS, 64 * ks + 16 * g), qa = ldsfrag(lds + L_QN, 16 * mt + r, RS, 64 * ks + 16 * g), kb = ldsfrag(lds + L_KN, 16 * ntc + r, RS, 64 * ks + 16 * g);
                akk = mfma16(ka, kb, akk); aqk = mfma16(qa, kb, aqk); }
            const int j = 16 * ntc + r; const float gj = gcs[j];
#pragma unroll
            for (int ii = 0; ii < 4; ++ii) { const int i = 16 * mt + 4 * g + ii; const float dec = (i >= j) ? __expf(gcs[i] - gj) : 0.f;
                *(LAS float*)(lds + L_LM + (i * 64 + j) * 4) = (i > j) ? bet[i] * akk[ii] * dec : 0.f;
                *(LAS unsigned short*)(lds + L_ATT + i * TS + j * 2) = (unsigned short)f2bf(aqk[ii] * dec); } }
    }
    __syncthreads();
#pragma unroll
    for (int i = 0; i < 2; ++i) { const int tsk = tid + 512 * i;
        if (tsk < 768) { const int a = tsk >> 8, hh = (tsk >> 7) & 1, d = tsk & 127;
            const LAS unsigned char* sp = lds + (a == 0 ? L_VV : L_KN) + d * 2; const LAS float* scl = (const LAS float*)(lds + (a == 0 ? L_BET : (a == 1 ? L_SCW : L_SKT)));
            LAS unsigned char* dp = lds + (a == 0 ? L_UT : (a == 1 ? L_WT : L_KTT)) + d * TS + 64 * hh;
#pragma unroll
            for (int q = 0; q < 4; ++q) { float kv[8];
#pragma unroll
                for (int e = 0; e < 8; ++e) { const int c = 32 * hh + 8 * q + e; kv[e] = __uint_as_float(((unsigned)*(const LAS unsigned short*)(sp + c * RS)) << 16) * scl[c]; }
                v4u o; o.x = pk2(kv[0], kv[1]); o.y = pk2(kv[2], kv[3]); o.z = pk2(kv[4], kv[5]); o.w = pk2(kv[6], kv[7]); *(LAS v4u*)(dp + 16 * q) = o; } } }
    __syncthreads();
    { const LAS float* Lm = (const LAS float*)(lds + L_LM); LAS float* Tm = (LAS float*)(lds + L_TM);
      if (tid < 64) { const int I = tid >> 4, j = tid & 15; float x[16];
#pragma unroll
          for (int i = 0; i < 16; ++i) { float s = (i == j) ? 1.f : 0.f;
#pragma unroll
              for (int kb = 0; kb < (i + 3) / 4; ++kb) { const f32x4 l = *(const LAS f32x4*)(Lm + (16 * I + i) * 64 + 16 * I + 4 * kb);
#pragma unroll
                  for (int e = 0; e < 4; ++e) if (4 * kb + e < i) s -= l[e] * x[4 * kb + e]; }
              x[i] = (i < j) ? 0.f : s; Tm[(16 * I + i) * 64 + 16 * I + j] = x[i]; } }
      __syncthreads();
#pragma unroll 1
      for (int lv = 1; lv < 4; ++lv) {
          for (int e = tid; e < (4 - lv) * 256; e += NWAVES * 64) { const int I = lv + (e >> 8), J = I - lv, rr = (e >> 4) & 15, cc = e & 15; float w = 0.f;
              for (int K = J; K < I; ++K) {
#pragma unroll
                  for (int kb = 0; kb < 4; ++kb) { const f32x4 l = *(const LAS f32x4*)(Lm + (16 * I + rr) * 64 + 16 * K + 4 * kb);
#pragma unroll
                      for (int q = 0; q < 4; ++q) w += l[q] * Tm[(16 * K + 4 * kb + q) * 64 + 16 * J + cc]; } }
              Tm[(16 * J + rr) * 64 + 16 * I + cc] = w; }
          __syncthreads();
          for (int e = tid; e < (4 - lv) * 256; e += NWAVES * 64) { const int I = lv + (e >> 8), J = I - lv, rr = (e >> 4) & 15, cc = e & 15; float t = 0.f;
#pragma unroll
              for (int kb = 0; kb < 4; ++kb) { const f32x4 l = *(const LAS f32x4*)(Tm + (16 * I + rr) * 64 + 16 * I + 4 * kb);
#pragma unroll
                  for (int q = 0; q < 4; ++q) t -= l[q] * Tm[(16 * J + 4 * kb + q) * 64 + 16 * I + cc]; }
              Tm[(16 * I + rr) * 64 + 16 * J + cc] = t; }
          __syncthreads();
      }
      { const int i = tid >> 3, j0 = (tid & 7) * 8; const f32x4 t0 = *(const LAS f32x4*)(Tm + i * 64 + j0), t1 = *(const LAS f32x4*)(Tm + i * 64 + j0 + 4); const bool keep = (i >> 4) >= (j0 >> 4);
        v4u o; o.x = keep ? pk2(t0[0], t0[1]) : 0u; o.y = keep ? pk2(t0[2], t0[3]) : 0u; o.z = keep ? pk2(t1[0], t1[1]) : 0u; o.w = keep ? pk2(t1[2], t1[3]) : 0u;
        *(LAS v4u*)(lds + L_TB + i * TS + j0 * 2) = o; }
      __syncthreads();
    }
    { bf16x8 af[4][2];
#pragma unroll
      for (int mt = 0; mt < 4; ++mt)
#pragma unroll
          for (int ks = 0; ks < 2; ++ks) af[mt][ks] = ldsfrag(lds + L_TB, 16 * mt + r, TS, 64 * ks + 16 * g);
#pragma unroll
      for (int q = 0; q < 2; ++q) { const int ng = 2 * wave + q; LAS unsigned char* base = lds + (ng >= 8 ? L_WT : L_UT) + (16 * (ng & 7) + r) * TS;
          const bf16x8 b0 = *(const LAS bf16x8*)(base + 16 * g), b1 = *(const LAS bf16x8*)(base + 64 + 16 * g);
          f32x4 acc[4];
#pragma unroll
          for (int mt = 0; mt < 4; ++mt) { acc[mt] = mfma16(af[mt][0], b0, (f32x4){0.f, 0.f, 0.f, 0.f}); acc[mt] = mfma16(af[mt][1], b1, acc[mt]); }
          asm volatile("s_waitcnt lgkmcnt(0)" ::: "memory");
#pragma unroll
          for (int mt = 0; mt < 4; ++mt) *(LAS v2u*)(base + (16 * mt + 4 * g) * 2) = pack4(acc[mt]); }
    }
    __syncthreads();
    {
        const size_t u16 = (size_t)unit * 16384, u8 = (size_t)unit * 8192;
        { const int kk = wave >> 1;
          bf16x8 af[2][2];
#pragma unroll
          for (int t2 = 0; t2 < 2; ++t2)
#pragma unroll
              for (int ks = 0; ks < 2; ++ks) af[t2][ks] = ldsfrag(lds + L_WT, 16 * (2 * kk + t2) + r, TS, 64 * ks + 16 * g);
#pragma unroll
          for (int q = 0; q < 4; ++q) { const int nt = 4 * (wave & 1) + q; f32x4 a0 = {0.f, 0.f, 0.f, 0.f}, a1 = {0.f, 0.f, 0.f, 0.f};
#pragma unroll
              for (int ks = 0; ks < 2; ++ks) { const bf16x8 bfr = ldsfrag(lds + L_KTT, 16 * nt + r, TS, 64 * ks + 16 * g); a0 = mfma16(af[0][ks], bfr, a0); a1 = mfma16(af[1][ks], bfr, a1); }
              v4u o; o.x = pk2(-a0[0], -a0[1]); o.y = pk2(-a0[2], -a0[3]); o.z = pk2(-a1[0], -a1[1]); o.w = pk2(-a1[2], -a1[3]);
              *(GAS v4u*)(X.PG + u16 + ((size_t)(nt * 4 + kk) * 64 + lane) * 8) = o; } }
        { const int mt = wave; bf16x8 af[2];
#pragma unroll
          for (int ks = 0; ks < 2; ++ks) af[ks] = ldsfrag(lds + L_KTT, 16 * mt + r, TS, 64 * ks + 16 * g);
#pragma unroll
          for (int nt = 0; nt < 8; ++nt) { f32x4 a0 = {0.f, 0.f, 0.f, 0.f};
#pragma unroll
              for (int ks = 0; ks < 2; ++ks) a0 = mfma16(af[ks], ldsfrag(lds + L_UT, 16 * nt + r, TS, 64 * ks + 16 * g), a0);
              *(GAS v2u*)(X.BG + u16 + ((size_t)(nt * 8 + mt) * 64 + lane) * 4) = pack4(a0); } }
        { const int kk = wave >> 1;
#pragma unroll
          for (int q = 0; q < 2; ++q) { const int ct = 2 * (wave & 1) + q; f32x4 a0 = {0.f, 0.f, 0.f, 0.f}, a1 = {0.f, 0.f, 0.f, 0.f};
#pragma unroll
              for (int ks = 0; ks < 2; ++ks) { const bf16x8 bfr = ldsfrag(lds + L_ATT, 16 * ct + r, TS, 64 * ks + 16 * g);
                  a0 = mfma16(ldsfrag(lds + L_WT, 16 * (2 * kk) + r, TS, 64 * ks + 16 * g), bfr, a0); a1 = mfma16(ldsfrag(lds + L_WT, 16 * (2 * kk + 1) + r, TS, 64 * ks + 16 * g), bfr, a1); }
              const int c = 16 * ct + r; const float eg = egs[c];
              const f32x4 q0 = unpack4(*(const LAS v2u*)(lds + L_QN + c * RS + (32 * kk + 4 * g) * 2)), q1 = unpack4(*(const LAS v2u*)(lds + L_QN + c * RS + (32 * kk + 16 + 4 * g) * 2));
              v4u o; o.x = pk2(q0[0] * eg - a0[0], q0[1] * eg - a0[1]); o.y = pk2(q0[2] * eg - a0[2], q0[3] * eg - a0[3]); o.z = pk2(q1[0] * eg - a1[0], q1[1] * eg - a1[1]); o.w = pk2(q1[2] * eg - a1[2], q1[3] * eg - a1[3]);
              *(GAS v4u*)(X.QP + u8 + ((size_t)(ct * 4 + kk) * 64 + lane) * 8) = o; } }
        { const int vt = wave; bf16x8 af[2];
#pragma unroll
          for (int ks = 0; ks < 2; ++ks) af[ks] = ldsfrag(lds + L_UT, 16 * vt + r, TS, 64 * ks + 16 * g);
#pragma unroll
          for (int ct = 0; ct < 4; ++ct) { f32x4 a0 = {0.f, 0.f, 0.f, 0.f};
#pragma unroll
              for (int ks = 0; ks < 2; ++ks) a0 = mfma16(af[ks], ldsfrag(lds + L_ATT, 16 * ct + r, TS, 64 * ks + 16 * g), a0);
              *(GAS v2u*)(X.OI + u8 + ((size_t)(vt * 4 + ct) * 64 + lane) * 4) = pack4(a0); } }
    }
    __syncthreads();
}

__device__ __forceinline__ void p3_hgrn_unit(LAS unsigned char* lds, const MixPtrs& X, int unit, int tid, int lane, int wave) {
    const int h = unit & 3, n = (unit >> 2) & 127, b = unit >> 9, r = lane & 15, g = lane >> 4;
    const size_t tok0 = (size_t)b * T + (size_t)n * 64;
#pragma unroll
    for (int i = 0; i < 4; ++i) { const int pair = (tid >> 4) + 32 * i, tz = pair >> 6, c = pair & 63, ch = tid & 15;
        const v4u q = *(const GAS v4u*)(X.projA + (tok0 + c) * PA + (tz ? 2560 : 1536) + h * 128 + ch * 8);
        *(LAS v4u*)(lds + (tz ? H_QR : H_FR) + c * RS + ch * 16) = q; }
    if (tid >= 256) { const int xq = tid - 256, v = xq & 127, hh = xq >> 7; const GAS unsigned short* src = (const GAS unsigned short*)X.projA + (tok0 + 32 * hh) * PA + 2048 + h * 128 + v;
#pragma unroll
        for (int q = 0; q < 4; ++q) { unsigned w[4];
#pragma unroll
            for (int e = 0; e < 4; ++e) { const unsigned lo = src[(size_t)(8 * q + 2 * e) * PA], hi = src[(size_t)(8 * q + 2 * e + 1) * PA]; w[e] = lo | (hi << 16); }
            v4u o; o.x = w[0]; o.y = w[1]; o.z = w[2]; o.w = w[3]; *(LAS v4u*)(lds + H_VT + v * TS + (32 * hh + 8 * q) * 2) = o; } }
    __syncthreads();
    {
        const int d = tid & 127, seg = tid >> 7; LAS float* segt = (LAS float*)(lds + H_AM + 9216);
        const float l0 = X.hg_lb[h * 128 + d], l1 = X.hg_lb[512 + h * 128 + d]; const float mx = fmaxf(l0, l1); const float e0 = __expf(l0 - mx), e1 = __expf(l1 - mx); const float lb = e0 / (e0 + e1);
        float lc[16], kq[16]; float run = 0.f;
#pragma unroll
        for (int ci = 0; ci < 16; ++ci) { const float sg = sigmoidf_(ldsbf(lds + H_FR, 16 * seg + ci, RS, d)); run += __logf(lb + (1.f - lb) * sg); lc[ci] = run; kq[ci] = (1.f - lb) * (1.f - sg); }
        segt[seg * 128 + d] = run;
        __syncthreads();
        const float t0 = segt[d], t1 = segt[128 + d], t2 = segt[256 + d], t3 = segt[384 + d];
        const float off = (seg > 0 ? t0 : 0.f) + (seg > 1 ? t1 : 0.f) + (seg > 2 ? t2 : 0.f), btot = (t0 + t1) + (t2 + t3);
        float kv[16];
#pragma unroll
        for (int ci = 0; ci < 16; ++ci) { const int c = 16 * seg + ci; const float bb = off + lc[ci];
            *(LAS unsigned short*)(lds + H_QE + c * RS + d * 2) = (unsigned short)f2bf(siluf_(ldsbf(lds + H_QR, c, RS, d)) * __expf(bb));
            *(LAS unsigned short*)(lds + H_KD + c * RS + d * 2) = (unsigned short)f2bf(kq[ci] * __expf(-bb));
            kv[ci] = kq[ci] * __expf(btot - bb); }
        if (seg == 0) X.AH[(size_t)unit * 128 + d] = __expf(btot);
#pragma unroll
        for (int q = 0; q < 2; ++q) { v4u o; o.x = pk2(kv[8 * q], kv[8 * q + 1]); o.y = pk2(kv[8 * q + 2], kv[8 * q + 3]); o.z = pk2(kv[8 * q + 4], kv[8 * q + 5]); o.w = pk2(kv[8 * q + 6], kv[8 * q + 7]);
            *(LAS v4u*)(lds + H_KTT + d * TS + (16 * seg + 8 * q) * 2) = o; }
    }
    __syncthreads();
    {
        const int mt = wave >> 1;
#pragma unroll
        for (int q = 0; q < 2; ++q) { const int ntc = 2 * (wave & 1) + q; f32x4 a0 = {0.f, 0.f, 0.f, 0.f};
#pragma unroll
            for (int ks = 0; ks < 4; ++ks) a0 = mfma16(ldsfrag(lds + H_QE, 16 * mt + r, RS, 64 * ks + 16 * g), ldsfrag(lds + H_KD, 16 * ntc + r, RS, 64 * ks + 16 * g), a0);
            const int j = 16 * ntc + r;
#pragma unroll
            for (int ii = 0; ii < 4; ++ii) { const int i = 16 * mt + 4 * g + ii; *(LAS unsigned short*)(lds + H_AM + i * TS + j * 2) = (unsigned short)f2bf((i >= j) ? a0[ii] : 0.f); } }
    }
    __syncthreads();
    {
        const size_t u16 = (size_t)unit * 16384, u8 = (size_t)unit * 8192;
        { const int mt = wave; bf16x8 af[2];
#pragma unroll
          for (int ks = 0; ks < 2; ++ks) af[ks] = ldsfrag(lds + H_KTT, 16 * mt + r, TS, 64 * ks + 16 * g);
#pragma unroll
          for (int nt = 0; nt < 8; ++nt) { f32x4 a0 = {0.f, 0.f, 0.f, 0.f};
#pragma unroll
              for (int ks = 0; ks < 2; ++ks) a0 = mfma16(af[ks], ldsfrag(lds + H_VT, 16 * nt + r, TS, 64 * ks + 16 * g), a0);
              *(GAS v2u*)(X.BH + u16 + ((size_t)(nt * 8 + mt) * 64 + lane) * 4) = pack4(a0); } }
        { const int vt = wave; bf16x8 af[2];
#pragma unroll
          for (int ks = 0; ks < 2; ++ks) af[ks] = ldsfrag(lds + H_VT, 16 * vt + r, TS, 64 * ks + 16 * g);
#pragma unroll
          for (int ct = 0; ct < 4; ++ct) { f32x4 a0 = {0.f, 0.f, 0.f, 0.f};
#pragma unroll
              for (int ks = 0; ks < 2; ++ks) a0 = mfma16(af[ks], ldsfrag(lds + H_AM, 16 * ct + r, TS, 64 * ks + 16 * g), a0);
              *(GAS v2u*)(X.OIH + u8 + ((size_t)(vt * 4 + ct) * 64 + lane) * 4) = pack4(a0); } }
#pragma unroll
        for (int q = 0; q < 2; ++q) { const int idx = wave * 2 + q, ct = idx >> 2, kk = idx & 3, c = 16 * ct + r;
            const v2u q0 = *(const LAS v2u*)(lds + H_QE + c * RS + (32 * kk + 4 * g) * 2), q1 = *(const LAS v2u*)(lds + H_QE + c * RS + (32 * kk + 16 + 4 * g) * 2);
            v4u o; o.x = q0.x; o.y = q0.y; o.z = q1.x; o.w = q1.y;
            *(GAS v4u*)(X.QE + u8 + ((size_t)(ct * 4 + kk) * 64 + lane) * 8) = o; }
    }
    __syncthreads();
}

__device__ __forceinline__ void p4_gdn_scan(LAS unsigned char* lds, const MixPtrs& X, int job, int lane, int wave) {
    const int s = job & 7, h = (job >> 3) & 3, b = job >> 5;
    const int unit0 = (b * 128) * 4 + h;
    if (wave >= 4) {
        const int lw = wave - 4;
        const char* src0 = (const char*)(X.PG + (size_t)unit0 * 16384) + lw * 8192 + lane * 16;
#define P4_ISSUE(n_) do { const char* s_ = src0 + (size_t)(n_) * (4 * 32768); _Pragma("unroll") for (int i_ = 0; i_ < 8; ++i_) \
        __builtin_amdgcn_global_load_lds((const unsigned*)(s_ + i_ * 1024), (LAS unsigned*)(lds + ((n_) & 3) * 32768 + lw * 8192 + i_ * 1024), 16, 0, 0); } while (0)
        P4_ISSUE(0); P4_ISSUE(1); P4_ISSUE(2);
#pragma unroll 1
        for (int n = 0; n < 128; ++n) {
            if (n + 2 < 128) asm volatile("s_waitcnt vmcnt(16)" ::: "memory"); else if (n + 1 < 128) asm volatile("s_waitcnt vmcnt(8)" ::: "memory"); else asm volatile("s_waitcnt vmcnt(0)" ::: "memory");
            __builtin_amdgcn_s_barrier();
            asm volatile("" ::: "memory");
            if (n + 3 < 128) P4_ISSUE(n + 3);
        }
#undef P4_ISSUE
    } else if (wave == 0) {
        f32x4 S[8]; bf16x8 sb[4];
#pragma unroll
        for (int mt = 0; mt < 8; ++mt) S[mt] = (f32x4){0.f, 0.f, 0.f, 0.f};
#pragma unroll
        for (int kk = 0; kk < 4; ++kk) { sb[kk] = (bf16x8){0, 0, 0, 0, 0, 0, 0, 0}; *(GAS bf16x8*)(X.SG + (size_t)unit0 * 16384 + ((size_t)(s * 4 + kk) * 64 + lane) * 8) = sb[kk]; }
        v2u bq[4][8]; float gl[4];
        const GAS v2u* bsrc = (const GAS v2u*)(X.BG + (size_t)unit0 * 16384 + ((size_t)(s * 8) * 64 + lane) * 4);
#pragma unroll
        for (int j = 0; j < 3; ++j) {
#pragma unroll
            for (int mt = 0; mt < 8; ++mt) bq[j][mt] = bsrc[(size_t)j * 16384 + mt * 64];
            gl[j] = X.GL[unit0 + 4 * j]; }
#pragma unroll 1
        for (int n0 = 0; n0 < 128; n0 += 4) {
#pragma unroll
            for (int j = 0; j < 4; ++j) {
                const int n = n0 + j, unit = unit0 + 4 * n;
                __builtin_amdgcn_s_barrier();
                asm volatile("" ::: "memory");
                if (n + 3 < 128) {
#pragma unroll
                    for (int mt = 0; mt < 8; ++mt) bq[(j + 3) & 3][mt] = bsrc[(size_t)(n + 3) * 16384 + mt * 64];
                    gl[(j + 3) & 3] = X.GL[unit + 12]; }
                const float e = __expf(gl[j]);
                f32x4 acc[8];
#pragma unroll
                for (int mt = 0; mt < 8; ++mt) acc[mt] = S[mt] * e + unpack4(bq[j][mt]);
                const LAS unsigned char* pb = lds + (n & 3) * 32768 + lane * 16;
#pragma unroll
                for (int kk = 0; kk < 4; ++kk)
#pragma unroll
                    for (int mt = 0; mt < 8; ++mt) acc[mt] = mfma16(*(const LAS bf16x8*)(pb + (mt * 4 + kk) * 1024), sb[kk], acc[mt]);
#pragma unroll
                for (int mt = 0; mt < 8; ++mt) S[mt] = acc[mt];
#pragma unroll
                for (int kk = 0; kk < 4; ++kk) { const v2u lo = pack4(S[2 * kk]), hi = pack4(S[2 * kk + 1]); v4u o; o.x = lo.x; o.y = lo.y; o.z = hi.x; o.w = hi.y; sb[kk] = __builtin_bit_cast(bf16x8, o);
                    if (n < 127) *(GAS v4u*)(X.SG + (size_t)(unit + 4) * 16384 + ((size_t)(s * 4 + kk) * 64 + lane) * 8) = o; }
            }
        }
    } else {
#pragma unroll 1
        for (int n = 0; n < 128; ++n) { __builtin_amdgcn_s_barrier(); asm volatile("" ::: "memory"); }
    }
}
__device__ __forceinline__ void p4_hgrn_scan(const MixPtrs& X, int task, int lane) {
    const int mt = task & 7, s = (task >> 3) & 7, h = (task >> 6) & 3, b = task >> 8, g = lane >> 4;
    const int unit0 = (b * 128) * 4 + h;
    f32x4 s0 = {0.f, 0.f, 0.f, 0.f};
    const GAS f32x4* ap = (const GAS f32x4*)(X.AH + (size_t)unit0 * 128 + 16 * mt + 4 * g);
    const GAS v2u* bp = (const GAS v2u*)(X.BH + (size_t)unit0 * 16384 + ((size_t)(s * 8 + mt) * 64 + lane) * 4);
    GAS v2u* sp = (GAS v2u*)(X.SH + (size_t)unit0 * 16384 + ((size_t)(s * 4 + (mt >> 1)) * 64 + lane) * 8 + 4 * (mt & 1));
    { v2u z; z.x = 0; z.y = 0; sp[0] = z; }
    f32x4 ra[8]; v2u rb[8];
#pragma unroll
    for (int j = 0; j < 8; ++j) { ra[j] = ap[(size_t)j * 128]; rb[j] = bp[(size_t)j * 16384]; }
#pragma unroll 1
    for (int n0 = 0; n0 < 128; n0 += 8) {
#pragma unroll
        for (int j = 0; j < 8; ++j) { const int n = n0 + j;
            s0 = ra[j] * s0 + unpack4(rb[j]);
            if (n + 8 < 128) { ra[j] = ap[(size_t)(n + 8) * 128]; rb[j] = bp[(size_t)(n + 8) * 16384]; }
            if (n < 127) sp[(size_t)(n + 1) * 16384] = pack4(s0); }
    }
}
__device__ __forceinline__ void p5_unit(LAS unsigned char* lds, const MixPtrs& X, int bn, int lane, int wave) {
    const int hd = wave & 3, type = wave >> 2, r = lane & 15, g = lane >> 4;
    const int unit = bn * 4 + hd; const size_t tok0 = (size_t)bn * 64;
    const bf16* SX = type ? X.SH : X.SG; const bf16* QX = type ? X.QE : X.QP; const bf16* OX = type ? X.OIH : X.OI;
    const size_t u16 = (size_t)unit * 16384, u8 = (size_t)unit * 8192;
    LAS float* exch = (LAS float*)lds;
    const float* nw = type ? X.hg_nw + hd * 128 : X.gdn_nw;
#pragma unroll 1
    for (int cp = 0; cp < 2; ++cp) {
        f32x4 acc[8][2]; v2u gtq[8][2];
#pragma unroll
        for (int vt = 0; vt < 8; ++vt)
#pragma unroll
            for (int cc = 0; cc < 2; ++cc) { acc[vt][cc] = unpack4(*(const GAS v2u*)(OX + u8 + ((size_t)(vt * 4 + 2 * cp + cc) * 64 + lane) * 4));
                gtq[vt][cc] = *(const GAS v2u*)(X.gates + (tok0 + 16 * (2 * cp + cc) + r) * 1024 + type * 512 + hd * 128 + 16 * vt + 4 * g); }
#pragma unroll
        for (int kk = 0; kk < 4; ++kk) {
            bf16x8 af[8], bfr[2];
#pragma unroll
            for (int vt = 0; vt < 8; ++vt) af[vt] = *(const GAS bf16x8*)(SX + u16 + ((size_t)(vt * 4 + kk) * 64 + lane) * 8);
#pragma unroll
            for (int cc = 0; cc < 2; ++cc) bfr[cc] = *(const GAS bf16x8*)(QX + u8 + ((size_t)((2 * cp + cc) * 4 + kk) * 64 + lane) * 8);
#pragma unroll
            for (int vt = 0; vt < 8; ++vt)
#pragma unroll
                for (int cc = 0; cc < 2; ++cc) acc[vt][cc] = mfma16(af[vt], bfr[cc], acc[vt][cc]);
        }
        float ssq[2];
#pragma unroll
        for (int cc = 0; cc < 2; ++cc) { float s = 0.f;
#pragma unroll
            for (int vt = 0; vt < 8; ++vt) s += (acc[vt][cc][0] * acc[vt][cc][0] + acc[vt][cc][1] * acc[vt][cc][1]) + (acc[vt][cc][2] * acc[vt][cc][2] + acc[vt][cc][3] * acc[vt][cc][3]);
            s += __shfl_xor(s, 16); s += __shfl_xor(s, 32); ssq[cc] = s; }
        if (type == 1 && g == 0) {
#pragma unroll
            for (int cc = 0; cc < 2; ++cc) exch[hd * 32 + 16 * cc + r] = ssq[cc]; }
        __syncthreads();
        float rstd[2];
#pragma unroll
        for (int cc = 0; cc < 2; ++cc) { if (type == 1) { const int c = 16 * cc + r; rstd[cc] = rsqrtf(((exch[c] + exch[32 + c]) + (exch[64 + c] + exch[96 + c])) * (1.f / 512.f) + 1e-6f); } else rstd[cc] = rsqrtf(ssq[cc] * (1.f / 128.f) + 1e-6f); }
#pragma unroll
        for (int vt = 0; vt < 8; ++vt) { const f32x4 w4 = *(const GAS f32x4*)(nw + 16 * vt + 4 * g);
#pragma unroll
            for (int cc = 0; cc < 2; ++cc) { const size_t off = (tok0 + 16 * (2 * cp + cc) + r) * 1024 + type * 512 + hd * 128 + 16 * vt + 4 * g;
                const f32x4 gt = unpack4(gtq[vt][cc]); f32x4 o;
#pragma unroll
                for (int e = 0; e < 4; ++e) o[e] = acc[vt][cc][e] * rstd[cc] * w4[e] * siluf_(gt[e]);
                *(GAS v2u*)(X.omix + off) = pack4(o); } }
        __syncthreads();
    }
}

struct Args { const float* in[23]; float* out; unsigned char* ws; int ph_lo, ph_hi, li, pad; };

__global__ void __launch_bounds__(NWAVES * 64, 2) mk_fwd(Args args) {
    extern __shared__ __attribute__((aligned(16))) unsigned char lds_raw[];
    LAS unsigned char* lds = (LAS unsigned char*)lds_raw;
    volatile LAS unsigned* MISC = (volatile LAS unsigned*)(lds + MISC_OFF);
    const int tid = threadIdx.x, lane = tid & 63, wave = __builtin_amdgcn_readfirstlane(tid >> 6);
    const int G = gridDim.x, bx = blockIdx.x, vcu = (G % 8 == 0) ? (bx % 8) * (G / 8) + bx / 8 : bx;
    const int gw = vcu * NWAVES + wave, NGW = G * NWAVES;
    unsigned char* ws = args.ws;
    gu32* ctl = (gu32*)(ws + WS_CTL);
    const float* x = args.in[0]; const float* cvec = args.in[1]; const float* w_ada = args.in[2]; const float* b_ada = args.in[3]; const float* norm1_w = args.in[4];
    const float* w_in = args.in[5]; const float* w_out = args.in[12];
    float* mod = (float*)(ws + WS_MOD); float* wab = (float*)(ws + WS_WAB); float* ab = (float*)(ws + WS_AB);
    bf16* wout_t = (bf16*)(ws + WS_WOUT_T); bf16* win_t = (bf16*)(ws + WS_WIN_T); bf16* h1 = (bf16*)(ws + WS_H1); bf16* projA = (bf16*)(ws + WS_PROJA); bf16* gates = (bf16*)(ws + WS_GATES);
    bf16* omix = (bf16*)(ws + WS_OMIX);
    bf16* h2 = (bf16*)(ws + WS_H2); bf16* w1t = (bf16*)(ws + WS_W1T); bf16* w2t = (bf16*)(ws + WS_W2T); bf16* act = (bf16*)(ws + WS_ACT); bf16* y0 = (bf16*)(ws + WS_Y0); bf16* y1 = (bf16*)(ws + WS_Y1);
    MixPtrs X; X.projA = projA; X.gates = gates; X.ab = ab; X.conv_w = args.in[6]; X.a_log = args.in[7]; X.dt_bias = args.in[8]; X.hg_lb = args.in[10]; X.gdn_nw = args.in[9]; X.hg_nw = args.in[11];
    X.PG = (bf16*)(ws + WS_PG); X.BG = (bf16*)(ws + WS_BG); X.QP = (bf16*)(ws + WS_QP); X.OI = (bf16*)(ws + WS_OI); X.BH = (bf16*)(ws + WS_BH); X.QE = (bf16*)(ws + WS_QE); X.OIH = (bf16*)(ws + WS_OIH);
    X.SG = (bf16*)args.out; X.SH = (bf16*)args.out + (size_t)UNITS * 16384; X.omix = omix; X.GL = (float*)(ws + WS_GL); X.AH = (float*)(ws + WS_AH);
    const int* list = (const int*)(ws + WS_LIST); const float* listw = (const float*)(ws + WS_LISTW);
    LAS unsigned* tb = (LAS unsigned*)(lds + SCR2_OFF);

    for (int u = tid; u < (LDS_BYTES - LDSCTL_OFF) / 4; u += NWAVES * 64) ((LAS unsigned*)(lds + LDSCTL_OFF))[u] = 0u;
    __syncthreads();
    XcdBarrier bar = xcd_barrier_post((unsigned*)(ctl + CW_BAR) + args.li * XCD_BAR_WORDS, MISC + 8);
    const int lo = args.ph_lo, hi = args.ph_hi;
#define IN(k) (lo <= (k) && (k) < hi)
#define BOTH(k) (IN(k) && IN((k) + 1))

    if (IN(0)) {
#define PH_BODY do { \
        if (bx < 96) { \
            LAS float* part = (LAS float*)(lds + RING_BYTES); \
            const int e = bx * 64 + lane; float a0 = 0.f, a1 = 0.f; \
_Pragma("unroll 32") \
            for (int d = wave * 128; d < wave * 128 + 128; ++d) { const float w = w_ada[(size_t)d * 6144 + e]; a0 += siluf_(cvec[d]) * w; a1 += siluf_(cvec[D + d]) * w; } \
            part[(wave * 2 + 0) * 64 + lane] = a0; part[(wave * 2 + 1) * 64 + lane] = a1; \
            __syncthreads(); \
            if (tid < 128) { const int bb = tid >> 6, l = tid & 63; float s = 0.f; \
_Pragma("unroll") \
                for (int w = 0; w < 8; ++w) s += part[(w * 2 + bb) * 64 + l]; \
                mod[bb * 6144 + bx * 64 + l] = s + b_ada[bx * 64 + l]; } \
        } else if (bx == 96) { \
            for (int idx = tid; idx < 8192; idx += NWAVES * 64) wab[idx] = w_in[(size_t)(idx >> 3) * DIN + 2048 + (idx & 7)]; \
        } else if (bx == 97) { \
            const float* w_router = args.in[14]; bf16* wrhi = (bf16*)(ws + WS_WRHI); bf16* wrlo = (bf16*)(ws + WS_WRLO); \
            for (int idx = tid; idx < 65536; idx += NWAVES * 64) { const int e = idx >> 10, k = idx & 1023; const float w = w_router[k * 64 + e]; const unsigned hi = f2bf(w); \
                wrhi[idx] = (bf16)hi; wrlo[idx] = (bf16)f2bf(w - __uint_as_float(hi << 16)); } \
        } \
        LAS float* scr = (LAS float*)(lds + wave * 16384); \
        constexpr int I_IN = 16 * 128, I_OUT = 16 * 32; \
        auto mk0 = [&](int it) { TrItem t; if (it < I_IN) { const int kb = it / 128, n0 = 32 * (it % 128); const int sc_ = n0 < 1536 ? n0 : (n0 < 3072 ? n0 + 520 : (n0 < 3584 ? n0 - 1536 : n0 + 8)); \
                t.W = w_in; t.ldw = DIN; t.src_col = sc_; t.WT = win_t; t.K = D; t.dst_row = n0; t.k0 = 64 * kb; } \
            else { const int r = it - I_IN, kb = r / 32, n0 = 32 * (r % 32); t.W = w_out; t.ldw = D; t.src_col = n0; t.WT = wout_t; t.K = D; t.dst_row = n0; t.k0 = 64 * kb; } return t; }; \
        TR_LOOP(gw, NGW, I_IN + I_OUT, mk0); \
        if (BOTH(0)) xcd_barrier(bar); \
    } while (0)
        PH_BODY; if (REPN(0) > 1) { PH_BODY; PH_BODY; }
#undef PH_BODY
    }
    if (IN(1)) {
#define PH_BODY do { \
        { \
            const GAS f32x4* wab4 = (const GAS f32x4*)wab; \
            for (int idx = tid; idx < 2048; idx += NWAVES * 64) { const int d = idx >> 1, qh = idx & 1; *(LAS f32x4*)(lds + (((qh * 4 + (d & 3)) * 256 + (d >> 2)) * 16)) = wab4[idx]; } \
            __syncthreads(); \
            const int nrows = (M - gw + NGW - 1) / NGW; \
            f32x4 vn[2][4]; \
_Pragma("unroll") \
            for (int q = 0; q < 2; ++q) { const int m = gw + q * NGW; \
_Pragma("unroll") \
                for (int j = 0; j < 4; ++j) vn[q][j] = (q < nrows) ? ((const GAS f32x4*)(x + (size_t)m * D) + lane)[64 * j] : (f32x4){0.f, 0.f, 0.f, 0.f}; } \
_Pragma("unroll 1") \
            for (int p = 0; p < nrows; p += 2) { \
                f32x4 v[2][4]; \
_Pragma("unroll") \
                for (int q = 0; q < 2; ++q) \
_Pragma("unroll") \
                    for (int j = 0; j < 4; ++j) v[q][j] = vn[q][j]; \
_Pragma("unroll") \
                for (int q = 0; q < 2; ++q) { const int m = gw + (p + 2 + q) * NGW; \
                    if (p + 2 + q < nrows) { \
_Pragma("unroll") \
                        for (int j = 0; j < 4; ++j) vn[q][j] = ((const GAS f32x4*)(x + (size_t)m * D) + lane)[64 * j]; } } \
_Pragma("unroll") \
                for (int q = 0; q < 2; ++q) { const int m = gw + (p + q) * NGW; \
                    if (p + q < nrows) { \
                        float ss = 0.f; \
_Pragma("unroll") \
                        for (int j = 0; j < 4; ++j) ss += (v[q][j].x * v[q][j].x + v[q][j].y * v[q][j].y) + (v[q][j].z * v[q][j].z + v[q][j].w * v[q][j].w); \
                        const float rstd = rsqrtf(wave_sum(ss) * (1.f / D) + 1e-6f); \
                        const GAS f32x4* nw4 = (const GAS f32x4*)norm1_w + lane; const GAS f32x4* sh4 = (const GAS f32x4*)(mod + (m >= T ? 6144 : 0)) + lane; const GAS f32x4* sc4 = sh4 + 256; \
                        GAS unsigned long long* o8 = (GAS unsigned long long*)(h1 + (size_t)m * D) + lane; \
                        f32x4 a0 = {0.f, 0.f, 0.f, 0.f}, a1 = {0.f, 0.f, 0.f, 0.f}; \
_Pragma("unroll") \
                        for (int j = 0; j < 4; ++j) { const f32x4 h = v[q][j] * rstd * nw4[64 * j] * (sc4[64 * j] + 1.0f) + sh4[64 * j]; \
                            o8[64 * j] = (unsigned long long)pk2(h.x, h.y) | ((unsigned long long)pk2(h.z, h.w) << 32); \
_Pragma("unroll") \
                            for (int i = 0; i < 4; ++i) { a0 += *(const LAS f32x4*)(lds + ((i * 256 + lane + 64 * j) * 16)) * h[i]; a1 += *(const LAS f32x4*)(lds + (((4 + i) * 256 + lane + 64 * j) * 16)) * h[i]; } } \
 \
                        const bool up5 = (lane & 32) != 0, up4 = (lane & 16) != 0, up3 = (lane & 8) != 0; \
                        f32x4 k4; \
_Pragma("unroll") \
                        for (int e = 0; e < 4; ++e) { const float snd = up5 ? a0[e] : a1[e]; k4[e] = (up5 ? a1[e] : a0[e]) + __shfl_xor(snd, 32); } \
                        float k2[2]; \
_Pragma("unroll") \
                        for (int e = 0; e < 2; ++e) { const float snd = up4 ? k4[e] : k4[2 + e]; k2[e] = (up4 ? k4[2 + e] : k4[e]) + __shfl_xor(snd, 16); } \
                        float k1; { const float snd = up3 ? k2[0] : k2[1]; k1 = (up3 ? k2[1] : k2[0]) + __shfl_xor(snd, 8); } \
                        k1 += __shfl_xor(k1, 4); k1 += __shfl_xor(k1, 2); k1 += __shfl_xor(k1, 1); \
                        if ((lane & 7) == 0) ab[(size_t)m * 8 + 4 * (lane >> 5) + 2 * ((lane >> 4) & 1) + ((lane >> 3) & 1)] = k1; \
                    } } \
            } \
            __syncthreads(); \
        } \
        if (BOTH(1)) xcd_barrier(bar); \
    } while (0)
        PH_BODY; if (REPN(1) > 1) { PH_BODY; PH_BODY; }
#undef PH_BODY
    }
    if (IN(2)) {
#define PH_BODY do { \
        pg8::Gemm g{h1, win_t, M, 4096, D}; pg8::StaticOrder S; S.init(M, 4096, G, (int)blockIdx.x); \
        pg8::EpiProj E{projA, gates}; \
        pg8::gemm_phase<pg8::EpiProj, pg8::StaticOrder, true, true>(lds, g, S, E); \
        if (BOTH(2)) xcd_barrier(bar); \
    } while (0)
        PH_BODY; if (REPN(2) > 1) { PH_BODY; PH_BODY; }
#undef PH_BODY
    }

    if (IN(3)) {
#define PH_BODY do { \
        for (int u = vcu; u < UNITS; u += G) p3_gdn_unit(lds, X, u, tid, lane, wave); \
        for (int u = vcu; u < UNITS; u += G) p3_hgrn_unit(lds, X, u, tid, lane, wave); \
        if (BOTH(3)) xcd_barrier(bar); \
    } while (0)
        PH_BODY; if (REPN(3) > 1) { PH_BODY; PH_BODY; }
#undef PH_BODY
    }
    if (IN(4)) {
#define PH_BODY do { \
        if (bx < 64) p4_gdn_scan(lds, X, bx, lane, wave); \
        else { \
            if (wave < 3 && (bx - 64) * 3 + wave < 512) p4_hgrn_scan(X, (bx - 64) * 3 + wave, lane); \
            LAS float* scr = (LAS float*)(lds + wave * 16384); \
            const float* w_gate = args.in[16]; const float* w_up = args.in[17]; const float* w_down = args.in[18]; const float* ws_gate = args.in[19]; const float* ws_up = args.in[20]; const float* ws_down = args.in[21]; \
            auto mk4 = [&](int it) { TrItem t; const int e = it / 384, r = it % 384; \
                if (r < 256) { const int up = r >> 7, q = r & 127, kb = q >> 3, n0 = 32 * (q & 7); \
                    t.W = e < NE ? (up ? w_up : w_gate) + (size_t)e * D * DE : (up ? ws_up : ws_gate); t.ldw = DE; t.src_col = n0; t.WT = w1t + (size_t)e * 512 * 1024; t.K = D; t.dst_row = (n0 >> 7) * 256 + up * 128 + (n0 & 127); t.k0 = 64 * kb; } \
                else { const int q = r - 256, kb = q >> 5, n0 = 32 * (q & 31); \
                    t.W = e < NE ? w_down + (size_t)e * DE * D : ws_down; t.ldw = D; t.src_col = n0; t.WT = w2t + (size_t)e * 1024 * 256; t.K = DE; t.dst_row = n0; t.k0 = 64 * kb; } return t; }; \
            TR_LOOP((bx - 64) * NWAVES + wave, (G - 64) * NWAVES, NEX * 384, mk4); \
        } \
        if (BOTH(4)) xcd_barrier(bar); \
    } while (0)
        PH_BODY; if (REPN(4) > 1) { PH_BODY; PH_BODY; }
#undef PH_BODY
    }
    if (IN(5)) {
#define PH_BODY do { \
        for (int bn = vcu; bn < BATCH * 128; bn += G) p5_unit(lds, X, bn, lane, wave); \
        if (BOTH(5)) xcd_barrier(bar); \
    } while (0)
        PH_BODY; if (REPN(5) > 1) { PH_BODY; PH_BODY; }
#undef PH_BODY
    }
    if (IN(6)) {
#define PH_BODY do { \
        pg8::Gemm g{omix, wout_t, M, D, D}; pg8::StaticOrder S; S.init(M, D, G, (int)blockIdx.x); \
        pg8::EpiResid E{x, mod, args.out}; \
        pg8::gemm_phase<pg8::EpiResid, pg8::StaticOrder, true, true>(lds, g, S, E); \
        if (BOTH(6)) xcd_barrier(bar); \
    } while (0)
        PH_BODY; if (REPN(6) > 1) { PH_BODY; PH_BODY; }
#undef PH_BODY
    }


    if (IN(7)) {
        constexpr int HS = 2064;
        constexpr int R_HI = 0, R_LO = 33024, R_PART = 66048, R_SC = 98816, R_SEL = 102912, R_CNT = 107008, R_BASE = 107520, R_ESE = 108032, R_ESL = 110080, R_EW = 112128, R_ELP = 114176;
        if (tid < 128) *(LAS unsigned*)(lds + R_CNT + tid * 4) = 0u;
        __syncthreads();
        int nu = 0;
        const float* norm2_w = args.in[13]; const float* rbias = args.in[15]; const bf16* wrhi = (const bf16*)(ws + WS_WRHI); const bf16* wrlo = (const bf16*)(ws + WS_WRLO);
        int* listo = (int*)(ws + WS_LIST); float* listwo = (float*)(ws + WS_LISTW);
        const int r = lane & 15, g = lane >> 4;
#pragma unroll 1
        for (int u = vcu; u < M / 16; u += G, ++nu) {
#pragma unroll 1
            for (int q = 0; q < 2; ++q) { const int rl = 2 * wave + q, m = 16 * u + rl;
                const GAS f32x4* xr = (const GAS f32x4*)(args.out + (size_t)m * D) + lane;
                f32x4 v[4]; float ss = 0.f;
#pragma unroll
                for (int j = 0; j < 4; ++j) { v[j] = xr[64 * j]; ss += (v[j].x * v[j].x + v[j].y * v[j].y) + (v[j].z * v[j].z + v[j].w * v[j].w); }
                const float rstd = rsqrtf(wave_sum(ss) * (1.f / D) + 1e-6f);
                const GAS f32x4* nw4 = (const GAS f32x4*)norm2_w + lane; const GAS f32x4* sh4 = (const GAS f32x4*)(mod + (m >= T ? 6144 : 0) + 3072) + lane; const GAS f32x4* sc4 = sh4 + 256;
                GAS unsigned long long* o8 = (GAS unsigned long long*)(h2 + (size_t)m * D) + lane;
#pragma unroll
                for (int j = 0; j < 4; ++j) { const f32x4 hv = v[j] * rstd * nw4[64 * j] * (sc4[64 * j] + 1.0f) + sh4[64 * j];
                    const unsigned h0 = f2bf(hv.x), h1_ = f2bf(hv.y), h2_ = f2bf(hv.z), h3 = f2bf(hv.w);
                    const unsigned long long hi = (unsigned long long)(h0 | (h1_ << 16)) | ((unsigned long long)(h2_ | (h3 << 16)) << 32);
                    o8[64 * j] = hi;
                    const unsigned long long lo = (unsigned long long)pk2(hv.x - __uint_as_float(h0 << 16), hv.y - __uint_as_float(h1_ << 16)) | ((unsigned long long)pk2(hv.z - __uint_as_float(h2_ << 16), hv.w - __uint_as_float(h3 << 16)) << 32);
                    *(LAS unsigned long long*)(lds + R_HI + rl * HS + (lane + 64 * j) * 8) = hi; *(LAS unsigned long long*)(lds + R_LO + rl * HS + (lane + 64 * j) * 8) = lo; } }
            __syncthreads();
            { f32x4 acc[4];
#pragma unroll
              for (int nt = 0; nt < 4; ++nt) acc[nt] = (f32x4){0.f, 0.f, 0.f, 0.f};
#pragma unroll
              for (int ks = 0; ks < 4; ++ks) { const int kb = (128 * wave + 32 * ks + 8 * g) * 2;
                  const bf16x8 ahi = *(const LAS bf16x8*)(lds + R_HI + r * HS + kb), alo = *(const LAS bf16x8*)(lds + R_LO + r * HS + kb);
#pragma unroll
                  for (int nt = 0; nt < 4; ++nt) { const size_t o = (size_t)(16 * nt + r) * 1024 + 128 * wave + 32 * ks + 8 * g; const bf16x8 bh = *(const GAS bf16x8*)(wrhi + o), bl = *(const GAS bf16x8*)(wrlo + o);
                      acc[nt] = mfma16(ahi, bh, acc[nt]); acc[nt] = mfma16(ahi, bl, acc[nt]); acc[nt] = mfma16(alo, bh, acc[nt]); } }
#pragma unroll
              for (int nt = 0; nt < 4; ++nt)
#pragma unroll
                  for (int ii = 0; ii < 4; ++ii) *(LAS float*)(lds + R_PART + ((wave * 16 + 4 * g + ii) * 64 + 16 * nt + r) * 4) = acc[nt][ii]; }
            __syncthreads();
#pragma unroll
            for (int q = 0; q < 2; ++q) { const int idx = tid + 512 * q; float s = 0.f;
#pragma unroll
                for (int w = 0; w < 8; ++w) s += *(const LAS float*)(lds + R_PART + (w * 1024 + idx) * 4);
                const float sc = sigmoidf_(s); *(LAS float*)(lds + R_SC + idx * 4) = sc; *(LAS float*)(lds + R_SEL + idx * 4) = sc + rbias[idx & 63]; }
            __syncthreads();
#pragma unroll 1
            for (int q = 0; q < 2; ++q) { const int rl = 2 * wave + q, m = 16 * u + rl;
                const float sel = *(const LAS float*)(lds + R_SEL + (rl * 64 + lane) * 4), score = *(const LAS float*)(lds + R_SC + (rl * 64 + lane) * 4);
                float m1 = sel; m1 = fmaxf(m1, __shfl_xor(m1, 1)); m1 = fmaxf(m1, __shfl_xor(m1, 2)); m1 = fmaxf(m1, __shfl_xor(m1, 4));
                const unsigned long long eq = __ballot(sel == m1) & (0xFFull << (lane & 56)); const int first = __ffsll((long long)eq) - 1;
                float m2 = (lane == first) ? -INFINITY : sel; m2 = fmaxf(m2, __shfl_xor(m2, 1)); m2 = fmaxf(m2, __shfl_xor(m2, 2)); m2 = fmaxf(m2, __shfl_xor(m2, 4));
                const float gs = m1 + m2; const int mygrp = lane >> 3; int grank = 0;
#pragma unroll
                for (int gg = 0; gg < 8; ++gg) { const float o = __shfl(gs, 8 * gg); grank += (o > gs || (o == gs && gg < mygrp)) ? 1 : 0; }
                const float msel = grank < 4 ? sel : -INFINITY; int erank = 0;
#pragma unroll
                for (int e2 = 0; e2 < 64; ++e2) { const float o = __shfl(msel, e2); erank += (o > msel || (o == msel && e2 < lane)) ? 1 : 0; }
                const bool chosen = grank < 4 && erank < 8;
                const float wsum = wave_sum(chosen ? score : 0.f);
                if (chosen && nu < 4) { const int se = (m >= T ? 64 : 0) + lane; const unsigned lp = __hip_atomic_fetch_add((LAS unsigned*)(lds + R_CNT + se * 4), 1u, __ATOMIC_RELAXED, __HIP_MEMORY_SCOPE_WORKGROUP);
                    const int ei = ((nu * 16 + rl) * 8 + erank) * 4;
                    *(LAS int*)(lds + R_ESE + ei) = se; *(LAS int*)(lds + R_ESL + ei) = m * 8 + erank; *(LAS float*)(lds + R_EW + ei) = score / wsum * 2.5f; *(LAS unsigned*)(lds + R_ELP + ei) = lp; } }
            __syncthreads();
            if (nu == 3 || u + G >= M / 16) {
                if (tid < 128) { const unsigned c = *(LAS unsigned*)(lds + R_CNT + tid * 4); *(LAS unsigned*)(lds + R_BASE + tid * 4) = c ? __hip_atomic_fetch_add(ctl + CW_CNT + 64 * tid, c, RLX_AGENT) : 0u; }
                __syncthreads();
                for (int idx = tid; idx < (nu + 1) * 128; idx += NWAVES * 64) { const int se = *(LAS int*)(lds + R_ESE + idx * 4); const unsigned pos = *(LAS unsigned*)(lds + R_BASE + se * 4) + *(LAS unsigned*)(lds + R_ELP + idx * 4);
                    if (pos < (unsigned)CAP) { listo[(size_t)se * CAP + pos] = *(LAS int*)(lds + R_ESL + idx * 4); listwo[(size_t)se * CAP + pos] = *(LAS float*)(lds + R_EW + idx * 4); } }
                __syncthreads();
                if (tid < 128) *(LAS unsigned*)(lds + R_CNT + tid * 4) = 0u;
                __syncthreads();
                nu = -1;
            }
        }
        if (BOTH(7)) xcd_barrier(bar);
    }
    if (lo <= 12 && hi > 8) {
        if (tid < 130) { const int hf = tid >= 65 ? 1 : 0, e = tid - 65 * hf; unsigned c = 8192u;
            if (e < 64) { c = __hip_atomic_load(ctl + CW_CNT + 64 * (hf * 64 + e), RLX_AGENT); c = c < (unsigned)CAP ? c : (unsigned)CAP; }
            tb[TB_CNT + tid] = c; }
        __syncthreads();
        if (tid == 0) { unsigned ro = 0; for (int s = 0; s < 130; ++s) { tb[TB_OFF + s] = ro; ro += tb[TB_CNT + s]; } }
        __syncthreads();
    }
#define MOE_PREFIX(lo_, hi_, NT_) do { __syncthreads(); if (tid == 0) { unsigned up = 0; for (int s = (lo_); s < (hi_); ++s) { tb[TB_PRE + s] = up; up += ((tb[TB_CNT + s] + 255u) >> 8) * (NT_); } tb[TB_PRE + (hi_)] = up; } __syncthreads(); } while (0)
    if (IN(8)) {
#define PH_BODY do { \
        MOE_PREFIX(0, 130, 2); \
        pg8::Moe1Prob P{D, pg8::MoeSched{tb, 0, 130, 2, G, (int)blockIdx.x}, h2, w1t, list}; \
        pg8::EpiMoe1 E{act, tb}; \
        pg8::gemm_phase_g<pg8::Moe1Prob, pg8::EpiMoe1>(lds, P, E); \
        if (BOTH(8)) xcd_barrier(bar); \
    } while (0)
        PH_BODY; if (REPN(8) > 1) { PH_BODY; PH_BODY; }
#undef PH_BODY
    }
#pragma unroll 1
    for (int hf = 0; hf < 2; ++hf) {
        if (IN(9 + 2 * hf)) for (int rep_ = 0; rep_ < REPN(9 + 2 * hf); ++rep_) {
            MOE_PREFIX(65 * hf, 65 * hf + 65, 4);
            pg8::Moe2Prob P{DE, pg8::MoeSched{tb, 65 * hf, 65 * hf + 65, 4, G, (int)blockIdx.x}, act, w2t, hf};
            pg8::EpiMoe2 E{y0, y1, args.out, mod, list, listw, tb, hf, rep_ == 0};
            pg8::gemm_phase_g<pg8::Moe2Prob, pg8::EpiMoe2>(lds, P, E);
            if (BOTH(9 + 2 * hf)) xcd_barrier(bar);
        }
        if (IN(10 + 2 * hf)) {
            const float* fw = args.in[22];
            const GAS f32x4* g24 = (const GAS f32x4*)(mod + hf * 6144 + 5120) + lane; const GAS f32x4* fw4 = (const GAS f32x4*)fw + lane;
#pragma unroll 1
            for (int i0 = gw; i0 < 8192; i0 += 2 * NGW) {
                unsigned long long yq[2][8][4]; f32x4 xv[2][4];
#pragma unroll
                for (int q = 0; q < 2; ++q) { const int tl = (i0 + q * NGW < 8192) ? i0 + q * NGW : i0;
                    const GAS f32x4* xr = (const GAS f32x4*)(args.out + (size_t)(hf * 8192 + tl) * D) + lane;
                    const GAS unsigned long long* yr = (const GAS unsigned long long*)(tl < 4096 ? y0 + (size_t)tl * 8 * D : y1 + (size_t)(tl - 4096) * 8 * D) + lane;
#pragma unroll
                    for (int j = 0; j < 4; ++j) { xv[q][j] = xr[64 * j];
#pragma unroll
                        for (int k = 0; k < 8; ++k) yq[q][k][j] = yr[k * 256 + 64 * j]; } }
#pragma unroll
                for (int q = 0; q < 2; ++q) { const int tl = i0 + q * NGW;
                    if (tl < 8192) {
                        GAS f32x4* xr = (GAS f32x4*)(args.out + (size_t)(hf * 8192 + tl) * D) + lane;
                        f32x4 v[4]; float ss = 0.f;
#pragma unroll
                        for (int j = 0; j < 4; ++j) { f32x4 s = {0.f, 0.f, 0.f, 0.f};
#pragma unroll
                            for (int k = 0; k < 8; ++k) { const unsigned long long qq = yq[q][k][j]; const unsigned a = (unsigned)qq, bb = (unsigned)(qq >> 32);
                                s.x += __uint_as_float(a << 16); s.y += __uint_as_float(a & 0xffff0000u); s.z += __uint_as_float(bb << 16); s.w += __uint_as_float(bb & 0xffff0000u); }
                            v[j] = xv[q][j] + g24[64 * j] * s; ss += (v[j].x * v[j].x + v[j].y * v[j].y) + (v[j].z * v[j].z + v[j].w * v[j].w); }
                        const float rstd = rsqrtf(wave_sum(ss) * (1.f / D) + 1e-6f);
#pragma unroll
                        for (int j = 0; j < 4; ++j) xr[64 * j] = v[j] * rstd * fw4[64 * j];
                    } }
            }
            if (BOTH(10 + 2 * hf)) xcd_barrier(bar);
        }
    }
#undef MOE_PREFIX
#undef IN
#undef BOTH
}

static void launch_mk(Args a, int lo, int hi, int li, int grid, hipStream_t stream) {
    a.ph_lo = lo; a.ph_hi = hi; a.li = li;
    hipLaunchKernelGGL(mk_fwd, dim3(grid), dim3(NWAVES * 64), LDS_BYTES, stream, a);
}
extern "C" void kernel_launch(void* const* d_in, const int* in_sizes, int n_in, void* d_out, int out_size, void* d_ws, size_t ws_size, hipStream_t stream) {
    static int grid = 0;
    if (grid == 0) {
        int dev = 0, cus = 0;
        if (hipGetDevice(&dev) != hipSuccess || hipDeviceGetAttribute(&cus, hipDeviceAttributeMultiprocessorCount, dev) != hipSuccess) { grid = -1; return; }
        if (hipFuncSetAttribute((const void*)mk_fwd, hipFuncAttributeMaxDynamicSharedMemorySize, LDS_BYTES) != hipSuccess) { grid = -1; return; }
        grid = cus;
    }
    if (grid < 0) return;
    unsigned char* ws = (unsigned char*)d_ws; float* out = (float*)d_out;
    (void)hipMemsetAsync(ws + WS_CTL, 0, CTL_ZERO_BYTES, stream);
    Args a{};
    for (int i = 0; i < 23; ++i) a.in[i] = (const float*)d_in[i];
    a.out = out; a.ws = ws;
    launch_mk(a, 0, 13, 0, grid, stream);
}
```

```cpp
#include <hip/hip_runtime.h>
#include <cstdio>
#include <cstdint>
namespace pg8 {
#define PG8_LAS __attribute__((address_space(3)))
typedef unsigned short bf16_t;
typedef short bf16x8 __attribute__((ext_vector_type(8)));
typedef float f32x4 __attribute__((ext_vector_type(4)));
typedef unsigned u32x4 __attribute__((ext_vector_type(4)));
constexpr int BM = 256, BK = 64, HALF = 128, HTB = HALF * BK * 2  , STAGE_BYTES = 8 * HTB, NXCD = 8, WGM = 8;

__host__ __device__ __forceinline__ int lds_byte(int r, int c) { const int st = (r >> 4) * 2 + (c >> 5), rr = r & 15, cc = c & 31, ob = rr * 64 + cc * 2; return st * 1024 + (ob ^ (((ob >> 9) & 1) << 5)); }
__host__ __device__ __forceinline__ void stage_rc(int b, int& R, int& C) { const int st = b / 1024, sb = b % 1024, swz = sb ^ (((sb >> 9) & 1) << 5); R = (st >> 1) * 16 + swz / 64; C = (st & 1) * 32 + (swz % 64) / 2; }
__host__ __device__ __forceinline__ int perm32(int rho) { const int n = rho >> 4, i = rho & 15; return 8 * (i >> 2) + 4 * n + (i & 3); }

struct Unit { int pm, pn; };
struct Gemm { const bf16_t* A; const bf16_t* Bt; int M, N, K; };

struct StaticOrder {
    int nM, nN, nwg, G, c;
    __host__ __device__ void init(int M, int N, int G_, int c_) { nM = M / BM; nN = N / BM; nwg = nM * nN; G = G_; c = c_; }
    __host__ __device__ bool next(int i, Unit& u) const {
        const long L = (long)i * G + c; if (L >= nwg) return false;
        int wgid = (int)L; { const int q = nwg / NXCD, r = nwg % NXCD, xcd = wgid % NXCD, off = wgid / NXCD; wgid = (xcd < r ? xcd * (q + 1) : r * (q + 1) + (xcd - r) * q) + off; }
        const int nig = WGM * nN, gid = wgid / nig, fm = gid * WGM, gsz = (nM - fm) < WGM ? (nM - fm) : WGM;
        u.pm = fm + ((wgid % nig) % gsz); u.pn = (wgid % nig) / gsz; return true;
    }
    __device__ __forceinline__ void a_ready(const Unit&) const {}
    __device__ __forceinline__ void done(const Unit&) const {}
};
__device__ __forceinline__ unsigned cvt_pk_bf16(float lo, float hi) { unsigned r; asm volatile("v_cvt_pk_bf16_f32 %0, %1, %2" : "=v"(r) : "v"(lo), "v"(hi)); return r; }
template <class Epi, class Sched, bool ALIGN_EPI = false, bool SP2 = false>
__device__ __forceinline__ void gemm_phase(PG8_LAS unsigned char* lds, const Gemm g, const Sched& S, const Epi& E) {
    const int tid = threadIdx.x, wid = __builtin_amdgcn_readfirstlane(tid >> 6), lane = tid & 63, wr = wid >> 2, wc = wid & 3, fr = lane & 15, fq = lane >> 4;
    const int K = g.K, nt = K / BK;
    unsigned voffA[2], voffB[2];
#pragma unroll
    for (int i = 0; i < 2; ++i) { int R, C; stage_rc(tid * 16 + i * 8192, R, C); const int Rb = Epi::PERM ? ((R & ~31) + perm32(R & 31)) : R;
        voffA[i] = (unsigned)(R * K + C) * 2u; voffB[i] = (unsigned)(Rb * K + C) * 2u; }
    const size_t kstep = (size_t)(BK * 2);
    const size_t hstep = (size_t)HALF * K * 2;
    const size_t tstep = 2 * hstep;
    const unsigned ldsw = (unsigned)wid * 1024u;
    const int aoff = lds_byte(wr * 64 + fr, fq * 8), boff = lds_byte(wc * 32 + fr, fq * 8);
#define PG8_SA(b, h) (((b) * 2 + (h)) * HTB)
#define PG8_SB(b, h) ((4 + (b) * 2 + (h)) * HTB)
#define PG8_STAGE(bufoff, gbase, voff) do { _Pragma("unroll") for (int _i = 0; _i < 2; ++_i) \
        __builtin_amdgcn_global_load_lds((const unsigned*)((const char*)(gbase) + (voff)[_i]), (PG8_LAS unsigned*)(lds + (bufoff) + ldsw + _i * 8192), 16, 0, 0); } while (0)
#define PG8_LDA(dst, b, h) do { _Pragma("unroll") for (int m = 0; m < 4; ++m) _Pragma("unroll") for (int k = 0; k < 2; ++k) dst[m][k] = *(const PG8_LAS bf16x8*)(lds + PG8_SA(b, h) + aoff + m * 2048 + k * 1024); } while (0)
#define PG8_LDB(dst, b, h) do { _Pragma("unroll") for (int n = 0; n < 2; ++n) _Pragma("unroll") for (int k = 0; k < 2; ++k) dst[n][k] = *(const PG8_LAS bf16x8*)(lds + PG8_SB(b, h) + boff + n * 2048 + k * 1024); } while (0)
#define PG8_MMA(ai, bj, At, Bt) do { __builtin_amdgcn_s_setprio(1); _Pragma("unroll") for (int m = 0; m < 4; ++m) _Pragma("unroll") for (int n = 0; n < 2; ++n) _Pragma("unroll") for (int k = 0; k < 2; ++k) \
        acc[ai][bj][m][n] = __builtin_amdgcn_mfma_f32_16x16x32_bf16(Bt[n][k], At[m][k], acc[ai][bj][m][n], 0, 0, 0); __builtin_amdgcn_s_setprio(0); } while (0)
#define PG8_WAIT_V(n) asm volatile("s_waitcnt vmcnt(" #n ")" ::: "memory")
#define PG8_WAIT_L(n) asm volatile("s_waitcnt lgkmcnt(" #n ")" ::: "memory")
#define PG8_BAR __builtin_amdgcn_s_barrier()
#define PG8_SCHED __builtin_amdgcn_sched_barrier(0)
    Unit cur, nxt; int ui = 0;
    if (!S.next(0, cur)) return;
    f32x4 acc[2][2][4][2];
#pragma unroll
    for (int a = 0; a < 2; ++a)
#pragma unroll
        for (int b = 0; b < 2; ++b)
#pragma unroll
            for (int m = 0; m < 4; ++m)
#pragma unroll
                for (int n = 0; n < 2; ++n) acc[a][b][m][n] = (f32x4){0.f, 0.f, 0.f, 0.f};
    bf16x8 At[4][2], B0[2][2], B1[2][2];
    const char* cA = (const char*)g.A + (size_t)cur.pm * tstep; const char* cB = (const char*)g.Bt + (size_t)cur.pn * tstep;
    S.a_ready(cur);
    if constexpr (SP2) {
        PG8_STAGE(PG8_SB(0, 0), cB, voffB); PG8_STAGE(PG8_SB(0, 1), cB + hstep, voffB); PG8_STAGE(PG8_SA(0, 0), cA, voffA); PG8_STAGE(PG8_SA(0, 1), cA + hstep, voffA);
        if (wr == 1) PG8_BAR;
        PG8_WAIT_V(2); PG8_BAR;
        PG8_STAGE(PG8_SB(1, 0), cB + kstep, voffB); PG8_STAGE(PG8_SA(1, 0), cA + kstep, voffA); PG8_STAGE(PG8_SB(1, 1), cB + hstep + kstep, voffB);
        PG8_WAIT_V(6); PG8_BAR;
    } else {
        PG8_STAGE(PG8_SB(0, 0), cB, voffB); PG8_STAGE(PG8_SA(0, 0), cA, voffA); PG8_STAGE(PG8_SB(0, 1), cB + hstep, voffB); PG8_STAGE(PG8_SA(0, 1), cA + hstep, voffA);
        if (wr == 1) PG8_BAR;
        PG8_WAIT_V(4); PG8_BAR;
        PG8_STAGE(PG8_SB(1, 0), cB + kstep, voffB); PG8_STAGE(PG8_SA(1, 0), cA + kstep, voffA); PG8_STAGE(PG8_SB(1, 1), cB + hstep + kstep, voffB);
        PG8_WAIT_V(6); PG8_BAR;
    }
    for (;;) {
        const bool has_next = S.next(ui + 1, nxt);
        const char* nA = has_next ? (const char*)g.A + (size_t)nxt.pm * tstep : cA; const char* nB = has_next ? (const char*)g.Bt + (size_t)nxt.pn * tstep : cB;
        for (int t = 0; t < nt; t += 2) {
            const bool last = (t == nt - 2);
            const char* a1 = cA + (size_t)(t + 1) * kstep;
            const char* a2 = last ? nA : cA + (size_t)(t + 2) * kstep; const char* b2 = last ? nB : cB + (size_t)(t + 2) * kstep;
            const char* a3 = a2 + kstep; const char* b3 = b2 + kstep;
            if (last && has_next) S.a_ready(nxt);
            if constexpr (SP2) {
            PG8_LDB(B0, 0, 0); PG8_LDB(B1, 0, 1); PG8_SCHED; PG8_LDA(At, 0, 0); PG8_STAGE(PG8_SA(1, 1), a1 + hstep, voffA);
            PG8_WAIT_V(8); PG8_WAIT_L(0); PG8_BAR; PG8_MMA(0, 0, At, B0); PG8_MMA(0, 1, At, B1); PG8_BAR; PG8_SCHED;
            PG8_LDA(At, 0, 1); PG8_STAGE(PG8_SB(0, 0), b2, voffB); PG8_STAGE(PG8_SB(0, 1), b2 + hstep, voffB); PG8_STAGE(PG8_SA(0, 0), a2, voffA);
            PG8_WAIT_V(8); PG8_WAIT_L(0); PG8_BAR; PG8_MMA(1, 0, At, B0); PG8_MMA(1, 1, At, B1); PG8_BAR; PG8_SCHED;
            PG8_LDB(B0, 1, 0); PG8_LDB(B1, 1, 1); PG8_SCHED; PG8_LDA(At, 1, 0); PG8_STAGE(PG8_SA(0, 1), a2 + hstep, voffA);
            PG8_WAIT_V(8); PG8_WAIT_L(0); PG8_BAR; PG8_MMA(0, 0, At, B0); PG8_MMA(0, 1, At, B1); PG8_BAR; PG8_SCHED;
            PG8_LDA(At, 1, 1); PG8_STAGE(PG8_SB(1, 0), b3, voffB); PG8_STAGE(PG8_SB(1, 1), b3 + hstep, voffB); PG8_STAGE(PG8_SA(1, 0), a3, voffA);
            PG8_WAIT_V(8); PG8_WAIT_L(0); PG8_BAR; PG8_MMA(1, 0, At, B0); PG8_MMA(1, 1, At, B1); PG8_BAR; PG8_SCHED;
            } else {
            PG8_LDB(B0, 0, 0); PG8_SCHED; PG8_LDA(At, 0, 0); PG8_STAGE(PG8_SA(1, 1), a1 + hstep, voffA);
            PG8_WAIT_L(8); PG8_BAR; PG8_WAIT_L(0); PG8_MMA(0, 0, At, B0); PG8_BAR; PG8_SCHED;
            PG8_LDB(B1, 0, 1); PG8_STAGE(PG8_SB(0, 0), b2, voffB);
            PG8_BAR; PG8_WAIT_L(0); PG8_MMA(0, 1, At, B1); PG8_BAR;
            PG8_LDA(At, 0, 1); PG8_STAGE(PG8_SA(0, 0), a2, voffA);
            PG8_BAR; PG8_WAIT_L(0); PG8_MMA(1, 0, At, B0); PG8_BAR; PG8_SCHED;
            PG8_STAGE(PG8_SB(0, 1), b2 + hstep, voffB);
            PG8_WAIT_V(6); PG8_BAR; PG8_MMA(1, 1, At, B1); PG8_BAR;
            PG8_LDB(B0, 1, 0); PG8_SCHED; PG8_LDA(At, 1, 0); PG8_STAGE(PG8_SA(0, 1), a2 + hstep, voffA);
            PG8_WAIT_L(8); PG8_BAR; PG8_WAIT_L(0); PG8_MMA(0, 0, At, B0); PG8_BAR; PG8_SCHED;
            PG8_LDB(B1, 1, 1); PG8_STAGE(PG8_SB(1, 0), b3, voffB);
            PG8_BAR; PG8_WAIT_L(0); PG8_MMA(0, 1, At, B1); PG8_BAR;
            PG8_LDA(At, 1, 1); PG8_STAGE(PG8_SA(1, 0), a3, voffA);
            PG8_BAR; PG8_WAIT_L(0); PG8_MMA(1, 0, At, B0); PG8_BAR; PG8_SCHED;
            PG8_STAGE(PG8_SB(1, 1), b3 + hstep, voffB);
            PG8_WAIT_V(6); PG8_BAR; PG8_MMA(1, 1, At, B1); PG8_BAR;
            }
        }
        if constexpr (ALIGN_EPI) { if (wr == 0) PG8_BAR; }
        if constexpr (!Epi::AFTER_DRAIN) { E(acc, cur, wr, wc, fr, fq); S.done(cur); }
        if (!has_next) break;
#pragma unroll
        for (int a = 0; a < 2; ++a)
#pragma unroll
            for (int b = 0; b < 2; ++b)
#pragma unroll
                for (int m = 0; m < 4; ++m)
#pragma unroll
                    for (int n = 0; n < 2; ++n) acc[a][b][m][n] = (f32x4){0.f, 0.f, 0.f, 0.f};
        cur = nxt; cA = nA; cB = nB; ++ui;
        if constexpr (ALIGN_EPI) { if (wr == 1) PG8_BAR; }
    }
    PG8_WAIT_V(0);
    if constexpr (!ALIGN_EPI) { if (wr == 0) PG8_BAR; }
    PG8_BAR;
    if constexpr (Epi::AFTER_DRAIN) { E.fused(acc, cur, wr, wc, fr, fq, lds, wid, lane); S.done(cur); }
#undef PG8_SA
#undef PG8_SB
#undef PG8_STAGE
#undef PG8_LDA
#undef PG8_LDB
#undef PG8_MMA
#undef PG8_WAIT_V
#undef PG8_WAIT_L
#undef PG8_BAR
#undef PG8_SCHED
}
}
#define GAS __attribute__((address_space(1)))
#define LAS __attribute__((address_space(3)))
typedef unsigned short bf16;
typedef unsigned v4u __attribute__((ext_vector_type(4)));
typedef float f32x4 __attribute__((ext_vector_type(4)));
typedef short bf16x8 __attribute__((ext_vector_type(8)));
typedef GAS unsigned gu32;
typedef GAS unsigned long long gu64;
#define RLX_AGENT __ATOMIC_RELAXED, __HIP_MEMORY_SCOPE_AGENT
#define LDS_WAIT() asm volatile("s_waitcnt lgkmcnt(0)" ::: "memory")
#define VM_WAIT() asm volatile("s_waitcnt vmcnt(0)" ::: "memory")
__device__ __forceinline__ unsigned long long rt() { return __builtin_amdgcn_s_memrealtime(); }
__device__ __forceinline__ unsigned f2bf(float f) { unsigned u = __builtin_bit_cast(unsigned, f); return (u + 0x7fffu + ((u >> 16) & 1u)) >> 16; }
__device__ __forceinline__ unsigned pk2(float lo, float hi) { return f2bf(lo) | (f2bf(hi) << 16); }
#define XB_TMO      128
#define XB_XCNT(j)  (256  + 64 * (j))
#define XB_XSUB(j)  (1280 + 64 * (j))
#define XB_XGEN(j)  (2304 + 64 * (j))
#define XB_TOP      3328
#define XB_TOPGEN   3392
#define XCD_BAR_WORDS 3456
#define XB_SPIN_CAP (1u << 18)

__device__ __forceinline__ unsigned xb_ld(unsigned* p)              { return __hip_atomic_load(p, __ATOMIC_RELAXED, __HIP_MEMORY_SCOPE_AGENT); }
__device__ __forceinline__ unsigned xb_add(unsigned* p, unsigned v) { return __hip_atomic_fetch_add(p, v, __ATOMIC_RELAXED, __HIP_MEMORY_SCOPE_AGENT); }
__device__ __forceinline__ unsigned xb_xcc_id() { return (unsigned)__builtin_amdgcn_s_getreg((3 << 11) | 20) & 0xFu; }
#define XB_SPIN(cond, bar) do { unsigned _sp = 0; while (cond) { __builtin_amdgcn_s_sleep(1); \
    if ((++_sp & 255u) == 0u) { if (xb_ld(&(bar)[XB_TMO])) break; if (_sp > XB_SPIN_CAP) { atomicAdd(&(bar)[XB_TMO], 1u); break; } } } } while (0)

struct XcdBarrier {
    unsigned* bar; unsigned x;
    volatile LAS unsigned* st;
};

__device__ __forceinline__ XcdBarrier xcd_barrier_post(unsigned* bar, volatile LAS unsigned* st) {
    XcdBarrier b; b.bar = bar; b.x = xb_xcc_id(); b.st = st;
    if (threadIdx.x == 0) (void)xb_add(&bar[XB_XCNT(b.x)], 1u);
    return b;
}
__device__ __forceinline__ void xcd_barrier_complete(unsigned* bar, unsigned x, unsigned& nloc, unsigned& nx) {
    const unsigned G = gridDim.x * gridDim.y * gridDim.z;
    unsigned sum, cnt, mine, sp = 0u;
    for (;;) {
        sum = 0u; cnt = 0u; mine = 0u;
#pragma unroll
        for (unsigned j = 0; j < 16; ++j) { const unsigned c = xb_ld(&bar[XB_XCNT(j)]); sum += c; cnt += (c > 0u) ? 1u : 0u; mine = (j == x) ? c : mine; }
        if (sum == G) break;
        __builtin_amdgcn_s_sleep(1);
        if ((++sp & 255u) == 0u) { if (xb_ld(&bar[XB_TMO])) break; if (sp > XB_SPIN_CAP) { atomicAdd(&bar[XB_TMO], 1u); break; } }
    }
    nloc = mine > 0u ? mine : 1u; nx = cnt > 0u ? cnt : 1u;
}

__device__ __forceinline__ void xcd_barrier(const XcdBarrier& b) {
    asm volatile("s_waitcnt vmcnt(0)" ::: "memory");
    __syncthreads();
    if (threadIdx.x == 0) {
        unsigned* bar = b.bar;
        __builtin_amdgcn_s_waitcnt(0);
        unsigned nloc = b.st[0], nx = b.st[1];
        if (nloc == 0u) { xcd_barrier_complete(bar, b.x, nloc, nx); b.st[0] = nloc; b.st[1] = nx; }
        const unsigned old = xb_add(&bar[XB_XSUB(b.x)], 1u);
        const unsigned gen = old / nloc;
        if (old + 1u == (gen + 1u) * nloc) {
            __builtin_amdgcn_fence(__ATOMIC_RELEASE, "agent");
            asm volatile("s_waitcnt vmcnt(0)" ::: "memory");
            const unsigned og = xb_add(&bar[XB_TOP], 1u);
            const unsigned tg = og / nx;
            if (og + 1u == (tg + 1u) * nx) xb_add(&bar[XB_TOPGEN], 1u);
            else XB_SPIN(xb_ld(&bar[XB_TOPGEN]) == tg, bar);
            __builtin_amdgcn_fence(__ATOMIC_ACQUIRE, "agent");
            xb_add(&bar[XB_XGEN(b.x)], 1u);
            asm volatile("s_waitcnt vmcnt(0)" ::: "memory");
        } else {
            XB_SPIN(xb_ld(&bar[XB_XGEN(b.x)]) == gen, bar);
            __builtin_amdgcn_fence(__ATOMIC_ACQUIRE, "agent");
            asm volatile("s_waitcnt vmcnt(0)" ::: "memory");
        }
    }
    __syncthreads();
}

namespace pg8 {
struct UnitG { int seg, mt, nt; };
template <class Prob, class Epi>
__device__ __forceinline__ void gemm_phase_g(PG8_LAS unsigned char* lds, const Prob& P, const Epi& E) {
    const int tid = threadIdx.x, wid = __builtin_amdgcn_readfirstlane(tid >> 6), lane = tid & 63, wr = wid >> 2, wc = wid & 3, fr = lane & 15, fq = lane >> 4;
    const int K = P.K, nt = K / BK;
    int sR[2], sC[2]; unsigned voffB[2];
#pragma unroll
    for (int i = 0; i < 2; ++i) { int R, C; stage_rc(tid * 16 + i * 8192, R, C); const int Rb = Epi::PERM ? ((R & ~31) + perm32(R & 31)) : R; sR[i] = R; sC[i] = C; voffB[i] = (unsigned)(Rb * K + C) * 2u; }
    const size_t kstep = (size_t)(BK * 2);
    const size_t hstep = (size_t)HALF * K * 2;
    const unsigned ldsw = (unsigned)wid * 1024u;
    const int aoff = lds_byte(wr * 64 + fr, fq * 8), boff = lds_byte(wc * 32 + fr, fq * 8);
#define PG8_SA(b, h) (((b) * 2 + (h)) * HTB)
#define PG8_SB(b, h) ((4 + (b) * 2 + (h)) * HTB)
#define PG8_STAGE(bufoff, gbase, voff) do { _Pragma("unroll") for (int _i = 0; _i < 2; ++_i) \
        __builtin_amdgcn_global_load_lds((const unsigned*)((const char*)(gbase) + (voff)[_i]), (PG8_LAS unsigned*)(lds + (bufoff) + ldsw + _i * 8192), 16, 0, 0); } while (0)
#define PG8_LDA(dst, b, h) do { _Pragma("unroll") for (int m = 0; m < 4; ++m) _Pragma("unroll") for (int k = 0; k < 2; ++k) dst[m][k] = *(const PG8_LAS bf16x8*)(lds + PG8_SA(b, h) + aoff + m * 2048 + k * 1024); } while (0)
#define PG8_LDB(dst, b, h) do { _Pragma("unroll") for (int n = 0; n < 2; ++n) _Pragma("unroll") for (int k = 0; k < 2; ++k) dst[n][k] = *(const PG8_LAS bf16x8*)(lds + PG8_SB(b, h) + boff + n * 2048 + k * 1024); } while (0)
#define PG8_MMA(ai, bj, At, Bt) do { __builtin_amdgcn_s_setprio(1); _Pragma("unroll") for (int m = 0; m < 4; ++m) _Pragma("unroll") for (int n = 0; n < 2; ++n) _Pragma("unroll") for (int k = 0; k < 2; ++k) \
        acc[ai][bj][m][n] = __builtin_amdgcn_mfma_f32_16x16x32_bf16(Bt[n][k], At[m][k], acc[ai][bj][m][n], 0, 0, 0); __builtin_amdgcn_s_setprio(0); } while (0)
#define PG8_WAIT_V(n) asm volatile("s_waitcnt vmcnt(" #n ")" ::: "memory")
#define PG8_WAIT_L(n) asm volatile("s_waitcnt lgkmcnt(" #n ")" ::: "memory")
#define PG8_BAR __builtin_amdgcn_s_barrier()
#define PG8_SCHED __builtin_amdgcn_sched_barrier(0)
    UnitG cur, nxt; int ui = 0;
    if (!P.next(0, cur)) return;
    f32x4 acc[2][2][4][2];
#pragma unroll
    for (int a = 0; a < 2; ++a)
#pragma unroll
        for (int b = 0; b < 2; ++b)
#pragma unroll
            for (int m = 0; m < 4; ++m)
#pragma unroll
                for (int n = 0; n < 2; ++n) acc[a][b][m][n] = (f32x4){0.f, 0.f, 0.f, 0.f};
    bf16x8 At[4][2], B0[2][2], B1[2][2];
    unsigned offA[2][2], offAn[2][2];
    const char* cA; const char* cB;
    P.setup(cur, sR, sC, cA, offA, cB);
    PG8_STAGE(PG8_SB(0, 0), cB, voffB); PG8_STAGE(PG8_SB(0, 1), cB + hstep, voffB); PG8_STAGE(PG8_SA(0, 0), cA, offA[0]); PG8_STAGE(PG8_SA(0, 1), cA, offA[1]);
    if (wr == 1) PG8_BAR;
    PG8_WAIT_V(2); PG8_BAR;
    PG8_STAGE(PG8_SB(1, 0), cB + kstep, voffB); PG8_STAGE(PG8_SA(1, 0), cA + kstep, offA[0]); PG8_STAGE(PG8_SB(1, 1), cB + hstep + kstep, voffB);
    PG8_WAIT_V(6); PG8_BAR;
    for (;;) {
        const bool has_next = P.next(ui + 1, nxt);
        const char* nA = cA; const char* nB = cB;
#pragma unroll
        for (int h = 0; h < 2; ++h)
#pragma unroll
            for (int i = 0; i < 2; ++i) offAn[h][i] = offA[h][i];
        if (has_next) P.setup(nxt, sR, sC, nA, offAn, nB);
        for (int t = 0; t < nt; t += 2) {
            const bool last = (t == nt - 2);
            const char* a1 = cA + (size_t)(t + 1) * kstep;
            const char* a2 = last ? nA : cA + (size_t)(t + 2) * kstep; const char* b2 = last ? nB : cB + (size_t)(t + 2) * kstep;
            const char* a3 = a2 + kstep; const char* b3 = b2 + kstep;
            unsigned o2[2][2];
#pragma unroll
            for (int h = 0; h < 2; ++h)
#pragma unroll
                for (int i = 0; i < 2; ++i) o2[h][i] = last ? offAn[h][i] : offA[h][i];
            PG8_LDB(B0, 0, 0); PG8_LDB(B1, 0, 1); PG8_SCHED; PG8_LDA(At, 0, 0); PG8_STAGE(PG8_SA(1, 1), a1, offA[1]);
            PG8_WAIT_V(8); PG8_WAIT_L(0); PG8_BAR; PG8_MMA(0, 0, At, B0); PG8_MMA(0, 1, At, B1); PG8_BAR; PG8_SCHED;
            PG8_LDA(At, 0, 1); PG8_STAGE(PG8_SB(0, 0), b2, voffB); PG8_STAGE(PG8_SB(0, 1), b2 + hstep, voffB); PG8_STAGE(PG8_SA(0, 0), a2, o2[0]);
            PG8_WAIT_V(8); PG8_WAIT_L(0); PG8_BAR; PG8_MMA(1, 0, At, B0); PG8_MMA(1, 1, At, B1); PG8_BAR; PG8_SCHED;
            PG8_LDB(B0, 1, 0); PG8_LDB(B1, 1, 1); PG8_SCHED; PG8_LDA(At, 1, 0); PG8_STAGE(PG8_SA(0, 1), a2, o2[1]);
            PG8_WAIT_V(8); PG8_WAIT_L(0); PG8_BAR; PG8_MMA(0, 0, At, B0); PG8_MMA(0, 1, At, B1); PG8_BAR; PG8_SCHED;
            PG8_LDA(At, 1, 1); PG8_STAGE(PG8_SB(1, 0), b3, voffB); PG8_STAGE(PG8_SB(1, 1), b3 + hstep, voffB); PG8_STAGE(PG8_SA(1, 0), a3, o2[0]);
            PG8_WAIT_V(8); PG8_WAIT_L(0); PG8_BAR; PG8_MMA(1, 0, At, B0); PG8_MMA(1, 1, At, B1); PG8_BAR; PG8_SCHED;
        }
        if (wr == 0) PG8_BAR;
        E(acc, cur, wr, wc, fr, fq);
        if (!has_next) break;
#pragma unroll
        for (int a = 0; a < 2; ++a)
#pragma unroll
            for (int b = 0; b < 2; ++b)
#pragma unroll
                for (int m = 0; m < 4; ++m)
#pragma unroll
                    for (int n = 0; n < 2; ++n) acc[a][b][m][n] = (f32x4){0.f, 0.f, 0.f, 0.f};
        cur = nxt; cA = nA; cB = nB; ++ui;
#pragma unroll
        for (int h = 0; h < 2; ++h)
#pragma unroll
            for (int i = 0; i < 2; ++i) offA[h][i] = offAn[h][i];
        if (wr == 1) PG8_BAR;
    }
    PG8_WAIT_V(0);
    PG8_BAR;
#undef PG8_SA
#undef PG8_SB
#undef PG8_STAGE
#undef PG8_LDA
#undef PG8_LDB
#undef PG8_MMA
#undef PG8_WAIT_V
#undef PG8_WAIT_L
#undef PG8_BAR
#undef PG8_SCHED
}
}

constexpr int NWAVES = 8;
constexpr int BATCH = 2, T = 8192, D = 1024, M = BATCH * T, DIN = 4104, PA = 3072;
constexpr int NE = 64, NEX = 65, DE = 256;
constexpr size_t MiB = 1u << 20;
constexpr size_t WS_CTL = 0, CTL_ZERO_BYTES = 256 * 1024;
constexpr size_t WS_WRHI = 512 * 1024, WS_WRLO = 640 * 1024;
constexpr size_t WS_MOD = 1 * MiB, WS_WAB = 1 * MiB + 256 * 1024, WS_AB = 1 * MiB + 512 * 1024;
constexpr size_t WS_WOUT_T = 2 * MiB, WS_WIN_T = 4 * MiB, WS_H1 = 12 * MiB, WS_PROJA = 44 * MiB, WS_GATES = 142 * MiB;
constexpr size_t WS_QP = 4 * MiB, WS_OI = 20 * MiB, WS_AH = 36 * MiB, WS_GL = 36 * MiB + 512 * 1024, WS_PG = 174 * MiB, WS_BG = 206 * MiB, WS_BH = 238 * MiB, WS_QE = 270 * MiB, WS_OIH = 286 * MiB;
constexpr size_t WS_OMIX = 174 * MiB;
constexpr size_t WS_H2 = 12 * MiB, WS_W1T = 44 * MiB, WS_W2T = 109 * MiB, WS_ACT = 142 * MiB, WS_LIST = 215 * MiB, WS_LISTW = 217 * MiB, WS_Y0 = 12 * MiB, WS_Y1 = 219 * MiB;
constexpr size_t WS_TOP = 302 * MiB;
constexpr int CAP = 4096;
constexpr int TB_PRE = 0, TB_CNT = 132, TB_OFF = 264;
constexpr int CW_CNT = 16384;
constexpr int CW_BAR = 4096;
constexpr int RING_BYTES = 131072, LDS_BYTES = 147456, LDSCTL_OFF = LDS_BYTES - 1024, MISC_OFF = LDSCTL_OFF + 320, SCR2_OFF = LDS_BYTES - 3072;

__device__ __forceinline__ float bf2f(bf16 v) { return __uint_as_float(((unsigned)v) << 16); }
__device__ __forceinline__ float sigmoidf_(float x) { return 1.f / (1.f + __expf(-x)); }
__device__ __forceinline__ float siluf_(float x) { return x / (1.f + __expf(-x)); }
__device__ __forceinline__ float softplusf_(float x) { return x > 20.f ? x : log1pf(expf(x)); }
__device__ __forceinline__ float wave_sum(float v) {
#pragma unroll
    for (int o = 1; o < 64; o <<= 1) v += __shfl_xor(v, o);
    return v;
}

namespace pg8 {
struct EpiProj {
    static constexpr bool PERM = true, AFTER_DRAIN = false;
    bf16_t* projA; bf16_t* gates;
    __device__ __forceinline__ void operator()(const f32x4 (&acc)[2][2][4][2], const Unit& u, int wr, int wc, int fr, int fq) const {
        const int row0 = u.pm * BM + wr * 64 + fr;
        bf16_t* base; int ldc, colt;
        if (u.pn < 12) { base = projA; ldc = 3072; colt = u.pn * BM; } else { base = gates; ldc = 1024; colt = (u.pn - 12) * BM; }
        const int col0 = colt + wc * 32 + 8 * fq;
#pragma unroll
        for (int ai = 0; ai < 2; ++ai)
#pragma unroll
            for (int m = 0; m < 4; ++m) { bf16_t* rowp = base + (size_t)(row0 + ai * HALF + m * 16) * ldc + col0;
#pragma unroll
                for (int bj = 0; bj < 2; ++bj) { const f32x4 v0 = acc[ai][bj][m][0], v1 = acc[ai][bj][m][1];
                    u32x4 w; w.x = cvt_pk_bf16(v0[0], v0[1]); w.y = cvt_pk_bf16(v0[2], v0[3]); w.z = cvt_pk_bf16(v1[0], v1[1]); w.w = cvt_pk_bf16(v1[2], v1[3]);
                    *(u32x4*)(rowp + bj * HALF) = w; } }
    }
};
struct EpiResid {
    static constexpr bool PERM = false, AFTER_DRAIN = false;
    const float* x; const float* mod; float* out;
    __device__ __forceinline__ void operator()(const f32x4 (&acc)[2][2][4][2], const Unit& u, int wr, int wc, int fr, int fq) const {
        const int col0 = u.pn * BM + wc * 32 + 4 * fq;
#pragma unroll
        for (int ai = 0; ai < 2; ++ai)
#pragma unroll
            for (int m = 0; m < 4; ++m) { const int r = u.pm * BM + ai * HALF + wr * 64 + m * 16 + fr; const float* g1 = mod + (r >= 8192 ? 6144 : 0) + 2048; const size_t off = (size_t)r * 1024 + col0;
#pragma unroll
                for (int bj = 0; bj < 2; ++bj)
#pragma unroll
                    for (int n = 0; n < 2; ++n) { const f32x4 gv = *(const f32x4*)(g1 + col0 + bj * HALF + n * 16); const f32x4 xv = *(const f32x4*)(x + off + bj * HALF + n * 16);
                        *(f32x4*)(out + off + bj * HALF + n * 16) = xv + gv * acc[ai][bj][m][n]; } }
    }
};

struct MoeSched {
    const LAS unsigned* tb; int lo, hi, NT, G, c;
    __device__ __forceinline__ bool next(int i, UnitG& u) const {
        const unsigned L = (unsigned)(i * G + c); if (L >= tb[TB_PRE + hi]) return false;
        int s = lo; while (L >= tb[TB_PRE + s + 1]) ++s;
        const unsigned loc = L - tb[TB_PRE + s], tiles = (tb[TB_CNT + s] + 255u) >> 8;
        u.seg = __builtin_amdgcn_readfirstlane(s); u.mt = __builtin_amdgcn_readfirstlane((int)(loc % tiles)); u.nt = __builtin_amdgcn_readfirstlane((int)(loc / tiles)); return true;
    }
};
struct Moe1Prob {
    int K; MoeSched S; const bf16_t* h2; const bf16_t* w1t; const int* list;
    __device__ __forceinline__ bool next(int i, UnitG& u) const { return S.next(i, u); }
    __device__ __forceinline__ void setup(const UnitG& u, const int (&sR)[2], const int (&sC)[2], const char*& cA, unsigned (&offA)[2][2], const char*& cB) const {
        const int hf = u.seg >= 65 ? 1 : 0, e = u.seg - 65 * hf; const int cnt = (int)S.tb[TB_CNT + u.seg];
#pragma unroll
        for (int h = 0; h < 2; ++h)
#pragma unroll
            for (int i = 0; i < 2; ++i) { const int r = 256 * u.mt + 128 * h + sR[i]; unsigned tok;
                if (e < 64) { const int rr = r < cnt ? r : cnt - 1; tok = (unsigned)list[(size_t)(hf * 64 + e) * CAP + rr] >> 3; } else tok = (unsigned)(hf * 8192 + (r < 8192 ? r : 8191));
                offA[h][i] = tok * 2048u + (unsigned)sC[i] * 2u; }
        cA = (const char*)h2; cB = (const char*)(w1t + ((size_t)e * 512 + (size_t)u.nt * 256) * 1024);
    }
};
struct Moe2Prob {
    int K; MoeSched S; const bf16_t* act; const bf16_t* w2t; int hf;
    __device__ __forceinline__ bool next(int i, UnitG& u) const { return S.next(i, u); }
    __device__ __forceinline__ void setup(const UnitG& u, const int (&sR)[2], const int (&sC)[2], const char*& cA, unsigned (&offA)[2][2], const char*& cB) const {
        const int e = u.seg - 65 * hf; const size_t rowbase = (size_t)S.tb[TB_OFF + u.seg] + 256u * (unsigned)u.mt;
#pragma unroll
        for (int h = 0; h < 2; ++h)
#pragma unroll
            for (int i = 0; i < 2; ++i) offA[h][i] = (unsigned)((128 * h + sR[i]) * 256 + sC[i]) * 2u;
        cA = (const char*)(act + rowbase * 256); cB = (const char*)(w2t + ((size_t)e * 1024 + (size_t)u.nt * 256) * 256);
    }
};
struct EpiMoe1 {
    static constexpr bool PERM = true;
    bf16_t* act; const LAS unsigned* tb;
    __device__ __forceinline__ void operator()(const f32x4 (&acc)[2][2][4][2], const UnitG& u, int wr, int wc, int fr, int fq) const {
        const int cnt = (int)tb[TB_CNT + u.seg]; const size_t rowbase = tb[TB_OFF + u.seg];
#pragma unroll
        for (int ai = 0; ai < 2; ++ai)
#pragma unroll
            for (int m = 0; m < 4; ++m) { const int r = 256 * u.mt + ai * HALF + wr * 64 + m * 16 + fr;
                if (r < cnt) { bf16_t* p = act + (rowbase + (size_t)r) * 256 + u.nt * 128 + wc * 32 + 8 * fq;
                    const f32x4 g0 = acc[ai][0][m][0], g1 = acc[ai][0][m][1], u0 = acc[ai][1][m][0], u1 = acc[ai][1][m][1]; f32x4 v0, v1;
#pragma unroll
                    for (int i = 0; i < 4; ++i) { v0[i] = g0[i] / (1.f + __expf(-g0[i])) * u0[i]; v1[i] = g1[i] / (1.f + __expf(-g1[i])) * u1[i]; }
                    u32x4 w; w.x = cvt_pk_bf16(v0[0], v0[1]); w.y = cvt_pk_bf16(v0[2], v0[3]); w.z = cvt_pk_bf16(v1[0], v1[1]); w.w = cvt_pk_bf16(v1[2], v1[3]);
                    *(u32x4*)p = w; } }
    }
};
struct EpiMoe2 {
    static constexpr bool PERM = true;
    bf16_t* y0; bf16_t* y1; float* x2; const float* mod; const int* list; const float* listw; const LAS unsigned* tb; int hf; int do_shared;
    __device__ __forceinline__ void operator()(const f32x4 (&acc)[2][2][4][2], const UnitG& u, int wr, int wc, int fr, int fq) const {
        const int cnt = (int)tb[TB_CNT + u.seg]; const int e = u.seg - 65 * hf; const int colt = u.nt * 256 + wc * 32 + 8 * fq;
#pragma unroll
        for (int ai = 0; ai < 2; ++ai)
#pragma unroll
            for (int m = 0; m < 4; ++m) { const int r = 256 * u.mt + ai * HALF + wr * 64 + m * 16 + fr;
                if (r < cnt) {
                    if (e < 64) { const size_t li = (size_t)(hf * 64 + e) * CAP + r; const int slot = list[li]; const float w = listw[li];
                        const int yr = slot - hf * 65536; bf16_t* p = (yr < 32768 ? y0 + (size_t)yr * 1024 : y1 + (size_t)(yr - 32768) * 1024) + colt;
#pragma unroll
                        for (int bj = 0; bj < 2; ++bj) { const f32x4 v0 = acc[ai][bj][m][0] * w, v1 = acc[ai][bj][m][1] * w;
                            u32x4 o; o.x = cvt_pk_bf16(v0[0], v0[1]); o.y = cvt_pk_bf16(v0[2], v0[3]); o.z = cvt_pk_bf16(v1[0], v1[1]); o.w = cvt_pk_bf16(v1[2], v1[3]);
                            *(u32x4*)(p + bj * HALF) = o; }
                    } else if (do_shared) { float* p = x2 + (size_t)(hf * 8192 + r) * 1024 + colt; const float* g2 = mod + hf * 6144 + 5120 + colt;
#pragma unroll
                        for (int bj = 0; bj < 2; ++bj)
#pragma unroll
                            for (int n = 0; n < 2; ++n) { f32x4* q = (f32x4*)(p + bj * HALF + 4 * n); *q = *q + *(const f32x4*)(g2 + bj * HALF + 4 * n) * acc[ai][bj][m][n]; } }
                } }
    }
};
}

struct TrItem { const float* W; int ldw, src_col; bf16* WT; int K, dst_row, k0; };
__device__ __forceinline__ void tr_load(const TrItem& t, int lane, f32x4 (&v)[8]) {
#pragma unroll
    for (int i = 0; i < 8; ++i) v[i] = *(const GAS f32x4*)(t.W + (size_t)(t.k0 + 8 * i + (lane >> 3)) * t.ldw + t.src_col + 4 * (lane & 7));
}
__device__ __forceinline__ void tr_finish(const TrItem& t, int lane, const f32x4 (&v)[8], LAS float* scr) {
#pragma unroll
    for (int i = 0; i < 8; ++i) { LAS float* p = scr + (8 * i + (lane >> 3)) * 33 + 4 * (lane & 7); p[0] = v[i][0]; p[1] = v[i][1]; p[2] = v[i][2]; p[3] = v[i][3]; }
    LDS_WAIT(); asm volatile("" ::: "memory");
    const int c = lane & 7;
#pragma unroll
    for (int j = 0; j < 4; ++j) { const int n = (lane >> 3) + 8 * j; const LAS float* s = scr + (8 * c) * 33 + n;
        v4u o; o.x = pk2(s[0 * 33], s[1 * 33]); o.y = pk2(s[2 * 33], s[3 * 33]); o.z = pk2(s[4 * 33], s[5 * 33]); o.w = pk2(s[6 * 33], s[7 * 33]);
        *(GAS v4u*)(t.WT + (size_t)(t.dst_row + n) * t.K + t.k0 + 8 * c) = o; }
    LDS_WAIT(); asm volatile("" ::: "memory");
}
#define TR_LOOP(it0, stride, nitems, MAKE) do { int it_ = (it0); if (it_ < (nitems)) { TrItem cur_ = MAKE(it_); f32x4 va_[8], vb_[8]; tr_load(cur_, lane, va_); \
    for (;;) { const int nx_ = it_ + (stride); const bool hn_ = nx_ < (nitems); TrItem nxt_ = cur_; if (hn_) { nxt_ = MAKE(nx_); tr_load(nxt_, lane, vb_); } \
        tr_finish(cur_, lane, va_, scr); if (!hn_) break; _Pragma("unroll") for (int q_ = 0; q_ < 8; ++q_) va_[q_] = vb_[q_]; cur_ = nxt_; it_ = nx_; } } } while (0)

#ifndef REP_PHASE
#define REP_PHASE -1
#endif
#ifndef REP_N
#define REP_N 1
#endif
#define REPN(k) ((k) == REP_PHASE ? REP_N : 1)

constexpr int UNITS = BATCH * 128 * 4;
constexpr int L_QN = 0, L_KN = 17408, L_VV = 34816, L_LM = 52224, L_ATT = 68608, L_UT = 77824, L_WT = 96256, L_KTT = 114688, L_GCS = 133120, L_EGS = 133376, L_BET = 133632, L_SCW = 133888, L_SKT = 134144, L_TM = L_KN, L_TB = L_VV;
constexpr int H_FR = 0, H_QR = 17408, H_QE = 34816, H_KD = 52224, H_KTT = 69632, H_VT = 88064, H_AM = 106496;
constexpr int RS = 272, TS = 144;

typedef unsigned v2u __attribute__((ext_vector_type(2)));
#define LBAR() do { asm volatile("s_waitcnt lgkmcnt(0)" ::: "memory"); __builtin_amdgcn_s_barrier(); asm volatile("" ::: "memory"); } while (0)
__device__ __forceinline__ f32x4 mfma16(bf16x8 a, bf16x8 b, f32x4 c) { return __builtin_amdgcn_mfma_f32_16x16x32_bf16(a, b, c, 0, 0, 0); }
__device__ __forceinline__ bf16x8 ldsfrag(const LAS unsigned char* base, int row, int stride, int kbyte) { return *(const LAS bf16x8*)(base + row * stride + kbyte); }
__device__ __forceinline__ void unpack8(const v4u q, float (&f)[8]) {
    f[0] = __uint_as_float(q.x << 16); f[1] = __uint_as_float(q.x & 0xffff0000u); f[2] = __uint_as_float(q.y << 16); f[3] = __uint_as_float(q.y & 0xffff0000u);
    f[4] = __uint_as_float(q.z << 16); f[5] = __uint_as_float(q.z & 0xffff0000u); f[6] = __uint_as_float(q.w << 16); f[7] = __uint_as_float(q.w & 0xffff0000u); }
__device__ __forceinline__ f32x4 unpack4(const v2u q) { return (f32x4){__uint_as_float(q.x << 16), __uint_as_float(q.x & 0xffff0000u), __uint_as_float(q.y << 16), __uint_as_float(q.y & 0xffff0000u)}; }
__device__ __forceinline__ v2u pack4(const f32x4 v) { v2u o; o.x = pk2(v[0], v[1]); o.y = pk2(v[2], v[3]); return o; }
__device__ __forceinline__ float ldsbf(const LAS unsigned char* base, int row, int stride, int col) { return __uint_as_float(((unsigned)*(const LAS unsigned short*)(base + row * stride + col * 2)) << 16); }

struct MixPtrs {
    const bf16* projA; const bf16* gates; const float* ab; const float* conv_w; const float* a_log; const float* dt_bias; const float* hg_lb; const float* gdn_nw; const float* hg_nw;
    bf16 *PG, *BG, *QP, *OI, *BH, *QE, *OIH, *SG, *SH, *omix; float *GL, *AH;
};

__device__ __forceinline__ void p3_gdn_unit(LAS unsigned char* lds, const MixPtrs& X, int unit, int tid, int lane, int wave) {
    const int h = unit & 3, n = (unit >> 2) & 127, b = unit >> 9, r = lane & 15, g = lane >> 4;
    const size_t tok0 = (size_t)b * T + (size_t)n * 64;
    LAS float* gcs = (LAS float*)(lds + L_GCS); LAS float* egs = (LAS float*)(lds + L_EGS); LAS float* bet = (LAS float*)(lds + L_BET);
    {
#pragma unroll 1
      for (int ib = 0; ib < 6; ib += 3) {
        v4u raw[3][4];
#pragma unroll
        for (int i2 = 0; i2 < 3; ++i2) { const int i = ib + i2; const int pair = (tid >> 4) + 32 * i, tz = pair >> 6, c = pair & 63, ch = tid & 15, col = tz * 512 + h * 128 + ch * 8;
#pragma unroll
            for (int j = 0; j < 4; ++j) { const int tl = n * 64 + c - 3 + j; raw[i2][j] = *(const GAS v4u*)(X.projA + ((size_t)b * T + (tl < 0 ? 0 : tl)) * PA + col); } }
#pragma unroll
        for (int i2 = 0; i2 < 3; ++i2) { const int i = ib + i2;
            const int pair = (tid >> 4) + 32 * i, tz = pair >> 6, c = pair & 63, ch = tid & 15, col = tz * 512 + h * 128 + ch * 8;
            float y[8];
#pragma unroll
            for (int e = 0; e < 8; ++e) y[e] = 0.f;
#pragma unroll
            for (int j = 0; j < 4; ++j) { const int tl = n * 64 + c - 3 + j; const float msk = tl >= 0 ? 1.f : 0.f; float xf[8]; unpack8(raw[i2][j], xf);
                const f32x4 w0 = *(const GAS f32x4*)(X.conv_w + j * 1536 + col) * msk, w1 = *(const GAS f32x4*)(X.conv_w + j * 1536 + col + 4) * msk;
#pragma unroll
                for (int e = 0; e < 4; ++e) { y[e] += w0[e] * xf[e]; y[4 + e] += w1[e] * xf[4 + e]; } }
            float ss = 0.f;
#pragma unroll
            for (int e = 0; e < 8; ++e) { y[e] = siluf_(y[e]); ss += y[e] * y[e]; }
            ss += __shfl_xor(ss, 1); ss += __shfl_xor(ss, 2); ss += __shfl_xor(ss, 4); ss += __shfl_xor(ss, 8);
            const float rn = tz == 2 ? 1.f : rsqrtf(ss + 1e-6f) * (tz == 0 ? 0.08838834764831845f : 1.f);
            v4u o; o.x = pk2(y[0] * rn, y[1] * rn); o.y = pk2(y[2] * rn, y[3] * rn); o.z = pk2(y[4] * rn, y[5] * rn); o.w = pk2(y[6] * rn, y[7] * rn);
            *(LAS v4u*)(lds + (tz == 0 ? L_QN : (tz == 1 ? L_KN : L_VV)) + c * RS + ch * 16) = o;
        }
      }
    }
    if (wave == 0) {
        const float araw = X.ab[(tok0 + lane) * 8 + 4 + h], braw = X.ab[(tok0 + lane) * 8 + h];
        float gv = -expf(X.a_log[h]) * softplusf_(araw + X.dt_bias[h]);
#pragma unroll
        for (int o = 1; o < 64; o <<= 1) { const float t = __shfl_up(gv, o); if (lane >= o) gv += t; }
        { const float eg_ = __expf(gv), be_ = sigmoidf_(braw); gcs[lane] = gv; egs[lane] = eg_; bet[lane] = be_; *(LAS float*)(lds + L_SCW + lane * 4) = be_ * eg_; *(LAS float*)(lds + L_SKT + lane * 4) = __expf(__shfl(gv, 63) - gv); }
        if (lane == 63) X.GL[unit] = gv;
    }
    LBAR();
    {
        const int mt = wave >> 1;
#pragma unroll
        for (int q = 0; q < 2; ++q) { const int ntc = 2 * (wave & 1) + q; f32x4 akk = {0.f, 0.f, 0.f, 0.f}, aqk = {0.f, 0.f, 0.f, 0.f};
#pragma unroll
            for (int ks = 0; ks < 4; ++ks) { const bf16x8 ka = ldsfrag(lds + L_KN, 16 * mt + r, RS, 64 * ks + 16 * g), qa = ldsfrag(lds + L_QN, 16 * mt + r, RS, 64 * ks + 16 * g), kb = ldsfrag(lds + L_KN, 16 * ntc + r, RS, 64 * ks + 16 * g);
                akk = mfma16(ka, kb, akk); aqk = mfma16(qa, kb, aqk); }
            const int j = 16 * ntc + r; const float gj = gcs[j];
#pragma unroll
            for (int ii = 0; ii < 4; ++ii) { const int i = 16 * mt + 4 * g + ii; const float dec = (i >= j) ? __expf(gcs[i] - gj) : 0.f;
                *(LAS float*)(lds + L_LM + (i * 64 + j) * 4) = (i > j) ? bet[i] * akk[ii] * dec : 0.f;
                *(LAS unsigned short*)(lds + L_ATT + i * TS + j * 2) = (unsigned short)f2bf(aqk[ii] * dec); } }
    }
    LBAR();
#pragma unroll
    for (int i = 0; i < 2; ++i) { const int tsk = tid + 512 * i;
        if (tsk < 768) { const int a = tsk >> 8, hh = (tsk >> 7) & 1, d = tsk & 127;
            const LAS unsigned char* sp = lds + (a == 0 ? L_VV : L_KN) + d * 2; const LAS float* scl = (const LAS float*)(lds + (a == 0 ? L_BET : (a == 1 ? L_SCW : L_SKT)));
            LAS unsigned char* dp = lds + (a == 0 ? L_UT : (a == 1 ? L_WT : L_KTT)) + d * TS + 64 * hh;
#pragma unroll
            for (int q = 0; q < 4; ++q) { float kv[8];
#pragma unroll
                for (int e = 0; e < 8; ++e) { const int c = 32 * hh + 8 * q + e; kv[e] = __uint_as_float(((unsigned)*(const LAS unsigned short*)(sp + c * RS)) << 16) * scl[c]; }
                v4u o; o.x = pk2(kv[0], kv[1]); o.y = pk2(kv[2], kv[3]); o.z = pk2(kv[4], kv[5]); o.w = pk2(kv[6], kv[7]); *(LAS v4u*)(dp + 16 * q) = o; } } }
    LBAR();
    { const LAS float* Lm = (const LAS float*)(lds + L_LM); LAS float* Tm = (LAS float*)(lds + L_TM);
      if (tid < 64) { const int I = tid >> 4, j = tid & 15; float x[16];
#pragma unroll
          for (int i = 0; i < 16; ++i) { float s = (i == j) ? 1.f : 0.f;
#pragma unroll
              for (int kb = 0; kb < (i + 3) / 4; ++kb) { const f32x4 l = *(const LAS f32x4*)(Lm + (16 * I + i) * 64 + 16 * I + 4 * kb);
#pragma unroll
                  for (int e = 0; e < 4; ++e) if (4 * kb + e < i) s -= l[e] * x[4 * kb + e]; }
              x[i] = (i < j) ? 0.f : s; Tm[(16 * I + i) * 64 + 16 * I + j] = x[i]; } }
      LBAR();
#pragma unroll 1
      for (int lv = 1; lv < 4; ++lv) {
          for (int e = tid; e < (4 - lv) * 256; e += NWAVES * 64) { const int I = lv + (e >> 8), J = I - lv, rr = (e >> 4) & 15, cc = e & 15; float w = 0.f;
              for (int K = J; K < I; ++K) {
#pragma unroll
                  for (int kb = 0; kb < 4; ++kb) { const f32x4 l = *(const LAS f32x4*)(Lm + (16 * I + rr) * 64 + 16 * K + 4 * kb);
#pragma unroll
                      for (int q = 0; q < 4; ++q) w += l[q] * Tm[(16 * K + 4 * kb + q) * 64 + 16 * J + cc]; } }
              Tm[(16 * J + rr) * 64 + 16 * I + cc] = w; }
          LBAR();
          for (int e = tid; e < (4 - lv) * 256; e += NWAVES * 64) { const int I = lv + (e >> 8), J = I - lv, rr = (e >> 4) & 15, cc = e & 15; float t = 0.f;
#pragma unroll
              for (int kb = 0; kb < 4; ++kb) { const f32x4 l = *(const LAS f32x4*)(Tm + (16 * I + rr) * 64 + 16 * I + 4 * kb);
#pragma unroll
                  for (int q = 0; q < 4; ++q) t -= l[q] * Tm[(16 * J + 4 * kb + q) * 64 + 16 * I + cc]; }
              Tm[(16 * I + rr) * 64 + 16 * J + cc] = t; }
          LBAR();
      }
      { const int i = tid >> 3, j0 = (tid & 7) * 8; const f32x4 t0 = *(const LAS f32x4*)(Tm + i * 64 + j0), t1 = *(const LAS f32x4*)(Tm + i * 64 + j0 + 4); const bool keep = (i >> 4) >= (j0 >> 4);
        v4u o; o.x = keep ? pk2(t0[0], t0[1]) : 0u; o.y = keep ? pk2(t0[2], t0[3]) : 0u; o.z = keep ? pk2(t1[0], t1[1]) : 0u; o.w = keep ? pk2(t1[2], t1[3]) : 0u;
        *(LAS v4u*)(lds + L_TB + i * TS + j0 * 2) = o; }
      LBAR();
    }
    { bf16x8 af[4][2];
#pragma unroll
      for (int mt = 0; mt < 4; ++mt)
#pragma unroll
          for (int ks = 0; ks < 2; ++ks) af[mt][ks] = ldsfrag(lds + L_TB, 16 * mt + r, TS, 64 * ks + 16 * g);
#pragma unroll
      for (int q = 0; q < 2; ++q) { const int ng = 2 * wave + q; LAS unsigned char* base = lds + (ng >= 8 ? L_WT : L_UT) + (16 * (ng & 7) + r) * TS;
          const bf16x8 b0 = *(const LAS bf16x8*)(base + 16 * g), b1 = *(const LAS bf16x8*)(base + 64 + 16 * g);
          f32x4 acc[4];
#pragma unroll
          for (int mt = 0; mt < 4; ++mt) { acc[mt] = mfma16(af[mt][0], b0, (f32x4){0.f, 0.f, 0.f, 0.f}); acc[mt] = mfma16(af[mt][1], b1, acc[mt]); }
          asm volatile("s_waitcnt lgkmcnt(0)" ::: "memory");
#pragma unroll
          for (int mt = 0; mt < 4; ++mt) *(LAS v2u*)(base + (16 * mt + 4 * g) * 2) = pack4(acc[mt]); }
    }
    LBAR();
    {
        const size_t u16 = (size_t)unit * 16384, u8 = (size_t)unit * 8192;
        { const int kk = wave >> 1;
          bf16x8 af[2][2];
#pragma unroll
          for (int t2 = 0; t2 < 2; ++t2)
#pragma unroll
              for (int ks = 0; ks < 2; ++ks) af[t2][ks] = ldsfrag(lds + L_WT, 16 * (2 * kk + t2) + r, TS, 64 * ks + 16 * g);
#pragma unroll
          for (int q = 0; q < 4; ++q) { const int nt = 4 * (wave & 1) + q; f32x4 a0 = {0.f, 0.f, 0.f, 0.f}, a1 = {0.f, 0.f, 0.f, 0.f};
#pragma unroll
              for (int ks = 0; ks < 2; ++ks) { const bf16x8 bfr = ldsfrag(lds + L_KTT, 16 * nt + r, TS, 64 * ks + 16 * g); a0 = mfma16(af[0][ks], bfr, a0); a1 = mfma16(af[1][ks], bfr, a1); }
              v4u o; o.x = pk2(-a0[0], -a0[1]); o.y = pk2(-a0[2], -a0[3]); o.z = pk2(-a1[0], -a1[1]); o.w = pk2(-a1[2], -a1[3]);
              *(GAS v4u*)(X.PG + u16 + ((size_t)(nt * 4 + kk) * 64 + lane) * 8) = o; } }
        { const int mt = wave; bf16x8 af[2];
#pragma unroll
          for (int ks = 0; ks < 2; ++ks) af[ks] = ldsfrag(lds + L_KTT, 16 * mt + r, TS, 64 * ks + 16 * g);
#pragma unroll
          for (int nt = 0; nt < 8; ++nt) { f32x4 a0 = {0.f, 0.f, 0.f, 0.f};
#pragma unroll
              for (int ks = 0; ks < 2; ++ks) a0 = mfma16(af[ks], ldsfrag(lds + L_UT, 16 * nt + r, TS, 64 * ks + 16 * g), a0);
              *(GAS v2u*)(X.BG + u16 + ((size_t)(nt * 8 + mt) * 64 + lane) * 4) = pack4(a0); } }
        { const int kk = wave >> 1;
#pragma unroll
          for (int q = 0; q < 2; ++q) { const int ct = 2 * (wave & 1) + q; f32x4 a0 = {0.f, 0.f, 0.f, 0.f}, a1 = {0.f, 0.f, 0.f, 0.f};
#pragma unroll
              for (int ks = 0; ks < 2; ++ks) { const bf16x8 bfr = ldsfrag(lds + L_ATT, 16 * ct + r, TS, 64 * ks + 16 * g);
                  a0 = mfma16(ldsfrag(lds + L_WT, 16 * (2 * kk) + r, TS, 64 * ks + 16 * g), bfr, a0); a1 = mfma16(ldsfrag(lds + L_WT, 16 * (2 * kk + 1) + r, TS, 64 * ks + 16 * g), bfr, a1); }
              const int c = 16 * ct + r; const float eg = egs[c];
              const f32x4 q0 = unpack4(*(const LAS v2u*)(lds + L_QN + c * RS + (32 * kk + 4 * g) * 2)), q1 = unpack4(*(const LAS v2u*)(lds + L_QN + c * RS + (32 * kk + 16 + 4 * g) * 2));
              v4u o; o.x = pk2(q0[0] * eg - a0[0], q0[1] * eg - a0[1]); o.y = pk2(q0[2] * eg - a0[2], q0[3] * eg - a0[3]); o.z = pk2(q1[0] * eg - a1[0], q1[1] * eg - a1[1]); o.w = pk2(q1[2] * eg - a1[2], q1[3] * eg - a1[3]);
              *(GAS v4u*)(X.QP + u8 + ((size_t)(ct * 4 + kk) * 64 + lane) * 8) = o; } }
        { const int vt = wave; bf16x8 af[2];
#pragma unroll
          for (int ks = 0; ks < 2; ++ks) af[ks] = ldsfrag(lds + L_UT, 16 * vt + r, TS, 64 * ks + 16 * g);
#pragma unroll
          for (int ct = 0; ct < 4; ++ct) { f32x4 a0 = {0.f, 0.f, 0.f, 0.f};
#pragma unroll
              for (int ks = 0; ks < 2; ++ks) a0 = mfma16(af[ks], ldsfrag(lds + L_ATT, 16 * ct + r, TS, 64 * ks + 16 * g), a0);
              *(GAS v2u*)(X.OI + u8 + ((size_t)(vt * 4 + ct) * 64 + lane) * 4) = pack4(a0); } }
    }
    LBAR();
}

__device__ __forceinline__ void p3_hgrn_unit(LAS unsigned char* lds, const MixPtrs& X, int unit, int tid, int lane, int wave) {
    const int h = unit & 3, n = (unit >> 2) & 127, b = unit >> 9, r = lane & 15, g = lane >> 4;
    const size_t tok0 = (size_t)b * T + (size_t)n * 64;
#pragma unroll
    for (int i = 0; i < 4; ++i) { const int pair = (tid >> 4) + 32 * i, tz = pair >> 6, c = pair & 63, ch = tid & 15;
        const v4u q = *(const GAS v4u*)(X.projA + (tok0 + c) * PA + (tz ? 2560 : 1536) + h * 128 + ch * 8);
        *(LAS v4u*)(lds + (tz ? H_QR : H_FR) + c * RS + ch * 16) = q; }
    {
        v4u rv[2];
#pragma unroll
        for (int i = 0; i < 2; ++i) { const int item = tid + 512 * i, c = item >> 4, ch = item & 15; rv[i] = *(const GAS v4u*)(X.projA + (tok0 + c) * PA + 2048 + h * 128 + ch * 8); }
#pragma unroll
        for (int i = 0; i < 2; ++i) { const int item = tid + 512 * i, c = item >> 4, ch = item & 15; const unsigned w[4] = {rv[i].x, rv[i].y, rv[i].z, rv[i].w};
#pragma unroll
            for (int e = 0; e < 4; ++e) { *(LAS unsigned short*)(lds + H_VT + (ch * 8 + 2 * e) * TS + c * 2) = (unsigned short)(w[e] & 0xffffu); *(LAS unsigned short*)(lds + H_VT + (ch * 8 + 2 * e + 1) * TS + c * 2) = (unsigned short)(w[e] >> 16); } }
    }
    LBAR();
    {
        const int d = tid & 127, seg = tid >> 7; LAS float* segt = (LAS float*)(lds + H_AM + 9216);
        const float l0 = X.hg_lb[h * 128 + d], l1 = X.hg_lb[512 + h * 128 + d]; const float mx = fmaxf(l0, l1); const float e0 = __expf(l0 - mx), e1 = __expf(l1 - mx); const float lb = e0 / (e0 + e1);
        float lc[16], kq[16]; float run = 0.f;
#pragma unroll
        for (int ci = 0; ci < 16; ++ci) { const float sg = sigmoidf_(ldsbf(lds + H_FR, 16 * seg + ci, RS, d)); run += __logf(lb + (1.f - lb) * sg); lc[ci] = run; kq[ci] = (1.f - lb) * (1.f - sg); }
        segt[seg * 128 + d] = run;
        LBAR();
        const float t0 = segt[d], t1 = segt[128 + d], t2 = segt[256 + d], t3 = segt[384 + d];
        const float off = (seg > 0 ? t0 : 0.f) + (seg > 1 ? t1 : 0.f) + (seg > 2 ? t2 : 0.f), btot = (t0 + t1) + (t2 + t3);
        float kv[16];
#pragma unroll
        for (int ci = 0; ci < 16; ++ci) { const int c = 16 * seg + ci; const float bb = off + lc[ci];
            *(LAS unsigned short*)(lds + H_QE + c * RS + d * 2) = (unsigned short)f2bf(siluf_(ldsbf(lds + H_QR, c, RS, d)) * __expf(bb));
            *(LAS unsigned short*)(lds + H_KD + c * RS + d * 2) = (unsigned short)f2bf(kq[ci] * __expf(-bb));
            kv[ci] = kq[ci] * __expf(btot - bb); }
        if (seg == 0) X.AH[(size_t)unit * 128 + d] = __expf(btot);
#pragma unroll
        for (int q = 0; q < 2; ++q) { v4u o; o.x = pk2(kv[8 * q], kv[8 * q + 1]); o.y = pk2(kv[8 * q + 2], kv[8 * q + 3]); o.z = pk2(kv[8 * q + 4], kv[8 * q + 5]); o.w = pk2(kv[8 * q + 6], kv[8 * q + 7]);
            *(LAS v4u*)(lds + H_KTT + d * TS + (16 * seg + 8 * q) * 2) = o; }
    }
    LBAR();
    {
        const int mt = wave >> 1;
#pragma unroll
        for (int q = 0; q < 2; ++q) { const int ntc = 2 * (wave & 1) + q; f32x4 a0 = {0.f, 0.f, 0.f, 0.f};
#pragma unroll
            for (int ks = 0; ks < 4; ++ks) a0 = mfma16(ldsfrag(lds + H_QE, 16 * mt + r, RS, 64 * ks + 16 * g), ldsfrag(lds + H_KD, 16 * ntc + r, RS, 64 * ks + 16 * g), a0);
            const int j = 16 * ntc + r;
#pragma unroll
            for (int ii = 0; ii < 4; ++ii) { const int i = 16 * mt + 4 * g + ii; *(LAS unsigned short*)(lds + H_AM + i * TS + j * 2) = (unsigned short)f2bf((i >= j) ? a0[ii] : 0.f); } }
    }
    LBAR();
    {
        const size_t u16 = (size_t)unit * 16384, u8 = (size_t)unit * 8192;
        { const int mt = wave; bf16x8 af[2];
#pragma unroll
          for (int ks = 0; ks < 2; ++ks) af[ks] = ldsfrag(lds + H_KTT, 16 * mt + r, TS, 64 * ks + 16 * g);
#pragma unroll
          for (int nt = 0; nt < 8; ++nt) { f32x4 a0 = {0.f, 0.f, 0.f, 0.f};
#pragma unroll
              for (int ks = 0; ks < 2; ++ks) a0 = mfma16(af[ks], ldsfrag(lds + H_VT, 16 * nt + r, TS, 64 * ks + 16 * g), a0);
              *(GAS v2u*)(X.BH + u16 + ((size_t)(nt * 8 + mt) * 64 + lane) * 4) = pack4(a0); } }
        { const int vt = wave; bf16x8 af[2];
#pragma unroll
          for (int ks = 0; ks < 2; ++ks) af[ks] = ldsfrag(lds + H_VT, 16 * vt + r, TS, 64 * ks + 16 * g);
#pragma unroll
          for (int ct = 0; ct < 4; ++ct) { f32x4 a0 = {0.f, 0.f, 0.f, 0.f};
#pragma unroll
              for (int ks = 0; ks < 2; ++ks) a0 = mfma16(af[ks], ldsfrag(lds + H_AM, 16 * ct + r, TS, 64 * ks + 16 * g), a0);
              *(GAS v2u*)(X.OIH + u8 + ((size_t)(vt * 4 + ct) * 64 + lane) * 4) = pack4(a0); } }
#pragma unroll
        for (int q = 0; q < 2; ++q) { const int idx = wave * 2 + q, ct = idx >> 2, kk = idx & 3, c = 16 * ct + r;
            const v2u q0 = *(const LAS v2u*)(lds + H_QE + c * RS + (32 * kk + 4 * g) * 2), q1 = *(const LAS v2u*)(lds + H_QE + c * RS + (32 * kk + 16 + 4 * g) * 2);
            v4u o; o.x = q0.x; o.y = q0.y; o.z = q1.x; o.w = q1.y;
            *(GAS v4u*)(X.QE + u8 + ((size_t)(ct * 4 + kk) * 64 + lane) * 8) = o; }
    }
    LBAR();
}

__device__ __forceinline__ void p4_gdn_scan(LAS unsigned char* lds, const MixPtrs& X, int job, int lane, int wave) {
    const int s = job >> 3, h = job & 3, b = (job >> 2) & 1;
    const int unit0 = (b * 128) * 4 + h;
    constexpr int BRING = 131072, GLOFF = BRING + 3 * 4096;
    if (wave >= 4) {
        const int lw = wave - 4;
        const char* src0 = (const char*)(X.PG + (size_t)unit0 * 16384) + lw * 8192 + lane * 16;
        const char* bsrc0 = (const char*)(X.BG + (size_t)unit0 * 16384 + (size_t)(s * 8) * 256) + lw * 1024 + lane * 16;
#define P4_ISSUE_P(n_) do { const char* s_ = src0 + (size_t)(n_) * (4 * 32768); _Pragma("unroll") for (int i_ = 0; i_ < 8; ++i_) \
        __builtin_amdgcn_global_load_lds((const unsigned*)(s_ + i_ * 1024), (LAS unsigned*)(lds + ((n_) & 3) * 32768 + lw * 8192 + i_ * 1024), 16, 0, 2); } while (0)
#define P4_ISSUE_B(n_) __builtin_amdgcn_global_load_lds((const unsigned*)(bsrc0 + (size_t)(n_) * (4 * 32768)), (LAS unsigned*)(lds + BRING + ((n_) % 3) * 4096 + lw * 1024), 16, 0, 0)
        P4_ISSUE_P(0); P4_ISSUE_B(0); P4_ISSUE_P(1); P4_ISSUE_B(1); P4_ISSUE_P(2);
#pragma unroll 1
        for (int n = 0; n < 128; ++n) {
            if (n + 2 < 128) asm volatile("s_waitcnt vmcnt(17)" ::: "memory"); else if (n + 1 < 128) asm volatile("s_waitcnt vmcnt(9)" ::: "memory"); else asm volatile("s_waitcnt vmcnt(0)" ::: "memory");
            __builtin_amdgcn_s_barrier();
            asm volatile("" ::: "memory");
            if (n + 2 < 128) P4_ISSUE_B(n + 2);
            if (n + 3 < 128) P4_ISSUE_P(n + 3);
        }
#undef P4_ISSUE_P
#undef P4_ISSUE_B
    } else if (wave == 0) {
        f32x4 S[8]; bf16x8 sb[4];
#pragma unroll
        for (int mt = 0; mt < 8; ++mt) S[mt] = (f32x4){0.f, 0.f, 0.f, 0.f};
#pragma unroll
        for (int kk = 0; kk < 4; ++kk) { sb[kk] = (bf16x8){0, 0, 0, 0, 0, 0, 0, 0}; *(GAS bf16x8*)(X.SG + (size_t)unit0 * 16384 + ((size_t)(s * 4 + kk) * 64 + lane) * 8) = sb[kk]; }
        { const float g0 = X.GL[unit0 + 4 * lane], g1 = X.GL[unit0 + 4 * (64 + lane)]; *(LAS float*)(lds + GLOFF + lane * 4) = g0; *(LAS float*)(lds + GLOFF + (64 + lane) * 4) = g1; }
        asm volatile("s_waitcnt vmcnt(0) lgkmcnt(0)" ::: "memory");
#pragma unroll 1
        for (int n = 0; n < 128; ++n) {
            const int unit = unit0 + 4 * n;
            __builtin_amdgcn_s_barrier();
            asm volatile("" ::: "memory");
            const float e = __expf(*(const LAS float*)(lds + GLOFF + n * 4));
            const LAS unsigned char* bb = lds + BRING + (n % 3) * 4096 + lane * 8;
            f32x4 acc[8];
#pragma unroll
            for (int mt = 0; mt < 8; ++mt) acc[mt] = S[mt] * e + unpack4(*(const LAS v2u*)(bb + mt * 512));
            const LAS unsigned char* pb = lds + (n & 3) * 32768 + lane * 16;
#pragma unroll
            for (int kk = 0; kk < 4; ++kk)
#pragma unroll
                for (int mt = 0; mt < 8; ++mt) acc[mt] = mfma16(*(const LAS bf16x8*)(pb + (mt * 4 + kk) * 1024), sb[kk], acc[mt]);
#pragma unroll
            for (int mt = 0; mt < 8; ++mt) S[mt] = acc[mt];
#pragma unroll
            for (int kk = 0; kk < 4; ++kk) { const v2u lo = pack4(S[2 * kk]), hi = pack4(S[2 * kk + 1]); v4u o; o.x = lo.x; o.y = lo.y; o.z = hi.x; o.w = hi.y; sb[kk] = __builtin_bit_cast(bf16x8, o);
                if (n < 127) *(GAS v4u*)(X.SG + (size_t)(unit + 4) * 16384 + ((size_t)(s * 4 + kk) * 64 + lane) * 8) = o; }
            asm volatile("s_waitcnt lgkmcnt(0)" ::: "memory");
        }
    } else {
#pragma unroll 1
        for (int n = 0; n < 128; ++n) { __builtin_amdgcn_s_barrier(); asm volatile("" ::: "memory"); }
    }
}
__device__ __forceinline__ void p4_hgrn_scan(const MixPtrs& X, int task, int lane) {
    const int mt = task & 7, s = (task >> 3) & 7, h = (task >> 6) & 3, b = task >> 8, g = lane >> 4;
    const int unit0 = (b * 128) * 4 + h;
    f32x4 s0 = {0.f, 0.f, 0.f, 0.f};
    const GAS f32x4* ap = (const GAS f32x4*)(X.AH + (size_t)unit0 * 128 + 16 * mt + 4 * g);
    const GAS v2u* bp = (const GAS v2u*)(X.BH + (size_t)unit0 * 16384 + ((size_t)(s * 8 + mt) * 64 + lane) * 4);
    GAS v2u* sp = (GAS v2u*)(X.SH + (size_t)unit0 * 16384 + ((size_t)(s * 4 + (mt >> 1)) * 64 + lane) * 8 + 4 * (mt & 1));
    { v2u z; z.x = 0; z.y = 0; sp[0] = z; }
    f32x4 ra[8]; v2u rb[8];
#pragma unroll
    for (int j = 0; j < 8; ++j) { ra[j] = ap[(size_t)j * 128]; rb[j] = bp[(size_t)j * 16384]; }
#pragma unroll 1
    for (int n0 = 0; n0 < 128; n0 += 8) {
#pragma unroll
        for (int j = 0; j < 8; ++j) { const int n = n0 + j;
            s0 = ra[j] * s0 + unpack4(rb[j]);
            if (n + 8 < 128) { ra[j] = ap[(size_t)(n + 8) * 128]; rb[j] = bp[(size_t)(n + 8) * 16384]; }
            if (n < 127) sp[(size_t)(n + 1) * 16384] = pack4(s0); }
    }
}
__device__ __forceinline__ void p5_unit(LAS unsigned char* lds, const MixPtrs& X, int bn, int lane, int wave) {
    const int hd = wave & 3, type = wave >> 2, r = lane & 15, g = lane >> 4;
    const int unit = bn * 4 + hd; const size_t tok0 = (size_t)bn * 64;
    const bf16* SX = type ? X.SH : X.SG; const bf16* QX = type ? X.QE : X.QP; const bf16* OX = type ? X.OIH : X.OI;
    const size_t u16 = (size_t)unit * 16384, u8 = (size_t)unit * 8192;
    LAS float* exch = (LAS float*)lds;
    const float* nw = type ? X.hg_nw + hd * 128 : X.gdn_nw;
#pragma unroll 1
    for (int cp = 0; cp < 2; ++cp) {
        f32x4 acc[8][2]; v2u gtq[8][2];
#pragma unroll
        for (int vt = 0; vt < 8; ++vt)
#pragma unroll
            for (int cc = 0; cc < 2; ++cc) { acc[vt][cc] = unpack4(*(const GAS v2u*)(OX + u8 + ((size_t)(vt * 4 + 2 * cp + cc) * 64 + lane) * 4));
                gtq[vt][cc] = *(const GAS v2u*)(X.gates + (tok0 + 16 * (2 * cp + cc) + r) * 1024 + type * 512 + hd * 128 + 16 * vt + 4 * g); }
#pragma unroll
        for (int kk = 0; kk < 4; ++kk) {
            bf16x8 af[8], bfr[2];
#pragma unroll
            for (int vt = 0; vt < 8; ++vt) af[vt] = *(const GAS bf16x8*)(SX + u16 + ((size_t)(vt * 4 + kk) * 64 + lane) * 8);
#pragma unroll
            for (int cc = 0; cc < 2; ++cc) bfr[cc] = *(const GAS bf16x8*)(QX + u8 + ((size_t)((2 * cp + cc) * 4 + kk) * 64 + lane) * 8);
#pragma unroll
            for (int vt = 0; vt < 8; ++vt)
#pragma unroll
                for (int cc = 0; cc < 2; ++cc) acc[vt][cc] = mfma16(af[vt], bfr[cc], acc[vt][cc]);
        }
        float ssq[2];
#pragma unroll
        for (int cc = 0; cc < 2; ++cc) { float s = 0.f;
#pragma unroll
            for (int vt = 0; vt < 8; ++vt) s += (acc[vt][cc][0] * acc[vt][cc][0] + acc[vt][cc][1] * acc[vt][cc][1]) + (acc[vt][cc][2] * acc[vt][cc][2] + acc[vt][cc][3] * acc[vt][cc][3]);
            s += __shfl_xor(s, 16); s += __shfl_xor(s, 32); ssq[cc] = s; }
        if (type == 1 && g == 0) {
#pragma unroll
            for (int cc = 0; cc < 2; ++cc) exch[hd * 32 + 16 * cc + r] = ssq[cc]; }
        LBAR();
        float rstd[2];
#pragma unroll
        for (int cc = 0; cc < 2; ++cc) { if (type == 1) { const int c = 16 * cc + r; rstd[cc] = rsqrtf(((exch[c] + exch[32 + c]) + (exch[64 + c] + exch[96 + c])) * (1.f / 512.f) + 1e-6f); } else rstd[cc] = rsqrtf(ssq[cc] * (1.f / 128.f) + 1e-6f); }
#pragma unroll
        for (int vt = 0; vt < 8; ++vt) { const f32x4 w4 = *(const GAS f32x4*)(nw + 16 * vt + 4 * g);
#pragma unroll
            for (int cc = 0; cc < 2; ++cc) { const size_t off = (tok0 + 16 * (2 * cp + cc) + r) * 1024 + type * 512 + hd * 128 + 16 * vt + 4 * g;
                const f32x4 gt = unpack4(gtq[vt][cc]); f32x4 o;
#pragma unroll
                for (int e = 0; e < 4; ++e) o[e] = acc[vt][cc][e] * rstd[cc] * w4[e] * siluf_(gt[e]);
                *(GAS v2u*)(X.omix + off) = pack4(o); } }
        LBAR();
    }
}

struct Args { const float* in[23]; float* out; unsigned char* ws; int ph_lo, ph_hi, li, pad; };

__global__ void __launch_bounds__(NWAVES * 64, 2) mk_fwd(Args args) {
    extern __shared__ __attribute__((aligned(16))) unsigned char lds_raw[];
    LAS unsigned char* lds = (LAS unsigned char*)lds_raw;
    volatile LAS unsigned* MISC = (volatile LAS unsigned*)(lds + MISC_OFF);
    const int tid = threadIdx.x, lane = tid & 63, wave = __builtin_amdgcn_readfirstlane(tid >> 6);
    const int G = gridDim.x, bx = blockIdx.x, vcu = (G % 8 == 0) ? (bx % 8) * (G / 8) + bx / 8 : bx;
    const int gw = vcu * NWAVES + wave, NGW = G * NWAVES;
    unsigned char* ws = args.ws;
    gu32* ctl = (gu32*)(ws + WS_CTL);
    const float* x = args.in[0]; const float* cvec = args.in[1]; const float* w_ada = args.in[2]; const float* b_ada = args.in[3]; const float* norm1_w = args.in[4];
    const float* w_in = args.in[5]; const float* w_out = args.in[12];
    float* mod = (float*)(ws + WS_MOD); float* wab = (float*)(ws + WS_WAB); float* ab = (float*)(ws + WS_AB);
    bf16* wout_t = (bf16*)(ws + WS_WOUT_T); bf16* win_t = (bf16*)(ws + WS_WIN_T); bf16* h1 = (bf16*)(ws + WS_H1); bf16* projA = (bf16*)(ws + WS_PROJA); bf16* gates = (bf16*)(ws + WS_GATES);
    bf16* omix = (bf16*)(ws + WS_OMIX);
    bf16* h2 = (bf16*)(ws + WS_H2); bf16* w1t = (bf16*)(ws + WS_W1T); bf16* w2t = (bf16*)(ws + WS_W2T); bf16* act = (bf16*)(ws + WS_ACT); bf16* y0 = (bf16*)(ws + WS_Y0); bf16* y1 = (bf16*)(ws + WS_Y1);
    MixPtrs X; X.projA = projA; X.gates = gates; X.ab = ab; X.conv_w = args.in[6]; X.a_log = args.in[7]; X.dt_bias = args.in[8]; X.hg_lb = args.in[10]; X.gdn_nw = args.in[9]; X.hg_nw = args.in[11];
    X.PG = (bf16*)(ws + WS_PG); X.BG = (bf16*)(ws + WS_BG); X.QP = (bf16*)(ws + WS_QP); X.OI = (bf16*)(ws + WS_OI); X.BH = (bf16*)(ws + WS_BH); X.QE = (bf16*)(ws + WS_QE); X.OIH = (bf16*)(ws + WS_OIH);
    X.SG = (bf16*)args.out; X.SH = (bf16*)args.out + (size_t)UNITS * 16384; X.omix = omix; X.GL = (float*)(ws + WS_GL); X.AH = (float*)(ws + WS_AH);
    const int* list = (const int*)(ws + WS_LIST); const float* listw = (const float*)(ws + WS_LISTW);
    LAS unsigned* tb = (LAS unsigned*)(lds + SCR2_OFF);

    for (int u = tid; u < (LDS_BYTES - LDSCTL_OFF) / 4; u += NWAVES * 64) ((LAS unsigned*)(lds + LDSCTL_OFF))[u] = 0u;
    __syncthreads();
    XcdBarrier bar = xcd_barrier_post((unsigned*)(ctl + CW_BAR) + args.li * XCD_BAR_WORDS, MISC + 8);
    const int lo = args.ph_lo, hi = args.ph_hi;
#define IN(k) (lo <= (k) && (k) < hi)
#define BOTH(k) (IN(k) && IN((k) + 1))

    if (IN(0)) {
#define PH_BODY do { \
        if (bx < 96) { \
            LAS float* part = (LAS float*)(lds + RING_BYTES); \
            const int e = bx * 64 + lane; float a0 = 0.f, a1 = 0.f; \
_Pragma("unroll 32") \
            for (int d = wave * 128; d < wave * 128 + 128; ++d) { const float w = w_ada[(size_t)d * 6144 + e]; a0 += siluf_(cvec[d]) * w; a1 += siluf_(cvec[D + d]) * w; } \
            part[(wave * 2 + 0) * 64 + lane] = a0; part[(wave * 2 + 1) * 64 + lane] = a1; \
            __syncthreads(); \
            if (tid < 128) { const int bb = tid >> 6, l = tid & 63; float s = 0.f; \
_Pragma("unroll") \
                for (int w = 0; w < 8; ++w) s += part[(w * 2 + bb) * 64 + l]; \
                mod[bb * 6144 + bx * 64 + l] = s + b_ada[bx * 64 + l]; } \
        } else if (bx == 96) { \
            for (int idx = tid; idx < 8192; idx += NWAVES * 64) wab[idx] = w_in[(size_t)(idx >> 3) * DIN + 2048 + (idx & 7)]; \
        } \
        { const float* w_router = args.in[14]; bf16* wrhi = (bf16*)(ws + WS_WRHI); bf16* wrlo = (bf16*)(ws + WS_WRLO); \
          for (int k = gw; k < 1024; k += NGW) { const float w = w_router[k * 64 + lane]; const unsigned hi = f2bf(w); \
              wrhi[lane * 1024 + k] = (bf16)hi; wrlo[lane * 1024 + k] = (bf16)f2bf(w - __uint_as_float(hi << 16)); } } \
        LAS float* scr = (LAS float*)(lds + wave * 16384); \
        constexpr int I_IN = 16 * 128, I_OUT = 16 * 32; \
        auto mk0 = [&](int it) { TrItem t; if (it < I_IN) { const int kb = it / 128, n0 = 32 * (it % 128); const int sc_ = n0 < 1536 ? n0 : (n0 < 3072 ? n0 + 520 : (n0 < 3584 ? n0 - 1536 : n0 + 8)); \
                t.W = w_in; t.ldw = DIN; t.src_col = sc_; t.WT = win_t; t.K = D; t.dst_row = n0; t.k0 = 64 * kb; } \
            else { const int r = it - I_IN, kb = r / 32, n0 = 32 * (r % 32); t.W = w_out; t.ldw = D; t.src_col = n0; t.WT = wout_t; t.K = D; t.dst_row = n0; t.k0 = 64 * kb; } return t; }; \
        TR_LOOP(gw, NGW, I_IN + I_OUT, mk0); \
        if (BOTH(0)) xcd_barrier(bar); \
    } while (0)
        PH_BODY; if (REPN(0) > 1) { PH_BODY; PH_BODY; }
#undef PH_BODY
    }
    if (IN(1)) {
#define PH_BODY do { \
        { \
            const GAS f32x4* wab4 = (const GAS f32x4*)wab; \
            for (int idx = tid; idx < 2048; idx += NWAVES * 64) { const int d = idx >> 1, qh = idx & 1; *(LAS f32x4*)(lds + (((qh * 4 + (d & 3)) * 256 + (d >> 2)) * 16)) = wab4[idx]; } \
            __syncthreads(); \
            const int nrows = (M - gw + NGW - 1) / NGW; \
            f32x4 sclr[4], shfr[4]; int curb = -1; \
            f32x4 vn[2][4]; \
_Pragma("unroll") \
            for (int q = 0; q < 2; ++q) { const int m = gw + q * NGW; \
_Pragma("unroll") \
                for (int j = 0; j < 4; ++j) vn[q][j] = (q < nrows) ? ((const GAS f32x4*)(x + (size_t)m * D) + lane)[64 * j] : (f32x4){0.f, 0.f, 0.f, 0.f}; } \
_Pragma("unroll 1") \
            for (int p = 0; p < nrows; p += 2) { \
                f32x4 v[2][4]; \
_Pragma("unroll") \
                for (int q = 0; q < 2; ++q) \
_Pragma("unroll") \
                    for (int j = 0; j < 4; ++j) v[q][j] = vn[q][j]; \
_Pragma("unroll") \
                for (int q = 0; q < 2; ++q) { const int m = gw + (p + 2 + q) * NGW; \
                    if (p + 2 + q < nrows) { \
_Pragma("unroll") \
                        for (int j = 0; j < 4; ++j) vn[q][j] = ((const GAS f32x4*)(x + (size_t)m * D) + lane)[64 * j]; } } \
_Pragma("unroll") \
                for (int q = 0; q < 2; ++q) { const int m = gw + (p + q) * NGW; \
                    if (p + q < nrows) { \
                        float ss = 0.f; \
_Pragma("unroll") \
                        for (int j = 0; j < 4; ++j) ss += (v[q][j].x * v[q][j].x + v[q][j].y * v[q][j].y) + (v[q][j].z * v[q][j].z + v[q][j].w * v[q][j].w); \
                        const float rstd = rsqrtf(wave_sum(ss) * (1.f / D) + 1e-6f); \
                        const int bsel = m >= T ? 1 : 0; \
                        if (bsel != curb) { curb = bsel; const GAS f32x4* sh4 = (const GAS f32x4*)(mod + bsel * 6144) + lane; \
_Pragma("unroll") \
                            for (int j = 0; j < 4; ++j) { sclr[j] = ((const GAS f32x4*)norm1_w + lane)[64 * j] * (sh4[256 + 64 * j] + 1.0f); shfr[j] = sh4[64 * j]; } } \
                        GAS unsigned long long* o8 = (GAS unsigned long long*)(h1 + (size_t)m * D) + lane; \
                        f32x4 a0 = {0.f, 0.f, 0.f, 0.f}, a1 = {0.f, 0.f, 0.f, 0.f}; \
_Pragma("unroll") \
                        for (int j = 0; j < 4; ++j) { __builtin_amdgcn_sched_barrier(0); const f32x4 h = v[q][j] * rstd * sclr[j] + shfr[j]; \
                            o8[64 * j] = (unsigned long long)pk2(h.x, h.y) | ((unsigned long long)pk2(h.z, h.w) << 32); \
_Pragma("unroll") \
                            for (int i = 0; i < 4; ++i) { a0 += *(const LAS f32x4*)(lds + ((i * 256 + lane + 64 * j) * 16)) * h[i]; a1 += *(const LAS f32x4*)(lds + (((4 + i) * 256 + lane + 64 * j) * 16)) * h[i]; } } \
 \
                        const bool up5 = (lane & 32) != 0, up4 = (lane & 16) != 0, up3 = (lane & 8) != 0; \
                        f32x4 k4; \
_Pragma("unroll") \
                        for (int e = 0; e < 4; ++e) { const float snd = up5 ? a0[e] : a1[e]; k4[e] = (up5 ? a1[e] : a0[e]) + __shfl_xor(snd, 32); } \
                        float k2[2]; \
_Pragma("unroll") \
                        for (int e = 0; e < 2; ++e) { const float snd = up4 ? k4[e] : k4[2 + e]; k2[e] = (up4 ? k4[2 + e] : k4[e]) + __shfl_xor(snd, 16); } \
                        float k1; { const float snd = up3 ? k2[0] : k2[1]; k1 = (up3 ? k2[1] : k2[0]) + __shfl_xor(snd, 8); } \
                        k1 += __shfl_xor(k1, 4); k1 += __shfl_xor(k1, 2); k1 += __shfl_xor(k1, 1); \
                        if ((lane & 7) == 0) ab[(size_t)m * 8 + 4 * (lane >> 5) + 2 * ((lane >> 4) & 1) + ((lane >> 3) & 1)] = k1; \
                    } } \
            } \
            __syncthreads(); \
        } \
        if (BOTH(1)) xcd_barrier(bar); \
    } while (0)
        PH_BODY; if (REPN(1) > 1) { PH_BODY; PH_BODY; }
#undef PH_BODY
    }
    if (IN(2)) {
#define PH_BODY do { \
        pg8::Gemm g{h1, win_t, M, 4096, D}; pg8::StaticOrder S; S.init(M, 4096, G, (int)blockIdx.x); \
        pg8::EpiProj E{projA, gates}; \
        pg8::gemm_phase<pg8::EpiProj, pg8::StaticOrder, true, true>(lds, g, S, E); \
        if (BOTH(2)) xcd_barrier(bar); \
    } while (0)
        PH_BODY; if (REPN(2) > 1) { PH_BODY; PH_BODY; }
#undef PH_BODY
    }

    if (IN(3)) {
#define PH_BODY do { \
        for (int u = vcu; u < UNITS; u += G) p3_gdn_unit(lds, X, u, tid, lane, wave); \
        for (int u = vcu; u < UNITS; u += G) p3_hgrn_unit(lds, X, u, tid, lane, wave); \
        if (BOTH(3)) xcd_barrier(bar); \
    } while (0)
        PH_BODY; if (REPN(3) > 1) { PH_BODY; PH_BODY; }
#undef PH_BODY
    }
    if (IN(4)) {
#define PH_BODY do { \
        if (bx < 64) p4_gdn_scan(lds, X, bx, lane, wave); \
        else { \
            if (wave < 3 && (bx - 64) * 3 + wave < 512) p4_hgrn_scan(X, (bx - 64) * 3 + wave, lane); \
            LAS float* scr = (LAS float*)(lds + wave * 16384); \
            const float* w_gate = args.in[16]; const float* w_up = args.in[17]; const float* w_down = args.in[18]; const float* ws_gate = args.in[19]; const float* ws_up = args.in[20]; const float* ws_down = args.in[21]; \
            auto mk4 = [&](int it) { TrItem t; const int e = it / 384, r = it % 384; \
                if (r < 256) { const int up = r >> 7, q = r & 127, kb = q >> 3, n0 = 32 * (q & 7); \
                    t.W = e < NE ? (up ? w_up : w_gate) + (size_t)e * D * DE : (up ? ws_up : ws_gate); t.ldw = DE; t.src_col = n0; t.WT = w1t + (size_t)e * 512 * 1024; t.K = D; t.dst_row = (n0 >> 7) * 256 + up * 128 + (n0 & 127); t.k0 = 64 * kb; } \
                else { const int q = r - 256, kb = q >> 5, n0 = 32 * (q & 31); \
                    t.W = e < NE ? w_down + (size_t)e * DE * D : ws_down; t.ldw = D; t.src_col = n0; t.WT = w2t + (size_t)e * 1024 * 256; t.K = DE; t.dst_row = n0; t.k0 = 64 * kb; } return t; }; \
            TR_LOOP((bx - 64) * NWAVES + wave, (G - 64) * NWAVES, NEX * 384, mk4); \
        } \
        if (BOTH(4)) xcd_barrier(bar); \
    } while (0)
        PH_BODY; if (REPN(4) > 1) { PH_BODY; PH_BODY; }
#undef PH_BODY
    }
    if (IN(5)) {
#define PH_BODY do { \
        for (int bn = vcu; bn < BATCH * 128; bn += G) p5_unit(lds, X, bn, lane, wave); \
        if (BOTH(5)) xcd_barrier(bar); \
    } while (0)
        PH_BODY; if (REPN(5) > 1) { PH_BODY; PH_BODY; }
#undef PH_BODY
    }
    if (IN(6)) {
#define PH_BODY do { \
        pg8::Gemm g{omix, wout_t, M, D, D}; pg8::StaticOrder S; S.init(M, D, G, (int)blockIdx.x); \
        pg8::EpiResid E{x, mod, args.out}; \
        pg8::gemm_phase<pg8::EpiResid, pg8::StaticOrder, true, true>(lds, g, S, E); \
        if (BOTH(6)) xcd_barrier(bar); \
    } while (0)
        PH_BODY; if (REPN(6) > 1) { PH_BODY; PH_BODY; }
#undef PH_BODY
    }


    if (IN(7)) {
        constexpr int HS = 2064;
        constexpr int R_HI = 0, R_LO = 33024, R_PART = 66048, R_SC = 98816, R_SEL = 102912, R_CNT = 107008, R_BASE = 107520, R_ESE = 108032, R_ESL = 110080, R_EW = 112128, R_ELP = 114176;
        if (tid < 128) *(LAS unsigned*)(lds + R_CNT + tid * 4) = 0u;
        __syncthreads();
        int nu = 0;
        const float* norm2_w = args.in[13]; const float* rbias = args.in[15]; const bf16* wrhi = (const bf16*)(ws + WS_WRHI); const bf16* wrlo = (const bf16*)(ws + WS_WRLO);
        int* listo = (int*)(ws + WS_LIST); float* listwo = (float*)(ws + WS_LISTW);
        const int r = lane & 15, g = lane >> 4;
#pragma unroll 1
        for (int u = vcu; u < M / 16; u += G, ++nu) {
            f32x4 sclr[4], shfr[4];
            { const GAS f32x4* sh4 = (const GAS f32x4*)(mod + (16 * u >= T ? 6144 : 0) + 3072) + lane;
#pragma unroll
              for (int j = 0; j < 4; ++j) { sclr[j] = ((const GAS f32x4*)norm2_w + lane)[64 * j] * (sh4[256 + 64 * j] + 1.0f); shfr[j] = sh4[64 * j]; } }
#pragma unroll 1
            for (int q = 0; q < 2; ++q) { const int rl = 2 * wave + q, m = 16 * u + rl;
                const GAS f32x4* xr = (const GAS f32x4*)(args.out + (size_t)m * D) + lane;
                f32x4 v[4]; float ss = 0.f;
#pragma unroll
                for (int j = 0; j < 4; ++j) { v[j] = xr[64 * j]; ss += (v[j].x * v[j].x + v[j].y * v[j].y) + (v[j].z * v[j].z + v[j].w * v[j].w); }
                const float rstd = rsqrtf(wave_sum(ss) * (1.f / D) + 1e-6f);
                GAS unsigned long long* o8 = (GAS unsigned long long*)(h2 + (size_t)m * D) + lane;
#pragma unroll
                for (int j = 0; j < 4; ++j) { const f32x4 hv = v[j] * rstd * sclr[j] + shfr[j];
                    const unsigned h0 = f2bf(hv.x), h1_ = f2bf(hv.y), h2_ = f2bf(hv.z), h3 = f2bf(hv.w);
                    const unsigned long long hi = (unsigned long long)(h0 | (h1_ << 16)) | ((unsigned long long)(h2_ | (h3 << 16)) << 32);
                    o8[64 * j] = hi;
                    const unsigned long long lo = (unsigned long long)pk2(hv.x - __uint_as_float(h0 << 16), hv.y - __uint_as_float(h1_ << 16)) | ((unsigned long long)pk2(hv.z - __uint_as_float(h2_ << 16), hv.w - __uint_as_float(h3 << 16)) << 32);
                    *(LAS unsigned long long*)(lds + R_HI + rl * HS + (lane + 64 * j) * 8) = hi; *(LAS unsigned long long*)(lds + R_LO + rl * HS + (lane + 64 * j) * 8) = lo; } }
            __syncthreads();
            { f32x4 acc[4];
#pragma unroll
              for (int nt = 0; nt < 4; ++nt) acc[nt] = (f32x4){0.f, 0.f, 0.f, 0.f};
#pragma unroll
              for (int ks = 0; ks < 4; ++ks) { const int kb = (128 * wave + 32 * ks + 8 * g) * 2;
                  const bf16x8 ahi = *(const LAS bf16x8*)(lds + R_HI + r * HS + kb), alo = *(const LAS bf16x8*)(lds + R_LO + r * HS + kb);
#pragma unroll
                  for (int nt = 0; nt < 4; ++nt) { const size_t o = (size_t)(16 * nt + r) * 1024 + 128 * wave + 32 * ks + 8 * g; const bf16x8 bh = *(const GAS bf16x8*)(wrhi + o), bl = *(const GAS bf16x8*)(wrlo + o);
                      acc[nt] = mfma16(ahi, bh, acc[nt]); acc[nt] = mfma16(ahi, bl, acc[nt]); acc[nt] = mfma16(alo, bh, acc[nt]); } }
#pragma unroll
              for (int nt = 0; nt < 4; ++nt)
#pragma unroll
                  for (int ii = 0; ii < 4; ++ii) *(LAS float*)(lds + R_PART + ((wave * 16 + 4 * g + ii) * 64 + 16 * nt + r) * 4) = acc[nt][ii]; }
            __syncthreads();
#pragma unroll
            for (int q = 0; q < 2; ++q) { const int idx = tid + 512 * q; float s = 0.f;
#pragma unroll
                for (int w = 0; w < 8; ++w) s += *(const LAS float*)(lds + R_PART + (w * 1024 + idx) * 4);
                const float sc = sigmoidf_(s); *(LAS float*)(lds + R_SC + idx * 4) = sc; *(LAS float*)(lds + R_SEL + idx * 4) = sc + rbias[idx & 63]; }
            __syncthreads();
#pragma unroll 1
            for (int q = 0; q < 2; ++q) { const int rl = 2 * wave + q, m = 16 * u + rl;
                const float sel = *(const LAS float*)(lds + R_SEL + (rl * 64 + lane) * 4), score = *(const LAS float*)(lds + R_SC + (rl * 64 + lane) * 4);
                float m1 = sel; m1 = fmaxf(m1, __shfl_xor(m1, 1)); m1 = fmaxf(m1, __shfl_xor(m1, 2)); m1 = fmaxf(m1, __shfl_xor(m1, 4));
                const unsigned long long eq = __ballot(sel == m1) & (0xFFull << (lane & 56)); const int first = __ffsll((long long)eq) - 1;
                float m2 = (lane == first) ? -INFINITY : sel; m2 = fmaxf(m2, __shfl_xor(m2, 1)); m2 = fmaxf(m2, __shfl_xor(m2, 2)); m2 = fmaxf(m2, __shfl_xor(m2, 4));
                const float gs = m1 + m2; const int mygrp = lane >> 3; int grank = 0;
#pragma unroll
                for (int gg = 0; gg < 8; ++gg) { const float o = __shfl(gs, 8 * gg); grank += (o > gs || (o == gs && gg < mygrp)) ? 1 : 0; }
                const float msel = grank < 4 ? sel : -INFINITY; int erank = 0;
#pragma unroll
                for (int e2 = 0; e2 < 64; ++e2) { const float o = __shfl(msel, e2); erank += (o > msel || (o == msel && e2 < lane)) ? 1 : 0; }
                const bool chosen = grank < 4 && erank < 8;
                const float wsum = wave_sum(chosen ? score : 0.f);
                if (chosen && nu < 4) { const int se = (m >= T ? 64 : 0) + lane; const unsigned lp = __hip_atomic_fetch_add((LAS unsigned*)(lds + R_CNT + se * 4), 1u, __ATOMIC_RELAXED, __HIP_MEMORY_SCOPE_WORKGROUP);
                    const int ei = ((nu * 16 + rl) * 8 + erank) * 4;
                    *(LAS int*)(lds + R_ESE + ei) = se; *(LAS int*)(lds + R_ESL + ei) = m * 8 + erank; *(LAS float*)(lds + R_EW + ei) = score / wsum * 2.5f; *(LAS unsigned*)(lds + R_ELP + ei) = lp; } }
            __syncthreads();
            if (nu == 3 || u + G >= M / 16) {
                if (tid < 128) { const unsigned c = *(LAS unsigned*)(lds + R_CNT + tid * 4); *(LAS unsigned*)(lds + R_BASE + tid * 4) = c ? __hip_atomic_fetch_add(ctl + CW_CNT + 64 * tid, c, RLX_AGENT) : 0u; }
                __syncthreads();
                for (int idx = tid; idx < (nu + 1) * 128; idx += NWAVES * 64) { const int se = *(LAS int*)(lds + R_ESE + idx * 4); const unsigned pos = *(LAS unsigned*)(lds + R_BASE + se * 4) + *(LAS unsigned*)(lds + R_ELP + idx * 4);
                    if (pos < (unsigned)CAP) { listo[(size_t)se * CAP + pos] = *(LAS int*)(lds + R_ESL + idx * 4); listwo[(size_t)se * CAP + pos] = *(LAS float*)(lds + R_EW + idx * 4); } }
                __syncthreads();
                if (tid < 128) *(LAS unsigned*)(lds + R_CNT + tid * 4) = 0u;
                __syncthreads();
                nu = -1;
            }
        }
        if (BOTH(7)) xcd_barrier(bar);
    }
    if (lo <= 12 && hi > 8) {
        if (tid < 130) { const int hf = tid >= 65 ? 1 : 0, e = tid - 65 * hf; unsigned c = 8192u;
            if (e < 64) { c = __hip_atomic_load(ctl + CW_CNT + 64 * (hf * 64 + e), RLX_AGENT); c = c < (unsigned)CAP ? c : (unsigned)CAP; }
            tb[TB_CNT + tid] = c; }
        __syncthreads();
        if (tid == 0) { unsigned ro = 0; for (int s = 0; s < 130; ++s) { tb[TB_OFF + s] = ro; ro += tb[TB_CNT + s]; } }
        __syncthreads();
    }
#define MOE_PREFIX(lo_, hi_, NT_) do { __syncthreads(); if (tid == 0) { unsigned up = 0; for (int s = (lo_); s < (hi_); ++s) { tb[TB_PRE + s] = up; up += ((tb[TB_CNT + s] + 255u) >> 8) * (NT_); } tb[TB_PRE + (hi_)] = up; } __syncthreads(); } while (0)
    if (IN(8)) {
#define PH_BODY do { \
        MOE_PREFIX(0, 130, 2); \
        pg8::Moe1Prob P{D, pg8::MoeSched{tb, 0, 130, 2, G, vcu}, h2, w1t, list}; \
        pg8::EpiMoe1 E{act, tb}; \
        pg8::gemm_phase_g<pg8::Moe1Prob, pg8::EpiMoe1>(lds, P, E); \
        if (BOTH(8)) xcd_barrier(bar); \
    } while (0)
        PH_BODY; if (REPN(8) > 1) { PH_BODY; PH_BODY; }
#undef PH_BODY
    }
#pragma unroll 1
    for (int hf = 0; hf < 2; ++hf) {
        if (IN(9 + 2 * hf)) for (int rep_ = 0; rep_ < REPN(9 + 2 * hf); ++rep_) {
            MOE_PREFIX(65 * hf, 65 * hf + 65, 4);
            pg8::Moe2Prob P{DE, pg8::MoeSched{tb, 65 * hf, 65 * hf + 65, 4, G, vcu}, act, w2t, hf};
            pg8::EpiMoe2 E{y0, y1, args.out, mod, list, listw, tb, hf, rep_ == 0};
            pg8::gemm_phase_g<pg8::Moe2Prob, pg8::EpiMoe2>(lds, P, E);
            if (BOTH(9 + 2 * hf)) xcd_barrier(bar);
        }
        if (IN(10 + 2 * hf)) {
            const float* fw = args.in[22];
            const GAS f32x4* g24 = (const GAS f32x4*)(mod + hf * 6144 + 5120) + lane; const GAS f32x4* fw4 = (const GAS f32x4*)fw + lane;
            f32x4 g2r[4], fwr[4];
#pragma unroll
            for (int j = 0; j < 4; ++j) { g2r[j] = g24[64 * j]; fwr[j] = fw4[64 * j]; }
#pragma unroll 1
            for (int i0 = gw; i0 < 8192; i0 += 2 * NGW) {
                unsigned long long yq[2][8][4]; f32x4 xv[2][4];
#pragma unroll
                for (int q = 0; q < 2; ++q) { const int tl = (i0 + q * NGW < 8192) ? i0 + q * NGW : i0;
                    const GAS f32x4* xr = (const GAS f32x4*)(args.out + (size_t)(hf * 8192 + tl) * D) + lane;
                    const GAS unsigned long long* yr = (const GAS unsigned long long*)(tl < 4096 ? y0 + (size_t)tl * 8 * D : y1 + (size_t)(tl - 4096) * 8 * D) + lane;
#pragma unroll
                    for (int j = 0; j < 4; ++j) { xv[q][j] = xr[64 * j];
#pragma unroll
                        for (int k = 0; k < 8; ++k) yq[q][k][j] = yr[k * 256 + 64 * j]; } }
#pragma unroll
                for (int q = 0; q < 2; ++q) { const int tl = i0 + q * NGW;
                    if (tl < 8192) {
                        GAS f32x4* xr = (GAS f32x4*)(args.out + (size_t)(hf * 8192 + tl) * D) + lane;
                        f32x4 v[4]; float ss = 0.f;
#pragma unroll
                        for (int j = 0; j < 4; ++j) { f32x4 s = {0.f, 0.f, 0.f, 0.f};
#pragma unroll
                            for (int k = 0; k < 8; ++k) { const unsigned long long qq = yq[q][k][j]; const unsigned a = (unsigned)qq, bb = (unsigned)(qq >> 32);
                                s.x += __uint_as_float(a << 16); s.y += __uint_as_float(a & 0xffff0000u); s.z += __uint_as_float(bb << 16); s.w += __uint_as_float(bb & 0xffff0000u); }
                            v[j] = xv[q][j] + g2r[j] * s; ss += (v[j].x * v[j].x + v[j].y * v[j].y) + (v[j].z * v[j].z + v[j].w * v[j].w); }
                        const float rstd = rsqrtf(wave_sum(ss) * (1.f / D) + 1e-6f);
#pragma unroll
                        for (int j = 0; j < 4; ++j) xr[64 * j] = v[j] * rstd * fwr[j];
                    } }
            }
            if (BOTH(10 + 2 * hf)) xcd_barrier(bar);
        }
    }
#undef MOE_PREFIX
#undef IN
#undef BOTH
}

static void launch_mk(Args a, int lo, int hi, int li, int grid, hipStream_t stream) {
    a.ph_lo = lo; a.ph_hi = hi; a.li = li;
    hipLaunchKernelGGL(mk_fwd, dim3(grid), dim3(NWAVES * 64), LDS_BYTES, stream, a);
}
extern "C" void kernel_launch(void* const* d_in, const int* in_sizes, int n_in, void* d_out, int out_size, void* d_ws, size_t ws_size, hipStream_t stream) {
    static int grid = 0;
    if (grid == 0) {
        int dev = 0, cus = 0;
        if (hipGetDevice(&dev) != hipSuccess || hipDeviceGetAttribute(&cus, hipDeviceAttributeMultiprocessorCount, dev) != hipSuccess) { grid = -1; return; }
        if (hipFuncSetAttribute((const void*)mk_fwd, hipFuncAttributeMaxDynamicSharedMemorySize, LDS_BYTES) != hipSuccess) { grid = -1; return; }
        grid = cus;
    }
    if (grid < 0) return;
    unsigned char* ws = (unsigned char*)d_ws; float* out = (float*)d_out;
    (void)hipMemsetAsync(ws + WS_CTL, 0, CTL_ZERO_BYTES, stream);
    Args a{};
    for (int i = 0; i < 23; ++i) a.in[i] = (const float*)d_in[i];
    a.out = out; a.ws = ws;
    launch_mk(a, 0, 13, 0, grid, stream);
}
```

```cpp
#include <hip/hip_runtime.h>
#include <cstdio>
#include <cstdint>
namespace pg8 {
#define PG8_LAS __attribute__((address_space(3)))
typedef unsigned short bf16_t;
typedef short bf16x8 __attribute__((ext_vector_type(8)));
typedef float f32x4 __attribute__((ext_vector_type(4)));
typedef unsigned u32x4 __attribute__((ext_vector_type(4)));
constexpr int BM = 256, BK = 64, HALF = 128, HTB = HALF * BK * 2  , STAGE_BYTES = 8 * HTB, NXCD = 8, WGM = 8;

__host__ __device__ __forceinline__ int lds_byte(int r, int c) { const int st = (r >> 4) * 2 + (c >> 5), rr = r & 15, cc = c & 31, ob = rr * 64 + cc * 2; return st * 1024 + (ob ^ (((ob >> 9) & 1) << 5)); }
__host__ __device__ __forceinline__ void stage_rc(int b, int& R, int& C) { const int st = b / 1024, sb = b % 1024, swz = sb ^ (((sb >> 9) & 1) << 5); R = (st >> 1) * 16 + swz / 64; C = (st & 1) * 32 + (swz % 64) / 2; }
__host__ __device__ __forceinline__ int perm32(int rho) { const int n = rho >> 4, i = rho & 15; return 8 * (i >> 2) + 4 * n + (i & 3); }

struct Unit { int pm, pn; };
struct Gemm { const bf16_t* A; const bf16_t* Bt; int M, N, K; };

struct StaticOrder {
    int nM, nN, nwg, G, c;
    __host__ __device__ void init(int M, int N, int G_, int c_) { nM = M / BM; nN = N / BM; nwg = nM * nN; G = G_; c = c_; }
    __host__ __device__ bool next(int i, Unit& u) const {
        const long L = (long)i * G + c; if (L >= nwg) return false;
        int wgid = (int)L; { const int q = nwg / NXCD, r = nwg % NXCD, xcd = wgid % NXCD, off = wgid / NXCD; wgid = (xcd < r ? xcd * (q + 1) : r * (q + 1) + (xcd - r) * q) + off; }
        const int nig = WGM * nN, gid = wgid / nig, fm = gid * WGM, gsz = (nM - fm) < WGM ? (nM - fm) : WGM;
        u.pm = fm + ((wgid % nig) % gsz); u.pn = (wgid % nig) / gsz; return true;
    }
    __device__ __forceinline__ void a_ready(const Unit&) const {}
    __device__ __forceinline__ void done(const Unit&) const {}
};
__device__ __forceinline__ unsigned cvt_pk_bf16(float lo, float hi) { unsigned r; asm volatile("v_cvt_pk_bf16_f32 %0, %1, %2" : "=v"(r) : "v"(lo), "v"(hi)); return r; }
template <class Epi, class Sched, bool ALIGN_EPI = false, bool SP2 = false>
__device__ __forceinline__ void gemm_phase(PG8_LAS unsigned char* lds, const Gemm g, const Sched& S, const Epi& E) {
    const int tid = threadIdx.x, wid = __builtin_amdgcn_readfirstlane(tid >> 6), lane = tid & 63, wr = wid >> 2, wc = wid & 3, fr = lane & 15, fq = lane >> 4;
    const int K = g.K, nt = K / BK;
    unsigned voffA[2], voffB[2];
#pragma unroll
    for (int i = 0; i < 2; ++i) { int R, C; stage_rc(tid * 16 + i * 8192, R, C); const int Rb = Epi::PERM ? ((R & ~31) + perm32(R & 31)) : R;
        voffA[i] = (unsigned)(R * K + C) * 2u; voffB[i] = (unsigned)(Rb * K + C) * 2u; }
    const size_t kstep = (size_t)(BK * 2);
    const size_t hstep = (size_t)HALF * K * 2;
    const size_t tstep = 2 * hstep;
    const unsigned ldsw = (unsigned)wid * 1024u;
    const int aoff = lds_byte(wr * 64 + fr, fq * 8), boff = lds_byte(wc * 32 + fr, fq * 8);
#define PG8_SA(b, h) (((b) * 2 + (h)) * HTB)
#define PG8_SB(b, h) ((4 + (b) * 2 + (h)) * HTB)
#define PG8_STAGE(bufoff, gbase, voff) do { _Pragma("unroll") for (int _i = 0; _i < 2; ++_i) \
        __builtin_amdgcn_global_load_lds((const unsigned*)((const char*)(gbase) + (voff)[_i]), (PG8_LAS unsigned*)(lds + (bufoff) + ldsw + _i * 8192), 16, 0, 0); } while (0)
#define PG8_LDA(dst, b, h) do { _Pragma("unroll") for (int m = 0; m < 4; ++m) _Pragma("unroll") for (int k = 0; k < 2; ++k) dst[m][k] = *(const PG8_LAS bf16x8*)(lds + PG8_SA(b, h) + aoff + m * 2048 + k * 1024); } while (0)
#define PG8_LDB(dst, b, h) do { _Pragma("unroll") for (int n = 0; n < 2; ++n) _Pragma("unroll") for (int k = 0; k < 2; ++k) dst[n][k] = *(const PG8_LAS bf16x8*)(lds + PG8_SB(b, h) + boff + n * 2048 + k * 1024); } while (0)
#define PG8_MMA(ai, bj, At, Bt) do { __builtin_amdgcn_s_setprio(1); _Pragma("unroll") for (int m = 0; m < 4; ++m) _Pragma("unroll") for (int n = 0; n < 2; ++n) _Pragma("unroll") for (int k = 0; k < 2; ++k) \
        acc[ai][bj][m][n] = __builtin_amdgcn_mfma_f32_16x16x32_bf16(Bt[n][k], At[m][k], acc[ai][bj][m][n], 0, 0, 0); __builtin_amdgcn_s_setprio(0); } while (0)
#define PG8_WAIT_V(n) asm volatile("s_waitcnt vmcnt(" #n ")" ::: "memory")
#define PG8_WAIT_L(n) asm volatile("s_waitcnt lgkmcnt(" #n ")" ::: "memory")
#define PG8_BAR __builtin_amdgcn_s_barrier()
#define PG8_SCHED __builtin_amdgcn_sched_barrier(0)
    Unit cur, nxt; int ui = 0;
    if (!S.next(0, cur)) return;
    f32x4 acc[2][2][4][2];
#pragma unroll
    for (int a = 0; a < 2; ++a)
#pragma unroll
        for (int b = 0; b < 2; ++b)
#pragma unroll
            for (int m = 0; m < 4; ++m)
#pragma unroll
                for (int n = 0; n < 2; ++n) acc[a][b][m][n] = (f32x4){0.f, 0.f, 0.f, 0.f};
    bf16x8 At[4][2], B0[2][2], B1[2][2];
    const char* cA = (const char*)g.A + (size_t)cur.pm * tstep; const char* cB = (const char*)g.Bt + (size_t)cur.pn * tstep;
    S.a_ready(cur);
    if constexpr (SP2) {
        PG8_STAGE(PG8_SB(0, 0), cB, voffB); PG8_STAGE(PG8_SB(0, 1), cB + hstep, voffB); PG8_STAGE(PG8_SA(0, 0), cA, voffA); PG8_STAGE(PG8_SA(0, 1), cA + hstep, voffA);
        if (wr == 1) PG8_BAR;
        PG8_WAIT_V(2); PG8_BAR;
        PG8_STAGE(PG8_SB(1, 0), cB + kstep, voffB); PG8_STAGE(PG8_SA(1, 0), cA + kstep, voffA); PG8_STAGE(PG8_SB(1, 1), cB + hstep + kstep, voffB);
        PG8_WAIT_V(6); PG8_BAR;
    } else {
        PG8_STAGE(PG8_SB(0, 0), cB, voffB); PG8_STAGE(PG8_SA(0, 0), cA, voffA); PG8_STAGE(PG8_SB(0, 1), cB + hstep, voffB); PG8_STAGE(PG8_SA(0, 1), cA + hstep, voffA);
        if (wr == 1) PG8_BAR;
        PG8_WAIT_V(4); PG8_BAR;
        PG8_STAGE(PG8_SB(1, 0), cB + kstep, voffB); PG8_STAGE(PG8_SA(1, 0), cA + kstep, voffA); PG8_STAGE(PG8_SB(1, 1), cB + hstep + kstep, voffB);
        PG8_WAIT_V(6); PG8_BAR;
    }
    for (;;) {
        const bool has_next = S.next(ui + 1, nxt);
        const char* nA = has_next ? (const char*)g.A + (size_t)nxt.pm * tstep : cA; const char* nB = has_next ? (const char*)g.Bt + (size_t)nxt.pn * tstep : cB;
        for (int t = 0; t < nt; t += 2) {
            const bool last = (t == nt - 2);
            const char* a1 = cA + (size_t)(t + 1) * kstep;
            const char* a2 = last ? nA : cA + (size_t)(t + 2) * kstep; const char* b2 = last ? nB : cB + (size_t)(t + 2) * kstep;
            const char* a3 = a2 + kstep; const char* b3 = b2 + kstep;
            if (last && has_next) S.a_ready(nxt);
            if constexpr (SP2) {
            PG8_LDB(B0, 0, 0); PG8_LDB(B1, 0, 1); PG8_SCHED; PG8_LDA(At, 0, 0); PG8_STAGE(PG8_SA(1, 1), a1 + hstep, voffA);
            PG8_WAIT_V(8); PG8_WAIT_L(0); PG8_BAR; PG8_MMA(0, 0, At, B0); PG8_MMA(0, 1, At, B1); PG8_BAR; PG8_SCHED;
            PG8_LDA(At, 0, 1); PG8_STAGE(PG8_SB(0, 0), b2, voffB); PG8_STAGE(PG8_SB(0, 1), b2 + hstep, voffB); PG8_STAGE(PG8_SA(0, 0), a2, voffA);
            PG8_WAIT_V(8); PG8_WAIT_L(0); PG8_BAR; PG8_MMA(1, 0, At, B0); PG8_MMA(1, 1, At, B1); PG8_BAR; PG8_SCHED;
            PG8_LDB(B0, 1, 0); PG8_LDB(B1, 1, 1); PG8_SCHED; PG8_LDA(At, 1, 0); PG8_STAGE(PG8_SA(0, 1), a2 + hstep, voffA);
            PG8_WAIT_V(8); PG8_WAIT_L(0); PG8_BAR; PG8_MMA(0, 0, At, B0); PG8_MMA(0, 1, At, B1); PG8_BAR; PG8_SCHED;
            PG8_LDA(At, 1, 1); PG8_STAGE(PG8_SB(1, 0), b3, voffB); PG8_STAGE(PG8_SB(1, 1), b3 + hstep, voffB); PG8_STAGE(PG8_SA(1, 0), a3, voffA);
            PG8_WAIT_V(8); PG8_WAIT_L(0); PG8_BAR; PG8_MMA(1, 0, At, B0); PG8_MMA(1, 1, At, B1); PG8_BAR; PG8_SCHED;
            } else {
            PG8_LDB(B0, 0, 0); PG8_SCHED; PG8_LDA(At, 0, 0); PG8_STAGE(PG8_SA(1, 1), a1 + hstep, voffA);
            PG8_WAIT_L(8); PG8_BAR; PG8_WAIT_L(0); PG8_MMA(0, 0, At, B0); PG8_BAR; PG8_SCHED;
            PG8_LDB(B1, 0, 1); PG8_STAGE(PG8_SB(0, 0), b2, voffB);
            PG8_BAR; PG8_WAIT_L(0); PG8_MMA(0, 1, At, B1); PG8_BAR;
            PG8_LDA(At, 0, 1); PG8_STAGE(PG8_SA(0, 0), a2, voffA);
            PG8_BAR; PG8_WAIT_L(0); PG8_MMA(1, 0, At, B0); PG8_BAR; PG8_SCHED;
            PG8_STAGE(PG8_SB(0, 1), b2 + hstep, voffB);
            PG8_WAIT_V(6); PG8_BAR; PG8_MMA(1, 1, At, B1); PG8_BAR;
            PG8_LDB(B0, 1, 0); PG8_SCHED; PG8_LDA(At, 1, 0); PG8_STAGE(PG8_SA(0, 1), a2 + hstep, voffA);
            PG8_WAIT_L(8); PG8_BAR; PG8_WAIT_L(0); PG8_MMA(0, 0, At, B0); PG8_BAR; PG8_SCHED;
            PG8_LDB(B1, 1, 1); PG8_STAGE(PG8_SB(1, 0), b3, voffB);
            PG8_BAR; PG8_WAIT_L(0); PG8_MMA(0, 1, At, B1); PG8_BAR;
            PG8_LDA(At, 1, 1); PG8_STAGE(PG8_SA(1, 0), a3, voffA);
            PG8_BAR; PG8_WAIT_L(0); PG8_MMA(1, 0, At, B0); PG8_BAR; PG8_SCHED;
            PG8_STAGE(PG8_SB(1, 1), b3 + hstep, voffB);
            PG8_WAIT_V(6); PG8_BAR; PG8_MMA(1, 1, At, B1); PG8_BAR;
            }
        }
        if constexpr (ALIGN_EPI) { if (wr == 0) PG8_BAR; }
        if constexpr (!Epi::AFTER_DRAIN) { E(acc, cur, wr, wc, fr, fq); S.done(cur); }
        if (!has_next) break;
#pragma unroll
        for (int a = 0; a < 2; ++a)
#pragma unroll
            for (int b = 0; b < 2; ++b)
#pragma unroll
                for (int m = 0; m < 4; ++m)
#pragma unroll
                    for (int n = 0; n < 2; ++n) acc[a][b][m][n] = (f32x4){0.f, 0.f, 0.f, 0.f};
        cur = nxt; cA = nA; cB = nB; ++ui;
        if constexpr (ALIGN_EPI) { if (wr == 1) PG8_BAR; }
    }
    PG8_WAIT_V(0);
    if constexpr (!ALIGN_EPI) { if (wr == 0) PG8_BAR; }
    PG8_BAR;
    if constexpr (Epi::AFTER_DRAIN) { E.fused(acc, cur, wr, wc, fr, fq, lds, wid, lane); S.done(cur); }
#undef PG8_SA
#undef PG8_SB
#undef PG8_STAGE
#undef PG8_LDA
#undef PG8_LDB
#undef PG8_MMA
#undef PG8_WAIT_V
#undef PG8_WAIT_L
#undef PG8_BAR
#undef PG8_SCHED
}
}
#define GAS __attribute__((address_space(1)))
#define LAS __attribute__((address_space(3)))
typedef unsigned short bf16;
typedef unsigned v4u __attribute__((ext_vector_type(4)));
typedef float f32x4 __attribute__((ext_vector_type(4)));
typedef short bf16x8 __attribute__((ext_vector_type(8)));
typedef GAS unsigned gu32;
typedef GAS unsigned long long gu64;
#define RLX_AGENT __ATOMIC_RELAXED, __HIP_MEMORY_SCOPE_AGENT
#define LDS_WAIT() asm volatile("s_waitcnt lgkmcnt(0)" ::: "memory")
#define VM_WAIT() asm volatile("s_waitcnt vmcnt(0)" ::: "memory")
__device__ __forceinline__ unsigned long long rt() { return __builtin_amdgcn_s_memrealtime(); }
__device__ __forceinline__ unsigned f2bf(float f) { unsigned u = __builtin_bit_cast(unsigned, f); return (u + 0x7fffu + ((u >> 16) & 1u)) >> 16; }
__device__ __forceinline__ unsigned pk2(float lo, float hi) { return f2bf(lo) | (f2bf(hi) << 16); }
#define XB_TMO      128
#define XB_XCNT(j)  (256  + 64 * (j))
#define XB_XSUB(j)  (1280 + 64 * (j))
#define XB_XGEN(j)  (2304 + 64 * (j))
#define XB_TOP      3328
#define XB_TOPGEN   3392
#define XCD_BAR_WORDS 3456
#define XB_SPIN_CAP (1u << 18)

__device__ __forceinline__ unsigned xb_ld(unsigned* p)              { return __hip_atomic_load(p, __ATOMIC_RELAXED, __HIP_MEMORY_SCOPE_AGENT); }
__device__ __forceinline__ unsigned xb_add(unsigned* p, unsigned v) { return __hip_atomic_fetch_add(p, v, __ATOMIC_RELAXED, __HIP_MEMORY_SCOPE_AGENT); }
__device__ __forceinline__ unsigned xb_xcc_id() { return (unsigned)__builtin_amdgcn_s_getreg((3 << 11) | 20) & 0xFu; }
#define XB_SPIN(cond, bar) do { unsigned _sp = 0; while (cond) { __builtin_amdgcn_s_sleep(1); \
    if ((++_sp & 255u) == 0u) { if (xb_ld(&(bar)[XB_TMO])) break; if (_sp > XB_SPIN_CAP) { atomicAdd(&(bar)[XB_TMO], 1u); break; } } } } while (0)

struct XcdBarrier {
    unsigned* bar; unsigned x;
    volatile LAS unsigned* st;
};

__device__ __forceinline__ XcdBarrier xcd_barrier_post(unsigned* bar, volatile LAS unsigned* st) {
    XcdBarrier b; b.bar = bar; b.x = xb_xcc_id(); b.st = st;
    if (threadIdx.x == 0) (void)xb_add(&bar[XB_XCNT(b.x)], 1u);
    return b;
}
__device__ __forceinline__ void xcd_barrier_complete(unsigned* bar, unsigned x, unsigned& nloc, unsigned& nx) {
    const unsigned G = gridDim.x * gridDim.y * gridDim.z;
    unsigned sum, cnt, mine, sp = 0u;
    for (;;) {
        sum = 0u; cnt = 0u; mine = 0u;
#pragma unroll
        for (unsigned j = 0; j < 16; ++j) { const unsigned c = xb_ld(&bar[XB_XCNT(j)]); sum += c; cnt += (c > 0u) ? 1u : 0u; mine = (j == x) ? c : mine; }
        if (sum == G) break;
        __builtin_amdgcn_s_sleep(1);
        if ((++sp & 255u) == 0u) { if (xb_ld(&bar[XB_TMO])) break; if (sp > XB_SPIN_CAP) { atomicAdd(&bar[XB_TMO], 1u); break; } }
    }
    nloc = mine > 0u ? mine : 1u; nx = cnt > 0u ? cnt : 1u;
}

__device__ __forceinline__ void xcd_barrier(const XcdBarrier& b) {
    asm volatile("s_waitcnt vmcnt(0)" ::: "memory");
    __syncthreads();
    if (threadIdx.x == 0) {
        unsigned* bar = b.bar;
        __builtin_amdgcn_s_waitcnt(0);
        unsigned nloc = b.st[0], nx = b.st[1];
        if (nloc == 0u) { xcd_barrier_complete(bar, b.x, nloc, nx); b.st[0] = nloc; b.st[1] = nx; }
        const unsigned old = xb_add(&bar[XB_XSUB(b.x)], 1u);
        const unsigned gen = old / nloc;
        if (old + 1u == (gen + 1u) * nloc) {
            __builtin_amdgcn_fence(__ATOMIC_RELEASE, "agent");
            asm volatile("s_waitcnt vmcnt(0)" ::: "memory");
            const unsigned og = xb_add(&bar[XB_TOP], 1u);
            const unsigned tg = og / nx;
            if (og + 1u == (tg + 1u) * nx) xb_add(&bar[XB_TOPGEN], 1u);
            else XB_SPIN(xb_ld(&bar[XB_TOPGEN]) == tg, bar);
            __builtin_amdgcn_fence(__ATOMIC_ACQUIRE, "agent");
            xb_add(&bar[XB_XGEN(b.x)], 1u);
            asm volatile("s_waitcnt vmcnt(0)" ::: "memory");
        } else {
            XB_SPIN(xb_ld(&bar[XB_XGEN(b.x)]) == gen, bar);
            __builtin_amdgcn_fence(__ATOMIC_ACQUIRE, "agent");
            asm volatile("s_waitcnt vmcnt(0)" ::: "memory");
        }
    }
    __syncthreads();
}

namespace pg8 {
struct UnitG { int seg, mt, nt; };
template <class Prob, class Epi>
__device__ __forceinline__ void gemm_phase_g(PG8_LAS unsigned char* lds, const Prob& P, const Epi& E) {
    const int tid = threadIdx.x, wid = __builtin_amdgcn_readfirstlane(tid >> 6), lane = tid & 63, wr = wid >> 2, wc = wid & 3, fr = lane & 15, fq = lane >> 4;
    const int K = P.K, nt = K / BK;
    int sR[2], sC[2]; unsigned voffB[2];
#pragma unroll
    for (int i = 0; i < 2; ++i) { int R, C; stage_rc(tid * 16 + i * 8192, R, C); const int Rb = Epi::PERM ? ((R & ~31) + perm32(R & 31)) : R; sR[i] = R; sC[i] = C; voffB[i] = (unsigned)(Rb * K + C) * 2u; }
    const size_t kstep = (size_t)(BK * 2);
    const size_t hstep = (size_t)HALF * K * 2;
    const unsigned ldsw = (unsigned)wid * 1024u;
    const int aoff = lds_byte(wr * 64 + fr, fq * 8), boff = lds_byte(wc * 32 + fr, fq * 8);
#define PG8_SA(b, h) (((b) * 2 + (h)) * HTB)
#define PG8_SB(b, h) ((4 + (b) * 2 + (h)) * HTB)
#define PG8_STAGE(bufoff, gbase, voff) do { _Pragma("unroll") for (int _i = 0; _i < 2; ++_i) \
        __builtin_amdgcn_global_load_lds((const unsigned*)((const char*)(gbase) + (voff)[_i]), (PG8_LAS unsigned*)(lds + (bufoff) + ldsw + _i * 8192), 16, 0, 0); } while (0)
#define PG8_LDA(dst, b, h) do { _Pragma("unroll") for (int m = 0; m < 4; ++m) _Pragma("unroll") for (int k = 0; k < 2; ++k) dst[m][k] = *(const PG8_LAS bf16x8*)(lds + PG8_SA(b, h) + aoff + m * 2048 + k * 1024); } while (0)
#define PG8_LDB(dst, b, h) do { _Pragma("unroll") for (int n = 0; n < 2; ++n) _Pragma("unroll") for (int k = 0; k < 2; ++k) dst[n][k] = *(const PG8_LAS bf16x8*)(lds + PG8_SB(b, h) + boff + n * 2048 + k * 1024); } while (0)
#define PG8_MMA(ai, bj, At, Bt) do { __builtin_amdgcn_s_setprio(1); _Pragma("unroll") for (int m = 0; m < 4; ++m) _Pragma("unroll") for (int n = 0; n < 2; ++n) _Pragma("unroll") for (int k = 0; k < 2; ++k) \
        acc[ai][bj][m][n] = __builtin_amdgcn_mfma_f32_16x16x32_bf16(Bt[n][k], At[m][k], acc[ai][bj][m][n], 0, 0, 0); __builtin_amdgcn_s_setprio(0); } while (0)
#define PG8_WAIT_V(n) asm volatile("s_waitcnt vmcnt(" #n ")" ::: "memory")
#define PG8_WAIT_L(n) asm volatile("s_waitcnt lgkmcnt(" #n ")" ::: "memory")
#define PG8_BAR __builtin_amdgcn_s_barrier()
#define PG8_SCHED __builtin_amdgcn_sched_barrier(0)
    UnitG cur, nxt; int ui = 0;
    if (!P.next(0, cur)) return;
    f32x4 acc[2][2][4][2];
#pragma unroll
    for (int a = 0; a < 2; ++a)
#pragma unroll
        for (int b = 0; b < 2; ++b)
#pragma unroll
            for (int m = 0; m < 4; ++m)
#pragma unroll
                for (int n = 0; n < 2; ++n) acc[a][b][m][n] = (f32x4){0.f, 0.f, 0.f, 0.f};
    bf16x8 At[4][2], B0[2][2], B1[2][2];
    unsigned offA[2][2], offAn[2][2];
    const char* cA; const char* cB;
    P.setup(cur, sR, sC, cA, offA, cB);
    PG8_STAGE(PG8_SB(0, 0), cB, voffB); PG8_STAGE(PG8_SB(0, 1), cB + hstep, voffB); PG8_STAGE(PG8_SA(0, 0), cA, offA[0]); PG8_STAGE(PG8_SA(0, 1), cA, offA[1]);
    if (wr == 1) PG8_BAR;
    PG8_WAIT_V(2); PG8_BAR;
    PG8_STAGE(PG8_SB(1, 0), cB + kstep, voffB); PG8_STAGE(PG8_SA(1, 0), cA + kstep, offA[0]); PG8_STAGE(PG8_SB(1, 1), cB + hstep + kstep, voffB);
    PG8_WAIT_V(6); PG8_BAR;
    for (;;) {
        const bool has_next = P.next(ui + 1, nxt);
        const char* nA = cA; const char* nB = cB;
#pragma unroll
        for (int h = 0; h < 2; ++h)
#pragma unroll
            for (int i = 0; i < 2; ++i) offAn[h][i] = offA[h][i];
        if (has_next) P.setup(nxt, sR, sC, nA, offAn, nB);
        for (int t = 0; t < nt; t += 2) {
            const bool last = (t == nt - 2);
            const char* a1 = cA + (size_t)(t + 1) * kstep;
            const char* a2 = last ? nA : cA + (size_t)(t + 2) * kstep; const char* b2 = last ? nB : cB + (size_t)(t + 2) * kstep;
            const char* a3 = a2 + kstep; const char* b3 = b2 + kstep;
            unsigned o2[2][2];
#pragma unroll
            for (int h = 0; h < 2; ++h)
#pragma unroll
                for (int i = 0; i < 2; ++i) o2[h][i] = last ? offAn[h][i] : offA[h][i];
            PG8_LDB(B0, 0, 0); PG8_LDB(B1, 0, 1); PG8_SCHED; PG8_LDA(At, 0, 0); PG8_STAGE(PG8_SA(1, 1), a1, offA[1]);
            PG8_WAIT_V(8); PG8_WAIT_L(0); PG8_BAR; PG8_MMA(0, 0, At, B0); PG8_MMA(0, 1, At, B1); PG8_BAR; PG8_SCHED;
            PG8_LDA(At, 0, 1); PG8_STAGE(PG8_SB(0, 0), b2, voffB); PG8_STAGE(PG8_SB(0, 1), b2 + hstep, voffB); PG8_STAGE(PG8_SA(0, 0), a2, o2[0]);
            PG8_WAIT_V(8); PG8_WAIT_L(0); PG8_BAR; PG8_MMA(1, 0, At, B0); PG8_MMA(1, 1, At, B1); PG8_BAR; PG8_SCHED;
            PG8_LDB(B0, 1, 0); PG8_LDB(B1, 1, 1); PG8_SCHED; PG8_LDA(At, 1, 0); PG8_STAGE(PG8_SA(0, 1), a2, o2[1]);
            PG8_WAIT_V(8); PG8_WAIT_L(0); PG8_BAR; PG8_MMA(0, 0, At, B0); PG8_MMA(0, 1, At, B1); PG8_BAR; PG8_SCHED;
            PG8_LDA(At, 1, 1); PG8_STAGE(PG8_SB(1, 0), b3, voffB); PG8_STAGE(PG8_SB(1, 1), b3 + hstep, voffB); PG8_STAGE(PG8_SA(1, 0), a3, o2[0]);
            PG8_WAIT_V(8); PG8_WAIT_L(0); PG8_BAR; PG8_MMA(1, 0, At, B0); PG8_MMA(1, 1, At, B1); PG8_BAR; PG8_SCHED;
        }
        if (wr == 0) PG8_BAR;
        E(acc, cur, wr, wc, fr, fq);
        if (!has_next) break;
#pragma unroll
        for (int a = 0; a < 2; ++a)
#pragma unroll
            for (int b = 0; b < 2; ++b)
#pragma unroll
                for (int m = 0; m < 4; ++m)
#pragma unroll
                    for (int n = 0; n < 2; ++n) acc[a][b][m][n] = (f32x4){0.f, 0.f, 0.f, 0.f};
        cur = nxt; cA = nA; cB = nB; ++ui;
#pragma unroll
        for (int h = 0; h < 2; ++h)
#pragma unroll
            for (int i = 0; i < 2; ++i) offA[h][i] = offAn[h][i];
        if (wr == 1) PG8_BAR;
    }
    PG8_WAIT_V(0);
    PG8_BAR;
#undef PG8_SA
#undef PG8_SB
#undef PG8_STAGE
#undef PG8_LDA
#undef PG8_LDB
#undef PG8_MMA
#undef PG8_WAIT_V
#undef PG8_WAIT_L
#undef PG8_BAR
#undef PG8_SCHED
}
}

constexpr int NWAVES = 8;
constexpr int BATCH = 2, T = 8192, D = 1024, M = BATCH * T, DIN = 4104, PA = 3072;
constexpr int NE = 64, NEX = 65, DE = 256;
constexpr size_t MiB = 1u << 20;
constexpr size_t WS_CTL = 0, CTL_ZERO_BYTES = 256 * 1024;
constexpr size_t WS_WRHI = 512 * 1024, WS_WRLO = 640 * 1024;
constexpr size_t WS_MOD = 1 * MiB, WS_WAB = 1 * MiB + 256 * 1024, WS_AB = 1 * MiB + 512 * 1024;
constexpr size_t WS_WOUT_T = 2 * MiB, WS_WIN_T = 4 * MiB, WS_H1 = 12 * MiB, WS_PROJA = 44 * MiB, WS_GATES = 142 * MiB;
constexpr size_t WS_QP = 4 * MiB, WS_OI = 20 * MiB, WS_AH = 36 * MiB, WS_GL = 36 * MiB + 512 * 1024, WS_PG = 174 * MiB, WS_BG = 206 * MiB, WS_BH = 238 * MiB, WS_QE = 270 * MiB, WS_OIH = 286 * MiB;
constexpr size_t WS_OMIX = 174 * MiB;
constexpr size_t WS_H2 = 12 * MiB, WS_W1T = 44 * MiB, WS_W2T = 109 * MiB, WS_ACT = 142 * MiB, WS_LIST = 215 * MiB, WS_LISTW = 217 * MiB, WS_Y0 = 12 * MiB, WS_Y1 = 219 * MiB;
constexpr size_t WS_TOP = 302 * MiB;
constexpr int CAP = 4096;
constexpr int TB_PRE = 0, TB_CNT = 132, TB_OFF = 264;
constexpr int CW_CNT = 16384;
constexpr int CW_BAR = 4096;
constexpr int RING_BYTES = 131072, LDS_BYTES = 147456, LDSCTL_OFF = LDS_BYTES - 1024, MISC_OFF = LDSCTL_OFF + 320, SCR2_OFF = LDS_BYTES - 3072;

__device__ __forceinline__ float bf2f(bf16 v) { return __uint_as_float(((unsigned)v) << 16); }
__device__ __forceinline__ float sigmoidf_(float x) { return 1.f / (1.f + __expf(-x)); }
__device__ __forceinline__ float siluf_(float x) { return x / (1.f + __expf(-x)); }
__device__ __forceinline__ float softplusf_(float x) { return x > 20.f ? x : log1pf(expf(x)); }
__device__ __forceinline__ float wave_sum(float v) {
#pragma unroll
    for (int o = 1; o < 64; o <<= 1) v += __shfl_xor(v, o);
    return v;
}

namespace pg8 {
struct EpiProj {
    static constexpr bool PERM = true, AFTER_DRAIN = false;
    bf16_t* projA; bf16_t* gates;
    __device__ __forceinline__ void operator()(const f32x4 (&acc)[2][2][4][2], const Unit& u, int wr, int wc, int fr, int fq) const {
        const int row0 = u.pm * BM + wr * 64 + fr;
        bf16_t* base; int ldc, colt;
        if (u.pn < 12) { base = projA; ldc = 3072; colt = u.pn * BM; } else { base = gates; ldc = 1024; colt = (u.pn - 12) * BM; }
        const int col0 = colt + wc * 32 + 8 * fq;
#pragma unroll
        for (int ai = 0; ai < 2; ++ai)
#pragma unroll
            for (int m = 0; m < 4; ++m) { bf16_t* rowp = base + (size_t)(row0 + ai * HALF + m * 16) * ldc + col0;
#pragma unroll
                for (int bj = 0; bj < 2; ++bj) { const f32x4 v0 = acc[ai][bj][m][0], v1 = acc[ai][bj][m][1];
                    u32x4 w; w.x = cvt_pk_bf16(v0[0], v0[1]); w.y = cvt_pk_bf16(v0[2], v0[3]); w.z = cvt_pk_bf16(v1[0], v1[1]); w.w = cvt_pk_bf16(v1[2], v1[3]);
                    *(u32x4*)(rowp + bj * HALF) = w; } }
    }
};
struct EpiResid {
    static constexpr bool PERM = false, AFTER_DRAIN = false;
    const float* x; const float* mod; float* out;
    __device__ __forceinline__ void operator()(const f32x4 (&acc)[2][2][4][2], const Unit& u, int wr, int wc, int fr, int fq) const {
        const int col0 = u.pn * BM + wc * 32 + 4 * fq;
#pragma unroll
        for (int ai = 0; ai < 2; ++ai)
#pragma unroll
            for (int m = 0; m < 4; ++m) { const int r = u.pm * BM + ai * HALF + wr * 64 + m * 16 + fr; const float* g1 = mod + (r >= 8192 ? 6144 : 0) + 2048; const size_t off = (size_t)r * 1024 + col0;
#pragma unroll
                for (int bj = 0; bj < 2; ++bj)
#pragma unroll
                    for (int n = 0; n < 2; ++n) { const f32x4 gv = *(const f32x4*)(g1 + col0 + bj * HALF + n * 16); const f32x4 xv = *(const f32x4*)(x + off + bj * HALF + n * 16);
                        *(f32x4*)(out + off + bj * HALF + n * 16) = xv + gv * acc[ai][bj][m][n]; } }
    }
};

struct MoeSched {
    const LAS unsigned* tb; int lo, hi, NT, G, c; int perm;
    __device__ __forceinline__ int segof(int p) const { return perm ? (p & 1) * 65 + (p >> 1) : p; }
    __device__ __forceinline__ bool next(int i, UnitG& u) const {
        const unsigned L = (unsigned)(i * G + c); if (L >= tb[TB_PRE + hi]) return false;
        int s = lo; while (L >= tb[TB_PRE + s + 1]) ++s;
        const int sg = segof(s);
        const unsigned loc = L - tb[TB_PRE + s], tiles = (tb[TB_CNT + sg] + 255u) >> 8;
        u.seg = __builtin_amdgcn_readfirstlane(sg); u.mt = __builtin_amdgcn_readfirstlane((int)(loc % tiles)); u.nt = __builtin_amdgcn_readfirstlane((int)(loc / tiles)); return true;
    }
};
struct Moe1Prob {
    int K; MoeSched S; const bf16_t* h2; const bf16_t* w1t; const int* list;
    __device__ __forceinline__ bool next(int i, UnitG& u) const { return S.next(i, u); }
    __device__ __forceinline__ void setup(const UnitG& u, const int (&sR)[2], const int (&sC)[2], const char*& cA, unsigned (&offA)[2][2], const char*& cB) const {
        const int hf = u.seg >= 65 ? 1 : 0, e = u.seg - 65 * hf; const int cnt = (int)S.tb[TB_CNT + u.seg];
#pragma unroll
        for (int h = 0; h < 2; ++h)
#pragma unroll
            for (int i = 0; i < 2; ++i) { const int r = 256 * u.mt + 128 * h + sR[i]; unsigned tok;
                if (e < 64) { const int rr = r < cnt ? r : cnt - 1; tok = (unsigned)list[(size_t)(hf * 64 + e) * CAP + rr] >> 3; } else tok = (unsigned)(hf * 8192 + (r < 8192 ? r : 8191));
                offA[h][i] = tok * 2048u + (unsigned)sC[i] * 2u; }
        cA = (const char*)h2; cB = (const char*)(w1t + ((size_t)e * 512 + (size_t)u.nt * 256) * 1024);
    }
};
struct Moe2Prob {
    int K; MoeSched S; const bf16_t* act; const bf16_t* w2t; int hf;
    __device__ __forceinline__ bool next(int i, UnitG& u) const { return S.next(i, u); }
    __device__ __forceinline__ void setup(const UnitG& u, const int (&sR)[2], const int (&sC)[2], const char*& cA, unsigned (&offA)[2][2], const char*& cB) const {
        const int e = u.seg - 65 * hf; const size_t rowbase = (size_t)S.tb[TB_OFF + u.seg] + 256u * (unsigned)u.mt;
#pragma unroll
        for (int h = 0; h < 2; ++h)
#pragma unroll
            for (int i = 0; i < 2; ++i) offA[h][i] = (unsigned)((128 * h + sR[i]) * 256 + sC[i]) * 2u;
        cA = (const char*)(act + rowbase * 256); cB = (const char*)(w2t + ((size_t)e * 1024 + (size_t)u.nt * 256) * 256);
    }
};
struct EpiMoe1 {
    static constexpr bool PERM = true;
    bf16_t* act; const LAS unsigned* tb;
    __device__ __forceinline__ void operator()(const f32x4 (&acc)[2][2][4][2], const UnitG& u, int wr, int wc, int fr, int fq) const {
        const int cnt = (int)tb[TB_CNT + u.seg]; const size_t rowbase = tb[TB_OFF + u.seg];
#pragma unroll
        for (int ai = 0; ai < 2; ++ai)
#pragma unroll
            for (int m = 0; m < 4; ++m) { const int r = 256 * u.mt + ai * HALF + wr * 64 + m * 16 + fr;
                if (r < cnt) { bf16_t* p = act + (rowbase + (size_t)r) * 256 + u.nt * 128 + wc * 32 + 8 * fq;
                    const f32x4 g0 = acc[ai][0][m][0], g1 = acc[ai][0][m][1], u0 = acc[ai][1][m][0], u1 = acc[ai][1][m][1]; f32x4 v0, v1;
#pragma unroll
                    for (int i = 0; i < 4; ++i) { v0[i] = g0[i] / (1.f + __expf(-g0[i])) * u0[i]; v1[i] = g1[i] / (1.f + __expf(-g1[i])) * u1[i]; }
                    u32x4 w; w.x = cvt_pk_bf16(v0[0], v0[1]); w.y = cvt_pk_bf16(v0[2], v0[3]); w.z = cvt_pk_bf16(v1[0], v1[1]); w.w = cvt_pk_bf16(v1[2], v1[3]);
                    *(u32x4*)p = w; } }
    }
};
struct EpiMoe2 {
    static constexpr bool PERM = true;
    bf16_t* y0; bf16_t* y1; float* x2; const float* mod; const int* list; const float* listw; const LAS unsigned* tb; int hf; int do_shared;
    __device__ __forceinline__ void operator()(const f32x4 (&acc)[2][2][4][2], const UnitG& u, int wr, int wc, int fr, int fq) const {
        const int cnt = (int)tb[TB_CNT + u.seg]; const int e = u.seg - 65 * hf; const int colt = u.nt * 256 + wc * 32 + 8 * fq;
#pragma unroll
        for (int ai = 0; ai < 2; ++ai)
#pragma unroll
            for (int m = 0; m < 4; ++m) { const int r = 256 * u.mt + ai * HALF + wr * 64 + m * 16 + fr;
                if (r < cnt) {
                    if (e < 64) { const size_t li = (size_t)(hf * 64 + e) * CAP + r; const int slot = list[li]; const float w = listw[li];
                        const int yr = slot - hf * 65536; bf16_t* p = (yr < 32768 ? y0 + (size_t)yr * 1024 : y1 + (size_t)(yr - 32768) * 1024) + colt;
#pragma unroll
                        for (int bj = 0; bj < 2; ++bj) { const f32x4 v0 = acc[ai][bj][m][0] * w, v1 = acc[ai][bj][m][1] * w;
                            u32x4 o; o.x = cvt_pk_bf16(v0[0], v0[1]); o.y = cvt_pk_bf16(v0[2], v0[3]); o.z = cvt_pk_bf16(v1[0], v1[1]); o.w = cvt_pk_bf16(v1[2], v1[3]);
                            *(u32x4*)(p + bj * HALF) = o; }
                    } else if (do_shared) { float* p = x2 + (size_t)(hf * 8192 + r) * 1024 + colt; const float* g2 = mod + hf * 6144 + 5120 + colt;
#pragma unroll
                        for (int bj = 0; bj < 2; ++bj)
#pragma unroll
                            for (int n = 0; n < 2; ++n) { f32x4* q = (f32x4*)(p + bj * HALF + 4 * n); *q = *q + *(const f32x4*)(g2 + bj * HALF + 4 * n) * acc[ai][bj][m][n]; } }
                } }
    }
};
}

struct TrItem { const float* W; int ldw, src_col; bf16* WT; int K, dst_row, k0; };
__device__ __forceinline__ void tr_load(const TrItem& t, int lane, f32x4 (&v)[8]) {
#pragma unroll
    for (int i = 0; i < 8; ++i) v[i] = *(const GAS f32x4*)(t.W + (size_t)(t.k0 + 8 * i + (lane >> 3)) * t.ldw + t.src_col + 4 * (lane & 7));
}
__device__ __forceinline__ void tr_finish(const TrItem& t, int lane, const f32x4 (&v)[8], LAS float* scr) {
#pragma unroll
    for (int i = 0; i < 8; ++i) { LAS float* p = scr + (8 * i + (lane >> 3)) * 33 + 4 * (lane & 7); p[0] = v[i][0]; p[1] = v[i][1]; p[2] = v[i][2]; p[3] = v[i][3]; }
    LDS_WAIT(); asm volatile("" ::: "memory");
    const int c = lane & 7;
#pragma unroll
    for (int j = 0; j < 4; ++j) { const int n = (lane >> 3) + 8 * j; const LAS float* s = scr + (8 * c) * 33 + n;
        v4u o; o.x = pk2(s[0 * 33], s[1 * 33]); o.y = pk2(s[2 * 33], s[3 * 33]); o.z = pk2(s[4 * 33], s[5 * 33]); o.w = pk2(s[6 * 33], s[7 * 33]);
        *(GAS v4u*)(t.WT + (size_t)(t.dst_row + n) * t.K + t.k0 + 8 * c) = o; }
    LDS_WAIT(); asm volatile("" ::: "memory");
}
#define TR_LOOP(it0, stride, nitems, MAKE) do { int it_ = (it0); if (it_ < (nitems)) { TrItem cur_ = MAKE(it_); f32x4 va_[8], vb_[8]; tr_load(cur_, lane, va_); \
    for (;;) { const int nx_ = it_ + (stride); const bool hn_ = nx_ < (nitems); TrItem nxt_ = cur_; if (hn_) { nxt_ = MAKE(nx_); tr_load(nxt_, lane, vb_); } \
        tr_finish(cur_, lane, va_, scr); if (!hn_) break; _Pragma("unroll") for (int q_ = 0; q_ < 8; ++q_) va_[q_] = vb_[q_]; cur_ = nxt_; it_ = nx_; } } } while (0)

#ifndef REP_PHASE
#define REP_PHASE -1
#endif
#ifndef REP_N
#define REP_N 1
#endif
#define REPN(k) ((k) == REP_PHASE ? REP_N : 1)

constexpr int UNITS = BATCH * 128 * 4;
constexpr int L_QN = 0, L_KN = 17408, L_VV = 34816, L_LM = 52224, L_ATT = 68608, L_UT = 77824, L_WT = 96256, L_KTT = 114688, L_GCS = 133120, L_EGS = 133376, L_BET = 133632, L_SCW = 133888, L_SKT = 134144, L_TM = L_KN, L_TB = L_VV;
constexpr int H_FR = 0, H_QR = 17408, H_QE = 34816, H_KD = 52224, H_KTT = 69632, H_VT = 88064, H_AM = 106496;
constexpr int RS = 272, TS = 144;

typedef unsigned v2u __attribute__((ext_vector_type(2)));
#define LBAR() do { asm volatile("s_waitcnt lgkmcnt(0)" ::: "memory"); __builtin_amdgcn_s_barrier(); asm volatile("" ::: "memory"); } while (0)
__device__ __forceinline__ f32x4 mfma16(bf16x8 a, bf16x8 b, f32x4 c) { return __builtin_amdgcn_mfma_f32_16x16x32_bf16(a, b, c, 0, 0, 0); }
__device__ __forceinline__ bf16x8 ldsfrag(const LAS unsigned char* base, int row, int stride, int kbyte) { return *(const LAS bf16x8*)(base + row * stride + kbyte); }
__device__ __forceinline__ void unpack8(const v4u q, float (&f)[8]) {
    f[0] = __uint_as_float(q.x << 16); f[1] = __uint_as_float(q.x & 0xffff0000u); f[2] = __uint_as_float(q.y << 16); f[3] = __uint_as_float(q.y & 0xffff0000u);
    f[4] = __uint_as_float(q.z << 16); f[5] = __uint_as_float(q.z & 0xffff0000u); f[6] = __uint_as_float(q.w << 16); f[7] = __uint_as_float(q.w & 0xffff0000u); }
__device__ __forceinline__ f32x4 unpack4(const v2u q) { return (f32x4){__uint_as_float(q.x << 16), __uint_as_float(q.x & 0xffff0000u), __uint_as_float(q.y << 16), __uint_as_float(q.y & 0xffff0000u)}; }
__device__ __forceinline__ v2u pack4(const f32x4 v) { v2u o; o.x = pk2(v[0], v[1]); o.y = pk2(v[2], v[3]); return o; }
__device__ __forceinline__ float ldsbf(const LAS unsigned char* base, int row, int stride, int col) { return __uint_as_float(((unsigned)*(const LAS unsigned short*)(base + row * stride + col * 2)) << 16); }

struct MixPtrs {
    const bf16* projA; const bf16* gates; const float* ab; const float* conv_w; const float* a_log; const float* dt_bias; const float* hg_lb; const float* gdn_nw; const float* hg_nw;
    bf16 *PG, *BG, *QP, *OI, *BH, *QE, *OIH, *SG, *SH, *omix; float *GL, *AH;
};

__device__ __forceinline__ void p3_gdn_unit(LAS unsigned char* lds, const MixPtrs& X, int unit, int tid, int lane, int wave) {
    const int h = unit & 3, n = (unit >> 2) & 127, b = unit >> 9, r = lane & 15, g = lane >> 4;
    const size_t tok0 = (size_t)b * T + (size_t)n * 64;
    LAS float* gcs = (LAS float*)(lds + L_GCS); LAS float* egs = (LAS float*)(lds + L_EGS); LAS float* bet = (LAS float*)(lds + L_BET);
    {
#pragma unroll 1
      for (int ib = 0; ib < 6; ib += 3) {
        v4u raw[3][4];
#pragma unroll
        for (int i2 = 0; i2 < 3; ++i2) { const int i = ib + i2; const int pair = (tid >> 4) + 32 * i, tz = pair >> 6, c = pair & 63, ch = tid & 15, col = tz * 512 + h * 128 + ch * 8;
#pragma unroll
            for (int j = 0; j < 4; ++j) { const int tl = n * 64 + c - 3 + j; raw[i2][j] = *(const GAS v4u*)(X.projA + ((size_t)b * T + (tl < 0 ? 0 : tl)) * PA + col); } }
#pragma unroll
        for (int i2 = 0; i2 < 3; ++i2) { const int i = ib + i2;
            const int pair = (tid >> 4) + 32 * i, tz = pair >> 6, c = pair & 63, ch = tid & 15, col = tz * 512 + h * 128 + ch * 8;
            float y[8];
#pragma unroll
            for (int e = 0; e < 8; ++e) y[e] = 0.f;
#pragma unroll
            for (int j = 0; j < 4; ++j) { const int tl = n * 64 + c - 3 + j; const float msk = tl >= 0 ? 1.f : 0.f; float xf[8]; unpack8(raw[i2][j], xf);
                const f32x4 w0 = *(const GAS f32x4*)(X.conv_w + j * 1536 + col) * msk, w1 = *(const GAS f32x4*)(X.conv_w + j * 1536 + col + 4) * msk;
#pragma unroll
                for (int e = 0; e < 4; ++e) { y[e] += w0[e] * xf[e]; y[4 + e] += w1[e] * xf[4 + e]; } }
            float ss = 0.f;
#pragma unroll
            for (int e = 0; e < 8; ++e) { y[e] = siluf_(y[e]); ss += y[e] * y[e]; }
            ss += __shfl_xor(ss, 1); ss += __shfl_xor(ss, 2); ss += __shfl_xor(ss, 4); ss += __shfl_xor(ss, 8);
            const float rn = tz == 2 ? 1.f : rsqrtf(ss + 1e-6f) * (tz == 0 ? 0.08838834764831845f : 1.f);
            v4u o; o.x = pk2(y[0] * rn, y[1] * rn); o.y = pk2(y[2] * rn, y[3] * rn); o.z = pk2(y[4] * rn, y[5] * rn); o.w = pk2(y[6] * rn, y[7] * rn);
            *(LAS v4u*)(lds + (tz == 0 ? L_QN : (tz == 1 ? L_KN : L_VV)) + c * RS + ch * 16) = o;
        }
      }
    }
    if (wave == 0) {
        const float araw = X.ab[(tok0 + lane) * 8 + 4 + h], braw = X.ab[(tok0 + lane) * 8 + h];
        float gv = -expf(X.a_log[h]) * softplusf_(araw + X.dt_bias[h]);
#pragma unroll
        for (int o = 1; o < 64; o <<= 1) { const float t = __shfl_up(gv, o); if (lane >= o) gv += t; }
        { const float eg_ = __expf(gv), be_ = sigmoidf_(braw); gcs[lane] = gv; egs[lane] = eg_; bet[lane] = be_; *(LAS float*)(lds + L_SCW + lane * 4) = be_ * eg_; *(LAS float*)(lds + L_SKT + lane * 4) = __expf(__shfl(gv, 63) - gv); }
        if (lane == 63) X.GL[unit] = gv;
    }
    LBAR();
    {
        const int mt = wave >> 1;
#pragma unroll
        for (int q = 0; q < 2; ++q) { const int ntc = 2 * (wave & 1) + q; f32x4 akk = {0.f, 0.f, 0.f, 0.f}, aqk = {0.f, 0.f, 0.f, 0.f};
#pragma unroll
            for (int ks = 0; ks < 4; ++ks) { const bf16x8 ka = ldsfrag(lds + L_KN, 16 * mt + r, RS, 64 * ks + 16 * g), qa = ldsfrag(lds + L_QN, 16 * mt + r, RS, 64 * ks + 16 * g), kb = ldsfrag(lds + L_KN, 16 * ntc + r, RS, 64 * ks + 16 * g);
                akk = mfma16(ka, kb, akk); aqk = mfma16(qa, kb, aqk); }
            const int j = 16 * ntc + r; const float gj = gcs[j];
#pragma unroll
            for (int ii = 0; ii < 4; ++ii) { const int i = 16 * mt + 4 * g + ii; const float dec = (i >= j) ? __expf(gcs[i] - gj) : 0.f;
                *(LAS float*)(lds + L_LM + (i * 64 + j) * 4) = (i > j) ? bet[i] * akk[ii] * dec : 0.f;
                *(LAS unsigned short*)(lds + L_ATT + i * TS + j * 2) = (unsigned short)f2bf(aqk[ii] * dec); } }
    }
    LBAR();
#pragma unroll
    for (int i = 0; i < 2; ++i) { const int tsk = tid + 512 * i;
        if (tsk < 768) { const int a = tsk >> 8, hh = (tsk >> 7) & 1, d = tsk & 127;
            const LAS unsigned char* sp = lds + (a == 0 ? L_VV : L_KN) + d * 2; const LAS float* scl = (const LAS float*)(lds + (a == 0 ? L_BET : (a == 1 ? L_SCW : L_SKT)));
            LAS unsigned char* dp = lds + (a == 0 ? L_UT : (a == 1 ? L_WT : L_KTT)) + d * TS + 64 * hh;
#pragma unroll
            for (int q = 0; q < 4; ++q) { float kv[8];
#pragma unroll
                for (int e = 0; e < 8; ++e) { const int c = 32 * hh + 8 * q + e; kv[e] = __uint_as_float(((unsigned)*(const LAS unsigned short*)(sp + c * RS)) << 16) * scl[c]; }
                v4u o; o.x = pk2(kv[0], kv[1]); o.y = pk2(kv[2], kv[3]); o.z = pk2(kv[4], kv[5]); o.w = pk2(kv[6], kv[7]); *(LAS v4u*)(dp + 16 * q) = o; } } }
    LBAR();
    { const LAS float* Lm = (const LAS float*)(lds + L_LM); LAS float* Tm = (LAS float*)(lds + L_TM);
      if (tid < 64) { const int I = tid >> 4, j = tid & 15; float x[16];
#pragma unroll
          for (int i = 0; i < 16; ++i) { float s = (i == j) ? 1.f : 0.f;
#pragma unroll
              for (int kb = 0; kb < (i + 3) / 4; ++kb) { const f32x4 l = *(const LAS f32x4*)(Lm + (16 * I + i) * 64 + 16 * I + 4 * kb);
#pragma unroll
                  for (int e = 0; e < 4; ++e) if (4 * kb + e < i) s -= l[e] * x[4 * kb + e]; }
              x[i] = (i < j) ? 0.f : s; Tm[(16 * I + i) * 64 + 16 * I + j] = x[i]; } }
      LBAR();
#pragma unroll 1
      for (int lv = 1; lv < 4; ++lv) {
          for (int e = tid; e < (4 - lv) * 256; e += NWAVES * 64) { const int I = lv + (e >> 8), J = I - lv, rr = (e >> 4) & 15, cc = e & 15; float w = 0.f;
              for (int K = J; K < I; ++K) {
#pragma unroll
                  for (int kb = 0; kb < 4; ++kb) { const f32x4 l = *(const LAS f32x4*)(Lm + (16 * I + rr) * 64 + 16 * K + 4 * kb);
#pragma unroll
                      for (int q = 0; q < 4; ++q) w += l[q] * Tm[(16 * K + 4 * kb + q) * 64 + 16 * J + cc]; } }
              Tm[(16 * J + rr) * 64 + 16 * I + cc] = w; }
          LBAR();
          for (int e = tid; e < (4 - lv) * 256; e += NWAVES * 64) { const int I = lv + (e >> 8), J = I - lv, rr = (e >> 4) & 15, cc = e & 15; float t = 0.f;
#pragma unroll
              for (int kb = 0; kb < 4; ++kb) { const f32x4 l = *(const LAS f32x4*)(Tm + (16 * I + rr) * 64 + 16 * I + 4 * kb);
#pragma unroll
                  for (int q = 0; q < 4; ++q) t -= l[q] * Tm[(16 * J + 4 * kb + q) * 64 + 16 * I + cc]; }
              Tm[(16 * I + rr) * 64 + 16 * J + cc] = t; }
          LBAR();
      }
      { const int i = tid >> 3, j0 = (tid & 7) * 8; const f32x4 t0 = *(const LAS f32x4*)(Tm + i * 64 + j0), t1 = *(const LAS f32x4*)(Tm + i * 64 + j0 + 4); const bool keep = (i >> 4) >= (j0 >> 4);
        v4u o; o.x = keep ? pk2(t0[0], t0[1]) : 0u; o.y = keep ? pk2(t0[2], t0[3]) : 0u; o.z = keep ? pk2(t1[0], t1[1]) : 0u; o.w = keep ? pk2(t1[2], t1[3]) : 0u;
        *(LAS v4u*)(lds + L_TB + i * TS + j0 * 2) = o; }
      LBAR();
    }
    { bf16x8 af[4][2];
#pragma unroll
      for (int mt = 0; mt < 4; ++mt)
#pragma unroll
          for (int ks = 0; ks < 2; ++ks) af[mt][ks] = ldsfrag(lds + L_TB, 16 * mt + r, TS, 64 * ks + 16 * g);
#pragma unroll
      for (int q = 0; q < 2; ++q) { const int ng = 2 * wave + q; LAS unsigned char* base = lds + (ng >= 8 ? L_WT : L_UT) + (16 * (ng & 7) + r) * TS;
          const bf16x8 b0 = *(const LAS bf16x8*)(base + 16 * g), b1 = *(const LAS bf16x8*)(base + 64 + 16 * g);
          f32x4 acc[4];
#pragma unroll
          for (int mt = 0; mt < 4; ++mt) { acc[mt] = mfma16(af[mt][0], b0, (f32x4){0.f, 0.f, 0.f, 0.f}); acc[mt] = mfma16(af[mt][1], b1, acc[mt]); }
          asm volatile("s_waitcnt lgkmcnt(0)" ::: "memory");
#pragma unroll
          for (int mt = 0; mt < 4; ++mt) *(LAS v2u*)(base + (16 * mt + 4 * g) * 2) = pack4(acc[mt]); }
    }
    LBAR();
    {
        const size_t u16 = (size_t)unit * 16384, u8 = (size_t)unit * 8192;
        { const int kk = wave >> 1;
          bf16x8 af[2][2];
#pragma unroll
          for (int t2 = 0; t2 < 2; ++t2)
#pragma unroll
              for (int ks = 0; ks < 2; ++ks) af[t2][ks] = ldsfrag(lds + L_WT, 16 * (2 * kk + t2) + r, TS, 64 * ks + 16 * g);
#pragma unroll
          for (int q = 0; q < 4; ++q) { const int nt = 4 * (wave & 1) + q; f32x4 a0 = {0.f, 0.f, 0.f, 0.f}, a1 = {0.f, 0.f, 0.f, 0.f};
#pragma unroll
              for (int ks = 0; ks < 2; ++ks) { const bf16x8 bfr = ldsfrag(lds + L_KTT, 16 * nt + r, TS, 64 * ks + 16 * g); a0 = mfma16(af[0][ks], bfr, a0); a1 = mfma16(af[1][ks], bfr, a1); }
              v4u o; o.x = pk2(-a0[0], -a0[1]); o.y = pk2(-a0[2], -a0[3]); o.z = pk2(-a1[0], -a1[1]); o.w = pk2(-a1[2], -a1[3]);
              *(GAS v4u*)(X.PG + u16 + ((size_t)(nt * 4 + kk) * 64 + lane) * 8) = o; } }
        { const int mt = wave; bf16x8 af[2];
#pragma unroll
          for (int ks = 0; ks < 2; ++ks) af[ks] = ldsfrag(lds + L_KTT, 16 * mt + r, TS, 64 * ks + 16 * g);
#pragma unroll
          for (int nt = 0; nt < 8; ++nt) { f32x4 a0 = {0.f, 0.f, 0.f, 0.f};
#pragma unroll
              for (int ks = 0; ks < 2; ++ks) a0 = mfma16(af[ks], ldsfrag(lds + L_UT, 16 * nt + r, TS, 64 * ks + 16 * g), a0);
              *(GAS v2u*)(X.BG + u16 + ((size_t)(nt * 8 + mt) * 64 + lane) * 4) = pack4(a0); } }
        { const int kk = wave >> 1;
#pragma unroll
          for (int q = 0; q < 2; ++q) { const int ct = 2 * (wave & 1) + q; f32x4 a0 = {0.f, 0.f, 0.f, 0.f}, a1 = {0.f, 0.f, 0.f, 0.f};
#pragma unroll
              for (int ks = 0; ks < 2; ++ks) { const bf16x8 bfr = ldsfrag(lds + L_ATT, 16 * ct + r, TS, 64 * ks + 16 * g);
                  a0 = mfma16(ldsfrag(lds + L_WT, 16 * (2 * kk) + r, TS, 64 * ks + 16 * g), bfr, a0); a1 = mfma16(ldsfrag(lds + L_WT, 16 * (2 * kk + 1) + r, TS, 64 * ks + 16 * g), bfr, a1); }
              const int c = 16 * ct + r; const float eg = egs[c];
              const f32x4 q0 = unpack4(*(const LAS v2u*)(lds + L_QN + c * RS + (32 * kk + 4 * g) * 2)), q1 = unpack4(*(const LAS v2u*)(lds + L_QN + c * RS + (32 * kk + 16 + 4 * g) * 2));
              v4u o; o.x = pk2(q0[0] * eg - a0[0], q0[1] * eg - a0[1]); o.y = pk2(q0[2] * eg - a0[2], q0[3] * eg - a0[3]); o.z = pk2(q1[0] * eg - a1[0], q1[1] * eg - a1[1]); o.w = pk2(q1[2] * eg - a1[2], q1[3] * eg - a1[3]);
              *(GAS v4u*)(X.QP + u8 + ((size_t)(ct * 4 + kk) * 64 + lane) * 8) = o; } }
        { const int vt = wave; bf16x8 af[2];
#pragma unroll
          for (int ks = 0; ks < 2; ++ks) af[ks] = ldsfrag(lds + L_UT, 16 * vt + r, TS, 64 * ks + 16 * g);
#pragma unroll
          for (int ct = 0; ct < 4; ++ct) { f32x4 a0 = {0.f, 0.f, 0.f, 0.f};
#pragma unroll
              for (int ks = 0; ks < 2; ++ks) a0 = mfma16(af[ks], ldsfrag(lds + L_ATT, 16 * ct + r, TS, 64 * ks + 16 * g), a0);
              *(GAS v2u*)(X.OI + u8 + ((size_t)(vt * 4 + ct) * 64 + lane) * 4) = pack4(a0); } }
    }
    LBAR();
}

__device__ __forceinline__ void p3_hgrn_unit(LAS unsigned char* lds, const MixPtrs& X, int unit, int tid, int lane, int wave) {
    const int h = unit & 3, n = (unit >> 2) & 127, b = unit >> 9, r = lane & 15, g = lane >> 4;
    const size_t tok0 = (size_t)b * T + (size_t)n * 64;
#pragma unroll
    for (int i = 0; i < 4; ++i) { const int pair = (tid >> 4) + 32 * i, tz = pair >> 6, c = pair & 63, ch = tid & 15;
        const v4u q = *(const GAS v4u*)(X.projA + (tok0 + c) * PA + (tz ? 2560 : 1536) + h * 128 + ch * 8);
        *(LAS v4u*)(lds + (tz ? H_QR : H_FR) + c * RS + ch * 16) = q; }
    {
        v4u rv[2];
#pragma unroll
        for (int i = 0; i < 2; ++i) { const int item = tid + 512 * i, c = item >> 4, ch = item & 15; rv[i] = *(const GAS v4u*)(X.projA + (tok0 + c) * PA + 2048 + h * 128 + ch * 8); }
#pragma unroll
        for (int i = 0; i < 2; ++i) { const int item = tid + 512 * i, c = item >> 4, ch = item & 15; const unsigned w[4] = {rv[i].x, rv[i].y, rv[i].z, rv[i].w};
#pragma unroll
            for (int e = 0; e < 4; ++e) { *(LAS unsigned short*)(lds + H_VT + (ch * 8 + 2 * e) * TS + c * 2) = (unsigned short)(w[e] & 0xffffu); *(LAS unsigned short*)(lds + H_VT + (ch * 8 + 2 * e + 1) * TS + c * 2) = (unsigned short)(w[e] >> 16); } }
    }
    LBAR();
    {
        const int d = tid & 127, seg = tid >> 7; LAS float* segt = (LAS float*)(lds + H_AM + 9216);
        const float l0 = X.hg_lb[h * 128 + d], l1 = X.hg_lb[512 + h * 128 + d]; const float mx = fmaxf(l0, l1); const float e0 = __expf(l0 - mx), e1 = __expf(l1 - mx); const float lb = e0 / (e0 + e1);
        float lc[16], kq[16]; float run = 0.f;
#pragma unroll
        for (int ci = 0; ci < 16; ++ci) { const float sg = sigmoidf_(ldsbf(lds + H_FR, 16 * seg + ci, RS, d)); run += __logf(lb + (1.f - lb) * sg); lc[ci] = run; kq[ci] = (1.f - lb) * (1.f - sg); }
        segt[seg * 128 + d] = run;
        LBAR();
        const float t0 = segt[d], t1 = segt[128 + d], t2 = segt[256 + d], t3 = segt[384 + d];
        const float off = (seg > 0 ? t0 : 0.f) + (seg > 1 ? t1 : 0.f) + (seg > 2 ? t2 : 0.f), btot = (t0 + t1) + (t2 + t3);
        float kv[16];
#pragma unroll
        for (int ci = 0; ci < 16; ++ci) { const int c = 16 * seg + ci; const float bb = off + lc[ci];
            *(LAS unsigned short*)(lds + H_QE + c * RS + d * 2) = (unsigned short)f2bf(siluf_(ldsbf(lds + H_QR, c, RS, d)) * __expf(bb));
            *(LAS unsigned short*)(lds + H_KD + c * RS + d * 2) = (unsigned short)f2bf(kq[ci] * __expf(-bb));
            kv[ci] = kq[ci] * __expf(btot - bb); }
        if (seg == 0) X.AH[(size_t)unit * 128 + d] = __expf(btot);
#pragma unroll
        for (int q = 0; q < 2; ++q) { v4u o; o.x = pk2(kv[8 * q], kv[8 * q + 1]); o.y = pk2(kv[8 * q + 2], kv[8 * q + 3]); o.z = pk2(kv[8 * q + 4], kv[8 * q + 5]); o.w = pk2(kv[8 * q + 6], kv[8 * q + 7]);
            *(LAS v4u*)(lds + H_KTT + d * TS + (16 * seg + 8 * q) * 2) = o; }
    }
    LBAR();
    {
        const int mt = wave >> 1;
#pragma unroll
        for (int q = 0; q < 2; ++q) { const int ntc = 2 * (wave & 1) + q; f32x4 a0 = {0.f, 0.f, 0.f, 0.f};
#pragma unroll
            for (int ks = 0; ks < 4; ++ks) a0 = mfma16(ldsfrag(lds + H_QE, 16 * mt + r, RS, 64 * ks + 16 * g), ldsfrag(lds + H_KD, 16 * ntc + r, RS, 64 * ks + 16 * g), a0);
            const int j = 16 * ntc + r;
#pragma unroll
            for (int ii = 0; ii < 4; ++ii) { const int i = 16 * mt + 4 * g + ii; *(LAS unsigned short*)(lds + H_AM + i * TS + j * 2) = (unsigned short)f2bf((i >= j) ? a0[ii] : 0.f); } }
    }
    LBAR();
    {
        const size_t u16 = (size_t)unit * 16384, u8 = (size_t)unit * 8192;
        { const int mt = wave; bf16x8 af[2];
#pragma unroll
          for (int ks = 0; ks < 2; ++ks) af[ks] = ldsfrag(lds + H_KTT, 16 * mt + r, TS, 64 * ks + 16 * g);
#pragma unroll
          for (int nt = 0; nt < 8; ++nt) { f32x4 a0 = {0.f, 0.f, 0.f, 0.f};
#pragma unroll
              for (int ks = 0; ks < 2; ++ks) a0 = mfma16(af[ks], ldsfrag(lds + H_VT, 16 * nt + r, TS, 64 * ks + 16 * g), a0);
              *(GAS v2u*)(X.BH + u16 + ((size_t)(nt * 8 + mt) * 64 + lane) * 4) = pack4(a0); } }
        { const int vt = wave; bf16x8 af[2];
#pragma unroll
          for (int ks = 0; ks < 2; ++ks) af[ks] = ldsfrag(lds + H_VT, 16 * vt + r, TS, 64 * ks + 16 * g);
#pragma unroll
          for (int ct = 0; ct < 4; ++ct) { f32x4 a0 = {0.f, 0.f, 0.f, 0.f};
#pragma unroll
              for (int ks = 0; ks < 2; ++ks) a0 = mfma16(af[ks], ldsfrag(lds + H_AM, 16 * ct + r, TS, 64 * ks + 16 * g), a0);
              *(GAS v2u*)(X.OIH + u8 + ((size_t)(vt * 4 + ct) * 64 + lane) * 4) = pack4(a0); } }
#pragma unroll
        for (int q = 0; q < 2; ++q) { const int idx = wave * 2 + q, ct = idx >> 2, kk = idx & 3, c = 16 * ct + r;
            const v2u q0 = *(const LAS v2u*)(lds + H_QE + c * RS + (32 * kk + 4 * g) * 2), q1 = *(const LAS v2u*)(lds + H_QE + c * RS + (32 * kk + 16 + 4 * g) * 2);
            v4u o; o.x = q0.x; o.y = q0.y; o.z = q1.x; o.w = q1.y;
            *(GAS v4u*)(X.QE + u8 + ((size_t)(ct * 4 + kk) * 64 + lane) * 8) = o; }
    }
    LBAR();
}

__device__ __forceinline__ void p4_gdn_scan(LAS unsigned char* lds, const MixPtrs& X, int job, int lane, int wave) {
    const int s = job >> 3, h = job & 3, b = (job >> 2) & 1;
    const int unit0 = (b * 128) * 4 + h;
    constexpr int BRING = 131072, GLOFF = BRING + 3 * 4096;
    if (wave >= 4) {
        const int lw = wave - 4;
        const char* src0 = (const char*)(X.PG + (size_t)unit0 * 16384) + lw * 8192 + lane * 16;
        const char* bsrc0 = (const char*)(X.BG + (size_t)unit0 * 16384 + (size_t)(s * 8) * 256) + lw * 1024 + lane * 16;
#define P4_ISSUE_P(n_) do { const char* s_ = src0 + (size_t)(n_) * (4 * 32768); _Pragma("unroll") for (int i_ = 0; i_ < 8; ++i_) \
        __builtin_amdgcn_global_load_lds((const unsigned*)(s_ + i_ * 1024), (LAS unsigned*)(lds + ((n_) & 3) * 32768 + lw * 8192 + i_ * 1024), 16, 0, 2); } while (0)
#define P4_ISSUE_B(n_) __builtin_amdgcn_global_load_lds((const unsigned*)(bsrc0 + (size_t)(n_) * (4 * 32768)), (LAS unsigned*)(lds + BRING + ((n_) % 3) * 4096 + lw * 1024), 16, 0, 0)
        P4_ISSUE_P(0); P4_ISSUE_B(0); P4_ISSUE_P(1); P4_ISSUE_B(1); P4_ISSUE_P(2);
#pragma unroll 1
        for (int n = 0; n < 128; ++n) {
            if (n + 2 < 128) asm volatile("s_waitcnt vmcnt(17)" ::: "memory"); else if (n + 1 < 128) asm volatile("s_waitcnt vmcnt(9)" ::: "memory"); else asm volatile("s_waitcnt vmcnt(0)" ::: "memory");
            __builtin_amdgcn_s_barrier();
            asm volatile("" ::: "memory");
            if (n + 2 < 128) P4_ISSUE_B(n + 2);
            if (n + 3 < 128) P4_ISSUE_P(n + 3);
        }
#undef P4_ISSUE_P
#undef P4_ISSUE_B
    } else if (wave == 0) {
        f32x4 S[8]; bf16x8 sb[4];
#pragma unroll
        for (int mt = 0; mt < 8; ++mt) S[mt] = (f32x4){0.f, 0.f, 0.f, 0.f};
#pragma unroll
        for (int kk = 0; kk < 4; ++kk) { sb[kk] = (bf16x8){0, 0, 0, 0, 0, 0, 0, 0}; *(GAS bf16x8*)(X.SG + (size_t)unit0 * 16384 + ((size_t)(s * 4 + kk) * 64 + lane) * 8) = sb[kk]; }
        { const float g0 = X.GL[unit0 + 4 * lane], g1 = X.GL[unit0 + 4 * (64 + lane)]; *(LAS float*)(lds + GLOFF + lane * 4) = g0; *(LAS float*)(lds + GLOFF + (64 + lane) * 4) = g1; }
        asm volatile("s_waitcnt vmcnt(0) lgkmcnt(0)" ::: "memory");
#pragma unroll 1
        for (int n = 0; n < 128; ++n) {
            const int unit = unit0 + 4 * n;
            __builtin_amdgcn_s_barrier();
            asm volatile("" ::: "memory");
            const float e = __expf(*(const LAS float*)(lds + GLOFF + n * 4));
            const LAS unsigned char* bb = lds + BRING + (n % 3) * 4096 + lane * 8;
            f32x4 acc[8];
#pragma unroll
            for (int mt = 0; mt < 8; ++mt) acc[mt] = S[mt] * e + unpack4(*(const LAS v2u*)(bb + mt * 512));
            const LAS unsigned char* pb = lds + (n & 3) * 32768 + lane * 16;
#pragma unroll
            for (int kk = 0; kk < 4; ++kk)
#pragma unroll
                for (int mt = 0; mt < 8; ++mt) acc[mt] = mfma16(*(const LAS bf16x8*)(pb + (mt * 4 + kk) * 1024), sb[kk], acc[mt]);
#pragma unroll
            for (int mt = 0; mt < 8; ++mt) S[mt] = acc[mt];
#pragma unroll
            for (int kk = 0; kk < 4; ++kk) { const v2u lo = pack4(S[2 * kk]), hi = pack4(S[2 * kk + 1]); v4u o; o.x = lo.x; o.y = lo.y; o.z = hi.x; o.w = hi.y; sb[kk] = __builtin_bit_cast(bf16x8, o);
                if (n < 127) *(GAS v4u*)(X.SG + (size_t)(unit + 4) * 16384 + ((size_t)(s * 4 + kk) * 64 + lane) * 8) = o; }
            asm volatile("s_waitcnt lgkmcnt(0)" ::: "memory");
        }
    } else {
#pragma unroll 1
        for (int n = 0; n < 128; ++n) { __builtin_amdgcn_s_barrier(); asm volatile("" ::: "memory"); }
    }
}
__device__ __forceinline__ void p4_hgrn_scan(const MixPtrs& X, int task, int lane) {
    const int mt = task & 7, s = (task >> 3) & 7, h = (task >> 6) & 3, b = task >> 8, g = lane >> 4;
    const int unit0 = (b * 128) * 4 + h;
    f32x4 s0 = {0.f, 0.f, 0.f, 0.f};
    const GAS f32x4* ap = (const GAS f32x4*)(X.AH + (size_t)unit0 * 128 + 16 * mt + 4 * g);
    const GAS v2u* bp = (const GAS v2u*)(X.BH + (size_t)unit0 * 16384 + ((size_t)(s * 8 + mt) * 64 + lane) * 4);
    GAS v2u* sp = (GAS v2u*)(X.SH + (size_t)unit0 * 16384 + ((size_t)(s * 4 + (mt >> 1)) * 64 + lane) * 8 + 4 * (mt & 1));
    { v2u z; z.x = 0; z.y = 0; sp[0] = z; }
    f32x4 ra[8]; v2u rb[8];
#pragma unroll
    for (int j = 0; j < 8; ++j) { ra[j] = ap[(size_t)j * 128]; rb[j] = bp[(size_t)j * 16384]; }
#pragma unroll 1
    for (int n0 = 0; n0 < 128; n0 += 8) {
#pragma unroll
        for (int j = 0; j < 8; ++j) { const int n = n0 + j;
            s0 = ra[j] * s0 + unpack4(rb[j]);
            if (n + 8 < 128) { ra[j] = ap[(size_t)(n + 8) * 128]; rb[j] = bp[(size_t)(n + 8) * 16384]; }
            if (n < 127) sp[(size_t)(n + 1) * 16384] = pack4(s0); }
    }
}
__device__ __forceinline__ void p5_unit(LAS unsigned char* lds, const MixPtrs& X, int bn, int lane, int wave) {
    const int hd = wave & 3, type = wave >> 2, r = lane & 15, g = lane >> 4;
    const int unit = bn * 4 + hd; const size_t tok0 = (size_t)bn * 64;
    const bf16* SX = type ? X.SH : X.SG; const bf16* QX = type ? X.QE : X.QP; const bf16* OX = type ? X.OIH : X.OI;
    const size_t u16 = (size_t)unit * 16384, u8 = (size_t)unit * 8192;
    LAS float* exch = (LAS float*)lds;
    const float* nw = type ? X.hg_nw + hd * 128 : X.gdn_nw;
    bf16x8 af[4][8];
#pragma unroll
    for (int kk = 0; kk < 4; ++kk)
#pragma unroll
        for (int vt = 0; vt < 8; ++vt) af[kk][vt] = *(const GAS bf16x8*)(SX + u16 + ((size_t)(vt * 4 + kk) * 64 + lane) * 8);
#pragma unroll 1
    for (int ct = 0; ct < 4; ++ct) {
        bf16x8 bfr[4]; v2u oq[8], gtq[8];
#pragma unroll
        for (int kk = 0; kk < 4; ++kk) bfr[kk] = *(const GAS bf16x8*)(QX + u8 + ((size_t)(ct * 4 + kk) * 64 + lane) * 8);
#pragma unroll
        for (int vt = 0; vt < 8; ++vt) { oq[vt] = *(const GAS v2u*)(OX + u8 + ((size_t)(vt * 4 + ct) * 64 + lane) * 4);
            gtq[vt] = *(const GAS v2u*)(X.gates + (tok0 + 16 * ct + r) * 1024 + type * 512 + hd * 128 + 16 * vt + 4 * g); }
        f32x4 acc[8];
#pragma unroll
        for (int vt = 0; vt < 8; ++vt) acc[vt] = unpack4(oq[vt]);
#pragma unroll
        for (int kk = 0; kk < 4; ++kk)
#pragma unroll
            for (int vt = 0; vt < 8; ++vt) acc[vt] = mfma16(af[kk][vt], bfr[kk], acc[vt]);
        float ssq = 0.f;
#pragma unroll
        for (int vt = 0; vt < 8; ++vt) ssq += (acc[vt][0] * acc[vt][0] + acc[vt][1] * acc[vt][1]) + (acc[vt][2] * acc[vt][2] + acc[vt][3] * acc[vt][3]);
        ssq += __shfl_xor(ssq, 16); ssq += __shfl_xor(ssq, 32);
        if (type == 1 && g == 0) exch[(ct & 1) * 64 + hd * 16 + r] = ssq;
        LBAR();
        float rstd;
        if (type == 1) { const LAS float* ex = exch + (ct & 1) * 64 + r; rstd = rsqrtf(((ex[0] + ex[16]) + (ex[32] + ex[48])) * (1.f / 512.f) + 1e-6f); } else rstd = rsqrtf(ssq * (1.f / 128.f) + 1e-6f);
#pragma unroll
        for (int vt = 0; vt < 8; ++vt) { const f32x4 w4 = *(const GAS f32x4*)(nw + 16 * vt + 4 * g); const size_t off = (tok0 + 16 * ct + r) * 1024 + type * 512 + hd * 128 + 16 * vt + 4 * g;
            const f32x4 gt = unpack4(gtq[vt]); f32x4 o;
#pragma unroll
            for (int e = 0; e < 4; ++e) o[e] = acc[vt][e] * rstd * w4[e] * siluf_(gt[e]);
            *(GAS v2u*)(X.omix + off) = pack4(o); }
    }
    LBAR();
}

struct Args { const float* in[23]; float* out; unsigned char* ws; int ph_lo, ph_hi, li, pad; };

__global__ void __launch_bounds__(NWAVES * 64, 2) mk_fwd(Args args) {
    extern __shared__ __attribute__((aligned(16))) unsigned char lds_raw[];
    LAS unsigned char* lds = (LAS unsigned char*)lds_raw;
    volatile LAS unsigned* MISC = (volatile LAS unsigned*)(lds + MISC_OFF);
    const int tid = threadIdx.x, lane = tid & 63, wave = __builtin_amdgcn_readfirstlane(tid >> 6);
    const int G = gridDim.x, bx = blockIdx.x, vcu = (G % 8 == 0) ? (bx % 8) * (G / 8) + bx / 8 : bx;
    const int gw = vcu * NWAVES + wave, NGW = G * NWAVES;
    unsigned char* ws = args.ws;
    gu32* ctl = (gu32*)(ws + WS_CTL);
    const float* x = args.in[0]; const float* cvec = args.in[1]; const float* w_ada = args.in[2]; const float* b_ada = args.in[3]; const float* norm1_w = args.in[4];
    const float* w_in = args.in[5]; const float* w_out = args.in[12];
    float* mod = (float*)(ws + WS_MOD); float* wab = (float*)(ws + WS_WAB); float* ab = (float*)(ws + WS_AB);
    bf16* wout_t = (bf16*)(ws + WS_WOUT_T); bf16* win_t = (bf16*)(ws + WS_WIN_T); bf16* h1 = (bf16*)(ws + WS_H1); bf16* projA = (bf16*)(ws + WS_PROJA); bf16* gates = (bf16*)(ws + WS_GATES);
    bf16* omix = (bf16*)(ws + WS_OMIX);
    bf16* h2 = (bf16*)(ws + WS_H2); bf16* w1t = (bf16*)(ws + WS_W1T); bf16* w2t = (bf16*)(ws + WS_W2T); bf16* act = (bf16*)(ws + WS_ACT); bf16* y0 = (bf16*)(ws + WS_Y0); bf16* y1 = (bf16*)(ws + WS_Y1);
    MixPtrs X; X.projA = projA; X.gates = gates; X.ab = ab; X.conv_w = args.in[6]; X.a_log = args.in[7]; X.dt_bias = args.in[8]; X.hg_lb = args.in[10]; X.gdn_nw = args.in[9]; X.hg_nw = args.in[11];
    X.PG = (bf16*)(ws + WS_PG); X.BG = (bf16*)(ws + WS_BG); X.QP = (bf16*)(ws + WS_QP); X.OI = (bf16*)(ws + WS_OI); X.BH = (bf16*)(ws + WS_BH); X.QE = (bf16*)(ws + WS_QE); X.OIH = (bf16*)(ws + WS_OIH);
    X.SG = (bf16*)args.out; X.SH = (bf16*)args.out + (size_t)UNITS * 16384; X.omix = omix; X.GL = (float*)(ws + WS_GL); X.AH = (float*)(ws + WS_AH);
    const int* list = (const int*)(ws + WS_LIST); const float* listw = (const float*)(ws + WS_LISTW);
    LAS unsigned* tb = (LAS unsigned*)(lds + SCR2_OFF);

    for (int u = tid; u < (LDS_BYTES - LDSCTL_OFF) / 4; u += NWAVES * 64) ((LAS unsigned*)(lds + LDSCTL_OFF))[u] = 0u;
    __syncthreads();
    XcdBarrier bar = xcd_barrier_post((unsigned*)(ctl + CW_BAR) + args.li * XCD_BAR_WORDS, MISC + 8);
    const int lo = args.ph_lo, hi = args.ph_hi;
#define IN(k) (lo <= (k) && (k) < hi)
#define BOTH(k) (IN(k) && IN((k) + 1))

    if (IN(0)) {
#define PH_BODY do { \
        if (bx < 96) { \
            LAS float* part = (LAS float*)(lds + RING_BYTES); \
            const int e = bx * 64 + lane; float a0 = 0.f, a1 = 0.f; \
_Pragma("unroll 32") \
            for (int d = wave * 128; d < wave * 128 + 128; ++d) { const float w = w_ada[(size_t)d * 6144 + e]; a0 += siluf_(cvec[d]) * w; a1 += siluf_(cvec[D + d]) * w; } \
            part[(wave * 2 + 0) * 64 + lane] = a0; part[(wave * 2 + 1) * 64 + lane] = a1; \
            __syncthreads(); \
            if (tid < 128) { const int bb = tid >> 6, l = tid & 63; float s = 0.f; \
_Pragma("unroll") \
                for (int w = 0; w < 8; ++w) s += part[(w * 2 + bb) * 64 + l]; \
                mod[bb * 6144 + bx * 64 + l] = s + b_ada[bx * 64 + l]; } \
        } else if (bx == 96) { \
            for (int idx = tid; idx < 8192; idx += NWAVES * 64) wab[idx] = w_in[(size_t)(idx >> 3) * DIN + 2048 + (idx & 7)]; \
        } \
        { const float* w_router = args.in[14]; bf16* wrhi = (bf16*)(ws + WS_WRHI); bf16* wrlo = (bf16*)(ws + WS_WRLO); \
          for (int k = gw; k < 1024; k += NGW) { const float w = w_router[k * 64 + lane]; const unsigned hi = f2bf(w); \
              wrhi[lane * 1024 + k] = (bf16)hi; wrlo[lane * 1024 + k] = (bf16)f2bf(w - __uint_as_float(hi << 16)); } } \
        LAS float* scr = (LAS float*)(lds + wave * 16384); \
        constexpr int I_IN = 16 * 128, I_OUT = 16 * 32; \
        auto mk0 = [&](int it) { TrItem t; if (it < I_IN) { const int kb = it / 128, n0 = 32 * (it % 128); const int sc_ = n0 < 1536 ? n0 : (n0 < 3072 ? n0 + 520 : (n0 < 3584 ? n0 - 1536 : n0 + 8)); \
                t.W = w_in; t.ldw = DIN; t.src_col = sc_; t.WT = win_t; t.K = D; t.dst_row = n0; t.k0 = 64 * kb; } \
            else { const int r = it - I_IN, kb = r / 32, n0 = 32 * (r % 32); t.W = w_out; t.ldw = D; t.src_col = n0; t.WT = wout_t; t.K = D; t.dst_row = n0; t.k0 = 64 * kb; } return t; }; \
        TR_LOOP(gw, NGW, I_IN + I_OUT, mk0); \
        if (BOTH(0)) xcd_barrier(bar); \
    } while (0)
        PH_BODY; if (REPN(0) > 1) { PH_BODY; PH_BODY; }
#undef PH_BODY
    }
    if (IN(1)) {
#define PH_BODY do { \
        { \
            const GAS f32x4* wab4 = (const GAS f32x4*)wab; \
            for (int idx = tid; idx < 2048; idx += NWAVES * 64) { const int d = idx >> 1, qh = idx & 1; *(LAS f32x4*)(lds + (((qh * 4 + (d & 3)) * 256 + (d >> 2)) * 16)) = wab4[idx]; } \
            __syncthreads(); \
            const int nrows = (M - gw + NGW - 1) / NGW; \
            f32x4 sclr[4], shfr[4]; int curb = -1; \
            f32x4 vn[2][4]; \
_Pragma("unroll") \
            for (int q = 0; q < 2; ++q) { const int m = gw + q * NGW; \
_Pragma("unroll") \
                for (int j = 0; j < 4; ++j) vn[q][j] = (q < nrows) ? ((const GAS f32x4*)(x + (size_t)m * D) + lane)[64 * j] : (f32x4){0.f, 0.f, 0.f, 0.f}; } \
_Pragma("unroll 1") \
            for (int p = 0; p < nrows; p += 2) { \
                f32x4 v[2][4]; \
_Pragma("unroll") \
                for (int q = 0; q < 2; ++q) \
_Pragma("unroll") \
                    for (int j = 0; j < 4; ++j) v[q][j] = vn[q][j]; \
_Pragma("unroll") \
                for (int q = 0; q < 2; ++q) { const int m = gw + (p + 2 + q) * NGW; \
                    if (p + 2 + q < nrows) { \
_Pragma("unroll") \
                        for (int j = 0; j < 4; ++j) vn[q][j] = ((const GAS f32x4*)(x + (size_t)m * D) + lane)[64 * j]; } } \
_Pragma("unroll") \
                for (int q = 0; q < 2; ++q) { const int m = gw + (p + q) * NGW; \
                    if (p + q < nrows) { \
                        float ss = 0.f; \
_Pragma("unroll") \
                        for (int j = 0; j < 4; ++j) ss += (v[q][j].x * v[q][j].x + v[q][j].y * v[q][j].y) + (v[q][j].z * v[q][j].z + v[q][j].w * v[q][j].w); \
                        const float rstd = rsqrtf(wave_sum(ss) * (1.f / D) + 1e-6f); \
                        const int bsel = m >= T ? 1 : 0; \
                        if (bsel != curb) { curb = bsel; const GAS f32x4* sh4 = (const GAS f32x4*)(mod + bsel * 6144) + lane; \
_Pragma("unroll") \
                            for (int j = 0; j < 4; ++j) { sclr[j] = ((const GAS f32x4*)norm1_w + lane)[64 * j] * (sh4[256 + 64 * j] + 1.0f); shfr[j] = sh4[64 * j]; } } \
                        GAS unsigned long long* o8 = (GAS unsigned long long*)(h1 + (size_t)m * D) + lane; \
                        f32x4 a0 = {0.f, 0.f, 0.f, 0.f}, a1 = {0.f, 0.f, 0.f, 0.f}; \
_Pragma("unroll") \
                        for (int j = 0; j < 4; ++j) { __builtin_amdgcn_sched_barrier(0); const f32x4 h = v[q][j] * rstd * sclr[j] + shfr[j]; \
                            o8[64 * j] = (unsigned long long)pk2(h.x, h.y) | ((unsigned long long)pk2(h.z, h.w) << 32); \
_Pragma("unroll") \
                            for (int i = 0; i < 4; ++i) { a0 += *(const LAS f32x4*)(lds + ((i * 256 + lane + 64 * j) * 16)) * h[i]; a1 += *(const LAS f32x4*)(lds + (((4 + i) * 256 + lane + 64 * j) * 16)) * h[i]; } } \
 \
                        const bool up5 = (lane & 32) != 0, up4 = (lane & 16) != 0, up3 = (lane & 8) != 0; \
                        f32x4 k4; \
_Pragma("unroll") \
                        for (int e = 0; e < 4; ++e) { const float snd = up5 ? a0[e] : a1[e]; k4[e] = (up5 ? a1[e] : a0[e]) + __shfl_xor(snd, 32); } \
                        float k2[2]; \
_Pragma("unroll") \
                        for (int e = 0; e < 2; ++e) { const float snd = up4 ? k4[e] : k4[2 + e]; k2[e] = (up4 ? k4[2 + e] : k4[e]) + __shfl_xor(snd, 16); } \
                        float k1; { const float snd = up3 ? k2[0] : k2[1]; k1 = (up3 ? k2[1] : k2[0]) + __shfl_xor(snd, 8); } \
                        k1 += __shfl_xor(k1, 4); k1 += __shfl_xor(k1, 2); k1 += __shfl_xor(k1, 1); \
                        if ((lane & 7) == 0) ab[(size_t)m * 8 + 4 * (lane >> 5) + 2 * ((lane >> 4) & 1) + ((lane >> 3) & 1)] = k1; \
                    } } \
            } \
            __syncthreads(); \
        } \
        if (BOTH(1)) xcd_barrier(bar); \
    } while (0)
        PH_BODY; if (REPN(1) > 1) { PH_BODY; PH_BODY; }
#undef PH_BODY
    }
    if (IN(2)) {
#define PH_BODY do { \
        pg8::Gemm g{h1, win_t, M, 4096, D}; pg8::StaticOrder S; S.init(M, 4096, G, (int)blockIdx.x); \
        pg8::EpiProj E{projA, gates}; \
        pg8::gemm_phase<pg8::EpiProj, pg8::StaticOrder, true, true>(lds, g, S, E); \
        if (BOTH(2)) xcd_barrier(bar); \
    } while (0)
        PH_BODY; if (REPN(2) > 1) { PH_BODY; PH_BODY; }
#undef PH_BODY
    }

    if (IN(3)) {
#define PH_BODY do { \
        for (int u = vcu; u < UNITS; u += G) p3_gdn_unit(lds, X, u, tid, lane, wave); \
        for (int u = vcu; u < UNITS; u += G) p3_hgrn_unit(lds, X, u, tid, lane, wave); \
        if (BOTH(3)) xcd_barrier(bar); \
    } while (0)
        PH_BODY; if (REPN(3) > 1) { PH_BODY; PH_BODY; }
#undef PH_BODY
    }
    if (IN(4)) {
#define PH_BODY do { \
        if (bx < 64) p4_gdn_scan(lds, X, bx, lane, wave); \
        else { \
            if (wave < 3 && (bx - 64) * 3 + wave < 512) p4_hgrn_scan(X, (bx - 64) * 3 + wave, lane); \
            LAS float* scr = (LAS float*)(lds + wave * 16384); \
            const float* w_gate = args.in[16]; const float* w_up = args.in[17]; const float* w_down = args.in[18]; const float* ws_gate = args.in[19]; const float* ws_up = args.in[20]; const float* ws_down = args.in[21]; \
            auto mk4 = [&](int it) { TrItem t; const int e = it / 384, r = it % 384; \
                if (r < 256) { const int up = r >> 7, q = r & 127, kb = q >> 3, n0 = 32 * (q & 7); \
                    t.W = e < NE ? (up ? w_up : w_gate) + (size_t)e * D * DE : (up ? ws_up : ws_gate); t.ldw = DE; t.src_col = n0; t.WT = w1t + (size_t)e * 512 * 1024; t.K = D; t.dst_row = (n0 >> 7) * 256 + up * 128 + (n0 & 127); t.k0 = 64 * kb; } \
                else { const int q = r - 256, kb = q >> 5, n0 = 32 * (q & 31); \
                    t.W = e < NE ? w_down + (size_t)e * DE * D : ws_down; t.ldw = D; t.src_col = n0; t.WT = w2t + (size_t)e * 1024 * 256; t.K = DE; t.dst_row = n0; t.k0 = 64 * kb; } return t; }; \
            TR_LOOP((bx - 64) * NWAVES + wave, (G - 64) * NWAVES, NEX * 384, mk4); \
        } \
        if (BOTH(4)) xcd_barrier(bar); \
    } while (0)
        PH_BODY; if (REPN(4) > 1) { PH_BODY; PH_BODY; }
#undef PH_BODY
    }
    if (IN(5)) {
#define PH_BODY do { \
        for (int bn = vcu; bn < BATCH * 128; bn += G) p5_unit(lds, X, bn, lane, wave); \
        if (BOTH(5)) xcd_barrier(bar); \
    } while (0)
        PH_BODY; if (REPN(5) > 1) { PH_BODY; PH_BODY; }
#undef PH_BODY
    }
    if (IN(6)) {
#define PH_BODY do { \
        pg8::Gemm g{omix, wout_t, M, D, D}; pg8::StaticOrder S; S.init(M, D, G, (int)blockIdx.x); \
        pg8::EpiResid E{x, mod, args.out}; \
        pg8::gemm_phase<pg8::EpiResid, pg8::StaticOrder, true, true>(lds, g, S, E); \
        if (BOTH(6)) xcd_barrier(bar); \
    } while (0)
        PH_BODY; if (REPN(6) > 1) { PH_BODY; PH_BODY; }
#undef PH_BODY
    }


    if (IN(7)) {
        constexpr int HS = 2064;
        constexpr int R_HI = 0, R_LO = 33024, R_PART = 66048, R_SC = 98816, R_SEL = 102912, R_CNT = 107008, R_BASE = 107520, R_ESE = 108032, R_ESL = 110080, R_EW = 112128, R_ELP = 114176;
        if (tid < 128) *(LAS unsigned*)(lds + R_CNT + tid * 4) = 0u;
        __syncthreads();
        int nu = 0;
        const float* norm2_w = args.in[13]; const float* rbias = args.in[15]; const bf16* wrhi = (const bf16*)(ws + WS_WRHI); const bf16* wrlo = (const bf16*)(ws + WS_WRLO);
        int* listo = (int*)(ws + WS_LIST); float* listwo = (float*)(ws + WS_LISTW);
        const int r = lane & 15, g = lane >> 4;
#pragma unroll 1
        for (int u = vcu; u < M / 16; u += G, ++nu) {
            f32x4 sclr[4], shfr[4];
            { const GAS f32x4* sh4 = (const GAS f32x4*)(mod + (16 * u >= T ? 6144 : 0) + 3072) + lane;
#pragma unroll
              for (int j = 0; j < 4; ++j) { sclr[j] = ((const GAS f32x4*)norm2_w + lane)[64 * j] * (sh4[256 + 64 * j] + 1.0f); shfr[j] = sh4[64 * j]; } }
#pragma unroll
            for (int q = 0; q < 2; ++q) { const int rl = 2 * wave + q, m = 16 * u + rl;
                const GAS f32x4* xr = (const GAS f32x4*)(args.out + (size_t)m * D) + lane;
                f32x4 v[4]; float ss = 0.f;
#pragma unroll
                for (int j = 0; j < 4; ++j) { v[j] = xr[64 * j]; ss += (v[j].x * v[j].x + v[j].y * v[j].y) + (v[j].z * v[j].z + v[j].w * v[j].w); }
                const float rstd = rsqrtf(wave_sum(ss) * (1.f / D) + 1e-6f);
                GAS unsigned long long* o8 = (GAS unsigned long long*)(h2 + (size_t)m * D) + lane;
#pragma unroll
                for (int j = 0; j < 4; ++j) { const f32x4 hv = v[j] * rstd * sclr[j] + shfr[j];
                    const unsigned h0 = f2bf(hv.x), h1_ = f2bf(hv.y), h2_ = f2bf(hv.z), h3 = f2bf(hv.w);
                    const unsigned long long hi = (unsigned long long)(h0 | (h1_ << 16)) | ((unsigned long long)(h2_ | (h3 << 16)) << 32);
                    o8[64 * j] = hi;
                    const unsigned long long lo = (unsigned long long)pk2(hv.x - __uint_as_float(h0 << 16), hv.y - __uint_as_float(h1_ << 16)) | ((unsigned long long)pk2(hv.z - __uint_as_float(h2_ << 16), hv.w - __uint_as_float(h3 << 16)) << 32);
                    *(LAS unsigned long long*)(lds + R_HI + rl * HS + (lane + 64 * j) * 8) = hi; *(LAS unsigned long long*)(lds + R_LO + rl * HS + (lane + 64 * j) * 8) = lo; } }
            __syncthreads();
            { f32x4 acc[4];
#pragma unroll
              for (int nt = 0; nt < 4; ++nt) acc[nt] = (f32x4){0.f, 0.f, 0.f, 0.f};
#pragma unroll
              for (int ks = 0; ks < 4; ++ks) { const int kb = (128 * wave + 32 * ks + 8 * g) * 2;
                  const bf16x8 ahi = *(const LAS bf16x8*)(lds + R_HI + r * HS + kb), alo = *(const LAS bf16x8*)(lds + R_LO + r * HS + kb);
#pragma unroll
                  for (int nt = 0; nt < 4; ++nt) { const size_t o = (size_t)(16 * nt + r) * 1024 + 128 * wave + 32 * ks + 8 * g; const bf16x8 bh = *(const GAS bf16x8*)(wrhi + o), bl = *(const GAS bf16x8*)(wrlo + o);
                      acc[nt] = mfma16(ahi, bh, acc[nt]); acc[nt] = mfma16(ahi, bl, acc[nt]); acc[nt] = mfma16(alo, bh, acc[nt]); } }
#pragma unroll
              for (int nt = 0; nt < 4; ++nt)
#pragma unroll
                  for (int ii = 0; ii < 4; ++ii) *(LAS float*)(lds + R_PART + ((wave * 16 + 4 * g + ii) * 64 + 16 * nt + r) * 4) = acc[nt][ii]; }
            __syncthreads();
#pragma unroll
            for (int q = 0; q < 2; ++q) { const int idx = tid + 512 * q; float s = 0.f;
#pragma unroll
                for (int w = 0; w < 8; ++w) s += *(const LAS float*)(lds + R_PART + (w * 1024 + idx) * 4);
                const float sc = sigmoidf_(s); *(LAS float*)(lds + R_SC + idx * 4) = sc; *(LAS float*)(lds + R_SEL + idx * 4) = sc + rbias[idx & 63]; }
            __syncthreads();
#pragma unroll
            for (int q = 0; q < 2; ++q) { const int rl = 2 * wave + q, m = 16 * u + rl;
                const float sel = *(const LAS float*)(lds + R_SEL + (rl * 64 + lane) * 4), score = *(const LAS float*)(lds + R_SC + (rl * 64 + lane) * 4);
                float m1 = sel; m1 = fmaxf(m1, __shfl_xor(m1, 1)); m1 = fmaxf(m1, __shfl_xor(m1, 2)); m1 = fmaxf(m1, __shfl_xor(m1, 4));
                const unsigned long long eq = __ballot(sel == m1) & (0xFFull << (lane & 56)); const int first = __ffsll((long long)eq) - 1;
                float m2 = (lane == first) ? -INFINITY : sel; m2 = fmaxf(m2, __shfl_xor(m2, 1)); m2 = fmaxf(m2, __shfl_xor(m2, 2)); m2 = fmaxf(m2, __shfl_xor(m2, 4));
                const float gs = m1 + m2; const int mygrp = lane >> 3; int grank = 0;
#pragma unroll
                for (int gg = 0; gg < 8; ++gg) { const float o = __shfl(gs, 8 * gg); grank += (o > gs || (o == gs && gg < mygrp)) ? 1 : 0; }
                const float msel = grank < 4 ? sel : -INFINITY; int erank = 0;
#pragma unroll
                for (int e2 = 0; e2 < 64; ++e2) { const float o = __shfl(msel, e2); erank += (o > msel || (o == msel && e2 < lane)) ? 1 : 0; }
                const bool chosen = grank < 4 && erank < 8;
                const float wsum = wave_sum(chosen ? score : 0.f);
                if (chosen && nu < 4) { const int se = (m >= T ? 64 : 0) + lane; const unsigned lp = __hip_atomic_fetch_add((LAS unsigned*)(lds + R_CNT + se * 4), 1u, __ATOMIC_RELAXED, __HIP_MEMORY_SCOPE_WORKGROUP);
                    const int ei = ((nu * 16 + rl) * 8 + erank) * 4;
                    *(LAS int*)(lds + R_ESE + ei) = se; *(LAS int*)(lds + R_ESL + ei) = m * 8 + erank; *(LAS float*)(lds + R_EW + ei) = score / wsum * 2.5f; *(LAS unsigned*)(lds + R_ELP + ei) = lp; } }
            __syncthreads();
            if (nu == 3 || u + G >= M / 16) {
                if (tid < 128) { const unsigned c = *(LAS unsigned*)(lds + R_CNT + tid * 4); *(LAS unsigned*)(lds + R_BASE + tid * 4) = c ? __hip_atomic_fetch_add(ctl + CW_CNT + 64 * tid, c, RLX_AGENT) : 0u; }
                __syncthreads();
                for (int idx = tid; idx < (nu + 1) * 128; idx += NWAVES * 64) { const int se = *(LAS int*)(lds + R_ESE + idx * 4); const unsigned pos = *(LAS unsigned*)(lds + R_BASE + se * 4) + *(LAS unsigned*)(lds + R_ELP + idx * 4);
                    if (pos < (unsigned)CAP) { listo[(size_t)se * CAP + pos] = *(LAS int*)(lds + R_ESL + idx * 4); listwo[(size_t)se * CAP + pos] = *(LAS float*)(lds + R_EW + idx * 4); } }
                __syncthreads();
                if (tid < 128) *(LAS unsigned*)(lds + R_CNT + tid * 4) = 0u;
                __syncthreads();
                nu = -1;
            }
        }
        if (BOTH(7)) xcd_barrier(bar);
    }
    if (lo <= 12 && hi > 8) {
        if (tid < 130) { const int hf = tid >= 65 ? 1 : 0, e = tid - 65 * hf; unsigned c = 8192u;
            if (e < 64) { c = __hip_atomic_load(ctl + CW_CNT + 64 * (hf * 64 + e), RLX_AGENT); c = c < (unsigned)CAP ? c : (unsigned)CAP; }
            tb[TB_CNT + tid] = c; }
        __syncthreads();
        if (tid == 0) { unsigned ro = 0; for (int s = 0; s < 130; ++s) { tb[TB_OFF + s] = ro; ro += tb[TB_CNT + s]; } }
        __syncthreads();
    }
#define MOE_PREFIX(lo_, hi_, NT_, perm_) do { __syncthreads(); if (tid == 0) { unsigned up = 0; for (int s = (lo_); s < (hi_); ++s) { const int sg_ = (perm_) ? (s & 1) * 65 + (s >> 1) : s; tb[TB_PRE + s] = up; up += ((tb[TB_CNT + sg_] + 255u) >> 8) * (NT_); } tb[TB_PRE + (hi_)] = up; } __syncthreads(); } while (0)
    if (IN(8)) {
#define PH_BODY do { \
        MOE_PREFIX(0, 130, 2, 0); \
        pg8::Moe1Prob P{D, pg8::MoeSched{tb, 0, 130, 2, G, vcu, 0}, h2, w1t, list}; \
        pg8::EpiMoe1 E{act, tb}; \
        pg8::gemm_phase_g<pg8::Moe1Prob, pg8::EpiMoe1>(lds, P, E); \
        if (BOTH(8)) xcd_barrier(bar); \
    } while (0)
        PH_BODY; if (REPN(8) > 1) { PH_BODY; PH_BODY; }
#undef PH_BODY
    }
#pragma unroll 1
    for (int hf = 0; hf < 2; ++hf) {
        if (IN(9 + 2 * hf)) for (int rep_ = 0; rep_ < REPN(9 + 2 * hf); ++rep_) {
            MOE_PREFIX(65 * hf, 65 * hf + 65, 4, 0);
            pg8::Moe2Prob P{DE, pg8::MoeSched{tb, 65 * hf, 65 * hf + 65, 4, G, vcu, 0}, act, w2t, hf};
            pg8::EpiMoe2 E{y0, y1, args.out, mod, list, listw, tb, hf, rep_ == 0};
            pg8::gemm_phase_g<pg8::Moe2Prob, pg8::EpiMoe2>(lds, P, E);
            if (BOTH(9 + 2 * hf)) xcd_barrier(bar);
        }
        if (IN(10 + 2 * hf)) {
            const float* fw = args.in[22];
            const GAS f32x4* g24 = (const GAS f32x4*)(mod + hf * 6144 + 5120) + lane; const GAS f32x4* fw4 = (const GAS f32x4*)fw + lane;
            f32x4 g2r[4], fwr[4];
#pragma unroll
            for (int j = 0; j < 4; ++j) { g2r[j] = g24[64 * j]; fwr[j] = fw4[64 * j]; }
#pragma unroll 1
            for (int i0 = gw; i0 < 8192; i0 += 2 * NGW) {
                unsigned long long yq[2][8][4]; f32x4 xv[2][4];
#pragma unroll
                for (int q = 0; q < 2; ++q) { const int tl = (i0 + q * NGW < 8192) ? i0 + q * NGW : i0;
                    const GAS f32x4* xr = (const GAS f32x4*)(args.out + (size_t)(hf * 8192 + tl) * D) + lane;
                    const GAS unsigned long long* yr = (const GAS unsigned long long*)(tl < 4096 ? y0 + (size_t)tl * 8 * D : y1 + (size_t)(tl - 4096) * 8 * D) + lane;
#pragma unroll
                    for (int j = 0; j < 4; ++j) { xv[q][j] = xr[64 * j];
#pragma unroll
                        for (int k = 0; k < 8; ++k) yq[q][k][j] = yr[k * 256 + 64 * j]; } }
#pragma unroll
                for (int q = 0; q < 2; ++q) { const int tl = i0 + q * NGW;
                    if (tl < 8192) {
                        GAS f32x4* xr = (GAS f32x4*)(args.out + (size_t)(hf * 8192 + tl) * D) + lane;
                        f32x4 v[4]; float ss = 0.f;
#pragma unroll
                        for (int j = 0; j < 4; ++j) { f32x4 s = {0.f, 0.f, 0.f, 0.f};
#pragma unroll
                            for (int k = 0; k < 8; ++k) { const unsigned long long qq = yq[q][k][j]; const unsigned a = (unsigned)qq, bb = (unsigned)(qq >> 32);
                                s.x += __uint_as_float(a << 16); s.y += __uint_as_float(a & 0xffff0000u); s.z += __uint_as_float(bb << 16); s.w += __uint_as_float(bb & 0xffff0000u); }
                            v[j] = xv[q][j] + g2r[j] * s; ss += (v[j].x * v[j].x + v[j].y * v[j].y) + (v[j].z * v[j].z + v[j].w * v[j].w); }
                        const float rstd = rsqrtf(wave_sum(ss) * (1.f / D) + 1e-6f);
#pragma unroll
                        for (int j = 0; j < 4; ++j) xr[64 * j] = v[j] * rstd * fwr[j];
                    } }
            }
            if (BOTH(10 + 2 * hf)) xcd_barrier(bar);
        }
    }
#undef MOE_PREFIX
#undef IN
#undef BOTH
}

static void launch_mk(Args a, int lo, int hi, int li, int grid, hipStream_t stream) {
    a.ph_lo = lo; a.ph_hi = hi; a.li = li;
    hipLaunchKernelGGL(mk_fwd, dim3(grid), dim3(NWAVES * 64), LDS_BYTES, stream, a);
}
extern "C" void kernel_launch(void* const* d_in, const int* in_sizes, int n_in, void* d_out, int out_size, void* d_ws, size_t ws_size, hipStream_t stream) {
    static int grid = 0;
    if (grid == 0) {
        int dev = 0, cus = 0;
        if (hipGetDevice(&dev) != hipSuccess || hipDeviceGetAttribute(&cus, hipDeviceAttributeMultiprocessorCount, dev) != hipSuccess) { grid = -1; return; }
        if (hipFuncSetAttribute((const void*)mk_fwd, hipFuncAttributeMaxDynamicSharedMemorySize, LDS_BYTES) != hipSuccess) { grid = -1; return; }
        grid = cus;
    }
    if (grid < 0) return;
    unsigned char* ws = (unsigned char*)d_ws; float* out = (float*)d_out;
    (void)hipMemsetAsync(ws + WS_CTL, 0, CTL_ZERO_BYTES, stream);
    Args a{};
    for (int i = 0; i < 23; ++i) a.in[i] = (const float*)d_in[i];
    a.out = out; a.ws = ws;
    launch_mk(a, 0, 13, 0, grid, stream);
}
```

```cpp
#include <hip/hip_runtime.h>
#include <cstdio>
#include <cstdint>
namespace pg8 {
#define PG8_LAS __attribute__((address_space(3)))
typedef unsigned short bf16_t;
typedef short bf16x8 __attribute__((ext_vector_type(8)));
typedef float f32x4 __attribute__((ext_vector_type(4)));
typedef unsigned u32x4 __attribute__((ext_vector_type(4)));
constexpr int BM = 256, BK = 64, HALF = 128, HTB = HALF * BK * 2  , STAGE_BYTES = 8 * HTB, NXCD = 8, WGM = 8;

__host__ __device__ __forceinline__ int lds_byte(int r, int c) { const int st = (r >> 4) * 2 + (c >> 5), rr = r & 15, cc = c & 31, ob = rr * 64 + cc * 2; return st * 1024 + (ob ^ (((ob >> 9) & 1) << 5)); }
__host__ __device__ __forceinline__ void stage_rc(int b, int& R, int& C) { const int st = b / 1024, sb = b % 1024, swz = sb ^ (((sb >> 9) & 1) << 5); R = (st >> 1) * 16 + swz / 64; C = (st & 1) * 32 + (swz % 64) / 2; }
__host__ __device__ __forceinline__ int perm32(int rho) { const int n = rho >> 4, i = rho & 15; return 8 * (i >> 2) + 4 * n + (i & 3); }

struct Unit { int pm, pn; };
struct Gemm { const bf16_t* A; const bf16_t* Bt; int M, N, K; };

struct StaticOrder {
    int nM, nN, nwg, G, c;
    __host__ __device__ void init(int M, int N, int G_, int c_) { nM = M / BM; nN = N / BM; nwg = nM * nN; G = G_; c = c_; }
    __host__ __device__ bool next(int i, Unit& u) const {
        const long L = (long)i * G + c; if (L >= nwg) return false;
        int wgid = (int)L; { const int q = nwg / NXCD, r = nwg % NXCD, xcd = wgid % NXCD, off = wgid / NXCD; wgid = (xcd < r ? xcd * (q + 1) : r * (q + 1) + (xcd - r) * q) + off; }
        const int nig = WGM * nN, gid = wgid / nig, fm = gid * WGM, gsz = (nM - fm) < WGM ? (nM - fm) : WGM;
        u.pm = fm + ((wgid % nig) % gsz); u.pn = (wgid % nig) / gsz; return true;
    }
    __device__ __forceinline__ void a_ready(const Unit&) const {}
    __device__ __forceinline__ void done(const Unit&) const {}
};
__device__ __forceinline__ unsigned cvt_pk_bf16(float lo, float hi) { unsigned r; asm volatile("v_cvt_pk_bf16_f32 %0, %1, %2" : "=v"(r) : "v"(lo), "v"(hi)); return r; }
template <class Epi, class Sched, bool ALIGN_EPI = false, bool SP2 = false>
__device__ __forceinline__ void gemm_phase(PG8_LAS unsigned char* lds, const Gemm g, const Sched& S, const Epi& E) {
    const int tid = threadIdx.x, wid = __builtin_amdgcn_readfirstlane(tid >> 6), lane = tid & 63, wr = wid >> 2, wc = wid & 3, fr = lane & 15, fq = lane >> 4;
    const int K = g.K, nt = K / BK;
    unsigned voffA[2], voffB[2];
#pragma unroll
    for (int i = 0; i < 2; ++i) { int R, C; stage_rc(tid * 16 + i * 8192, R, C); const int Rb = Epi::PERM ? ((R & ~31) + perm32(R & 31)) : R;
        voffA[i] = (unsigned)(R * K + C) * 2u; voffB[i] = (unsigned)(Rb * K + C) * 2u; }
    const size_t kstep = (size_t)(BK * 2);
    const size_t hstep = (size_t)HALF * K * 2;
    const size_t tstep = 2 * hstep;
    const unsigned ldsw = (unsigned)wid * 1024u;
    const int aoff = lds_byte(wr * 64 + fr, fq * 8), boff = lds_byte(wc * 32 + fr, fq * 8);
#define PG8_SA(b, h) (((b) * 2 + (h)) * HTB)
#define PG8_SB(b, h) ((4 + (b) * 2 + (h)) * HTB)
#define PG8_STAGE(bufoff, gbase, voff) do { _Pragma("unroll") for (int _i = 0; _i < 2; ++_i) \
        __builtin_amdgcn_global_load_lds((const unsigned*)((const char*)(gbase) + (voff)[_i]), (PG8_LAS unsigned*)(lds + (bufoff) + ldsw + _i * 8192), 16, 0, 0); } while (0)
#define PG8_LDA(dst, b, h) do { _Pragma("unroll") for (int m = 0; m < 4; ++m) _Pragma("unroll") for (int k = 0; k < 2; ++k) dst[m][k] = *(const PG8_LAS bf16x8*)(lds + PG8_SA(b, h) + aoff + m * 2048 + k * 1024); } while (0)
#define PG8_LDB(dst, b, h) do { _Pragma("unroll") for (int n = 0; n < 2; ++n) _Pragma("unroll") for (int k = 0; k < 2; ++k) dst[n][k] = *(const PG8_LAS bf16x8*)(lds + PG8_SB(b, h) + boff + n * 2048 + k * 1024); } while (0)
#define PG8_MMA(ai, bj, At, Bt) do { __builtin_amdgcn_s_setprio(1); _Pragma("unroll") for (int m = 0; m < 4; ++m) _Pragma("unroll") for (int n = 0; n < 2; ++n) _Pragma("unroll") for (int k = 0; k < 2; ++k) \
        acc[ai][bj][m][n] = __builtin_amdgcn_mfma_f32_16x16x32_bf16(Bt[n][k], At[m][k], acc[ai][bj][m][n], 0, 0, 0); __builtin_amdgcn_s_setprio(0); } while (0)
#define PG8_WAIT_V(n) asm volatile("s_waitcnt vmcnt(" #n ")" ::: "memory")
#define PG8_WAIT_L(n) asm volatile("s_waitcnt lgkmcnt(" #n ")" ::: "memory")
#define PG8_BAR __builtin_amdgcn_s_barrier()
#define PG8_SCHED __builtin_amdgcn_sched_barrier(0)
    Unit cur, nxt; int ui = 0;
    if (!S.next(0, cur)) return;
    f32x4 acc[2][2][4][2];
#pragma unroll
    for (int a = 0; a < 2; ++a)
#pragma unroll
        for (int b = 0; b < 2; ++b)
#pragma unroll
            for (int m = 0; m < 4; ++m)
#pragma unroll
                for (int n = 0; n < 2; ++n) acc[a][b][m][n] = (f32x4){0.f, 0.f, 0.f, 0.f};
    bf16x8 At[4][2], B0[2][2], B1[2][2];
    const char* cA = (const char*)g.A + (size_t)cur.pm * tstep; const char* cB = (const char*)g.Bt + (size_t)cur.pn * tstep;
    S.a_ready(cur);
    if constexpr (SP2) {
        PG8_STAGE(PG8_SB(0, 0), cB, voffB); PG8_STAGE(PG8_SB(0, 1), cB + hstep, voffB); PG8_STAGE(PG8_SA(0, 0), cA, voffA); PG8_STAGE(PG8_SA(0, 1), cA + hstep, voffA);
        if (wr == 1) PG8_BAR;
        PG8_WAIT_V(2); PG8_BAR;
        PG8_STAGE(PG8_SB(1, 0), cB + kstep, voffB); PG8_STAGE(PG8_SA(1, 0), cA + kstep, voffA); PG8_STAGE(PG8_SB(1, 1), cB + hstep + kstep, voffB);
        PG8_WAIT_V(6); PG8_BAR;
    } else {
        PG8_STAGE(PG8_SB(0, 0), cB, voffB); PG8_STAGE(PG8_SA(0, 0), cA, voffA); PG8_STAGE(PG8_SB(0, 1), cB + hstep, voffB); PG8_STAGE(PG8_SA(0, 1), cA + hstep, voffA);
        if (wr == 1) PG8_BAR;
        PG8_WAIT_V(4); PG8_BAR;
        PG8_STAGE(PG8_SB(1, 0), cB + kstep, voffB); PG8_STAGE(PG8_SA(1, 0), cA + kstep, voffA); PG8_STAGE(PG8_SB(1, 1), cB + hstep + kstep, voffB);
        PG8_WAIT_V(6); PG8_BAR;
    }
    for (;;) {
        const bool has_next = S.next(ui + 1, nxt);
        const char* nA = has_next ? (const char*)g.A + (size_t)nxt.pm * tstep : cA; const char* nB = has_next ? (const char*)g.Bt + (size_t)nxt.pn * tstep : cB;
        for (int t = 0; t < nt; t += 2) {
            const bool last = (t == nt - 2);
            const char* a1 = cA + (size_t)(t + 1) * kstep;
            const char* a2 = last ? nA : cA + (size_t)(t + 2) * kstep; const char* b2 = last ? nB : cB + (size_t)(t + 2) * kstep;
            const char* a3 = a2 + kstep; const char* b3 = b2 + kstep;
            if (last && has_next) S.a_ready(nxt);
            if constexpr (SP2) {
            PG8_LDB(B0, 0, 0); PG8_LDB(B1, 0, 1); PG8_SCHED; PG8_LDA(At, 0, 0); PG8_STAGE(PG8_SA(1, 1), a1 + hstep, voffA);
            PG8_WAIT_V(8); PG8_WAIT_L(0); PG8_BAR; PG8_MMA(0, 0, At, B0); PG8_MMA(0, 1, At, B1); PG8_BAR; PG8_SCHED;
            PG8_LDA(At, 0, 1); PG8_STAGE(PG8_SB(0, 0), b2, voffB); PG8_STAGE(PG8_SB(0, 1), b2 + hstep, voffB); PG8_STAGE(PG8_SA(0, 0), a2, voffA);
            PG8_WAIT_V(8); PG8_WAIT_L(0); PG8_BAR; PG8_MMA(1, 0, At, B0); PG8_MMA(1, 1, At, B1); PG8_BAR; PG8_SCHED;
            PG8_LDB(B0, 1, 0); PG8_LDB(B1, 1, 1); PG8_SCHED; PG8_LDA(At, 1, 0); PG8_STAGE(PG8_SA(0, 1), a2 + hstep, voffA);
            PG8_WAIT_V(8); PG8_WAIT_L(0); PG8_BAR; PG8_MMA(0, 0, At, B0); PG8_MMA(0, 1, At, B1); PG8_BAR; PG8_SCHED;
            PG8_LDA(At, 1, 1); PG8_STAGE(PG8_SB(1, 0), b3, voffB); PG8_STAGE(PG8_SB(1, 1), b3 + hstep, voffB); PG8_STAGE(PG8_SA(1, 0), a3, voffA);
            PG8_WAIT_V(8); PG8_WAIT_L(0); PG8_BAR; PG8_MMA(1, 0, At, B0); PG8_MMA(1, 1, At, B1); PG8_BAR; PG8_SCHED;
            } else {
            PG8_LDB(B0, 0, 0); PG8_SCHED; PG8_LDA(At, 0, 0); PG8_STAGE(PG8_SA(1, 1), a1 + hstep, voffA);
            PG8_WAIT_L(8); PG8_BAR; PG8_WAIT_L(0); PG8_MMA(0, 0, At, B0); PG8_BAR; PG8_SCHED;
            PG8_LDB(B1, 0, 1); PG8_STAGE(PG8_SB(0, 0), b2, voffB);
            PG8_BAR; PG8_WAIT_L(0); PG8_MMA(0, 1, At, B1); PG8_BAR;
            PG8_LDA(At, 0, 1); PG8_STAGE(PG8_SA(0, 0), a2, voffA);
            PG8_BAR; PG8_WAIT_L(0); PG8_MMA(1, 0, At, B0); PG8_BAR; PG8_SCHED;
            PG8_STAGE(PG8_SB(0, 1), b2 + hstep, voffB);
            PG8_WAIT_V(6); PG8_BAR; PG8_MMA(1, 1, At, B1); PG8_BAR;
            PG8_LDB(B0, 1, 0); PG8_SCHED; PG8_LDA(At, 1, 0); PG8_STAGE(PG8_SA(0, 1), a2 + hstep, voffA);
            PG8_WAIT_L(8); PG8_BAR; PG8_WAIT_L(0); PG8_MMA(0, 0, At, B0); PG8_BAR; PG8_SCHED;
            PG8_LDB(B1, 1, 1); PG8_STAGE(PG8_SB(1, 0), b3, voffB);
            PG8_BAR; PG8_WAIT_L(0); PG8_MMA(0, 1, At, B1); PG8_BAR;
            PG8_LDA(At, 1, 1); PG8_STAGE(PG8_SA(1, 0), a3, voffA);
            PG8_BAR; PG8_WAIT_L(0); PG8_MMA(1, 0, At, B0); PG8_BAR; PG8_SCHED;
            PG8_STAGE(PG8_SB(1, 1), b3 + hstep, voffB);
            PG8_WAIT_V(6); PG8_BAR; PG8_MMA(1, 1, At, B1); PG8_BAR;
            }
        }
        if constexpr (ALIGN_EPI) { if (wr == 0) PG8_BAR; }
        if constexpr (!Epi::AFTER_DRAIN) { E(acc, cur, wr, wc, fr, fq); S.done(cur); }
        if (!has_next) break;
#pragma unroll
        for (int a = 0; a < 2; ++a)
#pragma unroll
            for (int b = 0; b < 2; ++b)
#pragma unroll
                for (int m = 0; m < 4; ++m)
#pragma unroll
                    for (int n = 0; n < 2; ++n) acc[a][b][m][n] = (f32x4){0.f, 0.f, 0.f, 0.f};
        cur = nxt; cA = nA; cB = nB; ++ui;
        if constexpr (ALIGN_EPI) { if (wr == 1) PG8_BAR; }
    }
    PG8_WAIT_V(0);
    if constexpr (!ALIGN_EPI) { if (wr == 0) PG8_BAR; }
    PG8_BAR;
    if constexpr (Epi::AFTER_DRAIN) { E.fused(acc, cur, wr, wc, fr, fq, lds, wid, lane); S.done(cur); }
#undef PG8_SA
#undef PG8_SB
#undef PG8_STAGE
#undef PG8_LDA
#undef PG8_LDB
#undef PG8_MMA
#undef PG8_WAIT_V
#undef PG8_WAIT_L
#undef PG8_BAR
#undef PG8_SCHED
}
}
#define GAS __attribute__((address_space(1)))
#define LAS __attribute__((address_space(3)))
typedef unsigned short bf16;
typedef unsigned v4u __attribute__((ext_vector_type(4)));
typedef float f32x4 __attribute__((ext_vector_type(4)));
typedef short bf16x8 __attribute__((ext_vector_type(8)));
typedef GAS unsigned gu32;
typedef GAS unsigned long long gu64;
#define RLX_AGENT __ATOMIC_RELAXED, __HIP_MEMORY_SCOPE_AGENT
#define LDS_WAIT() asm volatile("s_waitcnt lgkmcnt(0)" ::: "memory")
#define VM_WAIT() asm volatile("s_waitcnt vmcnt(0)" ::: "memory")
__device__ __forceinline__ unsigned long long rt() { return __builtin_amdgcn_s_memrealtime(); }
__device__ __forceinline__ unsigned f2bf(float f) { unsigned u = __builtin_bit_cast(unsigned, f); return (u + 0x7fffu + ((u >> 16) & 1u)) >> 16; }
__device__ __forceinline__ unsigned pk2(float lo, float hi) { return f2bf(lo) | (f2bf(hi) << 16); }
#define XB_TMO      128
#define XB_XCNT(j)  (256  + 64 * (j))
#define XB_XSUB(j)  (1280 + 64 * (j))
#define XB_XGEN(j)  (2304 + 64 * (j))
#define XB_TOP      3328
#define XB_TOPGEN   3392
#define XCD_BAR_WORDS 3456
#define XB_SPIN_CAP (1u << 18)

__device__ __forceinline__ unsigned xb_ld(unsigned* p)              { return __hip_atomic_load(p, __ATOMIC_RELAXED, __HIP_MEMORY_SCOPE_AGENT); }
__device__ __forceinline__ unsigned xb_add(unsigned* p, unsigned v) { return __hip_atomic_fetch_add(p, v, __ATOMIC_RELAXED, __HIP_MEMORY_SCOPE_AGENT); }
__device__ __forceinline__ unsigned xb_xcc_id() { return (unsigned)__builtin_amdgcn_s_getreg((3 << 11) | 20) & 0xFu; }
#define XB_SPIN(cond, bar) do { unsigned _sp = 0; while (cond) { __builtin_amdgcn_s_sleep(1); \
    if ((++_sp & 255u) == 0u) { if (xb_ld(&(bar)[XB_TMO])) break; if (_sp > XB_SPIN_CAP) { atomicAdd(&(bar)[XB_TMO], 1u); break; } } } } while (0)

struct XcdBarrier {
    unsigned* bar; unsigned x;
    volatile LAS unsigned* st;
};

__device__ __forceinline__ XcdBarrier xcd_barrier_post(unsigned* bar, volatile LAS unsigned* st) {
    XcdBarrier b; b.bar = bar; b.x = xb_xcc_id(); b.st = st;
    if (threadIdx.x == 0) (void)xb_add(&bar[XB_XCNT(b.x)], 1u);
    return b;
}
__device__ __forceinline__ void xcd_barrier_complete(unsigned* bar, unsigned x, unsigned& nloc, unsigned& nx) {
    const unsigned G = gridDim.x * gridDim.y * gridDim.z;
    unsigned sum, cnt, mine, sp = 0u;
    for (;;) {
        sum = 0u; cnt = 0u; mine = 0u;
#pragma unroll
        for (unsigned j = 0; j < 16; ++j) { const unsigned c = xb_ld(&bar[XB_XCNT(j)]); sum += c; cnt += (c > 0u) ? 1u : 0u; mine = (j == x) ? c : mine; }
        if (sum == G) break;
        __builtin_amdgcn_s_sleep(1);
        if ((++sp & 255u) == 0u) { if (xb_ld(&bar[XB_TMO])) break; if (sp > XB_SPIN_CAP) { atomicAdd(&bar[XB_TMO], 1u); break; } }
    }
    nloc = mine > 0u ? mine : 1u; nx = cnt > 0u ? cnt : 1u;
}

__device__ __forceinline__ void xcd_barrier(const XcdBarrier& b) {
    asm volatile("s_waitcnt vmcnt(0)" ::: "memory");
    __syncthreads();
    if (threadIdx.x == 0) {
        unsigned* bar = b.bar;
        __builtin_amdgcn_s_waitcnt(0);
        unsigned nloc = b.st[0], nx = b.st[1];
        if (nloc == 0u) { xcd_barrier_complete(bar, b.x, nloc, nx); b.st[0] = nloc; b.st[1] = nx; }
        const unsigned old = xb_add(&bar[XB_XSUB(b.x)], 1u);
        const unsigned gen = old / nloc;
        if (old + 1u == (gen + 1u) * nloc) {
            __builtin_amdgcn_fence(__ATOMIC_RELEASE, "agent");
            asm volatile("s_waitcnt vmcnt(0)" ::: "memory");
            const unsigned og = xb_add(&bar[XB_TOP], 1u);
            const unsigned tg = og / nx;
            if (og + 1u == (tg + 1u) * nx) xb_add(&bar[XB_TOPGEN], 1u);
            else XB_SPIN(xb_ld(&bar[XB_TOPGEN]) == tg, bar);
            __builtin_amdgcn_fence(__ATOMIC_ACQUIRE, "agent");
            xb_add(&bar[XB_XGEN(b.x)], 1u);
            asm volatile("s_waitcnt vmcnt(0)" ::: "memory");
        } else {
            XB_SPIN(xb_ld(&bar[XB_XGEN(b.x)]) == gen, bar);
            __builtin_amdgcn_fence(__ATOMIC_ACQUIRE, "agent");
            asm volatile("s_waitcnt vmcnt(0)" ::: "memory");
        }
    }
    __syncthreads();
}

namespace pg8 {
struct UnitG { int seg, mt, nt; };
template <class Prob, class Epi, bool FP8 = false>
__device__ __forceinline__ void gemm_phase_g(PG8_LAS unsigned char* lds, const Prob& P, const Epi& E) {
    const int tid = threadIdx.x, wid = __builtin_amdgcn_readfirstlane(tid >> 6), lane = tid & 63, wr = wid >> 2, wc = wid & 3, fr = lane & 15, fq = lane >> 4;
    constexpr int EB = FP8 ? 1 : 2;
    const int K = P.K, nt = K * EB / 128;
    unsigned voffB[2], cbA[2];
#pragma unroll
    for (int i = 0; i < 2; ++i) { int R, C; stage_rc(tid * 16 + i * 8192, R, C); const int Rb = Epi::PERM ? ((R & ~31) + perm32(R & 31)) : R; voffB[i] = (unsigned)(Rb * K * EB + C * 2); cbA[i] = (unsigned)(C * 2); }
    const unsigned pitchA = (unsigned)P.pitchA;
    const size_t kstep = (size_t)(BK * 2);
    const size_t hstep = (size_t)HALF * K * EB;
    const unsigned ldsw = (unsigned)wid * 1024u;
    const int aoff = lds_byte(wr * 64 + fr, fq * 8), boff = lds_byte(wc * 32 + fr, fq * 8);
#define PG8_SA(b, h) (((b) * 2 + (h)) * HTB)
#define PG8_SB(b, h) ((4 + (b) * 2 + (h)) * HTB)
#define PG8_STAGE(bufoff, gbase, voff) do { _Pragma("unroll") for (int _i = 0; _i < 2; ++_i) \
        __builtin_amdgcn_global_load_lds((const unsigned*)((const char*)(gbase) + (voff)[_i]), (PG8_LAS unsigned*)(lds + (bufoff) + ldsw + _i * 8192), 16, 0, 0); } while (0)
#define PG8_STAGE_A(bufoff, gbase, rp_) do { const unsigned o0_ = ((rp_) & 0xffffu) * pitchA + cbA[0], o1_ = ((rp_) >> 16) * pitchA + cbA[1]; \
        __builtin_amdgcn_global_load_lds((const unsigned*)((const char*)(gbase) + o0_), (PG8_LAS unsigned*)(lds + (bufoff) + ldsw), 16, 0, 0); \
        __builtin_amdgcn_global_load_lds((const unsigned*)((const char*)(gbase) + o1_), (PG8_LAS unsigned*)(lds + (bufoff) + ldsw + 8192), 16, 0, 0); } while (0)
#define PG8_LDA(dst, b, h) do { _Pragma("unroll") for (int m = 0; m < 4; ++m) { const v4i_ lo_ = *(const PG8_LAS v4i_*)(lds + PG8_SA(b, h) + aoff + m * 2048), hi_ = *(const PG8_LAS v4i_*)(lds + PG8_SA(b, h) + aoff + m * 2048 + 1024); dst[m] = __builtin_shufflevector(lo_, hi_, 0, 1, 2, 3, 4, 5, 6, 7); } } while (0)
#define PG8_LDB(dst, b, h) do { _Pragma("unroll") for (int n = 0; n < 2; ++n) { const v4i_ lo_ = *(const PG8_LAS v4i_*)(lds + PG8_SB(b, h) + boff + n * 2048), hi_ = *(const PG8_LAS v4i_*)(lds + PG8_SB(b, h) + boff + n * 2048 + 1024); dst[n] = __builtin_shufflevector(lo_, hi_, 0, 1, 2, 3, 4, 5, 6, 7); } } while (0)
#define PG8_HALF(v_, k_) __builtin_bit_cast(bf16x8, (v4i_)__builtin_shufflevector(v_, v_, 4 * (k_), 4 * (k_) + 1, 4 * (k_) + 2, 4 * (k_) + 3))
#define PG8_MMA(ai, bj, At, Bt) do { __builtin_amdgcn_s_setprio(1); _Pragma("unroll") for (int m = 0; m < 4; ++m) _Pragma("unroll") for (int n = 0; n < 2; ++n) { \
        acc[ai][bj][m][n] = __builtin_amdgcn_mfma_f32_16x16x32_bf16(PG8_HALF(Bt[n], 0), PG8_HALF(At[m], 0), acc[ai][bj][m][n], 0, 0, 0); \
        acc[ai][bj][m][n] = __builtin_amdgcn_mfma_f32_16x16x32_bf16(PG8_HALF(Bt[n], 1), PG8_HALF(At[m], 1), acc[ai][bj][m][n], 0, 0, 0); } __builtin_amdgcn_s_setprio(0); } while (0)
#define PG8_Q(v_, q_) __builtin_bit_cast(long, (v2i_){v_[2 * (q_)], v_[2 * (q_) + 1]})
#define PG8_MMA8Q(ai, bj, At, Bt, q_) _Pragma("unroll") for (int m = 0; m < 4; ++m) _Pragma("unroll") for (int n = 0; n < 2; ++n) \
            acc[ai][bj][m][n] = __builtin_amdgcn_mfma_f32_16x16x32_fp8_fp8(PG8_Q(Bt[n], q_), PG8_Q(At[m], q_), acc[ai][bj][m][n], 0, 0, 0)
#define PG8_MMA8(ai, bj, At, Bt) do { typedef int v2i_ __attribute__((ext_vector_type(2))); __builtin_amdgcn_s_setprio(1); \
        PG8_MMA8Q(ai, bj, At, Bt, 0); PG8_MMA8Q(ai, bj, At, Bt, 1); PG8_MMA8Q(ai, bj, At, Bt, 2); PG8_MMA8Q(ai, bj, At, Bt, 3); \
        __builtin_amdgcn_s_setprio(0); } while (0)
#define PG8_MM(ai, bj, At, Bt) do { if constexpr (FP8) PG8_MMA8(ai, bj, At, Bt); else PG8_MMA(ai, bj, At, Bt); } while (0)
#define PG8_WAIT_V(n) asm volatile("s_waitcnt vmcnt(" #n ")" ::: "memory")
#define PG8_WAIT_L(n) asm volatile("s_waitcnt lgkmcnt(" #n ")" ::: "memory")
#define PG8_BAR __builtin_amdgcn_s_barrier()
#define PG8_SCHED __builtin_amdgcn_sched_barrier(0)
    UnitG cur, nxt; int ui = 0;
    if (!P.next(0, cur)) return;
    f32x4 acc[2][2][4][2];
#pragma unroll
    for (int a = 0; a < 2; ++a)
#pragma unroll
        for (int b = 0; b < 2; ++b)
#pragma unroll
            for (int m = 0; m < 4; ++m)
#pragma unroll
                for (int n = 0; n < 2; ++n) acc[a][b][m][n] = (f32x4){0.f, 0.f, 0.f, 0.f};
    typedef int v4i_ __attribute__((ext_vector_type(4))); typedef int v8i_ __attribute__((ext_vector_type(8)));
    v8i_ At[4], B0[2], B1[2];
    unsigned rowp[2], rowpn[2];
    const char* cA; const char* cB;
    P.setup(cur, cA, rowp, cB);
    PG8_STAGE(PG8_SB(0, 0), cB, voffB); PG8_STAGE(PG8_SB(0, 1), cB + hstep, voffB); PG8_STAGE_A(PG8_SA(0, 0), cA, rowp[0]); PG8_STAGE_A(PG8_SA(0, 1), cA, rowp[1]);
    if (wr == 1) PG8_BAR;
    PG8_WAIT_V(2); PG8_BAR;
    PG8_STAGE(PG8_SB(1, 0), cB + kstep, voffB); PG8_STAGE_A(PG8_SA(1, 0), cA + kstep, rowp[0]); PG8_STAGE(PG8_SB(1, 1), cB + hstep + kstep, voffB);
    PG8_WAIT_V(6); PG8_BAR;
    for (;;) {
        const bool has_next = P.next(ui + 1, nxt);
        const char* nA = cA; const char* nB = cB;
        rowpn[0] = rowp[0]; rowpn[1] = rowp[1];
        if (has_next) P.setup(nxt, nA, rowpn, nB);
        for (int t = 0; t < nt; t += 2) {
            const bool last = (t == nt - 2);
            const char* a1 = cA + (size_t)(t + 1) * kstep;
            const char* a2 = last ? nA : cA + (size_t)(t + 2) * kstep; const char* b2 = last ? nB : cB + (size_t)(t + 2) * kstep;
            const char* a3 = a2 + kstep; const char* b3 = b2 + kstep;
            const unsigned o2_0 = last ? rowpn[0] : rowp[0], o2_1 = last ? rowpn[1] : rowp[1];
            PG8_LDB(B0, 0, 0); PG8_LDB(B1, 0, 1); PG8_SCHED; PG8_LDA(At, 0, 0); PG8_STAGE_A(PG8_SA(1, 1), a1, rowp[1]);
            PG8_WAIT_V(8); PG8_WAIT_L(0); PG8_BAR; PG8_MM(0, 0, At, B0); PG8_MM(0, 1, At, B1); PG8_BAR; PG8_SCHED;
            PG8_LDA(At, 0, 1); PG8_STAGE(PG8_SB(0, 0), b2, voffB); PG8_STAGE(PG8_SB(0, 1), b2 + hstep, voffB); PG8_STAGE_A(PG8_SA(0, 0), a2, o2_0);
            PG8_WAIT_V(8); PG8_WAIT_L(0); PG8_BAR; PG8_MM(1, 0, At, B0); PG8_MM(1, 1, At, B1); PG8_BAR; PG8_SCHED;
            PG8_LDB(B0, 1, 0); PG8_LDB(B1, 1, 1); PG8_SCHED; PG8_LDA(At, 1, 0); PG8_STAGE_A(PG8_SA(0, 1), a2, o2_1);
            PG8_WAIT_V(8); PG8_WAIT_L(0); PG8_BAR; PG8_MM(0, 0, At, B0); PG8_MM(0, 1, At, B1); PG8_BAR; PG8_SCHED;
            PG8_LDA(At, 1, 1); PG8_STAGE(PG8_SB(1, 0), b3, voffB); PG8_STAGE(PG8_SB(1, 1), b3 + hstep, voffB); PG8_STAGE_A(PG8_SA(1, 0), a3, o2_0);
            PG8_WAIT_V(8); PG8_WAIT_L(0); PG8_BAR; PG8_MM(1, 0, At, B0); PG8_MM(1, 1, At, B1); PG8_BAR; PG8_SCHED;
        }
        if (wr == 0) PG8_BAR;
        E(acc, cur, wr, wc, fr, fq);
        if (!has_next) break;
#pragma unroll
        for (int a = 0; a < 2; ++a)
#pragma unroll
            for (int b = 0; b < 2; ++b)
#pragma unroll
                for (int m = 0; m < 4; ++m)
#pragma unroll
                    for (int n = 0; n < 2; ++n) acc[a][b][m][n] = (f32x4){0.f, 0.f, 0.f, 0.f};
        cur = nxt; cA = nA; cB = nB; ++ui;
        rowp[0] = rowpn[0]; rowp[1] = rowpn[1];
        if (wr == 1) PG8_BAR;
    }
    PG8_WAIT_V(0);
    PG8_BAR;
#undef PG8_SA
#undef PG8_SB
#undef PG8_STAGE
#undef PG8_STAGE_A
#undef PG8_LDA
#undef PG8_LDB
#undef PG8_MMA
#undef PG8_MMA8
#undef PG8_Q
#undef PG8_MMA8Q
#undef PG8_HALF
#undef PG8_MM
#undef PG8_WAIT_V
#undef PG8_WAIT_L
#undef PG8_BAR
#undef PG8_SCHED
}
}

constexpr int NWAVES = 8;
constexpr int BATCH = 2, T = 8192, D = 1024, M = BATCH * T, DIN = 4104, PA = 3072;
constexpr int NE = 64, NEX = 65, DE = 256;
constexpr size_t MiB = 1u << 20;
constexpr size_t WS_CTL = 0, CTL_ZERO_BYTES = 256 * 1024;
constexpr size_t WS_WRHI = 512 * 1024, WS_WRLO = 640 * 1024;
constexpr size_t WS_MOD = 1 * MiB, WS_WAB = 1 * MiB + 256 * 1024, WS_AB = 1 * MiB + 512 * 1024;
constexpr size_t WS_WOUT_T = 2 * MiB, WS_WIN_T = 4 * MiB, WS_H1 = 12 * MiB, WS_PROJA = 44 * MiB, WS_GATES = 142 * MiB;
constexpr size_t WS_QP = 4 * MiB, WS_OI = 20 * MiB, WS_AH = 36 * MiB, WS_GL = 36 * MiB + 512 * 1024, WS_PG = 174 * MiB, WS_BG = 206 * MiB, WS_BH = 238 * MiB, WS_QE = 270 * MiB, WS_OIH = 286 * MiB;
constexpr size_t WS_OMIX = 174 * MiB;
constexpr size_t WS_H2 = 12 * MiB, WS_W1T = 44 * MiB, WS_W2T = 109 * MiB, WS_ACT = 142 * MiB, WS_LIST = 215 * MiB, WS_LISTW = 217 * MiB, WS_Y0 = 12 * MiB, WS_Y1 = 219 * MiB;
constexpr size_t WS_YS = 80 * MiB;
constexpr size_t WS_TOP = 302 * MiB;
constexpr int CAP = 4096;
constexpr int TB_PRE = 0, TB_CNT = 132, TB_OFF = 264;
constexpr int CW_CNT = 16384;
constexpr int CW_BAR = 4096;
constexpr int RING_BYTES = 131072, LDS_BYTES = 147456, LDSCTL_OFF = LDS_BYTES - 1024, MISC_OFF = LDSCTL_OFF + 320, SCR2_OFF = LDS_BYTES - 3072;

__device__ __forceinline__ float bf2f(bf16 v) { return __uint_as_float(((unsigned)v) << 16); }
__device__ __forceinline__ float sigmoidf_(float x) { return 1.f / (1.f + __expf(-x)); }
__device__ __forceinline__ float siluf_(float x) { return x / (1.f + __expf(-x)); }
__device__ __forceinline__ float softplusf_(float x) { return x > 20.f ? x : log1pf(expf(x)); }
__device__ __forceinline__ float wave_sum(float v) {
#pragma unroll
    for (int o = 1; o < 64; o <<= 1) v += __shfl_xor(v, o);
    return v;
}

namespace pg8 {
struct EpiProj {
    static constexpr bool PERM = true, AFTER_DRAIN = false;
    bf16_t* projA; bf16_t* gates;
    __device__ __forceinline__ void operator()(const f32x4 (&acc)[2][2][4][2], const Unit& u, int wr, int wc, int fr, int fq) const {
        const int row0 = u.pm * BM + wr * 64 + fr;
        bf16_t* base; int ldc, colt;
        if (u.pn < 12) { base = projA; ldc = 3072; colt = u.pn * BM; } else { base = gates; ldc = 1024; colt = (u.pn - 12) * BM; }
        const int col0 = colt + wc * 32 + 8 * fq;
#pragma unroll
        for (int ai = 0; ai < 2; ++ai)
#pragma unroll
            for (int m = 0; m < 4; ++m) { bf16_t* rowp = base + (size_t)(row0 + ai * HALF + m * 16) * ldc + col0;
#pragma unroll
                for (int bj = 0; bj < 2; ++bj) { const f32x4 v0 = acc[ai][bj][m][0], v1 = acc[ai][bj][m][1];
                    u32x4 w; w.x = cvt_pk_bf16(v0[0], v0[1]); w.y = cvt_pk_bf16(v0[2], v0[3]); w.z = cvt_pk_bf16(v1[0], v1[1]); w.w = cvt_pk_bf16(v1[2], v1[3]);
                    *(u32x4*)(rowp + bj * HALF) = w; } }
    }
};
struct EpiResid {
    static constexpr bool PERM = false, AFTER_DRAIN = false;
    const float* x; const float* mod; float* out;
    __device__ __forceinline__ void operator()(const f32x4 (&acc)[2][2][4][2], const Unit& u, int wr, int wc, int fr, int fq) const {
        const int col0 = u.pn * BM + wc * 32 + 4 * fq;
        const float* g1 = mod + (u.pm * BM >= 8192 ? 6144 : 0) + 2048;
        f32x4 gv[2][2];
#pragma unroll
        for (int bj = 0; bj < 2; ++bj)
#pragma unroll
            for (int n = 0; n < 2; ++n) gv[bj][n] = *(const f32x4*)(g1 + col0 + bj * HALF + n * 16);
#pragma unroll
        for (int ai = 0; ai < 2; ++ai)
#pragma unroll
            for (int mp = 0; mp < 4; mp += 2) { f32x4 xv[2][2][2];
#pragma unroll
                for (int q = 0; q < 2; ++q) { const size_t off = (size_t)(u.pm * BM + ai * HALF + wr * 64 + (mp + q) * 16 + fr) * 1024 + col0;
#pragma unroll
                    for (int bj = 0; bj < 2; ++bj)
#pragma unroll
                        for (int n = 0; n < 2; ++n) xv[q][bj][n] = *(const f32x4*)(x + off + bj * HALF + n * 16); }
#pragma unroll
                for (int q = 0; q < 2; ++q) { const size_t off = (size_t)(u.pm * BM + ai * HALF + wr * 64 + (mp + q) * 16 + fr) * 1024 + col0;
#pragma unroll
                    for (int bj = 0; bj < 2; ++bj)
#pragma unroll
                        for (int n = 0; n < 2; ++n) *(f32x4*)(out + off + bj * HALF + n * 16) = xv[q][bj][n] + gv[bj][n] * acc[ai][bj][mp + q][n]; }
            }
    }
};

struct MoeSched {
    const LAS unsigned* tb; int lo, hi, NT, G, c; int perm;
    __device__ __forceinline__ int segof(int p) const { return perm ? (p & 1) * 65 + (p >> 1) : p; }
    __device__ __forceinline__ bool next(int i, UnitG& u) const {
        const unsigned L = (unsigned)(i * G + c); if (L >= tb[TB_PRE + hi]) return false;
        int s = lo; while (L >= tb[TB_PRE + s + 1]) ++s;
        const int sg = segof(s);
        const unsigned loc = L - tb[TB_PRE + s], tiles = (tb[TB_CNT + sg] + 255u) >> 8;
        u.seg = __builtin_amdgcn_readfirstlane(sg); u.mt = __builtin_amdgcn_readfirstlane((int)(loc % tiles)); u.nt = __builtin_amdgcn_readfirstlane((int)(loc / tiles)); return true;
    }
};
struct Moe1Prob {
    int K; int pitchA; MoeSched S; const unsigned char* h2; const unsigned char* w1t; const int* list;
    __device__ __forceinline__ bool next(int i, UnitG& u) const { return S.next(i, u); }
    __device__ __forceinline__ void setup(const UnitG& u, const char*& cA, unsigned (&rowp)[2], const char*& cB) const {
        int sR[2], sC[2];
#pragma unroll
        for (int i = 0; i < 2; ++i) stage_rc((int)threadIdx.x * 16 + i * 8192, sR[i], sC[i]);
        const int hf = u.seg >= 65 ? 1 : 0, e = u.seg - 65 * hf; const int cnt = (int)S.tb[TB_CNT + u.seg];
#pragma unroll
        for (int h = 0; h < 2; ++h) { unsigned tk[2];
#pragma unroll
            for (int i = 0; i < 2; ++i) { const int r = 256 * u.mt + 128 * h + sR[i];
                if (e < 64) { const int rr = r < cnt ? r : cnt - 1; tk[i] = (unsigned)list[(size_t)(hf * 64 + e) * CAP + rr] >> 3; } else tk[i] = (unsigned)(hf * 8192 + (r < 8192 ? r : 8191)); }
            rowp[h] = tk[0] | (tk[1] << 16); }
        cA = (const char*)h2; cB = (const char*)(w1t + ((size_t)e * 512 + (size_t)u.nt * 256) * 1024);
    }
};
struct Moe2Prob {
    int K; int pitchA; MoeSched S; const unsigned char* act; const unsigned char* w2t;
    __device__ __forceinline__ bool next(int i, UnitG& u) const { return S.next(i, u); }
    __device__ __forceinline__ void setup(const UnitG& u, const char*& cA, unsigned (&rowp)[2], const char*& cB) const {
        int sR[2], sC[2];
#pragma unroll
        for (int i = 0; i < 2; ++i) stage_rc((int)threadIdx.x * 16 + i * 8192, sR[i], sC[i]);
        const int hf = u.seg >= 65 ? 1 : 0, e = u.seg - 65 * hf; const size_t rowbase = (size_t)S.tb[TB_OFF + u.seg] + 256u * (unsigned)u.mt;
#pragma unroll
        for (int h = 0; h < 2; ++h) rowp[h] = (unsigned)(128 * h + sR[0]) | ((unsigned)(128 * h + sR[1]) << 16);
        cA = (const char*)(act + rowbase * 256); cB = (const char*)(w2t + ((size_t)e * 1024 + (size_t)u.nt * 256) * 256);
    }
};
struct EpiMoe1 {
    static constexpr bool PERM = true;
    unsigned char* act; const LAS unsigned* tb;
    __device__ __forceinline__ void operator()(const f32x4 (&acc)[2][2][4][2], const UnitG& u, int wr, int wc, int fr, int fq) const {
        const int cnt = (int)tb[TB_CNT + u.seg]; const size_t rowbase = tb[TB_OFF + u.seg];
#pragma unroll
        for (int ai = 0; ai < 2; ++ai)
#pragma unroll
            for (int m = 0; m < 4; ++m) { const int r = 256 * u.mt + ai * HALF + wr * 64 + m * 16 + fr;
                if (r < cnt) { unsigned char* p = act + (rowbase + (size_t)r) * 256 + u.nt * 128 + wc * 32 + 8 * fq;
                    const f32x4 g0 = acc[ai][0][m][0], g1 = acc[ai][0][m][1], u0 = acc[ai][1][m][0], u1 = acc[ai][1][m][1]; f32x4 v0, v1;
#pragma unroll
                    for (int i = 0; i < 4; ++i) { const float ga = g0[i] * 0.03125f, gb = g1[i] * 0.03125f; v0[i] = ga / (1.f + __expf(-ga)) * (u0[i] * 0.25f); v1[i] = gb / (1.f + __expf(-gb)) * (u1[i] * 0.25f); }
                    unsigned o0 = __builtin_amdgcn_cvt_pk_fp8_f32(v0[0], v0[1], 0, false); o0 = __builtin_amdgcn_cvt_pk_fp8_f32(v0[2], v0[3], o0, true);
                    unsigned o1 = __builtin_amdgcn_cvt_pk_fp8_f32(v1[0], v1[1], 0, false); o1 = __builtin_amdgcn_cvt_pk_fp8_f32(v1[2], v1[3], o1, true);
                    typedef unsigned u32x2_ __attribute__((ext_vector_type(2)));
                    *(u32x2_*)p = (u32x2_){o0, o1}; } }
    }
};
struct EpiMoe2 {
    static constexpr bool PERM = true;
    unsigned char* y0; unsigned char* y1; unsigned char* ys; const int* list; const float* listw; const LAS unsigned* tb;
    __device__ __forceinline__ void operator()(const f32x4 (&acc)[2][2][4][2], const UnitG& u, int wr, int wc, int fr, int fq) const {
        const int hf = u.seg >= 65 ? 1 : 0; const int cnt = (int)tb[TB_CNT + u.seg]; const int e = u.seg - 65 * hf; const int colt = u.nt * 256 + wc * 32 + 8 * fq;
        int slot[2][4]; float wgt[2][4];
#pragma unroll
        for (int ai = 0; ai < 2; ++ai)
#pragma unroll
            for (int m = 0; m < 4; ++m) { const int r = 256 * u.mt + ai * HALF + wr * 64 + m * 16 + fr; const int rr = r < cnt ? r : cnt - 1;
                if (e < 64) { const size_t li = (size_t)(hf * 64 + e) * CAP + rr; slot[ai][m] = list[li]; wgt[ai][m] = listw[li] * 0.25f; } else { slot[ai][m] = hf * 8192 + rr; wgt[ai][m] = 0.25f; } }
#pragma unroll
        for (int ai = 0; ai < 2; ++ai)
#pragma unroll
            for (int m = 0; m < 4; ++m) { const int r = 256 * u.mt + ai * HALF + wr * 64 + m * 16 + fr;
                if (r < cnt) { const int sl = slot[ai][m]; const float w = wgt[ai][m];
                    unsigned char* p = (e < 64 ? (hf ? y1 + (size_t)(sl - 65536) * 1024 : y0 + (size_t)sl * 1024) : ys + (size_t)sl * 1024) + colt;
#pragma unroll
                    for (int bj = 0; bj < 2; ++bj) { const f32x4 v0 = acc[ai][bj][m][0] * w, v1 = acc[ai][bj][m][1] * w;
                        unsigned o0 = __builtin_amdgcn_cvt_pk_fp8_f32(v0[0], v0[1], 0, false); o0 = __builtin_amdgcn_cvt_pk_fp8_f32(v0[2], v0[3], o0, true);
                        unsigned o1 = __builtin_amdgcn_cvt_pk_fp8_f32(v1[0], v1[1], 0, false); o1 = __builtin_amdgcn_cvt_pk_fp8_f32(v1[2], v1[3], o1, true);
                        typedef unsigned u32x2_ __attribute__((ext_vector_type(2)));
                        *(u32x2_*)(p + bj * HALF) = (u32x2_){o0, o1}; } } }
    }
};
}

struct TrItem { const float* W; int ldw, src_col; bf16* WT; int K, dst_row, k0; float f8scale; };
__device__ __forceinline__ void tr_load(const TrItem& t, int lane, f32x4 (&v)[8]) {
#pragma unroll
    for (int i = 0; i < 8; ++i) v[i] = *(const GAS f32x4*)(t.W + (size_t)(t.k0 + 8 * i + (lane >> 3)) * t.ldw + t.src_col + 4 * (lane & 7));
}
__device__ __forceinline__ void tr_finish(const TrItem& t, int lane, const f32x4 (&v)[8], LAS float* scr) {
#pragma unroll
    for (int i = 0; i < 8; ++i) { LAS float* p = scr + (8 * i + (lane >> 3)) * 33 + 4 * (lane & 7); p[0] = v[i][0]; p[1] = v[i][1]; p[2] = v[i][2]; p[3] = v[i][3]; }
    LDS_WAIT(); asm volatile("" ::: "memory");
    const int c = lane & 7;
#pragma unroll
    for (int j = 0; j < 4; ++j) { const int n = (lane >> 3) + 8 * j; const LAS float* s = scr + (8 * c) * 33 + n;
        if (t.f8scale != 0.f) { const float q = t.f8scale; typedef unsigned u32x2_ __attribute__((ext_vector_type(2)));
            unsigned o0 = __builtin_amdgcn_cvt_pk_fp8_f32(s[0 * 33] * q, s[1 * 33] * q, 0, false); o0 = __builtin_amdgcn_cvt_pk_fp8_f32(s[2 * 33] * q, s[3 * 33] * q, o0, true);
            unsigned o1 = __builtin_amdgcn_cvt_pk_fp8_f32(s[4 * 33] * q, s[5 * 33] * q, 0, false); o1 = __builtin_amdgcn_cvt_pk_fp8_f32(s[6 * 33] * q, s[7 * 33] * q, o1, true);
            *(GAS u32x2_*)((GAS unsigned char*)t.WT + (size_t)(t.dst_row + n) * t.K + t.k0 + 8 * c) = (u32x2_){o0, o1};
        } else {
        v4u o; o.x = pk2(s[0 * 33], s[1 * 33]); o.y = pk2(s[2 * 33], s[3 * 33]); o.z = pk2(s[4 * 33], s[5 * 33]); o.w = pk2(s[6 * 33], s[7 * 33]);
        *(GAS v4u*)(t.WT + (size_t)(t.dst_row + n) * t.K + t.k0 + 8 * c) = o; } }
    LDS_WAIT(); asm volatile("" ::: "memory");
}
#define TR_LOOP(it0, stride, nitems, MAKE) do { int it_ = (it0); if (it_ < (nitems)) { TrItem cur_ = MAKE(it_); f32x4 va_[8], vb_[8]; tr_load(cur_, lane, va_); \
    for (;;) { const int nx_ = it_ + (stride); const bool hn_ = nx_ < (nitems); TrItem nxt_ = cur_; if (hn_) { nxt_ = MAKE(nx_); tr_load(nxt_, lane, vb_); } \
        tr_finish(cur_, lane, va_, scr); if (!hn_) break; _Pragma("unroll") for (int q_ = 0; q_ < 8; ++q_) va_[q_] = vb_[q_]; cur_ = nxt_; it_ = nx_; } } } while (0)

#ifndef REP_PHASE
#define REP_PHASE -1
#endif
#ifndef REP_N
#define REP_N 1
#endif
#define REPN(k) ((k) == REP_PHASE ? REP_N : 1)

constexpr int UNITS = BATCH * 128 * 4;
constexpr int L_QN = 0, L_KN = 17408, L_VV = 34816, L_LM = 52224, L_ATT = 68608, L_UT = 77824, L_WT = 96256, L_KTT = 114688, L_GCS = 133120, L_EGS = 133376, L_BET = 133632, L_SCW = 133888, L_SKT = 134144, L_TM = L_KN, L_TB = L_VV;
constexpr int H_FR = 0, H_QR = 17408, H_QE = 34816, H_KD = 52224, H_KTT = 69632, H_VT = 88064, H_AM = 106496;
constexpr int RS = 272, TS = 144;

typedef unsigned v2u __attribute__((ext_vector_type(2)));
#define LBAR() do { asm volatile("s_waitcnt lgkmcnt(0)" ::: "memory"); __builtin_amdgcn_s_barrier(); asm volatile("" ::: "memory"); } while (0)
__device__ __forceinline__ f32x4 mfma16(bf16x8 a, bf16x8 b, f32x4 c) { return __builtin_amdgcn_mfma_f32_16x16x32_bf16(a, b, c, 0, 0, 0); }
__device__ __forceinline__ bf16x8 ldsfrag(const LAS unsigned char* base, int row, int stride, int kbyte) { return *(const LAS bf16x8*)(base + row * stride + kbyte); }
__device__ __forceinline__ void unpack8(const v4u q, float (&f)[8]) {
    f[0] = __uint_as_float(q.x << 16); f[1] = __uint_as_float(q.x & 0xffff0000u); f[2] = __uint_as_float(q.y << 16); f[3] = __uint_as_float(q.y & 0xffff0000u);
    f[4] = __uint_as_float(q.z << 16); f[5] = __uint_as_float(q.z & 0xffff0000u); f[6] = __uint_as_float(q.w << 16); f[7] = __uint_as_float(q.w & 0xffff0000u); }
__device__ __forceinline__ f32x4 unpack4(const v2u q) { return (f32x4){__uint_as_float(q.x << 16), __uint_as_float(q.x & 0xffff0000u), __uint_as_float(q.y << 16), __uint_as_float(q.y & 0xffff0000u)}; }
__device__ __forceinline__ v2u pack4(const f32x4 v) { v2u o; o.x = pk2(v[0], v[1]); o.y = pk2(v[2], v[3]); return o; }
__device__ __forceinline__ float ldsbf(const LAS unsigned char* base, int row, int stride, int col) { return __uint_as_float(((unsigned)*(const LAS unsigned short*)(base + row * stride + col * 2)) << 16); }

struct MixPtrs {
    const bf16* projA; const bf16* gates; const float* ab; const float* conv_w; const float* a_log; const float* dt_bias; const float* hg_lb; const float* gdn_nw; const float* hg_nw;
    bf16 *PG, *BG, *QP, *OI, *BH, *QE, *OIH, *SG, *SH, *omix; float *GL, *AH;
};

__device__ __forceinline__ void p3_gdn_unit(LAS unsigned char* lds, const MixPtrs& X, int unit, int tid, int lane, int wave) {
    const int h = unit & 3, n = (unit >> 2) & 127, b = unit >> 9, r = lane & 15, g = lane >> 4;
    const size_t tok0 = (size_t)b * T + (size_t)n * 64;
    LAS float* gcs = (LAS float*)(lds + L_GCS); LAS float* egs = (LAS float*)(lds + L_EGS); LAS float* bet = (LAS float*)(lds + L_BET);
    {
#pragma unroll 1
      for (int ib = 0; ib < 6; ib += 3) {
        v4u raw[3][4];
#pragma unroll
        for (int i2 = 0; i2 < 3; ++i2) { const int i = ib + i2; const int pair = (tid >> 4) + 32 * i, tz = pair >> 6, c = pair & 63, ch = tid & 15, col = tz * 512 + h * 128 + ch * 8;
#pragma unroll
            for (int j = 0; j < 4; ++j) { const int tl = n * 64 + c - 3 + j; raw[i2][j] = *(const GAS v4u*)(X.projA + ((size_t)b * T + (tl < 0 ? 0 : tl)) * PA + col); } }
#pragma unroll
        for (int i2 = 0; i2 < 3; ++i2) { const int i = ib + i2;
            const int pair = (tid >> 4) + 32 * i, tz = pair >> 6, c = pair & 63, ch = tid & 15, col = tz * 512 + h * 128 + ch * 8;
            float y[8];
#pragma unroll
            for (int e = 0; e < 8; ++e) y[e] = 0.f;
#pragma unroll
            for (int j = 0; j < 4; ++j) { const int tl = n * 64 + c - 3 + j; const float msk = tl >= 0 ? 1.f : 0.f; float xf[8]; unpack8(raw[i2][j], xf);
                const f32x4 w0 = *(const GAS f32x4*)(X.conv_w + j * 1536 + col) * msk, w1 = *(const GAS f32x4*)(X.conv_w + j * 1536 + col + 4) * msk;
#pragma unroll
                for (int e = 0; e < 4; ++e) { y[e] += w0[e] * xf[e]; y[4 + e] += w1[e] * xf[4 + e]; } }
            float ss = 0.f;
#pragma unroll
            for (int e = 0; e < 8; ++e) { y[e] = siluf_(y[e]); ss += y[e] * y[e]; }
            ss += __shfl_xor(ss, 1); ss += __shfl_xor(ss, 2); ss += __shfl_xor(ss, 4); ss += __shfl_xor(ss, 8);
            const float rn = tz == 2 ? 1.f : rsqrtf(ss + 1e-6f) * (tz == 0 ? 0.08838834764831845f : 1.f);
            v4u o; o.x = pk2(y[0] * rn, y[1] * rn); o.y = pk2(y[2] * rn, y[3] * rn); o.z = pk2(y[4] * rn, y[5] * rn); o.w = pk2(y[6] * rn, y[7] * rn);
            *(LAS v4u*)(lds + (tz == 0 ? L_QN : (tz == 1 ? L_KN : L_VV)) + c * RS + ch * 16) = o;
        }
      }
    }
    if (wave == 0) {
        const float araw = X.ab[(tok0 + lane) * 8 + 4 + h], braw = X.ab[(tok0 + lane) * 8 + h];
        float gv = -expf(X.a_log[h]) * softplusf_(araw + X.dt_bias[h]);
#pragma unroll
        for (int o = 1; o < 64; o <<= 1) { const float t = __shfl_up(gv, o); if (lane >= o) gv += t; }
        { const float eg_ = __expf(gv), be_ = sigmoidf_(braw); gcs[lane] = gv; egs[lane] = eg_; bet[lane] = be_; *(LAS float*)(lds + L_SCW + lane * 4) = be_ * eg_; *(LAS float*)(lds + L_SKT + lane * 4) = __expf(__shfl(gv, 63) - gv); }
        if (lane == 63) X.GL[unit] = gv;
    }
    LBAR();
    {
        const int mt = wave >> 1;
#pragma unroll
        for (int q = 0; q < 2; ++q) { const int ntc = 2 * (wave & 1) + q; f32x4 akk = {0.f, 0.f, 0.f, 0.f}, aqk = {0.f, 0.f, 0.f, 0.f};
#pragma unroll
            for (int ks = 0; ks < 4; ++ks) { const bf16x8 ka = ldsfrag(lds + L_KN, 16 * mt + r, RS, 64 * ks + 16 * g), qa = ldsfrag(lds + L_QN, 16 * mt + r, RS, 64 * ks + 16 * g), kb = ldsfrag(lds + L_KN, 16 * ntc + r, RS, 64 * ks + 16 * g);
                akk = mfma16(ka, kb, akk); aqk = mfma16(qa, kb, aqk); }
            const int j = 16 * ntc + r; const float gj = gcs[j];
#pragma unroll
            for (int ii = 0; ii < 4; ++ii) { const int i = 16 * mt + 4 * g + ii; const float dec = (i >= j) ? __expf(gcs[i] - gj) : 0.f;
                *(LAS float*)(lds + L_LM + (i * 64 + j) * 4) = (i > j) ? bet[i] * akk[ii] * dec : 0.f;
                *(LAS unsigned short*)(lds + L_ATT + i * TS + j * 2) = (unsigned short)f2bf(aqk[ii] * dec); } }
    }
    LBAR();
#pragma unroll
    for (int i = 0; i < 2; ++i) { const int tsk = tid + 512 * i;
        if (tsk < 768) { const int a = tsk >> 8, hh = (tsk >> 7) & 1, d = tsk & 127;
            const LAS unsigned char* sp = lds + (a == 0 ? L_VV : L_KN) + d * 2; const LAS float* scl = (const LAS float*)(lds + (a == 0 ? L_BET : (a == 1 ? L_SCW : L_SKT)));
            LAS unsigned char* dp = lds + (a == 0 ? L_UT : (a == 1 ? L_WT : L_KTT)) + d * TS + 64 * hh;
#pragma unroll
            for (int q = 0; q < 4; ++q) { float kv[8];
#pragma unroll
                for (int e = 0; e < 8; ++e) { const int c = 32 * hh + 8 * q + e; kv[e] = __uint_as_float(((unsigned)*(const LAS unsigned short*)(sp + c * RS)) << 16) * scl[c]; }
                v4u o; o.x = pk2(kv[0], kv[1]); o.y = pk2(kv[2], kv[3]); o.z = pk2(kv[4], kv[5]); o.w = pk2(kv[6], kv[7]); *(LAS v4u*)(dp + 16 * q) = o; } } }
    LBAR();
    { const LAS float* Lm = (const LAS float*)(lds + L_LM); LAS float* Tm = (LAS float*)(lds + L_TM);
      if (tid < 64) { const int I = tid >> 4, j = tid & 15; float x[16];
#pragma unroll
          for (int i = 0; i < 16; ++i) { float s = (i == j) ? 1.f : 0.f;
#pragma unroll
              for (int kb = 0; kb < (i + 3) / 4; ++kb) { const f32x4 l = *(const LAS f32x4*)(Lm + (16 * I + i) * 64 + 16 * I + 4 * kb);
#pragma unroll
                  for (int e = 0; e < 4; ++e) if (4 * kb + e < i) s -= l[e] * x[4 * kb + e]; }
              x[i] = (i < j) ? 0.f : s; Tm[(16 * I + i) * 64 + 16 * I + j] = x[i]; } }
      LBAR();
#pragma unroll 1
      for (int lv = 1; lv < 4; ++lv) {
          for (int e = tid; e < (4 - lv) * 256; e += NWAVES * 64) { const int I = lv + (e >> 8), J = I - lv, rr = (e >> 4) & 15, cc = e & 15; float w = 0.f;
              for (int K = J; K < I; ++K) {
#pragma unroll
                  for (int kb = 0; kb < 4; ++kb) { const f32x4 l = *(const LAS f32x4*)(Lm + (16 * I + rr) * 64 + 16 * K + 4 * kb);
#pragma unroll
                      for (int q = 0; q < 4; ++q) w += l[q] * Tm[(16 * K + 4 * kb + q) * 64 + 16 * J + cc]; } }
              Tm[(16 * J + rr) * 64 + 16 * I + cc] = w; }
          LBAR();
          for (int e = tid; e < (4 - lv) * 256; e += NWAVES * 64) { const int I = lv + (e >> 8), J = I - lv, rr = (e >> 4) & 15, cc = e & 15; float t = 0.f;
#pragma unroll
              for (int kb = 0; kb < 4; ++kb) { const f32x4 l = *(const LAS f32x4*)(Tm + (16 * I + rr) * 64 + 16 * I + 4 * kb);
#pragma unroll
                  for (int q = 0; q < 4; ++q) t -= l[q] * Tm[(16 * J + 4 * kb + q) * 64 + 16 * I + cc]; }
              Tm[(16 * I + rr) * 64 + 16 * J + cc] = t; }
          LBAR();
      }
      { const int i = tid >> 3, j0 = (tid & 7) * 8; const f32x4 t0 = *(const LAS f32x4*)(Tm + i * 64 + j0), t1 = *(const LAS f32x4*)(Tm + i * 64 + j0 + 4); const bool keep = (i >> 4) >= (j0 >> 4);
        v4u o; o.x = keep ? pk2(t0[0], t0[1]) : 0u; o.y = keep ? pk2(t0[2], t0[3]) : 0u; o.z = keep ? pk2(t1[0], t1[1]) : 0u; o.w = keep ? pk2(t1[2], t1[3]) : 0u;
        *(LAS v4u*)(lds + L_TB + i * TS + j0 * 2) = o; }
      LBAR();
    }
    { bf16x8 af[4][2];
#pragma unroll
      for (int mt = 0; mt < 4; ++mt)
#pragma unroll
          for (int ks = 0; ks < 2; ++ks) af[mt][ks] = ldsfrag(lds + L_TB, 16 * mt + r, TS, 64 * ks + 16 * g);
#pragma unroll
      for (int q = 0; q < 2; ++q) { const int ng = 2 * wave + q; LAS unsigned char* base = lds + (ng >= 8 ? L_WT : L_UT) + (16 * (ng & 7) + r) * TS;
          const bf16x8 b0 = *(const LAS bf16x8*)(base + 16 * g), b1 = *(const LAS bf16x8*)(base + 64 + 16 * g);
          f32x4 acc[4];
#pragma unroll
          for (int mt = 0; mt < 4; ++mt) { acc[mt] = mfma16(af[mt][0], b0, (f32x4){0.f, 0.f, 0.f, 0.f}); acc[mt] = mfma16(af[mt][1], b1, acc[mt]); }
          asm volatile("s_waitcnt lgkmcnt(0)" ::: "memory");
#pragma unroll
          for (int mt = 0; mt < 4; ++mt) *(LAS v2u*)(base + (16 * mt + 4 * g) * 2) = pack4(acc[mt]); }
    }
    LBAR();
    {
        const size_t u16 = (size_t)unit * 16384, u8 = (size_t)unit * 8192;
        { const int kk = wave >> 1;
          bf16x8 af[2][2];
#pragma unroll
          for (int t2 = 0; t2 < 2; ++t2)
#pragma unroll
              for (int ks = 0; ks < 2; ++ks) af[t2][ks] = ldsfrag(lds + L_WT, 16 * (2 * kk + t2) + r, TS, 64 * ks + 16 * g);
#pragma unroll
          for (int q = 0; q < 4; ++q) { const int nt = 4 * (wave & 1) + q; f32x4 a0 = {0.f, 0.f, 0.f, 0.f}, a1 = {0.f, 0.f, 0.f, 0.f};
#pragma unroll
              for (int ks = 0; ks < 2; ++ks) { const bf16x8 bfr = ldsfrag(lds + L_KTT, 16 * nt + r, TS, 64 * ks + 16 * g); a0 = mfma16(af[0][ks], bfr, a0); a1 = mfma16(af[1][ks], bfr, a1); }
              v4u o; o.x = pk2(-a0[0], -a0[1]); o.y = pk2(-a0[2], -a0[3]); o.z = pk2(-a1[0], -a1[1]); o.w = pk2(-a1[2], -a1[3]);
              *(GAS v4u*)(X.PG + u16 + ((size_t)(nt * 4 + kk) * 64 + lane) * 8) = o; } }
        { const int mt = wave; bf16x8 af[2];
#pragma unroll
          for (int ks = 0; ks < 2; ++ks) af[ks] = ldsfrag(lds + L_KTT, 16 * mt + r, TS, 64 * ks + 16 * g);
#pragma unroll
          for (int nt = 0; nt < 8; ++nt) { f32x4 a0 = {0.f, 0.f, 0.f, 0.f};
#pragma unroll
              for (int ks = 0; ks < 2; ++ks) a0 = mfma16(af[ks], ldsfrag(lds + L_UT, 16 * nt + r, TS, 64 * ks + 16 * g), a0);
              *(GAS v2u*)(X.BG + u16 + ((size_t)(nt * 8 + mt) * 64 + lane) * 4) = pack4(a0); } }
        { const int kk = wave >> 1;
#pragma unroll
          for (int q = 0; q < 2; ++q) { const int ct = 2 * (wave & 1) + q; f32x4 a0 = {0.f, 0.f, 0.f, 0.f}, a1 = {0.f, 0.f, 0.f, 0.f};
#pragma unroll
              for (int ks = 0; ks < 2; ++ks) { const bf16x8 bfr = ldsfrag(lds + L_ATT, 16 * ct + r, TS, 64 * ks + 16 * g);
                  a0 = mfma16(ldsfrag(lds + L_WT, 16 * (2 * kk) + r, TS, 64 * ks + 16 * g), bfr, a0); a1 = mfma16(ldsfrag(lds + L_WT, 16 * (2 * kk + 1) + r, TS, 64 * ks + 16 * g), bfr, a1); }
              const int c = 16 * ct + r; const float eg = egs[c];
              const f32x4 q0 = unpack4(*(const LAS v2u*)(lds + L_QN + c * RS + (32 * kk + 4 * g) * 2)), q1 = unpack4(*(const LAS v2u*)(lds + L_QN + c * RS + (32 * kk + 16 + 4 * g) * 2));
              v4u o; o.x = pk2(q0[0] * eg - a0[0], q0[1] * eg - a0[1]); o.y = pk2(q0[2] * eg - a0[2], q0[3] * eg - a0[3]); o.z = pk2(q1[0] * eg - a1[0], q1[1] * eg - a1[1]); o.w = pk2(q1[2] * eg - a1[2], q1[3] * eg - a1[3]);
              *(GAS v4u*)(X.QP + u8 + ((size_t)(ct * 4 + kk) * 64 + lane) * 8) = o; } }
        { const int vt = wave; bf16x8 af[2];
#pragma unroll
          for (int ks = 0; ks < 2; ++ks) af[ks] = ldsfrag(lds + L_UT, 16 * vt + r, TS, 64 * ks + 16 * g);
#pragma unroll
          for (int ct = 0; ct < 4; ++ct) { f32x4 a0 = {0.f, 0.f, 0.f, 0.f};
#pragma unroll
              for (int ks = 0; ks < 2; ++ks) a0 = mfma16(af[ks], ldsfrag(lds + L_ATT, 16 * ct + r, TS, 64 * ks + 16 * g), a0);
              *(GAS v2u*)(X.OI + u8 + ((size_t)(vt * 4 + ct) * 64 + lane) * 4) = pack4(a0); } }
    }
    LBAR();
}

__device__ __forceinline__ void p3_hgrn_unit(LAS unsigned char* lds, const MixPtrs& X, int unit, int tid, int lane, int wave) {
    const int h = unit & 3, n = (unit >> 2) & 127, b = unit >> 9, r = lane & 15, g = lane >> 4;
    const size_t tok0 = (size_t)b * T + (size_t)n * 64;
#pragma unroll
    for (int i = 0; i < 4; ++i) { const int pair = (tid >> 4) + 32 * i, tz = pair >> 6, c = pair & 63, ch = tid & 15;
        const v4u q = *(const GAS v4u*)(X.projA + (tok0 + c) * PA + (tz ? 2560 : 1536) + h * 128 + ch * 8);
        *(LAS v4u*)(lds + (tz ? H_QR : H_FR) + c * RS + ch * 16) = q; }
    {
        v4u rv[2];
#pragma unroll
        for (int i = 0; i < 2; ++i) { const int item = tid + 512 * i, c = item >> 4, ch = item & 15; rv[i] = *(const GAS v4u*)(X.projA + (tok0 + c) * PA + 2048 + h * 128 + ch * 8); }
#pragma unroll
        for (int i = 0; i < 2; ++i) { const int item = tid + 512 * i, c = item >> 4, ch = item & 15; const unsigned w[4] = {rv[i].x, rv[i].y, rv[i].z, rv[i].w};
#pragma unroll
            for (int e = 0; e < 4; ++e) { *(LAS unsigned short*)(lds + H_VT + (ch * 8 + 2 * e) * TS + c * 2) = (unsigned short)(w[e] & 0xffffu); *(LAS unsigned short*)(lds + H_VT + (ch * 8 + 2 * e + 1) * TS + c * 2) = (unsigned short)(w[e] >> 16); } }
    }
    LBAR();
    {
        const int d = tid & 127, seg = tid >> 7; LAS float* segt = (LAS float*)(lds + H_AM + 9216);
        const float l0 = X.hg_lb[h * 128 + d], l1 = X.hg_lb[512 + h * 128 + d]; const float mx = fmaxf(l0, l1); const float e0 = __expf(l0 - mx), e1 = __expf(l1 - mx); const float lb = e0 / (e0 + e1);
        float lc[16], kq[16]; float run = 0.f;
#pragma unroll
        for (int ci = 0; ci < 16; ++ci) { const float sg = sigmoidf_(ldsbf(lds + H_FR, 16 * seg + ci, RS, d)); run += __logf(lb + (1.f - lb) * sg); lc[ci] = run; kq[ci] = (1.f - lb) * (1.f - sg); }
        segt[seg * 128 + d] = run;
        LBAR();
        const float t0 = segt[d], t1 = segt[128 + d], t2 = segt[256 + d], t3 = segt[384 + d];
        const float off = (seg > 0 ? t0 : 0.f) + (seg > 1 ? t1 : 0.f) + (seg > 2 ? t2 : 0.f), btot = (t0 + t1) + (t2 + t3);
        float kv[16];
#pragma unroll
        for (int ci = 0; ci < 16; ++ci) { const int c = 16 * seg + ci; const float bb = off + lc[ci];
            *(LAS unsigned short*)(lds + H_QE + c * RS + d * 2) = (unsigned short)f2bf(siluf_(ldsbf(lds + H_QR, c, RS, d)) * __expf(bb));
            *(LAS unsigned short*)(lds + H_KD + c * RS + d * 2) = (unsigned short)f2bf(kq[ci] * __expf(-bb));
            kv[ci] = kq[ci] * __expf(btot - bb); }
        if (seg == 0) X.AH[(size_t)unit * 128 + d] = __expf(btot);
#pragma unroll
        for (int q = 0; q < 2; ++q) { v4u o; o.x = pk2(kv[8 * q], kv[8 * q + 1]); o.y = pk2(kv[8 * q + 2], kv[8 * q + 3]); o.z = pk2(kv[8 * q + 4], kv[8 * q + 5]); o.w = pk2(kv[8 * q + 6], kv[8 * q + 7]);
            *(LAS v4u*)(lds + H_KTT + d * TS + (16 * seg + 8 * q) * 2) = o; }
    }
    LBAR();
    {
        const int mt = wave >> 1;
#pragma unroll
        for (int q = 0; q < 2; ++q) { const int ntc = 2 * (wave & 1) + q; f32x4 a0 = {0.f, 0.f, 0.f, 0.f};
#pragma unroll
            for (int ks = 0; ks < 4; ++ks) a0 = mfma16(ldsfrag(lds + H_QE, 16 * mt + r, RS, 64 * ks + 16 * g), ldsfrag(lds + H_KD, 16 * ntc + r, RS, 64 * ks + 16 * g), a0);
            const int j = 16 * ntc + r;
#pragma unroll
            for (int ii = 0; ii < 4; ++ii) { const int i = 16 * mt + 4 * g + ii; *(LAS unsigned short*)(lds + H_AM + i * TS + j * 2) = (unsigned short)f2bf((i >= j) ? a0[ii] : 0.f); } }
    }
    LBAR();
    {
        const size_t u16 = (size_t)unit * 16384, u8 = (size_t)unit * 8192;
        { const int mt = wave; bf16x8 af[2];
#pragma unroll
          for (int ks = 0; ks < 2; ++ks) af[ks] = ldsfrag(lds + H_KTT, 16 * mt + r, TS, 64 * ks + 16 * g);
#pragma unroll
          for (int nt = 0; nt < 8; ++nt) { f32x4 a0 = {0.f, 0.f, 0.f, 0.f};
#pragma unroll
              for (int ks = 0; ks < 2; ++ks) a0 = mfma16(af[ks], ldsfrag(lds + H_VT, 16 * nt + r, TS, 64 * ks + 16 * g), a0);
              *(GAS v2u*)(X.BH + u16 + ((size_t)(nt * 8 + mt) * 64 + lane) * 4) = pack4(a0); } }
        { const int vt = wave; bf16x8 af[2];
#pragma unroll
          for (int ks = 0; ks < 2; ++ks) af[ks] = ldsfrag(lds + H_VT, 16 * vt + r, TS, 64 * ks + 16 * g);
#pragma unroll
          for (int ct = 0; ct < 4; ++ct) { f32x4 a0 = {0.f, 0.f, 0.f, 0.f};
#pragma unroll
              for (int ks = 0; ks < 2; ++ks) a0 = mfma16(af[ks], ldsfrag(lds + H_AM, 16 * ct + r, TS, 64 * ks + 16 * g), a0);
              *(GAS v2u*)(X.OIH + u8 + ((size_t)(vt * 4 + ct) * 64 + lane) * 4) = pack4(a0); } }
#pragma unroll
        for (int q = 0; q < 2; ++q) { const int idx = wave * 2 + q, ct = idx >> 2, kk = idx & 3, c = 16 * ct + r;
            const v2u q0 = *(const LAS v2u*)(lds + H_QE + c * RS + (32 * kk + 4 * g) * 2), q1 = *(const LAS v2u*)(lds + H_QE + c * RS + (32 * kk + 16 + 4 * g) * 2);
            v4u o; o.x = q0.x; o.y = q0.y; o.z = q1.x; o.w = q1.y;
            *(GAS v4u*)(X.QE + u8 + ((size_t)(ct * 4 + kk) * 64 + lane) * 8) = o; }
    }
    LBAR();
}

__device__ __forceinline__ void p4_gdn_scan(LAS unsigned char* lds, const MixPtrs& X, int job, int lane, int wave) {
    const int s = job >> 3, h = job & 3, b = (job >> 2) & 1;
    const int unit0 = (b * 128) * 4 + h;
    constexpr int BRING = 131072, GLOFF = BRING + 3 * 4096;
    if (wave >= 4) {
        const int lw = wave - 4;
        const char* src0 = (const char*)(X.PG + (size_t)unit0 * 16384) + lw * 8192 + lane * 16;
        const char* bsrc0 = (const char*)(X.BG + (size_t)unit0 * 16384 + (size_t)(s * 8) * 256) + lw * 1024 + lane * 16;
#define P4_ISSUE_P(n_) do { const char* s_ = src0 + (size_t)(n_) * (4 * 32768); _Pragma("unroll") for (int i_ = 0; i_ < 8; ++i_) \
        __builtin_amdgcn_global_load_lds((const unsigned*)(s_ + i_ * 1024), (LAS unsigned*)(lds + ((n_) & 3) * 32768 + lw * 8192 + i_ * 1024), 16, 0, 2); } while (0)
#define P4_ISSUE_B(n_) __builtin_amdgcn_global_load_lds((const unsigned*)(bsrc0 + (size_t)(n_) * (4 * 32768)), (LAS unsigned*)(lds + BRING + ((n_) % 3) * 4096 + lw * 1024), 16, 0, 0)
        P4_ISSUE_P(0); P4_ISSUE_B(0); P4_ISSUE_P(1); P4_ISSUE_B(1); P4_ISSUE_P(2);
#pragma unroll 1
        for (int n = 0; n < 128; ++n) {
            if (n + 2 < 128) asm volatile("s_waitcnt vmcnt(17)" ::: "memory"); else if (n + 1 < 128) asm volatile("s_waitcnt vmcnt(9)" ::: "memory"); else asm volatile("s_waitcnt vmcnt(0)" ::: "memory");
            __builtin_amdgcn_s_barrier();
            asm volatile("" ::: "memory");
            if (n + 2 < 128) P4_ISSUE_B(n + 2);
            if (n + 3 < 128) P4_ISSUE_P(n + 3);
        }
#undef P4_ISSUE_P
#undef P4_ISSUE_B
    } else if (wave == 0) {
        f32x4 S[8]; bf16x8 sb[4];
#pragma unroll
        for (int mt = 0; mt < 8; ++mt) S[mt] = (f32x4){0.f, 0.f, 0.f, 0.f};
#pragma unroll
        for (int kk = 0; kk < 4; ++kk) { sb[kk] = (bf16x8){0, 0, 0, 0, 0, 0, 0, 0}; *(GAS bf16x8*)(X.SG + (size_t)unit0 * 16384 + ((size_t)(s * 4 + kk) * 64 + lane) * 8) = sb[kk]; }
        { const float g0 = X.GL[unit0 + 4 * lane], g1 = X.GL[unit0 + 4 * (64 + lane)]; *(LAS float*)(lds + GLOFF + lane * 4) = g0; *(LAS float*)(lds + GLOFF + (64 + lane) * 4) = g1; }
        asm volatile("s_waitcnt vmcnt(0) lgkmcnt(0)" ::: "memory");
#pragma unroll 1
        for (int n = 0; n < 128; ++n) {
            const int unit = unit0 + 4 * n;
            __builtin_amdgcn_s_barrier();
            asm volatile("" ::: "memory");
            const float e = __expf(*(const LAS float*)(lds + GLOFF + n * 4));
            const LAS unsigned char* bb = lds + BRING + (n % 3) * 4096 + lane * 8;
            f32x4 acc[8];
#pragma unroll
            for (int mt = 0; mt < 8; ++mt) acc[mt] = S[mt] * e + unpack4(*(const LAS v2u*)(bb + mt * 512));
            const LAS unsigned char* pb = lds + (n & 3) * 32768 + lane * 16;
#pragma unroll
            for (int kk = 0; kk < 4; ++kk)
#pragma unroll
                for (int mt = 0; mt < 8; ++mt) acc[mt] = mfma16(*(const LAS bf16x8*)(pb + (mt * 4 + kk) * 1024), sb[kk], acc[mt]);
#pragma unroll
            for (int mt = 0; mt < 8; ++mt) S[mt] = acc[mt];
#pragma unroll
            for (int kk = 0; kk < 4; ++kk) { const v2u lo = pack4(S[2 * kk]), hi = pack4(S[2 * kk + 1]); v4u o; o.x = lo.x; o.y = lo.y; o.z = hi.x; o.w = hi.y; sb[kk] = __builtin_bit_cast(bf16x8, o);
                if (n < 127) *(GAS v4u*)(X.SG + (size_t)(unit + 4) * 16384 + ((size_t)(s * 4 + kk) * 64 + lane) * 8) = o; }
            asm volatile("s_waitcnt lgkmcnt(0)" ::: "memory");
        }
    } else {
#pragma unroll 1
        for (int n = 0; n < 128; ++n) { __builtin_amdgcn_s_barrier(); asm volatile("" ::: "memory"); }
    }
}
__device__ __forceinline__ void p4_hgrn_scan(const MixPtrs& X, int task, int lane) {
    const int mt = task & 7, s = (task >> 3) & 7, h = (task >> 6) & 3, b = task >> 8, g = lane >> 4;
    const int unit0 = (b * 128) * 4 + h;
    f32x4 s0 = {0.f, 0.f, 0.f, 0.f};
    const GAS f32x4* ap = (const GAS f32x4*)(X.AH + (size_t)unit0 * 128 + 16 * mt + 4 * g);
    const GAS v2u* bp = (const GAS v2u*)(X.BH + (size_t)unit0 * 16384 + ((size_t)(s * 8 + mt) * 64 + lane) * 4);
    GAS v2u* sp = (GAS v2u*)(X.SH + (size_t)unit0 * 16384 + ((size_t)(s * 4 + (mt >> 1)) * 64 + lane) * 8 + 4 * (mt & 1));
    { v2u z; z.x = 0; z.y = 0; sp[0] = z; }
    f32x4 ra[8]; v2u rb[8];
#pragma unroll
    for (int j = 0; j < 8; ++j) { ra[j] = ap[(size_t)j * 128]; rb[j] = bp[(size_t)j * 16384]; }
#pragma unroll 1
    for (int n0 = 0; n0 < 128; n0 += 8) {
#pragma unroll
        for (int j = 0; j < 8; ++j) { const int n = n0 + j;
            s0 = ra[j] * s0 + unpack4(rb[j]);
            if (n + 8 < 128) { ra[j] = ap[(size_t)(n + 8) * 128]; rb[j] = bp[(size_t)(n + 8) * 16384]; }
            if (n < 127) sp[(size_t)(n + 1) * 16384] = pack4(s0); }
    }
}
__device__ __forceinline__ void p5_unit(LAS unsigned char* lds, const MixPtrs& X, int bn, int lane, int wave) {
    const int hd = wave & 3, type = wave >> 2, r = lane & 15, g = lane >> 4;
    const int unit = bn * 4 + hd; const size_t tok0 = (size_t)bn * 64;
    const bf16* SX = type ? X.SH : X.SG; const bf16* QX = type ? X.QE : X.QP; const bf16* OX = type ? X.OIH : X.OI;
    const size_t u16 = (size_t)unit * 16384, u8 = (size_t)unit * 8192;
    LAS float* exch = (LAS float*)lds;
    const float* nw = type ? X.hg_nw + hd * 128 : X.gdn_nw;
    bf16x8 af[4][8];
#pragma unroll
    for (int kk = 0; kk < 4; ++kk)
#pragma unroll
        for (int vt = 0; vt < 8; ++vt) af[kk][vt] = *(const GAS bf16x8*)(SX + u16 + ((size_t)(vt * 4 + kk) * 64 + lane) * 8);
#pragma unroll 1
    for (int ct = 0; ct < 4; ++ct) {
        bf16x8 bfr[4]; v2u oq[8], gtq[8];
#pragma unroll
        for (int kk = 0; kk < 4; ++kk) bfr[kk] = *(const GAS bf16x8*)(QX + u8 + ((size_t)(ct * 4 + kk) * 64 + lane) * 8);
#pragma unroll
        for (int vt = 0; vt < 8; ++vt) { oq[vt] = *(const GAS v2u*)(OX + u8 + ((size_t)(vt * 4 + ct) * 64 + lane) * 4);
            gtq[vt] = *(const GAS v2u*)(X.gates + (tok0 + 16 * ct + r) * 1024 + type * 512 + hd * 128 + 16 * vt + 4 * g); }
        f32x4 acc[8];
#pragma unroll
        for (int vt = 0; vt < 8; ++vt) acc[vt] = unpack4(oq[vt]);
#pragma unroll
        for (int kk = 0; kk < 4; ++kk)
#pragma unroll
            for (int vt = 0; vt < 8; ++vt) acc[vt] = mfma16(af[kk][vt], bfr[kk], acc[vt]);
        float ssq = 0.f;
#pragma unroll
        for (int vt = 0; vt < 8; ++vt) ssq += (acc[vt][0] * acc[vt][0] + acc[vt][1] * acc[vt][1]) + (acc[vt][2] * acc[vt][2] + acc[vt][3] * acc[vt][3]);
        ssq += __shfl_xor(ssq, 16); ssq += __shfl_xor(ssq, 32);
        if (type == 1 && g == 0) exch[(ct & 1) * 64 + hd * 16 + r] = ssq;
        LBAR();
        float rstd;
        if (type == 1) { const LAS float* ex = exch + (ct & 1) * 64 + r; rstd = rsqrtf(((ex[0] + ex[16]) + (ex[32] + ex[48])) * (1.f / 512.f) + 1e-6f); } else rstd = rsqrtf(ssq * (1.f / 128.f) + 1e-6f);
#pragma unroll
        for (int vt = 0; vt < 8; ++vt) { const f32x4 w4 = *(const GAS f32x4*)(nw + 16 * vt + 4 * g); const size_t off = (tok0 + 16 * ct + r) * 1024 + type * 512 + hd * 128 + 16 * vt + 4 * g;
            const f32x4 gt = unpack4(gtq[vt]); f32x4 o;
#pragma unroll
            for (int e = 0; e < 4; ++e) o[e] = acc[vt][e] * rstd * w4[e] * siluf_(gt[e]);
            *(GAS v2u*)(X.omix + off) = pack4(o); }
    }
    LBAR();
}

struct Args { const float* in[23]; float* out; unsigned char* ws; int ph_lo, ph_hi, li, pad; };

__global__ void __launch_bounds__(NWAVES * 64, 2) mk_fwd(Args args) {
    extern __shared__ __attribute__((aligned(16))) unsigned char lds_raw[];
    LAS unsigned char* lds = (LAS unsigned char*)lds_raw;
    volatile LAS unsigned* MISC = (volatile LAS unsigned*)(lds + MISC_OFF);
    const int tid = threadIdx.x, lane = tid & 63, wave = __builtin_amdgcn_readfirstlane(tid >> 6);
    const int G = gridDim.x, bx = blockIdx.x, vcu = (G % 8 == 0) ? (bx % 8) * (G / 8) + bx / 8 : bx;
    const int gw = vcu * NWAVES + wave, NGW = G * NWAVES;
    unsigned char* ws = args.ws;
    gu32* ctl = (gu32*)(ws + WS_CTL);
    const float* x = args.in[0]; const float* cvec = args.in[1]; const float* w_ada = args.in[2]; const float* b_ada = args.in[3]; const float* norm1_w = args.in[4];
    const float* w_in = args.in[5]; const float* w_out = args.in[12];
    float* mod = (float*)(ws + WS_MOD); float* wab = (float*)(ws + WS_WAB); float* ab = (float*)(ws + WS_AB);
    bf16* wout_t = (bf16*)(ws + WS_WOUT_T); bf16* win_t = (bf16*)(ws + WS_WIN_T); bf16* h1 = (bf16*)(ws + WS_H1); bf16* projA = (bf16*)(ws + WS_PROJA); bf16* gates = (bf16*)(ws + WS_GATES);
    bf16* omix = (bf16*)(ws + WS_OMIX);
    bf16* h2 = (bf16*)(ws + WS_H2); bf16* w1t = (bf16*)(ws + WS_W1T); bf16* w2t = (bf16*)(ws + WS_W2T); bf16* act = (bf16*)(ws + WS_ACT); bf16* y0 = (bf16*)(ws + WS_Y0); bf16* y1 = (bf16*)(ws + WS_Y1);
    MixPtrs X; X.projA = projA; X.gates = gates; X.ab = ab; X.conv_w = args.in[6]; X.a_log = args.in[7]; X.dt_bias = args.in[8]; X.hg_lb = args.in[10]; X.gdn_nw = args.in[9]; X.hg_nw = args.in[11];
    X.PG = (bf16*)(ws + WS_PG); X.BG = (bf16*)(ws + WS_BG); X.QP = (bf16*)(ws + WS_QP); X.OI = (bf16*)(ws + WS_OI); X.BH = (bf16*)(ws + WS_BH); X.QE = (bf16*)(ws + WS_QE); X.OIH = (bf16*)(ws + WS_OIH);
    X.SG = (bf16*)args.out; X.SH = (bf16*)args.out + (size_t)UNITS * 16384; X.omix = omix; X.GL = (float*)(ws + WS_GL); X.AH = (float*)(ws + WS_AH);
    const int* list = (const int*)(ws + WS_LIST); const float* listw = (const float*)(ws + WS_LISTW);
    LAS unsigned* tb = (LAS unsigned*)(lds + SCR2_OFF);

    for (int u = tid; u < (LDS_BYTES - LDSCTL_OFF) / 4; u += NWAVES * 64) ((LAS unsigned*)(lds + LDSCTL_OFF))[u] = 0u;
    __syncthreads();
    XcdBarrier bar = xcd_barrier_post((unsigned*)(ctl + CW_BAR) + args.li * XCD_BAR_WORDS, MISC + 8);
    const int lo = args.ph_lo, hi = args.ph_hi;
#define IN(k) (lo <= (k) && (k) < hi)
#define BOTH(k) (IN(k) && IN((k) + 1))

    if (IN(0)) {
#define PH_BODY do { \
        if (bx < 96) { \
            LAS float* part = (LAS float*)(lds + RING_BYTES); \
            const int e = bx * 64 + lane; float a0 = 0.f, a1 = 0.f; \
_Pragma("unroll 32") \
            for (int d = wave * 128; d < wave * 128 + 128; ++d) { const float w = w_ada[(size_t)d * 6144 + e]; a0 += siluf_(cvec[d]) * w; a1 += siluf_(cvec[D + d]) * w; } \
            part[(wave * 2 + 0) * 64 + lane] = a0; part[(wave * 2 + 1) * 64 + lane] = a1; \
            __syncthreads(); \
            if (tid < 128) { const int bb = tid >> 6, l = tid & 63; float s = 0.f; \
_Pragma("unroll") \
                for (int w = 0; w < 8; ++w) s += part[(w * 2 + bb) * 64 + l]; \
                mod[bb * 6144 + bx * 64 + l] = s + b_ada[bx * 64 + l]; } \
        } else if (bx == 96) { \
            for (int idx = tid; idx < 8192; idx += NWAVES * 64) wab[idx] = w_in[(size_t)(idx >> 3) * DIN + 2048 + (idx & 7)]; \
        } \
        { const float* w_router = args.in[14]; bf16* wrhi = (bf16*)(ws + WS_WRHI); bf16* wrlo = (bf16*)(ws + WS_WRLO); \
          for (int k = gw; k < 1024; k += NGW) { const float w = w_router[k * 64 + lane]; const unsigned hi = f2bf(w); \
              wrhi[lane * 1024 + k] = (bf16)hi; wrlo[lane * 1024 + k] = (bf16)f2bf(w - __uint_as_float(hi << 16)); } } \
        LAS float* scr = (LAS float*)(lds + wave * 16384); \
        constexpr int I_IN = 16 * 128, I_OUT = 16 * 32; \
        auto mk0 = [&](int it) { TrItem t; if (it < I_IN) { const int kb = it / 128, n0 = 32 * (it % 128); const int sc_ = n0 < 1536 ? n0 : (n0 < 3072 ? n0 + 520 : (n0 < 3584 ? n0 - 1536 : n0 + 8)); \
                t.W = w_in; t.ldw = DIN; t.src_col = sc_; t.WT = win_t; t.K = D; t.dst_row = n0; t.k0 = 64 * kb; t.f8scale = 0.f; } \
            else { const int r = it - I_IN, kb = r / 32, n0 = 32 * (r % 32); t.W = w_out; t.ldw = D; t.src_col = n0; t.WT = wout_t; t.K = D; t.dst_row = n0; t.k0 = 64 * kb; t.f8scale = 0.f; } return t; }; \
        TR_LOOP(gw, NGW, I_IN + I_OUT, mk0); \
        if (BOTH(0)) xcd_barrier(bar); \
    } while (0)
        PH_BODY; if (REPN(0) > 1) { PH_BODY; PH_BODY; }
#undef PH_BODY
    }
    if (IN(1)) {
#define PH_BODY do { \
        { \
            const GAS f32x4* wab4 = (const GAS f32x4*)wab; \
            for (int idx = tid; idx < 2048; idx += NWAVES * 64) { const int d = idx >> 1, qh = idx & 1; *(LAS f32x4*)(lds + (((qh * 4 + (d & 3)) * 256 + (d >> 2)) * 16)) = wab4[idx]; } \
            __syncthreads(); \
            const int nrows = (M - gw + NGW - 1) / NGW; \
            f32x4 sclr[4], shfr[4]; int curb = -1; \
            f32x4 vn[2][4]; \
_Pragma("unroll") \
            for (int q = 0; q < 2; ++q) { const int m = gw + q * NGW; \
_Pragma("unroll") \
                for (int j = 0; j < 4; ++j) vn[q][j] = (q < nrows) ? ((const GAS f32x4*)(x + (size_t)m * D) + lane)[64 * j] : (f32x4){0.f, 0.f, 0.f, 0.f}; } \
_Pragma("unroll 1") \
            for (int p = 0; p < nrows; p += 2) { \
                f32x4 v[2][4]; \
_Pragma("unroll") \
                for (int q = 0; q < 2; ++q) \
_Pragma("unroll") \
                    for (int j = 0; j < 4; ++j) v[q][j] = vn[q][j]; \
_Pragma("unroll") \
                for (int q = 0; q < 2; ++q) { const int m = gw + (p + 2 + q) * NGW; \
                    if (p + 2 + q < nrows) { \
_Pragma("unroll") \
                        for (int j = 0; j < 4; ++j) vn[q][j] = ((const GAS f32x4*)(x + (size_t)m * D) + lane)[64 * j]; } } \
_Pragma("unroll") \
                for (int q = 0; q < 2; ++q) { const int m = gw + (p + q) * NGW; \
                    if (p + q < nrows) { \
                        float ss = 0.f; \
_Pragma("unroll") \
                        for (int j = 0; j < 4; ++j) ss += (v[q][j].x * v[q][j].x + v[q][j].y * v[q][j].y) + (v[q][j].z * v[q][j].z + v[q][j].w * v[q][j].w); \
                        const float rstd = rsqrtf(wave_sum(ss) * (1.f / D) + 1e-6f); \
                        const int bsel = m >= T ? 1 : 0; \
                        if (bsel != curb) { curb = bsel; const GAS f32x4* sh4 = (const GAS f32x4*)(mod + bsel * 6144) + lane; \
_Pragma("unroll") \
                            for (int j = 0; j < 4; ++j) { sclr[j] = ((const GAS f32x4*)norm1_w + lane)[64 * j] * (sh4[256 + 64 * j] + 1.0f); shfr[j] = sh4[64 * j]; } } \
                        GAS unsigned long long* o8 = (GAS unsigned long long*)(h1 + (size_t)m * D) + lane; \
                        f32x4 a0 = {0.f, 0.f, 0.f, 0.f}, a1 = {0.f, 0.f, 0.f, 0.f}; \
_Pragma("unroll") \
                        for (int j = 0; j < 4; ++j) { __builtin_amdgcn_sched_barrier(0); const f32x4 h = v[q][j] * rstd * sclr[j] + shfr[j]; \
                            o8[64 * j] = (unsigned long long)pk2(h.x, h.y) | ((unsigned long long)pk2(h.z, h.w) << 32); \
_Pragma("unroll") \
                            for (int i = 0; i < 4; ++i) { a0 += *(const LAS f32x4*)(lds + ((i * 256 + lane + 64 * j) * 16)) * h[i]; a1 += *(const LAS f32x4*)(lds + (((4 + i) * 256 + lane + 64 * j) * 16)) * h[i]; } } \
 \
                        const bool up5 = (lane & 32) != 0, up4 = (lane & 16) != 0, up3 = (lane & 8) != 0; \
                        f32x4 k4; \
_Pragma("unroll") \
                        for (int e = 0; e < 4; ++e) { const float snd = up5 ? a0[e] : a1[e]; k4[e] = (up5 ? a1[e] : a0[e]) + __shfl_xor(snd, 32); } \
                        float k2[2]; \
_Pragma("unroll") \
                        for (int e = 0; e < 2; ++e) { const float snd = up4 ? k4[e] : k4[2 + e]; k2[e] = (up4 ? k4[2 + e] : k4[e]) + __shfl_xor(snd, 16); } \
                        float k1; { const float snd = up3 ? k2[0] : k2[1]; k1 = (up3 ? k2[1] : k2[0]) + __shfl_xor(snd, 8); } \
                        k1 += __shfl_xor(k1, 4); k1 += __shfl_xor(k1, 2); k1 += __shfl_xor(k1, 1); \
                        if ((lane & 7) == 0) ab[(size_t)m * 8 + 4 * (lane >> 5) + 2 * ((lane >> 4) & 1) + ((lane >> 3) & 1)] = k1; \
                    } } \
            } \
            __syncthreads(); \
        } \
        if (BOTH(1)) xcd_barrier(bar); \
    } while (0)
        PH_BODY; if (REPN(1) > 1) { PH_BODY; PH_BODY; }
#undef PH_BODY
    }
    if (IN(2)) {
#define PH_BODY do { \
        pg8::Gemm g{h1, win_t, M, 4096, D}; pg8::StaticOrder S; S.init(M, 4096, G, (int)blockIdx.x); \
        pg8::EpiProj E{projA, gates}; \
        pg8::gemm_phase<pg8::EpiProj, pg8::StaticOrder, true, true>(lds, g, S, E); \
        if (BOTH(2)) xcd_barrier(bar); \
    } while (0)
        PH_BODY; if (REPN(2) > 1) { PH_BODY; PH_BODY; }
#undef PH_BODY
    }

    if (IN(3)) {
#define PH_BODY do { \
        for (int u = vcu; u < UNITS; u += G) p3_gdn_unit(lds, X, u, tid, lane, wave); \
        for (int u = vcu; u < UNITS; u += G) p3_hgrn_unit(lds, X, u, tid, lane, wave); \
        if (BOTH(3)) xcd_barrier(bar); \
    } while (0)
        PH_BODY; if (REPN(3) > 1) { PH_BODY; PH_BODY; }
#undef PH_BODY
    }
    if (IN(4)) {
#define PH_BODY do { \
        if (bx < 64) p4_gdn_scan(lds, X, bx, lane, wave); \
        else { \
            if (wave < 3 && (bx - 64) * 3 + wave < 512) p4_hgrn_scan(X, (bx - 64) * 3 + wave, lane); \
            LAS float* scr = (LAS float*)(lds + wave * 16384); \
            const float* w_gate = args.in[16]; const float* w_up = args.in[17]; const float* w_down = args.in[18]; const float* ws_gate = args.in[19]; const float* ws_up = args.in[20]; const float* ws_down = args.in[21]; \
            auto mk4 = [&](int it) { TrItem t; const int e = it / 384, r = it % 384; \
                if (r < 256) { const int up = r >> 7, q = r & 127, kb = q >> 3, n0 = 32 * (q & 7); \
                    t.W = e < NE ? (up ? w_up : w_gate) + (size_t)e * D * DE : (up ? ws_up : ws_gate); t.ldw = DE; t.src_col = n0; t.WT = (bf16*)((unsigned char*)w1t + (size_t)e * 512 * 1024); t.K = D; t.dst_row = (n0 >> 7) * 256 + up * 128 + (n0 & 127); t.k0 = 64 * kb; t.f8scale = 32.f; } \
                else { const int q = r - 256, kb = q >> 5, n0 = 32 * (q & 31); \
                    t.W = e < NE ? w_down + (size_t)e * DE * D : ws_down; t.ldw = D; t.src_col = n0; t.WT = (bf16*)((unsigned char*)w2t + (size_t)e * 1024 * 256); t.K = DE; t.dst_row = n0; t.k0 = 64 * kb; t.f8scale = 16.f; } return t; }; \
            TR_LOOP((bx - 64) * NWAVES + wave, (G - 64) * NWAVES, NEX * 384, mk4); \
        } \
        if (BOTH(4)) xcd_barrier(bar); \
    } while (0)
        PH_BODY; if (REPN(4) > 1) { PH_BODY; PH_BODY; }
#undef PH_BODY
    }
    if (IN(5)) {
#define PH_BODY do { \
        for (int bn = vcu; bn < BATCH * 128; bn += G) p5_unit(lds, X, bn, lane, wave); \
        if (BOTH(5)) xcd_barrier(bar); \
    } while (0)
        PH_BODY; if (REPN(5) > 1) { PH_BODY; PH_BODY; }
#undef PH_BODY
    }
    if (IN(6)) {
#define PH_BODY do { \
        pg8::Gemm g{omix, wout_t, M, D, D}; pg8::StaticOrder S; S.init(M, D, G, (int)blockIdx.x); \
        pg8::EpiResid E{x, mod, args.out}; \
        pg8::gemm_phase<pg8::EpiResid, pg8::StaticOrder, true, true>(lds, g, S, E); \
        if (BOTH(6)) xcd_barrier(bar); \
    } while (0)
        PH_BODY; if (REPN(6) > 1) { PH_BODY; PH_BODY; }
#undef PH_BODY
    }


    if (IN(7)) {
        constexpr int HS = 2064;
        constexpr int R_HI = 0, R_LO = 33024, R_PART = 66048, R_SC = 98816, R_SEL = 102912, R_CNT = 107008, R_BASE = 107520, R_ESE = 108032, R_ESL = 110080, R_EW = 112128, R_ELP = 114176;
        if (tid < 128) *(LAS unsigned*)(lds + R_CNT + tid * 4) = 0u;
        __syncthreads();
        int nu = 0;
        const float* norm2_w = args.in[13]; const float* rbias = args.in[15]; const bf16* wrhi = (const bf16*)(ws + WS_WRHI); const bf16* wrlo = (const bf16*)(ws + WS_WRLO);
        int* listo = (int*)(ws + WS_LIST); float* listwo = (float*)(ws + WS_LISTW);
        const int r = lane & 15, g = lane >> 4;
#pragma unroll 1
        for (int u = vcu; u < M / 16; u += G, ++nu) {
            const GAS f32x4* sh4 = (const GAS f32x4*)(mod + (16 * u >= T ? 6144 : 0) + 3072) + lane; const GAS f32x4* nw4 = (const GAS f32x4*)norm2_w + lane;
            f32x4 xrow[2][4];
#pragma unroll
            for (int q = 0; q < 2; ++q) { const GAS f32x4* xr = (const GAS f32x4*)(args.out + (size_t)(16 * u + 2 * wave + q) * D) + lane;
#pragma unroll
                for (int j = 0; j < 4; ++j) xrow[q][j] = xr[64 * j]; }
#pragma unroll
            for (int q = 0; q < 2; ++q) { const int rl = 2 * wave + q, m = 16 * u + rl;
                f32x4 v[4]; float ss = 0.f;
#pragma unroll
                for (int j = 0; j < 4; ++j) { v[j] = xrow[q][j]; ss += (v[j].x * v[j].x + v[j].y * v[j].y) + (v[j].z * v[j].z + v[j].w * v[j].w); }
                const float rstd = rsqrtf(wave_sum(ss) * (1.f / D) + 1e-6f);
                GAS unsigned* o4 = (GAS unsigned*)((unsigned char*)h2 + (size_t)m * D) + lane;
#pragma unroll
                for (int j = 0; j < 4; ++j) { const f32x4 hv = v[j] * rstd * (nw4[64 * j] * (sh4[256 + 64 * j] + 1.0f)) + sh4[64 * j];
                    const unsigned h0 = f2bf(hv.x), h1_ = f2bf(hv.y), h2_ = f2bf(hv.z), h3 = f2bf(hv.w);
                    const unsigned long long hi = (unsigned long long)(h0 | (h1_ << 16)) | ((unsigned long long)(h2_ | (h3 << 16)) << 32);
                    { unsigned q8 = __builtin_amdgcn_cvt_pk_fp8_f32(hv.x, hv.y, 0, false); q8 = __builtin_amdgcn_cvt_pk_fp8_f32(hv.z, hv.w, q8, true); o4[64 * j] = q8; }
                    const unsigned long long lo = (unsigned long long)pk2(hv.x - __uint_as_float(h0 << 16), hv.y - __uint_as_float(h1_ << 16)) | ((unsigned long long)pk2(hv.z - __uint_as_float(h2_ << 16), hv.w - __uint_as_float(h3 << 16)) << 32);
                    *(LAS unsigned long long*)(lds + R_HI + rl * HS + (lane + 64 * j) * 8) = hi; *(LAS unsigned long long*)(lds + R_LO + rl * HS + (lane + 64 * j) * 8) = lo; } }
            __syncthreads();
            { f32x4 acc[4];
#pragma unroll
              for (int nt = 0; nt < 4; ++nt) acc[nt] = (f32x4){0.f, 0.f, 0.f, 0.f};
#pragma unroll 2
              for (int ks = 0; ks < 4; ++ks) { const int kb = (128 * wave + 32 * ks + 8 * g) * 2;
                  const bf16x8 ahi = *(const LAS bf16x8*)(lds + R_HI + r * HS + kb), alo = *(const LAS bf16x8*)(lds + R_LO + r * HS + kb);
#pragma unroll
                  for (int nt = 0; nt < 4; ++nt) { const size_t o = (size_t)(16 * nt + r) * 1024 + 128 * wave + 32 * ks + 8 * g; const bf16x8 bh = *(const GAS bf16x8*)(wrhi + o), bl = *(const GAS bf16x8*)(wrlo + o);
                      acc[nt] = mfma16(ahi, bh, acc[nt]); acc[nt] = mfma16(ahi, bl, acc[nt]); acc[nt] = mfma16(alo, bh, acc[nt]); } }
#pragma unroll
              for (int nt = 0; nt < 4; ++nt)
#pragma unroll
                  for (int ii = 0; ii < 4; ++ii) *(LAS float*)(lds + R_PART + ((wave * 16 + 4 * g + ii) * 64 + 16 * nt + r) * 4) = acc[nt][ii]; }
            __syncthreads();
#pragma unroll
            for (int q = 0; q < 2; ++q) { const int idx = tid + 512 * q; float s = 0.f;
#pragma unroll
                for (int w = 0; w < 8; ++w) s += *(const LAS float*)(lds + R_PART + (w * 1024 + idx) * 4);
                const float sc = sigmoidf_(s); *(LAS float*)(lds + R_SC + idx * 4) = sc; *(LAS float*)(lds + R_SEL + idx * 4) = sc + rbias[idx & 63]; }
            __syncthreads();
#pragma unroll
            for (int q = 0; q < 2; ++q) { const int rl = 2 * wave + q, m = 16 * u + rl;
                const float sel = *(const LAS float*)(lds + R_SEL + (rl * 64 + lane) * 4), score = *(const LAS float*)(lds + R_SC + (rl * 64 + lane) * 4);
                float m1 = sel; m1 = fmaxf(m1, __shfl_xor(m1, 1)); m1 = fmaxf(m1, __shfl_xor(m1, 2)); m1 = fmaxf(m1, __shfl_xor(m1, 4));
                const unsigned long long eq = __ballot(sel == m1) & (0xFFull << (lane & 56)); const int first = __ffsll((long long)eq) - 1;
                float m2 = (lane == first) ? -INFINITY : sel; m2 = fmaxf(m2, __shfl_xor(m2, 1)); m2 = fmaxf(m2, __shfl_xor(m2, 2)); m2 = fmaxf(m2, __shfl_xor(m2, 4));
                const float gs = m1 + m2; const int mygrp = lane >> 3; int grank = 0;
#pragma unroll
                for (int gg = 0; gg < 8; ++gg) { const float o = __shfl(gs, 8 * gg); grank += (o > gs || (o == gs && gg < mygrp)) ? 1 : 0; }
                const float msel = grank < 4 ? sel : -INFINITY; int erank = 0;
#pragma unroll
                for (int e2 = 0; e2 < 64; ++e2) { const float o = __shfl(msel, e2); erank += (o > msel || (o == msel && e2 < lane)) ? 1 : 0; }
                const bool chosen = grank < 4 && erank < 8;
                const float wsum = wave_sum(chosen ? score : 0.f);
                if (chosen && nu < 4) { const int se = (m >= T ? 64 : 0) + lane; const unsigned lp = __hip_atomic_fetch_add((LAS unsigned*)(lds + R_CNT + se * 4), 1u, __ATOMIC_RELAXED, __HIP_MEMORY_SCOPE_WORKGROUP);
                    const int ei = ((nu * 16 + rl) * 8 + erank) * 4;
                    *(LAS int*)(lds + R_ESE + ei) = se; *(LAS int*)(lds + R_ESL + ei) = m * 8 + erank; *(LAS float*)(lds + R_EW + ei) = score / wsum * 2.5f; *(LAS unsigned*)(lds + R_ELP + ei) = lp; } }
            __syncthreads();
            if (nu == 3 || u + G >= M / 16) {
                if (tid < 128) { const unsigned c = *(LAS unsigned*)(lds + R_CNT + tid * 4); *(LAS unsigned*)(lds + R_BASE + tid * 4) = c ? __hip_atomic_fetch_add(ctl + CW_CNT + 64 * tid, c, RLX_AGENT) : 0u; }
                __syncthreads();
                for (int idx = tid; idx < (nu + 1) * 128; idx += NWAVES * 64) { const int se = *(LAS int*)(lds + R_ESE + idx * 4); const unsigned pos = *(LAS unsigned*)(lds + R_BASE + se * 4) + *(LAS unsigned*)(lds + R_ELP + idx * 4);
                    if (pos < (unsigned)CAP) { listo[(size_t)se * CAP + pos] = *(LAS int*)(lds + R_ESL + idx * 4); listwo[(size_t)se * CAP + pos] = *(LAS float*)(lds + R_EW + idx * 4); } }
                __syncthreads();
                if (tid < 128) *(LAS unsigned*)(lds + R_CNT + tid * 4) = 0u;
                __syncthreads();
                nu = -1;
            }
        }
        if (BOTH(7)) xcd_barrier(bar);
    }
    if (lo <= 10 && hi > 8) {
        if (tid < 130) { const int hf = tid >= 65 ? 1 : 0, e = tid - 65 * hf; unsigned c = 8192u;
            if (e < 64) { c = __hip_atomic_load(ctl + CW_CNT + 64 * (hf * 64 + e), RLX_AGENT); c = c < (unsigned)CAP ? c : (unsigned)CAP; }
            tb[TB_CNT + tid] = c; }
        __syncthreads();
        if (tid == 0) { unsigned ro = 0; for (int s = 0; s < 130; ++s) { tb[TB_OFF + s] = ro; ro += tb[TB_CNT + s]; } }
        __syncthreads();
    }
#define MOE_PREFIX(lo_, hi_, NT_, perm_) do { __syncthreads(); if (tid == 0) { unsigned up = 0; for (int s = (lo_); s < (hi_); ++s) { const int sg_ = (perm_) ? (s & 1) * 65 + (s >> 1) : s; tb[TB_PRE + s] = up; up += ((tb[TB_CNT + sg_] + 255u) >> 8) * (NT_); } tb[TB_PRE + (hi_)] = up; } __syncthreads(); } while (0)
    if (IN(8)) {
#define PH_BODY do { \
        MOE_PREFIX(0, 130, 2, 0); \
        pg8::Moe1Prob P{D, 1024, pg8::MoeSched{tb, 0, 130, 2, G, vcu, 0}, (const unsigned char*)h2, (const unsigned char*)w1t, list}; \
        pg8::EpiMoe1 E{(unsigned char*)act, tb}; \
        pg8::gemm_phase_g<pg8::Moe1Prob, pg8::EpiMoe1, true>(lds, P, E); \
        if (BOTH(8)) xcd_barrier(bar); \
    } while (0)
        PH_BODY; if (REPN(8) > 1) { PH_BODY; PH_BODY; }
#undef PH_BODY
    }
    if (IN(9)) for (int rep_ = 0; rep_ < REPN(9); ++rep_) {
        MOE_PREFIX(0, 130, 4, 0);
        pg8::Moe2Prob P{DE, 256, pg8::MoeSched{tb, 0, 130, 4, G, vcu, 0}, (const unsigned char*)act, (const unsigned char*)w2t};
        pg8::EpiMoe2 E{(unsigned char*)y0, (unsigned char*)y1, ws + WS_YS, list, listw, tb};
        pg8::gemm_phase_g<pg8::Moe2Prob, pg8::EpiMoe2, true>(lds, P, E);
        if (BOTH(9)) xcd_barrier(bar);
    }
    if (IN(10)) {
        const float* fw = args.in[22]; const unsigned char* yb0 = (const unsigned char*)y0; const unsigned char* yb1 = (const unsigned char*)y1;
        typedef float f32x2_ __attribute__((ext_vector_type(2)));
        f32x4 fwr[2][2];
#pragma unroll
        for (int j = 0; j < 2; ++j)
#pragma unroll
            for (int h2_ = 0; h2_ < 2; ++h2_) fwr[j][h2_] = ((const GAS f32x4*)fw)[2 * lane + 128 * j + h2_];
#define P10_LOAD(m_, yq_, xv_, g2v_) do { const int hf_ = (m_) >= T ? 1 : 0; const GAS f32x4* xr_ = (const GAS f32x4*)(args.out + (size_t)(m_) * D); \
            const GAS v2u* yr_ = (const GAS v2u*)(hf_ ? yb1 + (size_t)((m_) - T) * 8 * D : yb0 + (size_t)(m_) * 8 * D) + lane; const GAS v2u* ysr_ = (const GAS v2u*)(ws + WS_YS + (size_t)(m_) * D) + lane; \
            const GAS f32x4* g24_ = (const GAS f32x4*)(mod + hf_ * 6144 + 5120); \
            _Pragma("unroll") for (int j = 0; j < 2; ++j) { _Pragma("unroll") for (int h2_ = 0; h2_ < 2; ++h2_) { xv_[j][h2_] = xr_[2 * lane + 128 * j + h2_]; g2v_[j][h2_] = g24_[2 * lane + 128 * j + h2_]; } \
                _Pragma("unroll") for (int k = 0; k < 8; ++k) yq_[k][j] = yr_[k * 128 + 64 * j]; yq_[8][j] = ysr_[64 * j]; } } while (0)
        v2u yqn[9][2]; f32x4 xvn[2][2], g2n[2][2];
        if (gw < M) P10_LOAD(gw, yqn, xvn, g2n);
#pragma unroll 1
        for (int m = gw; m < M; m += NGW) {
            GAS f32x4* xr = (GAS f32x4*)(args.out + (size_t)m * D);
            v2u yq[9][2]; f32x4 xv[2][2], g2v[2][2];
#pragma unroll
            for (int j = 0; j < 2; ++j) {
#pragma unroll
                for (int k = 0; k < 9; ++k) yq[k][j] = yqn[k][j];
#pragma unroll
                for (int h2_ = 0; h2_ < 2; ++h2_) { xv[j][h2_] = xvn[j][h2_]; g2v[j][h2_] = g2n[j][h2_]; } }
            if (m + NGW < M) P10_LOAD(m + NGW, yqn, xvn, g2n);
            f32x4 v[2][2]; float ss = 0.f;
#pragma unroll
            for (int j = 0; j < 2; ++j) { f32x4 s0 = {0.f, 0.f, 0.f, 0.f}, s1 = {0.f, 0.f, 0.f, 0.f};
#pragma unroll
                for (int k = 0; k < 9; ++k) { const f32x2_ a = __builtin_amdgcn_cvt_pk_f32_fp8(yq[k][j].x, false), b = __builtin_amdgcn_cvt_pk_f32_fp8(yq[k][j].x, true), c = __builtin_amdgcn_cvt_pk_f32_fp8(yq[k][j].y, false), d = __builtin_amdgcn_cvt_pk_f32_fp8(yq[k][j].y, true);
                    s0.x += a.x; s0.y += a.y; s0.z += b.x; s0.w += b.y; s1.x += c.x; s1.y += c.y; s1.z += d.x; s1.w += d.y; }
                v[j][0] = xv[j][0] + g2v[j][0] * (s0 * 0.03125f); v[j][1] = xv[j][1] + g2v[j][1] * (s1 * 0.03125f);
#pragma unroll
                for (int h2_ = 0; h2_ < 2; ++h2_) ss += (v[j][h2_].x * v[j][h2_].x + v[j][h2_].y * v[j][h2_].y) + (v[j][h2_].z * v[j][h2_].z + v[j][h2_].w * v[j][h2_].w); }
            const float rstd = rsqrtf(wave_sum(ss) * (1.f / D) + 1e-6f);
#pragma unroll
            for (int j = 0; j < 2; ++j)
#pragma unroll
                for (int h2_ = 0; h2_ < 2; ++h2_) xr[2 * lane + 128 * j + h2_] = v[j][h2_] * rstd * fwr[j][h2_];
        }
#undef P10_LOAD
    }
#undef MOE_PREFIX
#undef IN
#undef BOTH
}

static void launch_mk(Args a, int lo, int hi, int li, int grid, hipStream_t stream) {
    a.ph_lo = lo; a.ph_hi = hi; a.li = li;
    hipLaunchKernelGGL(mk_fwd, dim3(grid), dim3(NWAVES * 64), LDS_BYTES, stream, a);
}
extern "C" void kernel_launch(void* const* d_in, const int* in_sizes, int n_in, void* d_out, int out_size, void* d_ws, size_t ws_size, hipStream_t stream) {
    static int grid = 0;
    if (grid == 0) {
        int dev = 0, cus = 0;
        if (hipGetDevice(&dev) != hipSuccess || hipDeviceGetAttribute(&cus, hipDeviceAttributeMultiprocessorCount, dev) != hipSuccess) { grid = -1; return; }
        if (hipFuncSetAttribute((const void*)mk_fwd, hipFuncAttributeMaxDynamicSharedMemorySize, LDS_BYTES) != hipSuccess) { grid = -1; return; }
        grid = cus;
    }
    if (grid < 0) return;
    unsigned char* ws = (unsigned char*)d_ws; float* out = (float*)d_out;
    (void)hipMemsetAsync(ws + WS_CTL, 0, CTL_ZERO_BYTES, stream);
    Args a{};
    for (int i = 0; i < 23; ++i) a.in[i] = (const float*)d_in[i];
    a.out = out; a.ws = ws;
    launch_mk(a, 0, 11, 0, grid, stream);
}
```

```cpp
#include <hip/hip_runtime.h>
#include <cstdio>
#include <cstdint>
namespace pg8 {
#define PG8_LAS __attribute__((address_space(3)))
typedef unsigned short bf16_t;
typedef short bf16x8 __attribute__((ext_vector_type(8)));
typedef float f32x4 __attribute__((ext_vector_type(4)));
typedef unsigned u32x4 __attribute__((ext_vector_type(4)));
constexpr int BM = 256, BK = 64, HALF = 128, HTB = HALF * BK * 2  , STAGE_BYTES = 8 * HTB, NXCD = 8, WGM = 8;

__host__ __device__ __forceinline__ int lds_byte(int r, int c) { const int st = (r >> 4) * 2 + (c >> 5), rr = r & 15, cc = c & 31, ob = rr * 64 + cc * 2; return st * 1024 + (ob ^ (((ob >> 9) & 1) << 5)); }
__host__ __device__ __forceinline__ void stage_rc(int b, int& R, int& C) { const int st = b / 1024, sb = b % 1024, swz = sb ^ (((sb >> 9) & 1) << 5); R = (st >> 1) * 16 + swz / 64; C = (st & 1) * 32 + (swz % 64) / 2; }
__host__ __device__ __forceinline__ int perm32(int rho) { const int n = rho >> 4, i = rho & 15; return 8 * (i >> 2) + 4 * n + (i & 3); }

struct Unit { int pm, pn; };
struct Gemm { const bf16_t* A; const bf16_t* Bt; int M, N, K; };

struct StaticOrder {
    int nM, nN, nwg, G, c;
    __host__ __device__ void init(int M, int N, int G_, int c_) { nM = M / BM; nN = N / BM; nwg = nM * nN; G = G_; c = c_; }
    __host__ __device__ bool next(int i, Unit& u) const {
        const long L = (long)i * G + c; if (L >= nwg) return false;
        int wgid = (int)L; { const int q = nwg / NXCD, r = nwg % NXCD, xcd = wgid % NXCD, off = wgid / NXCD; wgid = (xcd < r ? xcd * (q + 1) : r * (q + 1) + (xcd - r) * q) + off; }
        const int nig = WGM * nN, gid = wgid / nig, fm = gid * WGM, gsz = (nM - fm) < WGM ? (nM - fm) : WGM;
        u.pm = fm + ((wgid % nig) % gsz); u.pn = (wgid % nig) / gsz; return true;
    }
    __device__ __forceinline__ void a_ready(const Unit&) const {}
    __device__ __forceinline__ void done(const Unit&) const {}
};
__device__ __forceinline__ unsigned cvt_pk_bf16(float lo, float hi) { unsigned r; asm volatile("v_cvt_pk_bf16_f32 %0, %1, %2" : "=v"(r) : "v"(lo), "v"(hi)); return r; }
template <class Epi, class Sched, bool ALIGN_EPI = false, bool SP2 = false>
__device__ __forceinline__ void gemm_phase(PG8_LAS unsigned char* lds, const Gemm g, const Sched& S, const Epi& E) {
    const int tid = threadIdx.x, wid = __builtin_amdgcn_readfirstlane(tid >> 6), lane = tid & 63, wr = wid >> 2, wc = wid & 3, fr = lane & 15, fq = lane >> 4;
    const int K = g.K, nt = K / BK;
    unsigned voffA[2], voffB[2];
#pragma unroll
    for (int i = 0; i < 2; ++i) { int R, C; stage_rc(tid * 16 + i * 8192, R, C); const int Rb = Epi::PERM ? ((R & ~31) + perm32(R & 31)) : R;
        voffA[i] = (unsigned)(R * K + C) * 2u; voffB[i] = (unsigned)(Rb * K + C) * 2u; }
    const size_t kstep = (size_t)(BK * 2);
    const size_t hstep = (size_t)HALF * K * 2;
    const size_t tstep = 2 * hstep;
    const unsigned ldsw = (unsigned)wid * 1024u;
    const int aoff = lds_byte(wr * 64 + fr, fq * 8), boff = lds_byte(wc * 32 + fr, fq * 8);
#define PG8_SA(b, h) (((b) * 2 + (h)) * HTB)
#define PG8_SB(b, h) ((4 + (b) * 2 + (h)) * HTB)
#define PG8_STAGE(bufoff, gbase, voff) do { _Pragma("unroll") for (int _i = 0; _i < 2; ++_i) \
        __builtin_amdgcn_global_load_lds((const unsigned*)((const char*)(gbase) + (voff)[_i]), (PG8_LAS unsigned*)(lds + (bufoff) + ldsw + _i * 8192), 16, 0, 0); } while (0)
#define PG8_LDA(dst, b, h) do { _Pragma("unroll") for (int m = 0; m < 4; ++m) _Pragma("unroll") for (int k = 0; k < 2; ++k) dst[m][k] = *(const PG8_LAS bf16x8*)(lds + PG8_SA(b, h) + aoff + m * 2048 + k * 1024); } while (0)
#define PG8_LDB(dst, b, h) do { _Pragma("unroll") for (int n = 0; n < 2; ++n) _Pragma("unroll") for (int k = 0; k < 2; ++k) dst[n][k] = *(const PG8_LAS bf16x8*)(lds + PG8_SB(b, h) + boff + n * 2048 + k * 1024); } while (0)
#define PG8_MMA(ai, bj, At, Bt) do { __builtin_amdgcn_s_setprio(1); _Pragma("unroll") for (int m = 0; m < 4; ++m) _Pragma("unroll") for (int n = 0; n < 2; ++n) _Pragma("unroll") for (int k = 0; k < 2; ++k) \
        acc[ai][bj][m][n] = __builtin_amdgcn_mfma_f32_16x16x32_bf16(Bt[n][k], At[m][k], acc[ai][bj][m][n], 0, 0, 0); __builtin_amdgcn_s_setprio(0); } while (0)
#define PG8_WAIT_V(n) asm volatile("s_waitcnt vmcnt(" #n ")" ::: "memory")
#define PG8_WAIT_L(n) asm volatile("s_waitcnt lgkmcnt(" #n ")" ::: "memory")
#define PG8_BAR __builtin_amdgcn_s_barrier()
#define PG8_SCHED __builtin_amdgcn_sched_barrier(0)
    Unit cur, nxt; int ui = 0;
    if (!S.next(0, cur)) return;
    f32x4 acc[2][2][4][2];
#pragma unroll
    for (int a = 0; a < 2; ++a)
#pragma unroll
        for (int b = 0; b < 2; ++b)
#pragma unroll
            for (int m = 0; m < 4; ++m)
#pragma unroll
                for (int n = 0; n < 2; ++n) acc[a][b][m][n] = (f32x4){0.f, 0.f, 0.f, 0.f};
    bf16x8 At[4][2], B0[2][2], B1[2][2];
    const char* cA = (const char*)g.A + (size_t)cur.pm * tstep; const char* cB = (const char*)g.Bt + (size_t)cur.pn * tstep;
    S.a_ready(cur);
    if constexpr (SP2) {
        PG8_STAGE(PG8_SB(0, 0), cB, voffB); PG8_STAGE(PG8_SB(0, 1), cB + hstep, voffB); PG8_STAGE(PG8_SA(0, 0), cA, voffA); PG8_STAGE(PG8_SA(0, 1), cA + hstep, voffA);
        if (wr == 1) PG8_BAR;
        PG8_WAIT_V(2); PG8_BAR;
        PG8_STAGE(PG8_SB(1, 0), cB + kstep, voffB); PG8_STAGE(PG8_SA(1, 0), cA + kstep, voffA); PG8_STAGE(PG8_SB(1, 1), cB + hstep + kstep, voffB);
        PG8_WAIT_V(6); PG8_BAR;
    } else {
        PG8_STAGE(PG8_SB(0, 0), cB, voffB); PG8_STAGE(PG8_SA(0, 0), cA, voffA); PG8_STAGE(PG8_SB(0, 1), cB + hstep, voffB); PG8_STAGE(PG8_SA(0, 1), cA + hstep, voffA);
        if (wr == 1) PG8_BAR;
        PG8_WAIT_V(4); PG8_BAR;
        PG8_STAGE(PG8_SB(1, 0), cB + kstep, voffB); PG8_STAGE(PG8_SA(1, 0), cA + kstep, voffA); PG8_STAGE(PG8_SB(1, 1), cB + hstep + kstep, voffB);
        PG8_WAIT_V(6); PG8_BAR;
    }
    for (;;) {
        const bool has_next = S.next(ui + 1, nxt);
        const char* nA = has_next ? (const char*)g.A + (size_t)nxt.pm * tstep : cA; const char* nB = has_next ? (const char*)g.Bt + (size_t)nxt.pn * tstep : cB;
        for (int t = 0; t < nt; t += 2) {
            const bool last = (t == nt - 2);
            const char* a1 = cA + (size_t)(t + 1) * kstep;
            const char* a2 = last ? nA : cA + (size_t)(t + 2) * kstep; const char* b2 = last ? nB : cB + (size_t)(t + 2) * kstep;
            const char* a3 = a2 + kstep; const char* b3 = b2 + kstep;
            if (last && has_next) S.a_ready(nxt);
            if constexpr (SP2) {
            PG8_LDB(B0, 0, 0); PG8_LDB(B1, 0, 1); PG8_SCHED; PG8_LDA(At, 0, 0); PG8_STAGE(PG8_SA(1, 1), a1 + hstep, voffA);
            PG8_WAIT_V(8); PG8_WAIT_L(0); PG8_BAR; PG8_MMA(0, 0, At, B0); PG8_MMA(0, 1, At, B1); PG8_BAR; PG8_SCHED;
            PG8_LDA(At, 0, 1); PG8_STAGE(PG8_SB(0, 0), b2, voffB); PG8_STAGE(PG8_SB(0, 1), b2 + hstep, voffB); PG8_STAGE(PG8_SA(0, 0), a2, voffA);
            PG8_WAIT_V(8); PG8_WAIT_L(0); PG8_BAR; PG8_MMA(1, 0, At, B0); PG8_MMA(1, 1, At, B1); PG8_BAR; PG8_SCHED;
            PG8_LDB(B0, 1, 0); PG8_LDB(B1, 1, 1); PG8_SCHED; PG8_LDA(At, 1, 0); PG8_STAGE(PG8_SA(0, 1), a2 + hstep, voffA);
            PG8_WAIT_V(8); PG8_WAIT_L(0); PG8_BAR; PG8_MMA(0, 0, At, B0); PG8_MMA(0, 1, At, B1); PG8_BAR; PG8_SCHED;
            PG8_LDA(At, 1, 1); PG8_STAGE(PG8_SB(1, 0), b3, voffB); PG8_STAGE(PG8_SB(1, 1), b3 + hstep, voffB); PG8_STAGE(PG8_SA(1, 0), a3, voffA);
            PG8_WAIT_V(8); PG8_WAIT_L(0); PG8_BAR; PG8_MMA(1, 0, At, B0); PG8_MMA(1, 1, At, B1); PG8_BAR; PG8_SCHED;
            } else {
            PG8_LDB(B0, 0, 0); PG8_SCHED; PG8_LDA(At, 0, 0); PG8_STAGE(PG8_SA(1, 1), a1 + hstep, voffA);
            PG8_WAIT_L(8); PG8_BAR; PG8_WAIT_L(0); PG8_MMA(0, 0, At, B0); PG8_BAR; PG8_SCHED;
            PG8_LDB(B1, 0, 1); PG8_STAGE(PG8_SB(0, 0), b2, voffB);
            PG8_BAR; PG8_WAIT_L(0); PG8_MMA(0, 1, At, B1); PG8_BAR;
            PG8_LDA(At, 0, 1); PG8_STAGE(PG8_SA(0, 0), a2, voffA);
            PG8_BAR; PG8_WAIT_L(0); PG8_MMA(1, 0, At, B0); PG8_BAR; PG8_SCHED;
            PG8_STAGE(PG8_SB(0, 1), b2 + hstep, voffB);
            PG8_WAIT_V(6); PG8_BAR; PG8_MMA(1, 1, At, B1); PG8_BAR;
            PG8_LDB(B0, 1, 0); PG8_SCHED; PG8_LDA(At, 1, 0); PG8_STAGE(PG8_SA(0, 1), a2 + hstep, voffA);
            PG8_WAIT_L(8); PG8_BAR; PG8_WAIT_L(0); PG8_MMA(0, 0, At, B0); PG8_BAR; PG8_SCHED;
            PG8_LDB(B1, 1, 1); PG8_STAGE(PG8_SB(1, 0), b3, voffB);
            PG8_BAR; PG8_WAIT_L(0); PG8_MMA(0, 1, At, B1); PG8_BAR;
            PG8_LDA(At, 1, 1); PG8_STAGE(PG8_SA(1, 0), a3, voffA);
            PG8_BAR; PG8_WAIT_L(0); PG8_MMA(1, 0, At, B0); PG8_BAR; PG8_SCHED;
            PG8_STAGE(PG8_SB(1, 1), b3 + hstep, voffB);
            PG8_WAIT_V(6); PG8_BAR; PG8_MMA(1, 1, At, B1); PG8_BAR;
            }
        }
        if constexpr (ALIGN_EPI) { if (wr == 0) PG8_BAR; }
        if constexpr (!Epi::AFTER_DRAIN) { E(acc, cur, wr, wc, fr, fq); S.done(cur); }
        if (!has_next) break;
#pragma unroll
        for (int a = 0; a < 2; ++a)
#pragma unroll
            for (int b = 0; b < 2; ++b)
#pragma unroll
                for (int m = 0; m < 4; ++m)
#pragma unroll
                    for (int n = 0; n < 2; ++n) acc[a][b][m][n] = (f32x4){0.f, 0.f, 0.f, 0.f};
        cur = nxt; cA = nA; cB = nB; ++ui;
        if constexpr (ALIGN_EPI) { if (wr == 1) PG8_BAR; }
    }
    PG8_WAIT_V(0);
    if constexpr (!ALIGN_EPI) { if (wr == 0) PG8_BAR; }
    PG8_BAR;
    if constexpr (Epi::AFTER_DRAIN) { E.fused(acc, cur, wr, wc, fr, fq, lds, wid, lane); S.done(cur); }
#undef PG8_SA
#undef PG8_SB
#undef PG8_STAGE
#undef PG8_LDA
#undef PG8_LDB
#undef PG8_MMA
#undef PG8_WAIT_V
#undef PG8_WAIT_L
#undef PG8_BAR
#undef PG8_SCHED
}
}
#define GAS __attribute__((address_space(1)))
#define LAS __attribute__((address_space(3)))
typedef unsigned short bf16;
typedef unsigned v4u __attribute__((ext_vector_type(4)));
typedef float f32x4 __attribute__((ext_vector_type(4)));
typedef short bf16x8 __attribute__((ext_vector_type(8)));
typedef GAS unsigned gu32;
typedef GAS unsigned long long gu64;
#define RLX_AGENT __ATOMIC_RELAXED, __HIP_MEMORY_SCOPE_AGENT
#define LDS_WAIT() asm volatile("s_waitcnt lgkmcnt(0)" ::: "memory")
#define VM_WAIT() asm volatile("s_waitcnt vmcnt(0)" ::: "memory")
__device__ __forceinline__ unsigned long long rt() { return __builtin_amdgcn_s_memrealtime(); }
__device__ __forceinline__ unsigned f2bf(float f) { unsigned u = __builtin_bit_cast(unsigned, f); return (u + 0x7fffu + ((u >> 16) & 1u)) >> 16; }
__device__ __forceinline__ unsigned pk2(float lo, float hi) { return f2bf(lo) | (f2bf(hi) << 16); }
#define XB_TMO      128
#define XB_XCNT(j)  (256  + 64 * (j))
#define XB_XSUB(j)  (1280 + 64 * (j))
#define XB_XGEN(j)  (2304 + 64 * (j))
#define XB_TOP      3328
#define XB_TOPGEN   3392
#define XCD_BAR_WORDS 3456
#define XB_SPIN_CAP (1u << 18)

__device__ __forceinline__ unsigned xb_ld(unsigned* p)              { return __hip_atomic_load(p, __ATOMIC_RELAXED, __HIP_MEMORY_SCOPE_AGENT); }
__device__ __forceinline__ unsigned xb_add(unsigned* p, unsigned v) { return __hip_atomic_fetch_add(p, v, __ATOMIC_RELAXED, __HIP_MEMORY_SCOPE_AGENT); }
__device__ __forceinline__ unsigned xb_xcc_id() { return (unsigned)__builtin_amdgcn_s_getreg((3 << 11) | 20) & 0xFu; }
#define XB_SPIN(cond, bar) do { unsigned _sp = 0; while (cond) { __builtin_amdgcn_s_sleep(1); \
    if ((++_sp & 255u) == 0u) { if (xb_ld(&(bar)[XB_TMO])) break; if (_sp > XB_SPIN_CAP) { atomicAdd(&(bar)[XB_TMO], 1u); break; } } } } while (0)

struct XcdBarrier {
    unsigned* bar; unsigned x;
    volatile LAS unsigned* st;
};

__device__ __forceinline__ XcdBarrier xcd_barrier_post(unsigned* bar, volatile LAS unsigned* st) {
    XcdBarrier b; b.bar = bar; b.x = xb_xcc_id(); b.st = st;
    if (threadIdx.x == 0) (void)xb_add(&bar[XB_XCNT(b.x)], 1u);
    return b;
}
__device__ __forceinline__ void xcd_barrier_complete(unsigned* bar, unsigned x, unsigned& nloc, unsigned& nx) {
    const unsigned G = gridDim.x * gridDim.y * gridDim.z;
    unsigned sum, cnt, mine, sp = 0u;
    for (;;) {
        sum = 0u; cnt = 0u; mine = 0u;
#pragma unroll
        for (unsigned j = 0; j < 16; ++j) { const unsigned c = xb_ld(&bar[XB_XCNT(j)]); sum += c; cnt += (c > 0u) ? 1u : 0u; mine = (j == x) ? c : mine; }
        if (sum == G) break;
        __builtin_amdgcn_s_sleep(1);
        if ((++sp & 255u) == 0u) { if (xb_ld(&bar[XB_TMO])) break; if (sp > XB_SPIN_CAP) { atomicAdd(&bar[XB_TMO], 1u); break; } }
    }
    nloc = mine > 0u ? mine : 1u; nx = cnt > 0u ? cnt : 1u;
}

__device__ __forceinline__ void xcd_barrier(const XcdBarrier& b) {
    asm volatile("s_waitcnt vmcnt(0)" ::: "memory");
    __syncthreads();
    if (threadIdx.x == 0) {
        unsigned* bar = b.bar;
        __builtin_amdgcn_s_waitcnt(0);
        unsigned nloc = b.st[0], nx = b.st[1];
        if (nloc == 0u) { xcd_barrier_complete(bar, b.x, nloc, nx); b.st[0] = nloc; b.st[1] = nx; }
        const unsigned old = xb_add(&bar[XB_XSUB(b.x)], 1u);
        const unsigned gen = old / nloc;
        if (old + 1u == (gen + 1u) * nloc) {
            __builtin_amdgcn_fence(__ATOMIC_RELEASE, "agent");
            asm volatile("s_waitcnt vmcnt(0)" ::: "memory");
            const unsigned og = xb_add(&bar[XB_TOP], 1u);
            const unsigned tg = og / nx;
            if (og + 1u == (tg + 1u) * nx) xb_add(&bar[XB_TOPGEN], 1u);
            else XB_SPIN(xb_ld(&bar[XB_TOPGEN]) == tg, bar);
            __builtin_amdgcn_fence(__ATOMIC_ACQUIRE, "agent");
            xb_add(&bar[XB_XGEN(b.x)], 1u);
            asm volatile("s_waitcnt vmcnt(0)" ::: "memory");
        } else {
            XB_SPIN(xb_ld(&bar[XB_XGEN(b.x)]) == gen, bar);
            __builtin_amdgcn_fence(__ATOMIC_ACQUIRE, "agent");
            asm volatile("s_waitcnt vmcnt(0)" ::: "memory");
        }
    }
    __syncthreads();
}

namespace pg8 {
struct UnitG { int seg, mt, nt; };
template <class Prob, class Epi, bool FP8 = false>
__device__ __forceinline__ void gemm_phase_g(PG8_LAS unsigned char* lds, const Prob& P, const Epi& E) {
    const int tid = threadIdx.x, wid = __builtin_amdgcn_readfirstlane(tid >> 6), lane = tid & 63, wr = wid >> 2, wc = wid & 3, fr = lane & 15, fq = lane >> 4;
    constexpr int EB = FP8 ? 1 : 2;
    const int K = P.K, nt = K * EB / 128;
    unsigned voffB[2], cbA[2];
#pragma unroll
    for (int i = 0; i < 2; ++i) { int R, C; stage_rc(tid * 16 + i * 8192, R, C); const int Rb = Epi::PERM ? ((R & ~31) + perm32(R & 31)) : R; voffB[i] = (unsigned)(Rb * K * EB + C * 2); cbA[i] = (unsigned)(C * 2); }
    const unsigned pitchA = (unsigned)P.pitchA;
    const size_t kstep = (size_t)(BK * 2);
    const size_t hstep = (size_t)HALF * K * EB;
    const unsigned ldsw = (unsigned)wid * 1024u;
    const int aoff = lds_byte(wr * 64 + fr, fq * 8), boff = lds_byte(wc * 32 + fr, fq * 8);
#define PG8_SA(b, h) (((b) * 2 + (h)) * HTB)
#define PG8_SB(b, h) ((4 + (b) * 2 + (h)) * HTB)
#define PG8_STAGE(bufoff, gbase, voff) do { _Pragma("unroll") for (int _i = 0; _i < 2; ++_i) \
        __builtin_amdgcn_global_load_lds((const unsigned*)((const char*)(gbase) + (voff)[_i]), (PG8_LAS unsigned*)(lds + (bufoff) + ldsw + _i * 8192), 16, 0, 0); } while (0)
#define PG8_STAGE_A(bufoff, gbase, rp_) do { const unsigned o0_ = ((rp_) & 0xffffu) * pitchA + cbA[0], o1_ = ((rp_) >> 16) * pitchA + cbA[1]; \
        __builtin_amdgcn_global_load_lds((const unsigned*)((const char*)(gbase) + o0_), (PG8_LAS unsigned*)(lds + (bufoff) + ldsw), 16, 0, 0); \
        __builtin_amdgcn_global_load_lds((const unsigned*)((const char*)(gbase) + o1_), (PG8_LAS unsigned*)(lds + (bufoff) + ldsw + 8192), 16, 0, 0); } while (0)
#define PG8_LDA(dst, b, h) do { _Pragma("unroll") for (int m = 0; m < 4; ++m) { const v4i_ lo_ = *(const PG8_LAS v4i_*)(lds + PG8_SA(b, h) + aoff + m * 2048), hi_ = *(const PG8_LAS v4i_*)(lds + PG8_SA(b, h) + aoff + m * 2048 + 1024); dst[m] = __builtin_shufflevector(lo_, hi_, 0, 1, 2, 3, 4, 5, 6, 7); } } while (0)
#define PG8_LDB(dst, b, h) do { _Pragma("unroll") for (int n = 0; n < 2; ++n) { const v4i_ lo_ = *(const PG8_LAS v4i_*)(lds + PG8_SB(b, h) + boff + n * 2048), hi_ = *(const PG8_LAS v4i_*)(lds + PG8_SB(b, h) + boff + n * 2048 + 1024); dst[n] = __builtin_shufflevector(lo_, hi_, 0, 1, 2, 3, 4, 5, 6, 7); } } while (0)
#define PG8_HALF(v_, k_) __builtin_bit_cast(bf16x8, (v4i_)__builtin_shufflevector(v_, v_, 4 * (k_), 4 * (k_) + 1, 4 * (k_) + 2, 4 * (k_) + 3))
#define PG8_MMA(ai, bj, At, Bt) do { __builtin_amdgcn_s_setprio(1); _Pragma("unroll") for (int m = 0; m < 4; ++m) _Pragma("unroll") for (int n = 0; n < 2; ++n) { \
        acc[ai][bj][m][n] = __builtin_amdgcn_mfma_f32_16x16x32_bf16(PG8_HALF(Bt[n], 0), PG8_HALF(At[m], 0), acc[ai][bj][m][n], 0, 0, 0); \
        acc[ai][bj][m][n] = __builtin_amdgcn_mfma_f32_16x16x32_bf16(PG8_HALF(Bt[n], 1), PG8_HALF(At[m], 1), acc[ai][bj][m][n], 0, 0, 0); } __builtin_amdgcn_s_setprio(0); } while (0)
#define PG8_Q(v_, q_) __builtin_bit_cast(long, (v2i_){v_[2 * (q_)], v_[2 * (q_) + 1]})
#define PG8_MMA8Q(ai, bj, At, Bt, q_) _Pragma("unroll") for (int m = 0; m < 4; ++m) _Pragma("unroll") for (int n = 0; n < 2; ++n) \
            acc[ai][bj][m][n] = __builtin_amdgcn_mfma_f32_16x16x32_fp8_fp8(PG8_Q(Bt[n], q_), PG8_Q(At[m], q_), acc[ai][bj][m][n], 0, 0, 0)
#define PG8_MMA8(ai, bj, At, Bt) do { typedef int v2i_ __attribute__((ext_vector_type(2))); __builtin_amdgcn_s_setprio(1); \
        PG8_MMA8Q(ai, bj, At, Bt, 0); PG8_MMA8Q(ai, bj, At, Bt, 1); PG8_MMA8Q(ai, bj, At, Bt, 2); PG8_MMA8Q(ai, bj, At, Bt, 3); \
        __builtin_amdgcn_s_setprio(0); } while (0)
#define PG8_MM(ai, bj, At, Bt) do { if constexpr (FP8) PG8_MMA8(ai, bj, At, Bt); else PG8_MMA(ai, bj, At, Bt); } while (0)
#define PG8_WAIT_V(n) asm volatile("s_waitcnt vmcnt(" #n ")" ::: "memory")
#define PG8_WAIT_L(n) asm volatile("s_waitcnt lgkmcnt(" #n ")" ::: "memory")
#define PG8_BAR __builtin_amdgcn_s_barrier()
#define PG8_SCHED __builtin_amdgcn_sched_barrier(0)
    UnitG cur, nxt; int ui = 0;
    if (!P.next(0, cur)) return;
    f32x4 acc[2][2][4][2];
#pragma unroll
    for (int a = 0; a < 2; ++a)
#pragma unroll
        for (int b = 0; b < 2; ++b)
#pragma unroll
            for (int m = 0; m < 4; ++m)
#pragma unroll
                for (int n = 0; n < 2; ++n) acc[a][b][m][n] = (f32x4){0.f, 0.f, 0.f, 0.f};
    typedef int v4i_ __attribute__((ext_vector_type(4))); typedef int v8i_ __attribute__((ext_vector_type(8)));
    v8i_ At[4], B0[2], B1[2];
    unsigned rowp[2], rowpn[2];
    const char* cA; const char* cB;
    P.setup(cur, cA, rowp, cB);
    PG8_STAGE(PG8_SB(0, 0), cB, voffB); PG8_STAGE(PG8_SB(0, 1), cB + hstep, voffB); PG8_STAGE_A(PG8_SA(0, 0), cA, rowp[0]); PG8_STAGE_A(PG8_SA(0, 1), cA, rowp[1]);
    if (wr == 1) PG8_BAR;
    PG8_WAIT_V(2); PG8_BAR;
    PG8_STAGE(PG8_SB(1, 0), cB + kstep, voffB); PG8_STAGE_A(PG8_SA(1, 0), cA + kstep, rowp[0]); PG8_STAGE(PG8_SB(1, 1), cB + hstep + kstep, voffB);
    PG8_WAIT_V(6); PG8_BAR;
    for (;;) {
        const bool has_next = P.next(ui + 1, nxt);
        const char* nA = cA; const char* nB = cB;
        rowpn[0] = rowp[0]; rowpn[1] = rowp[1];
        if (has_next) P.setup(nxt, nA, rowpn, nB);
        for (int t = 0; t < nt; t += 2) {
            const bool last = (t == nt - 2);
            const char* a1 = cA + (size_t)(t + 1) * kstep;
            const char* a2 = last ? nA : cA + (size_t)(t + 2) * kstep; const char* b2 = last ? nB : cB + (size_t)(t + 2) * kstep;
            const char* a3 = a2 + kstep; const char* b3 = b2 + kstep;
            const unsigned o2_0 = last ? rowpn[0] : rowp[0], o2_1 = last ? rowpn[1] : rowp[1];
            PG8_LDB(B0, 0, 0); PG8_LDB(B1, 0, 1); PG8_SCHED; PG8_LDA(At, 0, 0); PG8_STAGE_A(PG8_SA(1, 1), a1, rowp[1]);
            PG8_WAIT_V(8); PG8_WAIT_L(0); PG8_BAR; PG8_MM(0, 0, At, B0); PG8_MM(0, 1, At, B1); PG8_BAR; PG8_SCHED;
            PG8_LDA(At, 0, 1); PG8_STAGE(PG8_SB(0, 0), b2, voffB); PG8_STAGE(PG8_SB(0, 1), b2 + hstep, voffB); PG8_STAGE_A(PG8_SA(0, 0), a2, o2_0);
            PG8_WAIT_V(8); PG8_WAIT_L(0); PG8_BAR; PG8_MM(1, 0, At, B0); PG8_MM(1, 1, At, B1); PG8_BAR; PG8_SCHED;
            PG8_LDB(B0, 1, 0); PG8_LDB(B1, 1, 1); PG8_SCHED; PG8_LDA(At, 1, 0); PG8_STAGE_A(PG8_SA(0, 1), a2, o2_1);
            PG8_WAIT_V(8); PG8_WAIT_L(0); PG8_BAR; PG8_MM(0, 0, At, B0); PG8_MM(0, 1, At, B1); PG8_BAR; PG8_SCHED;
            PG8_LDA(At, 1, 1); PG8_STAGE(PG8_SB(1, 0), b3, voffB); PG8_STAGE(PG8_SB(1, 1), b3 + hstep, voffB); PG8_STAGE_A(PG8_SA(1, 0), a3, o2_0);
            PG8_WAIT_V(8); PG8_WAIT_L(0); PG8_BAR; PG8_MM(1, 0, At, B0); PG8_MM(1, 1, At, B1); PG8_BAR; PG8_SCHED;
        }
        if (wr == 0) PG8_BAR;
        E(acc, cur, wr, wc, fr, fq);
        if (!has_next) break;
#pragma unroll
        for (int a = 0; a < 2; ++a)
#pragma unroll
            for (int b = 0; b < 2; ++b)
#pragma unroll
                for (int m = 0; m < 4; ++m)
#pragma unroll
                    for (int n = 0; n < 2; ++n) acc[a][b][m][n] = (f32x4){0.f, 0.f, 0.f, 0.f};
        cur = nxt; cA = nA; cB = nB; ++ui;
        rowp[0] = rowpn[0]; rowp[1] = rowpn[1];
        if (wr == 1) PG8_BAR;
    }
    PG8_WAIT_V(0);
    PG8_BAR;
#undef PG8_SA
#undef PG8_SB
#undef PG8_STAGE
#undef PG8_STAGE_A
#undef PG8_LDA
#undef PG8_LDB
#undef PG8_MMA
#undef PG8_MMA8
#undef PG8_Q
#undef PG8_MMA8Q
#undef PG8_HALF
#undef PG8_MM
#undef PG8_WAIT_V
#undef PG8_WAIT_L
#undef PG8_BAR
#undef PG8_SCHED
}
}

constexpr int NWAVES = 8;
constexpr int BATCH = 2, T = 8192, D = 1024, M = BATCH * T, DIN = 4104, PA = 3072;
constexpr int NE = 64, NEX = 65, DE = 256;
constexpr size_t MiB = 1u << 20;
constexpr size_t WS_CTL = 0, CTL_ZERO_BYTES = 256 * 1024;
constexpr size_t WS_WRHI = 512 * 1024, WS_WRLO = 640 * 1024;
constexpr size_t WS_MOD = 1 * MiB, WS_WAB = 1 * MiB + 256 * 1024, WS_AB = 1 * MiB + 512 * 1024;
constexpr size_t WS_WOUT_T = 2 * MiB, WS_WIN_T = 4 * MiB, WS_H1 = 12 * MiB, WS_PROJA = 44 * MiB, WS_GATES = 142 * MiB;
constexpr size_t WS_QP = 4 * MiB, WS_OI = 20 * MiB, WS_AH = 36 * MiB, WS_GL = 36 * MiB + 512 * 1024, WS_PG = 174 * MiB, WS_BG = 206 * MiB, WS_BH = 238 * MiB, WS_QE = 270 * MiB, WS_OIH = 286 * MiB;
constexpr size_t WS_OMIX = 174 * MiB;
constexpr size_t WS_H2 = 12 * MiB, WS_W1T = 44 * MiB, WS_W2T = 109 * MiB, WS_ACT = 142 * MiB, WS_LIST = 215 * MiB, WS_LISTW = 217 * MiB, WS_Y0 = 12 * MiB, WS_Y1 = 219 * MiB;
constexpr size_t WS_YS = 80 * MiB;
constexpr size_t WS_TOP = 302 * MiB;
constexpr int CAP = 8192;
constexpr int TB_PRE = 0, TB_CNT = 132, TB_OFF = 264;
constexpr int CW_CNT = 16384;
constexpr int CW_BAR = 4096;
constexpr int RING_BYTES = 131072, LDS_BYTES = 163840, LDSCTL_OFF = LDS_BYTES - 1024, MISC_OFF = LDSCTL_OFF + 320, SCR2_OFF = LDS_BYTES - 3072;

__device__ __forceinline__ float bf2f(bf16 v) { return __uint_as_float(((unsigned)v) << 16); }
__device__ __forceinline__ float sigmoidf_(float x) { return 1.f / (1.f + __expf(-x)); }
__device__ __forceinline__ float siluf_(float x) { return x / (1.f + __expf(-x)); }
__device__ __forceinline__ float softplusf_(float x) { return x > 20.f ? x : log1pf(expf(x)); }
__device__ __forceinline__ float c8(float x) { return __builtin_amdgcn_fmed3f(x, -448.f, 448.f); }
__device__ __forceinline__ float wave_sum(float v) {
#pragma unroll
    for (int o = 1; o < 64; o <<= 1) v += __shfl_xor(v, o);
    return v;
}

namespace pg8 {
struct EpiProj {
    static constexpr bool PERM = true, AFTER_DRAIN = false;
    bf16_t* projA; bf16_t* gates;
    __device__ __forceinline__ void operator()(const f32x4 (&acc)[2][2][4][2], const Unit& u, int wr, int wc, int fr, int fq) const {
        const int row0 = u.pm * BM + wr * 64 + fr;
        bf16_t* base; int ldc, colt;
        if (u.pn < 12) { base = projA; ldc = 3072; colt = u.pn * BM; } else { base = gates; ldc = 1024; colt = (u.pn - 12) * BM; }
        const int col0 = colt + wc * 32 + 8 * fq;
#pragma unroll
        for (int ai = 0; ai < 2; ++ai)
#pragma unroll
            for (int m = 0; m < 4; ++m) { bf16_t* rowp = base + (size_t)(row0 + ai * HALF + m * 16) * ldc + col0;
#pragma unroll
                for (int bj = 0; bj < 2; ++bj) { const f32x4 v0 = acc[ai][bj][m][0], v1 = acc[ai][bj][m][1];
                    u32x4 w; w.x = cvt_pk_bf16(v0[0], v0[1]); w.y = cvt_pk_bf16(v0[2], v0[3]); w.z = cvt_pk_bf16(v1[0], v1[1]); w.w = cvt_pk_bf16(v1[2], v1[3]);
                    *(u32x4*)(rowp + bj * HALF) = w; } }
    }
};
struct EpiResid {
    static constexpr bool PERM = false, AFTER_DRAIN = false;
    const float* x; const float* mod; float* out;
    __device__ __forceinline__ void operator()(const f32x4 (&acc)[2][2][4][2], const Unit& u, int wr, int wc, int fr, int fq) const {
        const int col0 = u.pn * BM + wc * 32 + 4 * fq;
        const float* g1 = mod + (u.pm * BM >= 8192 ? 6144 : 0) + 2048;
        f32x4 gv[2][2];
#pragma unroll
        for (int bj = 0; bj < 2; ++bj)
#pragma unroll
            for (int n = 0; n < 2; ++n) gv[bj][n] = *(const f32x4*)(g1 + col0 + bj * HALF + n * 16);
#pragma unroll
        for (int ai = 0; ai < 2; ++ai)
#pragma unroll
            for (int mp = 0; mp < 4; mp += 2) { f32x4 xv[2][2][2];
#pragma unroll
                for (int q = 0; q < 2; ++q) { const size_t off = (size_t)(u.pm * BM + ai * HALF + wr * 64 + (mp + q) * 16 + fr) * 1024 + col0;
#pragma unroll
                    for (int bj = 0; bj < 2; ++bj)
#pragma unroll
                        for (int n = 0; n < 2; ++n) xv[q][bj][n] = *(const f32x4*)(x + off + bj * HALF + n * 16); }
#pragma unroll
                for (int q = 0; q < 2; ++q) { const size_t off = (size_t)(u.pm * BM + ai * HALF + wr * 64 + (mp + q) * 16 + fr) * 1024 + col0;
#pragma unroll
                    for (int bj = 0; bj < 2; ++bj)
#pragma unroll
                        for (int n = 0; n < 2; ++n) *(f32x4*)(out + off + bj * HALF + n * 16) = xv[q][bj][n] + gv[bj][n] * acc[ai][bj][mp + q][n]; }
            }
    }
};

struct MoeSched {
    const LAS unsigned* tb; int lo, hi, NT, G, c; int perm;
    __device__ __forceinline__ int segof(int p) const { return perm ? (p & 1) * 65 + (p >> 1) : p; }
    __device__ __forceinline__ bool next(int i, UnitG& u) const {
        const unsigned L = (unsigned)(i * G + c); if (L >= tb[TB_PRE + hi]) return false;
        int s = lo; while (L >= tb[TB_PRE + s + 1]) ++s;
        const int sg = segof(s);
        const unsigned loc = L - tb[TB_PRE + s], tiles = (tb[TB_CNT + sg] + 255u) >> 8;
        u.seg = __builtin_amdgcn_readfirstlane(sg); u.mt = __builtin_amdgcn_readfirstlane((int)(loc % tiles)); u.nt = __builtin_amdgcn_readfirstlane((int)(loc / tiles)); return true;
    }
};
struct Moe1Prob {
    int K; int pitchA; MoeSched S; const unsigned char* h2; const unsigned char* w1t; const int* list;
    __device__ __forceinline__ bool next(int i, UnitG& u) const { return S.next(i, u); }
    __device__ __forceinline__ void setup(const UnitG& u, const char*& cA, unsigned (&rowp)[2], const char*& cB) const {
        int sR[2], sC[2];
#pragma unroll
        for (int i = 0; i < 2; ++i) stage_rc((int)threadIdx.x * 16 + i * 8192, sR[i], sC[i]);
        const int e = u.seg; const int cnt = (int)S.tb[TB_CNT + u.seg];
#pragma unroll
        for (int h = 0; h < 2; ++h) { unsigned tk[2];
#pragma unroll
            for (int i = 0; i < 2; ++i) { const int r = 256 * u.mt + 128 * h + sR[i];
                if (e < 64) { const int rr = r < cnt ? r : cnt - 1; tk[i] = (unsigned)list[(size_t)e * CAP + rr] >> 3; } else tk[i] = (unsigned)(r < M ? r : M - 1); }
            rowp[h] = tk[0] | (tk[1] << 16); }
        cA = (const char*)h2; cB = (const char*)(w1t + ((size_t)e * 512 + (size_t)u.nt * 256) * 1024);
    }
};
struct Moe2Prob {
    int K; int pitchA; MoeSched S; const unsigned char* act; const unsigned char* w2t;
    __device__ __forceinline__ bool next(int i, UnitG& u) const { return S.next(i, u); }
    __device__ __forceinline__ void setup(const UnitG& u, const char*& cA, unsigned (&rowp)[2], const char*& cB) const {
        int sR[2], sC[2];
#pragma unroll
        for (int i = 0; i < 2; ++i) stage_rc((int)threadIdx.x * 16 + i * 8192, sR[i], sC[i]);
        const int e = u.seg; const size_t rowbase = (size_t)S.tb[TB_OFF + u.seg] + 256u * (unsigned)u.mt;
#pragma unroll
        for (int h = 0; h < 2; ++h) rowp[h] = (unsigned)(128 * h + sR[0]) | ((unsigned)(128 * h + sR[1]) << 16);
        cA = (const char*)(act + rowbase * 256); cB = (const char*)(w2t + ((size_t)e * 1024 + (size_t)u.nt * 256) * 256);
    }
};
struct EpiMoe1 {
    static constexpr bool PERM = true;
    unsigned char* act; const LAS unsigned* tb;
    __device__ __forceinline__ void operator()(const f32x4 (&acc)[2][2][4][2], const UnitG& u, int wr, int wc, int fr, int fq) const {
        const int cnt = (int)tb[TB_CNT + u.seg]; const size_t rowbase = tb[TB_OFF + u.seg];
#pragma unroll
        for (int ai = 0; ai < 2; ++ai)
#pragma unroll
            for (int m = 0; m < 4; ++m) { const int r = 256 * u.mt + ai * HALF + wr * 64 + m * 16 + fr;
                if (r < cnt) { unsigned char* p = act + (rowbase + (size_t)r) * 256 + u.nt * 128 + wc * 32 + 8 * fq;
                    const f32x4 g0 = acc[ai][0][m][0], g1 = acc[ai][0][m][1], u0 = acc[ai][1][m][0], u1 = acc[ai][1][m][1]; f32x4 v0, v1;
#pragma unroll
                    for (int i = 0; i < 4; ++i) { const float ga = g0[i] * 0.03125f, gb = g1[i] * 0.03125f; v0[i] = ga / (1.f + __expf(-ga)) * (u0[i] * 0.25f); v1[i] = gb / (1.f + __expf(-gb)) * (u1[i] * 0.25f); }
                    unsigned o0 = __builtin_amdgcn_cvt_pk_fp8_f32(c8(v0[0]), c8(v0[1]), 0, false); o0 = __builtin_amdgcn_cvt_pk_fp8_f32(c8(v0[2]), c8(v0[3]), o0, true);
                    unsigned o1 = __builtin_amdgcn_cvt_pk_fp8_f32(c8(v1[0]), c8(v1[1]), 0, false); o1 = __builtin_amdgcn_cvt_pk_fp8_f32(c8(v1[2]), c8(v1[3]), o1, true);
                    typedef unsigned u32x2_ __attribute__((ext_vector_type(2)));
                    *(u32x2_*)p = (u32x2_){o0, o1}; } }
    }
};
struct EpiMoe2 {
    static constexpr bool PERM = true;
    unsigned char* y0; unsigned char* y1; unsigned char* ys; const int* list; const float* listw; const LAS unsigned* tb;
    __device__ __forceinline__ void operator()(const f32x4 (&acc)[2][2][4][2], const UnitG& u, int wr, int wc, int fr, int fq) const {
        const int cnt = (int)tb[TB_CNT + u.seg]; const int e = u.seg; const int colt = u.nt * 256 + wc * 32 + 8 * fq;
#pragma unroll
        for (int ai = 0; ai < 2; ++ai) { int slot[4]; float wgt[4];
#pragma unroll
            for (int m = 0; m < 4; ++m) { const int r = 256 * u.mt + ai * HALF + wr * 64 + m * 16 + fr; const int rr = r < cnt ? r : cnt - 1;
                if (e < 64) { const size_t li = (size_t)e * CAP + rr; slot[m] = list[li]; wgt[m] = listw[li] * 0.25f; } else { slot[m] = rr; wgt[m] = 0.25f; } }
#pragma unroll
            for (int m = 0; m < 4; ++m) { const int r = 256 * u.mt + ai * HALF + wr * 64 + m * 16 + fr;
                if (r < cnt) { const int sl = slot[m]; const float w = wgt[m];
                    unsigned char* p = (e < 64 ? (sl >= 65536 ? y1 + (size_t)(sl - 65536) * 1024 : y0 + (size_t)sl * 1024) : ys + (size_t)sl * 1024) + colt;
#pragma unroll
                    for (int bj = 0; bj < 2; ++bj) { const f32x4 v0 = acc[ai][bj][m][0] * w, v1 = acc[ai][bj][m][1] * w;
                        unsigned o0 = __builtin_amdgcn_cvt_pk_fp8_f32(v0[0], v0[1], 0, false); o0 = __builtin_amdgcn_cvt_pk_fp8_f32(v0[2], v0[3], o0, true);
                        unsigned o1 = __builtin_amdgcn_cvt_pk_fp8_f32(v1[0], v1[1], 0, false); o1 = __builtin_amdgcn_cvt_pk_fp8_f32(v1[2], v1[3], o1, true);
                        typedef unsigned u32x2_ __attribute__((ext_vector_type(2)));
                        *(u32x2_*)(p + bj * HALF) = (u32x2_){o0, o1}; } } } }
    }
};
}

struct TrItem { const float* W; int ldw, src_col; bf16* WT; int K, dst_row, k0; float f8scale; };
__device__ __forceinline__ void tr_load(const TrItem& t, int lane, f32x4 (&v)[8]) {
#pragma unroll
    for (int i = 0; i < 8; ++i) v[i] = *(const GAS f32x4*)(t.W + (size_t)(t.k0 + 8 * i + (lane >> 3)) * t.ldw + t.src_col + 4 * (lane & 7));
}
__device__ __forceinline__ void tr_finish(const TrItem& t, int lane, const f32x4 (&v)[8], LAS float* scr) {
#pragma unroll
    for (int i = 0; i < 8; ++i) { LAS float* p = scr + (8 * i + (lane >> 3)) * 33 + 4 * (lane & 7); p[0] = v[i][0]; p[1] = v[i][1]; p[2] = v[i][2]; p[3] = v[i][3]; }
    LDS_WAIT(); asm volatile("" ::: "memory");
    const int c = lane & 7;
#pragma unroll
    for (int j = 0; j < 4; ++j) { const int n = (lane >> 3) + 8 * j; const LAS float* s = scr + (8 * c) * 33 + n;
        if (t.f8scale != 0.f) { const float q = t.f8scale; typedef unsigned u32x2_ __attribute__((ext_vector_type(2)));
            unsigned o0 = __builtin_amdgcn_cvt_pk_fp8_f32(s[0 * 33] * q, s[1 * 33] * q, 0, false); o0 = __builtin_amdgcn_cvt_pk_fp8_f32(s[2 * 33] * q, s[3 * 33] * q, o0, true);
            unsigned o1 = __builtin_amdgcn_cvt_pk_fp8_f32(s[4 * 33] * q, s[5 * 33] * q, 0, false); o1 = __builtin_amdgcn_cvt_pk_fp8_f32(s[6 * 33] * q, s[7 * 33] * q, o1, true);
            *(GAS u32x2_*)((GAS unsigned char*)t.WT + (size_t)(t.dst_row + n) * t.K + t.k0 + 8 * c) = (u32x2_){o0, o1};
        } else {
        v4u o; o.x = pk2(s[0 * 33], s[1 * 33]); o.y = pk2(s[2 * 33], s[3 * 33]); o.z = pk2(s[4 * 33], s[5 * 33]); o.w = pk2(s[6 * 33], s[7 * 33]);
        *(GAS v4u*)(t.WT + (size_t)(t.dst_row + n) * t.K + t.k0 + 8 * c) = o; } }
    LDS_WAIT(); asm volatile("" ::: "memory");
}
#define TR_LOOP(it0, stride, nitems, MAKE) do { int it_ = (it0); if (it_ < (nitems)) { TrItem cur_ = MAKE(it_); f32x4 va_[8], vb_[8]; tr_load(cur_, lane, va_); \
    for (;;) { const int nx_ = it_ + (stride); const bool hn_ = nx_ < (nitems); TrItem nxt_ = cur_; if (hn_) { nxt_ = MAKE(nx_); tr_load(nxt_, lane, vb_); } \
        tr_finish(cur_, lane, va_, scr); if (!hn_) break; _Pragma("unroll") for (int q_ = 0; q_ < 8; ++q_) va_[q_] = vb_[q_]; cur_ = nxt_; it_ = nx_; } } } while (0)

#ifndef REP_PHASE
#define REP_PHASE -1
#endif
#ifndef REP_N
#define REP_N 1
#endif
#define REPN(k) ((k) == REP_PHASE ? REP_N : 1)

constexpr int UNITS = BATCH * 128 * 4;
constexpr int L_QN = 0, L_KN = 17408, L_VV = 34816, L_LM = 52224, L_ATT = 68608, L_UT = 77824, L_WT = 96256, L_KTT = 114688, L_GCS = 133120, L_EGS = 133376, L_BET = 133632, L_SCW = 133888, L_SKT = 134144, L_TM = L_KN, L_TB = L_VV;
constexpr int H_FR = 0, H_QR = 17408, H_QE = 34816, H_KD = 52224, H_KTT = 69632, H_VT = 88064, H_AM = 106496;
constexpr int RS = 272, TS = 144;

typedef unsigned v2u __attribute__((ext_vector_type(2)));
#define LBAR() do { asm volatile("s_waitcnt lgkmcnt(0)" ::: "memory"); __builtin_amdgcn_s_barrier(); asm volatile("" ::: "memory"); } while (0)
__device__ __forceinline__ f32x4 mfma16(bf16x8 a, bf16x8 b, f32x4 c) { return __builtin_amdgcn_mfma_f32_16x16x32_bf16(a, b, c, 0, 0, 0); }
__device__ __forceinline__ bf16x8 ldsfrag(const LAS unsigned char* base, int row, int stride, int kbyte) { return *(const LAS bf16x8*)(base + row * stride + kbyte); }
__device__ __forceinline__ void unpack8(const v4u q, float (&f)[8]) {
    f[0] = __uint_as_float(q.x << 16); f[1] = __uint_as_float(q.x & 0xffff0000u); f[2] = __uint_as_float(q.y << 16); f[3] = __uint_as_float(q.y & 0xffff0000u);
    f[4] = __uint_as_float(q.z << 16); f[5] = __uint_as_float(q.z & 0xffff0000u); f[6] = __uint_as_float(q.w << 16); f[7] = __uint_as_float(q.w & 0xffff0000u); }
__device__ __forceinline__ f32x4 unpack4(const v2u q) { return (f32x4){__uint_as_float(q.x << 16), __uint_as_float(q.x & 0xffff0000u), __uint_as_float(q.y << 16), __uint_as_float(q.y & 0xffff0000u)}; }
__device__ __forceinline__ v2u pack4(const f32x4 v) { v2u o; o.x = pk2(v[0], v[1]); o.y = pk2(v[2], v[3]); return o; }
__device__ __forceinline__ float ldsbf(const LAS unsigned char* base, int row, int stride, int col) { return __uint_as_float(((unsigned)*(const LAS unsigned short*)(base + row * stride + col * 2)) << 16); }

struct MixPtrs {
    const bf16* projA; const bf16* gates; const float* ab; const float* conv_w; const float* a_log; const float* dt_bias; const float* hg_lb; const float* gdn_nw; const float* hg_nw;
    bf16 *PG, *BG, *QP, *OI, *BH, *QE, *OIH, *SG, *SH, *omix; float *GL, *AH;
};

__device__ __forceinline__ void p3_gdn_unit(LAS unsigned char* lds, const MixPtrs& X, int unit, int tid, int lane, int wave) {
    const int h = unit & 3, n = (unit >> 2) & 127, b = unit >> 9, r = lane & 15, g = lane >> 4;
    const size_t tok0 = (size_t)b * T + (size_t)n * 64;
    LAS float* gcs = (LAS float*)(lds + L_GCS); LAS float* egs = (LAS float*)(lds + L_EGS); LAS float* bet = (LAS float*)(lds + L_BET);
    {
#pragma unroll 1
      for (int ib = 0; ib < 6; ib += 3) {
        v4u raw[3][4];
#pragma unroll
        for (int i2 = 0; i2 < 3; ++i2) { const int i = ib + i2; const int pair = (tid >> 4) + 32 * i, tz = pair >> 6, c = pair & 63, ch = tid & 15, col = tz * 512 + h * 128 + ch * 8;
#pragma unroll
            for (int j = 0; j < 4; ++j) { const int tl = n * 64 + c - 3 + j; raw[i2][j] = *(const GAS v4u*)(X.projA + ((size_t)b * T + (tl < 0 ? 0 : tl)) * PA + col); } }
#pragma unroll
        for (int i2 = 0; i2 < 3; ++i2) { const int i = ib + i2;
            const int pair = (tid >> 4) + 32 * i, tz = pair >> 6, c = pair & 63, ch = tid & 15, col = tz * 512 + h * 128 + ch * 8;
            float y[8];
#pragma unroll
            for (int e = 0; e < 8; ++e) y[e] = 0.f;
#pragma unroll
            for (int j = 0; j < 4; ++j) { const int tl = n * 64 + c - 3 + j; const float msk = tl >= 0 ? 1.f : 0.f; float xf[8]; unpack8(raw[i2][j], xf);
                const f32x4 w0 = *(const GAS f32x4*)(X.conv_w + j * 1536 + col) * msk, w1 = *(const GAS f32x4*)(X.conv_w + j * 1536 + col + 4) * msk;
#pragma unroll
                for (int e = 0; e < 4; ++e) { y[e] += w0[e] * xf[e]; y[4 + e] += w1[e] * xf[4 + e]; } }
            float ss = 0.f;
#pragma unroll
            for (int e = 0; e < 8; ++e) { y[e] = siluf_(y[e]); ss += y[e] * y[e]; }
            ss += __shfl_xor(ss, 1); ss += __shfl_xor(ss, 2); ss += __shfl_xor(ss, 4); ss += __shfl_xor(ss, 8);
            const float rn = tz == 2 ? 1.f : rsqrtf(ss + 1e-6f) * (tz == 0 ? 0.08838834764831845f : 1.f);
            v4u o; o.x = pk2(y[0] * rn, y[1] * rn); o.y = pk2(y[2] * rn, y[3] * rn); o.z = pk2(y[4] * rn, y[5] * rn); o.w = pk2(y[6] * rn, y[7] * rn);
            *(LAS v4u*)(lds + (tz == 0 ? L_QN : (tz == 1 ? L_KN : L_VV)) + c * RS + ch * 16) = o;
        }
      }
    }
    if (wave == 0) {
        const float araw = X.ab[(tok0 + lane) * 8 + 4 + h], braw = X.ab[(tok0 + lane) * 8 + h];
        float gv = -expf(X.a_log[h]) * softplusf_(araw + X.dt_bias[h]);
#pragma unroll
        for (int o = 1; o < 64; o <<= 1) { const float t = __shfl_up(gv, o); if (lane >= o) gv += t; }
        { const float eg_ = __expf(gv), be_ = sigmoidf_(braw); gcs[lane] = gv; egs[lane] = eg_; bet[lane] = be_; *(LAS float*)(lds + L_SCW + lane * 4) = be_ * eg_; *(LAS float*)(lds + L_SKT + lane * 4) = __expf(__shfl(gv, 63) - gv); }
        if (lane == 63) X.GL[unit] = gv;
    }
    LBAR();
    {
        const int mt = wave >> 1;
#pragma unroll
        for (int q = 0; q < 2; ++q) { const int ntc = 2 * (wave & 1) + q; f32x4 akk = {0.f, 0.f, 0.f, 0.f}, aqk = {0.f, 0.f, 0.f, 0.f};
#pragma unroll
            for (int ks = 0; ks < 4; ++ks) { const bf16x8 ka = ldsfrag(lds + L_KN, 16 * mt + r, RS, 64 * ks + 16 * g), qa = ldsfrag(lds + L_QN, 16 * mt + r, RS, 64 * ks + 16 * g), kb = ldsfrag(lds + L_KN, 16 * ntc + r, RS, 64 * ks + 16 * g);
                akk = mfma16(ka, kb, akk); aqk = mfma16(qa, kb, aqk); }
            const int j = 16 * ntc + r; const float gj = gcs[j];
#pragma unroll
            for (int ii = 0; ii < 4; ++ii) { const int i = 16 * mt + 4 * g + ii; const float dec = (i >= j) ? __expf(gcs[i] - gj) : 0.f;
                *(LAS float*)(lds + L_LM + (i * 64 + j) * 4) = (i > j) ? bet[i] * akk[ii] * dec : 0.f;
                *(LAS unsigned short*)(lds + L_ATT + i * TS + j * 2) = (unsigned short)f2bf(aqk[ii] * dec); } }
    }
    LBAR();
#pragma unroll
    for (int i = 0; i < 2; ++i) { const int tsk = tid + 512 * i;
        if (tsk < 768) { const int a = tsk >> 8, hh = (tsk >> 7) & 1, d = tsk & 127;
            const LAS unsigned char* sp = lds + (a == 0 ? L_VV : L_KN) + d * 2; const LAS float* scl = (const LAS float*)(lds + (a == 0 ? L_BET : (a == 1 ? L_SCW : L_SKT)));
            LAS unsigned char* dp = lds + (a == 0 ? L_UT : (a == 1 ? L_WT : L_KTT)) + d * TS + 64 * hh;
#pragma unroll
            for (int q = 0; q < 4; ++q) { float kv[8];
#pragma unroll
                for (int e = 0; e < 8; ++e) { const int c = 32 * hh + 8 * q + e; kv[e] = __uint_as_float(((unsigned)*(const LAS unsigned short*)(sp + c * RS)) << 16) * scl[c]; }
                v4u o; o.x = pk2(kv[0], kv[1]); o.y = pk2(kv[2], kv[3]); o.z = pk2(kv[4], kv[5]); o.w = pk2(kv[6], kv[7]); *(LAS v4u*)(dp + 16 * q) = o; } } }
    LBAR();
    { const LAS float* Lm = (const LAS float*)(lds + L_LM); LAS float* Tm = (LAS float*)(lds + L_TM);
      if (tid < 64) { const int I = tid >> 4, j = tid & 15; float x[16];
#pragma unroll
          for (int i = 0; i < 16; ++i) { float s = (i == j) ? 1.f : 0.f;
#pragma unroll
              for (int kb = 0; kb < (i + 3) / 4; ++kb) { const f32x4 l = *(const LAS f32x4*)(Lm + (16 * I + i) * 64 + 16 * I + 4 * kb);
#pragma unroll
                  for (int e = 0; e < 4; ++e) if (4 * kb + e < i) s -= l[e] * x[4 * kb + e]; }
              x[i] = (i < j) ? 0.f : s; Tm[(16 * I + i) * 64 + 16 * I + j] = x[i]; } }
      LBAR();
#pragma unroll 1
      for (int lv = 1; lv < 4; ++lv) {
          for (int e = tid; e < (4 - lv) * 256; e += NWAVES * 64) { const int I = lv + (e >> 8), J = I - lv, rr = (e >> 4) & 15, cc = e & 15; float w = 0.f;
              for (int K = J; K < I; ++K) {
#pragma unroll
                  for (int kb = 0; kb < 4; ++kb) { const f32x4 l = *(const LAS f32x4*)(Lm + (16 * I + rr) * 64 + 16 * K + 4 * kb);
#pragma unroll
                      for (int q = 0; q < 4; ++q) w += l[q] * Tm[(16 * K + 4 * kb + q) * 64 + 16 * J + cc]; } }
              Tm[(16 * J + rr) * 64 + 16 * I + cc] = w; }
          LBAR();
          for (int e = tid; e < (4 - lv) * 256; e += NWAVES * 64) { const int I = lv + (e >> 8), J = I - lv, rr = (e >> 4) & 15, cc = e & 15; float t = 0.f;
#pragma unroll
              for (int kb = 0; kb < 4; ++kb) { const f32x4 l = *(const LAS f32x4*)(Tm + (16 * I + rr) * 64 + 16 * I + 4 * kb);
#pragma unroll
                  for (int q = 0; q < 4; ++q) t -= l[q] * Tm[(16 * J + 4 * kb + q) * 64 + 16 * I + cc]; }
              Tm[(16 * I + rr) * 64 + 16 * J + cc] = t; }
          LBAR();
      }
      { const int i = tid >> 3, j0 = (tid & 7) * 8; const f32x4 t0 = *(const LAS f32x4*)(Tm + i * 64 + j0), t1 = *(const LAS f32x4*)(Tm + i * 64 + j0 + 4); const bool keep = (i >> 4) >= (j0 >> 4);
        v4u o; o.x = keep ? pk2(t0[0], t0[1]) : 0u; o.y = keep ? pk2(t0[2], t0[3]) : 0u; o.z = keep ? pk2(t1[0], t1[1]) : 0u; o.w = keep ? pk2(t1[2], t1[3]) : 0u;
        *(LAS v4u*)(lds + L_TB + i * TS + j0 * 2) = o; }
      LBAR();
    }
    { bf16x8 af[4][2];
#pragma unroll
      for (int mt = 0; mt < 4; ++mt)
#pragma unroll
          for (int ks = 0; ks < 2; ++ks) af[mt][ks] = ldsfrag(lds + L_TB, 16 * mt + r, TS, 64 * ks + 16 * g);
#pragma unroll
      for (int q = 0; q < 2; ++q) { const int ng = 2 * wave + q; LAS unsigned char* base = lds + (ng >= 8 ? L_WT : L_UT) + (16 * (ng & 7) + r) * TS;
          const bf16x8 b0 = *(const LAS bf16x8*)(base + 16 * g), b1 = *(const LAS bf16x8*)(base + 64 + 16 * g);
          f32x4 acc[4];
#pragma unroll
          for (int mt = 0; mt < 4; ++mt) { acc[mt] = mfma16(af[mt][0], b0, (f32x4){0.f, 0.f, 0.f, 0.f}); acc[mt] = mfma16(af[mt][1], b1, acc[mt]); }
          asm volatile("s_waitcnt lgkmcnt(0)" ::: "memory");
#pragma unroll
          for (int mt = 0; mt < 4; ++mt) *(LAS v2u*)(base + (16 * mt + 4 * g) * 2) = pack4(acc[mt]); }
    }
    LBAR();
    {
        const size_t u16 = (size_t)unit * 16384, u8 = (size_t)unit * 8192;
        { const int kk = wave >> 1;
          bf16x8 af[2][2];
#pragma unroll
          for (int t2 = 0; t2 < 2; ++t2)
#pragma unroll
              for (int ks = 0; ks < 2; ++ks) af[t2][ks] = ldsfrag(lds + L_WT, 16 * (2 * kk + t2) + r, TS, 64 * ks + 16 * g);
#pragma unroll
          for (int q = 0; q < 4; ++q) { const int nt = 4 * (wave & 1) + q; f32x4 a0 = {0.f, 0.f, 0.f, 0.f}, a1 = {0.f, 0.f, 0.f, 0.f};
#pragma unroll
              for (int ks = 0; ks < 2; ++ks) { const bf16x8 bfr = ldsfrag(lds + L_KTT, 16 * nt + r, TS, 64 * ks + 16 * g); a0 = mfma16(af[0][ks], bfr, a0); a1 = mfma16(af[1][ks], bfr, a1); }
              v2u o; o.x = __builtin_amdgcn_cvt_pk_fp8_f32(-16.f * a0[0], -16.f * a0[1], 0, false); o.x = __builtin_amdgcn_cvt_pk_fp8_f32(-16.f * a0[2], -16.f * a0[3], o.x, true);
              o.y = __builtin_amdgcn_cvt_pk_fp8_f32(-16.f * a1[0], -16.f * a1[1], 0, false); o.y = __builtin_amdgcn_cvt_pk_fp8_f32(-16.f * a1[2], -16.f * a1[3], o.y, true);
              *(GAS v2u*)((GAS unsigned char*)X.PG + (size_t)unit * 16384 + ((size_t)(nt * 4 + kk) * 64 + lane) * 8) = o; } }
        { const int mt = wave; bf16x8 af[2];
#pragma unroll
          for (int ks = 0; ks < 2; ++ks) af[ks] = ldsfrag(lds + L_KTT, 16 * mt + r, TS, 64 * ks + 16 * g);
#pragma unroll
          for (int nt = 0; nt < 8; ++nt) { f32x4 a0 = {0.f, 0.f, 0.f, 0.f};
#pragma unroll
              for (int ks = 0; ks < 2; ++ks) a0 = mfma16(af[ks], ldsfrag(lds + L_UT, 16 * nt + r, TS, 64 * ks + 16 * g), a0);
              *(GAS v2u*)(X.BG + u16 + ((size_t)(nt * 8 + mt) * 64 + lane) * 4) = pack4(a0); } }
        { const int kk = wave >> 1;
#pragma unroll
          for (int q = 0; q < 2; ++q) { const int ct = 2 * (wave & 1) + q; f32x4 a0 = {0.f, 0.f, 0.f, 0.f}, a1 = {0.f, 0.f, 0.f, 0.f};
#pragma unroll
              for (int ks = 0; ks < 2; ++ks) { const bf16x8 bfr = ldsfrag(lds + L_ATT, 16 * ct + r, TS, 64 * ks + 16 * g);
                  a0 = mfma16(ldsfrag(lds + L_WT, 16 * (2 * kk) + r, TS, 64 * ks + 16 * g), bfr, a0); a1 = mfma16(ldsfrag(lds + L_WT, 16 * (2 * kk + 1) + r, TS, 64 * ks + 16 * g), bfr, a1); }
              const int c = 16 * ct + r; const float eg = egs[c];
              const f32x4 q0 = unpack4(*(const LAS v2u*)(lds + L_QN + c * RS + (32 * kk + 4 * g) * 2)), q1 = unpack4(*(const LAS v2u*)(lds + L_QN + c * RS + (32 * kk + 16 + 4 * g) * 2));
              v4u o; o.x = pk2(q0[0] * eg - a0[0], q0[1] * eg - a0[1]); o.y = pk2(q0[2] * eg - a0[2], q0[3] * eg - a0[3]); o.z = pk2(q1[0] * eg - a1[0], q1[1] * eg - a1[1]); o.w = pk2(q1[2] * eg - a1[2], q1[3] * eg - a1[3]);
              *(GAS v4u*)(X.QP + u8 + ((size_t)(ct * 4 + kk) * 64 + lane) * 8) = o; } }
        { const int vt = wave; bf16x8 af[2];
#pragma unroll
          for (int ks = 0; ks < 2; ++ks) af[ks] = ldsfrag(lds + L_UT, 16 * vt + r, TS, 64 * ks + 16 * g);
#pragma unroll
          for (int ct = 0; ct < 4; ++ct) { f32x4 a0 = {0.f, 0.f, 0.f, 0.f};
#pragma unroll
              for (int ks = 0; ks < 2; ++ks) a0 = mfma16(af[ks], ldsfrag(lds + L_ATT, 16 * ct + r, TS, 64 * ks + 16 * g), a0);
              *(GAS v2u*)(X.OI + u8 + ((size_t)(vt * 4 + ct) * 64 + lane) * 4) = pack4(a0); } }
    }
    LBAR();
}

__device__ __forceinline__ void p3_hgrn_unit(LAS unsigned char* lds, const MixPtrs& X, int unit, int tid, int lane, int wave) {
    const int h = unit & 3, n = (unit >> 2) & 127, b = unit >> 9, r = lane & 15, g = lane >> 4;
    const size_t tok0 = (size_t)b * T + (size_t)n * 64;
#pragma unroll
    for (int i = 0; i < 4; ++i) { const int pair = (tid >> 4) + 32 * i, tz = pair >> 6, c = pair & 63, ch = tid & 15;
        const v4u q = *(const GAS v4u*)(X.projA + (tok0 + c) * PA + (tz ? 2560 : 1536) + h * 128 + ch * 8);
        *(LAS v4u*)(lds + (tz ? H_QR : H_FR) + c * RS + ch * 16) = q; }
    {
        v4u rv[2];
#pragma unroll
        for (int i = 0; i < 2; ++i) { const int item = tid + 512 * i, c = item >> 4, ch = item & 15; rv[i] = *(const GAS v4u*)(X.projA + (tok0 + c) * PA + 2048 + h * 128 + ch * 8); }
#pragma unroll
        for (int i = 0; i < 2; ++i) { const int item = tid + 512 * i, c = item >> 4, ch = item & 15; const unsigned w[4] = {rv[i].x, rv[i].y, rv[i].z, rv[i].w};
#pragma unroll
            for (int e = 0; e < 4; ++e) { *(LAS unsigned short*)(lds + H_VT + (ch * 8 + 2 * e) * TS + c * 2) = (unsigned short)(w[e] & 0xffffu); *(LAS unsigned short*)(lds + H_VT + (ch * 8 + 2 * e + 1) * TS + c * 2) = (unsigned short)(w[e] >> 16); } }
    }
    LBAR();
    {
        const int d = tid & 127, seg = tid >> 7; LAS float* segt = (LAS float*)(lds + H_AM + 9216);
        const float l0 = X.hg_lb[h * 128 + d], l1 = X.hg_lb[512 + h * 128 + d]; const float mx = fmaxf(l0, l1); const float e0 = __expf(l0 - mx), e1 = __expf(l1 - mx); const float lb = e0 / (e0 + e1);
        float lc[16], kq[16]; float run = 0.f;
#pragma unroll
        for (int ci = 0; ci < 16; ++ci) { const float sg = sigmoidf_(ldsbf(lds + H_FR, 16 * seg + ci, RS, d)); run += __logf(lb + (1.f - lb) * sg); lc[ci] = run; kq[ci] = (1.f - lb) * (1.f - sg); }
        segt[seg * 128 + d] = run;
        LBAR();
        const float t0 = segt[d], t1 = segt[128 + d], t2 = segt[256 + d], t3 = segt[384 + d];
        const float off = (seg > 0 ? t0 : 0.f) + (seg > 1 ? t1 : 0.f) + (seg > 2 ? t2 : 0.f), btot = (t0 + t1) + (t2 + t3);
        float kv[16];
#pragma unroll
        for (int ci = 0; ci < 16; ++ci) { const int c = 16 * seg + ci; const float bb = off + lc[ci];
            *(LAS unsigned short*)(lds + H_QE + c * RS + d * 2) = (unsigned short)f2bf(siluf_(ldsbf(lds + H_QR, c, RS, d)) * __expf(bb));
            *(LAS unsigned short*)(lds + H_KD + c * RS + d * 2) = (unsigned short)f2bf(kq[ci] * __expf(-bb));
            kv[ci] = kq[ci] * __expf(btot - bb); }
        if (seg == 0) X.AH[(size_t)unit * 128 + d] = __expf(btot);
#pragma unroll
        for (int q = 0; q < 2; ++q) { v4u o; o.x = pk2(kv[8 * q], kv[8 * q + 1]); o.y = pk2(kv[8 * q + 2], kv[8 * q + 3]); o.z = pk2(kv[8 * q + 4], kv[8 * q + 5]); o.w = pk2(kv[8 * q + 6], kv[8 * q + 7]);
            *(LAS v4u*)(lds + H_KTT + d * TS + (16 * seg + 8 * q) * 2) = o; }
    }
    LBAR();
    {
        const int mt = wave >> 1;
#pragma unroll
        for (int q = 0; q < 2; ++q) { const int ntc = 2 * (wave & 1) + q; f32x4 a0 = {0.f, 0.f, 0.f, 0.f};
#pragma unroll
            for (int ks = 0; ks < 4; ++ks) a0 = mfma16(ldsfrag(lds + H_QE, 16 * mt + r, RS, 64 * ks + 16 * g), ldsfrag(lds + H_KD, 16 * ntc + r, RS, 64 * ks + 16 * g), a0);
            const int j = 16 * ntc + r;
#pragma unroll
            for (int ii = 0; ii < 4; ++ii) { const int i = 16 * mt + 4 * g + ii; *(LAS unsigned short*)(lds + H_AM + i * TS + j * 2) = (unsigned short)f2bf((i >= j) ? a0[ii] : 0.f); } }
    }
    LBAR();
    {
        const size_t u16 = (size_t)unit * 16384, u8 = (size_t)unit * 8192;
        { const int mt = wave; bf16x8 af[2];
#pragma unroll
          for (int ks = 0; ks < 2; ++ks) af[ks] = ldsfrag(lds + H_KTT, 16 * mt + r, TS, 64 * ks + 16 * g);
#pragma unroll
          for (int nt = 0; nt < 8; ++nt) { f32x4 a0 = {0.f, 0.f, 0.f, 0.f};
#pragma unroll
              for (int ks = 0; ks < 2; ++ks) a0 = mfma16(af[ks], ldsfrag(lds + H_VT, 16 * nt + r, TS, 64 * ks + 16 * g), a0);
              *(GAS v2u*)(X.BH + u16 + ((size_t)(nt * 8 + mt) * 64 + lane) * 4) = pack4(a0); } }
        { const int vt = wave; bf16x8 af[2];
#pragma unroll
          for (int ks = 0; ks < 2; ++ks) af[ks] = ldsfrag(lds + H_VT, 16 * vt + r, TS, 64 * ks + 16 * g);
#pragma unroll
          for (int ct = 0; ct < 4; ++ct) { f32x4 a0 = {0.f, 0.f, 0.f, 0.f};
#pragma unroll
              for (int ks = 0; ks < 2; ++ks) a0 = mfma16(af[ks], ldsfrag(lds + H_AM, 16 * ct + r, TS, 64 * ks + 16 * g), a0);
              *(GAS v2u*)(X.OIH + u8 + ((size_t)(vt * 4 + ct) * 64 + lane) * 4) = pack4(a0); } }
#pragma unroll
        for (int q = 0; q < 2; ++q) { const int idx = wave * 2 + q, ct = idx >> 2, kk = idx & 3, c = 16 * ct + r;
            const v2u q0 = *(const LAS v2u*)(lds + H_QE + c * RS + (32 * kk + 4 * g) * 2), q1 = *(const LAS v2u*)(lds + H_QE + c * RS + (32 * kk + 16 + 4 * g) * 2);
            v4u o; o.x = q0.x; o.y = q0.y; o.z = q1.x; o.w = q1.y;
            *(GAS v4u*)(X.QE + u8 + ((size_t)(ct * 4 + kk) * 64 + lane) * 8) = o; }
    }
    LBAR();
}

__device__ __forceinline__ void p4_gdn_scan(LAS unsigned char* lds, const MixPtrs& X, int job, int lane, int wave) {
    const int s = job >> 3, h = job & 3, b = (job >> 2) & 1;
    const int unit0 = (b * 128) * 4 + h;
    constexpr int F8RING = 0, IMG = 65536, BRING = 131072, GLOFF = BRING + 5 * 4096;
    typedef float f32x2_ __attribute__((ext_vector_type(2)));
    if (wave >= 4) {
        const int lw = wave - 4;
        const char* src0 = (const char*)X.PG + (size_t)unit0 * 16384 + lw * 4096 + lane * 16;
        const char* bsrc0 = (const char*)(X.BG + (size_t)unit0 * 16384 + (size_t)(s * 8) * 256) + lw * 1024 + lane * 16;
#define P4_ISSUE(n_) do { const char* s_ = src0 + (size_t)(n_) * (4 * 16384); _Pragma("unroll") for (int i_ = 0; i_ < 4; ++i_) \
        __builtin_amdgcn_global_load_lds((const unsigned*)(s_ + i_ * 1024), (LAS unsigned*)(lds + F8RING + ((n_) & 3) * 16384 + lw * 4096 + i_ * 1024), 16, 0, 2); \
        __builtin_amdgcn_global_load_lds((const unsigned*)(bsrc0 + (size_t)(n_) * (4 * 32768)), (LAS unsigned*)(lds + BRING + ((n_) % 5) * 4096 + lw * 1024), 16, 0, 0); } while (0)
#define P4_DECODE(n_) do { const LAS unsigned char* f_ = lds + F8RING + ((n_) & 3) * 16384 + lw * 4096 + lane * 8; LAS unsigned char* o_ = lds + IMG + ((n_) & 1) * 32768 + lw * 8192 + lane * 16; \
        _Pragma("unroll") for (int q_ = 0; q_ < 8; ++q_) { const v2u q8 = *(const LAS v2u*)(f_ + q_ * 512); \
            const f32x2_ c0 = __builtin_amdgcn_cvt_pk_f32_fp8(q8.x, false), c1 = __builtin_amdgcn_cvt_pk_f32_fp8(q8.x, true), c2 = __builtin_amdgcn_cvt_pk_f32_fp8(q8.y, false), c3 = __builtin_amdgcn_cvt_pk_f32_fp8(q8.y, true); \
            v4u w_; w_.x = __builtin_amdgcn_perm(__float_as_uint(c0.y), __float_as_uint(c0.x), 0x07060302u); w_.y = __builtin_amdgcn_perm(__float_as_uint(c1.y), __float_as_uint(c1.x), 0x07060302u); \
            w_.z = __builtin_amdgcn_perm(__float_as_uint(c2.y), __float_as_uint(c2.x), 0x07060302u); w_.w = __builtin_amdgcn_perm(__float_as_uint(c3.y), __float_as_uint(c3.x), 0x07060302u); \
            *(LAS v4u*)(o_ + q_ * 1024) = w_; } } while (0)
        P4_ISSUE(0); P4_ISSUE(1); P4_ISSUE(2); P4_ISSUE(3);
        asm volatile("s_waitcnt vmcnt(15)" ::: "memory");
        P4_DECODE(0);
        asm volatile("s_waitcnt lgkmcnt(0)" ::: "memory");
#pragma unroll 1
        for (int n = 0; n < 128; ++n) {
            __builtin_amdgcn_s_barrier();
            asm volatile("" ::: "memory");
            if (n + 4 < 128) P4_ISSUE(n + 4);
            if (n + 1 < 128) {
                if (n + 4 < 128) asm volatile("s_waitcnt vmcnt(15)" ::: "memory"); else if (n + 3 < 128) asm volatile("s_waitcnt vmcnt(10)" ::: "memory"); else if (n + 2 < 128) asm volatile("s_waitcnt vmcnt(5)" ::: "memory"); else asm volatile("s_waitcnt vmcnt(0)" ::: "memory");
                P4_DECODE(n + 1);
                asm volatile("s_waitcnt lgkmcnt(0)" ::: "memory");
            }
        }
#undef P4_ISSUE
#undef P4_DECODE
    } else if (wave == 0) {
        f32x4 S[8]; bf16x8 sb[4];
#pragma unroll
        for (int mt = 0; mt < 8; ++mt) S[mt] = (f32x4){0.f, 0.f, 0.f, 0.f};
#pragma unroll
        for (int kk = 0; kk < 4; ++kk) { sb[kk] = (bf16x8){0, 0, 0, 0, 0, 0, 0, 0}; *(GAS bf16x8*)(X.SG + (size_t)unit0 * 16384 + ((size_t)(s * 4 + kk) * 64 + lane) * 8) = sb[kk]; }
        { const float g0 = X.GL[unit0 + 4 * lane], g1 = X.GL[unit0 + 4 * (64 + lane)]; *(LAS float*)(lds + GLOFF + lane * 4) = g0; *(LAS float*)(lds + GLOFF + (64 + lane) * 4) = g1; }
        asm volatile("s_waitcnt vmcnt(0) lgkmcnt(0)" ::: "memory");
#pragma unroll 1
        for (int n = 0; n < 128; ++n) {
            const int unit = unit0 + 4 * n;
            __builtin_amdgcn_s_barrier();
            asm volatile("" ::: "memory");
            const float e = __expf(*(const LAS float*)(lds + GLOFF + n * 4));
            const LAS unsigned char* bb = lds + BRING + (n % 5) * 4096 + lane * 8;
            f32x4 acc[8];
#pragma unroll
            for (int mt = 0; mt < 8; ++mt) acc[mt] = (f32x4){0.f, 0.f, 0.f, 0.f};
            const LAS unsigned char* pb = lds + IMG + (n & 1) * 32768 + lane * 16;
#pragma unroll
            for (int kk = 0; kk < 4; ++kk)
#pragma unroll
                for (int mt = 0; mt < 8; ++mt) acc[mt] = mfma16(*(const LAS bf16x8*)(pb + (mt * 4 + kk) * 1024), sb[kk], acc[mt]);
#pragma unroll
            for (int mt = 0; mt < 8; ++mt) S[mt] = S[mt] * e + unpack4(*(const LAS v2u*)(bb + mt * 512)) + acc[mt] * 0.0625f;
#pragma unroll
            for (int kk = 0; kk < 4; ++kk) { v4u o; o.x = pg8::cvt_pk_bf16(S[2 * kk][0], S[2 * kk][1]); o.y = pg8::cvt_pk_bf16(S[2 * kk][2], S[2 * kk][3]); o.z = pg8::cvt_pk_bf16(S[2 * kk + 1][0], S[2 * kk + 1][1]); o.w = pg8::cvt_pk_bf16(S[2 * kk + 1][2], S[2 * kk + 1][3]); asm volatile("s_nop 1" ::: ); sb[kk] = __builtin_bit_cast(bf16x8, o);
                if (n < 127) *(GAS v4u*)(X.SG + (size_t)(unit + 4) * 16384 + ((size_t)(s * 4 + kk) * 64 + lane) * 8) = o; }
            asm volatile("s_waitcnt lgkmcnt(0)" ::: "memory");
        }
    } else {
#pragma unroll 1
        for (int n = 0; n < 128; ++n) { __builtin_amdgcn_s_barrier(); asm volatile("" ::: "memory"); }
    }
}
__device__ __forceinline__ void p4_hgrn_scan(const MixPtrs& X, int task, int lane) {
    const int mt = task & 7, s = (task >> 3) & 7, h = (task >> 6) & 3, b = task >> 8, g = lane >> 4;
    const int unit0 = (b * 128) * 4 + h;
    f32x4 s0 = {0.f, 0.f, 0.f, 0.f};
    const GAS f32x4* ap = (const GAS f32x4*)(X.AH + (size_t)unit0 * 128 + 16 * mt + 4 * g);
    const GAS v2u* bp = (const GAS v2u*)(X.BH + (size_t)unit0 * 16384 + ((size_t)(s * 8 + mt) * 64 + lane) * 4);
    GAS v2u* sp = (GAS v2u*)(X.SH + (size_t)unit0 * 16384 + ((size_t)(s * 4 + (mt >> 1)) * 64 + lane) * 8 + 4 * (mt & 1));
    { v2u z; z.x = 0; z.y = 0; sp[0] = z; }
    f32x4 ra[8]; v2u rb[8];
#pragma unroll
    for (int j = 0; j < 8; ++j) { ra[j] = ap[(size_t)j * 128]; rb[j] = bp[(size_t)j * 16384]; }
#pragma unroll 1
    for (int n0 = 0; n0 < 128; n0 += 8) {
#pragma unroll
        for (int j = 0; j < 8; ++j) { const int n = n0 + j;
            s0 = ra[j] * s0 + unpack4(rb[j]);
            if (n + 8 < 128) { ra[j] = ap[(size_t)(n + 8) * 128]; rb[j] = bp[(size_t)(n + 8) * 16384]; }
            if (n < 127) sp[(size_t)(n + 1) * 16384] = pack4(s0); }
    }
}
__device__ __forceinline__ void p5_unit(LAS unsigned char* lds, const MixPtrs& X, int bn, int lane, int wave) {
    const int hd = wave & 3, type = wave >> 2, r = lane & 15, g = lane >> 4;
    const int unit = bn * 4 + hd; const size_t tok0 = (size_t)bn * 64;
    const bf16* SX = type ? X.SH : X.SG; const bf16* QX = type ? X.QE : X.QP; const bf16* OX = type ? X.OIH : X.OI;
    const size_t u16 = (size_t)unit * 16384, u8 = (size_t)unit * 8192;
    LAS float* exch = (LAS float*)lds;
    const float* nw = type ? X.hg_nw + hd * 128 : X.gdn_nw;
    bf16x8 af[4][8];
#pragma unroll
    for (int kk = 0; kk < 4; ++kk)
#pragma unroll
        for (int vt = 0; vt < 8; ++vt) af[kk][vt] = *(const GAS bf16x8*)(SX + u16 + ((size_t)(vt * 4 + kk) * 64 + lane) * 8);
#pragma unroll 1
    for (int ct = 0; ct < 4; ++ct) {
        bf16x8 bfr[4]; v2u oq[8], gtq[8];
#pragma unroll
        for (int kk = 0; kk < 4; ++kk) bfr[kk] = *(const GAS bf16x8*)(QX + u8 + ((size_t)(ct * 4 + kk) * 64 + lane) * 8);
#pragma unroll
        for (int vt = 0; vt < 8; ++vt) { oq[vt] = *(const GAS v2u*)(OX + u8 + ((size_t)(vt * 4 + ct) * 64 + lane) * 4);
            gtq[vt] = *(const GAS v2u*)(X.gates + (tok0 + 16 * ct + r) * 1024 + type * 512 + hd * 128 + 16 * vt + 4 * g); }
        f32x4 acc[8];
#pragma unroll
        for (int vt = 0; vt < 8; ++vt) acc[vt] = unpack4(oq[vt]);
#pragma unroll
        for (int kk = 0; kk < 4; ++kk)
#pragma unroll
            for (int vt = 0; vt < 8; ++vt) acc[vt] = mfma16(af[kk][vt], bfr[kk], acc[vt]);
        float ssq = 0.f;
#pragma unroll
        for (int vt = 0; vt < 8; ++vt) ssq += (acc[vt][0] * acc[vt][0] + acc[vt][1] * acc[vt][1]) + (acc[vt][2] * acc[vt][2] + acc[vt][3] * acc[vt][3]);
        ssq += __shfl_xor(ssq, 16); ssq += __shfl_xor(ssq, 32);
        if (type == 1 && g == 0) exch[(ct & 1) * 64 + hd * 16 + r] = ssq;
        LBAR();
        float rstd;
        if (type == 1) { const LAS float* ex = exch + (ct & 1) * 64 + r; rstd = rsqrtf(((ex[0] + ex[16]) + (ex[32] + ex[48])) * (1.f / 512.f) + 1e-6f); } else rstd = rsqrtf(ssq * (1.f / 128.f) + 1e-6f);
#pragma unroll
        for (int vt = 0; vt < 8; ++vt) { const f32x4 w4 = *(const GAS f32x4*)(nw + 16 * vt + 4 * g); const size_t off = (tok0 + 16 * ct + r) * 1024 + type * 512 + hd * 128 + 16 * vt + 4 * g;
            const f32x4 gt = unpack4(gtq[vt]); f32x4 o;
#pragma unroll
            for (int e = 0; e < 4; ++e) o[e] = acc[vt][e] * rstd * w4[e] * siluf_(gt[e]);
            *(GAS v2u*)(X.omix + off) = pack4(o); }
    }
    LBAR();
}

struct Args { const float* in[23]; float* out; unsigned char* ws; int ph_lo, ph_hi, li, pad; };

__global__ void __launch_bounds__(NWAVES * 64, 2) mk_fwd(Args args) {
    extern __shared__ __attribute__((aligned(16))) unsigned char lds_raw[];
    LAS unsigned char* lds = (LAS unsigned char*)lds_raw;
    volatile LAS unsigned* MISC = (volatile LAS unsigned*)(lds + MISC_OFF);
    const int tid = threadIdx.x, lane = tid & 63, wave = __builtin_amdgcn_readfirstlane(tid >> 6);
    const int G = gridDim.x, bx = blockIdx.x, vcu = (G % 8 == 0) ? (bx % 8) * (G / 8) + bx / 8 : bx;
    const int gw = vcu * NWAVES + wave, NGW = G * NWAVES;
    unsigned char* ws = args.ws;
    gu32* ctl = (gu32*)(ws + WS_CTL);
    const float* x = args.in[0]; const float* cvec = args.in[1]; const float* w_ada = args.in[2]; const float* b_ada = args.in[3]; const float* norm1_w = args.in[4];
    const float* w_in = args.in[5]; const float* w_out = args.in[12];
    float* mod = (float*)(ws + WS_MOD); float* wab = (float*)(ws + WS_WAB); float* ab = (float*)(ws + WS_AB);
    bf16* wout_t = (bf16*)(ws + WS_WOUT_T); bf16* win_t = (bf16*)(ws + WS_WIN_T); bf16* h1 = (bf16*)(ws + WS_H1); bf16* projA = (bf16*)(ws + WS_PROJA); bf16* gates = (bf16*)(ws + WS_GATES);
    bf16* omix = (bf16*)(ws + WS_OMIX);
    bf16* h2 = (bf16*)(ws + WS_H2); bf16* w1t = (bf16*)(ws + WS_W1T); bf16* w2t = (bf16*)(ws + WS_W2T); bf16* act = (bf16*)(ws + WS_ACT); bf16* y0 = (bf16*)(ws + WS_Y0); bf16* y1 = (bf16*)(ws + WS_Y1);
    MixPtrs X; X.projA = projA; X.gates = gates; X.ab = ab; X.conv_w = args.in[6]; X.a_log = args.in[7]; X.dt_bias = args.in[8]; X.hg_lb = args.in[10]; X.gdn_nw = args.in[9]; X.hg_nw = args.in[11];
    X.PG = (bf16*)(ws + WS_PG); X.BG = (bf16*)(ws + WS_BG); X.QP = (bf16*)(ws + WS_QP); X.OI = (bf16*)(ws + WS_OI); X.BH = (bf16*)(ws + WS_BH); X.QE = (bf16*)(ws + WS_QE); X.OIH = (bf16*)(ws + WS_OIH);
    X.SG = (bf16*)args.out; X.SH = (bf16*)args.out + (size_t)UNITS * 16384; X.omix = omix; X.GL = (float*)(ws + WS_GL); X.AH = (float*)(ws + WS_AH);
    const int* list = (const int*)(ws + WS_LIST); const float* listw = (const float*)(ws + WS_LISTW);
    LAS unsigned* tb = (LAS unsigned*)(lds + SCR2_OFF);

    for (int u = tid; u < (LDS_BYTES - LDSCTL_OFF) / 4; u += NWAVES * 64) ((LAS unsigned*)(lds + LDSCTL_OFF))[u] = 0u;
    __syncthreads();
    XcdBarrier bar = xcd_barrier_post((unsigned*)(ctl + CW_BAR) + args.li * XCD_BAR_WORDS, MISC + 8);
    const int lo = args.ph_lo, hi = args.ph_hi;
#define IN(k) (lo <= (k) && (k) < hi)
#define BOTH(k) (IN(k) && IN((k) + 1))

    if (IN(0)) {
#define PH_BODY do { \
        if (bx < 96) { \
            LAS float* part = (LAS float*)(lds + RING_BYTES); \
            const int e = bx * 64 + lane; float a0 = 0.f, a1 = 0.f; \
_Pragma("unroll 32") \
            for (int d = wave * 128; d < wave * 128 + 128; ++d) { const float w = w_ada[(size_t)d * 6144 + e]; a0 += siluf_(cvec[d]) * w; a1 += siluf_(cvec[D + d]) * w; } \
            part[(wave * 2 + 0) * 64 + lane] = a0; part[(wave * 2 + 1) * 64 + lane] = a1; \
            __syncthreads(); \
            if (tid < 128) { const int bb = tid >> 6, l = tid & 63; float s = 0.f; \
_Pragma("unroll") \
                for (int w = 0; w < 8; ++w) s += part[(w * 2 + bb) * 64 + l]; \
                mod[bb * 6144 + bx * 64 + l] = s + b_ada[bx * 64 + l]; } \
        } else if (bx == 96) { \
            for (int idx = tid; idx < 8192; idx += NWAVES * 64) wab[idx] = w_in[(size_t)(idx >> 3) * DIN + 2048 + (idx & 7)]; \
        } \
        { const float* w_router = args.in[14]; bf16* wrhi = (bf16*)(ws + WS_WRHI); bf16* wrlo = (bf16*)(ws + WS_WRLO); \
          for (int k = gw; k < 1024; k += NGW) { const float w = w_router[k * 64 + lane]; const unsigned hi = f2bf(w); \
              wrhi[lane * 1024 + k] = (bf16)hi; wrlo[lane * 1024 + k] = (bf16)f2bf(w - __uint_as_float(hi << 16)); } } \
        LAS float* scr = (LAS float*)(lds + wave * 16384); \
        constexpr int I_IN = 16 * 128, I_OUT = 16 * 32; \
        auto mk0 = [&](int it) { TrItem t; if (it < I_IN) { const int kb = it / 128, n0 = 32 * (it % 128); const int sc_ = n0 < 1536 ? n0 : (n0 < 3072 ? n0 + 520 : (n0 < 3584 ? n0 - 1536 : n0 + 8)); \
                t.W = w_in; t.ldw = DIN; t.src_col = sc_; t.WT = win_t; t.K = D; t.dst_row = n0; t.k0 = 64 * kb; t.f8scale = 0.f; } \
            else { const int r = it - I_IN, kb = r / 32, n0 = 32 * (r % 32); t.W = w_out; t.ldw = D; t.src_col = n0; t.WT = wout_t; t.K = D; t.dst_row = n0; t.k0 = 64 * kb; t.f8scale = 0.f; } return t; }; \
        TR_LOOP(gw, NGW, I_IN + I_OUT, mk0); \
        if (BOTH(0)) xcd_barrier(bar); \
    } while (0)
        PH_BODY; if (REPN(0) > 1) { PH_BODY; PH_BODY; }
#undef PH_BODY
    }
    if (IN(1)) {
#define PH_BODY do { \
        { \
            const GAS f32x4* wab4 = (const GAS f32x4*)wab; \
            for (int idx = tid; idx < 2048; idx += NWAVES * 64) { const int d = idx >> 1, qh = idx & 1; *(LAS f32x4*)(lds + (((qh * 4 + (d & 3)) * 256 + (d >> 2)) * 16)) = wab4[idx]; } \
            __syncthreads(); \
            const int nrows = (M - gw + NGW - 1) / NGW; \
            f32x4 sclr[4], shfr[4]; int curb = -1; \
            f32x4 vn[2][4]; \
_Pragma("unroll") \
            for (int q = 0; q < 2; ++q) { const int m = gw + q * NGW; \
_Pragma("unroll") \
                for (int j = 0; j < 4; ++j) vn[q][j] = (q < nrows) ? ((const GAS f32x4*)(x + (size_t)m * D) + lane)[64 * j] : (f32x4){0.f, 0.f, 0.f, 0.f}; } \
_Pragma("unroll 1") \
            for (int p = 0; p < nrows; p += 2) { \
                f32x4 v[2][4]; \
_Pragma("unroll") \
                for (int q = 0; q < 2; ++q) \
_Pragma("unroll") \
                    for (int j = 0; j < 4; ++j) v[q][j] = vn[q][j]; \
_Pragma("unroll") \
                for (int q = 0; q < 2; ++q) { const int m = gw + (p + 2 + q) * NGW; \
                    if (p + 2 + q < nrows) { \
_Pragma("unroll") \
                        for (int j = 0; j < 4; ++j) vn[q][j] = ((const GAS f32x4*)(x + (size_t)m * D) + lane)[64 * j]; } } \
_Pragma("unroll") \
                for (int q = 0; q < 2; ++q) { const int m = gw + (p + q) * NGW; \
                    if (p + q < nrows) { \
                        float ss = 0.f; \
_Pragma("unroll") \
                        for (int j = 0; j < 4; ++j) ss += (v[q][j].x * v[q][j].x + v[q][j].y * v[q][j].y) + (v[q][j].z * v[q][j].z + v[q][j].w * v[q][j].w); \
                        const float rstd = rsqrtf(wave_sum(ss) * (1.f / D) + 1e-6f); \
                        const int bsel = m >= T ? 1 : 0; \
                        if (bsel != curb) { curb = bsel; const GAS f32x4* sh4 = (const GAS f32x4*)(mod + bsel * 6144) + lane; \
_Pragma("unroll") \
                            for (int j = 0; j < 4; ++j) { sclr[j] = ((const GAS f32x4*)norm1_w + lane)[64 * j] * (sh4[256 + 64 * j] + 1.0f); shfr[j] = sh4[64 * j]; } } \
                        GAS unsigned long long* o8 = (GAS unsigned long long*)(h1 + (size_t)m * D) + lane; \
                        f32x4 a0 = {0.f, 0.f, 0.f, 0.f}, a1 = {0.f, 0.f, 0.f, 0.f}; \
_Pragma("unroll") \
                        for (int j = 0; j < 4; ++j) { __builtin_amdgcn_sched_barrier(0); const f32x4 h = v[q][j] * rstd * sclr[j] + shfr[j]; \
                            o8[64 * j] = (unsigned long long)pk2(h.x, h.y) | ((unsigned long long)pk2(h.z, h.w) << 32); \
_Pragma("unroll") \
                            for (int i = 0; i < 4; ++i) { a0 += *(const LAS f32x4*)(lds + ((i * 256 + lane + 64 * j) * 16)) * h[i]; a1 += *(const LAS f32x4*)(lds + (((4 + i) * 256 + lane + 64 * j) * 16)) * h[i]; } } \
 \
                        const bool up5 = (lane & 32) != 0, up4 = (lane & 16) != 0, up3 = (lane & 8) != 0; \
                        f32x4 k4; \
_Pragma("unroll") \
                        for (int e = 0; e < 4; ++e) { const float snd = up5 ? a0[e] : a1[e]; k4[e] = (up5 ? a1[e] : a0[e]) + __shfl_xor(snd, 32); } \
                        float k2[2]; \
_Pragma("unroll") \
                        for (int e = 0; e < 2; ++e) { const float snd = up4 ? k4[e] : k4[2 + e]; k2[e] = (up4 ? k4[2 + e] : k4[e]) + __shfl_xor(snd, 16); } \
                        float k1; { const float snd = up3 ? k2[0] : k2[1]; k1 = (up3 ? k2[1] : k2[0]) + __shfl_xor(snd, 8); } \
                        k1 += __shfl_xor(k1, 4); k1 += __shfl_xor(k1, 2); k1 += __shfl_xor(k1, 1); \
                        if ((lane & 7) == 0) ab[(size_t)m * 8 + 4 * (lane >> 5) + 2 * ((lane >> 4) & 1) + ((lane >> 3) & 1)] = k1; \
                    } } \
            } \
            __syncthreads(); \
        } \
        if (BOTH(1)) xcd_barrier(bar); \
    } while (0)
        PH_BODY; if (REPN(1) > 1) { PH_BODY; PH_BODY; }
#undef PH_BODY
    }
    if (IN(2)) {
#define PH_BODY do { \
        pg8::Gemm g{h1, win_t, M, 4096, D}; pg8::StaticOrder S; S.init(M, 4096, G, (int)blockIdx.x); \
        pg8::EpiProj E{projA, gates}; \
        pg8::gemm_phase<pg8::EpiProj, pg8::StaticOrder, true, true>(lds, g, S, E); \
        if (BOTH(2)) xcd_barrier(bar); \
    } while (0)
        PH_BODY; if (REPN(2) > 1) { PH_BODY; PH_BODY; }
#undef PH_BODY
    }

    if (IN(3)) {
#define PH_BODY do { \
        for (int u = vcu; u < UNITS; u += G) p3_gdn_unit(lds, X, u, tid, lane, wave); \
        for (int u = vcu; u < UNITS; u += G) p3_hgrn_unit(lds, X, u, tid, lane, wave); \
        if (BOTH(3)) xcd_barrier(bar); \
    } while (0)
        PH_BODY; if (REPN(3) > 1) { PH_BODY; PH_BODY; }
#undef PH_BODY
    }
    if (IN(4)) {
#define PH_BODY do { \
        if (bx < 64) p4_gdn_scan(lds, X, bx, lane, wave); \
        else { \
            if (wave < 3 && (bx - 64) * 3 + wave < 512) p4_hgrn_scan(X, (bx - 64) * 3 + wave, lane); \
            LAS float* scr = (LAS float*)(lds + wave * 16384); \
            const float* w_gate = args.in[16]; const float* w_up = args.in[17]; const float* w_down = args.in[18]; const float* ws_gate = args.in[19]; const float* ws_up = args.in[20]; const float* ws_down = args.in[21]; \
            auto mk4 = [&](int it) { TrItem t; const int e = it / 384, r = it % 384; \
                if (r < 256) { const int up = r >> 7, q = r & 127, kb = q >> 3, n0 = 32 * (q & 7); \
                    t.W = e < NE ? (up ? w_up : w_gate) + (size_t)e * D * DE : (up ? ws_up : ws_gate); t.ldw = DE; t.src_col = n0; t.WT = (bf16*)((unsigned char*)w1t + (size_t)e * 512 * 1024); t.K = D; t.dst_row = (n0 >> 7) * 256 + up * 128 + (n0 & 127); t.k0 = 64 * kb; t.f8scale = 32.f; } \
                else { const int q = r - 256, kb = q >> 5, n0 = 32 * (q & 31); \
                    t.W = e < NE ? w_down + (size_t)e * DE * D : ws_down; t.ldw = D; t.src_col = n0; t.WT = (bf16*)((unsigned char*)w2t + (size_t)e * 1024 * 256); t.K = DE; t.dst_row = n0; t.k0 = 64 * kb; t.f8scale = 16.f; } return t; }; \
            TR_LOOP((bx - 64) * NWAVES + wave, (G - 64) * NWAVES, NEX * 384, mk4); \
        } \
        if (BOTH(4)) xcd_barrier(bar); \
    } while (0)
        PH_BODY; if (REPN(4) > 1) { PH_BODY; PH_BODY; }
#undef PH_BODY
    }
    if (IN(5)) {
#define PH_BODY do { \
        for (int bn = vcu; bn < BATCH * 128; bn += G) p5_unit(lds, X, bn, lane, wave); \
        if (BOTH(5)) xcd_barrier(bar); \
    } while (0)
        PH_BODY; if (REPN(5) > 1) { PH_BODY; PH_BODY; }
#undef PH_BODY
    }
    if (IN(6)) {
#define PH_BODY do { \
        pg8::Gemm g{omix, wout_t, M, D, D}; pg8::StaticOrder S; S.init(M, D, G, (int)blockIdx.x); \
        pg8::EpiResid E{x, mod, args.out}; \
        pg8::gemm_phase<pg8::EpiResid, pg8::StaticOrder, true, true>(lds, g, S, E); \
        if (BOTH(6)) xcd_barrier(bar); \
    } while (0)
        PH_BODY; if (REPN(6) > 1) { PH_BODY; PH_BODY; }
#undef PH_BODY
    }


    if (IN(7)) {
        constexpr int HS = 2064;
        constexpr int R_HI = 0, R_LO = 33024, R_PART = 66048, R_SC = 98816, R_SEL = 102912, R_CNT = 107008, R_BASE = 107520, R_ESE = 108032, R_ESL = 110080, R_EW = 112128, R_ELP = 114176;
        if (tid < 64) *(LAS unsigned*)(lds + R_CNT + tid * 4) = 0u;
        __syncthreads();
        int nu = 0;
        const float* norm2_w = args.in[13]; const float* rbias = args.in[15]; const bf16* wrhi = (const bf16*)(ws + WS_WRHI); const bf16* wrlo = (const bf16*)(ws + WS_WRLO);
        int* listo = (int*)(ws + WS_LIST); float* listwo = (float*)(ws + WS_LISTW);
        const int r = lane & 15, g = lane >> 4;
#pragma unroll 1
        for (int u = vcu; u < M / 16; u += G, ++nu) {
            const GAS f32x4* sh4 = (const GAS f32x4*)(mod + (16 * u >= T ? 6144 : 0) + 3072) + lane; const GAS f32x4* nw4 = (const GAS f32x4*)norm2_w + lane;
            f32x4 xrow[2][4];
#pragma unroll
            for (int q = 0; q < 2; ++q) { const GAS f32x4* xr = (const GAS f32x4*)(args.out + (size_t)(16 * u + 2 * wave + q) * D) + lane;
#pragma unroll
                for (int j = 0; j < 4; ++j) xrow[q][j] = xr[64 * j]; }
#pragma unroll
            for (int q = 0; q < 2; ++q) { const int rl = 2 * wave + q, m = 16 * u + rl;
                f32x4 v[4]; float ss = 0.f;
#pragma unroll
                for (int j = 0; j < 4; ++j) { v[j] = xrow[q][j]; ss += (v[j].x * v[j].x + v[j].y * v[j].y) + (v[j].z * v[j].z + v[j].w * v[j].w); }
                const float rstd = rsqrtf(wave_sum(ss) * (1.f / D) + 1e-6f);
                GAS unsigned* o4 = (GAS unsigned*)((unsigned char*)h2 + (size_t)m * D) + lane;
#pragma unroll
                for (int j = 0; j < 4; ++j) { const f32x4 hv = v[j] * rstd * (nw4[64 * j] * (sh4[256 + 64 * j] + 1.0f)) + sh4[64 * j];
                    const unsigned h0 = f2bf(hv.x), h1_ = f2bf(hv.y), h2_ = f2bf(hv.z), h3 = f2bf(hv.w);
                    const unsigned long long hi = (unsigned long long)(h0 | (h1_ << 16)) | ((unsigned long long)(h2_ | (h3 << 16)) << 32);
                    { unsigned q8 = __builtin_amdgcn_cvt_pk_fp8_f32(hv.x, hv.y, 0, false); q8 = __builtin_amdgcn_cvt_pk_fp8_f32(hv.z, hv.w, q8, true); o4[64 * j] = q8; }
                    const unsigned long long lo = (unsigned long long)pk2(hv.x - __uint_as_float(h0 << 16), hv.y - __uint_as_float(h1_ << 16)) | ((unsigned long long)pk2(hv.z - __uint_as_float(h2_ << 16), hv.w - __uint_as_float(h3 << 16)) << 32);
                    *(LAS unsigned long long*)(lds + R_HI + rl * HS + (lane + 64 * j) * 8) = hi; *(LAS unsigned long long*)(lds + R_LO + rl * HS + (lane + 64 * j) * 8) = lo; } }
            __syncthreads();
            { f32x4 acc[4];
#pragma unroll
              for (int nt = 0; nt < 4; ++nt) acc[nt] = (f32x4){0.f, 0.f, 0.f, 0.f};
#pragma unroll 2
              for (int ks = 0; ks < 4; ++ks) { const int kb = (128 * wave + 32 * ks + 8 * g) * 2;
                  const bf16x8 ahi = *(const LAS bf16x8*)(lds + R_HI + r * HS + kb), alo = *(const LAS bf16x8*)(lds + R_LO + r * HS + kb);
#pragma unroll
                  for (int nt = 0; nt < 4; ++nt) { const size_t o = (size_t)(16 * nt + r) * 1024 + 128 * wave + 32 * ks + 8 * g; const bf16x8 bh = *(const GAS bf16x8*)(wrhi + o), bl = *(const GAS bf16x8*)(wrlo + o);
                      acc[nt] = mfma16(ahi, bh, acc[nt]); acc[nt] = mfma16(ahi, bl, acc[nt]); acc[nt] = mfma16(alo, bh, acc[nt]); } }
#pragma unroll
              for (int nt = 0; nt < 4; ++nt)
#pragma unroll
                  for (int ii = 0; ii < 4; ++ii) *(LAS float*)(lds + R_PART + ((wave * 16 + 4 * g + ii) * 64 + 16 * nt + r) * 4) = acc[nt][ii]; }
            __syncthreads();
#pragma unroll
            for (int q = 0; q < 2; ++q) { const int idx = tid + 512 * q; float s = 0.f;
#pragma unroll
                for (int w = 0; w < 8; ++w) s += *(const LAS float*)(lds + R_PART + (w * 1024 + idx) * 4);
                const float sc = sigmoidf_(s); *(LAS float*)(lds + R_SC + idx * 4) = sc; *(LAS float*)(lds + R_SEL + idx * 4) = sc + rbias[idx & 63]; }
            __syncthreads();
#pragma unroll
            for (int q = 0; q < 2; ++q) { const int rl = 2 * wave + q, m = 16 * u + rl;
                const float sel = *(const LAS float*)(lds + R_SEL + (rl * 64 + lane) * 4), score = *(const LAS float*)(lds + R_SC + (rl * 64 + lane) * 4);
                float m1 = sel; m1 = fmaxf(m1, __shfl_xor(m1, 1)); m1 = fmaxf(m1, __shfl_xor(m1, 2)); m1 = fmaxf(m1, __shfl_xor(m1, 4));
                const unsigned long long eq = __ballot(sel == m1) & (0xFFull << (lane & 56)); const int first = __ffsll((long long)eq) - 1;
                float m2 = (lane == first) ? -INFINITY : sel; m2 = fmaxf(m2, __shfl_xor(m2, 1)); m2 = fmaxf(m2, __shfl_xor(m2, 2)); m2 = fmaxf(m2, __shfl_xor(m2, 4));
                const float gs = m1 + m2; const int mygrp = lane >> 3; int grank = 0;
#pragma unroll
                for (int gg = 0; gg < 8; ++gg) { const float o = __shfl(gs, 8 * gg); grank += (o > gs || (o == gs && gg < mygrp)) ? 1 : 0; }
                const float msel = grank < 4 ? sel : -INFINITY; int erank = 0;
#pragma unroll
                for (int e2 = 0; e2 < 64; ++e2) { const float o = __shfl(msel, e2); erank += (o > msel || (o == msel && e2 < lane)) ? 1 : 0; }
                const bool chosen = grank < 4 && erank < 8;
                const float wsum = wave_sum(chosen ? score : 0.f);
                if (chosen && nu < 4) { const int se = lane; const unsigned lp = __hip_atomic_fetch_add((LAS unsigned*)(lds + R_CNT + se * 4), 1u, __ATOMIC_RELAXED, __HIP_MEMORY_SCOPE_WORKGROUP);
                    const int ei = ((nu * 16 + rl) * 8 + erank) * 4;
                    *(LAS int*)(lds + R_ESE + ei) = se; *(LAS int*)(lds + R_ESL + ei) = m * 8 + erank; *(LAS float*)(lds + R_EW + ei) = score / wsum * 2.5f; *(LAS unsigned*)(lds + R_ELP + ei) = lp; } }
            __syncthreads();
            if (nu == 3 || u + G >= M / 16) {
                if (tid < 64) { const unsigned c = *(LAS unsigned*)(lds + R_CNT + tid * 4); *(LAS unsigned*)(lds + R_BASE + tid * 4) = c ? __hip_atomic_fetch_add(ctl + CW_CNT + 64 * tid, c, RLX_AGENT) : 0u; }
                __syncthreads();
                for (int idx = tid; idx < (nu + 1) * 128; idx += NWAVES * 64) { const int se = *(LAS int*)(lds + R_ESE + idx * 4); const unsigned pos = *(LAS unsigned*)(lds + R_BASE + se * 4) + *(LAS unsigned*)(lds + R_ELP + idx * 4);
                    if (pos < (unsigned)CAP) { listo[(size_t)se * CAP + pos] = *(LAS int*)(lds + R_ESL + idx * 4); listwo[(size_t)se * CAP + pos] = *(LAS float*)(lds + R_EW + idx * 4); } }
                __syncthreads();
                if (tid < 64) *(LAS unsigned*)(lds + R_CNT + tid * 4) = 0u;
                __syncthreads();
                nu = -1;
            }
        }
        if (BOTH(7)) xcd_barrier(bar);
    }
    if (lo <= 10 && hi > 8) {
        if (tid < 65) { const int e = tid; unsigned c = (unsigned)M;
            if (e < 64) { c = __hip_atomic_load(ctl + CW_CNT + 64 * e, RLX_AGENT); c = c < (unsigned)CAP ? c : (unsigned)CAP; }
            tb[TB_CNT + tid] = c; }
        __syncthreads();
        if (tid == 0) { unsigned ro = 0; for (int s = 0; s < 65; ++s) { tb[TB_OFF + s] = ro; ro += tb[TB_CNT + s]; } }
        __syncthreads();
    }
#define MOE_PREFIX(lo_, hi_, NT_, perm_) do { __syncthreads(); if (tid == 0) { unsigned up = 0; for (int s = (lo_); s < (hi_); ++s) { const int sg_ = (perm_) ? (s & 1) * 65 + (s >> 1) : s; tb[TB_PRE + s] = up; up += ((tb[TB_CNT + sg_] + 255u) >> 8) * (NT_); } tb[TB_PRE + (hi_)] = up; } __syncthreads(); } while (0)
    if (IN(8)) {
#define PH_BODY do { \
        MOE_PREFIX(0, 65, 2, 0); \
        pg8::Moe1Prob P{D, 1024, pg8::MoeSched{tb, 0, 65, 2, G, vcu, 0}, (const unsigned char*)h2, (const unsigned char*)w1t, list}; \
        pg8::EpiMoe1 E{(unsigned char*)act, tb}; \
        pg8::gemm_phase_g<pg8::Moe1Prob, pg8::EpiMoe1, true>(lds, P, E); \
        if (BOTH(8)) xcd_barrier(bar); \
    } while (0)
        PH_BODY; if (REPN(8) > 1) { PH_BODY; PH_BODY; }
#undef PH_BODY
    }
    if (IN(9)) for (int rep_ = 0; rep_ < REPN(9); ++rep_) {
        MOE_PREFIX(0, 65, 4, 0);
        pg8::Moe2Prob P{DE, 256, pg8::MoeSched{tb, 0, 65, 4, G, vcu, 0}, (const unsigned char*)act, (const unsigned char*)w2t};
        pg8::EpiMoe2 E{(unsigned char*)y0, (unsigned char*)y1, ws + WS_YS, list, listw, tb};
        pg8::gemm_phase_g<pg8::Moe2Prob, pg8::EpiMoe2, true>(lds, P, E);
        if (BOTH(9)) xcd_barrier(bar);
    }
    if (IN(10)) {
        const float* fw = args.in[22]; const unsigned char* yb0 = (const unsigned char*)y0; const unsigned char* yb1 = (const unsigned char*)y1;
        typedef float f32x2_ __attribute__((ext_vector_type(2)));
        f32x4 fwr[2][2];
#pragma unroll
        for (int j = 0; j < 2; ++j)
#pragma unroll
            for (int h2_ = 0; h2_ < 2; ++h2_) fwr[j][h2_] = ((const GAS f32x4*)fw)[2 * lane + 128 * j + h2_];
#define P10_LOAD(m_, yq_, xv_, g2v_) do { const int hf_ = (m_) >= T ? 1 : 0; const GAS f32x4* xr_ = (const GAS f32x4*)(args.out + (size_t)(m_) * D); \
            const GAS v2u* yr_ = (const GAS v2u*)(hf_ ? yb1 + (size_t)((m_) - T) * 8 * D : yb0 + (size_t)(m_) * 8 * D) + lane; const GAS v2u* ysr_ = (const GAS v2u*)(ws + WS_YS + (size_t)(m_) * D) + lane; \
            const GAS f32x4* g24_ = (const GAS f32x4*)(mod + hf_ * 6144 + 5120); \
            _Pragma("unroll") for (int j = 0; j < 2; ++j) { _Pragma("unroll") for (int h2_ = 0; h2_ < 2; ++h2_) { xv_[j][h2_] = xr_[2 * lane + 128 * j + h2_]; g2v_[j][h2_] = g24_[2 * lane + 128 * j + h2_]; } \
                _Pragma("unroll") for (int k = 0; k < 8; ++k) yq_[k][j] = yr_[k * 128 + 64 * j]; yq_[8][j] = ysr_[64 * j]; } } while (0)
        v2u yqn[9][2]; f32x4 xvn[2][2], g2n[2][2];
        if (gw < M) P10_LOAD(gw, yqn, xvn, g2n);
#pragma unroll 1
        for (int m = gw; m < M; m += NGW) {
            GAS f32x4* xr = (GAS f32x4*)(args.out + (size_t)m * D);
            v2u yq[9][2]; f32x4 xv[2][2], g2v[2][2];
#pragma unroll
            for (int j = 0; j < 2; ++j) {
#pragma unroll
                for (int k = 0; k < 9; ++k) yq[k][j] = yqn[k][j];
#pragma unroll
                for (int h2_ = 0; h2_ < 2; ++h2_) { xv[j][h2_] = xvn[j][h2_]; g2v[j][h2_] = g2n[j][h2_]; } }
            if (m + NGW < M) P10_LOAD(m + NGW, yqn, xvn, g2n);
            f32x4 v[2][2]; float ss = 0.f;
#pragma unroll
            for (int j = 0; j < 2; ++j) { f32x4 s0 = {0.f, 0.f, 0.f, 0.f}, s1 = {0.f, 0.f, 0.f, 0.f};
#pragma unroll
                for (int k = 0; k < 9; ++k) { const f32x2_ a = __builtin_amdgcn_cvt_pk_f32_fp8(yq[k][j].x, false), b = __builtin_amdgcn_cvt_pk_f32_fp8(yq[k][j].x, true), c = __builtin_amdgcn_cvt_pk_f32_fp8(yq[k][j].y, false), d = __builtin_amdgcn_cvt_pk_f32_fp8(yq[k][j].y, true);
                    s0.x += a.x; s0.y += a.y; s0.z += b.x; s0.w += b.y; s1.x += c.x; s1.y += c.y; s1.z += d.x; s1.w += d.y; }
                v[j][0] = xv[j][0] + g2v[j][0] * (s0 * 0.03125f); v[j][1] = xv[j][1] + g2v[j][1] * (s1 * 0.03125f);
#pragma unroll
                for (int h2_ = 0; h2_ < 2; ++h2_) ss += (v[j][h2_].x * v[j][h2_].x + v[j][h2_].y * v[j][h2_].y) + (v[j][h2_].z * v[j][h2_].z + v[j][h2_].w * v[j][h2_].w); }
            const float rstd = rsqrtf(wave_sum(ss) * (1.f / D) + 1e-6f);
#pragma unroll
            for (int j = 0; j < 2; ++j)
#pragma unroll
                for (int h2_ = 0; h2_ < 2; ++h2_) xr[2 * lane + 128 * j + h2_] = v[j][h2_] * rstd * fwr[j][h2_];
        }
#undef P10_LOAD
    }
#undef MOE_PREFIX
#undef IN
#undef BOTH
}

static void launch_mk(Args a, int lo, int hi, int li, int grid, hipStream_t stream) {
    a.ph_lo = lo; a.ph_hi = hi; a.li = li;
    hipLaunchKernelGGL(mk_fwd, dim3(grid), dim3(NWAVES * 64), LDS_BYTES, stream, a);
}
extern "C" void kernel_launch(void* const* d_in, const int* in_sizes, int n_in, void* d_out, int out_size, void* d_ws, size_t ws_size, hipStream_t stream) {
    static int grid = 0;
    if (grid == 0) {
        int dev = 0, cus = 0;
        if (hipGetDevice(&dev) != hipSuccess || hipDeviceGetAttribute(&cus, hipDeviceAttributeMultiprocessorCount, dev) != hipSuccess) { grid = -1; return; }
        if (hipFuncSetAttribute((const void*)mk_fwd, hipFuncAttributeMaxDynamicSharedMemorySize, LDS_BYTES) != hipSuccess) { grid = -1; return; }
        grid = cus;
    }
    if (grid < 0) return;
    unsigned char* ws = (unsigned char*)d_ws; float* out = (float*)d_out;
    (void)hipMemsetAsync(ws + WS_CTL, 0, CTL_ZERO_BYTES, stream);
    Args a{};
    for (int i = 0; i < 23; ++i) a.in[i] = (const float*)d_in[i];
    a.out = out; a.ws = ws;
    launch_mk(a, 0, 11, 0, grid, stream);
}
```

```cpp
#include <hip/hip_runtime.h>
#include <cstdio>
#include <cstdint>
namespace pg8 {
#define PG8_LAS __attribute__((address_space(3)))
typedef unsigned short bf16_t;
typedef short bf16x8 __attribute__((ext_vector_type(8)));
typedef float f32x4 __attribute__((ext_vector_type(4)));
typedef unsigned u32x4 __attribute__((ext_vector_type(4)));
constexpr int BM = 256, BK = 64, HALF = 128, HTB = HALF * BK * 2  , STAGE_BYTES = 8 * HTB, NXCD = 8, WGM = 8;

__host__ __device__ __forceinline__ int lds_byte(int r, int c) { const int st = (r >> 4) * 2 + (c >> 5), rr = r & 15, cc = c & 31, ob = rr * 64 + cc * 2; return st * 1024 + (ob ^ (((ob >> 9) & 1) << 5)); }
__host__ __device__ __forceinline__ void stage_rc(int b, int& R, int& C) { const int st = b / 1024, sb = b % 1024, swz = sb ^ (((sb >> 9) & 1) << 5); R = (st >> 1) * 16 + swz / 64; C = (st & 1) * 32 + (swz % 64) / 2; }
__host__ __device__ __forceinline__ int perm32(int rho) { const int n = rho >> 4, i = rho & 15; return 8 * (i >> 2) + 4 * n + (i & 3); }

struct Unit { int pm, pn; };
struct Gemm { const bf16_t* A; const bf16_t* Bt; int M, N, K; };

struct StaticOrder {
    int nM, nN, nwg, G, c;
    __host__ __device__ void init(int M, int N, int G_, int c_) { nM = M / BM; nN = N / BM; nwg = nM * nN; G = G_; c = c_; }
    __host__ __device__ bool next(int i, Unit& u) const {
        const long L = (long)i * G + c; if (L >= nwg) return false;
        int wgid = (int)L; { const int q = nwg / NXCD, r = nwg % NXCD, xcd = wgid % NXCD, off = wgid / NXCD; wgid = (xcd < r ? xcd * (q + 1) : r * (q + 1) + (xcd - r) * q) + off; }
        const int nig = WGM * nN, gid = wgid / nig, fm = gid * WGM, gsz = (nM - fm) < WGM ? (nM - fm) : WGM;
        u.pm = fm + ((wgid % nig) % gsz); u.pn = (wgid % nig) / gsz; return true;
    }
    __device__ __forceinline__ void a_ready(const Unit&) const {}
    __device__ __forceinline__ void done(const Unit&) const {}
};
__device__ __forceinline__ unsigned cvt_pk_bf16(float lo, float hi) { unsigned r; asm volatile("v_cvt_pk_bf16_f32 %0, %1, %2" : "=v"(r) : "v"(lo), "v"(hi)); return r; }
template <class Epi, class Sched, bool ALIGN_EPI = false, bool SP2 = false>
__device__ __forceinline__ void gemm_phase(PG8_LAS unsigned char* lds, const Gemm g, const Sched& S, const Epi& E) {
    const int tid = threadIdx.x, wid = __builtin_amdgcn_readfirstlane(tid >> 6), lane = tid & 63, wr = wid >> 2, wc = wid & 3, fr = lane & 15, fq = lane >> 4;
    const int K = g.K, nt = K / BK;
    unsigned voffA[2], voffB[2];
#pragma unroll
    for (int i = 0; i < 2; ++i) { int R, C; stage_rc(tid * 16 + i * 8192, R, C); const int Rb = Epi::PERM ? ((R & ~31) + perm32(R & 31)) : R;
        voffA[i] = (unsigned)(R * K + C) * 2u; voffB[i] = (unsigned)(Rb * K + C) * 2u; }
    const size_t kstep = (size_t)(BK * 2);
    const size_t hstep = (size_t)HALF * K * 2;
    const size_t tstep = 2 * hstep;
    const unsigned ldsw = (unsigned)wid * 1024u;
    const int aoff = lds_byte(wr * 64 + fr, fq * 8), boff = lds_byte(wc * 32 + fr, fq * 8);
#define PG8_SA(b, h) (((b) * 2 + (h)) * HTB)
#define PG8_SB(b, h) ((4 + (b) * 2 + (h)) * HTB)
#define PG8_STAGE(bufoff, gbase, voff) do { _Pragma("unroll") for (int _i = 0; _i < 2; ++_i) \
        __builtin_amdgcn_global_load_lds((const unsigned*)((const char*)(gbase) + (voff)[_i]), (PG8_LAS unsigned*)(lds + (bufoff) + ldsw + _i * 8192), 16, 0, 0); } while (0)
#define PG8_LDA(dst, b, h) do { _Pragma("unroll") for (int m = 0; m < 4; ++m) _Pragma("unroll") for (int k = 0; k < 2; ++k) dst[m][k] = *(const PG8_LAS bf16x8*)(lds + PG8_SA(b, h) + aoff + m * 2048 + k * 1024); } while (0)
#define PG8_LDB(dst, b, h) do { _Pragma("unroll") for (int n = 0; n < 2; ++n) _Pragma("unroll") for (int k = 0; k < 2; ++k) dst[n][k] = *(const PG8_LAS bf16x8*)(lds + PG8_SB(b, h) + boff + n * 2048 + k * 1024); } while (0)
#define PG8_MMA(ai, bj, At, Bt) do { __builtin_amdgcn_s_setprio(1); _Pragma("unroll") for (int m = 0; m < 4; ++m) _Pragma("unroll") for (int n = 0; n < 2; ++n) _Pragma("unroll") for (int k = 0; k < 2; ++k) \
        acc[ai][bj][m][n] = __builtin_amdgcn_mfma_f32_16x16x32_bf16(Bt[n][k], At[m][k], acc[ai][bj][m][n], 0, 0, 0); __builtin_amdgcn_s_setprio(0); } while (0)
#define PG8_WAIT_V(n) asm volatile("s_waitcnt vmcnt(" #n ")" ::: "memory")
#define PG8_WAIT_L(n) asm volatile("s_waitcnt lgkmcnt(" #n ")" ::: "memory")
#define PG8_BAR __builtin_amdgcn_s_barrier()
#define PG8_SCHED __builtin_amdgcn_sched_barrier(0)
    Unit cur, nxt; int ui = 0;
    if (!S.next(0, cur)) return;
    f32x4 acc[2][2][4][2];
#pragma unroll
    for (int a = 0; a < 2; ++a)
#pragma unroll
        for (int b = 0; b < 2; ++b)
#pragma unroll
            for (int m = 0; m < 4; ++m)
#pragma unroll
                for (int n = 0; n < 2; ++n) acc[a][b][m][n] = (f32x4){0.f, 0.f, 0.f, 0.f};
    bf16x8 At[4][2], B0[2][2], B1[2][2];
    const char* cA = (const char*)g.A + (size_t)cur.pm * tstep; const char* cB = (const char*)g.Bt + (size_t)cur.pn * tstep;
    S.a_ready(cur);
    if constexpr (SP2) {
        PG8_STAGE(PG8_SB(0, 0), cB, voffB); PG8_STAGE(PG8_SB(0, 1), cB + hstep, voffB); PG8_STAGE(PG8_SA(0, 0), cA, voffA); PG8_STAGE(PG8_SA(0, 1), cA + hstep, voffA);
        if (wr == 1) PG8_BAR;
        PG8_WAIT_V(2); PG8_BAR;
        PG8_STAGE(PG8_SB(1, 0), cB + kstep, voffB); PG8_STAGE(PG8_SA(1, 0), cA + kstep, voffA); PG8_STAGE(PG8_SB(1, 1), cB + hstep + kstep, voffB);
        PG8_WAIT_V(6); PG8_BAR;
    } else {
        PG8_STAGE(PG8_SB(0, 0), cB, voffB); PG8_STAGE(PG8_SA(0, 0), cA, voffA); PG8_STAGE(PG8_SB(0, 1), cB + hstep, voffB); PG8_STAGE(PG8_SA(0, 1), cA + hstep, voffA);
        if (wr == 1) PG8_BAR;
        PG8_WAIT_V(4); PG8_BAR;
        PG8_STAGE(PG8_SB(1, 0), cB + kstep, voffB); PG8_STAGE(PG8_SA(1, 0), cA + kstep, voffA); PG8_STAGE(PG8_SB(1, 1), cB + hstep + kstep, voffB);
        PG8_WAIT_V(6); PG8_BAR;
    }
    for (;;) {
        const bool has_next = S.next(ui + 1, nxt);
        const char* nA = has_next ? (const char*)g.A + (size_t)nxt.pm * tstep : cA; const char* nB = has_next ? (const char*)g.Bt + (size_t)nxt.pn * tstep : cB;
        for (int t = 0; t < nt; t += 2) {
            const bool last = (t == nt - 2);
            const char* a1 = cA + (size_t)(t + 1) * kstep;
            const char* a2 = last ? nA : cA + (size_t)(t + 2) * kstep; const char* b2 = last ? nB : cB + (size_t)(t + 2) * kstep;
            const char* a3 = a2 + kstep; const char* b3 = b2 + kstep;
            if (last && has_next) S.a_ready(nxt);
            if constexpr (SP2) {
            PG8_LDB(B0, 0, 0); PG8_LDB(B1, 0, 1); PG8_SCHED; PG8_LDA(At, 0, 0); PG8_STAGE(PG8_SA(1, 1), a1 + hstep, voffA);
            PG8_WAIT_V(8); PG8_WAIT_L(0); PG8_BAR; PG8_MMA(0, 0, At, B0); PG8_MMA(0, 1, At, B1); PG8_BAR; PG8_SCHED;
            PG8_LDA(At, 0, 1); PG8_STAGE(PG8_SB(0, 0), b2, voffB); PG8_STAGE(PG8_SB(0, 1), b2 + hstep, voffB); PG8_STAGE(PG8_SA(0, 0), a2, voffA);
            PG8_WAIT_V(8); PG8_WAIT_L(0); PG8_BAR; PG8_MMA(1, 0, At, B0); PG8_MMA(1, 1, At, B1); PG8_BAR; PG8_SCHED;
            PG8_LDB(B0, 1, 0); PG8_LDB(B1, 1, 1); PG8_SCHED; PG8_LDA(At, 1, 0); PG8_STAGE(PG8_SA(0, 1), a2 + hstep, voffA);
            PG8_WAIT_V(8); PG8_WAIT_L(0); PG8_BAR; PG8_MMA(0, 0, At, B0); PG8_MMA(0, 1, At, B1); PG8_BAR; PG8_SCHED;
            PG8_LDA(At, 1, 1); PG8_STAGE(PG8_SB(1, 0), b3, voffB); PG8_STAGE(PG8_SB(1, 1), b3 + hstep, voffB); PG8_STAGE(PG8_SA(1, 0), a3, voffA);
            PG8_WAIT_V(8); PG8_WAIT_L(0); PG8_BAR; PG8_MMA(1, 0, At, B0); PG8_MMA(1, 1, At, B1); PG8_BAR; PG8_SCHED;
            } else {
            PG8_LDB(B0, 0, 0); PG8_SCHED; PG8_LDA(At, 0, 0); PG8_STAGE(PG8_SA(1, 1), a1 + hstep, voffA);
            PG8_WAIT_L(8); PG8_BAR; PG8_WAIT_L(0); PG8_MMA(0, 0, At, B0); PG8_BAR; PG8_SCHED;
            PG8_LDB(B1, 0, 1); PG8_STAGE(PG8_SB(0, 0), b2, voffB);
            PG8_BAR; PG8_WAIT_L(0); PG8_MMA(0, 1, At, B1); PG8_BAR;
            PG8_LDA(At, 0, 1); PG8_STAGE(PG8_SA(0, 0), a2, voffA);
            PG8_BAR; PG8_WAIT_L(0); PG8_MMA(1, 0, At, B0); PG8_BAR; PG8_SCHED;
            PG8_STAGE(PG8_SB(0, 1), b2 + hstep, voffB);
            PG8_WAIT_V(6); PG8_BAR; PG8_MMA(1, 1, At, B1); PG8_BAR;
            PG8_LDB(B0, 1, 0); PG8_SCHED; PG8_LDA(At, 1, 0); PG8_STAGE(PG8_SA(0, 1), a2 + hstep, voffA);
            PG8_WAIT_L(8); PG8_BAR; PG8_WAIT_L(0); PG8_MMA(0, 0, At, B0); PG8_BAR; PG8_SCHED;
            PG8_LDB(B1, 1, 1); PG8_STAGE(PG8_SB(1, 0), b3, voffB);
            PG8_BAR; PG8_WAIT_L(0); PG8_MMA(0, 1, At, B1); PG8_BAR;
            PG8_LDA(At, 1, 1); PG8_STAGE(PG8_SA(1, 0), a3, voffA);
            PG8_BAR; PG8_WAIT_L(0); PG8_MMA(1, 0, At, B0); PG8_BAR; PG8_SCHED;
            PG8_STAGE(PG8_SB(1, 1), b3 + hstep, voffB);
            PG8_WAIT_V(6); PG8_BAR; PG8_MMA(1, 1, At, B1); PG8_BAR;
            }
        }
        if constexpr (ALIGN_EPI) { if (wr == 0) PG8_BAR; }
        if constexpr (!Epi::AFTER_DRAIN) { E(acc, cur, wr, wc, fr, fq); S.done(cur); }
        if (!has_next) break;
#pragma unroll
        for (int a = 0; a < 2; ++a)
#pragma unroll
            for (int b = 0; b < 2; ++b)
#pragma unroll
                for (int m = 0; m < 4; ++m)
#pragma unroll
                    for (int n = 0; n < 2; ++n) acc[a][b][m][n] = (f32x4){0.f, 0.f, 0.f, 0.f};
        cur = nxt; cA = nA; cB = nB; ++ui;
        if constexpr (ALIGN_EPI) { if (wr == 1) PG8_BAR; }
    }
    PG8_WAIT_V(0);
    if constexpr (!ALIGN_EPI) { if (wr == 0) PG8_BAR; }
    PG8_BAR;
    if constexpr (Epi::AFTER_DRAIN) { E.fused(acc, cur, wr, wc, fr, fq, lds, wid, lane); S.done(cur); }
#undef PG8_SA
#undef PG8_SB
#undef PG8_STAGE
#undef PG8_LDA
#undef PG8_LDB
#undef PG8_MMA
#undef PG8_WAIT_V
#undef PG8_WAIT_L
#undef PG8_BAR
#undef PG8_SCHED
}
}
#define GAS __attribute__((address_space(1)))
#define LAS __attribute__((address_space(3)))
typedef unsigned short bf16;
typedef unsigned v4u __attribute__((ext_vector_type(4)));
typedef float f32x4 __attribute__((ext_vector_type(4)));
typedef short bf16x8 __attribute__((ext_vector_type(8)));
typedef GAS unsigned gu32;
typedef GAS unsigned long long gu64;
#define RLX_AGENT __ATOMIC_RELAXED, __HIP_MEMORY_SCOPE_AGENT
#define LDS_WAIT() asm volatile("s_waitcnt lgkmcnt(0)" ::: "memory")
#define VM_WAIT() asm volatile("s_waitcnt vmcnt(0)" ::: "memory")
__device__ __forceinline__ unsigned long long rt() { return __builtin_amdgcn_s_memrealtime(); }
__device__ __forceinline__ unsigned f2bf(float f) { unsigned u = __builtin_bit_cast(unsigned, f); return (u + 0x7fffu + ((u >> 16) & 1u)) >> 16; }
__device__ __forceinline__ unsigned pk2(float lo, float hi) { return f2bf(lo) | (f2bf(hi) << 16); }
#define XB_TMO      128
#define XB_XCNT(j)  (256  + 64 * (j))
#define XB_XSUB(j)  (1280 + 64 * (j))
#define XB_XGEN(j)  (2304 + 64 * (j))
#define XB_TOP      3328
#define XB_TOPGEN   3392
#define XCD_BAR_WORDS 3456
#define XB_SPIN_CAP (1u << 18)

__device__ __forceinline__ unsigned xb_ld(unsigned* p)              { return __hip_atomic_load(p, __ATOMIC_RELAXED, __HIP_MEMORY_SCOPE_AGENT); }
__device__ __forceinline__ unsigned xb_add(unsigned* p, unsigned v) { return __hip_atomic_fetch_add(p, v, __ATOMIC_RELAXED, __HIP_MEMORY_SCOPE_AGENT); }
__device__ __forceinline__ unsigned xb_xcc_id() { return (unsigned)__builtin_amdgcn_s_getreg((3 << 11) | 20) & 0xFu; }
#define XB_SPIN(cond, bar) do { unsigned _sp = 0; while (cond) { __builtin_amdgcn_s_sleep(1); \
    if ((++_sp & 255u) == 0u) { if (xb_ld(&(bar)[XB_TMO])) break; if (_sp > XB_SPIN_CAP) { atomicAdd(&(bar)[XB_TMO], 1u); break; } } } } while (0)

struct XcdBarrier {
    unsigned* bar; unsigned x;
    volatile LAS unsigned* st;
};

__device__ __forceinline__ XcdBarrier xcd_barrier_post(unsigned* bar, volatile LAS unsigned* st) {
    XcdBarrier b; b.bar = bar; b.x = xb_xcc_id(); b.st = st;
    if (threadIdx.x == 0) (void)xb_add(&bar[XB_XCNT(b.x)], 1u);
    return b;
}
__device__ __forceinline__ void xcd_barrier_complete(unsigned* bar, unsigned x, unsigned& nloc, unsigned& nx) {
    const unsigned G = gridDim.x * gridDim.y * gridDim.z;
    unsigned sum, cnt, mine, sp = 0u;
    for (;;) {
        sum = 0u; cnt = 0u; mine = 0u;
#pragma unroll
        for (unsigned j = 0; j < 16; ++j) { const unsigned c = xb_ld(&bar[XB_XCNT(j)]); sum += c; cnt += (c > 0u) ? 1u : 0u; mine = (j == x) ? c : mine; }
        if (sum == G) break;
        __builtin_amdgcn_s_sleep(1);
        if ((++sp & 255u) == 0u) { if (xb_ld(&bar[XB_TMO])) break; if (sp > XB_SPIN_CAP) { atomicAdd(&bar[XB_TMO], 1u); break; } }
    }
    nloc = mine > 0u ? mine : 1u; nx = cnt > 0u ? cnt : 1u;
}

__device__ __forceinline__ void xcd_barrier(const XcdBarrier& b) {
    asm volatile("s_waitcnt vmcnt(0)" ::: "memory");
    __syncthreads();
    if (threadIdx.x == 0) {
        unsigned* bar = b.bar;
        __builtin_amdgcn_s_waitcnt(0);
        unsigned nloc = b.st[0], nx = b.st[1];
        if (nloc == 0u) { xcd_barrier_complete(bar, b.x, nloc, nx); b.st[0] = nloc; b.st[1] = nx; }
        const unsigned old = xb_add(&bar[XB_XSUB(b.x)], 1u);
        const unsigned gen = old / nloc;
        if (old + 1u == (gen + 1u) * nloc) {
            __builtin_amdgcn_fence(__ATOMIC_RELEASE, "agent");
            asm volatile("s_waitcnt vmcnt(0)" ::: "memory");
            const unsigned og = xb_add(&bar[XB_TOP], 1u);
            const unsigned tg = og / nx;
            if (og + 1u == (tg + 1u) * nx) xb_add(&bar[XB_TOPGEN], 1u);
            else XB_SPIN(xb_ld(&bar[XB_TOPGEN]) == tg, bar);
            __builtin_amdgcn_fence(__ATOMIC_ACQUIRE, "agent");
            xb_add(&bar[XB_XGEN(b.x)], 1u);
            asm volatile("s_waitcnt vmcnt(0)" ::: "memory");
        } else {
            XB_SPIN(xb_ld(&bar[XB_XGEN(b.x)]) == gen, bar);
            __builtin_amdgcn_fence(__ATOMIC_ACQUIRE, "agent");
            asm volatile("s_waitcnt vmcnt(0)" ::: "memory");
        }
    }
    __syncthreads();
}

namespace pg8 {
struct UnitG { int seg, mt, nt; };
template <class Prob, class Epi, bool FP8 = false>
__device__ __forceinline__ void gemm_phase_g(PG8_LAS unsigned char* lds, const Prob& P, const Epi& E) {
    const int tid = threadIdx.x, wid = __builtin_amdgcn_readfirstlane(tid >> 6), lane = tid & 63, wr = wid >> 2, wc = wid & 3, fr = lane & 15, fq = lane >> 4;
    constexpr int EB = FP8 ? 1 : 2;
    const int K = P.K, nt = K * EB / 128;
    unsigned voffB[2], cbA[2];
#pragma unroll
    for (int i = 0; i < 2; ++i) { int R, C; stage_rc(tid * 16 + i * 8192, R, C); const int Rb = Epi::PERM ? ((R & ~31) + perm32(R & 31)) : R; voffB[i] = (unsigned)(Rb * K * EB + C * 2); cbA[i] = (unsigned)(C * 2); }
    const unsigned pitchA = (unsigned)P.pitchA;
    const size_t kstep = (size_t)(BK * 2);
    const size_t hstep = (size_t)HALF * K * EB;
    const unsigned ldsw = (unsigned)wid * 1024u;
    const int aoff = lds_byte(wr * 64 + fr, fq * 8), boff = lds_byte(wc * 32 + fr, fq * 8);
#define PG8_SA(b, h) (((b) * 2 + (h)) * HTB)
#define PG8_SB(b, h) ((4 + (b) * 2 + (h)) * HTB)
#define PG8_STAGE(bufoff, gbase, voff) do { _Pragma("unroll") for (int _i = 0; _i < 2; ++_i) \
        __builtin_amdgcn_global_load_lds((const unsigned*)((const char*)(gbase) + (voff)[_i]), (PG8_LAS unsigned*)(lds + (bufoff) + ldsw + _i * 8192), 16, 0, 0); } while (0)
#define PG8_STAGE_A(bufoff, gbase, rp_) do { const unsigned o0_ = ((rp_) & 0xffffu) * pitchA + cbA[0], o1_ = ((rp_) >> 16) * pitchA + cbA[1]; \
        __builtin_amdgcn_global_load_lds((const unsigned*)((const char*)(gbase) + o0_), (PG8_LAS unsigned*)(lds + (bufoff) + ldsw), 16, 0, 0); \
        __builtin_amdgcn_global_load_lds((const unsigned*)((const char*)(gbase) + o1_), (PG8_LAS unsigned*)(lds + (bufoff) + ldsw + 8192), 16, 0, 0); } while (0)
#define PG8_LDA(dst, b, h) do { _Pragma("unroll") for (int m = 0; m < 4; ++m) { const v4i_ lo_ = *(const PG8_LAS v4i_*)(lds + PG8_SA(b, h) + aoff + m * 2048), hi_ = *(const PG8_LAS v4i_*)(lds + PG8_SA(b, h) + aoff + m * 2048 + 1024); dst[m] = __builtin_shufflevector(lo_, hi_, 0, 1, 2, 3, 4, 5, 6, 7); } } while (0)
#define PG8_LDB(dst, b, h) do { _Pragma("unroll") for (int n = 0; n < 2; ++n) { const v4i_ lo_ = *(const PG8_LAS v4i_*)(lds + PG8_SB(b, h) + boff + n * 2048), hi_ = *(const PG8_LAS v4i_*)(lds + PG8_SB(b, h) + boff + n * 2048 + 1024); dst[n] = __builtin_shufflevector(lo_, hi_, 0, 1, 2, 3, 4, 5, 6, 7); } } while (0)
#define PG8_HALF(v_, k_) __builtin_bit_cast(bf16x8, (v4i_)__builtin_shufflevector(v_, v_, 4 * (k_), 4 * (k_) + 1, 4 * (k_) + 2, 4 * (k_) + 3))
#define PG8_MMA(ai, bj, At, Bt) do { __builtin_amdgcn_s_setprio(1); _Pragma("unroll") for (int m = 0; m < 4; ++m) _Pragma("unroll") for (int n = 0; n < 2; ++n) { \
        acc[ai][bj][m][n] = __builtin_amdgcn_mfma_f32_16x16x32_bf16(PG8_HALF(Bt[n], 0), PG8_HALF(At[m], 0), acc[ai][bj][m][n], 0, 0, 0); \
        acc[ai][bj][m][n] = __builtin_amdgcn_mfma_f32_16x16x32_bf16(PG8_HALF(Bt[n], 1), PG8_HALF(At[m], 1), acc[ai][bj][m][n], 0, 0, 0); } __builtin_amdgcn_s_setprio(0); } while (0)
#define PG8_Q(v_, q_) __builtin_bit_cast(long, (v2i_){v_[2 * (q_)], v_[2 * (q_) + 1]})
#define PG8_MMA8Q(ai, bj, At, Bt, q_) _Pragma("unroll") for (int m = 0; m < 4; ++m) _Pragma("unroll") for (int n = 0; n < 2; ++n) \
            acc[ai][bj][m][n] = __builtin_amdgcn_mfma_f32_16x16x32_fp8_fp8(PG8_Q(Bt[n], q_), PG8_Q(At[m], q_), acc[ai][bj][m][n], 0, 0, 0)
#define PG8_MMA8(ai, bj, At, Bt) do { typedef int v2i_ __attribute__((ext_vector_type(2))); __builtin_amdgcn_s_setprio(1); \
        PG8_MMA8Q(ai, bj, At, Bt, 0); PG8_MMA8Q(ai, bj, At, Bt, 1); PG8_MMA8Q(ai, bj, At, Bt, 2); PG8_MMA8Q(ai, bj, At, Bt, 3); \
        __builtin_amdgcn_s_setprio(0); } while (0)
#define PG8_MM(ai, bj, At, Bt) do { if constexpr (FP8) PG8_MMA8(ai, bj, At, Bt); else PG8_MMA(ai, bj, At, Bt); } while (0)
#define PG8_WAIT_V(n) asm volatile("s_waitcnt vmcnt(" #n ")" ::: "memory")
#define PG8_WAIT_L(n) asm volatile("s_waitcnt lgkmcnt(" #n ")" ::: "memory")
#define PG8_BAR __builtin_amdgcn_s_barrier()
#define PG8_SCHED __builtin_amdgcn_sched_barrier(0)
    UnitG cur, nxt; int ui = 0;
    if (!P.next(0, cur)) return;
    f32x4 acc[2][2][4][2];
#pragma unroll
    for (int a = 0; a < 2; ++a)
#pragma unroll
        for (int b = 0; b < 2; ++b)
#pragma unroll
            for (int m = 0; m < 4; ++m)
#pragma unroll
                for (int n = 0; n < 2; ++n) acc[a][b][m][n] = (f32x4){0.f, 0.f, 0.f, 0.f};
    typedef int v4i_ __attribute__((ext_vector_type(4))); typedef int v8i_ __attribute__((ext_vector_type(8)));
    v8i_ At[4], B0[2], B1[2];
    unsigned rowp[2], rowpn[2];
    const char* cA; const char* cB;
    P.setup_base(cur, cA, cB);
    P.meta(cur, lds, 0, wid, lane);
    P.rows_first(cur, lds, 0, rowp);
    PG8_STAGE(PG8_SB(0, 0), cB, voffB); PG8_STAGE(PG8_SB(0, 1), cB + hstep, voffB); PG8_STAGE_A(PG8_SA(0, 0), cA, rowp[0]); PG8_STAGE_A(PG8_SA(0, 1), cA, rowp[1]);
    if (wr == 1) PG8_BAR;
    PG8_WAIT_V(2); PG8_BAR;
    PG8_STAGE(PG8_SB(1, 0), cB + kstep, voffB); PG8_STAGE_A(PG8_SA(1, 0), cA + kstep, rowp[0]); PG8_STAGE(PG8_SB(1, 1), cB + hstep + kstep, voffB);
    PG8_WAIT_V(6); PG8_BAR;
    for (;;) {
        const bool has_next = P.next(ui + 1, nxt);
        const char* nA = cA; const char* nB = cB;
        rowpn[0] = rowp[0]; rowpn[1] = rowp[1];
        if (has_next) { P.setup_base(nxt, nA, nB); P.meta(nxt, lds, (ui + 1) % 3, wid, lane); }
        for (int t = 0; t < nt; t += 2) {
            const bool last = (t == nt - 2);
            const char* a1 = cA + (size_t)(t + 1) * kstep;
            const char* a2 = last ? nA : cA + (size_t)(t + 2) * kstep; const char* b2 = last ? nB : cB + (size_t)(t + 2) * kstep;
            const char* a3 = a2 + kstep; const char* b3 = b2 + kstep;
            if (last && has_next) P.rows(nxt, lds, (ui + 1) % 3, rowpn);
            const unsigned o2_0 = last ? rowpn[0] : rowp[0], o2_1 = last ? rowpn[1] : rowp[1];
            PG8_LDB(B0, 0, 0); PG8_LDB(B1, 0, 1); PG8_SCHED; PG8_LDA(At, 0, 0); PG8_STAGE_A(PG8_SA(1, 1), a1, rowp[1]);
            PG8_WAIT_V(8); PG8_WAIT_L(0); PG8_BAR; PG8_MM(0, 0, At, B0); PG8_MM(0, 1, At, B1); PG8_BAR; PG8_SCHED;
            PG8_LDA(At, 0, 1); PG8_STAGE(PG8_SB(0, 0), b2, voffB); PG8_STAGE(PG8_SB(0, 1), b2 + hstep, voffB); PG8_STAGE_A(PG8_SA(0, 0), a2, o2_0);
            PG8_WAIT_V(8); PG8_WAIT_L(0); PG8_BAR; PG8_MM(1, 0, At, B0); PG8_MM(1, 1, At, B1); PG8_BAR; PG8_SCHED;
            PG8_LDB(B0, 1, 0); PG8_LDB(B1, 1, 1); PG8_SCHED; PG8_LDA(At, 1, 0); PG8_STAGE_A(PG8_SA(0, 1), a2, o2_1);
            PG8_WAIT_V(8); PG8_WAIT_L(0); PG8_BAR; PG8_MM(0, 0, At, B0); PG8_MM(0, 1, At, B1); PG8_BAR; PG8_SCHED;
            PG8_LDA(At, 1, 1); PG8_STAGE(PG8_SB(1, 0), b3, voffB); PG8_STAGE(PG8_SB(1, 1), b3 + hstep, voffB); PG8_STAGE_A(PG8_SA(1, 0), a3, o2_0);
            PG8_WAIT_V(8); PG8_WAIT_L(0); PG8_BAR; PG8_MM(1, 0, At, B0); PG8_MM(1, 1, At, B1); PG8_BAR; PG8_SCHED;
        }
        if (wr == 0) PG8_BAR;
        E(acc, cur, wr, wc, fr, fq, lds, ui % 3);
        if (!has_next) break;
#pragma unroll
        for (int a = 0; a < 2; ++a)
#pragma unroll
            for (int b = 0; b < 2; ++b)
#pragma unroll
                for (int m = 0; m < 4; ++m)
#pragma unroll
                    for (int n = 0; n < 2; ++n) acc[a][b][m][n] = (f32x4){0.f, 0.f, 0.f, 0.f};
        cur = nxt; cA = nA; cB = nB; ++ui;
        rowp[0] = rowpn[0]; rowp[1] = rowpn[1];
        if (wr == 1) PG8_BAR;
    }
    PG8_WAIT_V(0);
    PG8_BAR;
#undef PG8_SA
#undef PG8_SB
#undef PG8_STAGE
#undef PG8_STAGE_A
#undef PG8_LDA
#undef PG8_LDB
#undef PG8_MMA
#undef PG8_MMA8
#undef PG8_Q
#undef PG8_MMA8Q
#undef PG8_HALF
#undef PG8_MM
#undef PG8_WAIT_V
#undef PG8_WAIT_L
#undef PG8_BAR
#undef PG8_SCHED
}
}

constexpr int NWAVES = 8;
constexpr int BATCH = 2, T = 8192, D = 1024, M = BATCH * T, DIN = 4104, PA = 3072;
constexpr int NE = 64, NEX = 65, DE = 256;
constexpr size_t MiB = 1u << 20;
constexpr size_t WS_CTL = 0, CTL_ZERO_BYTES = 256 * 1024;
constexpr size_t WS_WRHI = 512 * 1024, WS_WRLO = 640 * 1024;
constexpr size_t WS_MOD = 1 * MiB, WS_WAB = 1 * MiB + 256 * 1024, WS_AB = 1 * MiB + 512 * 1024;
constexpr size_t WS_WOUT_T = 2 * MiB, WS_WIN_T = 4 * MiB, WS_H1 = 12 * MiB, WS_PROJA = 44 * MiB, WS_GATES = 142 * MiB;
constexpr size_t WS_QP = 4 * MiB, WS_OI = 20 * MiB, WS_AH = 36 * MiB, WS_GL = 36 * MiB + 512 * 1024, WS_PG = 174 * MiB, WS_BG = 206 * MiB, WS_BH = 238 * MiB, WS_QE = 270 * MiB, WS_OIH = 286 * MiB;
constexpr size_t WS_OMIX = 174 * MiB;
constexpr size_t WS_H2 = 12 * MiB, WS_W1T = 44 * MiB, WS_W2T = 109 * MiB, WS_ACT = 142 * MiB, WS_LIST = 215 * MiB, WS_LISTW = 217 * MiB, WS_Y0 = 12 * MiB, WS_Y1 = 219 * MiB;
constexpr size_t WS_YS = 80 * MiB;
constexpr size_t WS_TOP = 302 * MiB;
constexpr int CAP = 8192;
constexpr int TB_PRE = 0, TB_CNT = 132, TB_OFF = 264;
constexpr int CW_CNT = 16384;
constexpr int CW_BAR = 4096;
constexpr int RING_BYTES = 131072, LDS_BYTES = 163840, LDSCTL_OFF = LDS_BYTES - 1024, MISC_OFF = LDSCTL_OFF + 320, SCR2_OFF = LDS_BYTES - 3072;

__device__ __forceinline__ float bf2f(bf16 v) { return __uint_as_float(((unsigned)v) << 16); }
__device__ __forceinline__ float sigmoidf_(float x) { return 1.f / (1.f + __expf(-x)); }
__device__ __forceinline__ float siluf_(float x) { return x / (1.f + __expf(-x)); }
__device__ __forceinline__ float softplusf_(float x) { return x > 20.f ? x : log1pf(expf(x)); }
__device__ __forceinline__ float c8(float x) { return __builtin_amdgcn_fmed3f(x, -448.f, 448.f); }
__device__ __forceinline__ float wave_sum(float v) {
#pragma unroll
    for (int o = 1; o < 64; o <<= 1) v += __shfl_xor(v, o);
    return v;
}

namespace pg8 {
struct EpiProj {
    static constexpr bool PERM = true, AFTER_DRAIN = false;
    bf16_t* projA; bf16_t* gates;
    __device__ __forceinline__ void operator()(const f32x4 (&acc)[2][2][4][2], const Unit& u, int wr, int wc, int fr, int fq) const {
        const int row0 = u.pm * BM + wr * 64 + fr;
        bf16_t* base; int ldc, colt;
        if (u.pn < 12) { base = projA; ldc = 3072; colt = u.pn * BM; } else { base = gates; ldc = 1024; colt = (u.pn - 12) * BM; }
        const int col0 = colt + wc * 32 + 8 * fq;
#pragma unroll
        for (int ai = 0; ai < 2; ++ai)
#pragma unroll
            for (int m = 0; m < 4; ++m) { bf16_t* rowp = base + (size_t)(row0 + ai * HALF + m * 16) * ldc + col0;
#pragma unroll
                for (int bj = 0; bj < 2; ++bj) { const f32x4 v0 = acc[ai][bj][m][0], v1 = acc[ai][bj][m][1];
                    u32x4 w; w.x = cvt_pk_bf16(v0[0], v0[1]); w.y = cvt_pk_bf16(v0[2], v0[3]); w.z = cvt_pk_bf16(v1[0], v1[1]); w.w = cvt_pk_bf16(v1[2], v1[3]);
                    *(u32x4*)(rowp + bj * HALF) = w; } }
    }
};
struct EpiResid {
    static constexpr bool PERM = false, AFTER_DRAIN = false;
    const float* x; const float* mod; float* out;
    __device__ __forceinline__ void operator()(const f32x4 (&acc)[2][2][4][2], const Unit& u, int wr, int wc, int fr, int fq) const {
        const int col0 = u.pn * BM + wc * 32 + 4 * fq;
        const float* g1 = mod + (u.pm * BM >= 8192 ? 6144 : 0) + 2048;
        f32x4 gv[2][2];
#pragma unroll
        for (int bj = 0; bj < 2; ++bj)
#pragma unroll
            for (int n = 0; n < 2; ++n) gv[bj][n] = *(const f32x4*)(g1 + col0 + bj * HALF + n * 16);
#pragma unroll
        for (int ai = 0; ai < 2; ++ai)
#pragma unroll
            for (int mp = 0; mp < 4; mp += 2) { f32x4 xv[2][2][2];
#pragma unroll
                for (int q = 0; q < 2; ++q) { const size_t off = (size_t)(u.pm * BM + ai * HALF + wr * 64 + (mp + q) * 16 + fr) * 1024 + col0;
#pragma unroll
                    for (int bj = 0; bj < 2; ++bj)
#pragma unroll
                        for (int n = 0; n < 2; ++n) xv[q][bj][n] = *(const f32x4*)(x + off + bj * HALF + n * 16); }
#pragma unroll
                for (int q = 0; q < 2; ++q) { const size_t off = (size_t)(u.pm * BM + ai * HALF + wr * 64 + (mp + q) * 16 + fr) * 1024 + col0;
#pragma unroll
                    for (int bj = 0; bj < 2; ++bj)
#pragma unroll
                        for (int n = 0; n < 2; ++n) *(f32x4*)(out + off + bj * HALF + n * 16) = xv[q][bj][n] + gv[bj][n] * acc[ai][bj][mp + q][n]; }
            }
    }
};

struct MoeSched {
    const LAS unsigned* tb; int lo, hi, NT, G, c; int perm;
    __device__ __forceinline__ int segof(int p) const { return perm ? (p & 1) * 65 + (p >> 1) : p; }
    __device__ __forceinline__ bool next(int i, UnitG& u) const {
        const unsigned L = (unsigned)(i * G + c); if (L >= tb[TB_PRE + hi]) return false;
        int s = lo; while (L >= tb[TB_PRE + s + 1]) ++s;
        const int sg = segof(s);
        const unsigned loc = L - tb[TB_PRE + s], tiles = (tb[TB_CNT + sg] + 255u) >> 8;
        u.seg = __builtin_amdgcn_readfirstlane(sg); u.mt = __builtin_amdgcn_readfirstlane((int)(loc % tiles)); u.nt = __builtin_amdgcn_readfirstlane((int)(loc / tiles)); return true;
    }
};
struct Moe1Prob {
    int K; int pitchA; MoeSched S; const unsigned char* h2; const unsigned char* w1t; const int* list;
    __device__ __forceinline__ bool next(int i, UnitG& u) const { return S.next(i, u); }
    __device__ __forceinline__ void setup_base(const UnitG& u, const char*& cA, const char*& cB) const { cA = (const char*)h2; cB = (const char*)(w1t + ((size_t)u.seg * 512 + (size_t)u.nt * 256) * 1024); }
    __device__ __forceinline__ void meta(const UnitG& u, PG8_LAS unsigned char* lds, int slot, int wid, int lane) const {
        if (wid == 0 && u.seg < 64) __builtin_amdgcn_global_load_lds((const unsigned*)(list + (size_t)u.seg * CAP + 256u * (unsigned)u.mt + 4u * (unsigned)lane), (PG8_LAS unsigned*)(lds + STAGE_BYTES + slot * 2048), 16, 0, 0);
    }
    __device__ __forceinline__ void rows(const UnitG& u, PG8_LAS unsigned char* lds, int slot, unsigned (&rowp)[2]) const {
        int sR[2], sC[2];
#pragma unroll
        for (int i = 0; i < 2; ++i) stage_rc((int)threadIdx.x * 16 + i * 8192, sR[i], sC[i]);
        const int e = u.seg; const int cnt = (int)S.tb[TB_CNT + u.seg]; const PG8_LAS int* tbl = (const PG8_LAS int*)(lds + STAGE_BYTES + slot * 2048);
#pragma unroll
        for (int h = 0; h < 2; ++h) { unsigned tk[2];
#pragma unroll
            for (int i = 0; i < 2; ++i) { const int rl = 128 * h + sR[i], r = 256 * u.mt + rl;
                if (e < 64) { const int last_ = cnt - 1 - 256 * u.mt; tk[i] = (unsigned)tbl[rl < last_ ? rl : last_] >> 3; } else tk[i] = (unsigned)(r < M ? r : M - 1); }
            rowp[h] = tk[0] | (tk[1] << 16); }
    }
    __device__ __forceinline__ void rows_first(const UnitG& u, PG8_LAS unsigned char* lds, int slot, unsigned (&rowp)[2]) const {
        asm volatile("s_waitcnt vmcnt(0)" ::: "memory"); __builtin_amdgcn_s_barrier(); asm volatile("" ::: "memory");
        rows(u, lds, slot, rowp);
    }
};
struct Moe2Prob {
    int K; int pitchA; MoeSched S; const unsigned char* act; const unsigned char* w2t; const int* list; const float* listw;
    __device__ __forceinline__ bool next(int i, UnitG& u) const { return S.next(i, u); }
    __device__ __forceinline__ void meta(const UnitG& u, PG8_LAS unsigned char* lds, int par, int wid, int lane) const {
        if (wid == 0 && u.seg < 64) { const size_t o = (size_t)u.seg * CAP + 256u * (unsigned)u.mt + 4u * (unsigned)lane;
            __builtin_amdgcn_global_load_lds((const unsigned*)(list + o), (PG8_LAS unsigned*)(lds + STAGE_BYTES + par * 2048), 16, 0, 0);
            __builtin_amdgcn_global_load_lds((const unsigned*)(listw + o), (PG8_LAS unsigned*)(lds + STAGE_BYTES + par * 2048 + 1024), 16, 0, 0); }
    }
    __device__ __forceinline__ void setup_base(const UnitG& u, const char*& cA, const char*& cB) const {
        const size_t rowbase = (size_t)S.tb[TB_OFF + u.seg] + 256u * (unsigned)u.mt;
        cA = (const char*)(act + rowbase * 256); cB = (const char*)(w2t + ((size_t)u.seg * 1024 + (size_t)u.nt * 256) * 256);
    }
    __device__ __forceinline__ void rows(const UnitG&, PG8_LAS unsigned char*, int, unsigned (&rowp)[2]) const {
        int sR[2], sC[2];
#pragma unroll
        for (int i = 0; i < 2; ++i) stage_rc((int)threadIdx.x * 16 + i * 8192, sR[i], sC[i]);
#pragma unroll
        for (int h = 0; h < 2; ++h) rowp[h] = (unsigned)(128 * h + sR[0]) | ((unsigned)(128 * h + sR[1]) << 16);
    }
    __device__ __forceinline__ void rows_first(const UnitG& u, PG8_LAS unsigned char* lds, int slot, unsigned (&rowp)[2]) const { rows(u, lds, slot, rowp); }
};
struct EpiMoe1 {
    static constexpr bool PERM = true;
    unsigned char* act; const LAS unsigned* tb;
    __device__ __forceinline__ void operator()(const f32x4 (&acc)[2][2][4][2], const UnitG& u, int wr, int wc, int fr_, int fq_, PG8_LAS unsigned char*, int) const {
        int t_ = (int)threadIdx.x; asm volatile("" : "+v"(t_));
        const int fr = t_ & 15, fq = (t_ >> 4) & 3;
        const int cnt = (int)tb[TB_CNT + u.seg]; const size_t rowbase = tb[TB_OFF + u.seg];
#pragma unroll
        for (int ai = 0; ai < 2; ++ai)
#pragma unroll
            for (int m = 0; m < 4; ++m) { const int r = 256 * u.mt + ai * HALF + wr * 64 + m * 16 + fr;
                if (r < cnt) { unsigned char* p = act + (rowbase + (size_t)r) * 256 + u.nt * 128 + wc * 32 + 8 * fq;
                    const f32x4 g0 = acc[ai][0][m][0], g1 = acc[ai][0][m][1], u0 = acc[ai][1][m][0], u1 = acc[ai][1][m][1]; f32x4 v0, v1;
#pragma unroll
                    for (int i = 0; i < 4; ++i) { const float ga = g0[i] * 0.03125f, gb = g1[i] * 0.03125f; v0[i] = ga / (1.f + __expf(-ga)) * (u0[i] * 0.25f); v1[i] = gb / (1.f + __expf(-gb)) * (u1[i] * 0.25f); }
                    unsigned o0 = __builtin_amdgcn_cvt_pk_fp8_f32(c8(v0[0]), c8(v0[1]), 0, false); o0 = __builtin_amdgcn_cvt_pk_fp8_f32(c8(v0[2]), c8(v0[3]), o0, true);
                    unsigned o1 = __builtin_amdgcn_cvt_pk_fp8_f32(c8(v1[0]), c8(v1[1]), 0, false); o1 = __builtin_amdgcn_cvt_pk_fp8_f32(c8(v1[2]), c8(v1[3]), o1, true);
                    typedef unsigned u32x2_ __attribute__((ext_vector_type(2)));
                    *(u32x2_*)p = (u32x2_){o0, o1}; } }
    }
};
struct EpiMoe2 {
    static constexpr bool PERM = true;
    unsigned char* y0; unsigned char* y1; unsigned char* ys; const LAS unsigned* tb;
    __device__ __forceinline__ void operator()(const f32x4 (&acc)[2][2][4][2], const UnitG& u, int wr, int wc, int fr_, int fq_, PG8_LAS unsigned char* lds, int par) const {
        int t_ = (int)threadIdx.x; asm volatile("" : "+v"(t_));
        const int fr = t_ & 15, fq = (t_ >> 4) & 3;
        const int cnt = (int)tb[TB_CNT + u.seg]; const int e = u.seg; const int colt = u.nt * 256 + wc * 32 + 8 * fq;
        const PG8_LAS int* mslot = (const PG8_LAS int*)(lds + STAGE_BYTES + par * 2048); const PG8_LAS float* mw = (const PG8_LAS float*)(lds + STAGE_BYTES + par * 2048 + 1024);
#pragma unroll
        for (int ai = 0; ai < 2; ++ai)
#pragma unroll
            for (int m = 0; m < 4; ++m) { const int rl = ai * HALF + wr * 64 + m * 16 + fr, r = 256 * u.mt + rl;
                if (r < cnt) { int sl; float w;
                    if (e < 64) { sl = mslot[rl]; w = mw[rl] * 0.25f; } else { sl = r; w = 0.25f; }
                    unsigned char* p = (e < 64 ? (sl >= 65536 ? y1 + (size_t)(sl - 65536) * 1024 : y0 + (size_t)sl * 1024) : ys + (size_t)sl * 1024) + colt;
#pragma unroll
                    for (int bj = 0; bj < 2; ++bj) { const f32x4 v0 = acc[ai][bj][m][0] * w, v1 = acc[ai][bj][m][1] * w;
                        unsigned o0 = __builtin_amdgcn_cvt_pk_fp8_f32(v0[0], v0[1], 0, false); o0 = __builtin_amdgcn_cvt_pk_fp8_f32(v0[2], v0[3], o0, true);
                        unsigned o1 = __builtin_amdgcn_cvt_pk_fp8_f32(v1[0], v1[1], 0, false); o1 = __builtin_amdgcn_cvt_pk_fp8_f32(v1[2], v1[3], o1, true);
                        typedef unsigned u32x2_ __attribute__((ext_vector_type(2)));
                        *(u32x2_*)(p + bj * HALF) = (u32x2_){o0, o1}; } } }
    }
};
}

struct TrItem { const float* W; int ldw, src_col; bf16* WT; int K, dst_row, k0; float f8scale; };
__device__ __forceinline__ void tr_load(const TrItem& t, int lane, f32x4 (&v)[8]) {
#pragma unroll
    for (int i = 0; i < 8; ++i) v[i] = *(const GAS f32x4*)(t.W + (size_t)(t.k0 + 8 * i + (lane >> 3)) * t.ldw + t.src_col + 4 * (lane & 7));
}
__device__ __forceinline__ void tr_finish(const TrItem& t, int lane, const f32x4 (&v)[8], LAS float* scr) {
#pragma unroll
    for (int i = 0; i < 8; ++i) { LAS float* p = scr + (8 * i + (lane >> 3)) * 33 + 4 * (lane & 7); p[0] = v[i][0]; p[1] = v[i][1]; p[2] = v[i][2]; p[3] = v[i][3]; }
    LDS_WAIT(); asm volatile("" ::: "memory");
    const int c = lane & 7;
#pragma unroll
    for (int j = 0; j < 4; ++j) { const int n = (lane >> 3) + 8 * j; const LAS float* s = scr + (8 * c) * 33 + n;
        if (t.f8scale != 0.f) { const float q = t.f8scale; typedef unsigned u32x2_ __attribute__((ext_vector_type(2)));
            unsigned o0 = __builtin_amdgcn_cvt_pk_fp8_f32(s[0 * 33] * q, s[1 * 33] * q, 0, false); o0 = __builtin_amdgcn_cvt_pk_fp8_f32(s[2 * 33] * q, s[3 * 33] * q, o0, true);
            unsigned o1 = __builtin_amdgcn_cvt_pk_fp8_f32(s[4 * 33] * q, s[5 * 33] * q, 0, false); o1 = __builtin_amdgcn_cvt_pk_fp8_f32(s[6 * 33] * q, s[7 * 33] * q, o1, true);
            *(GAS u32x2_*)((GAS unsigned char*)t.WT + (size_t)(t.dst_row + n) * t.K + t.k0 + 8 * c) = (u32x2_){o0, o1};
        } else {
        v4u o; o.x = pk2(s[0 * 33], s[1 * 33]); o.y = pk2(s[2 * 33], s[3 * 33]); o.z = pk2(s[4 * 33], s[5 * 33]); o.w = pk2(s[6 * 33], s[7 * 33]);
        *(GAS v4u*)(t.WT + (size_t)(t.dst_row + n) * t.K + t.k0 + 8 * c) = o; } }
    LDS_WAIT(); asm volatile("" ::: "memory");
}
#define TR_LOOP(it0, stride, nitems, MAKE) do { int it_ = (it0); if (it_ < (nitems)) { TrItem cur_ = MAKE(it_); f32x4 va_[8], vb_[8]; tr_load(cur_, lane, va_); \
    for (;;) { const int nx_ = it_ + (stride); const bool hn_ = nx_ < (nitems); TrItem nxt_ = cur_; if (hn_) { nxt_ = MAKE(nx_); tr_load(nxt_, lane, vb_); } \
        tr_finish(cur_, lane, va_, scr); if (!hn_) break; _Pragma("unroll") for (int q_ = 0; q_ < 8; ++q_) va_[q_] = vb_[q_]; cur_ = nxt_; it_ = nx_; } } } while (0)

#ifndef REP_PHASE
#define REP_PHASE -1
#endif
#ifndef REP_N
#define REP_N 1
#endif
#define REPN(k) ((k) == REP_PHASE ? REP_N : 1)

constexpr int UNITS = BATCH * 128 * 4;
constexpr int L_QN = 0, L_KN = 17408, L_VV = 34816, L_LM = 52224, L_ATT = 68608, L_UT = 77824, L_WT = 96256, L_KTT = 114688, L_GCS = 133120, L_EGS = 133376, L_BET = 133632, L_SCW = 133888, L_SKT = 134144, L_TM = L_KN, L_TB = L_VV;
constexpr int H_FR = 0, H_QR = 17408, H_QE = 34816, H_KD = 52224, H_KTT = 69632, H_VT = 88064, H_AM = 106496;
constexpr int RS = 272, TS = 144;

typedef unsigned v2u __attribute__((ext_vector_type(2)));
#define LBAR() do { asm volatile("s_waitcnt lgkmcnt(0)" ::: "memory"); __builtin_amdgcn_s_barrier(); asm volatile("" ::: "memory"); } while (0)
__device__ __forceinline__ f32x4 mfma16(bf16x8 a, bf16x8 b, f32x4 c) { return __builtin_amdgcn_mfma_f32_16x16x32_bf16(a, b, c, 0, 0, 0); }
__device__ __forceinline__ bf16x8 ldsfrag(const LAS unsigned char* base, int row, int stride, int kbyte) { return *(const LAS bf16x8*)(base + row * stride + kbyte); }
__device__ __forceinline__ void unpack8(const v4u q, float (&f)[8]) {
    f[0] = __uint_as_float(q.x << 16); f[1] = __uint_as_float(q.x & 0xffff0000u); f[2] = __uint_as_float(q.y << 16); f[3] = __uint_as_float(q.y & 0xffff0000u);
    f[4] = __uint_as_float(q.z << 16); f[5] = __uint_as_float(q.z & 0xffff0000u); f[6] = __uint_as_float(q.w << 16); f[7] = __uint_as_float(q.w & 0xffff0000u); }
__device__ __forceinline__ f32x4 unpack4(const v2u q) { return (f32x4){__uint_as_float(q.x << 16), __uint_as_float(q.x & 0xffff0000u), __uint_as_float(q.y << 16), __uint_as_float(q.y & 0xffff0000u)}; }
__device__ __forceinline__ v2u pack4(const f32x4 v) { v2u o; o.x = pk2(v[0], v[1]); o.y = pk2(v[2], v[3]); return o; }
__device__ __forceinline__ float ldsbf(const LAS unsigned char* base, int row, int stride, int col) { return __uint_as_float(((unsigned)*(const LAS unsigned short*)(base + row * stride + col * 2)) << 16); }

struct MixPtrs {
    const bf16* projA; const bf16* gates; const float* ab; const float* conv_w; const float* a_log; const float* dt_bias; const float* hg_lb; const float* gdn_nw; const float* hg_nw;
    bf16 *PG, *BG, *QP, *OI, *BH, *QE, *OIH, *SG, *SH, *omix; float *GL, *AH;
};

__device__ __forceinline__ void p3_gdn_unit(LAS unsigned char* lds, const MixPtrs& X, int unit, int tid, int lane, int wave) {
    const int h = unit & 3, n = (unit >> 2) & 127, b = unit >> 9, r = lane & 15, g = lane >> 4;
    const size_t tok0 = (size_t)b * T + (size_t)n * 64;
    LAS float* gcs = (LAS float*)(lds + L_GCS); LAS float* egs = (LAS float*)(lds + L_EGS); LAS float* bet = (LAS float*)(lds + L_BET);
    {
#pragma unroll 1
      for (int ib = 0; ib < 6; ib += 3) {
        v4u raw[3][4];
#pragma unroll
        for (int i2 = 0; i2 < 3; ++i2) { const int i = ib + i2; const int pair = (tid >> 4) + 32 * i, tz = pair >> 6, c = pair & 63, ch = tid & 15, col = tz * 512 + h * 128 + ch * 8;
#pragma unroll
            for (int j = 0; j < 4; ++j) { const int tl = n * 64 + c - 3 + j; raw[i2][j] = *(const GAS v4u*)(X.projA + ((size_t)b * T + (tl < 0 ? 0 : tl)) * PA + col); } }
#pragma unroll
        for (int i2 = 0; i2 < 3; ++i2) { const int i = ib + i2;
            const int pair = (tid >> 4) + 32 * i, tz = pair >> 6, c = pair & 63, ch = tid & 15, col = tz * 512 + h * 128 + ch * 8;
            float y[8];
#pragma unroll
            for (int e = 0; e < 8; ++e) y[e] = 0.f;
#pragma unroll
            for (int j = 0; j < 4; ++j) { const int tl = n * 64 + c - 3 + j; const float msk = tl >= 0 ? 1.f : 0.f; float xf[8]; unpack8(raw[i2][j], xf);
                const f32x4 w0 = *(const GAS f32x4*)(X.conv_w + j * 1536 + col) * msk, w1 = *(const GAS f32x4*)(X.conv_w + j * 1536 + col + 4) * msk;
#pragma unroll
                for (int e = 0; e < 4; ++e) { y[e] += w0[e] * xf[e]; y[4 + e] += w1[e] * xf[4 + e]; } }
            float ss = 0.f;
#pragma unroll
            for (int e = 0; e < 8; ++e) { y[e] = siluf_(y[e]); ss += y[e] * y[e]; }
            ss += __shfl_xor(ss, 1); ss += __shfl_xor(ss, 2); ss += __shfl_xor(ss, 4); ss += __shfl_xor(ss, 8);
            const float rn = tz == 2 ? 1.f : rsqrtf(ss + 1e-6f) * (tz == 0 ? 0.08838834764831845f : 1.f);
            v4u o; o.x = pk2(y[0] * rn, y[1] * rn); o.y = pk2(y[2] * rn, y[3] * rn); o.z = pk2(y[4] * rn, y[5] * rn); o.w = pk2(y[6] * rn, y[7] * rn);
            *(LAS v4u*)(lds + (tz == 0 ? L_QN : (tz == 1 ? L_KN : L_VV)) + c * RS + ch * 16) = o;
        }
      }
    }
    if (wave == 0) {
        const float araw = X.ab[(tok0 + lane) * 8 + 4 + h], braw = X.ab[(tok0 + lane) * 8 + h];
        float gv = -expf(X.a_log[h]) * softplusf_(araw + X.dt_bias[h]);
#pragma unroll
        for (int o = 1; o < 64; o <<= 1) { const float t = __shfl_up(gv, o); if (lane >= o) gv += t; }
        { const float eg_ = __expf(gv), be_ = sigmoidf_(braw); gcs[lane] = gv; egs[lane] = eg_; bet[lane] = be_; *(LAS float*)(lds + L_SCW + lane * 4) = be_ * eg_; *(LAS float*)(lds + L_SKT + lane * 4) = __expf(__shfl(gv, 63) - gv); }
        if (lane == 63) X.GL[unit] = gv;
    }
    LBAR();
    {
        const int mt = wave >> 1;
#pragma unroll
        for (int q = 0; q < 2; ++q) { const int ntc = 2 * (wave & 1) + q; f32x4 akk = {0.f, 0.f, 0.f, 0.f}, aqk = {0.f, 0.f, 0.f, 0.f};
#pragma unroll
            for (int ks = 0; ks < 4; ++ks) { const bf16x8 ka = ldsfrag(lds + L_KN, 16 * mt + r, RS, 64 * ks + 16 * g), qa = ldsfrag(lds + L_QN, 16 * mt + r, RS, 64 * ks + 16 * g), kb = ldsfrag(lds + L_KN, 16 * ntc + r, RS, 64 * ks + 16 * g);
                akk = mfma16(ka, kb, akk); aqk = mfma16(qa, kb, aqk); }
            const int j = 16 * ntc + r; const float gj = gcs[j];
#pragma unroll
            for (int ii = 0; ii < 4; ++ii) { const int i = 16 * mt + 4 * g + ii; const float dec = (i >= j) ? __expf(gcs[i] - gj) : 0.f;
                *(LAS float*)(lds + L_LM + (i * 64 + j) * 4) = (i > j) ? bet[i] * akk[ii] * dec : 0.f;
                *(LAS unsigned short*)(lds + L_ATT + i * TS + j * 2) = (unsigned short)f2bf(aqk[ii] * dec); } }
    }
    LBAR();
#pragma unroll
    for (int i = 0; i < 2; ++i) { const int tsk = tid + 512 * i;
        if (tsk < 768) { const int a = tsk >> 8, hh = (tsk >> 7) & 1, d = tsk & 127;
            const LAS unsigned char* sp = lds + (a == 0 ? L_VV : L_KN) + d * 2; const LAS float* scl = (const LAS float*)(lds + (a == 0 ? L_BET : (a == 1 ? L_SCW : L_SKT)));
            LAS unsigned char* dp = lds + (a == 0 ? L_UT : (a == 1 ? L_WT : L_KTT)) + d * TS + 64 * hh;
#pragma unroll
            for (int q = 0; q < 4; ++q) { float kv[8];
#pragma unroll
                for (int e = 0; e < 8; ++e) { const int c = 32 * hh + 8 * q + e; kv[e] = __uint_as_float(((unsigned)*(const LAS unsigned short*)(sp + c * RS)) << 16) * scl[c]; }
                v4u o; o.x = pk2(kv[0], kv[1]); o.y = pk2(kv[2], kv[3]); o.z = pk2(kv[4], kv[5]); o.w = pk2(kv[6], kv[7]); *(LAS v4u*)(dp + 16 * q) = o; } } }
    LBAR();
    { const LAS float* Lm = (const LAS float*)(lds + L_LM); LAS float* Tm = (LAS float*)(lds + L_TM);
      if (tid < 64) { const int I = tid >> 4, j = tid & 15; float x[16];
#pragma unroll
          for (int i = 0; i < 16; ++i) { float s = (i == j) ? 1.f : 0.f;
#pragma unroll
              for (int kb = 0; kb < (i + 3) / 4; ++kb) { const f32x4 l = *(const LAS f32x4*)(Lm + (16 * I + i) * 64 + 16 * I + 4 * kb);
#pragma unroll
                  for (int e = 0; e < 4; ++e) if (4 * kb + e < i) s -= l[e] * x[4 * kb + e]; }
              x[i] = (i < j) ? 0.f : s; Tm[(16 * I + i) * 64 + 16 * I + j] = x[i]; } }
      LBAR();
#pragma unroll 1
      for (int lv = 1; lv < 4; ++lv) {
          for (int e = tid; e < (4 - lv) * 256; e += NWAVES * 64) { const int I = lv + (e >> 8), J = I - lv, rr = (e >> 4) & 15, cc = e & 15; float w = 0.f;
              for (int K = J; K < I; ++K) {
#pragma unroll
                  for (int kb = 0; kb < 4; ++kb) { const f32x4 l = *(const LAS f32x4*)(Lm + (16 * I + rr) * 64 + 16 * K + 4 * kb);
#pragma unroll
                      for (int q = 0; q < 4; ++q) w += l[q] * Tm[(16 * K + 4 * kb + q) * 64 + 16 * J + cc]; } }
              Tm[(16 * J + rr) * 64 + 16 * I + cc] = w; }
          LBAR();
          for (int e = tid; e < (4 - lv) * 256; e += NWAVES * 64) { const int I = lv + (e >> 8), J = I - lv, rr = (e >> 4) & 15, cc = e & 15; float t = 0.f;
#pragma unroll
              for (int kb = 0; kb < 4; ++kb) { const f32x4 l = *(const LAS f32x4*)(Tm + (16 * I + rr) * 64 + 16 * I + 4 * kb);
#pragma unroll
                  for (int q = 0; q < 4; ++q) t -= l[q] * Tm[(16 * J + 4 * kb + q) * 64 + 16 * I + cc]; }
              Tm[(16 * I + rr) * 64 + 16 * J + cc] = t; }
          LBAR();
      }
      { const int i = tid >> 3, j0 = (tid & 7) * 8; const f32x4 t0 = *(const LAS f32x4*)(Tm + i * 64 + j0), t1 = *(const LAS f32x4*)(Tm + i * 64 + j0 + 4); const bool keep = (i >> 4) >= (j0 >> 4);
        v4u o; o.x = keep ? pk2(t0[0], t0[1]) : 0u; o.y = keep ? pk2(t0[2], t0[3]) : 0u; o.z = keep ? pk2(t1[0], t1[1]) : 0u; o.w = keep ? pk2(t1[2], t1[3]) : 0u;
        *(LAS v4u*)(lds + L_TB + i * TS + j0 * 2) = o; }
      LBAR();
    }
    { bf16x8 af[4][2];
#pragma unroll
      for (int mt = 0; mt < 4; ++mt)
#pragma unroll
          for (int ks = 0; ks < 2; ++ks) af[mt][ks] = ldsfrag(lds + L_TB, 16 * mt + r, TS, 64 * ks + 16 * g);
#pragma unroll
      for (int q = 0; q < 2; ++q) { const int ng = 2 * wave + q; LAS unsigned char* base = lds + (ng >= 8 ? L_WT : L_UT) + (16 * (ng & 7) + r) * TS;
          const bf16x8 b0 = *(const LAS bf16x8*)(base + 16 * g), b1 = *(const LAS bf16x8*)(base + 64 + 16 * g);
          f32x4 acc[4];
#pragma unroll
          for (int mt = 0; mt < 4; ++mt) { acc[mt] = mfma16(af[mt][0], b0, (f32x4){0.f, 0.f, 0.f, 0.f}); acc[mt] = mfma16(af[mt][1], b1, acc[mt]); }
          asm volatile("s_waitcnt lgkmcnt(0)" ::: "memory");
#pragma unroll
          for (int mt = 0; mt < 4; ++mt) *(LAS v2u*)(base + (16 * mt + 4 * g) * 2) = pack4(acc[mt]); }
    }
    LBAR();
    {
        const size_t u16 = (size_t)unit * 16384, u8 = (size_t)unit * 8192;
        { const int kk = wave >> 1;
          bf16x8 af[2][2];
#pragma unroll
          for (int t2 = 0; t2 < 2; ++t2)
#pragma unroll
              for (int ks = 0; ks < 2; ++ks) af[t2][ks] = ldsfrag(lds + L_WT, 16 * (2 * kk + t2) + r, TS, 64 * ks + 16 * g);
#pragma unroll
          for (int q = 0; q < 4; ++q) { const int nt = 4 * (wave & 1) + q; f32x4 a0 = {0.f, 0.f, 0.f, 0.f}, a1 = {0.f, 0.f, 0.f, 0.f};
#pragma unroll
              for (int ks = 0; ks < 2; ++ks) { const bf16x8 bfr = ldsfrag(lds + L_KTT, 16 * nt + r, TS, 64 * ks + 16 * g); a0 = mfma16(af[0][ks], bfr, a0); a1 = mfma16(af[1][ks], bfr, a1); }
              v2u o; o.x = __builtin_amdgcn_cvt_pk_fp8_f32(-16.f * a0[0], -16.f * a0[1], 0, false); o.x = __builtin_amdgcn_cvt_pk_fp8_f32(-16.f * a0[2], -16.f * a0[3], o.x, true);
              o.y = __builtin_amdgcn_cvt_pk_fp8_f32(-16.f * a1[0], -16.f * a1[1], 0, false); o.y = __builtin_amdgcn_cvt_pk_fp8_f32(-16.f * a1[2], -16.f * a1[3], o.y, true);
              *(GAS v2u*)((GAS unsigned char*)X.PG + (size_t)unit * 16384 + ((size_t)(nt * 4 + kk) * 64 + lane) * 8) = o; } }
        { const int mt = wave; bf16x8 af[2];
#pragma unroll
          for (int ks = 0; ks < 2; ++ks) af[ks] = ldsfrag(lds + L_KTT, 16 * mt + r, TS, 64 * ks + 16 * g);
#pragma unroll
          for (int nt = 0; nt < 8; ++nt) { f32x4 a0 = {0.f, 0.f, 0.f, 0.f};
#pragma unroll
              for (int ks = 0; ks < 2; ++ks) a0 = mfma16(af[ks], ldsfrag(lds + L_UT, 16 * nt + r, TS, 64 * ks + 16 * g), a0);
              *(GAS v2u*)(X.BG + u16 + ((size_t)(nt * 8 + mt) * 64 + lane) * 4) = pack4(a0); } }
        { const int kk = wave >> 1;
#pragma unroll
          for (int q = 0; q < 2; ++q) { const int ct = 2 * (wave & 1) + q; f32x4 a0 = {0.f, 0.f, 0.f, 0.f}, a1 = {0.f, 0.f, 0.f, 0.f};
#pragma unroll
              for (int ks = 0; ks < 2; ++ks) { const bf16x8 bfr = ldsfrag(lds + L_ATT, 16 * ct + r, TS, 64 * ks + 16 * g);
                  a0 = mfma16(ldsfrag(lds + L_WT, 16 * (2 * kk) + r, TS, 64 * ks + 16 * g), bfr, a0); a1 = mfma16(ldsfrag(lds + L_WT, 16 * (2 * kk + 1) + r, TS, 64 * ks + 16 * g), bfr, a1); }
              const int c = 16 * ct + r; const float eg = egs[c];
              const f32x4 q0 = unpack4(*(const LAS v2u*)(lds + L_QN + c * RS + (32 * kk + 4 * g) * 2)), q1 = unpack4(*(const LAS v2u*)(lds + L_QN + c * RS + (32 * kk + 16 + 4 * g) * 2));
              v4u o; o.x = pk2(q0[0] * eg - a0[0], q0[1] * eg - a0[1]); o.y = pk2(q0[2] * eg - a0[2], q0[3] * eg - a0[3]); o.z = pk2(q1[0] * eg - a1[0], q1[1] * eg - a1[1]); o.w = pk2(q1[2] * eg - a1[2], q1[3] * eg - a1[3]);
              *(GAS v4u*)(X.QP + u8 + ((size_t)(ct * 4 + kk) * 64 + lane) * 8) = o; } }
        { const int vt = wave; bf16x8 af[2];
#pragma unroll
          for (int ks = 0; ks < 2; ++ks) af[ks] = ldsfrag(lds + L_UT, 16 * vt + r, TS, 64 * ks + 16 * g);
#pragma unroll
          for (int ct = 0; ct < 4; ++ct) { f32x4 a0 = {0.f, 0.f, 0.f, 0.f};
#pragma unroll
              for (int ks = 0; ks < 2; ++ks) a0 = mfma16(af[ks], ldsfrag(lds + L_ATT, 16 * ct + r, TS, 64 * ks + 16 * g), a0);
              *(GAS v2u*)(X.OI + u8 + ((size_t)(vt * 4 + ct) * 64 + lane) * 4) = pack4(a0); } }
    }
    LBAR();
}

__device__ __forceinline__ void p3_hgrn_unit(LAS unsigned char* lds, const MixPtrs& X, int unit, int tid, int lane, int wave) {
    const int h = unit & 3, n = (unit >> 2) & 127, b = unit >> 9, r = lane & 15, g = lane >> 4;
    const size_t tok0 = (size_t)b * T + (size_t)n * 64;
#pragma unroll
    for (int i = 0; i < 4; ++i) { const int pair = (tid >> 4) + 32 * i, tz = pair >> 6, c = pair & 63, ch = tid & 15;
        const v4u q = *(const GAS v4u*)(X.projA + (tok0 + c) * PA + (tz ? 2560 : 1536) + h * 128 + ch * 8);
        *(LAS v4u*)(lds + (tz ? H_QR : H_FR) + c * RS + ch * 16) = q; }
    {
        v4u rv[2];
#pragma unroll
        for (int i = 0; i < 2; ++i) { const int item = tid + 512 * i, c = item >> 4, ch = item & 15; rv[i] = *(const GAS v4u*)(X.projA + (tok0 + c) * PA + 2048 + h * 128 + ch * 8); }
#pragma unroll
        for (int i = 0; i < 2; ++i) { const int item = tid + 512 * i, c = item >> 4, ch = item & 15; const unsigned w[4] = {rv[i].x, rv[i].y, rv[i].z, rv[i].w};
#pragma unroll
            for (int e = 0; e < 4; ++e) { *(LAS unsigned short*)(lds + H_VT + (ch * 8 + 2 * e) * TS + c * 2) = (unsigned short)(w[e] & 0xffffu); *(LAS unsigned short*)(lds + H_VT + (ch * 8 + 2 * e + 1) * TS + c * 2) = (unsigned short)(w[e] >> 16); } }
    }
    LBAR();
    {
        const int d = tid & 127, seg = tid >> 7; LAS float* segt = (LAS float*)(lds + H_AM + 9216);
        const float l0 = X.hg_lb[h * 128 + d], l1 = X.hg_lb[512 + h * 128 + d]; const float mx = fmaxf(l0, l1); const float e0 = __expf(l0 - mx), e1 = __expf(l1 - mx); const float lb = e0 / (e0 + e1);
        float lc[16], kq[16]; float run = 0.f;
#pragma unroll
        for (int ci = 0; ci < 16; ++ci) { const float sg = sigmoidf_(ldsbf(lds + H_FR, 16 * seg + ci, RS, d)); run += __logf(lb + (1.f - lb) * sg); lc[ci] = run; kq[ci] = (1.f - lb) * (1.f - sg); }
        segt[seg * 128 + d] = run;
        LBAR();
        const float t0 = segt[d], t1 = segt[128 + d], t2 = segt[256 + d], t3 = segt[384 + d];
        const float off = (seg > 0 ? t0 : 0.f) + (seg > 1 ? t1 : 0.f) + (seg > 2 ? t2 : 0.f), btot = (t0 + t1) + (t2 + t3);
        float kv[16];
#pragma unroll
        for (int ci = 0; ci < 16; ++ci) { const int c = 16 * seg + ci; const float bb = off + lc[ci];
            *(LAS unsigned short*)(lds + H_QE + c * RS + d * 2) = (unsigned short)f2bf(siluf_(ldsbf(lds + H_QR, c, RS, d)) * __expf(bb));
            *(LAS unsigned short*)(lds + H_KD + c * RS + d * 2) = (unsigned short)f2bf(kq[ci] * __expf(-bb));
            kv[ci] = kq[ci] * __expf(btot - bb); }
        if (seg == 0) X.AH[(size_t)unit * 128 + d] = __expf(btot);
#pragma unroll
        for (int q = 0; q < 2; ++q) { v4u o; o.x = pk2(kv[8 * q], kv[8 * q + 1]); o.y = pk2(kv[8 * q + 2], kv[8 * q + 3]); o.z = pk2(kv[8 * q + 4], kv[8 * q + 5]); o.w = pk2(kv[8 * q + 6], kv[8 * q + 7]);
            *(LAS v4u*)(lds + H_KTT + d * TS + (16 * seg + 8 * q) * 2) = o; }
    }
    LBAR();
    {
        const int mt = wave >> 1;
#pragma unroll
        for (int q = 0; q < 2; ++q) { const int ntc = 2 * (wave & 1) + q; f32x4 a0 = {0.f, 0.f, 0.f, 0.f};
#pragma unroll
            for (int ks = 0; ks < 4; ++ks) a0 = mfma16(ldsfrag(lds + H_QE, 16 * mt + r, RS, 64 * ks + 16 * g), ldsfrag(lds + H_KD, 16 * ntc + r, RS, 64 * ks + 16 * g), a0);
            const int j = 16 * ntc + r;
#pragma unroll
            for (int ii = 0; ii < 4; ++ii) { const int i = 16 * mt + 4 * g + ii; *(LAS unsigned short*)(lds + H_AM + i * TS + j * 2) = (unsigned short)f2bf((i >= j) ? a0[ii] : 0.f); } }
    }
    LBAR();
    {
        const size_t u16 = (size_t)unit * 16384, u8 = (size_t)unit * 8192;
        { const int mt = wave; bf16x8 af[2];
#pragma unroll
          for (int ks = 0; ks < 2; ++ks) af[ks] = ldsfrag(lds + H_KTT, 16 * mt + r, TS, 64 * ks + 16 * g);
#pragma unroll
          for (int nt = 0; nt < 8; ++nt) { f32x4 a0 = {0.f, 0.f, 0.f, 0.f};
#pragma unroll
              for (int ks = 0; ks < 2; ++ks) a0 = mfma16(af[ks], ldsfrag(lds + H_VT, 16 * nt + r, TS, 64 * ks + 16 * g), a0);
              *(GAS v2u*)(X.BH + u16 + ((size_t)(nt * 8 + mt) * 64 + lane) * 4) = pack4(a0); } }
        { const int vt = wave; bf16x8 af[2];
#pragma unroll
          for (int ks = 0; ks < 2; ++ks) af[ks] = ldsfrag(lds + H_VT, 16 * vt + r, TS, 64 * ks + 16 * g);
#pragma unroll
          for (int ct = 0; ct < 4; ++ct) { f32x4 a0 = {0.f, 0.f, 0.f, 0.f};
#pragma unroll
              for (int ks = 0; ks < 2; ++ks) a0 = mfma16(af[ks], ldsfrag(lds + H_AM, 16 * ct + r, TS, 64 * ks + 16 * g), a0);
              *(GAS v2u*)(X.OIH + u8 + ((size_t)(vt * 4 + ct) * 64 + lane) * 4) = pack4(a0); } }
#pragma unroll
        for (int q = 0; q < 2; ++q) { const int idx = wave * 2 + q, ct = idx >> 2, kk = idx & 3, c = 16 * ct + r;
            const v2u q0 = *(const LAS v2u*)(lds + H_QE + c * RS + (32 * kk + 4 * g) * 2), q1 = *(const LAS v2u*)(lds + H_QE + c * RS + (32 * kk + 16 + 4 * g) * 2);
            v4u o; o.x = q0.x; o.y = q0.y; o.z = q1.x; o.w = q1.y;
            *(GAS v4u*)(X.QE + u8 + ((size_t)(ct * 4 + kk) * 64 + lane) * 8) = o; }
    }
    LBAR();
}

__device__ __forceinline__ void p4_gdn_scan(LAS unsigned char* lds, const MixPtrs& X, int job, int lane, int wave) {
    const int s = job >> 3, h = job & 3, b = (job >> 2) & 1;
    const int unit0 = (b * 128) * 4 + h;
    constexpr int F8RING = 0, IMG = 65536, BRING = 131072, GLOFF = BRING + 5 * 4096;
    typedef float f32x2_ __attribute__((ext_vector_type(2)));
    if (wave >= 4) {
        const int lw = wave - 4;
        const char* src0 = (const char*)X.PG + (size_t)unit0 * 16384 + lw * 4096 + lane * 16;
        const char* bsrc0 = (const char*)(X.BG + (size_t)unit0 * 16384 + (size_t)(s * 8) * 256) + lw * 1024 + lane * 16;
#define P4_ISSUE(n_) do { const char* s_ = src0 + (size_t)(n_) * (4 * 16384); _Pragma("unroll") for (int i_ = 0; i_ < 4; ++i_) \
        __builtin_amdgcn_global_load_lds((const unsigned*)(s_ + i_ * 1024), (LAS unsigned*)(lds + F8RING + ((n_) & 3) * 16384 + lw * 4096 + i_ * 1024), 16, 0, 2); \
        __builtin_amdgcn_global_load_lds((const unsigned*)(bsrc0 + (size_t)(n_) * (4 * 32768)), (LAS unsigned*)(lds + BRING + ((n_) % 5) * 4096 + lw * 1024), 16, 0, 0); } while (0)
#define P4_DECODE(n_) do { const LAS unsigned char* f_ = lds + F8RING + ((n_) & 3) * 16384 + lw * 4096 + lane * 8; LAS unsigned char* o_ = lds + IMG + ((n_) & 1) * 32768 + lw * 8192 + lane * 16; \
        _Pragma("unroll") for (int q_ = 0; q_ < 8; ++q_) { const v2u q8 = *(const LAS v2u*)(f_ + q_ * 512); \
            const f32x2_ c0 = __builtin_amdgcn_cvt_pk_f32_fp8(q8.x, false), c1 = __builtin_amdgcn_cvt_pk_f32_fp8(q8.x, true), c2 = __builtin_amdgcn_cvt_pk_f32_fp8(q8.y, false), c3 = __builtin_amdgcn_cvt_pk_f32_fp8(q8.y, true); \
            v4u w_; w_.x = __builtin_amdgcn_perm(__float_as_uint(c0.y), __float_as_uint(c0.x), 0x07060302u); w_.y = __builtin_amdgcn_perm(__float_as_uint(c1.y), __float_as_uint(c1.x), 0x07060302u); \
            w_.z = __builtin_amdgcn_perm(__float_as_uint(c2.y), __float_as_uint(c2.x), 0x07060302u); w_.w = __builtin_amdgcn_perm(__float_as_uint(c3.y), __float_as_uint(c3.x), 0x07060302u); \
            *(LAS v4u*)(o_ + q_ * 1024) = w_; } } while (0)
        P4_ISSUE(0); P4_ISSUE(1); P4_ISSUE(2); P4_ISSUE(3);
        asm volatile("s_waitcnt vmcnt(15)" ::: "memory");
        P4_DECODE(0);
        asm volatile("s_waitcnt lgkmcnt(0)" ::: "memory");
#pragma unroll 1
        for (int n = 0; n < 128; ++n) {
            __builtin_amdgcn_s_barrier();
            asm volatile("" ::: "memory");
            if (n + 4 < 128) P4_ISSUE(n + 4);
            if (n + 1 < 128) {
                if (n + 4 < 128) asm volatile("s_waitcnt vmcnt(15)" ::: "memory"); else if (n + 3 < 128) asm volatile("s_waitcnt vmcnt(10)" ::: "memory"); else if (n + 2 < 128) asm volatile("s_waitcnt vmcnt(5)" ::: "memory"); else asm volatile("s_waitcnt vmcnt(0)" ::: "memory");
                P4_DECODE(n + 1);
                asm volatile("s_waitcnt lgkmcnt(0)" ::: "memory");
            }
        }
#undef P4_ISSUE
#undef P4_DECODE
    } else if (wave == 0) {
        f32x4 S[8]; bf16x8 sb[4];
#pragma unroll
        for (int mt = 0; mt < 8; ++mt) S[mt] = (f32x4){0.f, 0.f, 0.f, 0.f};
#pragma unroll
        for (int kk = 0; kk < 4; ++kk) { sb[kk] = (bf16x8){0, 0, 0, 0, 0, 0, 0, 0}; *(GAS bf16x8*)(X.SG + (size_t)unit0 * 16384 + ((size_t)(s * 4 + kk) * 64 + lane) * 8) = sb[kk]; }
        { const float g0 = X.GL[unit0 + 4 * lane], g1 = X.GL[unit0 + 4 * (64 + lane)]; *(LAS float*)(lds + GLOFF + lane * 4) = g0; *(LAS float*)(lds + GLOFF + (64 + lane) * 4) = g1; }
        asm volatile("s_waitcnt vmcnt(0) lgkmcnt(0)" ::: "memory");
#pragma unroll 1
        for (int n = 0; n < 128; ++n) {
            const int unit = unit0 + 4 * n;
            __builtin_amdgcn_s_barrier();
            asm volatile("" ::: "memory");
            const float e = __expf(*(const LAS float*)(lds + GLOFF + n * 4));
            const LAS unsigned char* bb = lds + BRING + (n % 5) * 4096 + lane * 8;
            f32x4 acc[8];
#pragma unroll
            for (int mt = 0; mt < 8; ++mt) acc[mt] = (f32x4){0.f, 0.f, 0.f, 0.f};
            const LAS unsigned char* pb = lds + IMG + (n & 1) * 32768 + lane * 16;
#pragma unroll
            for (int kk = 0; kk < 4; ++kk)
#pragma unroll
                for (int mt = 0; mt < 8; ++mt) acc[mt] = mfma16(*(const LAS bf16x8*)(pb + (mt * 4 + kk) * 1024), sb[kk], acc[mt]);
#pragma unroll
            for (int mt = 0; mt < 8; ++mt) S[mt] = S[mt] * e + unpack4(*(const LAS v2u*)(bb + mt * 512)) + acc[mt] * 0.0625f;
#pragma unroll
            for (int kk = 0; kk < 4; ++kk) { v4u o; o.x = pg8::cvt_pk_bf16(S[2 * kk][0], S[2 * kk][1]); o.y = pg8::cvt_pk_bf16(S[2 * kk][2], S[2 * kk][3]); o.z = pg8::cvt_pk_bf16(S[2 * kk + 1][0], S[2 * kk + 1][1]); o.w = pg8::cvt_pk_bf16(S[2 * kk + 1][2], S[2 * kk + 1][3]); asm volatile("s_nop 1" ::: ); sb[kk] = __builtin_bit_cast(bf16x8, o);
                if (n < 127) *(GAS v4u*)(X.SG + (size_t)(unit + 4) * 16384 + ((size_t)(s * 4 + kk) * 64 + lane) * 8) = o; }
            asm volatile("s_waitcnt lgkmcnt(0)" ::: "memory");
        }
    } else {
#pragma unroll 1
        for (int n = 0; n < 128; ++n) { __builtin_amdgcn_s_barrier(); asm volatile("" ::: "memory"); }
    }
}
__device__ __forceinline__ void p4_hgrn_scan(const MixPtrs& X, int task, int lane) {
    const int mt = task & 7, s = (task >> 3) & 7, h = (task >> 6) & 3, b = task >> 8, g = lane >> 4;
    const int unit0 = (b * 128) * 4 + h;
    f32x4 s0 = {0.f, 0.f, 0.f, 0.f};
    const GAS f32x4* ap = (const GAS f32x4*)(X.AH + (size_t)unit0 * 128 + 16 * mt + 4 * g);
    const GAS v2u* bp = (const GAS v2u*)(X.BH + (size_t)unit0 * 16384 + ((size_t)(s * 8 + mt) * 64 + lane) * 4);
    GAS v2u* sp = (GAS v2u*)(X.SH + (size_t)unit0 * 16384 + ((size_t)(s * 4 + (mt >> 1)) * 64 + lane) * 8 + 4 * (mt & 1));
    { v2u z; z.x = 0; z.y = 0; sp[0] = z; }
    f32x4 ra[8]; v2u rb[8];
#pragma unroll
    for (int j = 0; j < 8; ++j) { ra[j] = ap[(size_t)j * 128]; rb[j] = bp[(size_t)j * 16384]; }
#pragma unroll 1
    for (int n0 = 0; n0 < 128; n0 += 8) {
#pragma unroll
        for (int j = 0; j < 8; ++j) { const int n = n0 + j;
            s0 = ra[j] * s0 + unpack4(rb[j]);
            if (n + 8 < 128) { ra[j] = ap[(size_t)(n + 8) * 128]; rb[j] = bp[(size_t)(n + 8) * 16384]; }
            if (n < 127) sp[(size_t)(n + 1) * 16384] = pack4(s0); }
    }
}
__device__ __forceinline__ void p5_unit(LAS unsigned char* lds, const MixPtrs& X, int bn, int lane, int wave) {
    const int hd = wave & 3, type = wave >> 2, r = lane & 15, g = lane >> 4;
    const int unit = bn * 4 + hd; const size_t tok0 = (size_t)bn * 64;
    const bf16* SX = type ? X.SH : X.SG; const bf16* QX = type ? X.QE : X.QP; const bf16* OX = type ? X.OIH : X.OI;
    const size_t u16 = (size_t)unit * 16384, u8 = (size_t)unit * 8192;
    LAS float* exch = (LAS float*)lds;
    const float* nw = type ? X.hg_nw + hd * 128 : X.gdn_nw;
    bf16x8 af[4][8];
#pragma unroll
    for (int kk = 0; kk < 4; ++kk)
#pragma unroll
        for (int vt = 0; vt < 8; ++vt) af[kk][vt] = *(const GAS bf16x8*)(SX + u16 + ((size_t)(vt * 4 + kk) * 64 + lane) * 8);
#pragma unroll 1
    for (int ct = 0; ct < 4; ++ct) {
        bf16x8 bfr[4]; v2u oq[8], gtq[8];
#pragma unroll
        for (int kk = 0; kk < 4; ++kk) bfr[kk] = *(const GAS bf16x8*)(QX + u8 + ((size_t)(ct * 4 + kk) * 64 + lane) * 8);
#pragma unroll
        for (int vt = 0; vt < 8; ++vt) { oq[vt] = *(const GAS v2u*)(OX + u8 + ((size_t)(vt * 4 + ct) * 64 + lane) * 4);
            gtq[vt] = *(const GAS v2u*)(X.gates + (tok0 + 16 * ct + r) * 1024 + type * 512 + hd * 128 + 16 * vt + 4 * g); }
        f32x4 acc[8];
#pragma unroll
        for (int vt = 0; vt < 8; ++vt) acc[vt] = unpack4(oq[vt]);
#pragma unroll
        for (int kk = 0; kk < 4; ++kk)
#pragma unroll
            for (int vt = 0; vt < 8; ++vt) acc[vt] = mfma16(af[kk][vt], bfr[kk], acc[vt]);
        float ssq = 0.f;
#pragma unroll
        for (int vt = 0; vt < 8; ++vt) ssq += (acc[vt][0] * acc[vt][0] + acc[vt][1] * acc[vt][1]) + (acc[vt][2] * acc[vt][2] + acc[vt][3] * acc[vt][3]);
        ssq += __shfl_xor(ssq, 16); ssq += __shfl_xor(ssq, 32);
        if (type == 1 && g == 0) exch[(ct & 1) * 64 + hd * 16 + r] = ssq;
        LBAR();
        float rstd;
        if (type == 1) { const LAS float* ex = exch + (ct & 1) * 64 + r; rstd = rsqrtf(((ex[0] + ex[16]) + (ex[32] + ex[48])) * (1.f / 512.f) + 1e-6f); } else rstd = rsqrtf(ssq * (1.f / 128.f) + 1e-6f);
#pragma unroll
        for (int vt = 0; vt < 8; ++vt) { const f32x4 w4 = *(const GAS f32x4*)(nw + 16 * vt + 4 * g); const size_t off = (tok0 + 16 * ct + r) * 1024 + type * 512 + hd * 128 + 16 * vt + 4 * g;
            const f32x4 gt = unpack4(gtq[vt]); f32x4 o;
#pragma unroll
            for (int e = 0; e < 4; ++e) o[e] = acc[vt][e] * rstd * w4[e] * siluf_(gt[e]);
            *(GAS v2u*)(X.omix + off) = pack4(o); }
    }
    LBAR();
}

struct Args { const float* in[23]; float* out; unsigned char* ws; int ph_lo, ph_hi, li, pad; };

__global__ void __launch_bounds__(NWAVES * 64, 2) mk_fwd(Args args) {
    extern __shared__ __attribute__((aligned(16))) unsigned char lds_raw[];
    LAS unsigned char* lds = (LAS unsigned char*)lds_raw;
    volatile LAS unsigned* MISC = (volatile LAS unsigned*)(lds + MISC_OFF);
    const int tid = threadIdx.x, lane = tid & 63, wave = __builtin_amdgcn_readfirstlane(tid >> 6);
    const int G = gridDim.x, bx = blockIdx.x, vcu = (G % 8 == 0) ? (bx % 8) * (G / 8) + bx / 8 : bx;
    const int gw = vcu * NWAVES + wave, NGW = G * NWAVES;
    unsigned char* ws = args.ws;
    gu32* ctl = (gu32*)(ws + WS_CTL);
    const float* x = args.in[0]; const float* cvec = args.in[1]; const float* w_ada = args.in[2]; const float* b_ada = args.in[3]; const float* norm1_w = args.in[4];
    const float* w_in = args.in[5]; const float* w_out = args.in[12];
    float* mod = (float*)(ws + WS_MOD); float* wab = (float*)(ws + WS_WAB); float* ab = (float*)(ws + WS_AB);
    bf16* wout_t = (bf16*)(ws + WS_WOUT_T); bf16* win_t = (bf16*)(ws + WS_WIN_T); bf16* h1 = (bf16*)(ws + WS_H1); bf16* projA = (bf16*)(ws + WS_PROJA); bf16* gates = (bf16*)(ws + WS_GATES);
    bf16* omix = (bf16*)(ws + WS_OMIX);
    bf16* h2 = (bf16*)(ws + WS_H2); bf16* w1t = (bf16*)(ws + WS_W1T); bf16* w2t = (bf16*)(ws + WS_W2T); bf16* act = (bf16*)(ws + WS_ACT); bf16* y0 = (bf16*)(ws + WS_Y0); bf16* y1 = (bf16*)(ws + WS_Y1);
    MixPtrs X; X.projA = projA; X.gates = gates; X.ab = ab; X.conv_w = args.in[6]; X.a_log = args.in[7]; X.dt_bias = args.in[8]; X.hg_lb = args.in[10]; X.gdn_nw = args.in[9]; X.hg_nw = args.in[11];
    X.PG = (bf16*)(ws + WS_PG); X.BG = (bf16*)(ws + WS_BG); X.QP = (bf16*)(ws + WS_QP); X.OI = (bf16*)(ws + WS_OI); X.BH = (bf16*)(ws + WS_BH); X.QE = (bf16*)(ws + WS_QE); X.OIH = (bf16*)(ws + WS_OIH);
    X.SG = (bf16*)args.out; X.SH = (bf16*)args.out + (size_t)UNITS * 16384; X.omix = omix; X.GL = (float*)(ws + WS_GL); X.AH = (float*)(ws + WS_AH);
    const int* list = (const int*)(ws + WS_LIST); const float* listw = (const float*)(ws + WS_LISTW);
    LAS unsigned* tb = (LAS unsigned*)(lds + SCR2_OFF);

    for (int u = tid; u < (LDS_BYTES - LDSCTL_OFF) / 4; u += NWAVES * 64) ((LAS unsigned*)(lds + LDSCTL_OFF))[u] = 0u;
    __syncthreads();
    XcdBarrier bar = xcd_barrier_post((unsigned*)(ctl + CW_BAR) + args.li * XCD_BAR_WORDS, MISC + 8);
    const int lo = args.ph_lo, hi = args.ph_hi;
#define IN(k) (lo <= (k) && (k) < hi)
#define BOTH(k) (IN(k) && IN((k) + 1))

    if (IN(0)) {
#define PH_BODY do { \
        if (bx < 96) { \
            LAS float* part = (LAS float*)(lds + RING_BYTES); \
            const int e = bx * 64 + lane; float a0 = 0.f, a1 = 0.f; \
_Pragma("unroll 32") \
            for (int d = wave * 128; d < wave * 128 + 128; ++d) { const float w = w_ada[(size_t)d * 6144 + e]; a0 += siluf_(cvec[d]) * w; a1 += siluf_(cvec[D + d]) * w; } \
            part[(wave * 2 + 0) * 64 + lane] = a0; part[(wave * 2 + 1) * 64 + lane] = a1; \
            __syncthreads(); \
            if (tid < 128) { const int bb = tid >> 6, l = tid & 63; float s = 0.f; \
_Pragma("unroll") \
                for (int w = 0; w < 8; ++w) s += part[(w * 2 + bb) * 64 + l]; \
                mod[bb * 6144 + bx * 64 + l] = s + b_ada[bx * 64 + l]; } \
        } else if (bx == 96) { \
            for (int idx = tid; idx < 8192; idx += NWAVES * 64) wab[idx] = w_in[(size_t)(idx >> 3) * DIN + 2048 + (idx & 7)]; \
        } \
        { const float* w_router = args.in[14]; bf16* wrhi = (bf16*)(ws + WS_WRHI); bf16* wrlo = (bf16*)(ws + WS_WRLO); \
          for (int k = gw; k < 1024; k += NGW) { const float w = w_router[k * 64 + lane]; const unsigned hi = f2bf(w); \
              wrhi[lane * 1024 + k] = (bf16)hi; wrlo[lane * 1024 + k] = (bf16)f2bf(w - __uint_as_float(hi << 16)); } } \
        LAS float* scr = (LAS float*)(lds + wave * 16384); \
        constexpr int I_IN = 16 * 128, I_OUT = 16 * 32; \
        auto mk0 = [&](int it) { TrItem t; if (it < I_IN) { const int kb = it / 128, n0 = 32 * (it % 128); const int sc_ = n0 < 1536 ? n0 : (n0 < 3072 ? n0 + 520 : (n0 < 3584 ? n0 - 1536 : n0 + 8)); \
                t.W = w_in; t.ldw = DIN; t.src_col = sc_; t.WT = win_t; t.K = D; t.dst_row = n0; t.k0 = 64 * kb; t.f8scale = 0.f; } \
            else { const int r = it - I_IN, kb = r / 32, n0 = 32 * (r % 32); t.W = w_out; t.ldw = D; t.src_col = n0; t.WT = wout_t; t.K = D; t.dst_row = n0; t.k0 = 64 * kb; t.f8scale = 0.f; } return t; }; \
        TR_LOOP(gw, NGW, I_IN + I_OUT, mk0); \
        if (BOTH(0)) xcd_barrier(bar); \
    } while (0)
        PH_BODY; if (REPN(0) > 1) { PH_BODY; PH_BODY; }
#undef PH_BODY
    }
    if (IN(1)) {
#define PH_BODY do { \
        { \
            const GAS f32x4* wab4 = (const GAS f32x4*)wab; \
            for (int idx = tid; idx < 2048; idx += NWAVES * 64) { const int d = idx >> 1, qh = idx & 1; *(LAS f32x4*)(lds + (((qh * 4 + (d & 3)) * 256 + (d >> 2)) * 16)) = wab4[idx]; } \
            __syncthreads(); \
            const int nrows = (M - gw + NGW - 1) / NGW; \
            f32x4 sclr[4], shfr[4]; int curb = -1; \
            f32x4 vn[2][4]; \
_Pragma("unroll") \
            for (int q = 0; q < 2; ++q) { const int m = gw + q * NGW; \
_Pragma("unroll") \
                for (int j = 0; j < 4; ++j) vn[q][j] = (q < nrows) ? ((const GAS f32x4*)(x + (size_t)m * D) + lane)[64 * j] : (f32x4){0.f, 0.f, 0.f, 0.f}; } \
_Pragma("unroll 1") \
            for (int p = 0; p < nrows; p += 2) { \
                f32x4 v[2][4]; \
_Pragma("unroll") \
                for (int q = 0; q < 2; ++q) \
_Pragma("unroll") \
                    for (int j = 0; j < 4; ++j) v[q][j] = vn[q][j]; \
_Pragma("unroll") \
                for (int q = 0; q < 2; ++q) { const int m = gw + (p + 2 + q) * NGW; \
                    if (p + 2 + q < nrows) { \
_Pragma("unroll") \
                        for (int j = 0; j < 4; ++j) vn[q][j] = ((const GAS f32x4*)(x + (size_t)m * D) + lane)[64 * j]; } } \
_Pragma("unroll") \
                for (int q = 0; q < 2; ++q) { const int m = gw + (p + q) * NGW; \
                    if (p + q < nrows) { \
                        float ss = 0.f; \
_Pragma("unroll") \
                        for (int j = 0; j < 4; ++j) ss += (v[q][j].x * v[q][j].x + v[q][j].y * v[q][j].y) + (v[q][j].z * v[q][j].z + v[q][j].w * v[q][j].w); \
                        const float rstd = rsqrtf(wave_sum(ss) * (1.f / D) + 1e-6f); \
                        const int bsel = m >= T ? 1 : 0; \
                        if (bsel != curb) { curb = bsel; const GAS f32x4* sh4 = (const GAS f32x4*)(mod + bsel * 6144) + lane; \
_Pragma("unroll") \
                            for (int j = 0; j < 4; ++j) { sclr[j] = ((const GAS f32x4*)norm1_w + lane)[64 * j] * (sh4[256 + 64 * j] + 1.0f); shfr[j] = sh4[64 * j]; } } \
                        GAS unsigned long long* o8 = (GAS unsigned long long*)(h1 + (size_t)m * D) + lane; \
                        f32x4 a0 = {0.f, 0.f, 0.f, 0.f}, a1 = {0.f, 0.f, 0.f, 0.f}; \
_Pragma("unroll") \
                        for (int j = 0; j < 4; ++j) { __builtin_amdgcn_sched_barrier(0); const f32x4 h = v[q][j] * rstd * sclr[j] + shfr[j]; \
                            o8[64 * j] = (unsigned long long)pk2(h.x, h.y) | ((unsigned long long)pk2(h.z, h.w) << 32); \
_Pragma("unroll") \
                            for (int i = 0; i < 4; ++i) { a0 += *(const LAS f32x4*)(lds + ((i * 256 + lane + 64 * j) * 16)) * h[i]; a1 += *(const LAS f32x4*)(lds + (((4 + i) * 256 + lane + 64 * j) * 16)) * h[i]; } } \
 \
                        const bool up5 = (lane & 32) != 0, up4 = (lane & 16) != 0, up3 = (lane & 8) != 0; \
                        f32x4 k4; \
_Pragma("unroll") \
                        for (int e = 0; e < 4; ++e) { const float snd = up5 ? a0[e] : a1[e]; k4[e] = (up5 ? a1[e] : a0[e]) + __shfl_xor(snd, 32); } \
                        float k2[2]; \
_Pragma("unroll") \
                        for (int e = 0; e < 2; ++e) { const float snd = up4 ? k4[e] : k4[2 + e]; k2[e] = (up4 ? k4[2 + e] : k4[e]) + __shfl_xor(snd, 16); } \
                        float k1; { const float snd = up3 ? k2[0] : k2[1]; k1 = (up3 ? k2[1] : k2[0]) + __shfl_xor(snd, 8); } \
                        k1 += __shfl_xor(k1, 4); k1 += __shfl_xor(k1, 2); k1 += __shfl_xor(k1, 1); \
                        if ((lane & 7) == 0) ab[(size_t)m * 8 + 4 * (lane >> 5) + 2 * ((lane >> 4) & 1) + ((lane >> 3) & 1)] = k1; \
                    } } \
            } \
            __syncthreads(); \
        } \
        if (BOTH(1)) xcd_barrier(bar); \
    } while (0)
        PH_BODY; if (REPN(1) > 1) { PH_BODY; PH_BODY; }
#undef PH_BODY
    }
    if (IN(2)) {
#define PH_BODY do { \
        pg8::Gemm g{h1, win_t, M, 4096, D}; pg8::StaticOrder S; S.init(M, 4096, G, (int)blockIdx.x); \
        pg8::EpiProj E{projA, gates}; \
        pg8::gemm_phase<pg8::EpiProj, pg8::StaticOrder, true, true>(lds, g, S, E); \
        if (BOTH(2)) xcd_barrier(bar); \
    } while (0)
        PH_BODY; if (REPN(2) > 1) { PH_BODY; PH_BODY; }
#undef PH_BODY
    }

    if (IN(3)) {
#define PH_BODY do { \
        for (int u = vcu; u < UNITS; u += G) p3_gdn_unit(lds, X, u, tid, lane, wave); \
        for (int u = vcu; u < UNITS; u += G) p3_hgrn_unit(lds, X, u, tid, lane, wave); \
        if (BOTH(3)) xcd_barrier(bar); \
    } while (0)
        PH_BODY; if (REPN(3) > 1) { PH_BODY; PH_BODY; }
#undef PH_BODY
    }
    if (IN(4)) {
#define PH_BODY do { \
        if (bx < 64) p4_gdn_scan(lds, X, bx, lane, wave); \
        else { \
            if (wave < 3 && (bx - 64) * 3 + wave < 512) p4_hgrn_scan(X, (bx - 64) * 3 + wave, lane); \
            LAS float* scr = (LAS float*)(lds + wave * 16384); \
            const float* w_gate = args.in[16]; const float* w_up = args.in[17]; const float* w_down = args.in[18]; const float* ws_gate = args.in[19]; const float* ws_up = args.in[20]; const float* ws_down = args.in[21]; \
            auto mk4 = [&](int it) { TrItem t; const int e = it / 384, r = it % 384; \
                if (r < 256) { const int up = r >> 7, q = r & 127, kb = q >> 3, n0 = 32 * (q & 7); \
                    t.W = e < NE ? (up ? w_up : w_gate) + (size_t)e * D * DE : (up ? ws_up : ws_gate); t.ldw = DE; t.src_col = n0; t.WT = (bf16*)((unsigned char*)w1t + (size_t)e * 512 * 1024); t.K = D; t.dst_row = (n0 >> 7) * 256 + up * 128 + (n0 & 127); t.k0 = 64 * kb; t.f8scale = 32.f; } \
                else { const int q = r - 256, kb = q >> 5, n0 = 32 * (q & 31); \
                    t.W = e < NE ? w_down + (size_t)e * DE * D : ws_down; t.ldw = D; t.src_col = n0; t.WT = (bf16*)((unsigned char*)w2t + (size_t)e * 1024 * 256); t.K = DE; t.dst_row = n0; t.k0 = 64 * kb; t.f8scale = 16.f; } return t; }; \
            TR_LOOP((bx - 64) * NWAVES + wave, (G - 64) * NWAVES, NEX * 384, mk4); \
        } \
        if (BOTH(4)) xcd_barrier(bar); \
    } while (0)
        PH_BODY; if (REPN(4) > 1) { PH_BODY; PH_BODY; }
#undef PH_BODY
    }
    if (IN(5)) {
#define PH_BODY do { \
        for (int bn = vcu; bn < BATCH * 128; bn += G) p5_unit(lds, X, bn, lane, wave); \
        if (BOTH(5)) xcd_barrier(bar); \
    } while (0)
        PH_BODY; if (REPN(5) > 1) { PH_BODY; PH_BODY; }
#undef PH_BODY
    }
    if (IN(6)) {
#define PH_BODY do { \
        pg8::Gemm g{omix, wout_t, M, D, D}; pg8::StaticOrder S; S.init(M, D, G, (int)blockIdx.x); \
        pg8::EpiResid E{x, mod, args.out}; \
        pg8::gemm_phase<pg8::EpiResid, pg8::StaticOrder, true, true>(lds, g, S, E); \
        if (BOTH(6)) xcd_barrier(bar); \
    } while (0)
        PH_BODY; if (REPN(6) > 1) { PH_BODY; PH_BODY; }
#undef PH_BODY
    }


    if (IN(7)) {
        constexpr int HS = 2064;
        constexpr int R_HI = 0, R_LO = 66048, R_PART = 0  , R_SC = 132096, R_SEL = 140288, R_CNT = 148480, R_BASE = 148736, R_ESE = 148992, R_ESL = 151040, R_EW = 153088, R_ELP = 155136;
        if (tid < 64) *(LAS unsigned*)(lds + R_CNT + tid * 4) = 0u;
        __syncthreads();
        int nu = 0;
        const float* norm2_w = args.in[13]; const float* rbias = args.in[15]; const bf16* wrhi = (const bf16*)(ws + WS_WRHI); const bf16* wrlo = (const bf16*)(ws + WS_WRLO);
        int* listo = (int*)(ws + WS_LIST); float* listwo = (float*)(ws + WS_LISTW);
        const int r = lane & 15, g = lane >> 4;
#pragma unroll 1
        for (int u = vcu; u < M / 32; u += G, ++nu) {
            const GAS f32x4* sh4 = (const GAS f32x4*)(mod + (32 * u >= T ? 6144 : 0) + 3072) + lane; const GAS f32x4* nw4 = (const GAS f32x4*)norm2_w + lane;
#pragma unroll 1
            for (int qp = 0; qp < 4; qp += 2) {
                f32x4 xrow[2][4];
#pragma unroll
                for (int q = 0; q < 2; ++q) { const GAS f32x4* xr = (const GAS f32x4*)(args.out + (size_t)(32 * u + 4 * wave + qp + q) * D) + lane;
#pragma unroll
                    for (int j = 0; j < 4; ++j) xrow[q][j] = xr[64 * j]; }
#pragma unroll
                for (int q = 0; q < 2; ++q) { const int rl = 4 * wave + qp + q, m = 32 * u + rl;
                    f32x4 v[4]; float ss = 0.f;
#pragma unroll
                    for (int j = 0; j < 4; ++j) { v[j] = xrow[q][j]; ss += (v[j].x * v[j].x + v[j].y * v[j].y) + (v[j].z * v[j].z + v[j].w * v[j].w); }
                    const float rstd = rsqrtf(wave_sum(ss) * (1.f / D) + 1e-6f);
                    GAS unsigned* o4 = (GAS unsigned*)((unsigned char*)h2 + (size_t)m * D) + lane;
#pragma unroll
                    for (int j = 0; j < 4; ++j) { const f32x4 hv = v[j] * rstd * (nw4[64 * j] * (sh4[256 + 64 * j] + 1.0f)) + sh4[64 * j];
                        const unsigned h0 = f2bf(hv.x), h1_ = f2bf(hv.y), h2_ = f2bf(hv.z), h3 = f2bf(hv.w);
                        const unsigned long long hi = (unsigned long long)(h0 | (h1_ << 16)) | ((unsigned long long)(h2_ | (h3 << 16)) << 32);
                        { unsigned q8 = __builtin_amdgcn_cvt_pk_fp8_f32(hv.x, hv.y, 0, false); q8 = __builtin_amdgcn_cvt_pk_fp8_f32(hv.z, hv.w, q8, true); o4[64 * j] = q8; }
                        const unsigned long long lo = (unsigned long long)pk2(hv.x - __uint_as_float(h0 << 16), hv.y - __uint_as_float(h1_ << 16)) | ((unsigned long long)pk2(hv.z - __uint_as_float(h2_ << 16), hv.w - __uint_as_float(h3 << 16)) << 32);
                        *(LAS unsigned long long*)(lds + R_HI + rl * HS + (lane + 64 * j) * 8) = hi; *(LAS unsigned long long*)(lds + R_LO + rl * HS + (lane + 64 * j) * 8) = lo; } }
            }
            __syncthreads();
            f32x4 acc[2][4];
#pragma unroll
            for (int mt = 0; mt < 2; ++mt)
#pragma unroll
                for (int nt = 0; nt < 4; ++nt) acc[mt][nt] = (f32x4){0.f, 0.f, 0.f, 0.f};
#pragma unroll 2
            for (int ks = 0; ks < 4; ++ks) { const int kb = (128 * wave + 32 * ks + 8 * g) * 2;
                bf16x8 ahi[2], alo[2];
#pragma unroll
                for (int mt = 0; mt < 2; ++mt) { ahi[mt] = *(const LAS bf16x8*)(lds + R_HI + (16 * mt + r) * HS + kb); alo[mt] = *(const LAS bf16x8*)(lds + R_LO + (16 * mt + r) * HS + kb); }
#pragma unroll
                for (int nt = 0; nt < 4; ++nt) { const size_t o = (size_t)(16 * nt + r) * 1024 + 128 * wave + 32 * ks + 8 * g; const bf16x8 bh = *(const GAS bf16x8*)(wrhi + o), bl = *(const GAS bf16x8*)(wrlo + o);
#pragma unroll
                    for (int mt = 0; mt < 2; ++mt) { acc[mt][nt] = mfma16(ahi[mt], bh, acc[mt][nt]); acc[mt][nt] = mfma16(ahi[mt], bl, acc[mt][nt]); acc[mt][nt] = mfma16(alo[mt], bh, acc[mt][nt]); } } }
            __syncthreads();
#pragma unroll
            for (int mt = 0; mt < 2; ++mt)
#pragma unroll
                for (int nt = 0; nt < 4; ++nt)
#pragma unroll
                    for (int ii = 0; ii < 4; ++ii) *(LAS float*)(lds + R_PART + ((wave * 32 + 16 * mt + 4 * g + ii) * 64 + 16 * nt + r) * 4) = acc[mt][nt][ii];
            __syncthreads();
#pragma unroll
            for (int q = 0; q < 4; ++q) { const int idx = tid + 512 * q; float s = 0.f;
#pragma unroll
                for (int w = 0; w < 8; ++w) s += *(const LAS float*)(lds + R_PART + (w * 2048 + idx) * 4);
                const float sc = sigmoidf_(s); *(LAS float*)(lds + R_SC + idx * 4) = sc; *(LAS float*)(lds + R_SEL + idx * 4) = sc + rbias[idx & 63]; }
            __syncthreads();
#pragma unroll 2
            for (int q = 0; q < 4; ++q) { const int rl = 4 * wave + q, m = 32 * u + rl;
                const float sel = *(const LAS float*)(lds + R_SEL + (rl * 64 + lane) * 4), score = *(const LAS float*)(lds + R_SC + (rl * 64 + lane) * 4);
                float m1 = sel; m1 = fmaxf(m1, __shfl_xor(m1, 1)); m1 = fmaxf(m1, __shfl_xor(m1, 2)); m1 = fmaxf(m1, __shfl_xor(m1, 4));
                const unsigned long long eq = __ballot(sel == m1) & (0xFFull << (lane & 56)); const int first = __ffsll((long long)eq) - 1;
                float m2 = (lane == first) ? -INFINITY : sel; m2 = fmaxf(m2, __shfl_xor(m2, 1)); m2 = fmaxf(m2, __shfl_xor(m2, 2)); m2 = fmaxf(m2, __shfl_xor(m2, 4));
                const float gs = m1 + m2; const int mygrp = lane >> 3; int grank = 0;
#pragma unroll
                for (int gg = 0; gg < 8; ++gg) { const float o = __shfl(gs, 8 * gg); grank += (o > gs || (o == gs && gg < mygrp)) ? 1 : 0; }
                const float msel = grank < 4 ? sel : -INFINITY; int erank = 0;
#pragma unroll
                for (int e2 = 0; e2 < 64; ++e2) { const float o = __shfl(msel, e2); erank += (o > msel || (o == msel && e2 < lane)) ? 1 : 0; }
                const bool chosen = grank < 4 && erank < 8;
                const float wsum = wave_sum(chosen ? score : 0.f);
                if (chosen && nu < 2) { const int se = lane; const unsigned lp = __hip_atomic_fetch_add((LAS unsigned*)(lds + R_CNT + se * 4), 1u, __ATOMIC_RELAXED, __HIP_MEMORY_SCOPE_WORKGROUP);
                    const int ei = ((nu * 32 + rl) * 8 + erank) * 4;
                    *(LAS int*)(lds + R_ESE + ei) = se; *(LAS int*)(lds + R_ESL + ei) = m * 8 + erank; *(LAS float*)(lds + R_EW + ei) = score / wsum * 2.5f; *(LAS unsigned*)(lds + R_ELP + ei) = lp; } }
            __syncthreads();
            if (nu == 1 || u + G >= M / 32) {
                if (tid < 64) { const unsigned c = *(LAS unsigned*)(lds + R_CNT + tid * 4); *(LAS unsigned*)(lds + R_BASE + tid * 4) = c ? __hip_atomic_fetch_add(ctl + CW_CNT + 64 * tid, c, RLX_AGENT) : 0u; }
                __syncthreads();
                for (int idx = tid; idx < (nu + 1) * 256; idx += NWAVES * 64) { const int se = *(LAS int*)(lds + R_ESE + idx * 4); const unsigned pos = *(LAS unsigned*)(lds + R_BASE + se * 4) + *(LAS unsigned*)(lds + R_ELP + idx * 4);
                    if (pos < (unsigned)CAP) { listo[(size_t)se * CAP + pos] = *(LAS int*)(lds + R_ESL + idx * 4); listwo[(size_t)se * CAP + pos] = *(LAS float*)(lds + R_EW + idx * 4); } }
                __syncthreads();
                if (tid < 64) *(LAS unsigned*)(lds + R_CNT + tid * 4) = 0u;
                __syncthreads();
                nu = -1;
            }
        }
        if (BOTH(7)) xcd_barrier(bar);
    }
    if (lo <= 10 && hi > 8) {
        if (tid < 65) { const int e = tid; unsigned c = (unsigned)M;
            if (e < 64) { c = __hip_atomic_load(ctl + CW_CNT + 64 * e, RLX_AGENT); c = c < (unsigned)CAP ? c : (unsigned)CAP; }
            tb[TB_CNT + tid] = c; }
        __syncthreads();
        if (tid == 0) { unsigned ro = 0; for (int s = 0; s < 65; ++s) { tb[TB_OFF + s] = ro; ro += tb[TB_CNT + s]; } }
        __syncthreads();
    }
#define MOE_PREFIX(lo_, hi_, NT_, perm_) do { __syncthreads(); if (tid == 0) { unsigned up = 0; for (int s = (lo_); s < (hi_); ++s) { const int sg_ = (perm_) ? (s & 1) * 65 + (s >> 1) : s; tb[TB_PRE + s] = up; up += ((tb[TB_CNT + sg_] + 255u) >> 8) * (NT_); } tb[TB_PRE + (hi_)] = up; } __syncthreads(); } while (0)
    if (IN(8)) {
#define PH_BODY do { \
        MOE_PREFIX(0, 65, 2, 0); \
        pg8::Moe1Prob P{D, 1024, pg8::MoeSched{tb, 0, 65, 2, G, vcu, 0}, (const unsigned char*)h2, (const unsigned char*)w1t, list}; \
        pg8::EpiMoe1 E{(unsigned char*)act, tb}; \
        pg8::gemm_phase_g<pg8::Moe1Prob, pg8::EpiMoe1, true>(lds, P, E); \
        if (BOTH(8)) xcd_barrier(bar); \
    } while (0)
        PH_BODY; if (REPN(8) > 1) { PH_BODY; PH_BODY; }
#undef PH_BODY
    }
    if (IN(9)) for (int rep_ = 0; rep_ < REPN(9); ++rep_) {
        MOE_PREFIX(0, 65, 4, 0);
        pg8::Moe2Prob P{DE, 256, pg8::MoeSched{tb, 0, 65, 4, G, vcu, 0}, (const unsigned char*)act, (const unsigned char*)w2t, list, listw};
        pg8::EpiMoe2 E{(unsigned char*)y0, (unsigned char*)y1, ws + WS_YS, tb};
        pg8::gemm_phase_g<pg8::Moe2Prob, pg8::EpiMoe2, true>(lds, P, E);
        if (BOTH(9)) xcd_barrier(bar);
    }
    if (IN(10)) {
        const float* fw = args.in[22]; const unsigned char* yb0 = (const unsigned char*)y0; const unsigned char* yb1 = (const unsigned char*)y1;
        typedef float f32x2_ __attribute__((ext_vector_type(2)));
        f32x4 fwr[2][2];
#pragma unroll
        for (int j = 0; j < 2; ++j)
#pragma unroll
            for (int h2_ = 0; h2_ < 2; ++h2_) fwr[j][h2_] = ((const GAS f32x4*)fw)[2 * lane + 128 * j + h2_];
#define P10_LOAD(m_, yq_, xv_, g2v_) do { const int hf_ = (m_) >= T ? 1 : 0; const GAS f32x4* xr_ = (const GAS f32x4*)(args.out + (size_t)(m_) * D); \
            const GAS v2u* yr_ = (const GAS v2u*)(hf_ ? yb1 + (size_t)((m_) - T) * 8 * D : yb0 + (size_t)(m_) * 8 * D) + lane; const GAS v2u* ysr_ = (const GAS v2u*)(ws + WS_YS + (size_t)(m_) * D) + lane; \
            const GAS f32x4* g24_ = (const GAS f32x4*)(mod + hf_ * 6144 + 5120); \
            _Pragma("unroll") for (int j = 0; j < 2; ++j) { _Pragma("unroll") for (int h2_ = 0; h2_ < 2; ++h2_) { xv_[j][h2_] = xr_[2 * lane + 128 * j + h2_]; g2v_[j][h2_] = g24_[2 * lane + 128 * j + h2_]; } \
                _Pragma("unroll") for (int k = 0; k < 8; ++k) yq_[k][j] = yr_[k * 128 + 64 * j]; yq_[8][j] = ysr_[64 * j]; } } while (0)
        v2u yqn[9][2]; f32x4 xvn[2][2], g2n[2][2];
        if (gw < M) P10_LOAD(gw, yqn, xvn, g2n);
#pragma unroll 1
        for (int m = gw; m < M; m += NGW) {
            GAS f32x4* xr = (GAS f32x4*)(args.out + (size_t)m * D);
            v2u yq[9][2]; f32x4 xv[2][2], g2v[2][2];
#pragma unroll
            for (int j = 0; j < 2; ++j) {
#pragma unroll
                for (int k = 0; k < 9; ++k) yq[k][j] = yqn[k][j];
#pragma unroll
                for (int h2_ = 0; h2_ < 2; ++h2_) { xv[j][h2_] = xvn[j][h2_]; g2v[j][h2_] = g2n[j][h2_]; } }
            if (m + NGW < M) P10_LOAD(m + NGW, yqn, xvn, g2n);
            f32x4 v[2][2]; float ss = 0.f;
#pragma unroll
            for (int j = 0; j < 2; ++j) { f32x4 s0 = {0.f, 0.f, 0.f, 0.f}, s1 = {0.f, 0.f, 0.f, 0.f};
#pragma unroll
                for (int k = 0; k < 9; ++k) { const f32x2_ a = __builtin_amdgcn_cvt_pk_f32_fp8(yq[k][j].x, false), b = __builtin_amdgcn_cvt_pk_f32_fp8(yq[k][j].x, true), c = __builtin_amdgcn_cvt_pk_f32_fp8(yq[k][j].y, false), d = __builtin_amdgcn_cvt_pk_f32_fp8(yq[k][j].y, true);
                    s0.x += a.x; s0.y += a.y; s0.z += b.x; s0.w += b.y; s1.x += c.x; s1.y += c.y; s1.z += d.x; s1.w += d.y; }
                v[j][0] = xv[j][0] + g2v[j][0] * (s0 * 0.03125f); v[j][1] = xv[j][1] + g2v[j][1] * (s1 * 0.03125f);
#pragma unroll
                for (int h2_ = 0; h2_ < 2; ++h2_) ss += (v[j][h2_].x * v[j][h2_].x + v[j][h2_].y * v[j][h2_].y) + (v[j][h2_].z * v[j][h2_].z + v[j][h2_].w * v[j][h2_].w); }
            const float rstd = rsqrtf(wave_sum(ss) * (1.f / D) + 1e-6f);
#pragma unroll
            for (int j = 0; j < 2; ++j)
#pragma unroll
                for (int h2_ = 0; h2_ < 2; ++h2_) xr[2 * lane + 128 * j + h2_] = v[j][h2_] * rstd * fwr[j][h2_];
        }
#undef P10_LOAD
    }
#undef MOE_PREFIX
#undef IN
#undef BOTH
}

static void launch_mk(Args a, int lo, int hi, int li, int grid, hipStream_t stream) {
    a.ph_lo = lo; a.ph_hi = hi; a.li = li;
    hipLaunchKernelGGL(mk_fwd, dim3(grid), dim3(NWAVES * 64), LDS_BYTES, stream, a);
}
extern "C" void kernel_launch(void* const* d_in, const int* in_sizes, int n_in, void* d_out, int out_size, void* d_ws, size_t ws_size, hipStream_t stream) {
    static int grid = 0;
    if (grid == 0) {
        int dev = 0, cus = 0;
        if (hipGetDevice(&dev) != hipSuccess || hipDeviceGetAttribute(&cus, hipDeviceAttributeMultiprocessorCount, dev) != hipSuccess) { grid = -1; return; }
        if (hipFuncSetAttribute((const void*)mk_fwd, hipFuncAttributeMaxDynamicSharedMemorySize, LDS_BYTES) != hipSuccess) { grid = -1; return; }
        grid = cus;
    }
    if (grid < 0) return;
    unsigned char* ws = (unsigned char*)d_ws; float* out = (float*)d_out;
    (void)hipMemsetAsync(ws + WS_CTL, 0, CTL_ZERO_BYTES, stream);
    Args a{};
    for (int i = 0; i < 23; ++i) a.in[i] = (const float*)d_in[i];
    a.out = out; a.ws = ws;
    launch_mk(a, 0, 11, 0, grid, stream);
}
```

```cpp
#include <hip/hip_runtime.h>
#include <cstdio>
#include <cstdint>
namespace pg8 {
#define PG8_LAS __attribute__((address_space(3)))
typedef unsigned short bf16_t;
typedef short bf16x8 __attribute__((ext_vector_type(8)));
typedef float f32x4 __attribute__((ext_vector_type(4)));
typedef unsigned u32x4 __attribute__((ext_vector_type(4)));
constexpr int BM = 256, BK = 64, HALF = 128, HTB = HALF * BK * 2  , STAGE_BYTES = 8 * HTB, NXCD = 8, WGM = 8;

__host__ __device__ __forceinline__ int lds_byte(int r, int c) { const int st = (r >> 4) * 2 + (c >> 5), rr = r & 15, cc = c & 31, ob = rr * 64 + cc * 2; return st * 1024 + (ob ^ (((ob >> 9) & 1) << 5)); }
__host__ __device__ __forceinline__ void stage_rc(int b, int& R, int& C) { const int st = b / 1024, sb = b % 1024, swz = sb ^ (((sb >> 9) & 1) << 5); R = (st >> 1) * 16 + swz / 64; C = (st & 1) * 32 + (swz % 64) / 2; }
__host__ __device__ __forceinline__ int perm32(int rho) { const int n = rho >> 4, i = rho & 15; return 8 * (i >> 2) + 4 * n + (i & 3); }

struct Unit { int pm, pn; };
struct Gemm { const bf16_t* A; const bf16_t* Bt; int M, N, K; };

struct StaticOrder {
    int nM, nN, nwg, G, c;
    __host__ __device__ void init(int M, int N, int G_, int c_) { nM = M / BM; nN = N / BM; nwg = nM * nN; G = G_; c = c_; }
    __host__ __device__ bool next(int i, Unit& u) const {
        const long L = (long)i * G + c; if (L >= nwg) return false;
        int wgid = (int)L; { const int q = nwg / NXCD, r = nwg % NXCD, xcd = wgid % NXCD, off = wgid / NXCD; wgid = (xcd < r ? xcd * (q + 1) : r * (q + 1) + (xcd - r) * q) + off; }
        const int nig = WGM * nN, gid = wgid / nig, fm = gid * WGM, gsz = (nM - fm) < WGM ? (nM - fm) : WGM;
        u.pm = fm + ((wgid % nig) % gsz); u.pn = (wgid % nig) / gsz; return true;
    }
    __device__ __forceinline__ void a_ready(const Unit&) const {}
    __device__ __forceinline__ void done(const Unit&) const {}
};
__device__ __forceinline__ unsigned cvt_pk_bf16(float lo, float hi) { unsigned r; asm volatile("v_cvt_pk_bf16_f32 %0, %1, %2" : "=v"(r) : "v"(lo), "v"(hi)); return r; }
template <class Epi, class Sched, bool ALIGN_EPI = false, bool SP2 = false>
__device__ __forceinline__ void gemm_phase(PG8_LAS unsigned char* lds, const Gemm g, const Sched& S, const Epi& E) {
    const int tid = threadIdx.x, wid = __builtin_amdgcn_readfirstlane(tid >> 6), lane = tid & 63, wr = wid >> 2, wc = wid & 3, fr = lane & 15, fq = lane >> 4;
    const int K = g.K, nt = K / BK;
    unsigned voffA[2], voffB[2];
#pragma unroll
    for (int i = 0; i < 2; ++i) { int R, C; stage_rc(tid * 16 + i * 8192, R, C); const int Rb = Epi::PERM ? ((R & ~31) + perm32(R & 31)) : R;
        voffA[i] = (unsigned)(R * K + C) * 2u; voffB[i] = (unsigned)(Rb * K + C) * 2u; }
    const size_t kstep = (size_t)(BK * 2);
    const size_t hstep = (size_t)HALF * K * 2;
    const size_t tstep = 2 * hstep;
    const unsigned ldsw = (unsigned)wid * 1024u;
    const int aoff = lds_byte(wr * 64 + fr, fq * 8), boff = lds_byte(wc * 32 + fr, fq * 8);
#define PG8_SA(b, h) (((b) * 2 + (h)) * HTB)
#define PG8_SB(b, h) ((4 + (b) * 2 + (h)) * HTB)
#define PG8_STAGE(bufoff, gbase, voff) do { _Pragma("unroll") for (int _i = 0; _i < 2; ++_i) \
        __builtin_amdgcn_global_load_lds((const unsigned*)((const char*)(gbase) + (voff)[_i]), (PG8_LAS unsigned*)(lds + (bufoff) + ldsw + _i * 8192), 16, 0, 0); } while (0)
#define PG8_LDA(dst, b, h) do { _Pragma("unroll") for (int m = 0; m < 4; ++m) _Pragma("unroll") for (int k = 0; k < 2; ++k) dst[m][k] = *(const PG8_LAS bf16x8*)(lds + PG8_SA(b, h) + aoff + m * 2048 + k * 1024); } while (0)
#define PG8_LDB(dst, b, h) do { _Pragma("unroll") for (int n = 0; n < 2; ++n) _Pragma("unroll") for (int k = 0; k < 2; ++k) dst[n][k] = *(const PG8_LAS bf16x8*)(lds + PG8_SB(b, h) + boff + n * 2048 + k * 1024); } while (0)
#define PG8_MMA(ai, bj, At, Bt) do { __builtin_amdgcn_s_setprio(1); _Pragma("unroll") for (int m = 0; m < 4; ++m) _Pragma("unroll") for (int n = 0; n < 2; ++n) _Pragma("unroll") for (int k = 0; k < 2; ++k) \
        acc[ai][bj][m][n] = __builtin_amdgcn_mfma_f32_16x16x32_bf16(Bt[n][k], At[m][k], acc[ai][bj][m][n], 0, 0, 0); __builtin_amdgcn_s_setprio(0); } while (0)
#define PG8_WAIT_V(n) asm volatile("s_waitcnt vmcnt(" #n ")" ::: "memory")
#define PG8_WAIT_L(n) asm volatile("s_waitcnt lgkmcnt(" #n ")" ::: "memory")
#define PG8_BAR __builtin_amdgcn_s_barrier()
#define PG8_SCHED __builtin_amdgcn_sched_barrier(0)
    Unit cur, nxt; int ui = 0;
    if (!S.next(0, cur)) return;
    f32x4 acc[2][2][4][2];
#pragma unroll
    for (int a = 0; a < 2; ++a)
#pragma unroll
        for (int b = 0; b < 2; ++b)
#pragma unroll
            for (int m = 0; m < 4; ++m)
#pragma unroll
                for (int n = 0; n < 2; ++n) acc[a][b][m][n] = (f32x4){0.f, 0.f, 0.f, 0.f};
    bf16x8 At[4][2], B0[2][2], B1[2][2];
    const char* cA = (const char*)g.A + (size_t)cur.pm * tstep; const char* cB = (const char*)g.Bt + (size_t)cur.pn * tstep;
    S.a_ready(cur);
    if constexpr (SP2) {
        PG8_STAGE(PG8_SB(0, 0), cB, voffB); PG8_STAGE(PG8_SB(0, 1), cB + hstep, voffB); PG8_STAGE(PG8_SA(0, 0), cA, voffA); PG8_STAGE(PG8_SA(0, 1), cA + hstep, voffA);
        if (wr == 1) PG8_BAR;
        PG8_WAIT_V(2); PG8_BAR;
        PG8_STAGE(PG8_SB(1, 0), cB + kstep, voffB); PG8_STAGE(PG8_SA(1, 0), cA + kstep, voffA); PG8_STAGE(PG8_SB(1, 1), cB + hstep + kstep, voffB);
        PG8_WAIT_V(6); PG8_BAR;
    } else {
        PG8_STAGE(PG8_SB(0, 0), cB, voffB); PG8_STAGE(PG8_SA(0, 0), cA, voffA); PG8_STAGE(PG8_SB(0, 1), cB + hstep, voffB); PG8_STAGE(PG8_SA(0, 1), cA + hstep, voffA);
        if (wr == 1) PG8_BAR;
        PG8_WAIT_V(4); PG8_BAR;
        PG8_STAGE(PG8_SB(1, 0), cB + kstep, voffB); PG8_STAGE(PG8_SA(1, 0), cA + kstep, voffA); PG8_STAGE(PG8_SB(1, 1), cB + hstep + kstep, voffB);
        PG8_WAIT_V(6); PG8_BAR;
    }
    for (;;) {
        const bool has_next = S.next(ui + 1, nxt);
        const char* nA = has_next ? (const char*)g.A + (size_t)nxt.pm * tstep : cA; const char* nB = has_next ? (const char*)g.Bt + (size_t)nxt.pn * tstep : cB;
        for (int t = 0; t < nt; t += 2) {
            const bool last = (t == nt - 2);
            const char* a1 = cA + (size_t)(t + 1) * kstep;
            const char* a2 = last ? nA : cA + (size_t)(t + 2) * kstep; const char* b2 = last ? nB : cB + (size_t)(t + 2) * kstep;
            const char* a3 = a2 + kstep; const char* b3 = b2 + kstep;
            if (last && has_next) S.a_ready(nxt);
            if constexpr (SP2) {
            PG8_LDB(B0, 0, 0); PG8_LDB(B1, 0, 1); PG8_SCHED; PG8_LDA(At, 0, 0); PG8_STAGE(PG8_SA(1, 1), a1 + hstep, voffA);
            PG8_WAIT_V(8); PG8_WAIT_L(0); PG8_BAR; PG8_MMA(0, 0, At, B0); PG8_MMA(0, 1, At, B1); PG8_BAR; PG8_SCHED;
            PG8_LDA(At, 0, 1); PG8_STAGE(PG8_SB(0, 0), b2, voffB); PG8_STAGE(PG8_SB(0, 1), b2 + hstep, voffB); PG8_STAGE(PG8_SA(0, 0), a2, voffA);
            PG8_WAIT_V(8); PG8_WAIT_L(0); PG8_BAR; PG8_MMA(1, 0, At, B0); PG8_MMA(1, 1, At, B1); PG8_BAR; PG8_SCHED;
            PG8_LDB(B0, 1, 0); PG8_LDB(B1, 1, 1); PG8_SCHED; PG8_LDA(At, 1, 0); PG8_STAGE(PG8_SA(0, 1), a2 + hstep, voffA);
            PG8_WAIT_V(8); PG8_WAIT_L(0); PG8_BAR; PG8_MMA(0, 0, At, B0); PG8_MMA(0, 1, At, B1); PG8_BAR; PG8_SCHED;
            PG8_LDA(At, 1, 1); PG8_STAGE(PG8_SB(1, 0), b3, voffB); PG8_STAGE(PG8_SB(1, 1), b3 + hstep, voffB); PG8_STAGE(PG8_SA(1, 0), a3, voffA);
            PG8_WAIT_V(8); PG8_WAIT_L(0); PG8_BAR; PG8_MMA(1, 0, At, B0); PG8_MMA(1, 1, At, B1); PG8_BAR; PG8_SCHED;
            } else {
            PG8_LDB(B0, 0, 0); PG8_SCHED; PG8_LDA(At, 0, 0); PG8_STAGE(PG8_SA(1, 1), a1 + hstep, voffA);
            PG8_WAIT_L(8); PG8_BAR; PG8_WAIT_L(0); PG8_MMA(0, 0, At, B0); PG8_BAR; PG8_SCHED;
            PG8_LDB(B1, 0, 1); PG8_STAGE(PG8_SB(0, 0), b2, voffB);
            PG8_BAR; PG8_WAIT_L(0); PG8_MMA(0, 1, At, B1); PG8_BAR;
            PG8_LDA(At, 0, 1); PG8_STAGE(PG8_SA(0, 0), a2, voffA);
            PG8_BAR; PG8_WAIT_L(0); PG8_MMA(1, 0, At, B0); PG8_BAR; PG8_SCHED;
            PG8_STAGE(PG8_SB(0, 1), b2 + hstep, voffB);
            PG8_WAIT_V(6); PG8_BAR; PG8_MMA(1, 1, At, B1); PG8_BAR;
            PG8_LDB(B0, 1, 0); PG8_SCHED; PG8_LDA(At, 1, 0); PG8_STAGE(PG8_SA(0, 1), a2 + hstep, voffA);
            PG8_WAIT_L(8); PG8_BAR; PG8_WAIT_L(0); PG8_MMA(0, 0, At, B0); PG8_BAR; PG8_SCHED;
            PG8_LDB(B1, 1, 1); PG8_STAGE(PG8_SB(1, 0), b3, voffB);
            PG8_BAR; PG8_WAIT_L(0); PG8_MMA(0, 1, At, B1); PG8_BAR;
            PG8_LDA(At, 1, 1); PG8_STAGE(PG8_SA(1, 0), a3, voffA);
            PG8_BAR; PG8_WAIT_L(0); PG8_MMA(1, 0, At, B0); PG8_BAR; PG8_SCHED;
            PG8_STAGE(PG8_SB(1, 1), b3 + hstep, voffB);
            PG8_WAIT_V(6); PG8_BAR; PG8_MMA(1, 1, At, B1); PG8_BAR;
            }
        }
        if constexpr (ALIGN_EPI) { if (wr == 0) PG8_BAR; }
        if constexpr (!Epi::AFTER_DRAIN) { E(acc, cur, wr, wc, fr, fq); S.done(cur); }
        if (!has_next) break;
#pragma unroll
        for (int a = 0; a < 2; ++a)
#pragma unroll
            for (int b = 0; b < 2; ++b)
#pragma unroll
                for (int m = 0; m < 4; ++m)
#pragma unroll
                    for (int n = 0; n < 2; ++n) acc[a][b][m][n] = (f32x4){0.f, 0.f, 0.f, 0.f};
        cur = nxt; cA = nA; cB = nB; ++ui;
        if constexpr (ALIGN_EPI) { if (wr == 1) PG8_BAR; }
    }
    PG8_WAIT_V(0);
    if constexpr (!ALIGN_EPI) { if (wr == 0) PG8_BAR; }
    PG8_BAR;
    if constexpr (Epi::AFTER_DRAIN) { E.fused(acc, cur, wr, wc, fr, fq, lds, wid, lane); S.done(cur); }
#undef PG8_SA
#undef PG8_SB
#undef PG8_STAGE
#undef PG8_LDA
#undef PG8_LDB
#undef PG8_MMA
#undef PG8_WAIT_V
#undef PG8_WAIT_L
#undef PG8_BAR
#undef PG8_SCHED
}
}
#define GAS __attribute__((address_space(1)))
#define LAS __attribute__((address_space(3)))
typedef unsigned short bf16;
typedef unsigned v4u __attribute__((ext_vector_type(4)));
typedef float f32x4 __attribute__((ext_vector_type(4)));
typedef short bf16x8 __attribute__((ext_vector_type(8)));
typedef GAS unsigned gu32;
typedef GAS unsigned long long gu64;
#define RLX_AGENT __ATOMIC_RELAXED, __HIP_MEMORY_SCOPE_AGENT
#define LDS_WAIT() asm volatile("s_waitcnt lgkmcnt(0)" ::: "memory")
#define VM_WAIT() asm volatile("s_waitcnt vmcnt(0)" ::: "memory")
__device__ __forceinline__ unsigned long long rt() { return __builtin_amdgcn_s_memrealtime(); }
__device__ __forceinline__ unsigned f2bf(float f) { unsigned u = __builtin_bit_cast(unsigned, f); return (u + 0x7fffu + ((u >> 16) & 1u)) >> 16; }
__device__ __forceinline__ unsigned pk2(float lo, float hi) { return f2bf(lo) | (f2bf(hi) << 16); }
#define XB_TMO      128
#define XB_XCNT(j)  (256  + 64 * (j))
#define XB_XSUB(j)  (1280 + 64 * (j))
#define XB_XGEN(j)  (2304 + 64 * (j))
#define XB_TOP      3328
#define XB_TOPGEN   3392
#define XCD_BAR_WORDS 3456
#define XB_SPIN_CAP (1u << 18)

__device__ __forceinline__ unsigned xb_ld(unsigned* p)              { return __hip_atomic_load(p, __ATOMIC_RELAXED, __HIP_MEMORY_SCOPE_AGENT); }
__device__ __forceinline__ unsigned xb_add(unsigned* p, unsigned v) { return __hip_atomic_fetch_add(p, v, __ATOMIC_RELAXED, __HIP_MEMORY_SCOPE_AGENT); }
__device__ __forceinline__ unsigned xb_xcc_id() { return (unsigned)__builtin_amdgcn_s_getreg((3 << 11) | 20) & 0xFu; }
#define XB_SPIN(cond, bar) do { unsigned _sp = 0; while (cond) { __builtin_amdgcn_s_sleep(1); \
    if ((++_sp & 255u) == 0u) { if (xb_ld(&(bar)[XB_TMO])) break; if (_sp > XB_SPIN_CAP) { atomicAdd(&(bar)[XB_TMO], 1u); break; } } } } while (0)

struct XcdBarrier {
    unsigned* bar; unsigned x;
    volatile LAS unsigned* st;
};

__device__ __forceinline__ XcdBarrier xcd_barrier_post(unsigned* bar, volatile LAS unsigned* st) {
    XcdBarrier b; b.bar = bar; b.x = xb_xcc_id(); b.st = st;
    if (threadIdx.x == 0) (void)xb_add(&bar[XB_XCNT(b.x)], 1u);
    return b;
}
__device__ __forceinline__ void xcd_barrier_complete(unsigned* bar, unsigned x, unsigned& nloc, unsigned& nx) {
    const unsigned G = gridDim.x * gridDim.y * gridDim.z;
    unsigned sum, cnt, mine, sp = 0u;
    for (;;) {
        sum = 0u; cnt = 0u; mine = 0u;
#pragma unroll
        for (unsigned j = 0; j < 16; ++j) { const unsigned c = xb_ld(&bar[XB_XCNT(j)]); sum += c; cnt += (c > 0u) ? 1u : 0u; mine = (j == x) ? c : mine; }
        if (sum == G) break;
        __builtin_amdgcn_s_sleep(1);
        if ((++sp & 255u) == 0u) { if (xb_ld(&bar[XB_TMO])) break; if (sp > XB_SPIN_CAP) { atomicAdd(&bar[XB_TMO], 1u); break; } }
    }
    nloc = mine > 0u ? mine : 1u; nx = cnt > 0u ? cnt : 1u;
}

__device__ __forceinline__ void xcd_barrier(const XcdBarrier& b) {
    asm volatile("s_waitcnt vmcnt(0)" ::: "memory");
    __syncthreads();
    if (threadIdx.x == 0) {
        unsigned* bar = b.bar;
        __builtin_amdgcn_s_waitcnt(0);
        unsigned nloc = b.st[0], nx = b.st[1];
        if (nloc == 0u) { xcd_barrier_complete(bar, b.x, nloc, nx); b.st[0] = nloc; b.st[1] = nx; }
        const unsigned old = xb_add(&bar[XB_XSUB(b.x)], 1u);
        const unsigned gen = old / nloc;
        if (old + 1u == (gen + 1u) * nloc) {
            __builtin_amdgcn_fence(__ATOMIC_RELEASE, "agent");
            asm volatile("s_waitcnt vmcnt(0)" ::: "memory");
            const unsigned og = xb_add(&bar[XB_TOP], 1u);
            const unsigned tg = og / nx;
            if (og + 1u == (tg + 1u) * nx) xb_add(&bar[XB_TOPGEN], 1u);
            else XB_SPIN(xb_ld(&bar[XB_TOPGEN]) == tg, bar);
            __builtin_amdgcn_fence(__ATOMIC_ACQUIRE, "agent");
            xb_add(&bar[XB_XGEN(b.x)], 1u);
            asm volatile("s_waitcnt vmcnt(0)" ::: "memory");
        } else {
            XB_SPIN(xb_ld(&bar[XB_XGEN(b.x)]) == gen, bar);
            __builtin_amdgcn_fence(__ATOMIC_ACQUIRE, "agent");
            asm volatile("s_waitcnt vmcnt(0)" ::: "memory");
        }
    }
    __syncthreads();
}

namespace pg8 {
struct UnitG { int seg, mt, nt; };
template <class Prob, class Epi, bool FP8 = false>
__device__ __forceinline__ void gemm_phase_g(PG8_LAS unsigned char* lds, const Prob& P, const Epi& E) {
    const int tid = threadIdx.x, wid = __builtin_amdgcn_readfirstlane(tid >> 6), lane = tid & 63, wr = wid >> 2, wc = wid & 3, fr = lane & 15, fq = lane >> 4;
    constexpr int EB = FP8 ? 1 : 2;
    const int K = P.K, nt = K * EB / 128;
    unsigned voffB[2], cbA[2];
#pragma unroll
    for (int i = 0; i < 2; ++i) { int R, C; stage_rc(tid * 16 + i * 8192, R, C); const int Rb = Epi::PERM ? ((R & ~31) + perm32(R & 31)) : R; voffB[i] = (unsigned)(Rb * K * EB + C * 2); cbA[i] = (unsigned)(C * 2); }
    const unsigned pitchA = (unsigned)P.pitchA;
    const size_t kstep = (size_t)(BK * 2);
    const size_t hstep = (size_t)HALF * K * EB;
    const unsigned ldsw = (unsigned)wid * 1024u;
    const int aoff = lds_byte(wr * 64 + fr, fq * 8), boff = lds_byte(wc * 32 + fr, fq * 8);
#define PG8_SA(b, h) (((b) * 2 + (h)) * HTB)
#define PG8_SB(b, h) ((4 + (b) * 2 + (h)) * HTB)
#define PG8_STAGE(bufoff, gbase, voff) do { _Pragma("unroll") for (int _i = 0; _i < 2; ++_i) \
        __builtin_amdgcn_global_load_lds((const unsigned*)((const char*)(gbase) + (voff)[_i]), (PG8_LAS unsigned*)(lds + (bufoff) + ldsw + _i * 8192), 16, 0, 0); } while (0)
#define PG8_STAGE_A(bufoff, gbase, rp_) do { const unsigned o0_ = ((rp_) & 0xffffu) * pitchA + cbA[0], o1_ = ((rp_) >> 16) * pitchA + cbA[1]; \
        __builtin_amdgcn_global_load_lds((const unsigned*)((const char*)(gbase) + o0_), (PG8_LAS unsigned*)(lds + (bufoff) + ldsw), 16, 0, 0); \
        __builtin_amdgcn_global_load_lds((const unsigned*)((const char*)(gbase) + o1_), (PG8_LAS unsigned*)(lds + (bufoff) + ldsw + 8192), 16, 0, 0); } while (0)
#define PG8_LDA(dst, b, h) do { _Pragma("unroll") for (int m = 0; m < 4; ++m) { const v4i_ lo_ = *(const PG8_LAS v4i_*)(lds + PG8_SA(b, h) + aoff + m * 2048), hi_ = *(const PG8_LAS v4i_*)(lds + PG8_SA(b, h) + aoff + m * 2048 + 1024); dst[m] = __builtin_shufflevector(lo_, hi_, 0, 1, 2, 3, 4, 5, 6, 7); } } while (0)
#define PG8_LDB(dst, b, h) do { _Pragma("unroll") for (int n = 0; n < 2; ++n) { const v4i_ lo_ = *(const PG8_LAS v4i_*)(lds + PG8_SB(b, h) + boff + n * 2048), hi_ = *(const PG8_LAS v4i_*)(lds + PG8_SB(b, h) + boff + n * 2048 + 1024); dst[n] = __builtin_shufflevector(lo_, hi_, 0, 1, 2, 3, 4, 5, 6, 7); } } while (0)
#define PG8_HALF(v_, k_) __builtin_bit_cast(bf16x8, (v4i_)__builtin_shufflevector(v_, v_, 4 * (k_), 4 * (k_) + 1, 4 * (k_) + 2, 4 * (k_) + 3))
#define PG8_MMA(ai, bj, At, Bt) do { __builtin_amdgcn_s_setprio(1); _Pragma("unroll") for (int m = 0; m < 4; ++m) _Pragma("unroll") for (int n = 0; n < 2; ++n) { \
        acc[ai][bj][m][n] = __builtin_amdgcn_mfma_f32_16x16x32_bf16(PG8_HALF(Bt[n], 0), PG8_HALF(At[m], 0), acc[ai][bj][m][n], 0, 0, 0); \
        acc[ai][bj][m][n] = __builtin_amdgcn_mfma_f32_16x16x32_bf16(PG8_HALF(Bt[n], 1), PG8_HALF(At[m], 1), acc[ai][bj][m][n], 0, 0, 0); } __builtin_amdgcn_s_setprio(0); } while (0)
#define PG8_Q(v_, q_) __builtin_bit_cast(long, (v2i_){v_[2 * (q_)], v_[2 * (q_) + 1]})
#define PG8_MMA8Q(ai, bj, At, Bt, q_) _Pragma("unroll") for (int m = 0; m < 4; ++m) _Pragma("unroll") for (int n = 0; n < 2; ++n) \
            acc[ai][bj][m][n] = __builtin_amdgcn_mfma_f32_16x16x32_fp8_fp8(PG8_Q(Bt[n], q_), PG8_Q(At[m], q_), acc[ai][bj][m][n], 0, 0, 0)
#define PG8_MMA8(ai, bj, At, Bt) do { typedef int v2i_ __attribute__((ext_vector_type(2))); __builtin_amdgcn_s_setprio(1); \
        PG8_MMA8Q(ai, bj, At, Bt, 0); PG8_MMA8Q(ai, bj, At, Bt, 1); PG8_MMA8Q(ai, bj, At, Bt, 2); PG8_MMA8Q(ai, bj, At, Bt, 3); \
        __builtin_amdgcn_s_setprio(0); } while (0)
#define PG8_MM(ai, bj, At, Bt) do { if constexpr (FP8) PG8_MMA8(ai, bj, At, Bt); else PG8_MMA(ai, bj, At, Bt); } while (0)
#define PG8_WAIT_V(n) asm volatile("s_waitcnt vmcnt(" #n ")" ::: "memory")
#define PG8_WAIT_L(n) asm volatile("s_waitcnt lgkmcnt(" #n ")" ::: "memory")
#define PG8_BAR __builtin_amdgcn_s_barrier()
#define PG8_SCHED __builtin_amdgcn_sched_barrier(0)
    UnitG cur, nxt; int ui = 0;
    if (!P.next(0, cur)) return;
    f32x4 acc[2][2][4][2];
#pragma unroll
    for (int a = 0; a < 2; ++a)
#pragma unroll
        for (int b = 0; b < 2; ++b)
#pragma unroll
            for (int m = 0; m < 4; ++m)
#pragma unroll
                for (int n = 0; n < 2; ++n) acc[a][b][m][n] = (f32x4){0.f, 0.f, 0.f, 0.f};
    typedef int v4i_ __attribute__((ext_vector_type(4))); typedef int v8i_ __attribute__((ext_vector_type(8)));
    v8i_ At[4], B0[2], B1[2];
    unsigned rowp[2], rowpn[2];
    const char* cA; const char* cB;
    P.setup_base(cur, cA, cB);
    P.meta(cur, lds, 0, wid, lane);
    P.rows_first(cur, lds, 0, rowp);
    PG8_STAGE(PG8_SB(0, 0), cB, voffB); PG8_STAGE(PG8_SB(0, 1), cB + hstep, voffB); PG8_STAGE_A(PG8_SA(0, 0), cA, rowp[0]); PG8_STAGE_A(PG8_SA(0, 1), cA, rowp[1]);
    if (wr == 1) PG8_BAR;
    PG8_WAIT_V(2); PG8_BAR;
    PG8_STAGE(PG8_SB(1, 0), cB + kstep, voffB); PG8_STAGE_A(PG8_SA(1, 0), cA + kstep, rowp[0]); PG8_STAGE(PG8_SB(1, 1), cB + hstep + kstep, voffB);
    PG8_WAIT_V(6); PG8_BAR;
    for (;;) {
        const bool has_next = P.next(ui + 1, nxt);
        const char* nA = cA; const char* nB = cB;
        rowpn[0] = rowp[0]; rowpn[1] = rowp[1];
        if (has_next) { P.setup_base(nxt, nA, nB); P.meta(nxt, lds, (ui + 1) % 3, wid, lane); }
        for (int t = 0; t < nt; t += 2) {
            const bool last = (t == nt - 2);
            const char* a1 = cA + (size_t)(t + 1) * kstep;
            const char* a2 = last ? nA : cA + (size_t)(t + 2) * kstep; const char* b2 = last ? nB : cB + (size_t)(t + 2) * kstep;
            const char* a3 = a2 + kstep; const char* b3 = b2 + kstep;
            if (last && has_next) P.rows(nxt, lds, (ui + 1) % 3, rowpn);
            const unsigned o2_0 = last ? rowpn[0] : rowp[0], o2_1 = last ? rowpn[1] : rowp[1];
            PG8_LDB(B0, 0, 0); PG8_LDB(B1, 0, 1); PG8_SCHED; PG8_LDA(At, 0, 0); PG8_STAGE_A(PG8_SA(1, 1), a1, rowp[1]);
            PG8_WAIT_V(8); PG8_WAIT_L(0); PG8_BAR; PG8_MM(0, 0, At, B0); PG8_MM(0, 1, At, B1); PG8_BAR; PG8_SCHED;
            PG8_LDA(At, 0, 1); PG8_STAGE(PG8_SB(0, 0), b2, voffB); PG8_STAGE(PG8_SB(0, 1), b2 + hstep, voffB); PG8_STAGE_A(PG8_SA(0, 0), a2, o2_0);
            PG8_WAIT_V(8); PG8_WAIT_L(0); PG8_BAR; PG8_MM(1, 0, At, B0); PG8_MM(1, 1, At, B1); PG8_BAR; PG8_SCHED;
            PG8_LDB(B0, 1, 0); PG8_LDB(B1, 1, 1); PG8_SCHED; PG8_LDA(At, 1, 0); PG8_STAGE_A(PG8_SA(0, 1), a2, o2_1);
            PG8_WAIT_V(8); PG8_WAIT_L(0); PG8_BAR; PG8_MM(0, 0, At, B0); PG8_MM(0, 1, At, B1); PG8_BAR; PG8_SCHED;
            PG8_LDA(At, 1, 1); PG8_STAGE(PG8_SB(1, 0), b3, voffB); PG8_STAGE(PG8_SB(1, 1), b3 + hstep, voffB); PG8_STAGE_A(PG8_SA(1, 0), a3, o2_0);
            PG8_WAIT_V(8); PG8_WAIT_L(0); PG8_BAR; PG8_MM(1, 0, At, B0); PG8_MM(1, 1, At, B1); PG8_BAR; PG8_SCHED;
        }
        if (wr == 0) PG8_BAR;
        E(acc, cur, wr, wc, fr, fq, lds, ui % 3);
        if (!has_next) break;
#pragma unroll
        for (int a = 0; a < 2; ++a)
#pragma unroll
            for (int b = 0; b < 2; ++b)
#pragma unroll
                for (int m = 0; m < 4; ++m)
#pragma unroll
                    for (int n = 0; n < 2; ++n) acc[a][b][m][n] = (f32x4){0.f, 0.f, 0.f, 0.f};
        cur = nxt; cA = nA; cB = nB; ++ui;
        rowp[0] = rowpn[0]; rowp[1] = rowpn[1];
        if (wr == 1) PG8_BAR;
    }
    PG8_WAIT_V(0);
    PG8_BAR;
#undef PG8_SA
#undef PG8_SB
#undef PG8_STAGE
#undef PG8_STAGE_A
#undef PG8_LDA
#undef PG8_LDB
#undef PG8_MMA
#undef PG8_MMA8
#undef PG8_Q
#undef PG8_MMA8Q
#undef PG8_HALF
#undef PG8_MM
#undef PG8_WAIT_V
#undef PG8_WAIT_L
#undef PG8_BAR
#undef PG8_SCHED
}
}

constexpr int NWAVES = 8;
constexpr int BATCH = 2, T = 8192, D = 1024, M = BATCH * T, DIN = 4104, PA = 3072;
constexpr int NE = 64, NEX = 65, DE = 256;
constexpr size_t MiB = 1u << 20;
constexpr size_t WS_CTL = 0, CTL_ZERO_BYTES = 256 * 1024;
constexpr size_t WS_WRHI = 512 * 1024, WS_WRLO = 640 * 1024;
constexpr size_t WS_MOD = 1 * MiB, WS_WAB = 1 * MiB + 256 * 1024, WS_AB = 1 * MiB + 512 * 1024;
constexpr size_t WS_WOUT_T = 2 * MiB, WS_WIN_T = 4 * MiB, WS_H1 = 12 * MiB, WS_PROJA = 44 * MiB, WS_GATES = 142 * MiB;
constexpr size_t WS_QP = 4 * MiB, WS_OI = 20 * MiB, WS_AH = 36 * MiB, WS_GL = 36 * MiB + 512 * 1024, WS_PG = 174 * MiB, WS_BG = 206 * MiB, WS_BH = 238 * MiB, WS_QE = 270 * MiB, WS_OIH = 286 * MiB;
constexpr size_t WS_OMIX = 174 * MiB;
constexpr size_t WS_H2 = 12 * MiB, WS_W1T = 44 * MiB, WS_W2T = 109 * MiB, WS_ACT = 142 * MiB, WS_LIST = 215 * MiB, WS_LISTW = 217 * MiB, WS_Y0 = 12 * MiB, WS_Y1 = 219 * MiB;
constexpr size_t WS_YS = 80 * MiB;
constexpr size_t WS_TOP = 302 * MiB;
constexpr int CAP = 8192;
constexpr int TB_PRE = 0, TB_CNT = 132, TB_OFF = 264;
constexpr int CW_CNT = 16384;
constexpr int CW_BAR = 4096;
constexpr int RING_BYTES = 131072, LDS_BYTES = 163840, LDSCTL_OFF = LDS_BYTES - 1024, MISC_OFF = LDSCTL_OFF + 320, SCR2_OFF = LDS_BYTES - 3072;

__device__ __forceinline__ float bf2f(bf16 v) { return __uint_as_float(((unsigned)v) << 16); }
__device__ __forceinline__ float sigmoidf_(float x) { return 1.f / (1.f + __expf(-x)); }
__device__ __forceinline__ float siluf_(float x) { return x / (1.f + __expf(-x)); }
__device__ __forceinline__ float softplusf_(float x) { return x > 20.f ? x : log1pf(expf(x)); }
__device__ __forceinline__ float c8(float x) { return __builtin_amdgcn_fmed3f(x, -448.f, 448.f); }
__device__ __forceinline__ float wave_sum(float v) {
#pragma unroll
    for (int o = 1; o < 64; o <<= 1) v += __shfl_xor(v, o);
    return v;
}

namespace pg8 {
struct EpiProj {
    static constexpr bool PERM = true, AFTER_DRAIN = false;
    bf16_t* projA; bf16_t* gates;
    __device__ __forceinline__ void operator()(const f32x4 (&acc)[2][2][4][2], const Unit& u, int wr, int wc, int fr, int fq) const {
        const int row0 = u.pm * BM + wr * 64 + fr;
        bf16_t* base; int ldc, colt;
        if (u.pn < 12) { base = projA; ldc = 3072; colt = u.pn * BM; } else { base = gates; ldc = 1024; colt = (u.pn - 12) * BM; }
        const int col0 = colt + wc * 32 + 8 * fq;
#pragma unroll
        for (int ai = 0; ai < 2; ++ai)
#pragma unroll
            for (int m = 0; m < 4; ++m) { bf16_t* rowp = base + (size_t)(row0 + ai * HALF + m * 16) * ldc + col0;
#pragma unroll
                for (int bj = 0; bj < 2; ++bj) { const f32x4 v0 = acc[ai][bj][m][0], v1 = acc[ai][bj][m][1];
                    u32x4 w; w.x = cvt_pk_bf16(v0[0], v0[1]); w.y = cvt_pk_bf16(v0[2], v0[3]); w.z = cvt_pk_bf16(v1[0], v1[1]); w.w = cvt_pk_bf16(v1[2], v1[3]);
                    *(u32x4*)(rowp + bj * HALF) = w; } }
    }
};
struct EpiResid {
    static constexpr bool PERM = false, AFTER_DRAIN = false;
    const float* x; const float* mod; float* out;
    __device__ __forceinline__ void operator()(const f32x4 (&acc)[2][2][4][2], const Unit& u, int wr, int wc, int fr, int fq) const {
        const int col0 = u.pn * BM + wc * 32 + 4 * fq;
        const float* g1 = mod + (u.pm * BM >= 8192 ? 6144 : 0) + 2048;
        f32x4 gv[2][2];
#pragma unroll
        for (int bj = 0; bj < 2; ++bj)
#pragma unroll
            for (int n = 0; n < 2; ++n) gv[bj][n] = *(const f32x4*)(g1 + col0 + bj * HALF + n * 16);
#pragma unroll
        for (int ai = 0; ai < 2; ++ai)
#pragma unroll
            for (int mp = 0; mp < 4; mp += 2) { f32x4 xv[2][2][2];
#pragma unroll
                for (int q = 0; q < 2; ++q) { const size_t off = (size_t)(u.pm * BM + ai * HALF + wr * 64 + (mp + q) * 16 + fr) * 1024 + col0;
#pragma unroll
                    for (int bj = 0; bj < 2; ++bj)
#pragma unroll
                        for (int n = 0; n < 2; ++n) xv[q][bj][n] = *(const f32x4*)(x + off + bj * HALF + n * 16); }
#pragma unroll
                for (int q = 0; q < 2; ++q) { const size_t off = (size_t)(u.pm * BM + ai * HALF + wr * 64 + (mp + q) * 16 + fr) * 1024 + col0;
#pragma unroll
                    for (int bj = 0; bj < 2; ++bj)
#pragma unroll
                        for (int n = 0; n < 2; ++n) *(f32x4*)(out + off + bj * HALF + n * 16) = xv[q][bj][n] + gv[bj][n] * acc[ai][bj][mp + q][n]; }
            }
    }
};

struct MoeSched {
    const LAS unsigned* tb; int lo, hi, NT, G, c; int perm;
    __device__ __forceinline__ int segof(int p) const { return perm ? (p & 1) * 65 + (p >> 1) : p; }
    __device__ __forceinline__ bool next(int i, UnitG& u) const {
        const unsigned L = (unsigned)(i * G + c); if (L >= tb[TB_PRE + hi]) return false;
        int s = lo; { int hi_ = hi; while (hi_ - s > 1) { const int mid = (s + hi_) >> 1; if (L >= tb[TB_PRE + mid]) s = mid; else hi_ = mid; } }
        const int sg = segof(s);
        const unsigned loc = L - tb[TB_PRE + s], tiles = (tb[TB_CNT + sg] + 255u) >> 8;
        u.seg = __builtin_amdgcn_readfirstlane(sg); u.mt = __builtin_amdgcn_readfirstlane((int)(loc % tiles)); u.nt = __builtin_amdgcn_readfirstlane((int)(loc / tiles)); return true;
    }
};
struct Moe1Prob {
    int K; int pitchA; MoeSched S; const unsigned char* h2; const unsigned char* w1t; const int* list;
    __device__ __forceinline__ bool next(int i, UnitG& u) const { return S.next(i, u); }
    __device__ __forceinline__ void setup_base(const UnitG& u, const char*& cA, const char*& cB) const { cA = (const char*)h2; cB = (const char*)(w1t + ((size_t)u.seg * 512 + (size_t)u.nt * 256) * 1024); }
    __device__ __forceinline__ void meta(const UnitG& u, PG8_LAS unsigned char* lds, int slot, int wid, int lane) const {
        if (wid == 0 && u.seg < 64) __builtin_amdgcn_global_load_lds((const unsigned*)(list + (size_t)u.seg * CAP + 256u * (unsigned)u.mt + 4u * (unsigned)lane), (PG8_LAS unsigned*)(lds + STAGE_BYTES + slot * 2048), 16, 0, 0);
    }
    __device__ __forceinline__ void rows(const UnitG& u, PG8_LAS unsigned char* lds, int slot, unsigned (&rowp)[2]) const {
        int sR[2], sC[2];
#pragma unroll
        for (int i = 0; i < 2; ++i) stage_rc((int)threadIdx.x * 16 + i * 8192, sR[i], sC[i]);
        const int e = u.seg; const int cnt = (int)S.tb[TB_CNT + u.seg]; const PG8_LAS int* tbl = (const PG8_LAS int*)(lds + STAGE_BYTES + slot * 2048);
#pragma unroll
        for (int h = 0; h < 2; ++h) { unsigned tk[2];
#pragma unroll
            for (int i = 0; i < 2; ++i) { const int rl = 128 * h + sR[i], r = 256 * u.mt + rl;
                if (e < 64) { const int last_ = cnt - 1 - 256 * u.mt; tk[i] = (unsigned)tbl[rl < last_ ? rl : last_] >> 3; } else tk[i] = (unsigned)(r < M ? r : M - 1); }
            rowp[h] = tk[0] | (tk[1] << 16); }
    }
    __device__ __forceinline__ void rows_first(const UnitG& u, PG8_LAS unsigned char* lds, int slot, unsigned (&rowp)[2]) const {
        asm volatile("s_waitcnt vmcnt(0)" ::: "memory"); __builtin_amdgcn_s_barrier(); asm volatile("" ::: "memory");
        rows(u, lds, slot, rowp);
    }
};
struct Moe2Prob {
    int K; int pitchA; MoeSched S; const unsigned char* act; const unsigned char* w2t; const int* list; const float* listw;
    __device__ __forceinline__ bool next(int i, UnitG& u) const { return S.next(i, u); }
    __device__ __forceinline__ void meta(const UnitG& u, PG8_LAS unsigned char* lds, int par, int wid, int lane) const {
        if (wid == 0 && u.seg < 64) { const size_t o = (size_t)u.seg * CAP + 256u * (unsigned)u.mt + 4u * (unsigned)lane;
            __builtin_amdgcn_global_load_lds((const unsigned*)(list + o), (PG8_LAS unsigned*)(lds + STAGE_BYTES + par * 2048), 16, 0, 0);
            __builtin_amdgcn_global_load_lds((const unsigned*)(listw + o), (PG8_LAS unsigned*)(lds + STAGE_BYTES + par * 2048 + 1024), 16, 0, 0); }
    }
    __device__ __forceinline__ void setup_base(const UnitG& u, const char*& cA, const char*& cB) const {
        const size_t rowbase = (size_t)S.tb[TB_OFF + u.seg] + 256u * (unsigned)u.mt;
        cA = (const char*)(act + rowbase * 256); cB = (const char*)(w2t + ((size_t)u.seg * 1024 + (size_t)u.nt * 256) * 256);
    }
    __device__ __forceinline__ void rows(const UnitG&, PG8_LAS unsigned char*, int, unsigned (&rowp)[2]) const {
        int sR[2], sC[2];
#pragma unroll
        for (int i = 0; i < 2; ++i) stage_rc((int)threadIdx.x * 16 + i * 8192, sR[i], sC[i]);
#pragma unroll
        for (int h = 0; h < 2; ++h) rowp[h] = (unsigned)(128 * h + sR[0]) | ((unsigned)(128 * h + sR[1]) << 16);
    }
    __device__ __forceinline__ void rows_first(const UnitG& u, PG8_LAS unsigned char* lds, int slot, unsigned (&rowp)[2]) const { rows(u, lds, slot, rowp); }
};
struct EpiMoe1 {
    static constexpr bool PERM = true;
    unsigned char* act; const LAS unsigned* tb;
    __device__ __forceinline__ void operator()(const f32x4 (&acc)[2][2][4][2], const UnitG& u, int wr, int wc, int fr_, int fq_, PG8_LAS unsigned char*, int) const {
        int t_ = (int)threadIdx.x; asm volatile("" : "+v"(t_));
        const int fr = t_ & 15, fq = (t_ >> 4) & 3;
        const int cnt = (int)tb[TB_CNT + u.seg]; const size_t rowbase = tb[TB_OFF + u.seg];
#pragma unroll
        for (int ai = 0; ai < 2; ++ai)
#pragma unroll
            for (int m = 0; m < 4; ++m) { const int r = 256 * u.mt + ai * HALF + wr * 64 + m * 16 + fr;
                if (r < cnt) { unsigned char* p = act + (rowbase + (size_t)r) * 256 + u.nt * 128 + wc * 32 + 8 * fq;
                    const f32x4 g0 = acc[ai][0][m][0], g1 = acc[ai][0][m][1], u0 = acc[ai][1][m][0], u1 = acc[ai][1][m][1]; f32x4 v0, v1;
#pragma unroll
                    for (int i = 0; i < 4; ++i) { const float ga = g0[i] * 0.03125f, gb = g1[i] * 0.03125f; v0[i] = ga / (1.f + __expf(-ga)) * (u0[i] * 0.25f); v1[i] = gb / (1.f + __expf(-gb)) * (u1[i] * 0.25f); }
                    unsigned o0 = __builtin_amdgcn_cvt_pk_fp8_f32(c8(v0[0]), c8(v0[1]), 0, false); o0 = __builtin_amdgcn_cvt_pk_fp8_f32(c8(v0[2]), c8(v0[3]), o0, true);
                    unsigned o1 = __builtin_amdgcn_cvt_pk_fp8_f32(c8(v1[0]), c8(v1[1]), 0, false); o1 = __builtin_amdgcn_cvt_pk_fp8_f32(c8(v1[2]), c8(v1[3]), o1, true);
                    typedef unsigned u32x2_ __attribute__((ext_vector_type(2)));
                    *(u32x2_*)p = (u32x2_){o0, o1}; } }
    }
};
struct EpiMoe2 {
    static constexpr bool PERM = true;
    unsigned char* y0; unsigned char* y1; unsigned char* ys; const LAS unsigned* tb;
    __device__ __forceinline__ void operator()(const f32x4 (&acc)[2][2][4][2], const UnitG& u, int wr, int wc, int fr_, int fq_, PG8_LAS unsigned char* lds, int par) const {
        int t_ = (int)threadIdx.x; asm volatile("" : "+v"(t_));
        const int fr = t_ & 15, fq = (t_ >> 4) & 3;
        const int cnt = (int)tb[TB_CNT + u.seg]; const int e = u.seg; const int colt = u.nt * 256 + wc * 32 + 8 * fq;
        const PG8_LAS int* mslot = (const PG8_LAS int*)(lds + STAGE_BYTES + par * 2048); const PG8_LAS float* mw = (const PG8_LAS float*)(lds + STAGE_BYTES + par * 2048 + 1024);
#pragma unroll
        for (int ai = 0; ai < 2; ++ai)
#pragma unroll
            for (int m = 0; m < 4; ++m) { const int rl = ai * HALF + wr * 64 + m * 16 + fr, r = 256 * u.mt + rl;
                if (r < cnt) { int sl; float w;
                    if (e < 64) { sl = mslot[rl]; w = mw[rl] * 0.25f; } else { sl = r; w = 0.25f; }
                    unsigned char* p = (e < 64 ? (sl >= 65536 ? y1 + (size_t)(sl - 65536) * 1024 : y0 + (size_t)sl * 1024) : ys + (size_t)sl * 1024) + colt;
#pragma unroll
                    for (int bj = 0; bj < 2; ++bj) { const f32x4 v0 = acc[ai][bj][m][0] * w, v1 = acc[ai][bj][m][1] * w;
                        unsigned o0 = __builtin_amdgcn_cvt_pk_fp8_f32(v0[0], v0[1], 0, false); o0 = __builtin_amdgcn_cvt_pk_fp8_f32(v0[2], v0[3], o0, true);
                        unsigned o1 = __builtin_amdgcn_cvt_pk_fp8_f32(v1[0], v1[1], 0, false); o1 = __builtin_amdgcn_cvt_pk_fp8_f32(v1[2], v1[3], o1, true);
                        typedef unsigned u32x2_ __attribute__((ext_vector_type(2)));
                        *(u32x2_*)(p + bj * HALF) = (u32x2_){o0, o1}; } } }
    }
};
}

struct TrItem { const float* W; int ldw, src_col; bf16* WT; int K, dst_row, k0; float f8scale; };
__device__ __forceinline__ void tr_load(const TrItem& t, int lane, f32x4 (&v)[8]) {
#pragma unroll
    for (int i = 0; i < 8; ++i) v[i] = *(const GAS f32x4*)(t.W + (size_t)(t.k0 + 8 * i + (lane >> 3)) * t.ldw + t.src_col + 4 * (lane & 7));
}
__device__ __forceinline__ void tr_finish(const TrItem& t, int lane, const f32x4 (&v)[8], LAS float* scr) {
#pragma unroll
    for (int i = 0; i < 8; ++i) { LAS float* p = scr + (8 * i + (lane >> 3)) * 33 + 4 * (lane & 7); p[0] = v[i][0]; p[1] = v[i][1]; p[2] = v[i][2]; p[3] = v[i][3]; }
    LDS_WAIT(); asm volatile("" ::: "memory");
    const int c = lane & 7;
#pragma unroll
    for (int j = 0; j < 4; ++j) { const int n = (lane >> 3) + 8 * j; const LAS float* s = scr + (8 * c) * 33 + n;
        if (t.f8scale != 0.f) { const float q = t.f8scale; typedef unsigned u32x2_ __attribute__((ext_vector_type(2)));
            unsigned o0 = __builtin_amdgcn_cvt_pk_fp8_f32(s[0 * 33] * q, s[1 * 33] * q, 0, false); o0 = __builtin_amdgcn_cvt_pk_fp8_f32(s[2 * 33] * q, s[3 * 33] * q, o0, true);
            unsigned o1 = __builtin_amdgcn_cvt_pk_fp8_f32(s[4 * 33] * q, s[5 * 33] * q, 0, false); o1 = __builtin_amdgcn_cvt_pk_fp8_f32(s[6 * 33] * q, s[7 * 33] * q, o1, true);
            *(GAS u32x2_*)((GAS unsigned char*)t.WT + (size_t)(t.dst_row + n) * t.K + t.k0 + 8 * c) = (u32x2_){o0, o1};
        } else {
        v4u o; o.x = pk2(s[0 * 33], s[1 * 33]); o.y = pk2(s[2 * 33], s[3 * 33]); o.z = pk2(s[4 * 33], s[5 * 33]); o.w = pk2(s[6 * 33], s[7 * 33]);
        *(GAS v4u*)(t.WT + (size_t)(t.dst_row + n) * t.K + t.k0 + 8 * c) = o; } }
    LDS_WAIT(); asm volatile("" ::: "memory");
}
#define TR_LOOP(it0, stride, nitems, MAKE) do { int it_ = (it0); if (it_ < (nitems)) { TrItem cur_ = MAKE(it_); f32x4 va_[8], vb_[8]; tr_load(cur_, lane, va_); \
    for (;;) { const int nx_ = it_ + (stride); const bool hn_ = nx_ < (nitems); TrItem nxt_ = cur_; if (hn_) { nxt_ = MAKE(nx_); tr_load(nxt_, lane, vb_); } \
        tr_finish(cur_, lane, va_, scr); if (!hn_) break; _Pragma("unroll") for (int q_ = 0; q_ < 8; ++q_) va_[q_] = vb_[q_]; cur_ = nxt_; it_ = nx_; } } } while (0)

#ifndef REP_PHASE
#define REP_PHASE -1
#endif
#ifndef REP_N
#define REP_N 1
#endif
#define REPN(k) ((k) == REP_PHASE ? REP_N : 1)

constexpr int UNITS = BATCH * 128 * 4;
constexpr int L_QN = 0, L_KN = 17408, L_VV = 34816, L_LM = 52224, L_ATT = 68608, L_UT = 77824, L_WT = 96256, L_KTT = 114688, L_GCS = 133120, L_EGS = 133376, L_BET = 133632, L_SCW = 133888, L_SKT = 134144, L_TM = L_KN, L_TB = L_VV;
constexpr int H_FR = 0, H_QR = 17408, H_QE = 34816, H_KD = 52224, H_KTT = 69632, H_VT = 88064, H_AM = 106496;
constexpr int RS = 272, TS = 144;

typedef unsigned v2u __attribute__((ext_vector_type(2)));
#define LBAR() do { asm volatile("s_waitcnt lgkmcnt(0)" ::: "memory"); __builtin_amdgcn_s_barrier(); asm volatile("" ::: "memory"); } while (0)
__device__ __forceinline__ f32x4 mfma16(bf16x8 a, bf16x8 b, f32x4 c) { return __builtin_amdgcn_mfma_f32_16x16x32_bf16(a, b, c, 0, 0, 0); }
__device__ __forceinline__ bf16x8 ldsfrag(const LAS unsigned char* base, int row, int stride, int kbyte) { return *(const LAS bf16x8*)(base + row * stride + kbyte); }
__device__ __forceinline__ void unpack8(const v4u q, float (&f)[8]) {
    f[0] = __uint_as_float(q.x << 16); f[1] = __uint_as_float(q.x & 0xffff0000u); f[2] = __uint_as_float(q.y << 16); f[3] = __uint_as_float(q.y & 0xffff0000u);
    f[4] = __uint_as_float(q.z << 16); f[5] = __uint_as_float(q.z & 0xffff0000u); f[6] = __uint_as_float(q.w << 16); f[7] = __uint_as_float(q.w & 0xffff0000u); }
__device__ __forceinline__ f32x4 unpack4(const v2u q) { return (f32x4){__uint_as_float(q.x << 16), __uint_as_float(q.x & 0xffff0000u), __uint_as_float(q.y << 16), __uint_as_float(q.y & 0xffff0000u)}; }
__device__ __forceinline__ v2u pack4(const f32x4 v) { v2u o; o.x = pk2(v[0], v[1]); o.y = pk2(v[2], v[3]); return o; }
__device__ __forceinline__ float ldsbf(const LAS unsigned char* base, int row, int stride, int col) { return __uint_as_float(((unsigned)*(const LAS unsigned short*)(base + row * stride + col * 2)) << 16); }

struct MixPtrs {
    const bf16* projA; const bf16* gates; const float* ab; const float* conv_w; const float* a_log; const float* dt_bias; const float* hg_lb; const float* gdn_nw; const float* hg_nw;
    bf16 *PG, *BG, *QP, *OI, *BH, *QE, *OIH, *SG, *SH, *omix; float *GL, *AH;
};

__device__ __forceinline__ void p3_gdn_unit(LAS unsigned char* lds, const MixPtrs& X, int unit, int tid, int lane, int wave) {
    const int h = unit & 3, n = (unit >> 2) & 127, b = unit >> 9, r = lane & 15, g = lane >> 4;
    const size_t tok0 = (size_t)b * T + (size_t)n * 64;
    LAS float* gcs = (LAS float*)(lds + L_GCS); LAS float* egs = (LAS float*)(lds + L_EGS); LAS float* bet = (LAS float*)(lds + L_BET);
    {
#pragma unroll 1
      for (int ib = 0; ib < 6; ib += 3) {
        v4u raw[3][4];
#pragma unroll
        for (int i2 = 0; i2 < 3; ++i2) { const int i = ib + i2; const int pair = (tid >> 4) + 32 * i, tz = pair >> 6, c = pair & 63, ch = tid & 15, col = tz * 512 + h * 128 + ch * 8;
#pragma unroll
            for (int j = 0; j < 4; ++j) { const int tl = n * 64 + c - 3 + j; raw[i2][j] = *(const GAS v4u*)(X.projA + ((size_t)b * T + (tl < 0 ? 0 : tl)) * PA + col); } }
#pragma unroll
        for (int i2 = 0; i2 < 3; ++i2) { const int i = ib + i2;
            const int pair = (tid >> 4) + 32 * i, tz = pair >> 6, c = pair & 63, ch = tid & 15, col = tz * 512 + h * 128 + ch * 8;
            float y[8];
#pragma unroll
            for (int e = 0; e < 8; ++e) y[e] = 0.f;
#pragma unroll
            for (int j = 0; j < 4; ++j) { const int tl = n * 64 + c - 3 + j; const float msk = tl >= 0 ? 1.f : 0.f; float xf[8]; unpack8(raw[i2][j], xf);
                const f32x4 w0 = *(const GAS f32x4*)(X.conv_w + j * 1536 + col) * msk, w1 = *(const GAS f32x4*)(X.conv_w + j * 1536 + col + 4) * msk;
#pragma unroll
                for (int e = 0; e < 4; ++e) { y[e] += w0[e] * xf[e]; y[4 + e] += w1[e] * xf[4 + e]; } }
            float ss = 0.f;
#pragma unroll
            for (int e = 0; e < 8; ++e) { y[e] = siluf_(y[e]); ss += y[e] * y[e]; }
            ss += __shfl_xor(ss, 1); ss += __shfl_xor(ss, 2); ss += __shfl_xor(ss, 4); ss += __shfl_xor(ss, 8);
            const float rn = tz == 2 ? 1.f : rsqrtf(ss + 1e-6f) * (tz == 0 ? 0.08838834764831845f : 1.f);
            v4u o; o.x = pk2(y[0] * rn, y[1] * rn); o.y = pk2(y[2] * rn, y[3] * rn); o.z = pk2(y[4] * rn, y[5] * rn); o.w = pk2(y[6] * rn, y[7] * rn);
            *(LAS v4u*)(lds + (tz == 0 ? L_QN : (tz == 1 ? L_KN : L_VV)) + c * RS + ch * 16) = o;
        }
      }
    }
    if (wave == 0) {
        const float araw = X.ab[(tok0 + lane) * 8 + 4 + h], braw = X.ab[(tok0 + lane) * 8 + h];
        float gv = -expf(X.a_log[h]) * softplusf_(araw + X.dt_bias[h]);
#pragma unroll
        for (int o = 1; o < 64; o <<= 1) { const float t = __shfl_up(gv, o); if (lane >= o) gv += t; }
        { const float eg_ = __expf(gv), be_ = sigmoidf_(braw); gcs[lane] = gv; egs[lane] = eg_; bet[lane] = be_; *(LAS float*)(lds + L_SCW + lane * 4) = be_ * eg_; *(LAS float*)(lds + L_SKT + lane * 4) = __expf(__shfl(gv, 63) - gv); }
        if (lane == 63) X.GL[unit] = gv;
    }
    LBAR();
    {
        const int mt = wave >> 1;
#pragma unroll
        for (int q = 0; q < 2; ++q) { const int ntc = 2 * (wave & 1) + q; f32x4 akk = {0.f, 0.f, 0.f, 0.f}, aqk = {0.f, 0.f, 0.f, 0.f};
#pragma unroll
            for (int ks = 0; ks < 4; ++ks) { const bf16x8 ka = ldsfrag(lds + L_KN, 16 * mt + r, RS, 64 * ks + 16 * g), qa = ldsfrag(lds + L_QN, 16 * mt + r, RS, 64 * ks + 16 * g), kb = ldsfrag(lds + L_KN, 16 * ntc + r, RS, 64 * ks + 16 * g);
                akk = mfma16(ka, kb, akk); aqk = mfma16(qa, kb, aqk); }
            const int j = 16 * ntc + r; const float gj = gcs[j];
#pragma unroll
            for (int ii = 0; ii < 4; ++ii) { const int i = 16 * mt + 4 * g + ii; const float dec = (i >= j) ? __expf(gcs[i] - gj) : 0.f;
                *(LAS float*)(lds + L_LM + (i * 64 + j) * 4) = (i > j) ? bet[i] * akk[ii] * dec : 0.f;
                *(LAS unsigned short*)(lds + L_ATT + i * TS + j * 2) = (unsigned short)f2bf(aqk[ii] * dec); } }
    }
    LBAR();
#pragma unroll
    for (int i = 0; i < 2; ++i) { const int tsk = tid + 512 * i;
        if (tsk < 768) { const int a = tsk >> 8, hh = (tsk >> 7) & 1, d = tsk & 127;
            const LAS unsigned char* sp = lds + (a == 0 ? L_VV : L_KN) + d * 2; const LAS float* scl = (const LAS float*)(lds + (a == 0 ? L_BET : (a == 1 ? L_SCW : L_SKT)));
            LAS unsigned char* dp = lds + (a == 0 ? L_UT : (a == 1 ? L_WT : L_KTT)) + d * TS + 64 * hh;
#pragma unroll
            for (int q = 0; q < 4; ++q) { float kv[8];
#pragma unroll
                for (int e = 0; e < 8; ++e) { const int c = 32 * hh + 8 * q + e; kv[e] = __uint_as_float(((unsigned)*(const LAS unsigned short*)(sp + c * RS)) << 16) * scl[c]; }
                v4u o; o.x = pk2(kv[0], kv[1]); o.y = pk2(kv[2], kv[3]); o.z = pk2(kv[4], kv[5]); o.w = pk2(kv[6], kv[7]); *(LAS v4u*)(dp + 16 * q) = o; } } }
    LBAR();
    { const LAS float* Lm = (const LAS float*)(lds + L_LM); LAS float* Tm = (LAS float*)(lds + L_TM);
      if (tid < 64) { const int I = tid >> 4, j = tid & 15; float x[16];
#pragma unroll
          for (int i = 0; i < 16; ++i) { float s = (i == j) ? 1.f : 0.f;
#pragma unroll
              for (int kb = 0; kb < (i + 3) / 4; ++kb) { const f32x4 l = *(const LAS f32x4*)(Lm + (16 * I + i) * 64 + 16 * I + 4 * kb);
#pragma unroll
                  for (int e = 0; e < 4; ++e) if (4 * kb + e < i) s -= l[e] * x[4 * kb + e]; }
              x[i] = (i < j) ? 0.f : s; Tm[(16 * I + i) * 64 + 16 * I + j] = x[i]; } }
      LBAR();
#pragma unroll 1
      for (int lv = 1; lv < 4; ++lv) {
          for (int e = tid; e < (4 - lv) * 256; e += NWAVES * 64) { const int I = lv + (e >> 8), J = I - lv, rr = (e >> 4) & 15, cc = e & 15; float w = 0.f;
              for (int K = J; K < I; ++K) {
#pragma unroll
                  for (int kb = 0; kb < 4; ++kb) { const f32x4 l = *(const LAS f32x4*)(Lm + (16 * I + rr) * 64 + 16 * K + 4 * kb);
#pragma unroll
                      for (int q = 0; q < 4; ++q) w += l[q] * Tm[(16 * K + 4 * kb + q) * 64 + 16 * J + cc]; } }
              Tm[(16 * J + rr) * 64 + 16 * I + cc] = w; }
          LBAR();
          for (int e = tid; e < (4 - lv) * 256; e += NWAVES * 64) { const int I = lv + (e >> 8), J = I - lv, rr = (e >> 4) & 15, cc = e & 15; float t = 0.f;
#pragma unroll
              for (int kb = 0; kb < 4; ++kb) { const f32x4 l = *(const LAS f32x4*)(Tm + (16 * I + rr) * 64 + 16 * I + 4 * kb);
#pragma unroll
                  for (int q = 0; q < 4; ++q) t -= l[q] * Tm[(16 * J + 4 * kb + q) * 64 + 16 * I + cc]; }
              Tm[(16 * I + rr) * 64 + 16 * J + cc] = t; }
          LBAR();
      }
      { const int i = tid >> 3, j0 = (tid & 7) * 8; const f32x4 t0 = *(const LAS f32x4*)(Tm + i * 64 + j0), t1 = *(const LAS f32x4*)(Tm + i * 64 + j0 + 4); const bool keep = (i >> 4) >= (j0 >> 4);
        v4u o; o.x = keep ? pk2(t0[0], t0[1]) : 0u; o.y = keep ? pk2(t0[2], t0[3]) : 0u; o.z = keep ? pk2(t1[0], t1[1]) : 0u; o.w = keep ? pk2(t1[2], t1[3]) : 0u;
        *(LAS v4u*)(lds + L_TB + i * TS + j0 * 2) = o; }
      LBAR();
    }
    { bf16x8 af[4][2];
#pragma unroll
      for (int mt = 0; mt < 4; ++mt)
#pragma unroll
          for (int ks = 0; ks < 2; ++ks) af[mt][ks] = ldsfrag(lds + L_TB, 16 * mt + r, TS, 64 * ks + 16 * g);
#pragma unroll
      for (int q = 0; q < 2; ++q) { const int ng = 2 * wave + q; LAS unsigned char* base = lds + (ng >= 8 ? L_WT : L_UT) + (16 * (ng & 7) + r) * TS;
          const bf16x8 b0 = *(const LAS bf16x8*)(base + 16 * g), b1 = *(const LAS bf16x8*)(base + 64 + 16 * g);
          f32x4 acc[4];
#pragma unroll
          for (int mt = 0; mt < 4; ++mt) { acc[mt] = mfma16(af[mt][0], b0, (f32x4){0.f, 0.f, 0.f, 0.f}); acc[mt] = mfma16(af[mt][1], b1, acc[mt]); }
          asm volatile("s_waitcnt lgkmcnt(0)" ::: "memory");
#pragma unroll
          for (int mt = 0; mt < 4; ++mt) *(LAS v2u*)(base + (16 * mt + 4 * g) * 2) = pack4(acc[mt]); }
    }
    LBAR();
    {
        const size_t u16 = (size_t)unit * 16384, u8 = (size_t)unit * 8192;
        { const int kk = wave >> 1;
          bf16x8 af[2][2];
#pragma unroll
          for (int t2 = 0; t2 < 2; ++t2)
#pragma unroll
              for (int ks = 0; ks < 2; ++ks) af[t2][ks] = ldsfrag(lds + L_WT, 16 * (2 * kk + t2) + r, TS, 64 * ks + 16 * g);
#pragma unroll
          for (int q = 0; q < 4; ++q) { const int nt = 4 * (wave & 1) + q; f32x4 a0 = {0.f, 0.f, 0.f, 0.f}, a1 = {0.f, 0.f, 0.f, 0.f};
#pragma unroll
              for (int ks = 0; ks < 2; ++ks) { const bf16x8 bfr = ldsfrag(lds + L_KTT, 16 * nt + r, TS, 64 * ks + 16 * g); a0 = mfma16(af[0][ks], bfr, a0); a1 = mfma16(af[1][ks], bfr, a1); }
              v2u o; o.x = __builtin_amdgcn_cvt_pk_fp8_f32(-16.f * a0[0], -16.f * a0[1], 0, false); o.x = __builtin_amdgcn_cvt_pk_fp8_f32(-16.f * a0[2], -16.f * a0[3], o.x, true);
              o.y = __builtin_amdgcn_cvt_pk_fp8_f32(-16.f * a1[0], -16.f * a1[1], 0, false); o.y = __builtin_amdgcn_cvt_pk_fp8_f32(-16.f * a1[2], -16.f * a1[3], o.y, true);
              *(GAS v2u*)((GAS unsigned char*)X.PG + (size_t)unit * 16384 + ((size_t)(nt * 4 + kk) * 64 + lane) * 8) = o; } }
        { const int mt = wave; bf16x8 af[2];
#pragma unroll
          for (int ks = 0; ks < 2; ++ks) af[ks] = ldsfrag(lds + L_KTT, 16 * mt + r, TS, 64 * ks + 16 * g);
#pragma unroll
          for (int nt = 0; nt < 8; ++nt) { f32x4 a0 = {0.f, 0.f, 0.f, 0.f};
#pragma unroll
              for (int ks = 0; ks < 2; ++ks) a0 = mfma16(af[ks], ldsfrag(lds + L_UT, 16 * nt + r, TS, 64 * ks + 16 * g), a0);
              *(GAS v2u*)(X.BG + u16 + ((size_t)(nt * 8 + mt) * 64 + lane) * 4) = pack4(a0); } }
        { const int kk = wave >> 1;
#pragma unroll
          for (int q = 0; q < 2; ++q) { const int ct = 2 * (wave & 1) + q; f32x4 a0 = {0.f, 0.f, 0.f, 0.f}, a1 = {0.f, 0.f, 0.f, 0.f};
#pragma unroll
              for (int ks = 0; ks < 2; ++ks) { const bf16x8 bfr = ldsfrag(lds + L_ATT, 16 * ct + r, TS, 64 * ks + 16 * g);
                  a0 = mfma16(ldsfrag(lds + L_WT, 16 * (2 * kk) + r, TS, 64 * ks + 16 * g), bfr, a0); a1 = mfma16(ldsfrag(lds + L_WT, 16 * (2 * kk + 1) + r, TS, 64 * ks + 16 * g), bfr, a1); }
              const int c = 16 * ct + r; const float eg = egs[c];
              const f32x4 q0 = unpack4(*(const LAS v2u*)(lds + L_QN + c * RS + (32 * kk + 4 * g) * 2)), q1 = unpack4(*(const LAS v2u*)(lds + L_QN + c * RS + (32 * kk + 16 + 4 * g) * 2));
              v4u o; o.x = pk2(q0[0] * eg - a0[0], q0[1] * eg - a0[1]); o.y = pk2(q0[2] * eg - a0[2], q0[3] * eg - a0[3]); o.z = pk2(q1[0] * eg - a1[0], q1[1] * eg - a1[1]); o.w = pk2(q1[2] * eg - a1[2], q1[3] * eg - a1[3]);
              *(GAS v4u*)(X.QP + u8 + ((size_t)(ct * 4 + kk) * 64 + lane) * 8) = o; } }
        { const int vt = wave; bf16x8 af[2];
#pragma unroll
          for (int ks = 0; ks < 2; ++ks) af[ks] = ldsfrag(lds + L_UT, 16 * vt + r, TS, 64 * ks + 16 * g);
#pragma unroll
          for (int ct = 0; ct < 4; ++ct) { f32x4 a0 = {0.f, 0.f, 0.f, 0.f};
#pragma unroll
              for (int ks = 0; ks < 2; ++ks) a0 = mfma16(af[ks], ldsfrag(lds + L_ATT, 16 * ct + r, TS, 64 * ks + 16 * g), a0);
              *(GAS v2u*)(X.OI + u8 + ((size_t)(vt * 4 + ct) * 64 + lane) * 4) = pack4(a0); } }
    }
    LBAR();
}

__device__ __forceinline__ void p3_hgrn_unit(LAS unsigned char* lds, const MixPtrs& X, int unit, int tid, int lane, int wave) {
    const int h = unit & 3, n = (unit >> 2) & 127, b = unit >> 9, r = lane & 15, g = lane >> 4;
    const size_t tok0 = (size_t)b * T + (size_t)n * 64;
#pragma unroll
    for (int i = 0; i < 4; ++i) { const int pair = (tid >> 4) + 32 * i, tz = pair >> 6, c = pair & 63, ch = tid & 15;
        const v4u q = *(const GAS v4u*)(X.projA + (tok0 + c) * PA + (tz ? 2560 : 1536) + h * 128 + ch * 8);
        *(LAS v4u*)(lds + (tz ? H_QR : H_FR) + c * RS + ch * 16) = q; }
    {
        v4u rv[2];
#pragma unroll
        for (int i = 0; i < 2; ++i) { const int item = tid + 512 * i, c = item >> 4, ch = item & 15; rv[i] = *(const GAS v4u*)(X.projA + (tok0 + c) * PA + 2048 + h * 128 + ch * 8); }
#pragma unroll
        for (int i = 0; i < 2; ++i) { const int item = tid + 512 * i, c = item >> 4, ch = item & 15; const unsigned w[4] = {rv[i].x, rv[i].y, rv[i].z, rv[i].w};
#pragma unroll
            for (int e = 0; e < 4; ++e) { *(LAS unsigned short*)(lds + H_VT + (ch * 8 + 2 * e) * TS + c * 2) = (unsigned short)(w[e] & 0xffffu); *(LAS unsigned short*)(lds + H_VT + (ch * 8 + 2 * e + 1) * TS + c * 2) = (unsigned short)(w[e] >> 16); } }
    }
    LBAR();
    {
        const int d = tid & 127, seg = tid >> 7; LAS float* segt = (LAS float*)(lds + H_AM + 9216);
        const float l0 = X.hg_lb[h * 128 + d], l1 = X.hg_lb[512 + h * 128 + d]; const float mx = fmaxf(l0, l1); const float e0 = __expf(l0 - mx), e1 = __expf(l1 - mx); const float lb = e0 / (e0 + e1);
        float lc[16], kq[16]; float run = 0.f;
#pragma unroll
        for (int ci = 0; ci < 16; ++ci) { const float sg = sigmoidf_(ldsbf(lds + H_FR, 16 * seg + ci, RS, d)); run += __logf(lb + (1.f - lb) * sg); lc[ci] = run; kq[ci] = (1.f - lb) * (1.f - sg); }
        segt[seg * 128 + d] = run;
        LBAR();
        const float t0 = segt[d], t1 = segt[128 + d], t2 = segt[256 + d], t3 = segt[384 + d];
        const float off = (seg > 0 ? t0 : 0.f) + (seg > 1 ? t1 : 0.f) + (seg > 2 ? t2 : 0.f), btot = (t0 + t1) + (t2 + t3);
        float kv[16];
#pragma unroll
        for (int ci = 0; ci < 16; ++ci) { const int c = 16 * seg + ci; const float bb = off + lc[ci];
            *(LAS unsigned short*)(lds + H_QE + c * RS + d * 2) = (unsigned short)f2bf(siluf_(ldsbf(lds + H_QR, c, RS, d)) * __expf(bb));
            *(LAS unsigned short*)(lds + H_KD + c * RS + d * 2) = (unsigned short)f2bf(kq[ci] * __expf(-bb));
            kv[ci] = kq[ci] * __expf(btot - bb); }
        if (seg == 0) X.AH[(size_t)unit * 128 + d] = __expf(btot);
#pragma unroll
        for (int q = 0; q < 2; ++q) { v4u o; o.x = pk2(kv[8 * q], kv[8 * q + 1]); o.y = pk2(kv[8 * q + 2], kv[8 * q + 3]); o.z = pk2(kv[8 * q + 4], kv[8 * q + 5]); o.w = pk2(kv[8 * q + 6], kv[8 * q + 7]);
            *(LAS v4u*)(lds + H_KTT + d * TS + (16 * seg + 8 * q) * 2) = o; }
    }
    LBAR();
    {
        const int mt = wave >> 1;
#pragma unroll
        for (int q = 0; q < 2; ++q) { const int ntc = 2 * (wave & 1) + q; f32x4 a0 = {0.f, 0.f, 0.f, 0.f};
#pragma unroll
            for (int ks = 0; ks < 4; ++ks) a0 = mfma16(ldsfrag(lds + H_QE, 16 * mt + r, RS, 64 * ks + 16 * g), ldsfrag(lds + H_KD, 16 * ntc + r, RS, 64 * ks + 16 * g), a0);
            const int j = 16 * ntc + r;
#pragma unroll
            for (int ii = 0; ii < 4; ++ii) { const int i = 16 * mt + 4 * g + ii; *(LAS unsigned short*)(lds + H_AM + i * TS + j * 2) = (unsigned short)f2bf((i >= j) ? a0[ii] : 0.f); } }
    }
    LBAR();
    {
        const size_t u16 = (size_t)unit * 16384, u8 = (size_t)unit * 8192;
        { const int mt = wave; bf16x8 af[2];
#pragma unroll
          for (int ks = 0; ks < 2; ++ks) af[ks] = ldsfrag(lds + H_KTT, 16 * mt + r, TS, 64 * ks + 16 * g);
#pragma unroll
          for (int nt = 0; nt < 8; ++nt) { f32x4 a0 = {0.f, 0.f, 0.f, 0.f};
#pragma unroll
              for (int ks = 0; ks < 2; ++ks) a0 = mfma16(af[ks], ldsfrag(lds + H_VT, 16 * nt + r, TS, 64 * ks + 16 * g), a0);
              *(GAS v2u*)(X.BH + u16 + ((size_t)(nt * 8 + mt) * 64 + lane) * 4) = pack4(a0); } }
        { const int vt = wave; bf16x8 af[2];
#pragma unroll
          for (int ks = 0; ks < 2; ++ks) af[ks] = ldsfrag(lds + H_VT, 16 * vt + r, TS, 64 * ks + 16 * g);
#pragma unroll
          for (int ct = 0; ct < 4; ++ct) { f32x4 a0 = {0.f, 0.f, 0.f, 0.f};
#pragma unroll
              for (int ks = 0; ks < 2; ++ks) a0 = mfma16(af[ks], ldsfrag(lds + H_AM, 16 * ct + r, TS, 64 * ks + 16 * g), a0);
              *(GAS v2u*)(X.OIH + u8 + ((size_t)(vt * 4 + ct) * 64 + lane) * 4) = pack4(a0); } }
#pragma unroll
        for (int q = 0; q < 2; ++q) { const int idx = wave * 2 + q, ct = idx >> 2, kk = idx & 3, c = 16 * ct + r;
            const v2u q0 = *(const LAS v2u*)(lds + H_QE + c * RS + (32 * kk + 4 * g) * 2), q1 = *(const LAS v2u*)(lds + H_QE + c * RS + (32 * kk + 16 + 4 * g) * 2);
            v4u o; o.x = q0.x; o.y = q0.y; o.z = q1.x; o.w = q1.y;
            *(GAS v4u*)(X.QE + u8 + ((size_t)(ct * 4 + kk) * 64 + lane) * 8) = o; }
    }
    LBAR();
}

__device__ __forceinline__ void p4_gdn_scan(LAS unsigned char* lds, const MixPtrs& X, int job, int lane, int wave) {
    const int s = job >> 3, h = job & 3, b = (job >> 2) & 1;
    const int unit0 = (b * 128) * 4 + h;
    constexpr int F8RING = 0, BRING = 131072, GLOFF = BRING + 6 * 4096;
    if (wave >= 4) {
        const int lw = wave - 4;
        const char* src0 = (const char*)X.PG + (size_t)unit0 * 16384 + lw * 4096 + lane * 16;
        const char* bsrc0 = (const char*)(X.BG + (size_t)unit0 * 16384 + (size_t)(s * 8) * 256) + lw * 1024 + lane * 16;
#define P4_ISSUE(n_) do { const char* s_ = src0 + (size_t)(n_) * (4 * 16384); _Pragma("unroll") for (int i_ = 0; i_ < 4; ++i_) \
        __builtin_amdgcn_global_load_lds((const unsigned*)(s_ + i_ * 1024), (LAS unsigned*)(lds + F8RING + ((n_) & 7) * 16384 + lw * 4096 + i_ * 1024), 16, 0, 2); \
        __builtin_amdgcn_global_load_lds((const unsigned*)(bsrc0 + (size_t)(n_) * (4 * 32768)), (LAS unsigned*)(lds + BRING + ((n_) % 6) * 4096 + lw * 1024), 16, 0, 0); } while (0)
        P4_ISSUE(0); P4_ISSUE(1); P4_ISSUE(2); P4_ISSUE(3); P4_ISSUE(4);
        asm volatile("s_waitcnt vmcnt(20)" ::: "memory");
#pragma unroll 1
        for (int n = 0; n < 128; ++n) {
            __builtin_amdgcn_s_barrier();
            asm volatile("" ::: "memory");
            if (n + 5 < 128) P4_ISSUE(n + 5);
            if (n + 1 < 128) {
                if (n + 5 < 128) asm volatile("s_waitcnt vmcnt(20)" ::: "memory"); else if (n + 4 < 128) asm volatile("s_waitcnt vmcnt(15)" ::: "memory"); else if (n + 3 < 128) asm volatile("s_waitcnt vmcnt(10)" ::: "memory");
                else if (n + 2 < 128) asm volatile("s_waitcnt vmcnt(5)" ::: "memory"); else asm volatile("s_waitcnt vmcnt(0)" ::: "memory");
            }
        }
#undef P4_ISSUE
    } else if (wave == 0) {
        f32x4 S[8]; v2u sb8[4];
#pragma unroll
        for (int mt = 0; mt < 8; ++mt) S[mt] = (f32x4){0.f, 0.f, 0.f, 0.f};
#pragma unroll
        for (int kk = 0; kk < 4; ++kk) { sb8[kk] = (v2u){0u, 0u}; v4u z; z.x = 0; z.y = 0; z.z = 0; z.w = 0; *(GAS v4u*)(X.SG + (size_t)unit0 * 16384 + ((size_t)(s * 4 + kk) * 64 + lane) * 8) = z; }
        { const float g0 = X.GL[unit0 + 4 * lane], g1 = X.GL[unit0 + 4 * (64 + lane)]; *(LAS float*)(lds + GLOFF + lane * 4) = g0; *(LAS float*)(lds + GLOFF + (64 + lane) * 4) = g1; }
        asm volatile("s_waitcnt vmcnt(0) lgkmcnt(0)" ::: "memory");
#pragma unroll 1
        for (int n = 0; n < 128; ++n) {
            const int unit = unit0 + 4 * n;
            __builtin_amdgcn_s_barrier();
            asm volatile("" ::: "memory");
            const float e = __expf(*(const LAS float*)(lds + GLOFF + n * 4));
            const LAS unsigned char* bb = lds + BRING + (n % 6) * 4096 + lane * 8;
            f32x4 acc[8];
#pragma unroll
            for (int mt = 0; mt < 8; ++mt) acc[mt] = (f32x4){0.f, 0.f, 0.f, 0.f};
            const LAS unsigned char* pb = lds + F8RING + (n & 7) * 16384 + lane * 8;
#pragma unroll
            for (int kk = 0; kk < 4; ++kk)
#pragma unroll
                for (int mt = 0; mt < 8; ++mt) acc[mt] = __builtin_amdgcn_mfma_f32_16x16x32_fp8_fp8(__builtin_bit_cast(long, *(const LAS v2u*)(pb + (mt * 4 + kk) * 512)), __builtin_bit_cast(long, sb8[kk]), acc[mt], 0, 0, 0);
#pragma unroll
            for (int mt = 0; mt < 8; ++mt) S[mt] = S[mt] * e + unpack4(*(const LAS v2u*)(bb + mt * 512)) + acc[mt] * 0.00390625f;
#pragma unroll
            for (int kk = 0; kk < 4; ++kk) { const f32x4 a = S[2 * kk], c = S[2 * kk + 1];
                unsigned w0 = __builtin_amdgcn_cvt_pk_fp8_f32(c8(a[0] * 16.f), c8(a[1] * 16.f), 0, false); w0 = __builtin_amdgcn_cvt_pk_fp8_f32(c8(a[2] * 16.f), c8(a[3] * 16.f), w0, true);
                unsigned w1 = __builtin_amdgcn_cvt_pk_fp8_f32(c8(c[0] * 16.f), c8(c[1] * 16.f), 0, false); w1 = __builtin_amdgcn_cvt_pk_fp8_f32(c8(c[2] * 16.f), c8(c[3] * 16.f), w1, true);
                sb8[kk] = (v2u){w0, w1};
                if (n < 127) { v4u o; o.x = pg8::cvt_pk_bf16(a[0], a[1]); o.y = pg8::cvt_pk_bf16(a[2], a[3]); o.z = pg8::cvt_pk_bf16(c[0], c[1]); o.w = pg8::cvt_pk_bf16(c[2], c[3]);
                    *(GAS v4u*)(X.SG + (size_t)(unit + 4) * 16384 + ((size_t)(s * 4 + kk) * 64 + lane) * 8) = o; } }
            asm volatile("s_waitcnt lgkmcnt(0)" ::: "memory");
        }
    } else {
#pragma unroll 1
        for (int n = 0; n < 128; ++n) { __builtin_amdgcn_s_barrier(); asm volatile("" ::: "memory"); }
    }
}
__device__ __forceinline__ void p4_hgrn_scan(const MixPtrs& X, int task, int lane) {
    const int mt = task & 7, s = (task >> 3) & 7, h = (task >> 6) & 3, b = task >> 8, g = lane >> 4;
    const int unit0 = (b * 128) * 4 + h;
    f32x4 s0 = {0.f, 0.f, 0.f, 0.f};
    const GAS f32x4* ap = (const GAS f32x4*)(X.AH + (size_t)unit0 * 128 + 16 * mt + 4 * g);
    const GAS v2u* bp = (const GAS v2u*)(X.BH + (size_t)unit0 * 16384 + ((size_t)(s * 8 + mt) * 64 + lane) * 4);
    GAS v2u* sp = (GAS v2u*)(X.SH + (size_t)unit0 * 16384 + ((size_t)(s * 4 + (mt >> 1)) * 64 + lane) * 8 + 4 * (mt & 1));
    { v2u z; z.x = 0; z.y = 0; sp[0] = z; }
    f32x4 ra[32]; v2u rb[32];
#pragma unroll
    for (int j = 0; j < 32; ++j) { ra[j] = ap[(size_t)j * 128]; rb[j] = bp[(size_t)j * 16384]; }
#pragma unroll 1
    for (int n0 = 0; n0 < 128; n0 += 32) {
#pragma unroll
        for (int j = 0; j < 32; ++j) { const int n = n0 + j;
            s0 = ra[j] * s0 + unpack4(rb[j]);
            if (n + 32 < 128) { ra[j] = ap[(size_t)(n + 32) * 128]; rb[j] = bp[(size_t)(n + 32) * 16384]; }
            if (n < 127) sp[(size_t)(n + 1) * 16384] = pack4(s0); }
    }
}
__device__ __forceinline__ void p5_unit(LAS unsigned char* lds, const MixPtrs& X, int bn, int lane, int wave) {
    const int hd = wave & 3, type = wave >> 2, r = lane & 15, g = lane >> 4;
    const int unit = bn * 4 + hd; const size_t tok0 = (size_t)bn * 64;
    const bf16* SX = type ? X.SH : X.SG; const bf16* QX = type ? X.QE : X.QP; const bf16* OX = type ? X.OIH : X.OI;
    const size_t u16 = (size_t)unit * 16384, u8 = (size_t)unit * 8192;
    LAS float* exch = (LAS float*)lds;
    const float* nw = type ? X.hg_nw + hd * 128 : X.gdn_nw;
    bf16x8 af[4][8];
#pragma unroll
    for (int kk = 0; kk < 4; ++kk)
#pragma unroll
        for (int vt = 0; vt < 8; ++vt) af[kk][vt] = *(const GAS bf16x8*)(SX + u16 + ((size_t)(vt * 4 + kk) * 64 + lane) * 8);
#pragma unroll 1
    for (int ct = 0; ct < 4; ++ct) {
        bf16x8 bfr[4]; v2u oq[8], gtq[8];
#pragma unroll
        for (int kk = 0; kk < 4; ++kk) bfr[kk] = *(const GAS bf16x8*)(QX + u8 + ((size_t)(ct * 4 + kk) * 64 + lane) * 8);
#pragma unroll
        for (int vt = 0; vt < 8; ++vt) { oq[vt] = *(const GAS v2u*)(OX + u8 + ((size_t)(vt * 4 + ct) * 64 + lane) * 4);
            gtq[vt] = *(const GAS v2u*)(X.gates + (tok0 + 16 * ct + r) * 1024 + type * 512 + hd * 128 + 16 * vt + 4 * g); }
        f32x4 acc[8];
#pragma unroll
        for (int vt = 0; vt < 8; ++vt) acc[vt] = unpack4(oq[vt]);
#pragma unroll
        for (int kk = 0; kk < 4; ++kk)
#pragma unroll
            for (int vt = 0; vt < 8; ++vt) acc[vt] = mfma16(af[kk][vt], bfr[kk], acc[vt]);
        float ssq = 0.f;
#pragma unroll
        for (int vt = 0; vt < 8; ++vt) ssq += (acc[vt][0] * acc[vt][0] + acc[vt][1] * acc[vt][1]) + (acc[vt][2] * acc[vt][2] + acc[vt][3] * acc[vt][3]);
        ssq += __shfl_xor(ssq, 16); ssq += __shfl_xor(ssq, 32);
        if (type == 1 && g == 0) exch[(ct & 1) * 64 + hd * 16 + r] = ssq;
        LBAR();
        float rstd;
        if (type == 1) { const LAS float* ex = exch + (ct & 1) * 64 + r; rstd = rsqrtf(((ex[0] + ex[16]) + (ex[32] + ex[48])) * (1.f / 512.f) + 1e-6f); } else rstd = rsqrtf(ssq * (1.f / 128.f) + 1e-6f);
#pragma unroll
        for (int vt = 0; vt < 8; ++vt) { const f32x4 w4 = *(const GAS f32x4*)(nw + 16 * vt + 4 * g); const size_t off = (tok0 + 16 * ct + r) * 1024 + type * 512 + hd * 128 + 16 * vt + 4 * g;
            const f32x4 gt = unpack4(gtq[vt]); f32x4 o;
#pragma unroll
            for (int e = 0; e < 4; ++e) o[e] = acc[vt][e] * rstd * w4[e] * siluf_(gt[e]);
            *(GAS v2u*)(X.omix + off) = pack4(o); }
    }
    LBAR();
}

struct Args { const float* in[23]; float* out; unsigned char* ws; int ph_lo, ph_hi, li, pad; };

__global__ void __launch_bounds__(NWAVES * 64, 2) mk_fwd(Args args) {
    extern __shared__ __attribute__((aligned(16))) unsigned char lds_raw[];
    LAS unsigned char* lds = (LAS unsigned char*)lds_raw;
    volatile LAS unsigned* MISC = (volatile LAS unsigned*)(lds + MISC_OFF);
    const int tid = threadIdx.x, lane = tid & 63, wave = __builtin_amdgcn_readfirstlane(tid >> 6);
    const int G = gridDim.x, bx = blockIdx.x, vcu = (G % 8 == 0) ? (bx % 8) * (G / 8) + bx / 8 : bx;
    const int gw = vcu * NWAVES + wave, NGW = G * NWAVES;
    unsigned char* ws = args.ws;
    gu32* ctl = (gu32*)(ws + WS_CTL);
    const float* x = args.in[0]; const float* cvec = args.in[1]; const float* w_ada = args.in[2]; const float* b_ada = args.in[3]; const float* norm1_w = args.in[4];
    const float* w_in = args.in[5]; const float* w_out = args.in[12];
    float* mod = (float*)(ws + WS_MOD); float* wab = (float*)(ws + WS_WAB); float* ab = (float*)(ws + WS_AB);
    bf16* wout_t = (bf16*)(ws + WS_WOUT_T); bf16* win_t = (bf16*)(ws + WS_WIN_T); bf16* h1 = (bf16*)(ws + WS_H1); bf16* projA = (bf16*)(ws + WS_PROJA); bf16* gates = (bf16*)(ws + WS_GATES);
    bf16* omix = (bf16*)(ws + WS_OMIX);
    bf16* h2 = (bf16*)(ws + WS_H2); bf16* w1t = (bf16*)(ws + WS_W1T); bf16* w2t = (bf16*)(ws + WS_W2T); bf16* act = (bf16*)(ws + WS_ACT); bf16* y0 = (bf16*)(ws + WS_Y0); bf16* y1 = (bf16*)(ws + WS_Y1);
    MixPtrs X; X.projA = projA; X.gates = gates; X.ab = ab; X.conv_w = args.in[6]; X.a_log = args.in[7]; X.dt_bias = args.in[8]; X.hg_lb = args.in[10]; X.gdn_nw = args.in[9]; X.hg_nw = args.in[11];
    X.PG = (bf16*)(ws + WS_PG); X.BG = (bf16*)(ws + WS_BG); X.QP = (bf16*)(ws + WS_QP); X.OI = (bf16*)(ws + WS_OI); X.BH = (bf16*)(ws + WS_BH); X.QE = (bf16*)(ws + WS_QE); X.OIH = (bf16*)(ws + WS_OIH);
    X.SG = (bf16*)args.out; X.SH = (bf16*)args.out + (size_t)UNITS * 16384; X.omix = omix; X.GL = (float*)(ws + WS_GL); X.AH = (float*)(ws + WS_AH);
    const int* list = (const int*)(ws + WS_LIST); const float* listw = (const float*)(ws + WS_LISTW);
    LAS unsigned* tb = (LAS unsigned*)(lds + SCR2_OFF);

    for (int u = tid; u < (LDS_BYTES - LDSCTL_OFF) / 4; u += NWAVES * 64) ((LAS unsigned*)(lds + LDSCTL_OFF))[u] = 0u;
    __syncthreads();
    XcdBarrier bar = xcd_barrier_post((unsigned*)(ctl + CW_BAR) + args.li * XCD_BAR_WORDS, MISC + 8);
    const int lo = args.ph_lo, hi = args.ph_hi;
#define IN(k) (lo <= (k) && (k) < hi)
#define BOTH(k) (IN(k) && IN((k) + 1))

    if (IN(0)) {
#define PH_BODY do { \
        if (bx < 96) { \
            LAS float* part = (LAS float*)(lds + RING_BYTES); \
            const int e = bx * 64 + lane; float a0 = 0.f, a1 = 0.f; \
_Pragma("unroll 32") \
            for (int d = wave * 128; d < wave * 128 + 128; ++d) { const float w = w_ada[(size_t)d * 6144 + e]; a0 += siluf_(cvec[d]) * w; a1 += siluf_(cvec[D + d]) * w; } \
            part[(wave * 2 + 0) * 64 + lane] = a0; part[(wave * 2 + 1) * 64 + lane] = a1; \
            __syncthreads(); \
            if (tid < 128) { const int bb = tid >> 6, l = tid & 63; float s = 0.f; \
_Pragma("unroll") \
                for (int w = 0; w < 8; ++w) s += part[(w * 2 + bb) * 64 + l]; \
                mod[bb * 6144 + bx * 64 + l] = s + b_ada[bx * 64 + l]; } \
        } else if (bx == 96) { \
            for (int idx = tid; idx < 8192; idx += NWAVES * 64) wab[idx] = w_in[(size_t)(idx >> 3) * DIN + 2048 + (idx & 7)]; \
        } \
        { const float* w_router = args.in[14]; bf16* wrhi = (bf16*)(ws + WS_WRHI); bf16* wrlo = (bf16*)(ws + WS_WRLO); \
          for (int k = gw; k < 1024; k += NGW) { const float w = w_router[k * 64 + lane]; const unsigned hi = f2bf(w); \
              wrhi[lane * 1024 + k] = (bf16)hi; wrlo[lane * 1024 + k] = (bf16)f2bf(w - __uint_as_float(hi << 16)); } } \
        LAS float* scr = (LAS float*)(lds + wave * 16384); \
        constexpr int I_IN = 16 * 128, I_OUT = 16 * 32; \
        auto mk0 = [&](int it) { TrItem t; if (it < I_IN) { const int kb = it / 128, n0 = 32 * (it % 128); const int sc_ = n0 < 1536 ? n0 : (n0 < 3072 ? n0 + 520 : (n0 < 3584 ? n0 - 1536 : n0 + 8)); \
                t.W = w_in; t.ldw = DIN; t.src_col = sc_; t.WT = win_t; t.K = D; t.dst_row = n0; t.k0 = 64 * kb; t.f8scale = 0.f; } \
            else { const int r = it - I_IN, kb = r / 32, n0 = 32 * (r % 32); t.W = w_out; t.ldw = D; t.src_col = n0; t.WT = wout_t; t.K = D; t.dst_row = n0; t.k0 = 64 * kb; t.f8scale = 0.f; } return t; }; \
        TR_LOOP(gw, NGW, I_IN + I_OUT, mk0); \
        if (BOTH(0)) xcd_barrier(bar); \
    } while (0)
        PH_BODY; if (REPN(0) > 1) { PH_BODY; PH_BODY; }
#undef PH_BODY
    }
    if (IN(1)) {
#define PH_BODY do { \
        { \
            const GAS f32x4* wab4 = (const GAS f32x4*)wab; \
            for (int idx = tid; idx < 2048; idx += NWAVES * 64) { const int d = idx >> 1, qh = idx & 1; *(LAS f32x4*)(lds + (((qh * 4 + (d & 3)) * 256 + (d >> 2)) * 16)) = wab4[idx]; } \
            __syncthreads(); \
            const int nrows = (M - gw + NGW - 1) / NGW; \
            f32x4 sclr[4], shfr[4]; int curb = -1; \
            f32x4 vn[2][4]; \
_Pragma("unroll") \
            for (int q = 0; q < 2; ++q) { const int m = gw + q * NGW; \
_Pragma("unroll") \
                for (int j = 0; j < 4; ++j) vn[q][j] = (q < nrows) ? ((const GAS f32x4*)(x + (size_t)m * D) + lane)[64 * j] : (f32x4){0.f, 0.f, 0.f, 0.f}; } \
_Pragma("unroll 1") \
            for (int p = 0; p < nrows; p += 2) { \
                f32x4 v[2][4]; \
_Pragma("unroll") \
                for (int q = 0; q < 2; ++q) \
_Pragma("unroll") \
                    for (int j = 0; j < 4; ++j) v[q][j] = vn[q][j]; \
_Pragma("unroll") \
                for (int q = 0; q < 2; ++q) { const int m = gw + (p + 2 + q) * NGW; \
                    if (p + 2 + q < nrows) { \
_Pragma("unroll") \
                        for (int j = 0; j < 4; ++j) vn[q][j] = ((const GAS f32x4*)(x + (size_t)m * D) + lane)[64 * j]; } } \
_Pragma("unroll") \
                for (int q = 0; q < 2; ++q) { const int m = gw + (p + q) * NGW; \
                    if (p + q < nrows) { \
                        float ss = 0.f; \
_Pragma("unroll") \
                        for (int j = 0; j < 4; ++j) ss += (v[q][j].x * v[q][j].x + v[q][j].y * v[q][j].y) + (v[q][j].z * v[q][j].z + v[q][j].w * v[q][j].w); \
                        const float rstd = rsqrtf(wave_sum(ss) * (1.f / D) + 1e-6f); \
                        const int bsel = m >= T ? 1 : 0; \
                        if (bsel != curb) { curb = bsel; const GAS f32x4* sh4 = (const GAS f32x4*)(mod + bsel * 6144) + lane; \
_Pragma("unroll") \
                            for (int j = 0; j < 4; ++j) { sclr[j] = ((const GAS f32x4*)norm1_w + lane)[64 * j] * (sh4[256 + 64 * j] + 1.0f); shfr[j] = sh4[64 * j]; } } \
                        GAS unsigned long long* o8 = (GAS unsigned long long*)(h1 + (size_t)m * D) + lane; \
                        f32x4 a0 = {0.f, 0.f, 0.f, 0.f}, a1 = {0.f, 0.f, 0.f, 0.f}; \
_Pragma("unroll") \
                        for (int j = 0; j < 4; ++j) { __builtin_amdgcn_sched_barrier(0); const f32x4 h = v[q][j] * rstd * sclr[j] + shfr[j]; \
                            o8[64 * j] = (unsigned long long)pk2(h.x, h.y) | ((unsigned long long)pk2(h.z, h.w) << 32); \
_Pragma("unroll") \
                            for (int i = 0; i < 4; ++i) { a0 += *(const LAS f32x4*)(lds + ((i * 256 + lane + 64 * j) * 16)) * h[i]; a1 += *(const LAS f32x4*)(lds + (((4 + i) * 256 + lane + 64 * j) * 16)) * h[i]; } } \
 \
                        const bool up5 = (lane & 32) != 0, up4 = (lane & 16) != 0, up3 = (lane & 8) != 0; \
                        f32x4 k4; \
_Pragma("unroll") \
                        for (int e = 0; e < 4; ++e) { const float snd = up5 ? a0[e] : a1[e]; k4[e] = (up5 ? a1[e] : a0[e]) + __shfl_xor(snd, 32); } \
                        float k2[2]; \
_Pragma("unroll") \
                        for (int e = 0; e < 2; ++e) { const float snd = up4 ? k4[e] : k4[2 + e]; k2[e] = (up4 ? k4[2 + e] : k4[e]) + __shfl_xor(snd, 16); } \
                        float k1; { const float snd = up3 ? k2[0] : k2[1]; k1 = (up3 ? k2[1] : k2[0]) + __shfl_xor(snd, 8); } \
                        k1 += __shfl_xor(k1, 4); k1 += __shfl_xor(k1, 2); k1 += __shfl_xor(k1, 1); \
                        if ((lane & 7) == 0) ab[(size_t)m * 8 + 4 * (lane >> 5) + 2 * ((lane >> 4) & 1) + ((lane >> 3) & 1)] = k1; \
                    } } \
            } \
            __syncthreads(); \
        } \
        if (BOTH(1)) xcd_barrier(bar); \
    } while (0)
        PH_BODY; if (REPN(1) > 1) { PH_BODY; PH_BODY; }
#undef PH_BODY
    }
    if (IN(2)) {
#define PH_BODY do { \
        pg8::Gemm g{h1, win_t, M, 4096, D}; pg8::StaticOrder S; S.init(M, 4096, G, (int)blockIdx.x); \
        pg8::EpiProj E{projA, gates}; \
        pg8::gemm_phase<pg8::EpiProj, pg8::StaticOrder, true, true>(lds, g, S, E); \
        if (BOTH(2)) xcd_barrier(bar); \
    } while (0)
        PH_BODY; if (REPN(2) > 1) { PH_BODY; PH_BODY; }
#undef PH_BODY
    }

    if (IN(3)) {
#define PH_BODY do { \
        for (int u = vcu; u < UNITS; u += G) p3_gdn_unit(lds, X, u, tid, lane, wave); \
        for (int u = vcu; u < UNITS; u += G) p3_hgrn_unit(lds, X, u, tid, lane, wave); \
        if (BOTH(3)) xcd_barrier(bar); \
    } while (0)
        PH_BODY; if (REPN(3) > 1) { PH_BODY; PH_BODY; }
#undef PH_BODY
    }
    if (IN(4)) {
#define PH_BODY do { \
        if (bx < 64) p4_gdn_scan(lds, X, bx, lane, wave); \
        else { \
            if (wave < 3 && (bx - 64) * 3 + wave < 512) p4_hgrn_scan(X, (bx - 64) * 3 + wave, lane); \
            LAS float* scr = (LAS float*)(lds + wave * 16384); \
            const float* w_gate = args.in[16]; const float* w_up = args.in[17]; const float* w_down = args.in[18]; const float* ws_gate = args.in[19]; const float* ws_up = args.in[20]; const float* ws_down = args.in[21]; \
            auto mk4 = [&](int it) { TrItem t; const int e = it / 384, r = it % 384; \
                if (r < 256) { const int up = r >> 7, q = r & 127, kb = q >> 3, n0 = 32 * (q & 7); \
                    t.W = e < NE ? (up ? w_up : w_gate) + (size_t)e * D * DE : (up ? ws_up : ws_gate); t.ldw = DE; t.src_col = n0; t.WT = (bf16*)((unsigned char*)w1t + (size_t)e * 512 * 1024); t.K = D; t.dst_row = (n0 >> 7) * 256 + up * 128 + (n0 & 127); t.k0 = 64 * kb; t.f8scale = 32.f; } \
                else { const int q = r - 256, kb = q >> 5, n0 = 32 * (q & 31); \
                    t.W = e < NE ? w_down + (size_t)e * DE * D : ws_down; t.ldw = D; t.src_col = n0; t.WT = (bf16*)((unsigned char*)w2t + (size_t)e * 1024 * 256); t.K = DE; t.dst_row = n0; t.k0 = 64 * kb; t.f8scale = 16.f; } return t; }; \
            TR_LOOP((bx - 64) * NWAVES + wave, (G - 64) * NWAVES, NEX * 384, mk4); \
        } \
        if (BOTH(4)) xcd_barrier(bar); \
    } while (0)
        PH_BODY; if (REPN(4) > 1) { PH_BODY; PH_BODY; }
#undef PH_BODY
    }
    if (IN(5)) {
#define PH_BODY do { \
        for (int bn = vcu; bn < BATCH * 128; bn += G) p5_unit(lds, X, bn, lane, wave); \
        if (BOTH(5)) xcd_barrier(bar); \
    } while (0)
        PH_BODY; if (REPN(5) > 1) { PH_BODY; PH_BODY; }
#undef PH_BODY
    }
    if (IN(6)) {
#define PH_BODY do { \
        pg8::Gemm g{omix, wout_t, M, D, D}; pg8::StaticOrder S; S.init(M, D, G, (int)blockIdx.x); \
        pg8::EpiResid E{x, mod, args.out}; \
        pg8::gemm_phase<pg8::EpiResid, pg8::StaticOrder, true, true>(lds, g, S, E); \
        if (BOTH(6)) xcd_barrier(bar); \
    } while (0)
        PH_BODY; if (REPN(6) > 1) { PH_BODY; PH_BODY; }
#undef PH_BODY
    }


    if (IN(7)) {
        constexpr int HS = 2064;
        constexpr int R_HI = 0, R_LO = 66048, R_PART = 0  , R_SC = 132096, R_SEL = 140288, R_CNT = 148480, R_BASE = 148736, R_ESE = 148992, R_ESL = 151040, R_EW = 153088, R_ELP = 155136;
        if (tid < 64) *(LAS unsigned*)(lds + R_CNT + tid * 4) = 0u;
        __syncthreads();
        int nu = 0;
        const float* norm2_w = args.in[13]; const float* rbias = args.in[15]; const bf16* wrhi = (const bf16*)(ws + WS_WRHI); const bf16* wrlo = (const bf16*)(ws + WS_WRLO);
        int* listo = (int*)(ws + WS_LIST); float* listwo = (float*)(ws + WS_LISTW);
        const int r = lane & 15, g = lane >> 4;
#pragma unroll 1
        for (int u = vcu; u < M / 32; u += G, ++nu) {
            const GAS f32x4* sh4 = (const GAS f32x4*)(mod + (32 * u >= T ? 6144 : 0) + 3072) + lane; const GAS f32x4* nw4 = (const GAS f32x4*)norm2_w + lane;
#pragma unroll 1
            for (int qp = 0; qp < 4; qp += 2) {
                f32x4 xrow[2][4];
#pragma unroll
                for (int q = 0; q < 2; ++q) { const GAS f32x4* xr = (const GAS f32x4*)(args.out + (size_t)(32 * u + 4 * wave + qp + q) * D) + lane;
#pragma unroll
                    for (int j = 0; j < 4; ++j) xrow[q][j] = xr[64 * j]; }
#pragma unroll
                for (int q = 0; q < 2; ++q) { const int rl = 4 * wave + qp + q, m = 32 * u + rl;
                    f32x4 v[4]; float ss = 0.f;
#pragma unroll
                    for (int j = 0; j < 4; ++j) { v[j] = xrow[q][j]; ss += (v[j].x * v[j].x + v[j].y * v[j].y) + (v[j].z * v[j].z + v[j].w * v[j].w); }
                    const float rstd = rsqrtf(wave_sum(ss) * (1.f / D) + 1e-6f);
                    GAS unsigned* o4 = (GAS unsigned*)((unsigned char*)h2 + (size_t)m * D) + lane;
#pragma unroll
                    for (int j = 0; j < 4; ++j) { const f32x4 hv = v[j] * rstd * (nw4[64 * j] * (sh4[256 + 64 * j] + 1.0f)) + sh4[64 * j];
                        const unsigned h0 = f2bf(hv.x), h1_ = f2bf(hv.y), h2_ = f2bf(hv.z), h3 = f2bf(hv.w);
                        const unsigned long long hi = (unsigned long long)(h0 | (h1_ << 16)) | ((unsigned long long)(h2_ | (h3 << 16)) << 32);
                        { unsigned q8 = __builtin_amdgcn_cvt_pk_fp8_f32(hv.x, hv.y, 0, false); q8 = __builtin_amdgcn_cvt_pk_fp8_f32(hv.z, hv.w, q8, true); o4[64 * j] = q8; }
                        const unsigned long long lo = (unsigned long long)pk2(hv.x - __uint_as_float(h0 << 16), hv.y - __uint_as_float(h1_ << 16)) | ((unsigned long long)pk2(hv.z - __uint_as_float(h2_ << 16), hv.w - __uint_as_float(h3 << 16)) << 32);
                        *(LAS unsigned long long*)(lds + R_HI + rl * HS + (lane + 64 * j) * 8) = hi; *(LAS unsigned long long*)(lds + R_LO + rl * HS + (lane + 64 * j) * 8) = lo; } }
            }
            __syncthreads();
            f32x4 acc[2][4];
#pragma unroll
            for (int mt = 0; mt < 2; ++mt)
#pragma unroll
                for (int nt = 0; nt < 4; ++nt) acc[mt][nt] = (f32x4){0.f, 0.f, 0.f, 0.f};
#pragma unroll 2
            for (int ks = 0; ks < 4; ++ks) { const int kb = (128 * wave + 32 * ks + 8 * g) * 2;
                bf16x8 ahi[2], alo[2];
#pragma unroll
                for (int mt = 0; mt < 2; ++mt) { ahi[mt] = *(const LAS bf16x8*)(lds + R_HI + (16 * mt + r) * HS + kb); alo[mt] = *(const LAS bf16x8*)(lds + R_LO + (16 * mt + r) * HS + kb); }
#pragma unroll
                for (int nt = 0; nt < 4; ++nt) { const size_t o = (size_t)(16 * nt + r) * 1024 + 128 * wave + 32 * ks + 8 * g; const bf16x8 bh = *(const GAS bf16x8*)(wrhi + o), bl = *(const GAS bf16x8*)(wrlo + o);
#pragma unroll
                    for (int mt = 0; mt < 2; ++mt) { acc[mt][nt] = mfma16(ahi[mt], bh, acc[mt][nt]); acc[mt][nt] = mfma16(ahi[mt], bl, acc[mt][nt]); acc[mt][nt] = mfma16(alo[mt], bh, acc[mt][nt]); } } }
            __syncthreads();
#pragma unroll
            for (int mt = 0; mt < 2; ++mt)
#pragma unroll
                for (int nt = 0; nt < 4; ++nt)
#pragma unroll
                    for (int ii = 0; ii < 4; ++ii) *(LAS float*)(lds + R_PART + ((wave * 32 + 16 * mt + 4 * g + ii) * 64 + 16 * nt + r) * 4) = acc[mt][nt][ii];
            __syncthreads();
#pragma unroll
            for (int q = 0; q < 4; ++q) { const int idx = tid + 512 * q; float s = 0.f;
#pragma unroll
                for (int w = 0; w < 8; ++w) s += *(const LAS float*)(lds + R_PART + (w * 2048 + idx) * 4);
                const float sc = sigmoidf_(s); *(LAS float*)(lds + R_SC + idx * 4) = sc; *(LAS float*)(lds + R_SEL + idx * 4) = sc + rbias[idx & 63]; }
            __syncthreads();
#pragma unroll 2
            for (int q = 0; q < 4; ++q) { const int rl = 4 * wave + q, m = 32 * u + rl;
                const float sel = *(const LAS float*)(lds + R_SEL + (rl * 64 + lane) * 4), score = *(const LAS float*)(lds + R_SC + (rl * 64 + lane) * 4);
                float m1 = sel; m1 = fmaxf(m1, __shfl_xor(m1, 1)); m1 = fmaxf(m1, __shfl_xor(m1, 2)); m1 = fmaxf(m1, __shfl_xor(m1, 4));
                const unsigned long long eq = __ballot(sel == m1) & (0xFFull << (lane & 56)); const int first = __ffsll((long long)eq) - 1;
                float m2 = (lane == first) ? -INFINITY : sel; m2 = fmaxf(m2, __shfl_xor(m2, 1)); m2 = fmaxf(m2, __shfl_xor(m2, 2)); m2 = fmaxf(m2, __shfl_xor(m2, 4));
                const float gs = m1 + m2; const int mygrp = lane >> 3; int grank = 0;
#pragma unroll
                for (int gg = 0; gg < 8; ++gg) { const float o = __shfl(gs, 8 * gg); grank += (o > gs || (o == gs && gg < mygrp)) ? 1 : 0; }
                const float msel = grank < 4 ? sel : -INFINITY; int erank = 0;
#pragma unroll
                for (int e2 = 0; e2 < 64; ++e2) { const float o = __shfl(msel, e2); erank += (o > msel || (o == msel && e2 < lane)) ? 1 : 0; }
                const bool chosen = grank < 4 && erank < 8;
                const float wsum = wave_sum(chosen ? score : 0.f);
                if (chosen && nu < 2) { const int se = lane; const unsigned lp = __hip_atomic_fetch_add((LAS unsigned*)(lds + R_CNT + se * 4), 1u, __ATOMIC_RELAXED, __HIP_MEMORY_SCOPE_WORKGROUP);
                    const int ei = ((nu * 32 + rl) * 8 + erank) * 4;
                    *(LAS int*)(lds + R_ESE + ei) = se; *(LAS int*)(lds + R_ESL + ei) = m * 8 + erank; *(LAS float*)(lds + R_EW + ei) = score / wsum * 2.5f; *(LAS unsigned*)(lds + R_ELP + ei) = lp; } }
            __syncthreads();
            if (nu == 1 || u + G >= M / 32) {
                if (tid < 64) { const unsigned c = *(LAS unsigned*)(lds + R_CNT + tid * 4); *(LAS unsigned*)(lds + R_BASE + tid * 4) = c ? __hip_atomic_fetch_add(ctl + CW_CNT + 64 * tid, c, RLX_AGENT) : 0u; }
                __syncthreads();
                for (int idx = tid; idx < (nu + 1) * 256; idx += NWAVES * 64) { const int se = *(LAS int*)(lds + R_ESE + idx * 4); const unsigned pos = *(LAS unsigned*)(lds + R_BASE + se * 4) + *(LAS unsigned*)(lds + R_ELP + idx * 4);
                    if (pos < (unsigned)CAP) { listo[(size_t)se * CAP + pos] = *(LAS int*)(lds + R_ESL + idx * 4); listwo[(size_t)se * CAP + pos] = *(LAS float*)(lds + R_EW + idx * 4); } }
                __syncthreads();
                if (tid < 64) *(LAS unsigned*)(lds + R_CNT + tid * 4) = 0u;
                __syncthreads();
                nu = -1;
            }
        }
        if (BOTH(7)) xcd_barrier(bar);
    }
    if (lo <= 10 && hi > 8) {
        if (wave == 0) { unsigned c = __hip_atomic_load(ctl + CW_CNT + 64 * lane, RLX_AGENT); c = c < (unsigned)CAP ? c : (unsigned)CAP;
            unsigned inc = c;
#pragma unroll
            for (int o = 1; o < 64; o <<= 1) { const unsigned t = __shfl_up(inc, o); if (lane >= o) inc += t; }
            tb[TB_CNT + lane] = c; tb[TB_OFF + lane] = inc - c;
            if (lane == 63) { tb[TB_CNT + 64] = (unsigned)M; tb[TB_OFF + 64] = inc; } }
        __syncthreads();
    }
#define MOE_PREFIX(lo_, hi_, NT_, perm_) do { __syncthreads(); if (wave == 0) { const unsigned un_ = ((tb[TB_CNT + lane] + 255u) >> 8) * (NT_); unsigned inc_ = un_; \
        _Pragma("unroll") for (int o_ = 1; o_ < 64; o_ <<= 1) { const unsigned t_ = __shfl_up(inc_, o_); if (lane >= o_) inc_ += t_; } \
        tb[TB_PRE + lane] = inc_ - un_; if (lane == 63) { tb[TB_PRE + 64] = inc_; tb[TB_PRE + 65] = inc_ + ((tb[TB_CNT + 64] + 255u) >> 8) * (NT_); } } __syncthreads(); } while (0)
    if (IN(8)) {
#define PH_BODY do { \
        MOE_PREFIX(0, 65, 2, 0); \
        pg8::Moe1Prob P{D, 1024, pg8::MoeSched{tb, 0, 65, 2, G, vcu, 0}, (const unsigned char*)h2, (const unsigned char*)w1t, list}; \
        pg8::EpiMoe1 E{(unsigned char*)act, tb}; \
        pg8::gemm_phase_g<pg8::Moe1Prob, pg8::EpiMoe1, true>(lds, P, E); \
        if (BOTH(8)) xcd_barrier(bar); \
    } while (0)
        PH_BODY; if (REPN(8) > 1) { PH_BODY; PH_BODY; }
#undef PH_BODY
    }
    if (IN(9)) for (int rep_ = 0; rep_ < REPN(9); ++rep_) {
        MOE_PREFIX(0, 65, 4, 0);
        pg8::Moe2Prob P{DE, 256, pg8::MoeSched{tb, 0, 65, 4, G, vcu, 0}, (const unsigned char*)act, (const unsigned char*)w2t, list, listw};
        pg8::EpiMoe2 E{(unsigned char*)y0, (unsigned char*)y1, ws + WS_YS, tb};
        pg8::gemm_phase_g<pg8::Moe2Prob, pg8::EpiMoe2, true>(lds, P, E);
        if (BOTH(9)) xcd_barrier(bar);
    }
    if (IN(10)) {
        const float* fw = args.in[22]; const unsigned char* yb0 = (const unsigned char*)y0; const unsigned char* yb1 = (const unsigned char*)y1;
        typedef float f32x2_ __attribute__((ext_vector_type(2)));
        f32x4 fwr[2][2];
#pragma unroll
        for (int j = 0; j < 2; ++j)
#pragma unroll
            for (int h2_ = 0; h2_ < 2; ++h2_) fwr[j][h2_] = ((const GAS f32x4*)fw)[2 * lane + 128 * j + h2_];
#define P10_LOAD(m_, yq_, xv_, g2v_) do { const int hf_ = (m_) >= T ? 1 : 0; const GAS f32x4* xr_ = (const GAS f32x4*)(args.out + (size_t)(m_) * D); \
            const GAS v2u* yr_ = (const GAS v2u*)(hf_ ? yb1 + (size_t)((m_) - T) * 8 * D : yb0 + (size_t)(m_) * 8 * D) + lane; const GAS v2u* ysr_ = (const GAS v2u*)(ws + WS_YS + (size_t)(m_) * D) + lane; \
            const GAS f32x4* g24_ = (const GAS f32x4*)(mod + hf_ * 6144 + 5120); \
            _Pragma("unroll") for (int j = 0; j < 2; ++j) { _Pragma("unroll") for (int h2_ = 0; h2_ < 2; ++h2_) { xv_[j][h2_] = xr_[2 * lane + 128 * j + h2_]; g2v_[j][h2_] = g24_[2 * lane + 128 * j + h2_]; } \
                _Pragma("unroll") for (int k = 0; k < 8; ++k) yq_[k][j] = yr_[k * 128 + 64 * j]; yq_[8][j] = ysr_[64 * j]; } } while (0)
        v2u yqn[9][2]; f32x4 xvn[2][2], g2n[2][2];
        if (gw < M) P10_LOAD(gw, yqn, xvn, g2n);
#pragma unroll 1
        for (int m = gw; m < M; m += NGW) {
            GAS f32x4* xr = (GAS f32x4*)(args.out + (size_t)m * D);
            v2u yq[9][2]; f32x4 xv[2][2], g2v[2][2];
#pragma unroll
            for (int j = 0; j < 2; ++j) {
#pragma unroll
                for (int k = 0; k < 9; ++k) yq[k][j] = yqn[k][j];
#pragma unroll
                for (int h2_ = 0; h2_ < 2; ++h2_) { xv[j][h2_] = xvn[j][h2_]; g2v[j][h2_] = g2n[j][h2_]; } }
            if (m + NGW < M) P10_LOAD(m + NGW, yqn, xvn, g2n);
            f32x4 v[2][2]; float ss = 0.f;
#pragma unroll
            for (int j = 0; j < 2; ++j) { f32x4 s0 = {0.f, 0.f, 0.f, 0.f}, s1 = {0.f, 0.f, 0.f, 0.f};
#pragma unroll
                for (int k = 0; k < 9; ++k) { const f32x2_ a = __builtin_amdgcn_cvt_pk_f32_fp8(yq[k][j].x, false), b = __builtin_amdgcn_cvt_pk_f32_fp8(yq[k][j].x, true), c = __builtin_amdgcn_cvt_pk_f32_fp8(yq[k][j].y, false), d = __builtin_amdgcn_cvt_pk_f32_fp8(yq[k][j].y, true);
                    s0.x += a.x; s0.y += a.y; s0.z += b.x; s0.w += b.y; s1.x += c.x; s1.y += c.y; s1.z += d.x; s1.w += d.y; }
                v[j][0] = xv[j][0] + g2v[j][0] * (s0 * 0.03125f); v[j][1] = xv[j][1] + g2v[j][1] * (s1 * 0.03125f);
#pragma unroll
                for (int h2_ = 0; h2_ < 2; ++h2_) ss += (v[j][h2_].x * v[j][h2_].x + v[j][h2_].y * v[j][h2_].y) + (v[j][h2_].z * v[j][h2_].z + v[j][h2_].w * v[j][h2_].w); }
            const float rstd = rsqrtf(wave_sum(ss) * (1.f / D) + 1e-6f);
#pragma unroll
            for (int j = 0; j < 2; ++j)
#pragma unroll
                for (int h2_ = 0; h2_ < 2; ++h2_) xr[2 * lane + 128 * j + h2_] = v[j][h2_] * rstd * fwr[j][h2_];
        }
#undef P10_LOAD
    }
#undef MOE_PREFIX
#undef IN
#undef BOTH
}

static void launch_mk(Args a, int lo, int hi, int li, int grid, hipStream_t stream) {
    a.ph_lo = lo; a.ph_hi = hi; a.li = li;
    hipLaunchKernelGGL(mk_fwd, dim3(grid), dim3(NWAVES * 64), LDS_BYTES, stream, a);
}
extern "C" void kernel_launch(void* const* d_in, const int* in_sizes, int n_in, void* d_out, int out_size, void* d_ws, size_t ws_size, hipStream_t stream) {
    static int grid = 0;
    if (grid == 0) {
        int dev = 0, cus = 0;
        if (hipGetDevice(&dev) != hipSuccess || hipDeviceGetAttribute(&cus, hipDeviceAttributeMultiprocessorCount, dev) != hipSuccess) { grid = -1; return; }
        if (hipFuncSetAttribute((const void*)mk_fwd, hipFuncAttributeMaxDynamicSharedMemorySize, LDS_BYTES) != hipSuccess) { grid = -1; return; }
        grid = cus;
    }
    if (grid < 0) return;
    unsigned char* ws = (unsigned char*)d_ws; float* out = (float*)d_out;
    (void)hipMemsetAsync(ws + WS_CTL, 0, CTL_ZERO_BYTES, stream);
    Args a{};
    for (int i = 0; i < 23; ++i) a.in[i] = (const float*)d_in[i];
    a.out = out; a.ws = ws;
    launch_mk(a, 0, 11, 0, grid, stream);
}
```

```cpp
#include <hip/hip_runtime.h>
#include <cstdio>
#include <cstdint>
namespace pg8 {
#define PG8_LAS __attribute__((address_space(3)))
typedef unsigned short bf16_t;
typedef short bf16x8 __attribute__((ext_vector_type(8)));
typedef float f32x4 __attribute__((ext_vector_type(4)));
typedef unsigned u32x4 __attribute__((ext_vector_type(4)));
constexpr int BM = 256, BK = 64, HALF = 128, HTB = HALF * BK * 2  , STAGE_BYTES = 8 * HTB, NXCD = 8, WGM = 8;

__host__ __device__ __forceinline__ int lds_byte(int r, int c) { const int st = (r >> 4) * 2 + (c >> 5), rr = r & 15, cc = c & 31, ob = rr * 64 + cc * 2; return st * 1024 + (ob ^ (((ob >> 9) & 1) << 5)); }
__host__ __device__ __forceinline__ void stage_rc(int b, int& R, int& C) { const int st = b / 1024, sb = b % 1024, swz = sb ^ (((sb >> 9) & 1) << 5); R = (st >> 1) * 16 + swz / 64; C = (st & 1) * 32 + (swz % 64) / 2; }
__host__ __device__ __forceinline__ int perm32(int rho) { const int n = rho >> 4, i = rho & 15; return 8 * (i >> 2) + 4 * n + (i & 3); }

struct Unit { int pm, pn; };
struct Gemm { const bf16_t* A; const bf16_t* Bt; int M, N, K; };

struct StaticOrder {
    int nM, nN, nwg, G, c;
    __host__ __device__ void init(int M, int N, int G_, int c_) { nM = M / BM; nN = N / BM; nwg = nM * nN; G = G_; c = c_; }
    __host__ __device__ bool next(int i, Unit& u) const {
        const long L = (long)i * G + c; if (L >= nwg) return false;
        int wgid = (int)L; { const int q = nwg / NXCD, r = nwg % NXCD, xcd = wgid % NXCD, off = wgid / NXCD; wgid = (xcd < r ? xcd * (q + 1) : r * (q + 1) + (xcd - r) * q) + off; }
        const int nig = WGM * nN, gid = wgid / nig, fm = gid * WGM, gsz = (nM - fm) < WGM ? (nM - fm) : WGM;
        u.pm = fm + ((wgid % nig) % gsz); u.pn = (wgid % nig) / gsz; return true;
    }
    __device__ __forceinline__ void a_ready(const Unit&) const {}
    __device__ __forceinline__ void done(const Unit&) const {}
};
__device__ __forceinline__ unsigned cvt_pk_bf16(float lo, float hi) { unsigned r; asm volatile("v_cvt_pk_bf16_f32 %0, %1, %2" : "=v"(r) : "v"(lo), "v"(hi)); return r; }
template <class Epi, class Sched, bool ALIGN_EPI = false, bool SP2 = false>
__device__ __forceinline__ void gemm_phase(PG8_LAS unsigned char* lds, const Gemm g, const Sched& S, const Epi& E) {
    const int tid = threadIdx.x, wid = __builtin_amdgcn_readfirstlane(tid >> 6), lane = tid & 63, wr = wid >> 2, wc = wid & 3, fr = lane & 15, fq = lane >> 4;
    const int K = g.K, nt = K / BK;
    unsigned voffA[2], voffB[2];
#pragma unroll
    for (int i = 0; i < 2; ++i) { int R, C; stage_rc(tid * 16 + i * 8192, R, C); const int Rb = Epi::PERM ? ((R & ~31) + perm32(R & 31)) : R;
        voffA[i] = (unsigned)(R * K + C) * 2u; voffB[i] = (unsigned)(Rb * K + C) * 2u; }
    const size_t kstep = (size_t)(BK * 2);
    const size_t hstep = (size_t)HALF * K * 2;
    const size_t tstep = 2 * hstep;
    const unsigned ldsw = (unsigned)wid * 1024u;
    const int aoff = lds_byte(wr * 64 + fr, fq * 8), boff = lds_byte(wc * 32 + fr, fq * 8);
#define PG8_SA(b, h) (((b) * 2 + (h)) * HTB)
#define PG8_SB(b, h) ((4 + (b) * 2 + (h)) * HTB)
#define PG8_STAGE(bufoff, gbase, voff) do { _Pragma("unroll") for (int _i = 0; _i < 2; ++_i) \
        __builtin_amdgcn_global_load_lds((const unsigned*)((const char*)(gbase) + (voff)[_i]), (PG8_LAS unsigned*)(lds + (bufoff) + ldsw + _i * 8192), 16, 0, 0); } while (0)
#define PG8_LDA(dst, b, h) do { _Pragma("unroll") for (int m = 0; m < 4; ++m) _Pragma("unroll") for (int k = 0; k < 2; ++k) dst[m][k] = *(const PG8_LAS bf16x8*)(lds + PG8_SA(b, h) + aoff + m * 2048 + k * 1024); } while (0)
#define PG8_LDB(dst, b, h) do { _Pragma("unroll") for (int n = 0; n < 2; ++n) _Pragma("unroll") for (int k = 0; k < 2; ++k) dst[n][k] = *(const PG8_LAS bf16x8*)(lds + PG8_SB(b, h) + boff + n * 2048 + k * 1024); } while (0)
#define PG8_MMA(ai, bj, At, Bt) do { __builtin_amdgcn_s_setprio(1); _Pragma("unroll") for (int m = 0; m < 4; ++m) _Pragma("unroll") for (int n = 0; n < 2; ++n) _Pragma("unroll") for (int k = 0; k < 2; ++k) \
        acc[ai][bj][m][n] = __builtin_amdgcn_mfma_f32_16x16x32_bf16(Bt[n][k], At[m][k], acc[ai][bj][m][n], 0, 0, 0); __builtin_amdgcn_s_setprio(0); } while (0)
#define PG8_WAIT_V(n) asm volatile("s_waitcnt vmcnt(" #n ")" ::: "memory")
#define PG8_WAIT_L(n) asm volatile("s_waitcnt lgkmcnt(" #n ")" ::: "memory")
#define PG8_BAR __builtin_amdgcn_s_barrier()
#define PG8_SCHED __builtin_amdgcn_sched_barrier(0)
    Unit cur, nxt; int ui = 0;
    if (!S.next(0, cur)) return;
    f32x4 acc[2][2][4][2];
#pragma unroll
    for (int a = 0; a < 2; ++a)
#pragma unroll
        for (int b = 0; b < 2; ++b)
#pragma unroll
            for (int m = 0; m < 4; ++m)
#pragma unroll
                for (int n = 0; n < 2; ++n) acc[a][b][m][n] = (f32x4){0.f, 0.f, 0.f, 0.f};
    bf16x8 At[4][2], B0[2][2], B1[2][2];
    const char* cA = (const char*)g.A + (size_t)cur.pm * tstep; const char* cB = (const char*)g.Bt + (size_t)cur.pn * tstep;
    S.a_ready(cur);
    if constexpr (SP2) {
        PG8_STAGE(PG8_SB(0, 0), cB, voffB); PG8_STAGE(PG8_SB(0, 1), cB + hstep, voffB); PG8_STAGE(PG8_SA(0, 0), cA, voffA); PG8_STAGE(PG8_SA(0, 1), cA + hstep, voffA);
        if (wr == 1) PG8_BAR;
        PG8_WAIT_V(2); PG8_BAR;
        PG8_STAGE(PG8_SB(1, 0), cB + kstep, voffB); PG8_STAGE(PG8_SA(1, 0), cA + kstep, voffA); PG8_STAGE(PG8_SB(1, 1), cB + hstep + kstep, voffB);
        PG8_WAIT_V(6); PG8_BAR;
    } else {
        PG8_STAGE(PG8_SB(0, 0), cB, voffB); PG8_STAGE(PG8_SA(0, 0), cA, voffA); PG8_STAGE(PG8_SB(0, 1), cB + hstep, voffB); PG8_STAGE(PG8_SA(0, 1), cA + hstep, voffA);
        if (wr == 1) PG8_BAR;
        PG8_WAIT_V(4); PG8_BAR;
        PG8_STAGE(PG8_SB(1, 0), cB + kstep, voffB); PG8_STAGE(PG8_SA(1, 0), cA + kstep, voffA); PG8_STAGE(PG8_SB(1, 1), cB + hstep + kstep, voffB);
        PG8_WAIT_V(6); PG8_BAR;
    }
    for (;;) {
        const bool has_next = S.next(ui + 1, nxt);
        const char* nA = has_next ? (const char*)g.A + (size_t)nxt.pm * tstep : cA; const char* nB = has_next ? (const char*)g.Bt + (size_t)nxt.pn * tstep : cB;
        for (int t = 0; t < nt; t += 2) {
            const bool last = (t == nt - 2);
            const char* a1 = cA + (size_t)(t + 1) * kstep;
            const char* a2 = last ? nA : cA + (size_t)(t + 2) * kstep; const char* b2 = last ? nB : cB + (size_t)(t + 2) * kstep;
            const char* a3 = a2 + kstep; const char* b3 = b2 + kstep;
            if (last && has_next) S.a_ready(nxt);
            if constexpr (SP2) {
            PG8_LDB(B0, 0, 0); PG8_LDB(B1, 0, 1); PG8_SCHED; PG8_LDA(At, 0, 0); PG8_STAGE(PG8_SA(1, 1), a1 + hstep, voffA);
            PG8_WAIT_V(8); PG8_WAIT_L(0); PG8_BAR; PG8_MMA(0, 0, At, B0); PG8_MMA(0, 1, At, B1); PG8_BAR; PG8_SCHED;
            PG8_LDA(At, 0, 1); PG8_STAGE(PG8_SB(0, 0), b2, voffB); PG8_STAGE(PG8_SB(0, 1), b2 + hstep, voffB); PG8_STAGE(PG8_SA(0, 0), a2, voffA);
            PG8_WAIT_V(8); PG8_WAIT_L(0); PG8_BAR; PG8_MMA(1, 0, At, B0); PG8_MMA(1, 1, At, B1); PG8_BAR; PG8_SCHED;
            PG8_LDB(B0, 1, 0); PG8_LDB(B1, 1, 1); PG8_SCHED; PG8_LDA(At, 1, 0); PG8_STAGE(PG8_SA(0, 1), a2 + hstep, voffA);
            PG8_WAIT_V(8); PG8_WAIT_L(0); PG8_BAR; PG8_MMA(0, 0, At, B0); PG8_MMA(0, 1, At, B1); PG8_BAR; PG8_SCHED;
            PG8_LDA(At, 1, 1); PG8_STAGE(PG8_SB(1, 0), b3, voffB); PG8_STAGE(PG8_SB(1, 1), b3 + hstep, voffB); PG8_STAGE(PG8_SA(1, 0), a3, voffA);
            PG8_WAIT_V(8); PG8_WAIT_L(0); PG8_BAR; PG8_MMA(1, 0, At, B0); PG8_MMA(1, 1, At, B1); PG8_BAR; PG8_SCHED;
            } else {
            PG8_LDB(B0, 0, 0); PG8_SCHED; PG8_LDA(At, 0, 0); PG8_STAGE(PG8_SA(1, 1), a1 + hstep, voffA);
            PG8_WAIT_L(8); PG8_BAR; PG8_WAIT_L(0); PG8_MMA(0, 0, At, B0); PG8_BAR; PG8_SCHED;
            PG8_LDB(B1, 0, 1); PG8_STAGE(PG8_SB(0, 0), b2, voffB);
            PG8_BAR; PG8_WAIT_L(0); PG8_MMA(0, 1, At, B1); PG8_BAR;
            PG8_LDA(At, 0, 1); PG8_STAGE(PG8_SA(0, 0), a2, voffA);
            PG8_BAR; PG8_WAIT_L(0); PG8_MMA(1, 0, At, B0); PG8_BAR; PG8_SCHED;
            PG8_STAGE(PG8_SB(0, 1), b2 + hstep, voffB);
            PG8_WAIT_V(6); PG8_BAR; PG8_MMA(1, 1, At, B1); PG8_BAR;
            PG8_LDB(B0, 1, 0); PG8_SCHED; PG8_LDA(At, 1, 0); PG8_STAGE(PG8_SA(0, 1), a2 + hstep, voffA);
            PG8_WAIT_L(8); PG8_BAR; PG8_WAIT_L(0); PG8_MMA(0, 0, At, B0); PG8_BAR; PG8_SCHED;
            PG8_LDB(B1, 1, 1); PG8_STAGE(PG8_SB(1, 0), b3, voffB);
            PG8_BAR; PG8_WAIT_L(0); PG8_MMA(0, 1, At, B1); PG8_BAR;
            PG8_LDA(At, 1, 1); PG8_STAGE(PG8_SA(1, 0), a3, voffA);
            PG8_BAR; PG8_WAIT_L(0); PG8_MMA(1, 0, At, B0); PG8_BAR; PG8_SCHED;
            PG8_STAGE(PG8_SB(1, 1), b3 + hstep, voffB);
            PG8_WAIT_V(6); PG8_BAR; PG8_MMA(1, 1, At, B1); PG8_BAR;
            }
        }
        if constexpr (ALIGN_EPI) { if (wr == 0) PG8_BAR; }
        if constexpr (!Epi::AFTER_DRAIN) { E(acc, cur, wr, wc, fr, fq); S.done(cur); }
        if (!has_next) break;
#pragma unroll
        for (int a = 0; a < 2; ++a)
#pragma unroll
            for (int b = 0; b < 2; ++b)
#pragma unroll
                for (int m = 0; m < 4; ++m)
#pragma unroll
                    for (int n = 0; n < 2; ++n) acc[a][b][m][n] = (f32x4){0.f, 0.f, 0.f, 0.f};
        cur = nxt; cA = nA; cB = nB; ++ui;
        if constexpr (ALIGN_EPI) { if (wr == 1) PG8_BAR; }
    }
    PG8_WAIT_V(0);
    if constexpr (!ALIGN_EPI) { if (wr == 0) PG8_BAR; }
    PG8_BAR;
    if constexpr (Epi::AFTER_DRAIN) { E.fused(acc, cur, wr, wc, fr, fq, lds, wid, lane); S.done(cur); }
#undef PG8_SA
#undef PG8_SB
#undef PG8_STAGE
#undef PG8_LDA
#undef PG8_LDB
#undef PG8_MMA
#undef PG8_WAIT_V
#undef PG8_WAIT_L
#undef PG8_BAR
#undef PG8_SCHED
}
}
#define GAS __attribute__((address_space(1)))
#define LAS __attribute__((address_space(3)))
typedef unsigned short bf16;
typedef unsigned v4u __attribute__((ext_vector_type(4)));
typedef float f32x4 __attribute__((ext_vector_type(4)));
typedef short bf16x8 __attribute__((ext_vector_type(8)));
typedef GAS unsigned gu32;
typedef GAS unsigned long long gu64;
#define RLX_AGENT __ATOMIC_RELAXED, __HIP_MEMORY_SCOPE_AGENT
#define LDS_WAIT() asm volatile("s_waitcnt lgkmcnt(0)" ::: "memory")
#define VM_WAIT() asm volatile("s_waitcnt vmcnt(0)" ::: "memory")
__device__ __forceinline__ unsigned long long rt() { return __builtin_amdgcn_s_memrealtime(); }
__device__ __forceinline__ unsigned f2bf(float f) { unsigned u = __builtin_bit_cast(unsigned, f); return (u + 0x7fffu + ((u >> 16) & 1u)) >> 16; }
__device__ __forceinline__ unsigned pk2(float lo, float hi) { return f2bf(lo) | (f2bf(hi) << 16); }
#define XB_TMO      128
#define XB_XCNT(j)  (256  + 64 * (j))
#define XB_XSUB(j)  (1280 + 64 * (j))
#define XB_XGEN(j)  (2304 + 64 * (j))
#define XB_TOP      3328
#define XB_TOPGEN   3392
#define XCD_BAR_WORDS 3456
#define XB_SPIN_CAP (1u << 18)

__device__ __forceinline__ unsigned xb_ld(unsigned* p)              { return __hip_atomic_load(p, __ATOMIC_RELAXED, __HIP_MEMORY_SCOPE_AGENT); }
__device__ __forceinline__ unsigned xb_add(unsigned* p, unsigned v) { return __hip_atomic_fetch_add(p, v, __ATOMIC_RELAXED, __HIP_MEMORY_SCOPE_AGENT); }
__device__ __forceinline__ unsigned xb_xcc_id() { return (unsigned)__builtin_amdgcn_s_getreg((3 << 11) | 20) & 0xFu; }
#define XB_SPIN(cond, bar) do { unsigned _sp = 0; while (cond) { __builtin_amdgcn_s_sleep(1); \
    if ((++_sp & 255u) == 0u) { if (xb_ld(&(bar)[XB_TMO])) break; if (_sp > XB_SPIN_CAP) { atomicAdd(&(bar)[XB_TMO], 1u); break; } } } } while (0)

struct XcdBarrier {
    unsigned* bar; unsigned x;
    volatile LAS unsigned* st;
};

__device__ __forceinline__ XcdBarrier xcd_barrier_post(unsigned* bar, volatile LAS unsigned* st) {
    XcdBarrier b; b.bar = bar; b.x = xb_xcc_id(); b.st = st;
    if (threadIdx.x == 0) (void)xb_add(&bar[XB_XCNT(b.x)], 1u);
    return b;
}
__device__ __forceinline__ void xcd_barrier_complete(unsigned* bar, unsigned x, unsigned& nloc, unsigned& nx) {
    const unsigned G = gridDim.x * gridDim.y * gridDim.z;
    unsigned sum, cnt, mine, sp = 0u;
    for (;;) {
        sum = 0u; cnt = 0u; mine = 0u;
#pragma unroll
        for (unsigned j = 0; j < 16; ++j) { const unsigned c = xb_ld(&bar[XB_XCNT(j)]); sum += c; cnt += (c > 0u) ? 1u : 0u; mine = (j == x) ? c : mine; }
        if (sum == G) break;
        __builtin_amdgcn_s_sleep(1);
        if ((++sp & 255u) == 0u) { if (xb_ld(&bar[XB_TMO])) break; if (sp > XB_SPIN_CAP) { atomicAdd(&bar[XB_TMO], 1u); break; } }
    }
    nloc = mine > 0u ? mine : 1u; nx = cnt > 0u ? cnt : 1u;
}

__device__ __forceinline__ void xcd_barrier(const XcdBarrier& b) {
    asm volatile("s_waitcnt vmcnt(0)" ::: "memory");
    __syncthreads();
    if (threadIdx.x == 0) {
        unsigned* bar = b.bar;
        __builtin_amdgcn_s_waitcnt(0);
        unsigned nloc = b.st[0], nx = b.st[1];
        if (nloc == 0u) { xcd_barrier_complete(bar, b.x, nloc, nx); b.st[0] = nloc; b.st[1] = nx; }
        const unsigned old = xb_add(&bar[XB_XSUB(b.x)], 1u);
        const unsigned gen = old / nloc;
        if (old + 1u == (gen + 1u) * nloc) {
            __builtin_amdgcn_fence(__ATOMIC_RELEASE, "agent");
            asm volatile("s_waitcnt vmcnt(0)" ::: "memory");
            const unsigned og = xb_add(&bar[XB_TOP], 1u);
            const unsigned tg = og / nx;
            if (og + 1u == (tg + 1u) * nx) xb_add(&bar[XB_TOPGEN], 1u);
            else XB_SPIN(xb_ld(&bar[XB_TOPGEN]) == tg, bar);
            __builtin_amdgcn_fence(__ATOMIC_ACQUIRE, "agent");
            xb_add(&bar[XB_XGEN(b.x)], 1u);
            asm volatile("s_waitcnt vmcnt(0)" ::: "memory");
        } else {
            XB_SPIN(xb_ld(&bar[XB_XGEN(b.x)]) == gen, bar);
            __builtin_amdgcn_fence(__ATOMIC_ACQUIRE, "agent");
            asm volatile("s_waitcnt vmcnt(0)" ::: "memory");
        }
    }
    __syncthreads();
}

namespace pg8 {
struct UnitG { int seg, mt, nt; };
template <class Prob, class Epi, bool FP8 = false>
__device__ __forceinline__ void gemm_phase_g(PG8_LAS unsigned char* lds, const Prob& P, const Epi& E) {
    const int tid = threadIdx.x, wid = __builtin_amdgcn_readfirstlane(tid >> 6), lane = tid & 63, wr = wid >> 2, wc = wid & 3, fr = lane & 15, fq = lane >> 4;
    constexpr int EB = FP8 ? 1 : 2;
    const int K = P.K, nt = K * EB / 128;
    unsigned voffB[2], cbA[2];
#pragma unroll
    for (int i = 0; i < 2; ++i) { int R, C; stage_rc(tid * 16 + i * 8192, R, C); const int Rb = Epi::PERM ? ((R & ~31) + perm32(R & 31)) : R; voffB[i] = (unsigned)(Rb * K * EB + C * 2); cbA[i] = (unsigned)(C * 2); }
    const unsigned pitchA = (unsigned)P.pitchA;
    const size_t kstep = (size_t)(BK * 2);
    const size_t hstep = (size_t)HALF * K * EB;
    const unsigned ldsw = (unsigned)wid * 1024u;
    const int aoff = lds_byte(wr * 64 + fr, fq * 8), boff = lds_byte(wc * 32 + fr, fq * 8);
#define PG8_SA(b, h) (((b) * 2 + (h)) * HTB)
#define PG8_SB(b, h) ((4 + (b) * 2 + (h)) * HTB)
#define PG8_STAGE(bufoff, gbase, voff) do { _Pragma("unroll") for (int _i = 0; _i < 2; ++_i) \
        __builtin_amdgcn_global_load_lds((const unsigned*)((const char*)(gbase) + (voff)[_i]), (PG8_LAS unsigned*)(lds + (bufoff) + ldsw + _i * 8192), 16, 0, 0); } while (0)
#define PG8_STAGE_A(bufoff, gbase, rp_) do { const unsigned o0_ = ((rp_) & 0xffffu) * pitchA + cbA[0], o1_ = ((rp_) >> 16) * pitchA + cbA[1]; \
        __builtin_amdgcn_global_load_lds((const unsigned*)((const char*)(gbase) + o0_), (PG8_LAS unsigned*)(lds + (bufoff) + ldsw), 16, 0, 0); \
        __builtin_amdgcn_global_load_lds((const unsigned*)((const char*)(gbase) + o1_), (PG8_LAS unsigned*)(lds + (bufoff) + ldsw + 8192), 16, 0, 0); } while (0)
#define PG8_LDA(dst, b, h) do { _Pragma("unroll") for (int m = 0; m < 4; ++m) { const v4i_ lo_ = *(const PG8_LAS v4i_*)(lds + PG8_SA(b, h) + aoff + m * 2048), hi_ = *(const PG8_LAS v4i_*)(lds + PG8_SA(b, h) + aoff + m * 2048 + 1024); dst[m] = __builtin_shufflevector(lo_, hi_, 0, 1, 2, 3, 4, 5, 6, 7); } } while (0)
#define PG8_LDB(dst, b, h) do { _Pragma("unroll") for (int n = 0; n < 2; ++n) { const v4i_ lo_ = *(const PG8_LAS v4i_*)(lds + PG8_SB(b, h) + boff + n * 2048), hi_ = *(const PG8_LAS v4i_*)(lds + PG8_SB(b, h) + boff + n * 2048 + 1024); dst[n] = __builtin_shufflevector(lo_, hi_, 0, 1, 2, 3, 4, 5, 6, 7); } } while (0)
#define PG8_HALF(v_, k_) __builtin_bit_cast(bf16x8, (v4i_)__builtin_shufflevector(v_, v_, 4 * (k_), 4 * (k_) + 1, 4 * (k_) + 2, 4 * (k_) + 3))
#define PG8_MMA(ai, bj, At, Bt) do { __builtin_amdgcn_s_setprio(1); _Pragma("unroll") for (int m = 0; m < 4; ++m) _Pragma("unroll") for (int n = 0; n < 2; ++n) { \
        acc[ai][bj][m][n] = __builtin_amdgcn_mfma_f32_16x16x32_bf16(PG8_HALF(Bt[n], 0), PG8_HALF(At[m], 0), acc[ai][bj][m][n], 0, 0, 0); \
        acc[ai][bj][m][n] = __builtin_amdgcn_mfma_f32_16x16x32_bf16(PG8_HALF(Bt[n], 1), PG8_HALF(At[m], 1), acc[ai][bj][m][n], 0, 0, 0); } __builtin_amdgcn_s_setprio(0); } while (0)
#define PG8_Q(v_, q_) __builtin_bit_cast(long, (v2i_){v_[2 * (q_)], v_[2 * (q_) + 1]})
#define PG8_MMA8Q(ai, bj, At, Bt, q_) _Pragma("unroll") for (int m = 0; m < 4; ++m) _Pragma("unroll") for (int n = 0; n < 2; ++n) \
            acc[ai][bj][m][n] = __builtin_amdgcn_mfma_f32_16x16x32_fp8_fp8(PG8_Q(Bt[n], q_), PG8_Q(At[m], q_), acc[ai][bj][m][n], 0, 0, 0)
#define PG8_MMA8(ai, bj, At, Bt) do { typedef int v2i_ __attribute__((ext_vector_type(2))); __builtin_amdgcn_s_setprio(1); \
        PG8_MMA8Q(ai, bj, At, Bt, 0); PG8_MMA8Q(ai, bj, At, Bt, 1); PG8_MMA8Q(ai, bj, At, Bt, 2); PG8_MMA8Q(ai, bj, At, Bt, 3); \
        __builtin_amdgcn_s_setprio(0); } while (0)
#define PG8_MM(ai, bj, At, Bt) do { if constexpr (FP8) PG8_MMA8(ai, bj, At, Bt); else PG8_MMA(ai, bj, At, Bt); } while (0)
#define PG8_WAIT_V(n) asm volatile("s_waitcnt vmcnt(" #n ")" ::: "memory")
#define PG8_WAIT_L(n) asm volatile("s_waitcnt lgkmcnt(" #n ")" ::: "memory")
#define PG8_BAR __builtin_amdgcn_s_barrier()
#define PG8_SCHED __builtin_amdgcn_sched_barrier(0)
    UnitG cur, nxt; int ui = 0;
    if (!P.next(0, cur)) return;
    f32x4 acc[2][2][4][2];
#pragma unroll
    for (int a = 0; a < 2; ++a)
#pragma unroll
        for (int b = 0; b < 2; ++b)
#pragma unroll
            for (int m = 0; m < 4; ++m)
#pragma unroll
                for (int n = 0; n < 2; ++n) acc[a][b][m][n] = (f32x4){0.f, 0.f, 0.f, 0.f};
    typedef int v4i_ __attribute__((ext_vector_type(4))); typedef int v8i_ __attribute__((ext_vector_type(8)));
    v8i_ At[4], B0[2], B1[2];
    unsigned rowp[2], rowpn[2];
    const char* cA; const char* cB;
    P.setup_base(cur, cA, cB);
    P.meta(cur, lds, 0, wid, lane);
    P.rows_first(cur, lds, 0, rowp);
    PG8_STAGE(PG8_SB(0, 0), cB, voffB); PG8_STAGE(PG8_SB(0, 1), cB + hstep, voffB); PG8_STAGE_A(PG8_SA(0, 0), cA, rowp[0]); PG8_STAGE_A(PG8_SA(0, 1), cA, rowp[1]);
    if (wr == 1) PG8_BAR;
    PG8_WAIT_V(2); PG8_BAR;
    PG8_STAGE(PG8_SB(1, 0), cB + kstep, voffB); PG8_STAGE_A(PG8_SA(1, 0), cA + kstep, rowp[0]); PG8_STAGE(PG8_SB(1, 1), cB + hstep + kstep, voffB);
    PG8_WAIT_V(6); PG8_BAR;
    for (;;) {
        const bool has_next = P.next(ui + 1, nxt);
        const char* nA = cA; const char* nB = cB;
        rowpn[0] = rowp[0]; rowpn[1] = rowp[1];
        if (has_next) { P.setup_base(nxt, nA, nB); P.meta(nxt, lds, (ui + 1) % 3, wid, lane); }
        for (int t = 0; t < nt; t += 2) {
            const bool last = (t == nt - 2);
            const char* a1 = cA + (size_t)(t + 1) * kstep;
            const char* a2 = last ? nA : cA + (size_t)(t + 2) * kstep; const char* b2 = last ? nB : cB + (size_t)(t + 2) * kstep;
            const char* a3 = a2 + kstep; const char* b3 = b2 + kstep;
            if (last && has_next) P.rows(nxt, lds, (ui + 1) % 3, rowpn);
            const unsigned o2_0 = last ? rowpn[0] : rowp[0], o2_1 = last ? rowpn[1] : rowp[1];
            PG8_LDB(B0, 0, 0); PG8_LDB(B1, 0, 1); PG8_SCHED; PG8_LDA(At, 0, 0); PG8_STAGE_A(PG8_SA(1, 1), a1, rowp[1]);
            PG8_WAIT_V(8); PG8_WAIT_L(0); PG8_BAR; PG8_MM(0, 0, At, B0); PG8_MM(0, 1, At, B1); PG8_BAR; PG8_SCHED;
            PG8_LDA(At, 0, 1); PG8_STAGE(PG8_SB(0, 0), b2, voffB); PG8_STAGE(PG8_SB(0, 1), b2 + hstep, voffB); PG8_STAGE_A(PG8_SA(0, 0), a2, o2_0);
            PG8_WAIT_V(8); PG8_WAIT_L(0); PG8_BAR; PG8_MM(1, 0, At, B0); PG8_MM(1, 1, At, B1); PG8_BAR; PG8_SCHED;
            PG8_LDB(B0, 1, 0); PG8_LDB(B1, 1, 1); PG8_SCHED; PG8_LDA(At, 1, 0); PG8_STAGE_A(PG8_SA(0, 1), a2, o2_1);
            PG8_WAIT_V(8); PG8_WAIT_L(0); PG8_BAR; PG8_MM(0, 0, At, B0); PG8_MM(0, 1, At, B1); PG8_BAR; PG8_SCHED;
            PG8_LDA(At, 1, 1); PG8_STAGE(PG8_SB(1, 0), b3, voffB); PG8_STAGE(PG8_SB(1, 1), b3 + hstep, voffB); PG8_STAGE_A(PG8_SA(1, 0), a3, o2_0);
            PG8_WAIT_V(8); PG8_WAIT_L(0); PG8_BAR; PG8_MM(1, 0, At, B0); PG8_MM(1, 1, At, B1); PG8_BAR; PG8_SCHED;
        }
        if (wr == 0) PG8_BAR;
        E(acc, cur, wr, wc, fr, fq, lds, ui % 3);
        if (!has_next) break;
#pragma unroll
        for (int a = 0; a < 2; ++a)
#pragma unroll
            for (int b = 0; b < 2; ++b)
#pragma unroll
                for (int m = 0; m < 4; ++m)
#pragma unroll
                    for (int n = 0; n < 2; ++n) acc[a][b][m][n] = (f32x4){0.f, 0.f, 0.f, 0.f};
        cur = nxt; cA = nA; cB = nB; ++ui;
        rowp[0] = rowpn[0]; rowp[1] = rowpn[1];
        if (wr == 1) PG8_BAR;
    }
    PG8_WAIT_V(0);
    PG8_BAR;
#undef PG8_SA
#undef PG8_SB
#undef PG8_STAGE
#undef PG8_STAGE_A
#undef PG8_LDA
#undef PG8_LDB
#undef PG8_MMA
#undef PG8_MMA8
#undef PG8_Q
#undef PG8_MMA8Q
#undef PG8_HALF
#undef PG8_MM
#undef PG8_WAIT_V
#undef PG8_WAIT_L
#undef PG8_BAR
#undef PG8_SCHED
}
}

constexpr int NWAVES = 8;
constexpr int BATCH = 2, T = 8192, D = 1024, M = BATCH * T, DIN = 4104, PA = 3072;
constexpr int NE = 64, NEX = 65, DE = 256;
constexpr size_t MiB = 1u << 20;
constexpr size_t WS_CTL = 0, CTL_ZERO_BYTES = 256 * 1024;
constexpr size_t WS_WRHI = 512 * 1024, WS_WRLO = 640 * 1024;
constexpr size_t WS_MOD = 1 * MiB, WS_WAB = 1 * MiB + 256 * 1024, WS_AB = 1 * MiB + 512 * 1024;
constexpr size_t WS_WOUT_T = 2 * MiB, WS_WIN_T = 4 * MiB, WS_H1 = 12 * MiB, WS_PROJA = 44 * MiB, WS_GATES = 142 * MiB;
constexpr size_t WS_QP = 4 * MiB, WS_OI = 20 * MiB, WS_AH = 36 * MiB, WS_GL = 36 * MiB + 512 * 1024, WS_PG = 174 * MiB, WS_BG = 206 * MiB, WS_BH = 238 * MiB, WS_QE = 270 * MiB, WS_OIH = 286 * MiB;
constexpr size_t WS_OMIX = 174 * MiB;
constexpr size_t WS_H2 = 12 * MiB, WS_W1T = 44 * MiB, WS_W2T = 109 * MiB, WS_ACT = 142 * MiB, WS_LIST = 215 * MiB, WS_LISTW = 217 * MiB, WS_Y0 = 12 * MiB, WS_Y1 = 219 * MiB;
constexpr size_t WS_YS = 80 * MiB;
constexpr size_t WS_TOP = 302 * MiB;
constexpr int CAP = 8192;
constexpr int TB_PRE = 0, TB_CNT = 132, TB_OFF = 264;
constexpr int CW_CNT = 16384;
constexpr int CW_BAR = 4096;
constexpr int RING_BYTES = 131072, LDS_BYTES = 163840, LDSCTL_OFF = LDS_BYTES - 1024, MISC_OFF = LDSCTL_OFF + 320, SCR2_OFF = LDS_BYTES - 3072;

__device__ __forceinline__ float bf2f(bf16 v) { return __uint_as_float(((unsigned)v) << 16); }
__device__ __forceinline__ float sigmoidf_(float x) { return 1.f / (1.f + __expf(-x)); }
__device__ __forceinline__ float siluf_(float x) { return x / (1.f + __expf(-x)); }
__device__ __forceinline__ float softplusf_(float x) { return x > 20.f ? x : log1pf(expf(x)); }
__device__ __forceinline__ float c8(float x) { return __builtin_amdgcn_fmed3f(x, -448.f, 448.f); }
__device__ __forceinline__ float wave_sum(float v) {
#pragma unroll
    for (int o = 1; o < 64; o <<= 1) v += __shfl_xor(v, o);
    return v;
}

template <int CTRL> __device__ __forceinline__ float dppf(float v) { return __int_as_float(__builtin_amdgcn_update_dpp(__float_as_int(v), __float_as_int(v), CTRL, 0xf, 0xf, false)); }
__device__ __forceinline__ float rdlane(float v, int l) { return __int_as_float(__builtin_amdgcn_readlane(__float_as_int(v), l)); }
__device__ __forceinline__ float wave_max(float v) {
    v = fmaxf(v, dppf<0xB1>(v)); v = fmaxf(v, dppf<0x4E>(v)); v = fmaxf(v, dppf<0x141>(v)); v = fmaxf(v, dppf<0x140>(v));
    return fmaxf(fmaxf(rdlane(v, 0), rdlane(v, 16)), fmaxf(rdlane(v, 32), rdlane(v, 48)));
}
__device__ __forceinline__ float wave_sum_dpp(float v) {
    v += dppf<0xB1>(v); v += dppf<0x4E>(v); v += dppf<0x141>(v); v += dppf<0x140>(v);
    return (rdlane(v, 0) + rdlane(v, 16)) + (rdlane(v, 32) + rdlane(v, 48));
}

namespace pg8 {
struct EpiProj {
    static constexpr bool PERM = true, AFTER_DRAIN = false;
    bf16_t* projA; bf16_t* gates;
    __device__ __forceinline__ void operator()(const f32x4 (&acc)[2][2][4][2], const Unit& u, int wr, int wc, int fr, int fq) const {
        const int row0 = u.pm * BM + wr * 64 + fr;
        bf16_t* base; int ldc, colt;
        if (u.pn < 12) { base = projA; ldc = 3072; colt = u.pn * BM; } else { base = gates; ldc = 1024; colt = (u.pn - 12) * BM; }
        const int col0 = colt + wc * 32 + 8 * fq;
#pragma unroll
        for (int ai = 0; ai < 2; ++ai)
#pragma unroll
            for (int m = 0; m < 4; ++m) { bf16_t* rowp = base + (size_t)(row0 + ai * HALF + m * 16) * ldc + col0;
#pragma unroll
                for (int bj = 0; bj < 2; ++bj) { const f32x4 v0 = acc[ai][bj][m][0], v1 = acc[ai][bj][m][1];
                    u32x4 w; w.x = cvt_pk_bf16(v0[0], v0[1]); w.y = cvt_pk_bf16(v0[2], v0[3]); w.z = cvt_pk_bf16(v1[0], v1[1]); w.w = cvt_pk_bf16(v1[2], v1[3]);
                    *(u32x4*)(rowp + bj * HALF) = w; } }
    }
};
struct EpiResid {
    static constexpr bool PERM = false, AFTER_DRAIN = false;
    const float* x; const float* mod; float* out;
    __device__ __forceinline__ void operator()(const f32x4 (&acc)[2][2][4][2], const Unit& u, int wr, int wc, int fr, int fq) const {
        const int col0 = u.pn * BM + wc * 32 + 4 * fq;
        const float* g1 = mod + (u.pm * BM >= 8192 ? 6144 : 0) + 2048;
        f32x4 gv[2][2];
#pragma unroll
        for (int bj = 0; bj < 2; ++bj)
#pragma unroll
            for (int n = 0; n < 2; ++n) gv[bj][n] = *(const f32x4*)(g1 + col0 + bj * HALF + n * 16);
#pragma unroll
        for (int ai = 0; ai < 2; ++ai)
#pragma unroll
            for (int mp = 0; mp < 4; mp += 2) { f32x4 xv[2][2][2];
#pragma unroll
                for (int q = 0; q < 2; ++q) { const size_t off = (size_t)(u.pm * BM + ai * HALF + wr * 64 + (mp + q) * 16 + fr) * 1024 + col0;
#pragma unroll
                    for (int bj = 0; bj < 2; ++bj)
#pragma unroll
                        for (int n = 0; n < 2; ++n) xv[q][bj][n] = *(const f32x4*)(x + off + bj * HALF + n * 16); }
#pragma unroll
                for (int q = 0; q < 2; ++q) { const size_t off = (size_t)(u.pm * BM + ai * HALF + wr * 64 + (mp + q) * 16 + fr) * 1024 + col0;
#pragma unroll
                    for (int bj = 0; bj < 2; ++bj)
#pragma unroll
                        for (int n = 0; n < 2; ++n) *(f32x4*)(out + off + bj * HALF + n * 16) = xv[q][bj][n] + gv[bj][n] * acc[ai][bj][mp + q][n]; }
            }
    }
};

struct MoeSched {
    const LAS unsigned* tb; int lo, hi, NT, G, c; int perm;
    __device__ __forceinline__ int segof(int p) const { return perm ? (p & 1) * 65 + (p >> 1) : p; }
    __device__ __forceinline__ bool next(int i, UnitG& u) const {
        const unsigned L = (unsigned)(i * G + c); if (L >= tb[TB_PRE + hi]) return false;
        int s = lo; { int hi_ = hi; while (hi_ - s > 1) { const int mid = (s + hi_) >> 1; if (L >= tb[TB_PRE + mid]) s = mid; else hi_ = mid; } }
        const int sg = segof(s);
        const unsigned loc = L - tb[TB_PRE + s], tiles = (tb[TB_CNT + sg] + 255u) >> 8;
        u.seg = __builtin_amdgcn_readfirstlane(sg); u.mt = __builtin_amdgcn_readfirstlane((int)(loc % tiles)); u.nt = __builtin_amdgcn_readfirstlane((int)(loc / tiles)); return true;
    }
};
struct Moe1Prob {
    int K; int pitchA; MoeSched S; const unsigned char* h2; const unsigned char* w1t; const int* list;
    __device__ __forceinline__ bool next(int i, UnitG& u) const { return S.next(i, u); }
    __device__ __forceinline__ void setup_base(const UnitG& u, const char*& cA, const char*& cB) const { cA = (const char*)h2; cB = (const char*)(w1t + ((size_t)u.seg * 512 + (size_t)u.nt * 256) * 1024); }
    __device__ __forceinline__ void meta(const UnitG& u, PG8_LAS unsigned char* lds, int slot, int wid, int lane) const {
        if (wid == 0 && u.seg < 64) __builtin_amdgcn_global_load_lds((const unsigned*)(list + (size_t)u.seg * CAP + 256u * (unsigned)u.mt + 4u * (unsigned)lane), (PG8_LAS unsigned*)(lds + STAGE_BYTES + slot * 2048), 16, 0, 0);
    }
    __device__ __forceinline__ void rows(const UnitG& u, PG8_LAS unsigned char* lds, int slot, unsigned (&rowp)[2]) const {
        int sR[2], sC[2];
#pragma unroll
        for (int i = 0; i < 2; ++i) stage_rc((int)threadIdx.x * 16 + i * 8192, sR[i], sC[i]);
        const int e = u.seg; const int cnt = (int)S.tb[TB_CNT + u.seg]; const PG8_LAS int* tbl = (const PG8_LAS int*)(lds + STAGE_BYTES + slot * 2048);
#pragma unroll
        for (int h = 0; h < 2; ++h) { unsigned tk[2];
#pragma unroll
            for (int i = 0; i < 2; ++i) { const int rl = 128 * h + sR[i], r = 256 * u.mt + rl;
                if (e < 64) { const int last_ = cnt - 1 - 256 * u.mt; tk[i] = (unsigned)tbl[rl < last_ ? rl : last_] >> 3; } else tk[i] = (unsigned)(r < M ? r : M - 1); }
            rowp[h] = tk[0] | (tk[1] << 16); }
    }
    __device__ __forceinline__ void rows_first(const UnitG& u, PG8_LAS unsigned char* lds, int slot, unsigned (&rowp)[2]) const {
        asm volatile("s_waitcnt vmcnt(0)" ::: "memory"); __builtin_amdgcn_s_barrier(); asm volatile("" ::: "memory");
        rows(u, lds, slot, rowp);
    }
};
struct Moe2Prob {
    int K; int pitchA; MoeSched S; const unsigned char* act; const unsigned char* w2t; const int* list; const float* listw;
    __device__ __forceinline__ bool next(int i, UnitG& u) const { return S.next(i, u); }
    __device__ __forceinline__ void meta(const UnitG& u, PG8_LAS unsigned char* lds, int par, int wid, int lane) const {
        if (wid == 0 && u.seg < 64) { const size_t o = (size_t)u.seg * CAP + 256u * (unsigned)u.mt + 4u * (unsigned)lane;
            __builtin_amdgcn_global_load_lds((const unsigned*)(list + o), (PG8_LAS unsigned*)(lds + STAGE_BYTES + par * 2048), 16, 0, 0);
            __builtin_amdgcn_global_load_lds((const unsigned*)(listw + o), (PG8_LAS unsigned*)(lds + STAGE_BYTES + par * 2048 + 1024), 16, 0, 0); }
    }
    __device__ __forceinline__ void setup_base(const UnitG& u, const char*& cA, const char*& cB) const {
        const size_t rowbase = (size_t)S.tb[TB_OFF + u.seg] + 256u * (unsigned)u.mt;
        cA = (const char*)(act + rowbase * 256); cB = (const char*)(w2t + ((size_t)u.seg * 1024 + (size_t)u.nt * 256) * 256);
    }
    __device__ __forceinline__ void rows(const UnitG&, PG8_LAS unsigned char*, int, unsigned (&rowp)[2]) const {
        int sR[2], sC[2];
#pragma unroll
        for (int i = 0; i < 2; ++i) stage_rc((int)threadIdx.x * 16 + i * 8192, sR[i], sC[i]);
#pragma unroll
        for (int h = 0; h < 2; ++h) rowp[h] = (unsigned)(128 * h + sR[0]) | ((unsigned)(128 * h + sR[1]) << 16);
    }
    __device__ __forceinline__ void rows_first(const UnitG& u, PG8_LAS unsigned char* lds, int slot, unsigned (&rowp)[2]) const { rows(u, lds, slot, rowp); }
};
struct EpiMoe1 {
    static constexpr bool PERM = true;
    unsigned char* act; const LAS unsigned* tb;
    __device__ __forceinline__ void operator()(const f32x4 (&acc)[2][2][4][2], const UnitG& u, int wr, int wc, int fr_, int fq_, PG8_LAS unsigned char*, int) const {
        int t_ = (int)threadIdx.x; asm volatile("" : "+v"(t_));
        const int fr = t_ & 15, fq = (t_ >> 4) & 3;
        const int cnt = (int)tb[TB_CNT + u.seg]; const size_t rowbase = tb[TB_OFF + u.seg];
#pragma unroll
        for (int ai = 0; ai < 2; ++ai)
#pragma unroll
            for (int m = 0; m < 4; ++m) { const int r = 256 * u.mt + ai * HALF + wr * 64 + m * 16 + fr;
                if (r < cnt) { unsigned char* p = act + (rowbase + (size_t)r) * 256 + u.nt * 128 + wc * 32 + 8 * fq;
                    const f32x4 g0 = acc[ai][0][m][0], g1 = acc[ai][0][m][1], u0 = acc[ai][1][m][0], u1 = acc[ai][1][m][1]; f32x4 v0, v1;
#pragma unroll
                    for (int i = 0; i < 4; ++i) { const float ga = g0[i] * 0.03125f, gb = g1[i] * 0.03125f; v0[i] = ga / (1.f + __expf(-ga)) * (u0[i] * 0.25f); v1[i] = gb / (1.f + __expf(-gb)) * (u1[i] * 0.25f); }
                    unsigned o0 = __builtin_amdgcn_cvt_pk_fp8_f32(c8(v0[0]), c8(v0[1]), 0, false); o0 = __builtin_amdgcn_cvt_pk_fp8_f32(c8(v0[2]), c8(v0[3]), o0, true);
                    unsigned o1 = __builtin_amdgcn_cvt_pk_fp8_f32(c8(v1[0]), c8(v1[1]), 0, false); o1 = __builtin_amdgcn_cvt_pk_fp8_f32(c8(v1[2]), c8(v1[3]), o1, true);
                    typedef unsigned u32x2_ __attribute__((ext_vector_type(2)));
                    *(u32x2_*)p = (u32x2_){o0, o1}; } }
    }
};
struct EpiMoe2 {
    static constexpr bool PERM = true;
    unsigned char* y0; unsigned char* y1; unsigned char* ys; const LAS unsigned* tb;
    __device__ __forceinline__ void operator()(const f32x4 (&acc)[2][2][4][2], const UnitG& u, int wr, int wc, int fr_, int fq_, PG8_LAS unsigned char* lds, int par) const {
        int t_ = (int)threadIdx.x; asm volatile("" : "+v"(t_));
        const int fr = t_ & 15, fq = (t_ >> 4) & 3;
        const int cnt = (int)tb[TB_CNT + u.seg]; const int e = u.seg; const int colt = u.nt * 256 + wc * 32 + 8 * fq;
        const PG8_LAS int* mslot = (const PG8_LAS int*)(lds + STAGE_BYTES + par * 2048); const PG8_LAS float* mw = (const PG8_LAS float*)(lds + STAGE_BYTES + par * 2048 + 1024);
#pragma unroll
        for (int ai = 0; ai < 2; ++ai)
#pragma unroll
            for (int m = 0; m < 4; ++m) { const int rl = ai * HALF + wr * 64 + m * 16 + fr, r = 256 * u.mt + rl;
                if (r < cnt) { int sl; float w;
                    if (e < 64) { sl = mslot[rl]; w = mw[rl] * 0.25f; } else { sl = r; w = 0.25f; }
                    unsigned char* p = (e < 64 ? (sl >= 65536 ? y1 + (size_t)(sl - 65536) * 1024 : y0 + (size_t)sl * 1024) : ys + (size_t)sl * 1024) + colt;
#pragma unroll
                    for (int bj = 0; bj < 2; ++bj) { const f32x4 v0 = acc[ai][bj][m][0] * w, v1 = acc[ai][bj][m][1] * w;
                        unsigned o0 = __builtin_amdgcn_cvt_pk_fp8_f32(v0[0], v0[1], 0, false); o0 = __builtin_amdgcn_cvt_pk_fp8_f32(v0[2], v0[3], o0, true);
                        unsigned o1 = __builtin_amdgcn_cvt_pk_fp8_f32(v1[0], v1[1], 0, false); o1 = __builtin_amdgcn_cvt_pk_fp8_f32(v1[2], v1[3], o1, true);
                        typedef unsigned u32x2_ __attribute__((ext_vector_type(2)));
                        *(u32x2_*)(p + bj * HALF) = (u32x2_){o0, o1}; } } }
    }
};
}

struct TrItem { const float* W; int ldw, src_col; bf16* WT; int K, dst_row, k0; float f8scale; };
__device__ __forceinline__ void tr_load(const TrItem& t, int lane, f32x4 (&v)[8]) {
#pragma unroll
    for (int i = 0; i < 8; ++i) v[i] = *(const GAS f32x4*)(t.W + (size_t)(t.k0 + 8 * i + (lane >> 3)) * t.ldw + t.src_col + 4 * (lane & 7));
}
__device__ __forceinline__ void tr_finish(const TrItem& t, int lane, const f32x4 (&v)[8], LAS float* scr) {
#pragma unroll
    for (int i = 0; i < 8; ++i) { LAS float* p = scr + (8 * i + (lane >> 3)) * 33 + 4 * (lane & 7); p[0] = v[i][0]; p[1] = v[i][1]; p[2] = v[i][2]; p[3] = v[i][3]; }
    LDS_WAIT(); asm volatile("" ::: "memory");
    const int c = lane & 7;
#pragma unroll
    for (int j = 0; j < 4; ++j) { const int n = (lane >> 3) + 8 * j; const LAS float* s = scr + (8 * c) * 33 + n;
        if (t.f8scale != 0.f) { const float q = t.f8scale; typedef unsigned u32x2_ __attribute__((ext_vector_type(2)));
            unsigned o0 = __builtin_amdgcn_cvt_pk_fp8_f32(s[0 * 33] * q, s[1 * 33] * q, 0, false); o0 = __builtin_amdgcn_cvt_pk_fp8_f32(s[2 * 33] * q, s[3 * 33] * q, o0, true);
            unsigned o1 = __builtin_amdgcn_cvt_pk_fp8_f32(s[4 * 33] * q, s[5 * 33] * q, 0, false); o1 = __builtin_amdgcn_cvt_pk_fp8_f32(s[6 * 33] * q, s[7 * 33] * q, o1, true);
            *(GAS u32x2_*)((GAS unsigned char*)t.WT + (size_t)(t.dst_row + n) * t.K + t.k0 + 8 * c) = (u32x2_){o0, o1};
        } else {
        v4u o; o.x = pk2(s[0 * 33], s[1 * 33]); o.y = pk2(s[2 * 33], s[3 * 33]); o.z = pk2(s[4 * 33], s[5 * 33]); o.w = pk2(s[6 * 33], s[7 * 33]);
        *(GAS v4u*)(t.WT + (size_t)(t.dst_row + n) * t.K + t.k0 + 8 * c) = o; } }
    LDS_WAIT(); asm volatile("" ::: "memory");
}
#define TR_LOOP(it0, stride, nitems, MAKE) do { int it_ = (it0); if (it_ < (nitems)) { TrItem cur_ = MAKE(it_); f32x4 va_[8], vb_[8]; tr_load(cur_, lane, va_); \
    for (;;) { const int nx_ = it_ + (stride); const bool hn_ = nx_ < (nitems); TrItem nxt_ = cur_; if (hn_) { nxt_ = MAKE(nx_); tr_load(nxt_, lane, vb_); } \
        tr_finish(cur_, lane, va_, scr); if (!hn_) break; _Pragma("unroll") for (int q_ = 0; q_ < 8; ++q_) va_[q_] = vb_[q_]; cur_ = nxt_; it_ = nx_; } } } while (0)

#ifndef REP_PHASE
#define REP_PHASE -1
#endif
#ifndef REP_N
#define REP_N 1
#endif
#define REPN(k) ((k) == REP_PHASE ? REP_N : 1)

constexpr int UNITS = BATCH * 128 * 4;
constexpr int L_QN = 0, L_KN = 17408, L_VV = 34816, L_LM = 52224, L_ATT = 68608, L_UT = 77824, L_WT = 96256, L_KTT = 114688, L_GCS = 133120, L_EGS = 133376, L_BET = 133632, L_SCW = 133888, L_SKT = 134144, L_TM = L_KN, L_TB = L_VV;
constexpr int H_FR = 0, H_QR = 17408, H_QE = 34816, H_KD = 52224, H_KTT = 69632, H_VT = 88064, H_AM = 106496;
constexpr int RS = 272, TS = 144;

typedef unsigned v2u __attribute__((ext_vector_type(2)));
#define LBAR() do { asm volatile("s_waitcnt lgkmcnt(0)" ::: "memory"); __builtin_amdgcn_s_barrier(); asm volatile("" ::: "memory"); } while (0)
__device__ __forceinline__ f32x4 mfma16(bf16x8 a, bf16x8 b, f32x4 c) { return __builtin_amdgcn_mfma_f32_16x16x32_bf16(a, b, c, 0, 0, 0); }
__device__ __forceinline__ bf16x8 ldsfrag(const LAS unsigned char* base, int row, int stride, int kbyte) { return *(const LAS bf16x8*)(base + row * stride + kbyte); }
__device__ __forceinline__ void unpack8(const v4u q, float (&f)[8]) {
    f[0] = __uint_as_float(q.x << 16); f[1] = __uint_as_float(q.x & 0xffff0000u); f[2] = __uint_as_float(q.y << 16); f[3] = __uint_as_float(q.y & 0xffff0000u);
    f[4] = __uint_as_float(q.z << 16); f[5] = __uint_as_float(q.z & 0xffff0000u); f[6] = __uint_as_float(q.w << 16); f[7] = __uint_as_float(q.w & 0xffff0000u); }
__device__ __forceinline__ f32x4 unpack4(const v2u q) { return (f32x4){__uint_as_float(q.x << 16), __uint_as_float(q.x & 0xffff0000u), __uint_as_float(q.y << 16), __uint_as_float(q.y & 0xffff0000u)}; }
__device__ __forceinline__ v2u pack4(const f32x4 v) { v2u o; o.x = pk2(v[0], v[1]); o.y = pk2(v[2], v[3]); return o; }
__device__ __forceinline__ float ldsbf(const LAS unsigned char* base, int row, int stride, int col) { return __uint_as_float(((unsigned)*(const LAS unsigned short*)(base + row * stride + col * 2)) << 16); }

struct MixPtrs {
    const bf16* projA; const bf16* gates; const float* ab; const float* conv_w; const float* a_log; const float* dt_bias; const float* hg_lb; const float* gdn_nw; const float* hg_nw;
    bf16 *PG, *BG, *QP, *OI, *BH, *QE, *OIH, *SG, *SH, *omix; float *GL, *AH;
};

__device__ __forceinline__ void p3_gdn_unit(LAS unsigned char* lds, const MixPtrs& X, int unit, int tid, int lane, int wave) {
    const int h = unit & 3, n = (unit >> 2) & 127, b = unit >> 9, r = lane & 15, g = lane >> 4;
    const size_t tok0 = (size_t)b * T + (size_t)n * 64;
    LAS float* gcs = (LAS float*)(lds + L_GCS); LAS float* egs = (LAS float*)(lds + L_EGS); LAS float* bet = (LAS float*)(lds + L_BET);
    {
#pragma unroll 1
      for (int ib = 0; ib < 6; ib += 3) {
        v4u raw[3][4];
#pragma unroll
        for (int i2 = 0; i2 < 3; ++i2) { const int i = ib + i2; const int pair = (tid >> 4) + 32 * i, tz = pair >> 6, c = pair & 63, ch = tid & 15, col = tz * 512 + h * 128 + ch * 8;
#pragma unroll
            for (int j = 0; j < 4; ++j) { const int tl = n * 64 + c - 3 + j; raw[i2][j] = *(const GAS v4u*)(X.projA + ((size_t)b * T + (tl < 0 ? 0 : tl)) * PA + col); } }
#pragma unroll
        for (int i2 = 0; i2 < 3; ++i2) { const int i = ib + i2;
            const int pair = (tid >> 4) + 32 * i, tz = pair >> 6, c = pair & 63, ch = tid & 15, col = tz * 512 + h * 128 + ch * 8;
            float y[8];
#pragma unroll
            for (int e = 0; e < 8; ++e) y[e] = 0.f;
#pragma unroll
            for (int j = 0; j < 4; ++j) { const int tl = n * 64 + c - 3 + j; const float msk = tl >= 0 ? 1.f : 0.f; float xf[8]; unpack8(raw[i2][j], xf);
                const f32x4 w0 = *(const GAS f32x4*)(X.conv_w + j * 1536 + col) * msk, w1 = *(const GAS f32x4*)(X.conv_w + j * 1536 + col + 4) * msk;
#pragma unroll
                for (int e = 0; e < 4; ++e) { y[e] += w0[e] * xf[e]; y[4 + e] += w1[e] * xf[4 + e]; } }
            float ss = 0.f;
#pragma unroll
            for (int e = 0; e < 8; ++e) { y[e] = siluf_(y[e]); ss += y[e] * y[e]; }
            ss += __shfl_xor(ss, 1); ss += __shfl_xor(ss, 2); ss += __shfl_xor(ss, 4); ss += __shfl_xor(ss, 8);
            const float rn = tz == 2 ? 1.f : rsqrtf(ss + 1e-6f) * (tz == 0 ? 0.08838834764831845f : 1.f);
            v4u o; o.x = pk2(y[0] * rn, y[1] * rn); o.y = pk2(y[2] * rn, y[3] * rn); o.z = pk2(y[4] * rn, y[5] * rn); o.w = pk2(y[6] * rn, y[7] * rn);
            *(LAS v4u*)(lds + (tz == 0 ? L_QN : (tz == 1 ? L_KN : L_VV)) + c * RS + ch * 16) = o;
        }
      }
    }
    if (wave == 0) {
        const float araw = X.ab[(tok0 + lane) * 8 + 4 + h], braw = X.ab[(tok0 + lane) * 8 + h];
        float gv = -expf(X.a_log[h]) * softplusf_(araw + X.dt_bias[h]);
#pragma unroll
        for (int o = 1; o < 64; o <<= 1) { const float t = __shfl_up(gv, o); if (lane >= o) gv += t; }
        { const float eg_ = __expf(gv), be_ = sigmoidf_(braw); gcs[lane] = gv; egs[lane] = eg_; bet[lane] = be_; *(LAS float*)(lds + L_SCW + lane * 4) = be_ * eg_; *(LAS float*)(lds + L_SKT + lane * 4) = __expf(__shfl(gv, 63) - gv); }
        if (lane == 63) X.GL[unit] = gv;
    }
    LBAR();
    {
        const int mt = wave >> 1;
#pragma unroll
        for (int q = 0; q < 2; ++q) { const int ntc = 2 * (wave & 1) + q; f32x4 akk = {0.f, 0.f, 0.f, 0.f}, aqk = {0.f, 0.f, 0.f, 0.f};
#pragma unroll
            for (int ks = 0; ks < 4; ++ks) { const bf16x8 ka = ldsfrag(lds + L_KN, 16 * mt + r, RS, 64 * ks + 16 * g), qa = ldsfrag(lds + L_QN, 16 * mt + r, RS, 64 * ks + 16 * g), kb = ldsfrag(lds + L_KN, 16 * ntc + r, RS, 64 * ks + 16 * g);
                akk = mfma16(ka, kb, akk); aqk = mfma16(qa, kb, aqk); }
            const int j = 16 * ntc + r; const float gj = gcs[j];
#pragma unroll
            for (int ii = 0; ii < 4; ++ii) { const int i = 16 * mt + 4 * g + ii; const float dec = (i >= j) ? __expf(gcs[i] - gj) : 0.f;
                *(LAS float*)(lds + L_LM + (i * 64 + j) * 4) = (i > j) ? bet[i] * akk[ii] * dec : 0.f;
                *(LAS unsigned short*)(lds + L_ATT + i * TS + j * 2) = (unsigned short)f2bf(aqk[ii] * dec); } }
    }
    LBAR();
#pragma unroll
    for (int i = 0; i < 2; ++i) { const int tsk = tid + 512 * i;
        if (tsk < 768) { const int a = tsk >> 8, hh = (tsk >> 7) & 1, d = tsk & 127;
            const LAS unsigned char* sp = lds + (a == 0 ? L_VV : L_KN) + d * 2; const LAS float* scl = (const LAS float*)(lds + (a == 0 ? L_BET : (a == 1 ? L_SCW : L_SKT)));
            LAS unsigned char* dp = lds + (a == 0 ? L_UT : (a == 1 ? L_WT : L_KTT)) + d * TS + 64 * hh;
#pragma unroll
            for (int q = 0; q < 4; ++q) { float kv[8];
#pragma unroll
                for (int e = 0; e < 8; ++e) { const int c = 32 * hh + 8 * q + e; kv[e] = __uint_as_float(((unsigned)*(const LAS unsigned short*)(sp + c * RS)) << 16) * scl[c]; }
                v4u o; o.x = pk2(kv[0], kv[1]); o.y = pk2(kv[2], kv[3]); o.z = pk2(kv[4], kv[5]); o.w = pk2(kv[6], kv[7]); *(LAS v4u*)(dp + 16 * q) = o; } } }
    LBAR();
    { const LAS float* Lm = (const LAS float*)(lds + L_LM); LAS float* Tm = (LAS float*)(lds + L_TM);
      if (tid < 64) { const int I = tid >> 4, j = tid & 15; float x[16];
#pragma unroll
          for (int i = 0; i < 16; ++i) { float s = (i == j) ? 1.f : 0.f;
#pragma unroll
              for (int kb = 0; kb < (i + 3) / 4; ++kb) { const f32x4 l = *(const LAS f32x4*)(Lm + (16 * I + i) * 64 + 16 * I + 4 * kb);
#pragma unroll
                  for (int e = 0; e < 4; ++e) if (4 * kb + e < i) s -= l[e] * x[4 * kb + e]; }
              x[i] = (i < j) ? 0.f : s; Tm[(16 * I + i) * 64 + 16 * I + j] = x[i]; } }
      LBAR();
#pragma unroll 1
      for (int lv = 1; lv < 4; ++lv) {
          for (int e = tid; e < (4 - lv) * 256; e += NWAVES * 64) { const int I = lv + (e >> 8), J = I - lv, rr = (e >> 4) & 15, cc = e & 15; float w = 0.f;
              for (int K = J; K < I; ++K) {
#pragma unroll
                  for (int kb = 0; kb < 4; ++kb) { const f32x4 l = *(const LAS f32x4*)(Lm + (16 * I + rr) * 64 + 16 * K + 4 * kb);
#pragma unroll
                      for (int q = 0; q < 4; ++q) w += l[q] * Tm[(16 * K + 4 * kb + q) * 64 + 16 * J + cc]; } }
              Tm[(16 * J + rr) * 64 + 16 * I + cc] = w; }
          LBAR();
          for (int e = tid; e < (4 - lv) * 256; e += NWAVES * 64) { const int I = lv + (e >> 8), J = I - lv, rr = (e >> 4) & 15, cc = e & 15; float t = 0.f;
#pragma unroll
              for (int kb = 0; kb < 4; ++kb) { const f32x4 l = *(const LAS f32x4*)(Tm + (16 * I + rr) * 64 + 16 * I + 4 * kb);
#pragma unroll
                  for (int q = 0; q < 4; ++q) t -= l[q] * Tm[(16 * J + 4 * kb + q) * 64 + 16 * I + cc]; }
              Tm[(16 * I + rr) * 64 + 16 * J + cc] = t; }
          LBAR();
      }
      { const int i = tid >> 3, j0 = (tid & 7) * 8; const f32x4 t0 = *(const LAS f32x4*)(Tm + i * 64 + j0), t1 = *(const LAS f32x4*)(Tm + i * 64 + j0 + 4); const bool keep = (i >> 4) >= (j0 >> 4);
        v4u o; o.x = keep ? pk2(t0[0], t0[1]) : 0u; o.y = keep ? pk2(t0[2], t0[3]) : 0u; o.z = keep ? pk2(t1[0], t1[1]) : 0u; o.w = keep ? pk2(t1[2], t1[3]) : 0u;
        *(LAS v4u*)(lds + L_TB + i * TS + j0 * 2) = o; }
      LBAR();
    }
    { bf16x8 af[4][2];
#pragma unroll
      for (int mt = 0; mt < 4; ++mt)
#pragma unroll
          for (int ks = 0; ks < 2; ++ks) af[mt][ks] = ldsfrag(lds + L_TB, 16 * mt + r, TS, 64 * ks + 16 * g);
#pragma unroll
      for (int q = 0; q < 2; ++q) { const int ng = 2 * wave + q; LAS unsigned char* base = lds + (ng >= 8 ? L_WT : L_UT) + (16 * (ng & 7) + r) * TS;
          const bf16x8 b0 = *(const LAS bf16x8*)(base + 16 * g), b1 = *(const LAS bf16x8*)(base + 64 + 16 * g);
          f32x4 acc[4];
#pragma unroll
          for (int mt = 0; mt < 4; ++mt) { acc[mt] = mfma16(af[mt][0], b0, (f32x4){0.f, 0.f, 0.f, 0.f}); acc[mt] = mfma16(af[mt][1], b1, acc[mt]); }
          asm volatile("s_waitcnt lgkmcnt(0)" ::: "memory");
#pragma unroll
          for (int mt = 0; mt < 4; ++mt) *(LAS v2u*)(base + (16 * mt + 4 * g) * 2) = pack4(acc[mt]); }
    }
    LBAR();
    {
        const size_t u16 = (size_t)unit * 16384, u8 = (size_t)unit * 8192;
        { const int kk = wave >> 1;
          bf16x8 af[2][2];
#pragma unroll
          for (int t2 = 0; t2 < 2; ++t2)
#pragma unroll
              for (int ks = 0; ks < 2; ++ks) af[t2][ks] = ldsfrag(lds + L_WT, 16 * (2 * kk + t2) + r, TS, 64 * ks + 16 * g);
#pragma unroll
          for (int q = 0; q < 4; ++q) { const int nt = 4 * (wave & 1) + q; f32x4 a0 = {0.f, 0.f, 0.f, 0.f}, a1 = {0.f, 0.f, 0.f, 0.f};
#pragma unroll
              for (int ks = 0; ks < 2; ++ks) { const bf16x8 bfr = ldsfrag(lds + L_KTT, 16 * nt + r, TS, 64 * ks + 16 * g); a0 = mfma16(af[0][ks], bfr, a0); a1 = mfma16(af[1][ks], bfr, a1); }
              v2u o; o.x = __builtin_amdgcn_cvt_pk_fp8_f32(-16.f * a0[0], -16.f * a0[1], 0, false); o.x = __builtin_amdgcn_cvt_pk_fp8_f32(-16.f * a0[2], -16.f * a0[3], o.x, true);
              o.y = __builtin_amdgcn_cvt_pk_fp8_f32(-16.f * a1[0], -16.f * a1[1], 0, false); o.y = __builtin_amdgcn_cvt_pk_fp8_f32(-16.f * a1[2], -16.f * a1[3], o.y, true);
              *(GAS v2u*)((GAS unsigned char*)X.PG + (size_t)unit * 16384 + ((size_t)(nt * 4 + kk) * 64 + lane) * 8) = o; } }
        { const int mt = wave; bf16x8 af[2];
#pragma unroll
          for (int ks = 0; ks < 2; ++ks) af[ks] = ldsfrag(lds + L_KTT, 16 * mt + r, TS, 64 * ks + 16 * g);
#pragma unroll
          for (int nt = 0; nt < 8; ++nt) { f32x4 a0 = {0.f, 0.f, 0.f, 0.f};
#pragma unroll
              for (int ks = 0; ks < 2; ++ks) a0 = mfma16(af[ks], ldsfrag(lds + L_UT, 16 * nt + r, TS, 64 * ks + 16 * g), a0);
              *(GAS v2u*)(X.BG + u16 + ((size_t)(nt * 8 + mt) * 64 + lane) * 4) = pack4(a0); } }
        { const int kk = wave >> 1;
#pragma unroll
          for (int q = 0; q < 2; ++q) { const int ct = 2 * (wave & 1) + q; f32x4 a0 = {0.f, 0.f, 0.f, 0.f}, a1 = {0.f, 0.f, 0.f, 0.f};
#pragma unroll
              for (int ks = 0; ks < 2; ++ks) { const bf16x8 bfr = ldsfrag(lds + L_ATT, 16 * ct + r, TS, 64 * ks + 16 * g);
                  a0 = mfma16(ldsfrag(lds + L_WT, 16 * (2 * kk) + r, TS, 64 * ks + 16 * g), bfr, a0); a1 = mfma16(ldsfrag(lds + L_WT, 16 * (2 * kk + 1) + r, TS, 64 * ks + 16 * g), bfr, a1); }
              const int c = 16 * ct + r; const float eg = egs[c];
              const f32x4 q0 = unpack4(*(const LAS v2u*)(lds + L_QN + c * RS + (32 * kk + 4 * g) * 2)), q1 = unpack4(*(const LAS v2u*)(lds + L_QN + c * RS + (32 * kk + 16 + 4 * g) * 2));
              v4u o; o.x = pk2(q0[0] * eg - a0[0], q0[1] * eg - a0[1]); o.y = pk2(q0[2] * eg - a0[2], q0[3] * eg - a0[3]); o.z = pk2(q1[0] * eg - a1[0], q1[1] * eg - a1[1]); o.w = pk2(q1[2] * eg - a1[2], q1[3] * eg - a1[3]);
              *(GAS v4u*)(X.QP + u8 + ((size_t)(ct * 4 + kk) * 64 + lane) * 8) = o; } }
        { const int vt = wave; bf16x8 af[2];
#pragma unroll
          for (int ks = 0; ks < 2; ++ks) af[ks] = ldsfrag(lds + L_UT, 16 * vt + r, TS, 64 * ks + 16 * g);
#pragma unroll
          for (int ct = 0; ct < 4; ++ct) { f32x4 a0 = {0.f, 0.f, 0.f, 0.f};
#pragma unroll
              for (int ks = 0; ks < 2; ++ks) a0 = mfma16(af[ks], ldsfrag(lds + L_ATT, 16 * ct + r, TS, 64 * ks + 16 * g), a0);
              *(GAS v2u*)(X.OI + u8 + ((size_t)(vt * 4 + ct) * 64 + lane) * 4) = pack4(a0); } }
    }
    LBAR();
}

__device__ __forceinline__ void p3_hgrn_unit(LAS unsigned char* lds, const MixPtrs& X, int unit, int tid, int lane, int wave) {
    const int h = unit & 3, n = (unit >> 2) & 127, b = unit >> 9, r = lane & 15, g = lane >> 4;
    const size_t tok0 = (size_t)b * T + (size_t)n * 64;
#pragma unroll
    for (int i = 0; i < 4; ++i) { const int pair = (tid >> 4) + 32 * i, tz = pair >> 6, c = pair & 63, ch = tid & 15;
        const v4u q = *(const GAS v4u*)(X.projA + (tok0 + c) * PA + (tz ? 2560 : 1536) + h * 128 + ch * 8);
        *(LAS v4u*)(lds + (tz ? H_QR : H_FR) + c * RS + ch * 16) = q; }
    {
        v4u rv[2];
#pragma unroll
        for (int i = 0; i < 2; ++i) { const int item = tid + 512 * i, c = item >> 4, ch = item & 15; rv[i] = *(const GAS v4u*)(X.projA + (tok0 + c) * PA + 2048 + h * 128 + ch * 8); }
#pragma unroll
        for (int i = 0; i < 2; ++i) { const int item = tid + 512 * i, c = item >> 4, ch = item & 15; const unsigned w[4] = {rv[i].x, rv[i].y, rv[i].z, rv[i].w};
#pragma unroll
            for (int e = 0; e < 4; ++e) { *(LAS unsigned short*)(lds + H_VT + (ch * 8 + 2 * e) * TS + c * 2) = (unsigned short)(w[e] & 0xffffu); *(LAS unsigned short*)(lds + H_VT + (ch * 8 + 2 * e + 1) * TS + c * 2) = (unsigned short)(w[e] >> 16); } }
    }
    LBAR();
    {
        const int d = tid & 127, seg = tid >> 7; LAS float* segt = (LAS float*)(lds + H_AM + 9216);
        const float l0 = X.hg_lb[h * 128 + d], l1 = X.hg_lb[512 + h * 128 + d]; const float mx = fmaxf(l0, l1); const float e0 = __expf(l0 - mx), e1 = __expf(l1 - mx); const float lb = e0 / (e0 + e1);
        float lc[16], kq[16]; float run = 0.f;
#pragma unroll
        for (int ci = 0; ci < 16; ++ci) { const float sg = sigmoidf_(ldsbf(lds + H_FR, 16 * seg + ci, RS, d)); run += __logf(lb + (1.f - lb) * sg); lc[ci] = run; kq[ci] = (1.f - lb) * (1.f - sg); }
        segt[seg * 128 + d] = run;
        LBAR();
        const float t0 = segt[d], t1 = segt[128 + d], t2 = segt[256 + d], t3 = segt[384 + d];
        const float off = (seg > 0 ? t0 : 0.f) + (seg > 1 ? t1 : 0.f) + (seg > 2 ? t2 : 0.f), btot = (t0 + t1) + (t2 + t3);
        float kv[16];
#pragma unroll
        for (int ci = 0; ci < 16; ++ci) { const int c = 16 * seg + ci; const float bb = off + lc[ci];
            *(LAS unsigned short*)(lds + H_QE + c * RS + d * 2) = (unsigned short)f2bf(siluf_(ldsbf(lds + H_QR, c, RS, d)) * __expf(bb));
            *(LAS unsigned short*)(lds + H_KD + c * RS + d * 2) = (unsigned short)f2bf(kq[ci] * __expf(-bb));
            kv[ci] = kq[ci] * __expf(btot - bb); }
        if (seg == 0) X.AH[(size_t)unit * 128 + d] = __expf(btot);
#pragma unroll
        for (int q = 0; q < 2; ++q) { v4u o; o.x = pk2(kv[8 * q], kv[8 * q + 1]); o.y = pk2(kv[8 * q + 2], kv[8 * q + 3]); o.z = pk2(kv[8 * q + 4], kv[8 * q + 5]); o.w = pk2(kv[8 * q + 6], kv[8 * q + 7]);
            *(LAS v4u*)(lds + H_KTT + d * TS + (16 * seg + 8 * q) * 2) = o; }
    }
    LBAR();
    {
        const int mt = wave >> 1;
#pragma unroll
        for (int q = 0; q < 2; ++q) { const int ntc = 2 * (wave & 1) + q; f32x4 a0 = {0.f, 0.f, 0.f, 0.f};
#pragma unroll
            for (int ks = 0; ks < 4; ++ks) a0 = mfma16(ldsfrag(lds + H_QE, 16 * mt + r, RS, 64 * ks + 16 * g), ldsfrag(lds + H_KD, 16 * ntc + r, RS, 64 * ks + 16 * g), a0);
            const int j = 16 * ntc + r;
#pragma unroll
            for (int ii = 0; ii < 4; ++ii) { const int i = 16 * mt + 4 * g + ii; *(LAS unsigned short*)(lds + H_AM + i * TS + j * 2) = (unsigned short)f2bf((i >= j) ? a0[ii] : 0.f); } }
    }
    LBAR();
    {
        const size_t u16 = (size_t)unit * 16384, u8 = (size_t)unit * 8192;
        { const int mt = wave; bf16x8 af[2];
#pragma unroll
          for (int ks = 0; ks < 2; ++ks) af[ks] = ldsfrag(lds + H_KTT, 16 * mt + r, TS, 64 * ks + 16 * g);
#pragma unroll
          for (int nt = 0; nt < 8; ++nt) { f32x4 a0 = {0.f, 0.f, 0.f, 0.f};
#pragma unroll
              for (int ks = 0; ks < 2; ++ks) a0 = mfma16(af[ks], ldsfrag(lds + H_VT, 16 * nt + r, TS, 64 * ks + 16 * g), a0);
              *(GAS v2u*)(X.BH + u16 + ((size_t)(nt * 8 + mt) * 64 + lane) * 4) = pack4(a0); } }
        { const int vt = wave; bf16x8 af[2];
#pragma unroll
          for (int ks = 0; ks < 2; ++ks) af[ks] = ldsfrag(lds + H_VT, 16 * vt + r, TS, 64 * ks + 16 * g);
#pragma unroll
          for (int ct = 0; ct < 4; ++ct) { f32x4 a0 = {0.f, 0.f, 0.f, 0.f};
#pragma unroll
              for (int ks = 0; ks < 2; ++ks) a0 = mfma16(af[ks], ldsfrag(lds + H_AM, 16 * ct + r, TS, 64 * ks + 16 * g), a0);
              *(GAS v2u*)(X.OIH + u8 + ((size_t)(vt * 4 + ct) * 64 + lane) * 4) = pack4(a0); } }
#pragma unroll
        for (int q = 0; q < 2; ++q) { const int idx = wave * 2 + q, ct = idx >> 2, kk = idx & 3, c = 16 * ct + r;
            const v2u q0 = *(const LAS v2u*)(lds + H_QE + c * RS + (32 * kk + 4 * g) * 2), q1 = *(const LAS v2u*)(lds + H_QE + c * RS + (32 * kk + 16 + 4 * g) * 2);
            v4u o; o.x = q0.x; o.y = q0.y; o.z = q1.x; o.w = q1.y;
            *(GAS v4u*)(X.QE + u8 + ((size_t)(ct * 4 + kk) * 64 + lane) * 8) = o; }
    }
    LBAR();
}

__device__ __forceinline__ void p4_gdn_scan(LAS unsigned char* lds, const MixPtrs& X, int job, int lane, int wave) {
    const int s = job >> 3, h = job & 3, b = (job >> 2) & 1;
    const int unit0 = (b * 128) * 4 + h;
    constexpr int F8RING = 0, BRING = 131072, GLOFF = BRING + 6 * 4096;
    if (wave >= 4) {
        const int lw = wave - 4;
        const char* src0 = (const char*)X.PG + (size_t)unit0 * 16384 + lw * 4096 + lane * 16;
        const char* bsrc0 = (const char*)(X.BG + (size_t)unit0 * 16384 + (size_t)(s * 8) * 256) + lw * 1024 + lane * 16;
#define P4_ISSUE(n_) do { const char* s_ = src0 + (size_t)(n_) * (4 * 16384); _Pragma("unroll") for (int i_ = 0; i_ < 4; ++i_) \
        __builtin_amdgcn_global_load_lds((const unsigned*)(s_ + i_ * 1024), (LAS unsigned*)(lds + F8RING + ((n_) & 7) * 16384 + lw * 4096 + i_ * 1024), 16, 0, 2); \
        __builtin_amdgcn_global_load_lds((const unsigned*)(bsrc0 + (size_t)(n_) * (4 * 32768)), (LAS unsigned*)(lds + BRING + ((n_) % 6) * 4096 + lw * 1024), 16, 0, 0); } while (0)
        P4_ISSUE(0); P4_ISSUE(1); P4_ISSUE(2); P4_ISSUE(3); P4_ISSUE(4);
        asm volatile("s_waitcnt vmcnt(20)" ::: "memory");
#pragma unroll 1
        for (int n = 0; n < 128; ++n) {
            __builtin_amdgcn_s_barrier();
            asm volatile("" ::: "memory");
            if (n + 5 < 128) P4_ISSUE(n + 5);
            if (n + 1 < 128) {
                if (n + 5 < 128) asm volatile("s_waitcnt vmcnt(20)" ::: "memory"); else if (n + 4 < 128) asm volatile("s_waitcnt vmcnt(15)" ::: "memory"); else if (n + 3 < 128) asm volatile("s_waitcnt vmcnt(10)" ::: "memory");
                else if (n + 2 < 128) asm volatile("s_waitcnt vmcnt(5)" ::: "memory"); else asm volatile("s_waitcnt vmcnt(0)" ::: "memory");
            }
        }
#undef P4_ISSUE
    } else if (wave == 0) {
        f32x4 S[8]; v2u sb8[4];
#pragma unroll
        for (int mt = 0; mt < 8; ++mt) S[mt] = (f32x4){0.f, 0.f, 0.f, 0.f};
#pragma unroll
        for (int kk = 0; kk < 4; ++kk) { sb8[kk] = (v2u){0u, 0u}; v4u z; z.x = 0; z.y = 0; z.z = 0; z.w = 0; *(GAS v4u*)(X.SG + (size_t)unit0 * 16384 + ((size_t)(s * 4 + kk) * 64 + lane) * 8) = z; }
        { const float g0 = X.GL[unit0 + 4 * lane], g1 = X.GL[unit0 + 4 * (64 + lane)]; *(LAS float*)(lds + GLOFF + lane * 4) = g0; *(LAS float*)(lds + GLOFF + (64 + lane) * 4) = g1; }
        asm volatile("s_waitcnt vmcnt(0) lgkmcnt(0)" ::: "memory");
#pragma unroll 1
        for (int n = 0; n < 128; ++n) {
            const int unit = unit0 + 4 * n;
            __builtin_amdgcn_s_barrier();
            asm volatile("" ::: "memory");
            const float e = __expf(*(const LAS float*)(lds + GLOFF + n * 4));
            const LAS unsigned char* bb = lds + BRING + (n % 6) * 4096 + lane * 8;
            f32x4 acc[8];
#pragma unroll
            for (int mt = 0; mt < 8; ++mt) acc[mt] = (f32x4){0.f, 0.f, 0.f, 0.f};
            const LAS unsigned char* pb = lds + F8RING + (n & 7) * 16384 + lane * 8;
#pragma unroll
            for (int kk = 0; kk < 4; ++kk)
#pragma unroll
                for (int mt = 0; mt < 8; ++mt) acc[mt] = __builtin_amdgcn_mfma_f32_16x16x32_fp8_fp8(__builtin_bit_cast(long, *(const LAS v2u*)(pb + (mt * 4 + kk) * 512)), __builtin_bit_cast(long, sb8[kk]), acc[mt], 0, 0, 0);
#pragma unroll
            for (int mt = 0; mt < 8; ++mt) S[mt] = S[mt] * e + unpack4(*(const LAS v2u*)(bb + mt * 512)) + acc[mt] * 0.00390625f;
#pragma unroll
            for (int kk = 0; kk < 4; ++kk) { const f32x4 a = S[2 * kk], c = S[2 * kk + 1];
                unsigned w0 = __builtin_amdgcn_cvt_pk_fp8_f32(c8(a[0] * 16.f), c8(a[1] * 16.f), 0, false); w0 = __builtin_amdgcn_cvt_pk_fp8_f32(c8(a[2] * 16.f), c8(a[3] * 16.f), w0, true);
                unsigned w1 = __builtin_amdgcn_cvt_pk_fp8_f32(c8(c[0] * 16.f), c8(c[1] * 16.f), 0, false); w1 = __builtin_amdgcn_cvt_pk_fp8_f32(c8(c[2] * 16.f), c8(c[3] * 16.f), w1, true);
                sb8[kk] = (v2u){w0, w1};
                if (n < 127) { v4u o; o.x = pg8::cvt_pk_bf16(a[0], a[1]); o.y = pg8::cvt_pk_bf16(a[2], a[3]); o.z = pg8::cvt_pk_bf16(c[0], c[1]); o.w = pg8::cvt_pk_bf16(c[2], c[3]);
                    *(GAS v4u*)(X.SG + (size_t)(unit + 4) * 16384 + ((size_t)(s * 4 + kk) * 64 + lane) * 8) = o; } }
            asm volatile("s_waitcnt lgkmcnt(0)" ::: "memory");
        }
    } else {
#pragma unroll 1
        for (int n = 0; n < 128; ++n) { __builtin_amdgcn_s_barrier(); asm volatile("" ::: "memory"); }
    }
}
__device__ __forceinline__ void p4_hgrn_scan(const MixPtrs& X, int task, int lane) {
    const int mt = task & 7, s = (task >> 3) & 7, h = (task >> 6) & 3, b = task >> 8, g = lane >> 4;
    const int unit0 = (b * 128) * 4 + h;
    f32x4 s0 = {0.f, 0.f, 0.f, 0.f};
    const GAS f32x4* ap = (const GAS f32x4*)(X.AH + (size_t)unit0 * 128 + 16 * mt + 4 * g);
    const GAS v2u* bp = (const GAS v2u*)(X.BH + (size_t)unit0 * 16384 + ((size_t)(s * 8 + mt) * 64 + lane) * 4);
    GAS v2u* sp = (GAS v2u*)(X.SH + (size_t)unit0 * 16384 + ((size_t)(s * 4 + (mt >> 1)) * 64 + lane) * 8 + 4 * (mt & 1));
    { v2u z; z.x = 0; z.y = 0; sp[0] = z; }
    f32x4 ra[32]; v2u rb[32];
#pragma unroll
    for (int j = 0; j < 32; ++j) { ra[j] = ap[(size_t)j * 128]; rb[j] = bp[(size_t)j * 16384]; }
#pragma unroll 1
    for (int n0 = 0; n0 < 128; n0 += 32) {
#pragma unroll
        for (int j = 0; j < 32; ++j) { const int n = n0 + j;
            s0 = ra[j] * s0 + unpack4(rb[j]);
            if (n + 32 < 128) { ra[j] = ap[(size_t)(n + 32) * 128]; rb[j] = bp[(size_t)(n + 32) * 16384]; }
            if (n < 127) sp[(size_t)(n + 1) * 16384] = pack4(s0); }
    }
}
__device__ __forceinline__ void p5_unit(LAS unsigned char* lds, const MixPtrs& X, int bn, int lane, int wave) {
    const int hd = wave & 3, type = wave >> 2, r = lane & 15, g = lane >> 4;
    const int unit = bn * 4 + hd; const size_t tok0 = (size_t)bn * 64;
    const bf16* SX = type ? X.SH : X.SG; const bf16* QX = type ? X.QE : X.QP; const bf16* OX = type ? X.OIH : X.OI;
    const size_t u16 = (size_t)unit * 16384, u8 = (size_t)unit * 8192;
    LAS float* exch = (LAS float*)lds;
    const float* nw = type ? X.hg_nw + hd * 128 : X.gdn_nw;
    bf16x8 af[4][8];
#pragma unroll
    for (int kk = 0; kk < 4; ++kk)
#pragma unroll
        for (int vt = 0; vt < 8; ++vt) af[kk][vt] = *(const GAS bf16x8*)(SX + u16 + ((size_t)(vt * 4 + kk) * 64 + lane) * 8);
#pragma unroll 1
    for (int ct = 0; ct < 4; ++ct) {
        bf16x8 bfr[4]; v2u oq[8], gtq[8];
#pragma unroll
        for (int kk = 0; kk < 4; ++kk) bfr[kk] = *(const GAS bf16x8*)(QX + u8 + ((size_t)(ct * 4 + kk) * 64 + lane) * 8);
#pragma unroll
        for (int vt = 0; vt < 8; ++vt) { oq[vt] = *(const GAS v2u*)(OX + u8 + ((size_t)(vt * 4 + ct) * 64 + lane) * 4);
            gtq[vt] = *(const GAS v2u*)(X.gates + (tok0 + 16 * ct + r) * 1024 + type * 512 + hd * 128 + 16 * vt + 4 * g); }
        f32x4 acc[8];
#pragma unroll
        for (int vt = 0; vt < 8; ++vt) acc[vt] = unpack4(oq[vt]);
#pragma unroll
        for (int kk = 0; kk < 4; ++kk)
#pragma unroll
            for (int vt = 0; vt < 8; ++vt) acc[vt] = mfma16(af[kk][vt], bfr[kk], acc[vt]);
        float ssq = 0.f;
#pragma unroll
        for (int vt = 0; vt < 8; ++vt) ssq += (acc[vt][0] * acc[vt][0] + acc[vt][1] * acc[vt][1]) + (acc[vt][2] * acc[vt][2] + acc[vt][3] * acc[vt][3]);
        ssq += __shfl_xor(ssq, 16); ssq += __shfl_xor(ssq, 32);
        if (type == 1 && g == 0) exch[(ct & 1) * 64 + hd * 16 + r] = ssq;
        LBAR();
        float rstd;
        if (type == 1) { const LAS float* ex = exch + (ct & 1) * 64 + r; rstd = rsqrtf(((ex[0] + ex[16]) + (ex[32] + ex[48])) * (1.f / 512.f) + 1e-6f); } else rstd = rsqrtf(ssq * (1.f / 128.f) + 1e-6f);
#pragma unroll
        for (int vt = 0; vt < 8; ++vt) { const f32x4 w4 = *(const GAS f32x4*)(nw + 16 * vt + 4 * g); const size_t off = (tok0 + 16 * ct + r) * 1024 + type * 512 + hd * 128 + 16 * vt + 4 * g;
            const f32x4 gt = unpack4(gtq[vt]); f32x4 o;
#pragma unroll
            for (int e = 0; e < 4; ++e) o[e] = acc[vt][e] * rstd * w4[e] * siluf_(gt[e]);
            *(GAS v2u*)(X.omix + off) = pack4(o); }
    }
    LBAR();
}

struct Args { const float* in[23]; float* out; unsigned char* ws; int ph_lo, ph_hi, li, pad; };

__global__ void __launch_bounds__(NWAVES * 64, 2) mk_fwd(Args args) {
    extern __shared__ __attribute__((aligned(16))) unsigned char lds_raw[];
    LAS unsigned char* lds = (LAS unsigned char*)lds_raw;
    volatile LAS unsigned* MISC = (volatile LAS unsigned*)(lds + MISC_OFF);
    const int tid = threadIdx.x, lane = tid & 63, wave = __builtin_amdgcn_readfirstlane(tid >> 6);
    const int G = gridDim.x, bx = blockIdx.x, vcu = (G % 8 == 0) ? (bx % 8) * (G / 8) + bx / 8 : bx;
    const int gw = vcu * NWAVES + wave, NGW = G * NWAVES;
    unsigned char* ws = args.ws;
    gu32* ctl = (gu32*)(ws + WS_CTL);
    const float* x = args.in[0]; const float* cvec = args.in[1]; const float* w_ada = args.in[2]; const float* b_ada = args.in[3]; const float* norm1_w = args.in[4];
    const float* w_in = args.in[5]; const float* w_out = args.in[12];
    float* mod = (float*)(ws + WS_MOD); float* wab = (float*)(ws + WS_WAB); float* ab = (float*)(ws + WS_AB);
    bf16* wout_t = (bf16*)(ws + WS_WOUT_T); bf16* win_t = (bf16*)(ws + WS_WIN_T); bf16* h1 = (bf16*)(ws + WS_H1); bf16* projA = (bf16*)(ws + WS_PROJA); bf16* gates = (bf16*)(ws + WS_GATES);
    bf16* omix = (bf16*)(ws + WS_OMIX);
    bf16* h2 = (bf16*)(ws + WS_H2); bf16* w1t = (bf16*)(ws + WS_W1T); bf16* w2t = (bf16*)(ws + WS_W2T); bf16* act = (bf16*)(ws + WS_ACT); bf16* y0 = (bf16*)(ws + WS_Y0); bf16* y1 = (bf16*)(ws + WS_Y1);
    MixPtrs X; X.projA = projA; X.gates = gates; X.ab = ab; X.conv_w = args.in[6]; X.a_log = args.in[7]; X.dt_bias = args.in[8]; X.hg_lb = args.in[10]; X.gdn_nw = args.in[9]; X.hg_nw = args.in[11];
    X.PG = (bf16*)(ws + WS_PG); X.BG = (bf16*)(ws + WS_BG); X.QP = (bf16*)(ws + WS_QP); X.OI = (bf16*)(ws + WS_OI); X.BH = (bf16*)(ws + WS_BH); X.QE = (bf16*)(ws + WS_QE); X.OIH = (bf16*)(ws + WS_OIH);
    X.SG = (bf16*)args.out; X.SH = (bf16*)args.out + (size_t)UNITS * 16384; X.omix = omix; X.GL = (float*)(ws + WS_GL); X.AH = (float*)(ws + WS_AH);
    const int* list = (const int*)(ws + WS_LIST); const float* listw = (const float*)(ws + WS_LISTW);
    LAS unsigned* tb = (LAS unsigned*)(lds + SCR2_OFF);

    for (int u = tid; u < (LDS_BYTES - LDSCTL_OFF) / 4; u += NWAVES * 64) ((LAS unsigned*)(lds + LDSCTL_OFF))[u] = 0u;
    __syncthreads();
    XcdBarrier bar = xcd_barrier_post((unsigned*)(ctl + CW_BAR) + args.li * XCD_BAR_WORDS, MISC + 8);
    const int lo = args.ph_lo, hi = args.ph_hi;
#define IN(k) (lo <= (k) && (k) < hi)
#define BOTH(k) (IN(k) && IN((k) + 1))

    if (IN(0)) {
#define PH_BODY do { \
        if (bx < 96) { \
            LAS float* part = (LAS float*)(lds + RING_BYTES); \
            const int e = bx * 64 + lane; float a0 = 0.f, a1 = 0.f; \
_Pragma("unroll 32") \
            for (int d = wave * 128; d < wave * 128 + 128; ++d) { const float w = w_ada[(size_t)d * 6144 + e]; a0 += siluf_(cvec[d]) * w; a1 += siluf_(cvec[D + d]) * w; } \
            part[(wave * 2 + 0) * 64 + lane] = a0; part[(wave * 2 + 1) * 64 + lane] = a1; \
            __syncthreads(); \
            if (tid < 128) { const int bb = tid >> 6, l = tid & 63; float s = 0.f; \
_Pragma("unroll") \
                for (int w = 0; w < 8; ++w) s += part[(w * 2 + bb) * 64 + l]; \
                mod[bb * 6144 + bx * 64 + l] = s + b_ada[bx * 64 + l]; } \
        } else if (bx == 96) { \
            for (int idx = tid; idx < 8192; idx += NWAVES * 64) wab[idx] = w_in[(size_t)(idx >> 3) * DIN + 2048 + (idx & 7)]; \
        } \
        { const float* w_router = args.in[14]; bf16* wrhi = (bf16*)(ws + WS_WRHI); bf16* wrlo = (bf16*)(ws + WS_WRLO); \
          for (int k = gw; k < 1024; k += NGW) { const float w = w_router[k * 64 + lane]; const unsigned hi = f2bf(w); \
              wrhi[lane * 1024 + k] = (bf16)hi; wrlo[lane * 1024 + k] = (bf16)f2bf(w - __uint_as_float(hi << 16)); } } \
        LAS float* scr = (LAS float*)(lds + wave * 16384); \
        constexpr int I_IN = 16 * 128, I_OUT = 16 * 32; \
        auto mk0 = [&](int it) { TrItem t; if (it < I_IN) { const int kb = it / 128, n0 = 32 * (it % 128); const int sc_ = n0 < 1536 ? n0 : (n0 < 3072 ? n0 + 520 : (n0 < 3584 ? n0 - 1536 : n0 + 8)); \
                t.W = w_in; t.ldw = DIN; t.src_col = sc_; t.WT = win_t; t.K = D; t.dst_row = n0; t.k0 = 64 * kb; t.f8scale = 0.f; } \
            else { const int r = it - I_IN, kb = r / 32, n0 = 32 * (r % 32); t.W = w_out; t.ldw = D; t.src_col = n0; t.WT = wout_t; t.K = D; t.dst_row = n0; t.k0 = 64 * kb; t.f8scale = 0.f; } return t; }; \
        TR_LOOP(gw, NGW, I_IN + I_OUT, mk0); \
        if (BOTH(0)) xcd_barrier(bar); \
    } while (0)
        PH_BODY; if (REPN(0) > 1) { PH_BODY; PH_BODY; }
#undef PH_BODY
    }
    if (IN(1)) {
#define PH_BODY do { \
        { \
            const GAS f32x4* wab4 = (const GAS f32x4*)wab; \
            for (int idx = tid; idx < 2048; idx += NWAVES * 64) { const int d = idx >> 1, qh = idx & 1; *(LAS f32x4*)(lds + (((qh * 4 + (d & 3)) * 256 + (d >> 2)) * 16)) = wab4[idx]; } \
            __syncthreads(); \
            const int nrows = (M - gw + NGW - 1) / NGW; \
            f32x4 sclr[4], shfr[4]; int curb = -1; \
            f32x4 vn[2][4]; \
_Pragma("unroll") \
            for (int q = 0; q < 2; ++q) { const int m = gw + q * NGW; \
_Pragma("unroll") \
                for (int j = 0; j < 4; ++j) vn[q][j] = (q < nrows) ? ((const GAS f32x4*)(x + (size_t)m * D) + lane)[64 * j] : (f32x4){0.f, 0.f, 0.f, 0.f}; } \
_Pragma("unroll 1") \
            for (int p = 0; p < nrows; p += 2) { \
                f32x4 v[2][4]; \
_Pragma("unroll") \
                for (int q = 0; q < 2; ++q) \
_Pragma("unroll") \
                    for (int j = 0; j < 4; ++j) v[q][j] = vn[q][j]; \
_Pragma("unroll") \
                for (int q = 0; q < 2; ++q) { const int m = gw + (p + 2 + q) * NGW; \
                    if (p + 2 + q < nrows) { \
_Pragma("unroll") \
                        for (int j = 0; j < 4; ++j) vn[q][j] = ((const GAS f32x4*)(x + (size_t)m * D) + lane)[64 * j]; } } \
_Pragma("unroll") \
                for (int q = 0; q < 2; ++q) { const int m = gw + (p + q) * NGW; \
                    if (p + q < nrows) { \
                        float ss = 0.f; \
_Pragma("unroll") \
                        for (int j = 0; j < 4; ++j) ss += (v[q][j].x * v[q][j].x + v[q][j].y * v[q][j].y) + (v[q][j].z * v[q][j].z + v[q][j].w * v[q][j].w); \
                        const float rstd = rsqrtf(wave_sum(ss) * (1.f / D) + 1e-6f); \
                        const int bsel = m >= T ? 1 : 0; \
                        if (bsel != curb) { curb = bsel; const GAS f32x4* sh4 = (const GAS f32x4*)(mod + bsel * 6144) + lane; \
_Pragma("unroll") \
                            for (int j = 0; j < 4; ++j) { sclr[j] = ((const GAS f32x4*)norm1_w + lane)[64 * j] * (sh4[256 + 64 * j] + 1.0f); shfr[j] = sh4[64 * j]; } } \
                        GAS unsigned long long* o8 = (GAS unsigned long long*)(h1 + (size_t)m * D) + lane; \
                        f32x4 a0 = {0.f, 0.f, 0.f, 0.f}, a1 = {0.f, 0.f, 0.f, 0.f}; \
_Pragma("unroll") \
                        for (int j = 0; j < 4; ++j) { __builtin_amdgcn_sched_barrier(0); const f32x4 h = v[q][j] * rstd * sclr[j] + shfr[j]; \
                            o8[64 * j] = (unsigned long long)pk2(h.x, h.y) | ((unsigned long long)pk2(h.z, h.w) << 32); \
_Pragma("unroll") \
                            for (int i = 0; i < 4; ++i) { a0 += *(const LAS f32x4*)(lds + ((i * 256 + lane + 64 * j) * 16)) * h[i]; a1 += *(const LAS f32x4*)(lds + (((4 + i) * 256 + lane + 64 * j) * 16)) * h[i]; } } \
 \
                        const bool up5 = (lane & 32) != 0, up4 = (lane & 16) != 0, up3 = (lane & 8) != 0; \
                        f32x4 k4; \
_Pragma("unroll") \
                        for (int e = 0; e < 4; ++e) { const float snd = up5 ? a0[e] : a1[e]; k4[e] = (up5 ? a1[e] : a0[e]) + __shfl_xor(snd, 32); } \
                        float k2[2]; \
_Pragma("unroll") \
                        for (int e = 0; e < 2; ++e) { const float snd = up4 ? k4[e] : k4[2 + e]; k2[e] = (up4 ? k4[2 + e] : k4[e]) + __shfl_xor(snd, 16); } \
                        float k1; { const float snd = up3 ? k2[0] : k2[1]; k1 = (up3 ? k2[1] : k2[0]) + __shfl_xor(snd, 8); } \
                        k1 += __shfl_xor(k1, 4); k1 += __shfl_xor(k1, 2); k1 += __shfl_xor(k1, 1); \
                        if ((lane & 7) == 0) ab[(size_t)m * 8 + 4 * (lane >> 5) + 2 * ((lane >> 4) & 1) + ((lane >> 3) & 1)] = k1; \
                    } } \
            } \
            __syncthreads(); \
        } \
        if (BOTH(1)) xcd_barrier(bar); \
    } while (0)
        PH_BODY; if (REPN(1) > 1) { PH_BODY; PH_BODY; }
#undef PH_BODY
    }
    if (IN(2)) {
#define PH_BODY do { \
        pg8::Gemm g{h1, win_t, M, 4096, D}; pg8::StaticOrder S; S.init(M, 4096, G, (int)blockIdx.x); \
        pg8::EpiProj E{projA, gates}; \
        pg8::gemm_phase<pg8::EpiProj, pg8::StaticOrder, true, true>(lds, g, S, E); \
        if (BOTH(2)) xcd_barrier(bar); \
    } while (0)
        PH_BODY; if (REPN(2) > 1) { PH_BODY; PH_BODY; }
#undef PH_BODY
    }

    if (IN(3)) {
#define PH_BODY do { \
        for (int u = vcu; u < UNITS; u += G) p3_gdn_unit(lds, X, u, tid, lane, wave); \
        for (int u = vcu; u < UNITS; u += G) p3_hgrn_unit(lds, X, u, tid, lane, wave); \
        if (BOTH(3)) xcd_barrier(bar); \
    } while (0)
        PH_BODY; if (REPN(3) > 1) { PH_BODY; PH_BODY; }
#undef PH_BODY
    }
    if (IN(4)) {
#define PH_BODY do { \
        if (bx < 64) p4_gdn_scan(lds, X, bx, lane, wave); \
        else { \
            if (wave < 3 && (bx - 64) * 3 + wave < 512) p4_hgrn_scan(X, (bx - 64) * 3 + wave, lane); \
            LAS float* scr = (LAS float*)(lds + wave * 16384); \
            const float* w_gate = args.in[16]; const float* w_up = args.in[17]; const float* w_down = args.in[18]; const float* ws_gate = args.in[19]; const float* ws_up = args.in[20]; const float* ws_down = args.in[21]; \
            auto mk4 = [&](int it) { TrItem t; const int e = it / 384, r = it % 384; \
                if (r < 256) { const int up = r >> 7, q = r & 127, kb = q >> 3, n0 = 32 * (q & 7); \
                    t.W = e < NE ? (up ? w_up : w_gate) + (size_t)e * D * DE : (up ? ws_up : ws_gate); t.ldw = DE; t.src_col = n0; t.WT = (bf16*)((unsigned char*)w1t + (size_t)e * 512 * 1024); t.K = D; t.dst_row = (n0 >> 7) * 256 + up * 128 + (n0 & 127); t.k0 = 64 * kb; t.f8scale = 32.f; } \
                else { const int q = r - 256, kb = q >> 5, n0 = 32 * (q & 31); \
                    t.W = e < NE ? w_down + (size_t)e * DE * D : ws_down; t.ldw = D; t.src_col = n0; t.WT = (bf16*)((unsigned char*)w2t + (size_t)e * 1024 * 256); t.K = DE; t.dst_row = n0; t.k0 = 64 * kb; t.f8scale = 16.f; } return t; }; \
            TR_LOOP((bx - 64) * NWAVES + wave, (G - 64) * NWAVES, NEX * 384, mk4); \
        } \
        if (BOTH(4)) xcd_barrier(bar); \
    } while (0)
        PH_BODY; if (REPN(4) > 1) { PH_BODY; PH_BODY; }
#undef PH_BODY
    }
    if (IN(5)) {
#define PH_BODY do { \
        for (int bn = vcu; bn < BATCH * 128; bn += G) p5_unit(lds, X, bn, lane, wave); \
        if (BOTH(5)) xcd_barrier(bar); \
    } while (0)
        PH_BODY; if (REPN(5) > 1) { PH_BODY; PH_BODY; }
#undef PH_BODY
    }
    if (IN(6)) {
#define PH_BODY do { \
        pg8::Gemm g{omix, wout_t, M, D, D}; pg8::StaticOrder S; S.init(M, D, G, (int)blockIdx.x); \
        pg8::EpiResid E{x, mod, args.out}; \
        pg8::gemm_phase<pg8::EpiResid, pg8::StaticOrder, true, true>(lds, g, S, E); \
        if (BOTH(6)) xcd_barrier(bar); \
    } while (0)
        PH_BODY; if (REPN(6) > 1) { PH_BODY; PH_BODY; }
#undef PH_BODY
    }


    if (IN(7)) {
        constexpr int HS = 2064;
        constexpr int R_HI = 0, R_LO = 66048, R_PART = 0  , R_SC = 132096, R_SEL = 140288, R_CNT = 148480, R_BASE = 148736, R_ESE = 148992, R_ESL = 151040, R_EW = 153088, R_ELP = 155136;
        if (tid < 64) *(LAS unsigned*)(lds + R_CNT + tid * 4) = 0u;
        __syncthreads();
        int nu = 0;
        const float* norm2_w = args.in[13]; const float* rbias = args.in[15]; const bf16* wrhi = (const bf16*)(ws + WS_WRHI); const bf16* wrlo = (const bf16*)(ws + WS_WRLO);
        int* listo = (int*)(ws + WS_LIST); float* listwo = (float*)(ws + WS_LISTW);
        const int r = lane & 15, g = lane >> 4;
#pragma unroll 1
        for (int u = vcu; u < M / 32; u += G, ++nu) {
            const GAS f32x4* sh4 = (const GAS f32x4*)(mod + (32 * u >= T ? 6144 : 0) + 3072) + lane; const GAS f32x4* nw4 = (const GAS f32x4*)norm2_w + lane;
#pragma unroll 1
            for (int qp = 0; qp < 4; qp += 2) {
                f32x4 xrow[2][4];
#pragma unroll
                for (int q = 0; q < 2; ++q) { const GAS f32x4* xr = (const GAS f32x4*)(args.out + (size_t)(32 * u + 4 * wave + qp + q) * D) + lane;
#pragma unroll
                    for (int j = 0; j < 4; ++j) xrow[q][j] = xr[64 * j]; }
#pragma unroll
                for (int q = 0; q < 2; ++q) { const int rl = 4 * wave + qp + q, m = 32 * u + rl;
                    f32x4 v[4]; float ss = 0.f;
#pragma unroll
                    for (int j = 0; j < 4; ++j) { v[j] = xrow[q][j]; ss += (v[j].x * v[j].x + v[j].y * v[j].y) + (v[j].z * v[j].z + v[j].w * v[j].w); }
                    const float rstd = rsqrtf(wave_sum(ss) * (1.f / D) + 1e-6f);
                    GAS unsigned* o4 = (GAS unsigned*)((unsigned char*)h2 + (size_t)m * D) + lane;
#pragma unroll
                    for (int j = 0; j < 4; ++j) { const f32x4 hv = v[j] * rstd * (nw4[64 * j] * (sh4[256 + 64 * j] + 1.0f)) + sh4[64 * j];
                        const unsigned h0 = f2bf(hv.x), h1_ = f2bf(hv.y), h2_ = f2bf(hv.z), h3 = f2bf(hv.w);
                        const unsigned long long hi = (unsigned long long)(h0 | (h1_ << 16)) | ((unsigned long long)(h2_ | (h3 << 16)) << 32);
                        { unsigned q8 = __builtin_amdgcn_cvt_pk_fp8_f32(hv.x, hv.y, 0, false); q8 = __builtin_amdgcn_cvt_pk_fp8_f32(hv.z, hv.w, q8, true); o4[64 * j] = q8; }
                        const unsigned long long lo = (unsigned long long)pk2(hv.x - __uint_as_float(h0 << 16), hv.y - __uint_as_float(h1_ << 16)) | ((unsigned long long)pk2(hv.z - __uint_as_float(h2_ << 16), hv.w - __uint_as_float(h3 << 16)) << 32);
                        *(LAS unsigned long long*)(lds + R_HI + rl * HS + (lane + 64 * j) * 8) = hi; *(LAS unsigned long long*)(lds + R_LO + rl * HS + (lane + 64 * j) * 8) = lo; } }
            }
            __syncthreads();
            f32x4 acc[2][4];
#pragma unroll
            for (int mt = 0; mt < 2; ++mt)
#pragma unroll
                for (int nt = 0; nt < 4; ++nt) acc[mt][nt] = (f32x4){0.f, 0.f, 0.f, 0.f};
#pragma unroll 2
            for (int ks = 0; ks < 4; ++ks) { const int kb = (128 * wave + 32 * ks + 8 * g) * 2;
                bf16x8 ahi[2], alo[2];
#pragma unroll
                for (int mt = 0; mt < 2; ++mt) { ahi[mt] = *(const LAS bf16x8*)(lds + R_HI + (16 * mt + r) * HS + kb); alo[mt] = *(const LAS bf16x8*)(lds + R_LO + (16 * mt + r) * HS + kb); }
#pragma unroll
                for (int nt = 0; nt < 4; ++nt) { const size_t o = (size_t)(16 * nt + r) * 1024 + 128 * wave + 32 * ks + 8 * g; const bf16x8 bh = *(const GAS bf16x8*)(wrhi + o), bl = *(const GAS bf16x8*)(wrlo + o);
#pragma unroll
                    for (int mt = 0; mt < 2; ++mt) { acc[mt][nt] = mfma16(ahi[mt], bh, acc[mt][nt]); acc[mt][nt] = mfma16(ahi[mt], bl, acc[mt][nt]); acc[mt][nt] = mfma16(alo[mt], bh, acc[mt][nt]); } } }
            __syncthreads();
#pragma unroll
            for (int mt = 0; mt < 2; ++mt)
#pragma unroll
                for (int nt = 0; nt < 4; ++nt)
#pragma unroll
                    for (int ii = 0; ii < 4; ++ii) *(LAS float*)(lds + R_PART + ((wave * 32 + 16 * mt + 4 * g + ii) * 64 + 16 * nt + r) * 4) = acc[mt][nt][ii];
            __syncthreads();
#pragma unroll
            for (int q = 0; q < 4; ++q) { const int idx = tid + 512 * q; float s = 0.f;
#pragma unroll
                for (int w = 0; w < 8; ++w) s += *(const LAS float*)(lds + R_PART + (w * 2048 + idx) * 4);
                const float sc = sigmoidf_(s); *(LAS float*)(lds + R_SC + idx * 4) = sc; *(LAS float*)(lds + R_SEL + idx * 4) = sc + rbias[idx & 63]; }
            __syncthreads();
#pragma unroll 2
            for (int q = 0; q < 4; ++q) { const int rl = 4 * wave + q, m = 32 * u + rl;
                const float sel = *(const LAS float*)(lds + R_SEL + (rl * 64 + lane) * 4), score = *(const LAS float*)(lds + R_SC + (rl * 64 + lane) * 4);
                float ga = sel, gb = -INFINITY;
                { const float a2 = dppf<0xB1>(ga), lo_ = fminf(ga, a2); ga = fmaxf(ga, a2); gb = lo_; }
                { const float a2 = dppf<0x4E>(ga), b2 = dppf<0x4E>(gb), lo_ = fminf(ga, a2); ga = fmaxf(ga, a2); gb = fmaxf(lo_, fmaxf(gb, b2)); }
                { const float a2 = dppf<0x141>(ga), b2 = dppf<0x141>(gb), lo_ = fminf(ga, a2); ga = fmaxf(ga, a2); gb = fmaxf(lo_, fmaxf(gb, b2)); }
                const float gs = ga + gb; const int mygrp = lane >> 3; int grank = 0;
#pragma unroll
                for (int gg = 0; gg < 8; ++gg) { const float o = rdlane(gs, 8 * gg); grank += (o > gs || (o == gs && gg < mygrp)) ? 1 : 0; }
                float msel = grank < 4 ? sel : -INFINITY; int erank = -1;
#pragma unroll
                for (int it = 0; it < 8; ++it) { const float mx = wave_max(msel);
                    const unsigned long long eq = __ballot(msel == mx); const int first = __builtin_amdgcn_readfirstlane(__ffsll((long long)eq) - 1);
                    const bool me = lane == first; msel = me ? -INFINITY : msel; erank = me ? it : erank; }
                const bool chosen = erank >= 0;
                const float wsum = wave_sum_dpp(chosen ? score : 0.f);
                if (chosen && nu < 2) { const int se = lane; const unsigned lp = __hip_atomic_fetch_add((LAS unsigned*)(lds + R_CNT + se * 4), 1u, __ATOMIC_RELAXED, __HIP_MEMORY_SCOPE_WORKGROUP);
                    const int ei = ((nu * 32 + rl) * 8 + erank) * 4;
                    *(LAS int*)(lds + R_ESE + ei) = se; *(LAS int*)(lds + R_ESL + ei) = m * 8 + erank; *(LAS float*)(lds + R_EW + ei) = score / wsum * 2.5f; *(LAS unsigned*)(lds + R_ELP + ei) = lp; } }
            __syncthreads();
            if (nu == 1 || u + G >= M / 32) {
                if (tid < 64) { const unsigned c = *(LAS unsigned*)(lds + R_CNT + tid * 4); *(LAS unsigned*)(lds + R_BASE + tid * 4) = c ? __hip_atomic_fetch_add(ctl + CW_CNT + 64 * tid, c, RLX_AGENT) : 0u; }
                __syncthreads();
                for (int idx = tid; idx < (nu + 1) * 256; idx += NWAVES * 64) { const int se = *(LAS int*)(lds + R_ESE + idx * 4); const unsigned pos = *(LAS unsigned*)(lds + R_BASE + se * 4) + *(LAS unsigned*)(lds + R_ELP + idx * 4);
                    if (pos < (unsigned)CAP) { listo[(size_t)se * CAP + pos] = *(LAS int*)(lds + R_ESL + idx * 4); listwo[(size_t)se * CAP + pos] = *(LAS float*)(lds + R_EW + idx * 4); } }
                __syncthreads();
                if (tid < 64) *(LAS unsigned*)(lds + R_CNT + tid * 4) = 0u;
                __syncthreads();
                nu = -1;
            }
        }
        if (BOTH(7)) xcd_barrier(bar);
    }
    if (lo <= 10 && hi > 8) {
        if (wave == 0) { unsigned c = __hip_atomic_load(ctl + CW_CNT + 64 * lane, RLX_AGENT); c = c < (unsigned)CAP ? c : (unsigned)CAP;
            unsigned inc = c;
#pragma unroll
            for (int o = 1; o < 64; o <<= 1) { const unsigned t = __shfl_up(inc, o); if (lane >= o) inc += t; }
            tb[TB_CNT + lane] = c; tb[TB_OFF + lane] = inc - c;
            if (lane == 63) { tb[TB_CNT + 64] = (unsigned)M; tb[TB_OFF + 64] = inc; } }
        __syncthreads();
    }
#define MOE_PREFIX(lo_, hi_, NT_, perm_) do { __syncthreads(); if (wave == 0) { const unsigned un_ = ((tb[TB_CNT + lane] + 255u) >> 8) * (NT_); unsigned inc_ = un_; \
        _Pragma("unroll") for (int o_ = 1; o_ < 64; o_ <<= 1) { const unsigned t_ = __shfl_up(inc_, o_); if (lane >= o_) inc_ += t_; } \
        tb[TB_PRE + lane] = inc_ - un_; if (lane == 63) { tb[TB_PRE + 64] = inc_; tb[TB_PRE + 65] = inc_ + ((tb[TB_CNT + 64] + 255u) >> 8) * (NT_); } } __syncthreads(); } while (0)
    if (IN(8)) {
#define PH_BODY do { \
        MOE_PREFIX(0, 65, 2, 0); \
        pg8::Moe1Prob P{D, 1024, pg8::MoeSched{tb, 0, 65, 2, G, vcu, 0}, (const unsigned char*)h2, (const unsigned char*)w1t, list}; \
        pg8::EpiMoe1 E{(unsigned char*)act, tb}; \
        pg8::gemm_phase_g<pg8::Moe1Prob, pg8::EpiMoe1, true>(lds, P, E); \
        if (BOTH(8)) xcd_barrier(bar); \
    } while (0)
        PH_BODY; if (REPN(8) > 1) { PH_BODY; PH_BODY; }
#undef PH_BODY
    }
    if (IN(9)) for (int rep_ = 0; rep_ < REPN(9); ++rep_) {
        MOE_PREFIX(0, 65, 4, 0);
        pg8::Moe2Prob P{DE, 256, pg8::MoeSched{tb, 0, 65, 4, G, vcu, 0}, (const unsigned char*)act, (const unsigned char*)w2t, list, listw};
        pg8::EpiMoe2 E{(unsigned char*)y0, (unsigned char*)y1, ws + WS_YS, tb};
        pg8::gemm_phase_g<pg8::Moe2Prob, pg8::EpiMoe2, true>(lds, P, E);
        if (BOTH(9)) xcd_barrier(bar);
    }
    if (IN(10)) {
        const float* fw = args.in[22]; const unsigned char* yb0 = (const unsigned char*)y0; const unsigned char* yb1 = (const unsigned char*)y1;
        typedef float f32x2_ __attribute__((ext_vector_type(2)));
        f32x4 fwr[2][2];
#pragma unroll
        for (int j = 0; j < 2; ++j)
#pragma unroll
            for (int h2_ = 0; h2_ < 2; ++h2_) fwr[j][h2_] = ((const GAS f32x4*)fw)[2 * lane + 128 * j + h2_];
#define P10_LOAD(m_, yq_, xv_, g2v_) do { const int hf_ = (m_) >= T ? 1 : 0; const GAS f32x4* xr_ = (const GAS f32x4*)(args.out + (size_t)(m_) * D); \
            const GAS v2u* yr_ = (const GAS v2u*)(hf_ ? yb1 + (size_t)((m_) - T) * 8 * D : yb0 + (size_t)(m_) * 8 * D) + lane; const GAS v2u* ysr_ = (const GAS v2u*)(ws + WS_YS + (size_t)(m_) * D) + lane; \
            const GAS f32x4* g24_ = (const GAS f32x4*)(mod + hf_ * 6144 + 5120); \
            _Pragma("unroll") for (int j = 0; j < 2; ++j) { _Pragma("unroll") for (int h2_ = 0; h2_ < 2; ++h2_) { xv_[j][h2_] = xr_[2 * lane + 128 * j + h2_]; g2v_[j][h2_] = g24_[2 * lane + 128 * j + h2_]; } \
                _Pragma("unroll") for (int k = 0; k < 8; ++k) yq_[k][j] = yr_[k * 128 + 64 * j]; yq_[8][j] = ysr_[64 * j]; } } while (0)
        v2u yqn[9][2]; f32x4 xvn[2][2], g2n[2][2];
        if (gw < M) P10_LOAD(gw, yqn, xvn, g2n);
#pragma unroll 1
        for (int m = gw; m < M; m += NGW) {
            GAS f32x4* xr = (GAS f32x4*)(args.out + (size_t)m * D);
            v2u yq[9][2]; f32x4 xv[2][2], g2v[2][2];
#pragma unroll
            for (int j = 0; j < 2; ++j) {
#pragma unroll
                for (int k = 0; k < 9; ++k) yq[k][j] = yqn[k][j];
#pragma unroll
                for (int h2_ = 0; h2_ < 2; ++h2_) { xv[j][h2_] = xvn[j][h2_]; g2v[j][h2_] = g2n[j][h2_]; } }
            if (m + NGW < M) P10_LOAD(m + NGW, yqn, xvn, g2n);
            f32x4 v[2][2]; float ss = 0.f;
#pragma unroll
            for (int j = 0; j < 2; ++j) { f32x4 s0 = {0.f, 0.f, 0.f, 0.f}, s1 = {0.f, 0.f, 0.f, 0.f};
#pragma unroll
                for (int k = 0; k < 9; ++k) { const f32x2_ a = __builtin_amdgcn_cvt_pk_f32_fp8(yq[k][j].x, false), b = __builtin_amdgcn_cvt_pk_f32_fp8(yq[k][j].x, true), c = __builtin_amdgcn_cvt_pk_f32_fp8(yq[k][j].y, false), d = __builtin_amdgcn_cvt_pk_f32_fp8(yq[k][j].y, true);
                    s0.x += a.x; s0.y += a.y; s0.z += b.x; s0.w += b.y; s1.x += c.x; s1.y += c.y; s1.z += d.x; s1.w += d.y; }
                v[j][0] = xv[j][0] + g2v[j][0] * (s0 * 0.03125f); v[j][1] = xv[j][1] + g2v[j][1] * (s1 * 0.03125f);
#pragma unroll
                for (int h2_ = 0; h2_ < 2; ++h2_) ss += (v[j][h2_].x * v[j][h2_].x + v[j][h2_].y * v[j][h2_].y) + (v[j][h2_].z * v[j][h2_].z + v[j][h2_].w * v[j][h2_].w); }
            const float rstd = rsqrtf(wave_sum(ss) * (1.f / D) + 1e-6f);
#pragma unroll
            for (int j = 0; j < 2; ++j)
#pragma unroll
                for (int h2_ = 0; h2_ < 2; ++h2_) xr[2 * lane + 128 * j + h2_] = v[j][h2_] * rstd * fwr[j][h2_];
        }
#undef P10_LOAD
    }
#undef MOE_PREFIX
#undef IN
#undef BOTH
}

static void launch_mk(Args a, int lo, int hi, int li, int grid, hipStream_t stream) {
    a.ph_lo = lo; a.ph_hi = hi; a.li = li;
    hipLaunchKernelGGL(mk_fwd, dim3(grid), dim3(NWAVES * 64), LDS_BYTES, stream, a);
}
extern "C" void kernel_launch(void* const* d_in, const int* in_sizes, int n_in, void* d_out, int out_size, void* d_ws, size_t ws_size, hipStream_t stream) {
    static int grid = 0;
    if (grid == 0) {
        int dev = 0, cus = 0;
        if (hipGetDevice(&dev) != hipSuccess || hipDeviceGetAttribute(&cus, hipDeviceAttributeMultiprocessorCount, dev) != hipSuccess) { grid = -1; return; }
        if (hipFuncSetAttribute((const void*)mk_fwd, hipFuncAttributeMaxDynamicSharedMemorySize, LDS_BYTES) != hipSuccess) { grid = -1; return; }
        grid = cus;
    }
    if (grid < 0) return;
    unsigned char* ws = (unsigned char*)d_ws; float* out = (float*)d_out;
    (void)hipMemsetAsync(ws + WS_CTL, 0, CTL_ZERO_BYTES, stream);
    Args a{};
    for (int i = 0; i < 23; ++i) a.in[i] = (const float*)d_in[i];
    a.out = out; a.ws = ws;
    launch_mk(a, 0, 11, 0, grid, stream);
}
```

```cpp
#include <hip/hip_runtime.h>
#include <cstdio>
#include <cstdint>
namespace pg8 {
#define PG8_LAS __attribute__((address_space(3)))
typedef unsigned short bf16_t;
typedef short bf16x8 __attribute__((ext_vector_type(8)));
typedef float f32x4 __attribute__((ext_vector_type(4)));
typedef unsigned u32x4 __attribute__((ext_vector_type(4)));
constexpr int BM = 256, BK = 64, HALF = 128, HTB = HALF * BK * 2  , STAGE_BYTES = 8 * HTB, NXCD = 8, WGM = 8;

__host__ __device__ __forceinline__ int lds_byte(int r, int c) { const int st = (r >> 4) * 2 + (c >> 5), rr = r & 15, cc = c & 31, ob = rr * 64 + cc * 2; return st * 1024 + (ob ^ (((ob >> 9) & 1) << 5)); }
__host__ __device__ __forceinline__ void stage_rc(int b, int& R, int& C) { const int st = b / 1024, sb = b % 1024, swz = sb ^ (((sb >> 9) & 1) << 5); R = (st >> 1) * 16 + swz / 64; C = (st & 1) * 32 + (swz % 64) / 2; }
__host__ __device__ __forceinline__ int perm32(int rho) { const int n = rho >> 4, i = rho & 15; return 8 * (i >> 2) + 4 * n + (i & 3); }

struct Unit { int pm, pn; };
struct Gemm { const bf16_t* A; const bf16_t* Bt; int M, N, K; };

struct StaticOrder {
    int nM, nN, nwg, G, c;
    __host__ __device__ void init(int M, int N, int G_, int c_) { nM = M / BM; nN = N / BM; nwg = nM * nN; G = G_; c = c_; }
    __host__ __device__ bool next(int i, Unit& u) const {
        const long L = (long)i * G + c; if (L >= nwg) return false;
        int wgid = (int)L; { const int q = nwg / NXCD, r = nwg % NXCD, xcd = wgid % NXCD, off = wgid / NXCD; wgid = (xcd < r ? xcd * (q + 1) : r * (q + 1) + (xcd - r) * q) + off; }
        const int nig = WGM * nN, gid = wgid / nig, fm = gid * WGM, gsz = (nM - fm) < WGM ? (nM - fm) : WGM;
        u.pm = fm + ((wgid % nig) % gsz); u.pn = (wgid % nig) / gsz; return true;
    }
    __device__ __forceinline__ void a_ready(const Unit&) const {}
    __device__ __forceinline__ void done(const Unit&) const {}
};
__device__ __forceinline__ unsigned cvt_pk_bf16(float lo, float hi) { unsigned r; asm volatile("v_cvt_pk_bf16_f32 %0, %1, %2" : "=v"(r) : "v"(lo), "v"(hi)); return r; }
template <class Epi, class Sched, bool ALIGN_EPI = false, bool SP2 = false>
__device__ __forceinline__ void gemm_phase(PG8_LAS unsigned char* lds, const Gemm g, const Sched& S, const Epi& E) {
    const int tid = threadIdx.x, wid = __builtin_amdgcn_readfirstlane(tid >> 6), lane = tid & 63, wr = wid >> 2, wc = wid & 3, fr = lane & 15, fq = lane >> 4;
    const int K = g.K, nt = K / BK;
    unsigned voffA[2], voffB[2];
#pragma unroll
    for (int i = 0; i < 2; ++i) { int R, C; stage_rc(tid * 16 + i * 8192, R, C); const int Rb = Epi::PERM ? ((R & ~31) + perm32(R & 31)) : R;
        voffA[i] = (unsigned)(R * K + C) * 2u; voffB[i] = (unsigned)(Rb * K + C) * 2u; }
    const size_t kstep = (size_t)(BK * 2);
    const size_t hstep = (size_t)HALF * K * 2;
    const size_t tstep = 2 * hstep;
    const unsigned ldsw = (unsigned)wid * 1024u;
    const int aoff = lds_byte(wr * 64 + fr, fq * 8), boff = lds_byte(wc * 32 + fr, fq * 8);
#define PG8_SA(b, h) (((b) * 2 + (h)) * HTB)
#define PG8_SB(b, h) ((4 + (b) * 2 + (h)) * HTB)
#define PG8_STAGE(bufoff, gbase, voff) do { _Pragma("unroll") for (int _i = 0; _i < 2; ++_i) \
        __builtin_amdgcn_global_load_lds((const unsigned*)((const char*)(gbase) + (voff)[_i]), (PG8_LAS unsigned*)(lds + (bufoff) + ldsw + _i * 8192), 16, 0, 0); } while (0)
#define PG8_LDA(dst, b, h) do { _Pragma("unroll") for (int m = 0; m < 4; ++m) _Pragma("unroll") for (int k = 0; k < 2; ++k) dst[m][k] = *(const PG8_LAS bf16x8*)(lds + PG8_SA(b, h) + aoff + m * 2048 + k * 1024); } while (0)
#define PG8_LDB(dst, b, h) do { _Pragma("unroll") for (int n = 0; n < 2; ++n) _Pragma("unroll") for (int k = 0; k < 2; ++k) dst[n][k] = *(const PG8_LAS bf16x8*)(lds + PG8_SB(b, h) + boff + n * 2048 + k * 1024); } while (0)
#define PG8_MMA(ai, bj, At, Bt) do { __builtin_amdgcn_s_setprio(1); _Pragma("unroll") for (int m = 0; m < 4; ++m) _Pragma("unroll") for (int n = 0; n < 2; ++n) _Pragma("unroll") for (int k = 0; k < 2; ++k) \
        acc[ai][bj][m][n] = __builtin_amdgcn_mfma_f32_16x16x32_bf16(Bt[n][k], At[m][k], acc[ai][bj][m][n], 0, 0, 0); __builtin_amdgcn_s_setprio(0); } while (0)
#define PG8_WAIT_V(n) asm volatile("s_waitcnt vmcnt(" #n ")" ::: "memory")
#define PG8_WAIT_L(n) asm volatile("s_waitcnt lgkmcnt(" #n ")" ::: "memory")
#define PG8_BAR __builtin_amdgcn_s_barrier()
#define PG8_SCHED __builtin_amdgcn_sched_barrier(0)
    Unit cur, nxt; int ui = 0;
    if (!S.next(0, cur)) return;
    f32x4 acc[2][2][4][2];
#pragma unroll
    for (int a = 0; a < 2; ++a)
#pragma unroll
        for (int b = 0; b < 2; ++b)
#pragma unroll
            for (int m = 0; m < 4; ++m)
#pragma unroll
                for (int n = 0; n < 2; ++n) acc[a][b][m][n] = (f32x4){0.f, 0.f, 0.f, 0.f};
    bf16x8 At[4][2], B0[2][2], B1[2][2];
    const char* cA = (const char*)g.A + (size_t)cur.pm * tstep; const char* cB = (const char*)g.Bt + (size_t)cur.pn * tstep;
    S.a_ready(cur);
    if constexpr (SP2) {
        PG8_STAGE(PG8_SB(0, 0), cB, voffB); PG8_STAGE(PG8_SB(0, 1), cB + hstep, voffB); PG8_STAGE(PG8_SA(0, 0), cA, voffA); PG8_STAGE(PG8_SA(0, 1), cA + hstep, voffA);
        if (wr == 1) PG8_BAR;
        PG8_WAIT_V(2); PG8_BAR;
        PG8_STAGE(PG8_SB(1, 0), cB + kstep, voffB); PG8_STAGE(PG8_SA(1, 0), cA + kstep, voffA); PG8_STAGE(PG8_SB(1, 1), cB + hstep + kstep, voffB);
        PG8_WAIT_V(6); PG8_BAR;
    } else {
        PG8_STAGE(PG8_SB(0, 0), cB, voffB); PG8_STAGE(PG8_SA(0, 0), cA, voffA); PG8_STAGE(PG8_SB(0, 1), cB + hstep, voffB); PG8_STAGE(PG8_SA(0, 1), cA + hstep, voffA);
        if (wr == 1) PG8_BAR;
        PG8_WAIT_V(4); PG8_BAR;
        PG8_STAGE(PG8_SB(1, 0), cB + kstep, voffB); PG8_STAGE(PG8_SA(1, 0), cA + kstep, voffA); PG8_STAGE(PG8_SB(1, 1), cB + hstep + kstep, voffB);
        PG8_WAIT_V(6); PG8_BAR;
    }
    for (;;) {
        const bool has_next = S.next(ui + 1, nxt);
        const char* nA = has_next ? (const char*)g.A + (size_t)nxt.pm * tstep : cA; const char* nB = has_next ? (const char*)g.Bt + (size_t)nxt.pn * tstep : cB;
        for (int t = 0; t < nt; t += 2) {
            const bool last = (t == nt - 2);
            const char* a1 = cA + (size_t)(t + 1) * kstep;
            const char* a2 = last ? nA : cA + (size_t)(t + 2) * kstep; const char* b2 = last ? nB : cB + (size_t)(t + 2) * kstep;
            const char* a3 = a2 + kstep; const char* b3 = b2 + kstep;
            if (last && has_next) S.a_ready(nxt);
            if constexpr (SP2) {
            PG8_LDB(B0, 0, 0); PG8_LDB(B1, 0, 1); PG8_SCHED; PG8_LDA(At, 0, 0); PG8_STAGE(PG8_SA(1, 1), a1 + hstep, voffA);
            PG8_WAIT_V(8); PG8_WAIT_L(0); PG8_BAR; PG8_MMA(0, 0, At, B0); PG8_MMA(0, 1, At, B1); PG8_BAR; PG8_SCHED;
            PG8_LDA(At, 0, 1); PG8_STAGE(PG8_SB(0, 0), b2, voffB); PG8_STAGE(PG8_SB(0, 1), b2 + hstep, voffB); PG8_STAGE(PG8_SA(0, 0), a2, voffA);
            PG8_WAIT_V(8); PG8_WAIT_L(0); PG8_BAR; PG8_MMA(1, 0, At, B0); PG8_MMA(1, 1, At, B1); PG8_BAR; PG8_SCHED;
            PG8_LDB(B0, 1, 0); PG8_LDB(B1, 1, 1); PG8_SCHED; PG8_LDA(At, 1, 0); PG8_STAGE(PG8_SA(0, 1), a2 + hstep, voffA);
            PG8_WAIT_V(8); PG8_WAIT_L(0); PG8_BAR; PG8_MMA(0, 0, At, B0); PG8_MMA(0, 1, At, B1); PG8_BAR; PG8_SCHED;
            PG8_LDA(At, 1, 1); PG8_STAGE(PG8_SB(1, 0), b3, voffB); PG8_STAGE(PG8_SB(1, 1), b3 + hstep, voffB); PG8_STAGE(PG8_SA(1, 0), a3, voffA);
            PG8_WAIT_V(8); PG8_WAIT_L(0); PG8_BAR; PG8_MMA(1, 0, At, B0); PG8_MMA(1, 1, At, B1); PG8_BAR; PG8_SCHED;
            } else {
            PG8_LDB(B0, 0, 0); PG8_SCHED; PG8_LDA(At, 0, 0); PG8_STAGE(PG8_SA(1, 1), a1 + hstep, voffA);
            PG8_WAIT_L(8); PG8_BAR; PG8_WAIT_L(0); PG8_MMA(0, 0, At, B0); PG8_BAR; PG8_SCHED;
            PG8_LDB(B1, 0, 1); PG8_STAGE(PG8_SB(0, 0), b2, voffB);
            PG8_BAR; PG8_WAIT_L(0); PG8_MMA(0, 1, At, B1); PG8_BAR;
            PG8_LDA(At, 0, 1); PG8_STAGE(PG8_SA(0, 0), a2, voffA);
            PG8_BAR; PG8_WAIT_L(0); PG8_MMA(1, 0, At, B0); PG8_BAR; PG8_SCHED;
            PG8_STAGE(PG8_SB(0, 1), b2 + hstep, voffB);
            PG8_WAIT_V(6); PG8_BAR; PG8_MMA(1, 1, At, B1); PG8_BAR;
            PG8_LDB(B0, 1, 0); PG8_SCHED; PG8_LDA(At, 1, 0); PG8_STAGE(PG8_SA(0, 1), a2 + hstep, voffA);
            PG8_WAIT_L(8); PG8_BAR; PG8_WAIT_L(0); PG8_MMA(0, 0, At, B0); PG8_BAR; PG8_SCHED;
            PG8_LDB(B1, 1, 1); PG8_STAGE(PG8_SB(1, 0), b3, voffB);
            PG8_BAR; PG8_WAIT_L(0); PG8_MMA(0, 1, At, B1); PG8_BAR;
            PG8_LDA(At, 1, 1); PG8_STAGE(PG8_SA(1, 0), a3, voffA);
            PG8_BAR; PG8_WAIT_L(0); PG8_MMA(1, 0, At, B0); PG8_BAR; PG8_SCHED;
            PG8_STAGE(PG8_SB(1, 1), b3 + hstep, voffB);
            PG8_WAIT_V(6); PG8_BAR; PG8_MMA(1, 1, At, B1); PG8_BAR;
            }
        }
        if constexpr (ALIGN_EPI) { if (wr == 0) PG8_BAR; }
        if constexpr (!Epi::AFTER_DRAIN) { E(acc, cur, wr, wc, fr, fq); S.done(cur); }
        if (!has_next) break;
#pragma unroll
        for (int a = 0; a < 2; ++a)
#pragma unroll
            for (int b = 0; b < 2; ++b)
#pragma unroll
                for (int m = 0; m < 4; ++m)
#pragma unroll
                    for (int n = 0; n < 2; ++n) acc[a][b][m][n] = (f32x4){0.f, 0.f, 0.f, 0.f};
        cur = nxt; cA = nA; cB = nB; ++ui;
        if constexpr (ALIGN_EPI) { if (wr == 1) PG8_BAR; }
    }
    PG8_WAIT_V(0);
    if constexpr (!ALIGN_EPI) { if (wr == 0) PG8_BAR; }
    PG8_BAR;
    if constexpr (Epi::AFTER_DRAIN) { E.fused(acc, cur, wr, wc, fr, fq, lds, wid, lane); S.done(cur); }
#undef PG8_SA
#undef PG8_SB
#undef PG8_STAGE
#undef PG8_LDA
#undef PG8_LDB
#undef PG8_MMA
#undef PG8_WAIT_V
#undef PG8_WAIT_L
#undef PG8_BAR
#undef PG8_SCHED
}
}
#define GAS __attribute__((address_space(1)))
#define LAS __attribute__((address_space(3)))
typedef unsigned short bf16;
typedef unsigned v4u __attribute__((ext_vector_type(4)));
typedef float f32x4 __attribute__((ext_vector_type(4)));
typedef short bf16x8 __attribute__((ext_vector_type(8)));
typedef GAS unsigned gu32;
typedef GAS unsigned long long gu64;
#define RLX_AGENT __ATOMIC_RELAXED, __HIP_MEMORY_SCOPE_AGENT
#define LDS_WAIT() asm volatile("s_waitcnt lgkmcnt(0)" ::: "memory")
#define VM_WAIT() asm volatile("s_waitcnt vmcnt(0)" ::: "memory")
__device__ __forceinline__ unsigned long long rt() { return __builtin_amdgcn_s_memrealtime(); }
__device__ __forceinline__ unsigned f2bf(float f) { unsigned u = __builtin_bit_cast(unsigned, f); return (u + 0x7fffu + ((u >> 16) & 1u)) >> 16; }
__device__ __forceinline__ unsigned pk2(float lo, float hi) { return f2bf(lo) | (f2bf(hi) << 16); }
#define XB_TMO      128
#define XB_XCNT(j)  (256  + 64 * (j))
#define XB_XSUB(j)  (1280 + 64 * (j))
#define XB_XGEN(j)  (2304 + 64 * (j))
#define XB_TOP      3328
#define XB_TOPGEN   3392
#define XCD_BAR_WORDS 3456
#define XB_SPIN_CAP (1u << 18)

__device__ __forceinline__ unsigned xb_ld(unsigned* p)              { return __hip_atomic_load(p, __ATOMIC_RELAXED, __HIP_MEMORY_SCOPE_AGENT); }
__device__ __forceinline__ unsigned xb_add(unsigned* p, unsigned v) { return __hip_atomic_fetch_add(p, v, __ATOMIC_RELAXED, __HIP_MEMORY_SCOPE_AGENT); }
__device__ __forceinline__ unsigned xb_xcc_id() { return (unsigned)__builtin_amdgcn_s_getreg((3 << 11) | 20) & 0xFu; }
#define XB_SPIN(cond, bar) do { unsigned _sp = 0; while (cond) { __builtin_amdgcn_s_sleep(1); \
    if ((++_sp & 255u) == 0u) { if (xb_ld(&(bar)[XB_TMO])) break; if (_sp > XB_SPIN_CAP) { atomicAdd(&(bar)[XB_TMO], 1u); break; } } } } while (0)

struct XcdBarrier {
    unsigned* bar; unsigned x;
    volatile LAS unsigned* st;
};

__device__ __forceinline__ XcdBarrier xcd_barrier_post(unsigned* bar, volatile LAS unsigned* st) {
    XcdBarrier b; b.bar = bar; b.x = xb_xcc_id(); b.st = st;
    if (threadIdx.x == 0) (void)xb_add(&bar[XB_XCNT(b.x)], 1u);
    return b;
}
__device__ __forceinline__ void xcd_barrier_complete(unsigned* bar, unsigned x, unsigned& nloc, unsigned& nx) {
    const unsigned G = gridDim.x * gridDim.y * gridDim.z;
    unsigned sum, cnt, mine, sp = 0u;
    for (;;) {
        sum = 0u; cnt = 0u; mine = 0u;
#pragma unroll
        for (unsigned j = 0; j < 16; ++j) { const unsigned c = xb_ld(&bar[XB_XCNT(j)]); sum += c; cnt += (c > 0u) ? 1u : 0u; mine = (j == x) ? c : mine; }
        if (sum == G) break;
        __builtin_amdgcn_s_sleep(1);
        if ((++sp & 255u) == 0u) { if (xb_ld(&bar[XB_TMO])) break; if (sp > XB_SPIN_CAP) { atomicAdd(&bar[XB_TMO], 1u); break; } }
    }
    nloc = mine > 0u ? mine : 1u; nx = cnt > 0u ? cnt : 1u;
}

__device__ __forceinline__ void xcd_barrier(const XcdBarrier& b) {
    asm volatile("s_waitcnt vmcnt(0)" ::: "memory");
    __syncthreads();
    if (threadIdx.x == 0) {
        unsigned* bar = b.bar;
        __builtin_amdgcn_s_waitcnt(0);
        unsigned nloc = b.st[0], nx = b.st[1];
        if (nloc == 0u) { xcd_barrier_complete(bar, b.x, nloc, nx); b.st[0] = nloc; b.st[1] = nx; }
        const unsigned old = xb_add(&bar[XB_XSUB(b.x)], 1u);
        const unsigned gen = old / nloc;
        if (old + 1u == (gen + 1u) * nloc) {
            __builtin_amdgcn_fence(__ATOMIC_RELEASE, "agent");
            asm volatile("s_waitcnt vmcnt(0)" ::: "memory");
            const unsigned og = xb_add(&bar[XB_TOP], 1u);
            const unsigned tg = og / nx;
            if (og + 1u == (tg + 1u) * nx) xb_add(&bar[XB_TOPGEN], 1u);
            else XB_SPIN(xb_ld(&bar[XB_TOPGEN]) == tg, bar);
            __builtin_amdgcn_fence(__ATOMIC_ACQUIRE, "agent");
            xb_add(&bar[XB_XGEN(b.x)], 1u);
            asm volatile("s_waitcnt vmcnt(0)" ::: "memory");
        } else {
            XB_SPIN(xb_ld(&bar[XB_XGEN(b.x)]) == gen, bar);
            __builtin_amdgcn_fence(__ATOMIC_ACQUIRE, "agent");
            asm volatile("s_waitcnt vmcnt(0)" ::: "memory");
        }
    }
    __syncthreads();
}

namespace pg8 {
struct UnitG { int seg, mt, nt; };
template <class Prob, class Epi, bool FP8 = false>
__device__ __forceinline__ void gemm_phase_g(PG8_LAS unsigned char* lds, const Prob& P, const Epi& E) {
    const int tid = threadIdx.x, wid = __builtin_amdgcn_readfirstlane(tid >> 6), lane = tid & 63, wr = wid >> 2, wc = wid & 3, fr = lane & 15, fq = lane >> 4;
    constexpr int EB = FP8 ? 1 : 2;
    const int K = P.K, nt = K * EB / 128;
    unsigned voffB[2], cbA[2];
#pragma unroll
    for (int i = 0; i < 2; ++i) { int R, C; stage_rc(tid * 16 + i * 8192, R, C); const int Rb = Epi::PERM ? ((R & ~31) + perm32(R & 31)) : R; voffB[i] = (unsigned)(Rb * K * EB + C * 2); cbA[i] = (unsigned)(C * 2); }
    const unsigned pitchA = (unsigned)P.pitchA;
    const size_t kstep = (size_t)(BK * 2);
    const size_t hstep = (size_t)HALF * K * EB;
    const unsigned ldsw = (unsigned)wid * 1024u;
    const int aoff = lds_byte(wr * 64 + fr, fq * 8), boff = lds_byte(wc * 32 + fr, fq * 8);
#define PG8_SA(b, h) (((b) * 2 + (h)) * HTB)
#define PG8_SB(b, h) ((4 + (b) * 2 + (h)) * HTB)
#define PG8_STAGE(bufoff, gbase, voff) do { _Pragma("unroll") for (int _i = 0; _i < 2; ++_i) \
        __builtin_amdgcn_global_load_lds((const unsigned*)((const char*)(gbase) + (voff)[_i]), (PG8_LAS unsigned*)(lds + (bufoff) + ldsw + _i * 8192), 16, 0, 0); } while (0)
#define PG8_STAGE_A(bufoff, gbase, rp_) do { const unsigned o0_ = ((rp_) & 0xffffu) * pitchA + cbA[0], o1_ = ((rp_) >> 16) * pitchA + cbA[1]; \
        __builtin_amdgcn_global_load_lds((const unsigned*)((const char*)(gbase) + o0_), (PG8_LAS unsigned*)(lds + (bufoff) + ldsw), 16, 0, 0); \
        __builtin_amdgcn_global_load_lds((const unsigned*)((const char*)(gbase) + o1_), (PG8_LAS unsigned*)(lds + (bufoff) + ldsw + 8192), 16, 0, 0); } while (0)
#define PG8_LDA(dst, b, h) do { _Pragma("unroll") for (int m = 0; m < 4; ++m) { const v4i_ lo_ = *(const PG8_LAS v4i_*)(lds + PG8_SA(b, h) + aoff + m * 2048), hi_ = *(const PG8_LAS v4i_*)(lds + PG8_SA(b, h) + aoff + m * 2048 + 1024); dst[m] = __builtin_shufflevector(lo_, hi_, 0, 1, 2, 3, 4, 5, 6, 7); } } while (0)
#define PG8_LDB(dst, b, h) do { _Pragma("unroll") for (int n = 0; n < 2; ++n) { const v4i_ lo_ = *(const PG8_LAS v4i_*)(lds + PG8_SB(b, h) + boff + n * 2048), hi_ = *(const PG8_LAS v4i_*)(lds + PG8_SB(b, h) + boff + n * 2048 + 1024); dst[n] = __builtin_shufflevector(lo_, hi_, 0, 1, 2, 3, 4, 5, 6, 7); } } while (0)
#define PG8_HALF(v_, k_) __builtin_bit_cast(bf16x8, (v4i_)__builtin_shufflevector(v_, v_, 4 * (k_), 4 * (k_) + 1, 4 * (k_) + 2, 4 * (k_) + 3))
#define PG8_MMA(ai, bj, At, Bt) do { __builtin_amdgcn_s_setprio(1); _Pragma("unroll") for (int m = 0; m < 4; ++m) _Pragma("unroll") for (int n = 0; n < 2; ++n) { \
        acc[ai][bj][m][n] = __builtin_amdgcn_mfma_f32_16x16x32_bf16(PG8_HALF(Bt[n], 0), PG8_HALF(At[m], 0), acc[ai][bj][m][n], 0, 0, 0); \
        acc[ai][bj][m][n] = __builtin_amdgcn_mfma_f32_16x16x32_bf16(PG8_HALF(Bt[n], 1), PG8_HALF(At[m], 1), acc[ai][bj][m][n], 0, 0, 0); } __builtin_amdgcn_s_setprio(0); } while (0)
#define PG8_Q(v_, q_) __builtin_bit_cast(long, (v2i_){v_[2 * (q_)], v_[2 * (q_) + 1]})
#define PG8_MMA8Q(ai, bj, At, Bt, q_) _Pragma("unroll") for (int m = 0; m < 4; ++m) _Pragma("unroll") for (int n = 0; n < 2; ++n) \
            acc[ai][bj][m][n] = __builtin_amdgcn_mfma_f32_16x16x32_fp8_fp8(PG8_Q(Bt[n], q_), PG8_Q(At[m], q_), acc[ai][bj][m][n], 0, 0, 0)
#define PG8_MMA8(ai, bj, At, Bt) do { typedef int v2i_ __attribute__((ext_vector_type(2))); __builtin_amdgcn_s_setprio(1); \
        PG8_MMA8Q(ai, bj, At, Bt, 0); PG8_MMA8Q(ai, bj, At, Bt, 1); PG8_MMA8Q(ai, bj, At, Bt, 2); PG8_MMA8Q(ai, bj, At, Bt, 3); \
        __builtin_amdgcn_s_setprio(0); } while (0)
#define PG8_MM(ai, bj, At, Bt) do { if constexpr (FP8) PG8_MMA8(ai, bj, At, Bt); else PG8_MMA(ai, bj, At, Bt); } while (0)
#define PG8_WAIT_V(n) asm volatile("s_waitcnt vmcnt(" #n ")" ::: "memory")
#define PG8_WAIT_L(n) asm volatile("s_waitcnt lgkmcnt(" #n ")" ::: "memory")
#define PG8_BAR __builtin_amdgcn_s_barrier()
#define PG8_SCHED __builtin_amdgcn_sched_barrier(0)
    UnitG cur, nxt; int ui = 0;
    if (!P.next(0, cur)) return;
    f32x4 acc[2][2][4][2];
#pragma unroll
    for (int a = 0; a < 2; ++a)
#pragma unroll
        for (int b = 0; b < 2; ++b)
#pragma unroll
            for (int m = 0; m < 4; ++m)
#pragma unroll
                for (int n = 0; n < 2; ++n) acc[a][b][m][n] = (f32x4){0.f, 0.f, 0.f, 0.f};
    typedef int v4i_ __attribute__((ext_vector_type(4))); typedef int v8i_ __attribute__((ext_vector_type(8)));
    v8i_ At[4], B0[2], B1[2];
    unsigned rowp[2], rowpn[2];
    const char* cA; const char* cB;
    P.setup_base(cur, cA, cB);
    P.meta(cur, lds, 0, wid, lane);
    P.rows_first(cur, lds, 0, rowp);
    PG8_STAGE(PG8_SB(0, 0), cB, voffB); PG8_STAGE(PG8_SB(0, 1), cB + hstep, voffB); PG8_STAGE_A(PG8_SA(0, 0), cA, rowp[0]); PG8_STAGE_A(PG8_SA(0, 1), cA, rowp[1]);
    if (wr == 1) PG8_BAR;
    PG8_WAIT_V(2); PG8_BAR;
    PG8_STAGE(PG8_SB(1, 0), cB + kstep, voffB); PG8_STAGE_A(PG8_SA(1, 0), cA + kstep, rowp[0]); PG8_STAGE(PG8_SB(1, 1), cB + hstep + kstep, voffB);
    PG8_WAIT_V(6); PG8_BAR;
    for (;;) {
        const bool has_next = P.next(ui + 1, nxt);
        const char* nA = cA; const char* nB = cB;
        rowpn[0] = rowp[0]; rowpn[1] = rowp[1];
        if (has_next) { P.setup_base(nxt, nA, nB); P.meta(nxt, lds, (ui + 1) % 3, wid, lane); }
        for (int t = 0; t < nt; t += 2) {
            const bool last = (t == nt - 2);
            const char* a1 = cA + (size_t)(t + 1) * kstep;
            const char* a2 = last ? nA : cA + (size_t)(t + 2) * kstep; const char* b2 = last ? nB : cB + (size_t)(t + 2) * kstep;
            const char* a3 = a2 + kstep; const char* b3 = b2 + kstep;
            if (last && has_next) P.rows(nxt, lds, (ui + 1) % 3, rowpn);
            const unsigned o2_0 = last ? rowpn[0] : rowp[0], o2_1 = last ? rowpn[1] : rowp[1];
            PG8_LDB(B0, 0, 0); PG8_LDB(B1, 0, 1); PG8_SCHED; PG8_LDA(At, 0, 0); PG8_STAGE_A(PG8_SA(1, 1), a1, rowp[1]);
            PG8_WAIT_V(8); PG8_WAIT_L(0); PG8_BAR; PG8_MM(0, 0, At, B0); PG8_MM(0, 1, At, B1); PG8_BAR; PG8_SCHED;
            PG8_LDA(At, 0, 1); PG8_STAGE(PG8_SB(0, 0), b2, voffB); PG8_STAGE(PG8_SB(0, 1), b2 + hstep, voffB); PG8_STAGE_A(PG8_SA(0, 0), a2, o2_0);
            PG8_WAIT_V(8); PG8_WAIT_L(0); PG8_BAR; PG8_MM(1, 0, At, B0); PG8_MM(1, 1, At, B1); PG8_BAR; PG8_SCHED;
            PG8_LDB(B0, 1, 0); PG8_LDB(B1, 1, 1); PG8_SCHED; PG8_LDA(At, 1, 0); PG8_STAGE_A(PG8_SA(0, 1), a2, o2_1);
            PG8_WAIT_V(8); PG8_WAIT_L(0); PG8_BAR; PG8_MM(0, 0, At, B0); PG8_MM(0, 1, At, B1); PG8_BAR; PG8_SCHED;
            PG8_LDA(At, 1, 1); PG8_STAGE(PG8_SB(1, 0), b3, voffB); PG8_STAGE(PG8_SB(1, 1), b3 + hstep, voffB); PG8_STAGE_A(PG8_SA(1, 0), a3, o2_0);
            PG8_WAIT_V(8); PG8_WAIT_L(0); PG8_BAR; PG8_MM(1, 0, At, B0); PG8_MM(1, 1, At, B1); PG8_BAR; PG8_SCHED;
        }
        if (wr == 0) PG8_BAR;
        E(acc, cur, wr, wc, fr, fq, lds, ui % 3);
        if (!has_next) break;
#pragma unroll
        for (int a = 0; a < 2; ++a)
#pragma unroll
            for (int b = 0; b < 2; ++b)
#pragma unroll
                for (int m = 0; m < 4; ++m)
#pragma unroll
                    for (int n = 0; n < 2; ++n) acc[a][b][m][n] = (f32x4){0.f, 0.f, 0.f, 0.f};
        cur = nxt; cA = nA; cB = nB; ++ui;
        rowp[0] = rowpn[0]; rowp[1] = rowpn[1];
        if (wr == 1) PG8_BAR;
    }
    PG8_WAIT_V(0);
    PG8_BAR;
#undef PG8_SA
#undef PG8_SB
#undef PG8_STAGE
#undef PG8_STAGE_A
#undef PG8_LDA
#undef PG8_LDB
#undef PG8_MMA
#undef PG8_MMA8
#undef PG8_Q
#undef PG8_MMA8Q
#undef PG8_HALF
#undef PG8_MM
#undef PG8_WAIT_V
#undef PG8_WAIT_L
#undef PG8_BAR
#undef PG8_SCHED
}
}

constexpr int NWAVES = 8;
constexpr int BATCH = 2, T = 8192, D = 1024, M = BATCH * T, DIN = 4104, PA = 3072;
constexpr int NE = 64, NEX = 65, DE = 256;
constexpr size_t MiB = 1u << 20;
constexpr size_t WS_CTL = 0, CTL_ZERO_BYTES = 256 * 1024;
constexpr size_t WS_WRHI = 512 * 1024, WS_WRLO = 640 * 1024;
constexpr size_t WS_MOD = 1 * MiB, WS_WAB = 1 * MiB + 256 * 1024, WS_AB = 1 * MiB + 512 * 1024;
constexpr size_t WS_WOUT_T = 2 * MiB, WS_WIN_T = 4 * MiB, WS_H1 = 12 * MiB, WS_PROJA = 44 * MiB, WS_GATES = 142 * MiB;
constexpr size_t WS_QP = 4 * MiB, WS_OI = 20 * MiB, WS_AH = 36 * MiB, WS_GL = 36 * MiB + 512 * 1024, WS_PG = 174 * MiB, WS_BG = 206 * MiB, WS_BH = 238 * MiB, WS_QE = 270 * MiB, WS_OIH = 286 * MiB;
constexpr size_t WS_OMIX = 174 * MiB;
constexpr size_t WS_H2 = 12 * MiB, WS_W1T = 44 * MiB, WS_W2T = 109 * MiB, WS_ACT = 142 * MiB, WS_LIST = 215 * MiB, WS_LISTW = 217 * MiB, WS_Y0 = 12 * MiB, WS_Y1 = 219 * MiB;
constexpr size_t WS_YS = 80 * MiB;
constexpr size_t WS_TOP = 302 * MiB;
constexpr int CAP = 8192;
constexpr int TB_PRE = 0, TB_CNT = 132, TB_OFF = 264;
constexpr int CW_CNT = 16384;
constexpr int CW_BAR = 4096;
constexpr int RING_BYTES = 131072, LDS_BYTES = 163840, LDSCTL_OFF = LDS_BYTES - 1024, MISC_OFF = LDSCTL_OFF + 320, SCR2_OFF = LDS_BYTES - 3072;

__device__ __forceinline__ float bf2f(bf16 v) { return __uint_as_float(((unsigned)v) << 16); }
__device__ __forceinline__ float frcp_(float x) { return __builtin_amdgcn_rcpf(x); }
__device__ __forceinline__ float sigmoidf_(float x) { return frcp_(1.f + __expf(-x)); }
__device__ __forceinline__ float siluf_(float x) { return x * frcp_(1.f + __expf(-x)); }
__device__ __forceinline__ float softplusf_(float x) { return x > 20.f ? x : log1pf(expf(x)); }
__device__ __forceinline__ float c8(float x) { return __builtin_amdgcn_fmed3f(x, -448.f, 448.f); }
__device__ __forceinline__ float wave_sum(float v) {
#pragma unroll
    for (int o = 1; o < 64; o <<= 1) v += __shfl_xor(v, o);
    return v;
}

template <int CTRL> __device__ __forceinline__ float dppf(float v) { return __int_as_float(__builtin_amdgcn_update_dpp(__float_as_int(v), __float_as_int(v), CTRL, 0xf, 0xf, false)); }
__device__ __forceinline__ float rdlane(float v, int l) { return __int_as_float(__builtin_amdgcn_readlane(__float_as_int(v), l)); }
__device__ __forceinline__ float wave_max(float v) {
    v = fmaxf(v, dppf<0xB1>(v)); v = fmaxf(v, dppf<0x4E>(v)); v = fmaxf(v, dppf<0x141>(v)); v = fmaxf(v, dppf<0x140>(v));
    return fmaxf(fmaxf(rdlane(v, 0), rdlane(v, 16)), fmaxf(rdlane(v, 32), rdlane(v, 48)));
}
__device__ __forceinline__ float wave_sum_dpp(float v) {
    v += dppf<0xB1>(v); v += dppf<0x4E>(v); v += dppf<0x141>(v); v += dppf<0x140>(v);
    return (rdlane(v, 0) + rdlane(v, 16)) + (rdlane(v, 32) + rdlane(v, 48));
}

namespace pg8 {
struct EpiProj {
    static constexpr bool PERM = true, AFTER_DRAIN = false;
    bf16_t* projA; bf16_t* gates;
    __device__ __forceinline__ void operator()(const f32x4 (&acc)[2][2][4][2], const Unit& u, int wr, int wc, int fr, int fq) const {
        const int row0 = u.pm * BM + wr * 64 + fr;
        bf16_t* base; int ldc, colt;
        if (u.pn < 12) { base = projA; ldc = 3072; colt = u.pn * BM; } else { base = gates; ldc = 1024; colt = (u.pn - 12) * BM; }
        const int col0 = colt + wc * 32 + 8 * fq;
#pragma unroll
        for (int ai = 0; ai < 2; ++ai)
#pragma unroll
            for (int m = 0; m < 4; ++m) { bf16_t* rowp = base + (size_t)(row0 + ai * HALF + m * 16) * ldc + col0;
#pragma unroll
                for (int bj = 0; bj < 2; ++bj) { const f32x4 v0 = acc[ai][bj][m][0], v1 = acc[ai][bj][m][1];
                    u32x4 w; w.x = cvt_pk_bf16(v0[0], v0[1]); w.y = cvt_pk_bf16(v0[2], v0[3]); w.z = cvt_pk_bf16(v1[0], v1[1]); w.w = cvt_pk_bf16(v1[2], v1[3]);
                    *(u32x4*)(rowp + bj * HALF) = w; } }
    }
};
struct EpiResid {
    static constexpr bool PERM = false, AFTER_DRAIN = false;
    const float* x; const float* mod; float* out;
    __device__ __forceinline__ void operator()(const f32x4 (&acc)[2][2][4][2], const Unit& u, int wr, int wc, int fr, int fq) const {
        const int col0 = u.pn * BM + wc * 32 + 4 * fq;
        const float* g1 = mod + (u.pm * BM >= 8192 ? 6144 : 0) + 2048;
        f32x4 gv[2][2];
#pragma unroll
        for (int bj = 0; bj < 2; ++bj)
#pragma unroll
            for (int n = 0; n < 2; ++n) gv[bj][n] = *(const f32x4*)(g1 + col0 + bj * HALF + n * 16);
#pragma unroll
        for (int ai = 0; ai < 2; ++ai)
#pragma unroll
            for (int mp = 0; mp < 4; mp += 2) { f32x4 xv[2][2][2];
#pragma unroll
                for (int q = 0; q < 2; ++q) { const size_t off = (size_t)(u.pm * BM + ai * HALF + wr * 64 + (mp + q) * 16 + fr) * 1024 + col0;
#pragma unroll
                    for (int bj = 0; bj < 2; ++bj)
#pragma unroll
                        for (int n = 0; n < 2; ++n) xv[q][bj][n] = *(const f32x4*)(x + off + bj * HALF + n * 16); }
#pragma unroll
                for (int q = 0; q < 2; ++q) { const size_t off = (size_t)(u.pm * BM + ai * HALF + wr * 64 + (mp + q) * 16 + fr) * 1024 + col0;
#pragma unroll
                    for (int bj = 0; bj < 2; ++bj)
#pragma unroll
                        for (int n = 0; n < 2; ++n) *(f32x4*)(out + off + bj * HALF + n * 16) = xv[q][bj][n] + gv[bj][n] * acc[ai][bj][mp + q][n]; }
            }
    }
};

struct MoeSched {
    const LAS unsigned* tb; int lo, hi, NT, G, c; int perm;
    __device__ __forceinline__ int segof(int p) const { return perm ? (p & 1) * 65 + (p >> 1) : p; }
    __device__ __forceinline__ bool next(int i, UnitG& u) const {
        const unsigned L = (unsigned)(i * G + c); if (L >= tb[TB_PRE + hi]) return false;
        int s = lo; { int hi_ = hi; while (hi_ - s > 1) { const int mid = (s + hi_) >> 1; if (L >= tb[TB_PRE + mid]) s = mid; else hi_ = mid; } }
        const int sg = segof(s);
        const unsigned loc = L - tb[TB_PRE + s], tiles = (tb[TB_CNT + sg] + 255u) >> 8;
        u.seg = __builtin_amdgcn_readfirstlane(sg); u.mt = __builtin_amdgcn_readfirstlane((int)(loc % tiles)); u.nt = __builtin_amdgcn_readfirstlane((int)(loc / tiles)); return true;
    }
};
struct Moe1Prob {
    int K; int pitchA; MoeSched S; const unsigned char* h2; const unsigned char* w1t; const int* list;
    __device__ __forceinline__ bool next(int i, UnitG& u) const { return S.next(i, u); }
    __device__ __forceinline__ void setup_base(const UnitG& u, const char*& cA, const char*& cB) const { cA = (const char*)h2; cB = (const char*)(w1t + ((size_t)u.seg * 512 + (size_t)u.nt * 256) * 1024); }
    __device__ __forceinline__ void meta(const UnitG& u, PG8_LAS unsigned char* lds, int slot, int wid, int lane) const {
        if (wid == 0 && u.seg < 64) __builtin_amdgcn_global_load_lds((const unsigned*)(list + (size_t)u.seg * CAP + 256u * (unsigned)u.mt + 4u * (unsigned)lane), (PG8_LAS unsigned*)(lds + STAGE_BYTES + slot * 2048), 16, 0, 0);
    }
    __device__ __forceinline__ void rows(const UnitG& u, PG8_LAS unsigned char* lds, int slot, unsigned (&rowp)[2]) const {
        int sR[2], sC[2];
#pragma unroll
        for (int i = 0; i < 2; ++i) stage_rc((int)threadIdx.x * 16 + i * 8192, sR[i], sC[i]);
        const int e = u.seg; const int cnt = (int)S.tb[TB_CNT + u.seg]; const PG8_LAS int* tbl = (const PG8_LAS int*)(lds + STAGE_BYTES + slot * 2048);
#pragma unroll
        for (int h = 0; h < 2; ++h) { unsigned tk[2];
#pragma unroll
            for (int i = 0; i < 2; ++i) { const int rl = 128 * h + sR[i], r = 256 * u.mt + rl;
                if (e < 64) { const int last_ = cnt - 1 - 256 * u.mt; tk[i] = (unsigned)tbl[rl < last_ ? rl : last_] >> 3; } else tk[i] = (unsigned)(r < M ? r : M - 1); }
            rowp[h] = tk[0] | (tk[1] << 16); }
    }
    __device__ __forceinline__ void rows_first(const UnitG& u, PG8_LAS unsigned char* lds, int slot, unsigned (&rowp)[2]) const {
        asm volatile("s_waitcnt vmcnt(0)" ::: "memory"); __builtin_amdgcn_s_barrier(); asm volatile("" ::: "memory");
        rows(u, lds, slot, rowp);
    }
};
struct Moe2Prob {
    int K; int pitchA; MoeSched S; const unsigned char* act; const unsigned char* w2t; const int* list; const float* listw;
    __device__ __forceinline__ bool next(int i, UnitG& u) const { return S.next(i, u); }
    __device__ __forceinline__ void meta(const UnitG& u, PG8_LAS unsigned char* lds, int par, int wid, int lane) const {
        if (wid == 0 && u.seg < 64) { const size_t o = (size_t)u.seg * CAP + 256u * (unsigned)u.mt + 4u * (unsigned)lane;
            __builtin_amdgcn_global_load_lds((const unsigned*)(list + o), (PG8_LAS unsigned*)(lds + STAGE_BYTES + par * 2048), 16, 0, 0);
            __builtin_amdgcn_global_load_lds((const unsigned*)(listw + o), (PG8_LAS unsigned*)(lds + STAGE_BYTES + par * 2048 + 1024), 16, 0, 0); }
    }
    __device__ __forceinline__ void setup_base(const UnitG& u, const char*& cA, const char*& cB) const {
        const size_t rowbase = (size_t)S.tb[TB_OFF + u.seg] + 256u * (unsigned)u.mt;
        cA = (const char*)(act + rowbase * 256); cB = (const char*)(w2t + ((size_t)u.seg * 1024 + (size_t)u.nt * 256) * 256);
    }
    __device__ __forceinline__ void rows(const UnitG&, PG8_LAS unsigned char*, int, unsigned (&rowp)[2]) const {
        int sR[2], sC[2];
#pragma unroll
        for (int i = 0; i < 2; ++i) stage_rc((int)threadIdx.x * 16 + i * 8192, sR[i], sC[i]);
#pragma unroll
        for (int h = 0; h < 2; ++h) rowp[h] = (unsigned)(128 * h + sR[0]) | ((unsigned)(128 * h + sR[1]) << 16);
    }
    __device__ __forceinline__ void rows_first(const UnitG& u, PG8_LAS unsigned char* lds, int slot, unsigned (&rowp)[2]) const { rows(u, lds, slot, rowp); }
};
struct EpiMoe1 {
    static constexpr bool PERM = true;
    unsigned char* act; const LAS unsigned* tb;
    __device__ __forceinline__ void operator()(const f32x4 (&acc)[2][2][4][2], const UnitG& u, int wr, int wc, int fr_, int fq_, PG8_LAS unsigned char*, int) const {
        int t_ = (int)threadIdx.x; asm volatile("" : "+v"(t_));
        const int fr = t_ & 15, fq = (t_ >> 4) & 3;
        const int cnt = (int)tb[TB_CNT + u.seg]; const size_t rowbase = tb[TB_OFF + u.seg];
#pragma unroll
        for (int ai = 0; ai < 2; ++ai)
#pragma unroll
            for (int m = 0; m < 4; ++m) { const int r = 256 * u.mt + ai * HALF + wr * 64 + m * 16 + fr;
                if (r < cnt) { unsigned char* p = act + (rowbase + (size_t)r) * 256 + u.nt * 128 + wc * 32 + 8 * fq;
                    const f32x4 g0 = acc[ai][0][m][0], g1 = acc[ai][0][m][1], u0 = acc[ai][1][m][0], u1 = acc[ai][1][m][1]; f32x4 v0, v1;
#pragma unroll
                    for (int i = 0; i < 4; ++i) { const float ga = g0[i] * 0.03125f, gb = g1[i] * 0.03125f; v0[i] = ga * frcp_(1.f + __expf(-ga)) * (u0[i] * 0.25f); v1[i] = gb * frcp_(1.f + __expf(-gb)) * (u1[i] * 0.25f); }
                    unsigned o0 = __builtin_amdgcn_cvt_pk_fp8_f32(c8(v0[0]), c8(v0[1]), 0, false); o0 = __builtin_amdgcn_cvt_pk_fp8_f32(c8(v0[2]), c8(v0[3]), o0, true);
                    unsigned o1 = __builtin_amdgcn_cvt_pk_fp8_f32(c8(v1[0]), c8(v1[1]), 0, false); o1 = __builtin_amdgcn_cvt_pk_fp8_f32(c8(v1[2]), c8(v1[3]), o1, true);
                    typedef unsigned u32x2_ __attribute__((ext_vector_type(2)));
                    *(u32x2_*)p = (u32x2_){o0, o1}; } }
    }
};
struct EpiMoe2 {
    static constexpr bool PERM = true;
    unsigned char* y0; unsigned char* y1; unsigned char* ys; const LAS unsigned* tb;
    __device__ __forceinline__ void operator()(const f32x4 (&acc)[2][2][4][2], const UnitG& u, int wr, int wc, int fr_, int fq_, PG8_LAS unsigned char* lds, int par) const {
        int t_ = (int)threadIdx.x; asm volatile("" : "+v"(t_));
        const int fr = t_ & 15, fq = (t_ >> 4) & 3;
        const int cnt = (int)tb[TB_CNT + u.seg]; const int e = u.seg; const int colt = u.nt * 256 + wc * 32 + 8 * fq;
        const PG8_LAS int* mslot = (const PG8_LAS int*)(lds + STAGE_BYTES + par * 2048); const PG8_LAS float* mw = (const PG8_LAS float*)(lds + STAGE_BYTES + par * 2048 + 1024);
#pragma unroll
        for (int ai = 0; ai < 2; ++ai)
#pragma unroll
            for (int m = 0; m < 4; ++m) { const int rl = ai * HALF + wr * 64 + m * 16 + fr, r = 256 * u.mt + rl;
                if (r < cnt) { int sl; float w;
                    if (e < 64) { sl = mslot[rl]; w = mw[rl] * 0.25f; } else { sl = r; w = 0.25f; }
                    unsigned char* p = (e < 64 ? (sl >= 65536 ? y1 + (size_t)(sl - 65536) * 1024 : y0 + (size_t)sl * 1024) : ys + (size_t)sl * 1024) + colt;
#pragma unroll
                    for (int bj = 0; bj < 2; ++bj) { const f32x4 v0 = acc[ai][bj][m][0] * w, v1 = acc[ai][bj][m][1] * w;
                        unsigned o0 = __builtin_amdgcn_cvt_pk_fp8_f32(v0[0], v0[1], 0, false); o0 = __builtin_amdgcn_cvt_pk_fp8_f32(v0[2], v0[3], o0, true);
                        unsigned o1 = __builtin_amdgcn_cvt_pk_fp8_f32(v1[0], v1[1], 0, false); o1 = __builtin_amdgcn_cvt_pk_fp8_f32(v1[2], v1[3], o1, true);
                        typedef unsigned u32x2_ __attribute__((ext_vector_type(2)));
                        *(u32x2_*)(p + bj * HALF) = (u32x2_){o0, o1}; } } }
    }
};
}

struct TrItem { const float* W; int ldw, src_col; bf16* WT; int K, dst_row, k0; float f8scale; };
__device__ __forceinline__ void tr_load(const TrItem& t, int lane, f32x4 (&v)[8]) {
#pragma unroll
    for (int i = 0; i < 8; ++i) v[i] = *(const GAS f32x4*)(t.W + (size_t)(t.k0 + 8 * i + (lane >> 3)) * t.ldw + t.src_col + 4 * (lane & 7));
}
__device__ __forceinline__ void tr_finish(const TrItem& t, int lane, const f32x4 (&v)[8], LAS float* scr) {
#pragma unroll
    for (int i = 0; i < 8; ++i) { LAS float* p = scr + (8 * i + (lane >> 3)) * 33 + 4 * (lane & 7); p[0] = v[i][0]; p[1] = v[i][1]; p[2] = v[i][2]; p[3] = v[i][3]; }
    LDS_WAIT(); asm volatile("" ::: "memory");
    const int c = lane & 7;
#pragma unroll
    for (int j = 0; j < 4; ++j) { const int n = (lane >> 3) + 8 * j; const LAS float* s = scr + (8 * c) * 33 + n;
        if (t.f8scale != 0.f) { const float q = t.f8scale; typedef unsigned u32x2_ __attribute__((ext_vector_type(2)));
            unsigned o0 = __builtin_amdgcn_cvt_pk_fp8_f32(s[0 * 33] * q, s[1 * 33] * q, 0, false); o0 = __builtin_amdgcn_cvt_pk_fp8_f32(s[2 * 33] * q, s[3 * 33] * q, o0, true);
            unsigned o1 = __builtin_amdgcn_cvt_pk_fp8_f32(s[4 * 33] * q, s[5 * 33] * q, 0, false); o1 = __builtin_amdgcn_cvt_pk_fp8_f32(s[6 * 33] * q, s[7 * 33] * q, o1, true);
            *(GAS u32x2_*)((GAS unsigned char*)t.WT + (size_t)(t.dst_row + n) * t.K + t.k0 + 8 * c) = (u32x2_){o0, o1};
        } else {
        v4u o; o.x = pk2(s[0 * 33], s[1 * 33]); o.y = pk2(s[2 * 33], s[3 * 33]); o.z = pk2(s[4 * 33], s[5 * 33]); o.w = pk2(s[6 * 33], s[7 * 33]);
        *(GAS v4u*)(t.WT + (size_t)(t.dst_row + n) * t.K + t.k0 + 8 * c) = o; } }
    LDS_WAIT(); asm volatile("" ::: "memory");
}
#define TR_LOOP(it0, stride, nitems, MAKE) do { int it_ = (it0); if (it_ < (nitems)) { TrItem cur_ = MAKE(it_); f32x4 va_[8], vb_[8]; tr_load(cur_, lane, va_); \
    for (;;) { const int nx_ = it_ + (stride); const bool hn_ = nx_ < (nitems); TrItem nxt_ = cur_; if (hn_) { nxt_ = MAKE(nx_); tr_load(nxt_, lane, vb_); } \
        tr_finish(cur_, lane, va_, scr); if (!hn_) break; _Pragma("unroll") for (int q_ = 0; q_ < 8; ++q_) va_[q_] = vb_[q_]; cur_ = nxt_; it_ = nx_; } } } while (0)

#ifndef REP_PHASE
#define REP_PHASE -1
#endif
#ifndef REP_N
#define REP_N 1
#endif
#define REPN(k) ((k) == REP_PHASE ? REP_N : 1)

constexpr int UNITS = BATCH * 128 * 4;
constexpr int L_QN = 0, L_KN = 17408, L_VV = 34816, L_LM = 52224, L_ATT = 68608, L_UT = 77824, L_WT = 96256, L_KTT = 114688, L_GCS = 133120, L_EGS = 133376, L_BET = 133632, L_SCW = 133888, L_SKT = 134144, L_TM = L_KN, L_TB = L_VV;
constexpr int H_FR = 0, H_QR = 17408, H_QE = 34816, H_KD = 52224, H_KTT = 69632, H_VT = 88064, H_AM = 106496;
constexpr int RS = 272, TS = 144;

typedef unsigned v2u __attribute__((ext_vector_type(2)));
#define LBAR() do { asm volatile("s_waitcnt lgkmcnt(0)" ::: "memory"); __builtin_amdgcn_s_barrier(); asm volatile("" ::: "memory"); } while (0)
__device__ __forceinline__ f32x4 mfma16(bf16x8 a, bf16x8 b, f32x4 c) { return __builtin_amdgcn_mfma_f32_16x16x32_bf16(a, b, c, 0, 0, 0); }
__device__ __forceinline__ bf16x8 ldsfrag(const LAS unsigned char* base, int row, int stride, int kbyte) { return *(const LAS bf16x8*)(base + row * stride + kbyte); }
__device__ __forceinline__ void unpack8(const v4u q, float (&f)[8]) {
    f[0] = __uint_as_float(q.x << 16); f[1] = __uint_as_float(q.x & 0xffff0000u); f[2] = __uint_as_float(q.y << 16); f[3] = __uint_as_float(q.y & 0xffff0000u);
    f[4] = __uint_as_float(q.z << 16); f[5] = __uint_as_float(q.z & 0xffff0000u); f[6] = __uint_as_float(q.w << 16); f[7] = __uint_as_float(q.w & 0xffff0000u); }
__device__ __forceinline__ f32x4 unpack4(const v2u q) { return (f32x4){__uint_as_float(q.x << 16), __uint_as_float(q.x & 0xffff0000u), __uint_as_float(q.y << 16), __uint_as_float(q.y & 0xffff0000u)}; }
__device__ __forceinline__ v2u pack4(const f32x4 v) { v2u o; o.x = pk2(v[0], v[1]); o.y = pk2(v[2], v[3]); return o; }
__device__ __forceinline__ float ldsbf(const LAS unsigned char* base, int row, int stride, int col) { return __uint_as_float(((unsigned)*(const LAS unsigned short*)(base + row * stride + col * 2)) << 16); }

struct MixPtrs {
    const bf16* projA; const bf16* gates; const float* ab; const float* conv_w; const float* a_log; const float* dt_bias; const float* hg_lb; const float* gdn_nw; const float* hg_nw;
    bf16 *PG, *BG, *QP, *OI, *BH, *QE, *OIH, *SG, *SH, *omix; float *GL, *AH;
};

__device__ __forceinline__ void p3_gdn_unit(LAS unsigned char* lds, const MixPtrs& X, int unit, int tid, int lane, int wave) {
    const int h = unit & 3, n = (unit >> 2) & 127, b = unit >> 9, r = lane & 15, g = lane >> 4;
    const size_t tok0 = (size_t)b * T + (size_t)n * 64;
    LAS float* gcs = (LAS float*)(lds + L_GCS); LAS float* egs = (LAS float*)(lds + L_EGS); LAS float* bet = (LAS float*)(lds + L_BET);
    {
#pragma unroll 1
      for (int ib = 0; ib < 6; ib += 3) {
        v4u raw[3][4];
#pragma unroll
        for (int i2 = 0; i2 < 3; ++i2) { const int i = ib + i2; const int pair = (tid >> 4) + 32 * i, tz = pair >> 6, c = pair & 63, ch = tid & 15, col = tz * 512 + h * 128 + ch * 8;
#pragma unroll
            for (int j = 0; j < 4; ++j) { const int tl = n * 64 + c - 3 + j; raw[i2][j] = *(const GAS v4u*)(X.projA + ((size_t)b * T + (tl < 0 ? 0 : tl)) * PA + col); } }
#pragma unroll
        for (int i2 = 0; i2 < 3; ++i2) { const int i = ib + i2;
            const int pair = (tid >> 4) + 32 * i, tz = pair >> 6, c = pair & 63, ch = tid & 15, col = tz * 512 + h * 128 + ch * 8;
            float y[8];
#pragma unroll
            for (int e = 0; e < 8; ++e) y[e] = 0.f;
#pragma unroll
            for (int j = 0; j < 4; ++j) { const int tl = n * 64 + c - 3 + j; const float msk = tl >= 0 ? 1.f : 0.f; float xf[8]; unpack8(raw[i2][j], xf);
                const f32x4 w0 = *(const GAS f32x4*)(X.conv_w + j * 1536 + col) * msk, w1 = *(const GAS f32x4*)(X.conv_w + j * 1536 + col + 4) * msk;
#pragma unroll
                for (int e = 0; e < 4; ++e) { y[e] += w0[e] * xf[e]; y[4 + e] += w1[e] * xf[4 + e]; } }
            float ss = 0.f;
#pragma unroll
            for (int e = 0; e < 8; ++e) { y[e] = siluf_(y[e]); ss += y[e] * y[e]; }
            ss += __shfl_xor(ss, 1); ss += __shfl_xor(ss, 2); ss += __shfl_xor(ss, 4); ss += __shfl_xor(ss, 8);
            const float rn = tz == 2 ? 1.f : rsqrtf(ss + 1e-6f) * (tz == 0 ? 0.08838834764831845f : 1.f);
            v4u o; o.x = pk2(y[0] * rn, y[1] * rn); o.y = pk2(y[2] * rn, y[3] * rn); o.z = pk2(y[4] * rn, y[5] * rn); o.w = pk2(y[6] * rn, y[7] * rn);
            *(LAS v4u*)(lds + (tz == 0 ? L_QN : (tz == 1 ? L_KN : L_VV)) + c * RS + ch * 16) = o;
        }
      }
    }
    if (wave == 0) {
        const float araw = X.ab[(tok0 + lane) * 8 + 4 + h], braw = X.ab[(tok0 + lane) * 8 + h];
        float gv = -expf(X.a_log[h]) * softplusf_(araw + X.dt_bias[h]);
#pragma unroll
        for (int o = 1; o < 64; o <<= 1) { const float t = __shfl_up(gv, o); if (lane >= o) gv += t; }
        { const float eg_ = __expf(gv), be_ = sigmoidf_(braw); gcs[lane] = gv; egs[lane] = eg_; bet[lane] = be_; *(LAS float*)(lds + L_SCW + lane * 4) = be_ * eg_; *(LAS float*)(lds + L_SKT + lane * 4) = __expf(__shfl(gv, 63) - gv); }
        if (lane == 63) X.GL[unit] = gv;
    }
    LBAR();
    {
        const int mt = wave >> 1;
#pragma unroll
        for (int q = 0; q < 2; ++q) { const int ntc = 2 * (wave & 1) + q; f32x4 akk = {0.f, 0.f, 0.f, 0.f}, aqk = {0.f, 0.f, 0.f, 0.f};
#pragma unroll
            for (int ks = 0; ks < 4; ++ks) { const bf16x8 ka = ldsfrag(lds + L_KN, 16 * mt + r, RS, 64 * ks + 16 * g), qa = ldsfrag(lds + L_QN, 16 * mt + r, RS, 64 * ks + 16 * g), kb = ldsfrag(lds + L_KN, 16 * ntc + r, RS, 64 * ks + 16 * g);
                akk = mfma16(ka, kb, akk); aqk = mfma16(qa, kb, aqk); }
            const int j = 16 * ntc + r; const float gj = gcs[j];
#pragma unroll
            for (int ii = 0; ii < 4; ++ii) { const int i = 16 * mt + 4 * g + ii; const float dec = (i >= j) ? __expf(gcs[i] - gj) : 0.f;
                *(LAS float*)(lds + L_LM + (i * 64 + j) * 4) = (i > j) ? bet[i] * akk[ii] * dec : 0.f;
                *(LAS unsigned short*)(lds + L_ATT + i * TS + j * 2) = (unsigned short)f2bf(aqk[ii] * dec); } }
    }
    LBAR();
#pragma unroll
    for (int i = 0; i < 2; ++i) { const int tsk = tid + 512 * i;
        if (tsk < 768) { const int a = tsk >> 8, hh = (tsk >> 7) & 1, d = tsk & 127;
            const LAS unsigned char* sp = lds + (a == 0 ? L_VV : L_KN) + d * 2; const LAS float* scl = (const LAS float*)(lds + (a == 0 ? L_BET : (a == 1 ? L_SCW : L_SKT)));
            LAS unsigned char* dp = lds + (a == 0 ? L_UT : (a == 1 ? L_WT : L_KTT)) + d * TS + 64 * hh;
#pragma unroll
            for (int q = 0; q < 4; ++q) { float kv[8];
#pragma unroll
                for (int e = 0; e < 8; ++e) { const int c = 32 * hh + 8 * q + e; kv[e] = __uint_as_float(((unsigned)*(const LAS unsigned short*)(sp + c * RS)) << 16) * scl[c]; }
                v4u o; o.x = pk2(kv[0], kv[1]); o.y = pk2(kv[2], kv[3]); o.z = pk2(kv[4], kv[5]); o.w = pk2(kv[6], kv[7]); *(LAS v4u*)(dp + 16 * q) = o; } } }
    LBAR();
    { const LAS float* Lm = (const LAS float*)(lds + L_LM); LAS float* Tm = (LAS float*)(lds + L_TM);
      if (tid < 64) { const int I = tid >> 4, j = tid & 15; float x[16];
#pragma unroll
          for (int i = 0; i < 16; ++i) { float s = (i == j) ? 1.f : 0.f;
#pragma unroll
              for (int kb = 0; kb < (i + 3) / 4; ++kb) { const f32x4 l = *(const LAS f32x4*)(Lm + (16 * I + i) * 64 + 16 * I + 4 * kb);
#pragma unroll
                  for (int e = 0; e < 4; ++e) if (4 * kb + e < i) s -= l[e] * x[4 * kb + e]; }
              x[i] = (i < j) ? 0.f : s; Tm[(16 * I + i) * 64 + 16 * I + j] = x[i]; } }
      LBAR();
      { const int r = lane & 15, g = lane >> 4;
#pragma unroll 1
      for (int lv = 1; lv < 4; ++lv) {
          if (wave < 4 - lv) { const int I = lv + wave, J = wave; f32x4 acc = {0.f, 0.f, 0.f, 0.f};
              for (int K = J; K < I; ++K) { const f32x4 a = *(const LAS f32x4*)(Lm + (16 * I + r) * 64 + 16 * K + 4 * g); float bq[4];
#pragma unroll
                  for (int s = 0; s < 4; ++s) bq[s] = Tm[(16 * K + 4 * g + s) * 64 + 16 * J + r];
#pragma unroll
                  for (int s = 0; s < 4; ++s) acc = __builtin_amdgcn_mfma_f32_16x16x4f32(a[s], bq[s], acc, 0, 0, 0); }
#pragma unroll
              for (int i = 0; i < 4; ++i) Tm[(16 * J + 4 * g + i) * 64 + 16 * I + r] = acc[i]; }
          LBAR();
          if (wave < 4 - lv) { const int I = lv + wave, J = wave; f32x4 acc = {0.f, 0.f, 0.f, 0.f};
              const f32x4 a = *(const LAS f32x4*)(Tm + (16 * I + r) * 64 + 16 * I + 4 * g); float bq[4];
#pragma unroll
              for (int s = 0; s < 4; ++s) bq[s] = Tm[(16 * J + 4 * g + s) * 64 + 16 * I + r];
#pragma unroll
              for (int s = 0; s < 4; ++s) acc = __builtin_amdgcn_mfma_f32_16x16x4f32(a[s], bq[s], acc, 0, 0, 0);
#pragma unroll
              for (int i = 0; i < 4; ++i) Tm[(16 * I + 4 * g + i) * 64 + 16 * J + r] = -acc[i]; }
          LBAR();
      } }
      { const int i = tid >> 3, j0 = (tid & 7) * 8; const f32x4 t0 = *(const LAS f32x4*)(Tm + i * 64 + j0), t1 = *(const LAS f32x4*)(Tm + i * 64 + j0 + 4); const bool keep = (i >> 4) >= (j0 >> 4);
        v4u o; o.x = keep ? pk2(t0[0], t0[1]) : 0u; o.y = keep ? pk2(t0[2], t0[3]) : 0u; o.z = keep ? pk2(t1[0], t1[1]) : 0u; o.w = keep ? pk2(t1[2], t1[3]) : 0u;
        *(LAS v4u*)(lds + L_TB + i * TS + j0 * 2) = o; }
      LBAR();
    }
    { bf16x8 af[4][2];
#pragma unroll
      for (int mt = 0; mt < 4; ++mt)
#pragma unroll
          for (int ks = 0; ks < 2; ++ks) af[mt][ks] = ldsfrag(lds + L_TB, 16 * mt + r, TS, 64 * ks + 16 * g);
#pragma unroll
      for (int q = 0; q < 2; ++q) { const int ng = 2 * wave + q; LAS unsigned char* base = lds + (ng >= 8 ? L_WT : L_UT) + (16 * (ng & 7) + r) * TS;
          const bf16x8 b0 = *(const LAS bf16x8*)(base + 16 * g), b1 = *(const LAS bf16x8*)(base + 64 + 16 * g);
          f32x4 acc[4];
#pragma unroll
          for (int mt = 0; mt < 4; ++mt) { acc[mt] = mfma16(af[mt][0], b0, (f32x4){0.f, 0.f, 0.f, 0.f}); acc[mt] = mfma16(af[mt][1], b1, acc[mt]); }
          asm volatile("s_waitcnt lgkmcnt(0)" ::: "memory");
#pragma unroll
          for (int mt = 0; mt < 4; ++mt) *(LAS v2u*)(base + (16 * mt + 4 * g) * 2) = pack4(acc[mt]); }
    }
    LBAR();
    {
        const size_t u16 = (size_t)unit * 16384, u8 = (size_t)unit * 8192;
        { const int kk = wave >> 1;
          bf16x8 af[2][2];
#pragma unroll
          for (int t2 = 0; t2 < 2; ++t2)
#pragma unroll
              for (int ks = 0; ks < 2; ++ks) af[t2][ks] = ldsfrag(lds + L_WT, 16 * (2 * kk + t2) + r, TS, 64 * ks + 16 * g);
#pragma unroll
          for (int q = 0; q < 4; ++q) { const int nt = 4 * (wave & 1) + q; f32x4 a0 = {0.f, 0.f, 0.f, 0.f}, a1 = {0.f, 0.f, 0.f, 0.f};
#pragma unroll
              for (int ks = 0; ks < 2; ++ks) { const bf16x8 bfr = ldsfrag(lds + L_KTT, 16 * nt + r, TS, 64 * ks + 16 * g); a0 = mfma16(af[0][ks], bfr, a0); a1 = mfma16(af[1][ks], bfr, a1); }
              v2u o; o.x = __builtin_amdgcn_cvt_pk_fp8_f32(-16.f * a0[0], -16.f * a0[1], 0, false); o.x = __builtin_amdgcn_cvt_pk_fp8_f32(-16.f * a0[2], -16.f * a0[3], o.x, true);
              o.y = __builtin_amdgcn_cvt_pk_fp8_f32(-16.f * a1[0], -16.f * a1[1], 0, false); o.y = __builtin_amdgcn_cvt_pk_fp8_f32(-16.f * a1[2], -16.f * a1[3], o.y, true);
              *(GAS v2u*)((GAS unsigned char*)X.PG + (size_t)unit * 16384 + ((size_t)(nt * 4 + kk) * 64 + lane) * 8) = o; } }
        { const int mt = wave; bf16x8 af[2];
#pragma unroll
          for (int ks = 0; ks < 2; ++ks) af[ks] = ldsfrag(lds + L_KTT, 16 * mt + r, TS, 64 * ks + 16 * g);
#pragma unroll
          for (int nt = 0; nt < 8; ++nt) { f32x4 a0 = {0.f, 0.f, 0.f, 0.f};
#pragma unroll
              for (int ks = 0; ks < 2; ++ks) a0 = mfma16(af[ks], ldsfrag(lds + L_UT, 16 * nt + r, TS, 64 * ks + 16 * g), a0);
              *(GAS v2u*)(X.BG + u16 + ((size_t)(nt * 8 + mt) * 64 + lane) * 4) = pack4(a0); } }
        { const int kk = wave >> 1;
#pragma unroll
          for (int q = 0; q < 2; ++q) { const int ct = 2 * (wave & 1) + q; f32x4 a0 = {0.f, 0.f, 0.f, 0.f}, a1 = {0.f, 0.f, 0.f, 0.f};
#pragma unroll
              for (int ks = 0; ks < 2; ++ks) { const bf16x8 bfr = ldsfrag(lds + L_ATT, 16 * ct + r, TS, 64 * ks + 16 * g);
                  a0 = mfma16(ldsfrag(lds + L_WT, 16 * (2 * kk) + r, TS, 64 * ks + 16 * g), bfr, a0); a1 = mfma16(ldsfrag(lds + L_WT, 16 * (2 * kk + 1) + r, TS, 64 * ks + 16 * g), bfr, a1); }
              const int c = 16 * ct + r; const float eg = egs[c];
              const f32x4 q0 = unpack4(*(const LAS v2u*)(lds + L_QN + c * RS + (32 * kk + 4 * g) * 2)), q1 = unpack4(*(const LAS v2u*)(lds + L_QN + c * RS + (32 * kk + 16 + 4 * g) * 2));
              v4u o; o.x = pk2(q0[0] * eg - a0[0], q0[1] * eg - a0[1]); o.y = pk2(q0[2] * eg - a0[2], q0[3] * eg - a0[3]); o.z = pk2(q1[0] * eg - a1[0], q1[1] * eg - a1[1]); o.w = pk2(q1[2] * eg - a1[2], q1[3] * eg - a1[3]);
              *(GAS v4u*)(X.QP + u8 + ((size_t)(ct * 4 + kk) * 64 + lane) * 8) = o; } }
        { const int vt = wave; bf16x8 af[2];
#pragma unroll
          for (int ks = 0; ks < 2; ++ks) af[ks] = ldsfrag(lds + L_UT, 16 * vt + r, TS, 64 * ks + 16 * g);
#pragma unroll
          for (int ct = 0; ct < 4; ++ct) { f32x4 a0 = {0.f, 0.f, 0.f, 0.f};
#pragma unroll
              for (int ks = 0; ks < 2; ++ks) a0 = mfma16(af[ks], ldsfrag(lds + L_ATT, 16 * ct + r, TS, 64 * ks + 16 * g), a0);
              *(GAS v2u*)(X.OI + u8 + ((size_t)(vt * 4 + ct) * 64 + lane) * 4) = pack4(a0); } }
    }
    LBAR();
}

__device__ __forceinline__ void p3_hgrn_unit(LAS unsigned char* lds, const MixPtrs& X, int unit, int tid, int lane, int wave) {
    const int h = unit & 3, n = (unit >> 2) & 127, b = unit >> 9, r = lane & 15, g = lane >> 4;
    const size_t tok0 = (size_t)b * T + (size_t)n * 64;
#pragma unroll
    for (int i = 0; i < 4; ++i) { const int pair = (tid >> 4) + 32 * i, tz = pair >> 6, c = pair & 63, ch = tid & 15;
        const v4u q = *(const GAS v4u*)(X.projA + (tok0 + c) * PA + (tz ? 2560 : 1536) + h * 128 + ch * 8);
        *(LAS v4u*)(lds + (tz ? H_QR : H_FR) + c * RS + ch * 16) = q; }
    {
        v4u rv[2];
#pragma unroll
        for (int i = 0; i < 2; ++i) { const int item = tid + 512 * i, c = item >> 4, ch = item & 15; rv[i] = *(const GAS v4u*)(X.projA + (tok0 + c) * PA + 2048 + h * 128 + ch * 8); }
#pragma unroll
        for (int i = 0; i < 2; ++i) { const int item = tid + 512 * i, c = item >> 4, ch = item & 15; const unsigned w[4] = {rv[i].x, rv[i].y, rv[i].z, rv[i].w};
#pragma unroll
            for (int e = 0; e < 4; ++e) { *(LAS unsigned short*)(lds + H_VT + (ch * 8 + 2 * e) * TS + c * 2) = (unsigned short)(w[e] & 0xffffu); *(LAS unsigned short*)(lds + H_VT + (ch * 8 + 2 * e + 1) * TS + c * 2) = (unsigned short)(w[e] >> 16); } }
    }
    LBAR();
    {
        const int d = tid & 127, seg = tid >> 7; LAS float* segt = (LAS float*)(lds + H_AM + 9216);
        const float l0 = X.hg_lb[h * 128 + d], l1 = X.hg_lb[512 + h * 128 + d]; const float mx = fmaxf(l0, l1); const float e0 = __expf(l0 - mx), e1 = __expf(l1 - mx); const float lb = e0 * frcp_(e0 + e1);
        float lc[16], kq[16]; float run = 0.f;
#pragma unroll
        for (int ci = 0; ci < 16; ++ci) { const float sg = sigmoidf_(ldsbf(lds + H_FR, 16 * seg + ci, RS, d)); run += __logf(lb + (1.f - lb) * sg); lc[ci] = run; kq[ci] = (1.f - lb) * (1.f - sg); }
        segt[seg * 128 + d] = run;
        LBAR();
        const float t0 = segt[d], t1 = segt[128 + d], t2 = segt[256 + d], t3 = segt[384 + d];
        const float off = (seg > 0 ? t0 : 0.f) + (seg > 1 ? t1 : 0.f) + (seg > 2 ? t2 : 0.f), btot = (t0 + t1) + (t2 + t3);
        float kv[16];
#pragma unroll
        for (int ci = 0; ci < 16; ++ci) { const int c = 16 * seg + ci; const float bb = off + lc[ci];
            *(LAS unsigned short*)(lds + H_QE + c * RS + d * 2) = (unsigned short)f2bf(siluf_(ldsbf(lds + H_QR, c, RS, d)) * __expf(bb));
            *(LAS unsigned short*)(lds + H_KD + c * RS + d * 2) = (unsigned short)f2bf(kq[ci] * __expf(-bb));
            kv[ci] = kq[ci] * __expf(btot - bb); }
        if (seg == 0) X.AH[(size_t)unit * 128 + d] = __expf(btot);
#pragma unroll
        for (int q = 0; q < 2; ++q) { v4u o; o.x = pk2(kv[8 * q], kv[8 * q + 1]); o.y = pk2(kv[8 * q + 2], kv[8 * q + 3]); o.z = pk2(kv[8 * q + 4], kv[8 * q + 5]); o.w = pk2(kv[8 * q + 6], kv[8 * q + 7]);
            *(LAS v4u*)(lds + H_KTT + d * TS + (16 * seg + 8 * q) * 2) = o; }
    }
    LBAR();
    {
        const int mt = wave >> 1;
#pragma unroll
        for (int q = 0; q < 2; ++q) { const int ntc = 2 * (wave & 1) + q; f32x4 a0 = {0.f, 0.f, 0.f, 0.f};
#pragma unroll
            for (int ks = 0; ks < 4; ++ks) a0 = mfma16(ldsfrag(lds + H_QE, 16 * mt + r, RS, 64 * ks + 16 * g), ldsfrag(lds + H_KD, 16 * ntc + r, RS, 64 * ks + 16 * g), a0);
            const int j = 16 * ntc + r;
#pragma unroll
            for (int ii = 0; ii < 4; ++ii) { const int i = 16 * mt + 4 * g + ii; *(LAS unsigned short*)(lds + H_AM + i * TS + j * 2) = (unsigned short)f2bf((i >= j) ? a0[ii] : 0.f); } }
    }
    LBAR();
    {
        const size_t u16 = (size_t)unit * 16384, u8 = (size_t)unit * 8192;
        { const int mt = wave; bf16x8 af[2];
#pragma unroll
          for (int ks = 0; ks < 2; ++ks) af[ks] = ldsfrag(lds + H_KTT, 16 * mt + r, TS, 64 * ks + 16 * g);
#pragma unroll
          for (int nt = 0; nt < 8; ++nt) { f32x4 a0 = {0.f, 0.f, 0.f, 0.f};
#pragma unroll
              for (int ks = 0; ks < 2; ++ks) a0 = mfma16(af[ks], ldsfrag(lds + H_VT, 16 * nt + r, TS, 64 * ks + 16 * g), a0);
              *(GAS v2u*)(X.BH + u16 + ((size_t)(nt * 8 + mt) * 64 + lane) * 4) = pack4(a0); } }
        { const int vt = wave; bf16x8 af[2];
#pragma unroll
          for (int ks = 0; ks < 2; ++ks) af[ks] = ldsfrag(lds + H_VT, 16 * vt + r, TS, 64 * ks + 16 * g);
#pragma unroll
          for (int ct = 0; ct < 4; ++ct) { f32x4 a0 = {0.f, 0.f, 0.f, 0.f};
#pragma unroll
              for (int ks = 0; ks < 2; ++ks) a0 = mfma16(af[ks], ldsfrag(lds + H_AM, 16 * ct + r, TS, 64 * ks + 16 * g), a0);
              *(GAS v2u*)(X.OIH + u8 + ((size_t)(vt * 4 + ct) * 64 + lane) * 4) = pack4(a0); } }
#pragma unroll
        for (int q = 0; q < 2; ++q) { const int idx = wave * 2 + q, ct = idx >> 2, kk = idx & 3, c = 16 * ct + r;
            const v2u q0 = *(const LAS v2u*)(lds + H_QE + c * RS + (32 * kk + 4 * g) * 2), q1 = *(const LAS v2u*)(lds + H_QE + c * RS + (32 * kk + 16 + 4 * g) * 2);
            v4u o; o.x = q0.x; o.y = q0.y; o.z = q1.x; o.w = q1.y;
            *(GAS v4u*)(X.QE + u8 + ((size_t)(ct * 4 + kk) * 64 + lane) * 8) = o; }
    }
    LBAR();
}

__device__ __forceinline__ void p4_gdn_scan(LAS unsigned char* lds, const MixPtrs& X, int job, int lane, int wave) {
    const int s = job >> 3, h = job & 3, b = (job >> 2) & 1;
    const int unit0 = (b * 128) * 4 + h;
    constexpr int F8RING = 0, BRING = 131072, GLOFF = BRING + 6 * 4096;
    if (wave >= 4) {
        const int lw = wave - 4;
        const char* src0 = (const char*)X.PG + (size_t)unit0 * 16384 + lw * 4096 + lane * 16;
        const char* bsrc0 = (const char*)(X.BG + (size_t)unit0 * 16384 + (size_t)(s * 8) * 256) + lw * 1024 + lane * 16;
#define P4_ISSUE(n_) do { const char* s_ = src0 + (size_t)(n_) * (4 * 16384); _Pragma("unroll") for (int i_ = 0; i_ < 4; ++i_) \
        __builtin_amdgcn_global_load_lds((const unsigned*)(s_ + i_ * 1024), (LAS unsigned*)(lds + F8RING + ((n_) & 7) * 16384 + lw * 4096 + i_ * 1024), 16, 0, 2); \
        __builtin_amdgcn_global_load_lds((const unsigned*)(bsrc0 + (size_t)(n_) * (4 * 32768)), (LAS unsigned*)(lds + BRING + ((n_) % 6) * 4096 + lw * 1024), 16, 0, 0); } while (0)
        P4_ISSUE(0); P4_ISSUE(1); P4_ISSUE(2); P4_ISSUE(3); P4_ISSUE(4);
        asm volatile("s_waitcnt vmcnt(20)" ::: "memory");
#pragma unroll 1
        for (int n = 0; n < 128; ++n) {
            __builtin_amdgcn_s_barrier();
            asm volatile("" ::: "memory");
            if (n + 5 < 128) P4_ISSUE(n + 5);
            if (n + 1 < 128) {
                if (n + 5 < 128) asm volatile("s_waitcnt vmcnt(20)" ::: "memory"); else if (n + 4 < 128) asm volatile("s_waitcnt vmcnt(15)" ::: "memory"); else if (n + 3 < 128) asm volatile("s_waitcnt vmcnt(10)" ::: "memory");
                else if (n + 2 < 128) asm volatile("s_waitcnt vmcnt(5)" ::: "memory"); else asm volatile("s_waitcnt vmcnt(0)" ::: "memory");
            }
        }
#undef P4_ISSUE
    } else if (wave == 0) {
        f32x4 S[8]; v2u sb8[4];
#pragma unroll
        for (int mt = 0; mt < 8; ++mt) S[mt] = (f32x4){0.f, 0.f, 0.f, 0.f};
#pragma unroll
        for (int kk = 0; kk < 4; ++kk) { sb8[kk] = (v2u){0u, 0u}; v4u z; z.x = 0; z.y = 0; z.z = 0; z.w = 0; *(GAS v4u*)(X.SG + (size_t)unit0 * 16384 + ((size_t)(s * 4 + kk) * 64 + lane) * 8) = z; }
        { const float g0 = X.GL[unit0 + 4 * lane], g1 = X.GL[unit0 + 4 * (64 + lane)]; *(LAS float*)(lds + GLOFF + lane * 4) = g0; *(LAS float*)(lds + GLOFF + (64 + lane) * 4) = g1; }
        asm volatile("s_waitcnt vmcnt(0) lgkmcnt(0)" ::: "memory");
#pragma unroll 1
        for (int n = 0; n < 128; ++n) {
            const int unit = unit0 + 4 * n;
            __builtin_amdgcn_s_barrier();
            asm volatile("" ::: "memory");
            const float e = __expf(*(const LAS float*)(lds + GLOFF + n * 4));
            const LAS unsigned char* bb = lds + BRING + (n % 6) * 4096 + lane * 8;
            f32x4 acc[8];
#pragma unroll
            for (int mt = 0; mt < 8; ++mt) acc[mt] = (f32x4){0.f, 0.f, 0.f, 0.f};
            const LAS unsigned char* pb = lds + F8RING + (n & 7) * 16384 + lane * 8;
#pragma unroll
            for (int kk = 0; kk < 4; ++kk)
#pragma unroll
                for (int mt = 0; mt < 8; ++mt) acc[mt] = __builtin_amdgcn_mfma_f32_16x16x32_fp8_fp8(__builtin_bit_cast(long, *(const LAS v2u*)(pb + (mt * 4 + kk) * 512)), __builtin_bit_cast(long, sb8[kk]), acc[mt], 0, 0, 0);
#pragma unroll
            for (int mt = 0; mt < 8; ++mt) S[mt] = S[mt] * e + unpack4(*(const LAS v2u*)(bb + mt * 512)) + acc[mt] * 0.00390625f;
#pragma unroll
            for (int kk = 0; kk < 4; ++kk) { const f32x4 a = S[2 * kk], c = S[2 * kk + 1];
                unsigned w0 = __builtin_amdgcn_cvt_pk_fp8_f32(c8(a[0] * 16.f), c8(a[1] * 16.f), 0, false); w0 = __builtin_amdgcn_cvt_pk_fp8_f32(c8(a[2] * 16.f), c8(a[3] * 16.f), w0, true);
                unsigned w1 = __builtin_amdgcn_cvt_pk_fp8_f32(c8(c[0] * 16.f), c8(c[1] * 16.f), 0, false); w1 = __builtin_amdgcn_cvt_pk_fp8_f32(c8(c[2] * 16.f), c8(c[3] * 16.f), w1, true);
                sb8[kk] = (v2u){w0, w1};
                if (n < 127) { v4u o; o.x = pg8::cvt_pk_bf16(a[0], a[1]); o.y = pg8::cvt_pk_bf16(a[2], a[3]); o.z = pg8::cvt_pk_bf16(c[0], c[1]); o.w = pg8::cvt_pk_bf16(c[2], c[3]);
                    *(GAS v4u*)(X.SG + (size_t)(unit + 4) * 16384 + ((size_t)(s * 4 + kk) * 64 + lane) * 8) = o; } }
            asm volatile("s_waitcnt lgkmcnt(0)" ::: "memory");
        }
    } else {
#pragma unroll 1
        for (int n = 0; n < 128; ++n) { __builtin_amdgcn_s_barrier(); asm volatile("" ::: "memory"); }
    }
}
__device__ __forceinline__ void p4_hgrn_scan(const MixPtrs& X, int task, int lane) {
    const int mt = task & 7, s = (task >> 3) & 7, h = (task >> 6) & 3, b = task >> 8, g = lane >> 4;
    const int unit0 = (b * 128) * 4 + h;
    f32x4 s0 = {0.f, 0.f, 0.f, 0.f};
    const GAS f32x4* ap = (const GAS f32x4*)(X.AH + (size_t)unit0 * 128 + 16 * mt + 4 * g);
    const GAS v2u* bp = (const GAS v2u*)(X.BH + (size_t)unit0 * 16384 + ((size_t)(s * 8 + mt) * 64 + lane) * 4);
    GAS v2u* sp = (GAS v2u*)(X.SH + (size_t)unit0 * 16384 + ((size_t)(s * 4 + (mt >> 1)) * 64 + lane) * 8 + 4 * (mt & 1));
    { v2u z; z.x = 0; z.y = 0; sp[0] = z; }
    f32x4 ra[32]; v2u rb[32];
#pragma unroll
    for (int j = 0; j < 32; ++j) { ra[j] = ap[(size_t)j * 128]; rb[j] = bp[(size_t)j * 16384]; }
#pragma unroll 1
    for (int n0 = 0; n0 < 128; n0 += 32) {
#pragma unroll
        for (int j = 0; j < 32; ++j) { const int n = n0 + j;
            s0 = ra[j] * s0 + unpack4(rb[j]);
            if (n + 32 < 128) { ra[j] = ap[(size_t)(n + 32) * 128]; rb[j] = bp[(size_t)(n + 32) * 16384]; }
            if (n < 127) sp[(size_t)(n + 1) * 16384] = pack4(s0); }
    }
}
__device__ __forceinline__ void p5_unit(LAS unsigned char* lds, const MixPtrs& X, int bn, int lane, int wave) {
    const int hd = wave & 3, type = wave >> 2, r = lane & 15, g = lane >> 4;
    const int unit = bn * 4 + hd; const size_t tok0 = (size_t)bn * 64;
    const bf16* SX = type ? X.SH : X.SG; const bf16* QX = type ? X.QE : X.QP; const bf16* OX = type ? X.OIH : X.OI;
    const size_t u16 = (size_t)unit * 16384, u8 = (size_t)unit * 8192;
    LAS float* exch = (LAS float*)lds;
    const float* nw = type ? X.hg_nw + hd * 128 : X.gdn_nw;
    bf16x8 af[4][8];
#pragma unroll
    for (int kk = 0; kk < 4; ++kk)
#pragma unroll
        for (int vt = 0; vt < 8; ++vt) af[kk][vt] = *(const GAS bf16x8*)(SX + u16 + ((size_t)(vt * 4 + kk) * 64 + lane) * 8);
#pragma unroll 1
    for (int ct = 0; ct < 4; ++ct) {
        bf16x8 bfr[4]; v2u oq[8], gtq[8];
#pragma unroll
        for (int kk = 0; kk < 4; ++kk) bfr[kk] = *(const GAS bf16x8*)(QX + u8 + ((size_t)(ct * 4 + kk) * 64 + lane) * 8);
#pragma unroll
        for (int vt = 0; vt < 8; ++vt) { oq[vt] = *(const GAS v2u*)(OX + u8 + ((size_t)(vt * 4 + ct) * 64 + lane) * 4);
            gtq[vt] = *(const GAS v2u*)(X.gates + (tok0 + 16 * ct + r) * 1024 + type * 512 + hd * 128 + 16 * vt + 4 * g); }
        f32x4 acc[8];
#pragma unroll
        for (int vt = 0; vt < 8; ++vt) acc[vt] = unpack4(oq[vt]);
#pragma unroll
        for (int kk = 0; kk < 4; ++kk)
#pragma unroll
            for (int vt = 0; vt < 8; ++vt) acc[vt] = mfma16(af[kk][vt], bfr[kk], acc[vt]);
        float ssq = 0.f;
#pragma unroll
        for (int vt = 0; vt < 8; ++vt) ssq += (acc[vt][0] * acc[vt][0] + acc[vt][1] * acc[vt][1]) + (acc[vt][2] * acc[vt][2] + acc[vt][3] * acc[vt][3]);
        ssq += __shfl_xor(ssq, 16); ssq += __shfl_xor(ssq, 32);
        if (type == 1 && g == 0) exch[(ct & 1) * 64 + hd * 16 + r] = ssq;
        LBAR();
        float rstd;
        if (type == 1) { const LAS float* ex = exch + (ct & 1) * 64 + r; rstd = rsqrtf(((ex[0] + ex[16]) + (ex[32] + ex[48])) * (1.f / 512.f) + 1e-6f); } else rstd = rsqrtf(ssq * (1.f / 128.f) + 1e-6f);
#pragma unroll
        for (int vt = 0; vt < 8; ++vt) { const f32x4 w4 = *(const GAS f32x4*)(nw + 16 * vt + 4 * g); const size_t off = (tok0 + 16 * ct + r) * 1024 + type * 512 + hd * 128 + 16 * vt + 4 * g;
            const f32x4 gt = unpack4(gtq[vt]); f32x4 o;
#pragma unroll
            for (int e = 0; e < 4; ++e) o[e] = acc[vt][e] * rstd * w4[e] * siluf_(gt[e]);
            *(GAS v2u*)(X.omix + off) = pack4(o); }
    }
    LBAR();
}

struct Args { const float* in[23]; float* out; unsigned char* ws; int ph_lo, ph_hi, li, pad; };

__global__ void __launch_bounds__(NWAVES * 64, 2) mk_fwd(Args args) {
    extern __shared__ __attribute__((aligned(16))) unsigned char lds_raw[];
    LAS unsigned char* lds = (LAS unsigned char*)lds_raw;
    volatile LAS unsigned* MISC = (volatile LAS unsigned*)(lds + MISC_OFF);
    const int tid = threadIdx.x, lane = tid & 63, wave = __builtin_amdgcn_readfirstlane(tid >> 6);
    const int G = gridDim.x, bx = blockIdx.x, vcu = (G % 8 == 0) ? (bx % 8) * (G / 8) + bx / 8 : bx;
    const int gw = vcu * NWAVES + wave, NGW = G * NWAVES;
    unsigned char* ws = args.ws;
    gu32* ctl = (gu32*)(ws + WS_CTL);
    const float* x = args.in[0]; const float* cvec = args.in[1]; const float* w_ada = args.in[2]; const float* b_ada = args.in[3]; const float* norm1_w = args.in[4];
    const float* w_in = args.in[5]; const float* w_out = args.in[12];
    float* mod = (float*)(ws + WS_MOD); float* wab = (float*)(ws + WS_WAB); float* ab = (float*)(ws + WS_AB);
    bf16* wout_t = (bf16*)(ws + WS_WOUT_T); bf16* win_t = (bf16*)(ws + WS_WIN_T); bf16* h1 = (bf16*)(ws + WS_H1); bf16* projA = (bf16*)(ws + WS_PROJA); bf16* gates = (bf16*)(ws + WS_GATES);
    bf16* omix = (bf16*)(ws + WS_OMIX);
    bf16* h2 = (bf16*)(ws + WS_H2); bf16* w1t = (bf16*)(ws + WS_W1T); bf16* w2t = (bf16*)(ws + WS_W2T); bf16* act = (bf16*)(ws + WS_ACT); bf16* y0 = (bf16*)(ws + WS_Y0); bf16* y1 = (bf16*)(ws + WS_Y1);
    MixPtrs X; X.projA = projA; X.gates = gates; X.ab = ab; X.conv_w = args.in[6]; X.a_log = args.in[7]; X.dt_bias = args.in[8]; X.hg_lb = args.in[10]; X.gdn_nw = args.in[9]; X.hg_nw = args.in[11];
    X.PG = (bf16*)(ws + WS_PG); X.BG = (bf16*)(ws + WS_BG); X.QP = (bf16*)(ws + WS_QP); X.OI = (bf16*)(ws + WS_OI); X.BH = (bf16*)(ws + WS_BH); X.QE = (bf16*)(ws + WS_QE); X.OIH = (bf16*)(ws + WS_OIH);
    X.SG = (bf16*)args.out; X.SH = (bf16*)args.out + (size_t)UNITS * 16384; X.omix = omix; X.GL = (float*)(ws + WS_GL); X.AH = (float*)(ws + WS_AH);
    const int* list = (const int*)(ws + WS_LIST); const float* listw = (const float*)(ws + WS_LISTW);
    LAS unsigned* tb = (LAS unsigned*)(lds + SCR2_OFF);

    for (int u = tid; u < (LDS_BYTES - LDSCTL_OFF) / 4; u += NWAVES * 64) ((LAS unsigned*)(lds + LDSCTL_OFF))[u] = 0u;
    __syncthreads();
    XcdBarrier bar = xcd_barrier_post((unsigned*)(ctl + CW_BAR) + args.li * XCD_BAR_WORDS, MISC + 8);
    const int lo = args.ph_lo, hi = args.ph_hi;
#define IN(k) (lo <= (k) && (k) < hi)
#define BOTH(k) (IN(k) && IN((k) + 1))

    if (IN(0)) {
#define PH_BODY do { \
        if (bx < 96) { \
            LAS float* part = (LAS float*)(lds + RING_BYTES); \
            const int e = bx * 64 + lane; float a0 = 0.f, a1 = 0.f; \
_Pragma("unroll 32") \
            for (int d = wave * 128; d < wave * 128 + 128; ++d) { const float w = w_ada[(size_t)d * 6144 + e]; a0 += siluf_(cvec[d]) * w; a1 += siluf_(cvec[D + d]) * w; } \
            part[(wave * 2 + 0) * 64 + lane] = a0; part[(wave * 2 + 1) * 64 + lane] = a1; \
            __syncthreads(); \
            if (tid < 128) { const int bb = tid >> 6, l = tid & 63; float s = 0.f; \
_Pragma("unroll") \
                for (int w = 0; w < 8; ++w) s += part[(w * 2 + bb) * 64 + l]; \
                mod[bb * 6144 + bx * 64 + l] = s + b_ada[bx * 64 + l]; } \
        } else if (bx == 96) { \
            for (int idx = tid; idx < 8192; idx += NWAVES * 64) wab[idx] = w_in[(size_t)(idx >> 3) * DIN + 2048 + (idx & 7)]; \
        } \
        { const float* w_router = args.in[14]; bf16* wrhi = (bf16*)(ws + WS_WRHI); bf16* wrlo = (bf16*)(ws + WS_WRLO); \
          for (int k = gw; k < 1024; k += NGW) { const float w = w_router[k * 64 + lane]; const unsigned hi = f2bf(w); \
              wrhi[lane * 1024 + k] = (bf16)hi; wrlo[lane * 1024 + k] = (bf16)f2bf(w - __uint_as_float(hi << 16)); } } \
        LAS float* scr = (LAS float*)(lds + wave * 16384); \
        constexpr int I_IN = 16 * 128, I_OUT = 16 * 32; \
        auto mk0 = [&](int it) { TrItem t; if (it < I_IN) { const int kb = it / 128, n0 = 32 * (it % 128); const int sc_ = n0 < 1536 ? n0 : (n0 < 3072 ? n0 + 520 : (n0 < 3584 ? n0 - 1536 : n0 + 8)); \
                t.W = w_in; t.ldw = DIN; t.src_col = sc_; t.WT = win_t; t.K = D; t.dst_row = n0; t.k0 = 64 * kb; t.f8scale = 0.f; } \
            else { const int r = it - I_IN, kb = r / 32, n0 = 32 * (r % 32); t.W = w_out; t.ldw = D; t.src_col = n0; t.WT = wout_t; t.K = D; t.dst_row = n0; t.k0 = 64 * kb; t.f8scale = 0.f; } return t; }; \
        TR_LOOP(gw, NGW, I_IN + I_OUT, mk0); \
        if (BOTH(0)) xcd_barrier(bar); \
    } while (0)
        PH_BODY; if (REPN(0) > 1) { PH_BODY; PH_BODY; }
#undef PH_BODY
    }
    if (IN(1)) {
#define PH_BODY do { \
        { \
            const GAS f32x4* wab4 = (const GAS f32x4*)wab; \
            for (int idx = tid; idx < 2048; idx += NWAVES * 64) { const int d = idx >> 1, qh = idx & 1; *(LAS f32x4*)(lds + (((qh * 4 + (d & 3)) * 256 + (d >> 2)) * 16)) = wab4[idx]; } \
            __syncthreads(); \
            const int nrows = (M - gw + NGW - 1) / NGW; \
            f32x4 sclr[4], shfr[4]; int curb = -1; \
            f32x4 vn[2][4]; \
_Pragma("unroll") \
            for (int q = 0; q < 2; ++q) { const int m = gw + q * NGW; \
_Pragma("unroll") \
                for (int j = 0; j < 4; ++j) vn[q][j] = (q < nrows) ? ((const GAS f32x4*)(x + (size_t)m * D) + lane)[64 * j] : (f32x4){0.f, 0.f, 0.f, 0.f}; } \
_Pragma("unroll 1") \
            for (int p = 0; p < nrows; p += 2) { \
                f32x4 v[2][4]; \
_Pragma("unroll") \
                for (int q = 0; q < 2; ++q) \
_Pragma("unroll") \
                    for (int j = 0; j < 4; ++j) v[q][j] = vn[q][j]; \
_Pragma("unroll") \
                for (int q = 0; q < 2; ++q) { const int m = gw + (p + 2 + q) * NGW; \
                    if (p + 2 + q < nrows) { \
_Pragma("unroll") \
                        for (int j = 0; j < 4; ++j) vn[q][j] = ((const GAS f32x4*)(x + (size_t)m * D) + lane)[64 * j]; } } \
_Pragma("unroll") \
                for (int q = 0; q < 2; ++q) { const int m = gw + (p + q) * NGW; \
                    if (p + q < nrows) { \
                        float ss = 0.f; \
_Pragma("unroll") \
                        for (int j = 0; j < 4; ++j) ss += (v[q][j].x * v[q][j].x + v[q][j].y * v[q][j].y) + (v[q][j].z * v[q][j].z + v[q][j].w * v[q][j].w); \
                        const float rstd = rsqrtf(wave_sum(ss) * (1.f / D) + 1e-6f); \
                        const int bsel = m >= T ? 1 : 0; \
                        if (bsel != curb) { curb = bsel; const GAS f32x4* sh4 = (const GAS f32x4*)(mod + bsel * 6144) + lane; \
_Pragma("unroll") \
                            for (int j = 0; j < 4; ++j) { sclr[j] = ((const GAS f32x4*)norm1_w + lane)[64 * j] * (sh4[256 + 64 * j] + 1.0f); shfr[j] = sh4[64 * j]; } } \
                        GAS unsigned long long* o8 = (GAS unsigned long long*)(h1 + (size_t)m * D) + lane; \
                        f32x4 a0 = {0.f, 0.f, 0.f, 0.f}, a1 = {0.f, 0.f, 0.f, 0.f}; \
_Pragma("unroll") \
                        for (int j = 0; j < 4; ++j) { __builtin_amdgcn_sched_barrier(0); const f32x4 h = v[q][j] * rstd * sclr[j] + shfr[j]; \
                            o8[64 * j] = (unsigned long long)pk2(h.x, h.y) | ((unsigned long long)pk2(h.z, h.w) << 32); \
_Pragma("unroll") \
                            for (int i = 0; i < 4; ++i) { a0 += *(const LAS f32x4*)(lds + ((i * 256 + lane + 64 * j) * 16)) * h[i]; a1 += *(const LAS f32x4*)(lds + (((4 + i) * 256 + lane + 64 * j) * 16)) * h[i]; } } \
 \
                        const bool up5 = (lane & 32) != 0, up4 = (lane & 16) != 0, up3 = (lane & 8) != 0; \
                        f32x4 k4; \
_Pragma("unroll") \
                        for (int e = 0; e < 4; ++e) { const float snd = up5 ? a0[e] : a1[e]; k4[e] = (up5 ? a1[e] : a0[e]) + __shfl_xor(snd, 32); } \
                        float k2[2]; \
_Pragma("unroll") \
                        for (int e = 0; e < 2; ++e) { const float snd = up4 ? k4[e] : k4[2 + e]; k2[e] = (up4 ? k4[2 + e] : k4[e]) + __shfl_xor(snd, 16); } \
                        float k1; { const float snd = up3 ? k2[0] : k2[1]; k1 = (up3 ? k2[1] : k2[0]) + __shfl_xor(snd, 8); } \
                        k1 += __shfl_xor(k1, 4); k1 += __shfl_xor(k1, 2); k1 += __shfl_xor(k1, 1); \
                        if ((lane & 7) == 0) ab[(size_t)m * 8 + 4 * (lane >> 5) + 2 * ((lane >> 4) & 1) + ((lane >> 3) & 1)] = k1; \
                    } } \
            } \
            __syncthreads(); \
        } \
        if (BOTH(1)) xcd_barrier(bar); \
    } while (0)
        PH_BODY; if (REPN(1) > 1) { PH_BODY; PH_BODY; }
#undef PH_BODY
    }
    if (IN(2)) {
#define PH_BODY do { \
        pg8::Gemm g{h1, win_t, M, 4096, D}; pg8::StaticOrder S; S.init(M, 4096, G, (int)blockIdx.x); \
        pg8::EpiProj E{projA, gates}; \
        pg8::gemm_phase<pg8::EpiProj, pg8::StaticOrder, true, true>(lds, g, S, E); \
        if (BOTH(2)) xcd_barrier(bar); \
    } while (0)
        PH_BODY; if (REPN(2) > 1) { PH_BODY; PH_BODY; }
#undef PH_BODY
    }

    if (IN(3)) {
#define PH_BODY do { \
        for (int u = vcu; u < UNITS; u += G) p3_gdn_unit(lds, X, u, tid, lane, wave); \
        for (int u = vcu; u < UNITS; u += G) p3_hgrn_unit(lds, X, u, tid, lane, wave); \
        if (BOTH(3)) xcd_barrier(bar); \
    } while (0)
        PH_BODY; if (REPN(3) > 1) { PH_BODY; PH_BODY; }
#undef PH_BODY
    }
    if (IN(4)) {
#define PH_BODY do { \
        if (bx < 64) p4_gdn_scan(lds, X, bx, lane, wave); \
        else { \
            if (wave < 3 && (bx - 64) * 3 + wave < 512) p4_hgrn_scan(X, (bx - 64) * 3 + wave, lane); \
            LAS float* scr = (LAS float*)(lds + wave * 16384); \
            const float* w_gate = args.in[16]; const float* w_up = args.in[17]; const float* w_down = args.in[18]; const float* ws_gate = args.in[19]; const float* ws_up = args.in[20]; const float* ws_down = args.in[21]; \
            auto mk4 = [&](int it) { TrItem t; const int e = it / 384, r = it % 384; \
                if (r < 256) { const int up = r >> 7, q = r & 127, kb = q >> 3, n0 = 32 * (q & 7); \
                    t.W = e < NE ? (up ? w_up : w_gate) + (size_t)e * D * DE : (up ? ws_up : ws_gate); t.ldw = DE; t.src_col = n0; t.WT = (bf16*)((unsigned char*)w1t + (size_t)e * 512 * 1024); t.K = D; t.dst_row = (n0 >> 7) * 256 + up * 128 + (n0 & 127); t.k0 = 64 * kb; t.f8scale = 32.f; } \
                else { const int q = r - 256, kb = q >> 5, n0 = 32 * (q & 31); \
                    t.W = e < NE ? w_down + (size_t)e * DE * D : ws_down; t.ldw = D; t.src_col = n0; t.WT = (bf16*)((unsigned char*)w2t + (size_t)e * 1024 * 256); t.K = DE; t.dst_row = n0; t.k0 = 64 * kb; t.f8scale = 16.f; } return t; }; \
            TR_LOOP((bx - 64) * NWAVES + wave, (G - 64) * NWAVES, NEX * 384, mk4); \
        } \
        if (BOTH(4)) xcd_barrier(bar); \
    } while (0)
        PH_BODY; if (REPN(4) > 1) { PH_BODY; PH_BODY; }
#undef PH_BODY
    }
    if (IN(5)) {
#define PH_BODY do { \
        for (int bn = vcu; bn < BATCH * 128; bn += G) p5_unit(lds, X, bn, lane, wave); \
        if (BOTH(5)) xcd_barrier(bar); \
    } while (0)
        PH_BODY; if (REPN(5) > 1) { PH_BODY; PH_BODY; }
#undef PH_BODY
    }
    if (IN(6)) {
#define PH_BODY do { \
        pg8::Gemm g{omix, wout_t, M, D, D}; pg8::StaticOrder S; S.init(M, D, G, (int)blockIdx.x); \
        pg8::EpiResid E{x, mod, args.out}; \
        pg8::gemm_phase<pg8::EpiResid, pg8::StaticOrder, true, true>(lds, g, S, E); \
        if (BOTH(6)) xcd_barrier(bar); \
    } while (0)
        PH_BODY; if (REPN(6) > 1) { PH_BODY; PH_BODY; }
#undef PH_BODY
    }


    if (IN(7)) {
        constexpr int HS = 2064;
        constexpr int R_HI = 0, R_LO = 66048, R_PART = 0  , R_SC = 132096, R_SEL = 140288, R_CNT = 148480, R_BASE = 148736, R_ESE = 148992, R_ESL = 151040, R_EW = 153088, R_ELP = 155136;
        if (tid < 64) *(LAS unsigned*)(lds + R_CNT + tid * 4) = 0u;
        __syncthreads();
        int nu = 0;
        const float* norm2_w = args.in[13]; const float* rbias = args.in[15]; const bf16* wrhi = (const bf16*)(ws + WS_WRHI); const bf16* wrlo = (const bf16*)(ws + WS_WRLO);
        int* listo = (int*)(ws + WS_LIST); float* listwo = (float*)(ws + WS_LISTW);
        const int r = lane & 15, g = lane >> 4;
#pragma unroll 1
        for (int u = vcu; u < M / 32; u += G, ++nu) {
            const GAS f32x4* sh4 = (const GAS f32x4*)(mod + (32 * u >= T ? 6144 : 0) + 3072) + lane; const GAS f32x4* nw4 = (const GAS f32x4*)norm2_w + lane;
#pragma unroll 1
            for (int qp = 0; qp < 4; qp += 2) {
                f32x4 xrow[2][4];
#pragma unroll
                for (int q = 0; q < 2; ++q) { const GAS f32x4* xr = (const GAS f32x4*)(args.out + (size_t)(32 * u + 4 * wave + qp + q) * D) + lane;
#pragma unroll
                    for (int j = 0; j < 4; ++j) xrow[q][j] = xr[64 * j]; }
#pragma unroll
                for (int q = 0; q < 2; ++q) { const int rl = 4 * wave + qp + q, m = 32 * u + rl;
                    f32x4 v[4]; float ss = 0.f;
#pragma unroll
                    for (int j = 0; j < 4; ++j) { v[j] = xrow[q][j]; ss += (v[j].x * v[j].x + v[j].y * v[j].y) + (v[j].z * v[j].z + v[j].w * v[j].w); }
                    const float rstd = rsqrtf(wave_sum(ss) * (1.f / D) + 1e-6f);
                    GAS unsigned* o4 = (GAS unsigned*)((unsigned char*)h2 + (size_t)m * D) + lane;
#pragma unroll
                    for (int j = 0; j < 4; ++j) { const f32x4 hv = v[j] * rstd * (nw4[64 * j] * (sh4[256 + 64 * j] + 1.0f)) + sh4[64 * j];
                        const unsigned h0 = f2bf(hv.x), h1_ = f2bf(hv.y), h2_ = f2bf(hv.z), h3 = f2bf(hv.w);
                        const unsigned long long hi = (unsigned long long)(h0 | (h1_ << 16)) | ((unsigned long long)(h2_ | (h3 << 16)) << 32);
                        { unsigned q8 = __builtin_amdgcn_cvt_pk_fp8_f32(hv.x, hv.y, 0, false); q8 = __builtin_amdgcn_cvt_pk_fp8_f32(hv.z, hv.w, q8, true); o4[64 * j] = q8; }
                        const unsigned long long lo = (unsigned long long)pk2(hv.x - __uint_as_float(h0 << 16), hv.y - __uint_as_float(h1_ << 16)) | ((unsigned long long)pk2(hv.z - __uint_as_float(h2_ << 16), hv.w - __uint_as_float(h3 << 16)) << 32);
                        *(LAS unsigned long long*)(lds + R_HI + rl * HS + (lane + 64 * j) * 8) = hi; *(LAS unsigned long long*)(lds + R_LO + rl * HS + (lane + 64 * j) * 8) = lo; } }
            }
            __syncthreads();
            f32x4 acc[2][4];
#pragma unroll
            for (int mt = 0; mt < 2; ++mt)
#pragma unroll
                for (int nt = 0; nt < 4; ++nt) acc[mt][nt] = (f32x4){0.f, 0.f, 0.f, 0.f};
#pragma unroll 2
            for (int ks = 0; ks < 4; ++ks) { const int kb = (128 * wave + 32 * ks + 8 * g) * 2;
                bf16x8 ahi[2], alo[2];
#pragma unroll
                for (int mt = 0; mt < 2; ++mt) { ahi[mt] = *(const LAS bf16x8*)(lds + R_HI + (16 * mt + r) * HS + kb); alo[mt] = *(const LAS bf16x8*)(lds + R_LO + (16 * mt + r) * HS + kb); }
#pragma unroll
                for (int nt = 0; nt < 4; ++nt) { const size_t o = (size_t)(16 * nt + r) * 1024 + 128 * wave + 32 * ks + 8 * g; const bf16x8 bh = *(const GAS bf16x8*)(wrhi + o), bl = *(const GAS bf16x8*)(wrlo + o);
#pragma unroll
                    for (int mt = 0; mt < 2; ++mt) { acc[mt][nt] = mfma16(ahi[mt], bh, acc[mt][nt]); acc[mt][nt] = mfma16(ahi[mt], bl, acc[mt][nt]); acc[mt][nt] = mfma16(alo[mt], bh, acc[mt][nt]); } } }
            __syncthreads();
#pragma unroll
            for (int mt = 0; mt < 2; ++mt)
#pragma unroll
                for (int nt = 0; nt < 4; ++nt)
#pragma unroll
                    for (int ii = 0; ii < 4; ++ii) *(LAS float*)(lds + R_PART + ((wave * 32 + 16 * mt + 4 * g + ii) * 64 + 16 * nt + r) * 4) = acc[mt][nt][ii];
            __syncthreads();
#pragma unroll
            for (int q = 0; q < 4; ++q) { const int idx = tid + 512 * q; float s = 0.f;
#pragma unroll
                for (int w = 0; w < 8; ++w) s += *(const LAS float*)(lds + R_PART + (w * 2048 + idx) * 4);
                const float sc = sigmoidf_(s); *(LAS float*)(lds + R_SC + idx * 4) = sc; *(LAS float*)(lds + R_SEL + idx * 4) = sc + rbias[idx & 63]; }
            __syncthreads();
#pragma unroll 2
            for (int q = 0; q < 4; ++q) { const int rl = 4 * wave + q, m = 32 * u + rl;
                const float sel = *(const LAS float*)(lds + R_SEL + (rl * 64 + lane) * 4), score = *(const LAS float*)(lds + R_SC + (rl * 64 + lane) * 4);
                float ga = sel, gb = -INFINITY;
                { const float a2 = dppf<0xB1>(ga), lo_ = fminf(ga, a2); ga = fmaxf(ga, a2); gb = lo_; }
                { const float a2 = dppf<0x4E>(ga), b2 = dppf<0x4E>(gb), lo_ = fminf(ga, a2); ga = fmaxf(ga, a2); gb = fmaxf(lo_, fmaxf(gb, b2)); }
                { const float a2 = dppf<0x141>(ga), b2 = dppf<0x141>(gb), lo_ = fminf(ga, a2); ga = fmaxf(ga, a2); gb = fmaxf(lo_, fmaxf(gb, b2)); }
                const float gs = ga + gb; const int mygrp = lane >> 3; int grank = 0;
#pragma unroll
                for (int gg = 0; gg < 8; ++gg) { const float o = rdlane(gs, 8 * gg); grank += (o > gs || (o == gs && gg < mygrp)) ? 1 : 0; }
                float msel = grank < 4 ? sel : -INFINITY; int erank = -1;
#pragma unroll
                for (int it = 0; it < 8; ++it) { const float mx = wave_max(msel);
                    const unsigned long long eq = __ballot(msel == mx); const int first = __builtin_amdgcn_readfirstlane(__ffsll((long long)eq) - 1);
                    const bool me = lane == first; msel = me ? -INFINITY : msel; erank = me ? it : erank; }
                const bool chosen = erank >= 0;
                const float wsum = wave_sum_dpp(chosen ? score : 0.f);
                if (chosen && nu < 2) { const int se = lane; const unsigned lp = __hip_atomic_fetch_add((LAS unsigned*)(lds + R_CNT + se * 4), 1u, __ATOMIC_RELAXED, __HIP_MEMORY_SCOPE_WORKGROUP);
                    const int ei = ((nu * 32 + rl) * 8 + erank) * 4;
                    *(LAS int*)(lds + R_ESE + ei) = se; *(LAS int*)(lds + R_ESL + ei) = m * 8 + erank; *(LAS float*)(lds + R_EW + ei) = score * frcp_(wsum) * 2.5f; *(LAS unsigned*)(lds + R_ELP + ei) = lp; } }
            __syncthreads();
            if (nu == 1 || u + G >= M / 32) {
                if (tid < 64) { const unsigned c = *(LAS unsigned*)(lds + R_CNT + tid * 4); *(LAS unsigned*)(lds + R_BASE + tid * 4) = c ? __hip_atomic_fetch_add(ctl + CW_CNT + 64 * tid, c, RLX_AGENT) : 0u; }
                __syncthreads();
                for (int idx = tid; idx < (nu + 1) * 256; idx += NWAVES * 64) { const int se = *(LAS int*)(lds + R_ESE + idx * 4); const unsigned pos = *(LAS unsigned*)(lds + R_BASE + se * 4) + *(LAS unsigned*)(lds + R_ELP + idx * 4);
                    if (pos < (unsigned)CAP) { listo[(size_t)se * CAP + pos] = *(LAS int*)(lds + R_ESL + idx * 4); listwo[(size_t)se * CAP + pos] = *(LAS float*)(lds + R_EW + idx * 4); } }
                __syncthreads();
                if (tid < 64) *(LAS unsigned*)(lds + R_CNT + tid * 4) = 0u;
                __syncthreads();
                nu = -1;
            }
        }
        if (BOTH(7)) xcd_barrier(bar);
    }
    if (lo <= 10 && hi > 8) {
        if (wave == 0) { unsigned c = __hip_atomic_load(ctl + CW_CNT + 64 * lane, RLX_AGENT); c = c < (unsigned)CAP ? c : (unsigned)CAP;
            unsigned inc = c;
#pragma unroll
            for (int o = 1; o < 64; o <<= 1) { const unsigned t = __shfl_up(inc, o); if (lane >= o) inc += t; }
            tb[TB_CNT + lane] = c; tb[TB_OFF + lane] = inc - c;
            if (lane == 63) { tb[TB_CNT + 64] = (unsigned)M; tb[TB_OFF + 64] = inc; } }
        __syncthreads();
    }
#define MOE_PREFIX(lo_, hi_, NT_, perm_) do { __syncthreads(); if (wave == 0) { const unsigned un_ = ((tb[TB_CNT + lane] + 255u) >> 8) * (NT_); unsigned inc_ = un_; \
        _Pragma("unroll") for (int o_ = 1; o_ < 64; o_ <<= 1) { const unsigned t_ = __shfl_up(inc_, o_); if (lane >= o_) inc_ += t_; } \
        tb[TB_PRE + lane] = inc_ - un_; if (lane == 63) { tb[TB_PRE + 64] = inc_; tb[TB_PRE + 65] = inc_ + ((tb[TB_CNT + 64] + 255u) >> 8) * (NT_); } } __syncthreads(); } while (0)
    if (IN(8)) {
#define PH_BODY do { \
        MOE_PREFIX(0, 65, 2, 0); \
        pg8::Moe1Prob P{D, 1024, pg8::MoeSched{tb, 0, 65, 2, G, vcu, 0}, (const unsigned char*)h2, (const unsigned char*)w1t, list}; \
        pg8::EpiMoe1 E{(unsigned char*)act, tb}; \
        pg8::gemm_phase_g<pg8::Moe1Prob, pg8::EpiMoe1, true>(lds, P, E); \
        if (BOTH(8)) xcd_barrier(bar); \
    } while (0)
        PH_BODY; if (REPN(8) > 1) { PH_BODY; PH_BODY; }
#undef PH_BODY
    }
    if (IN(9)) for (int rep_ = 0; rep_ < REPN(9); ++rep_) {
        MOE_PREFIX(0, 65, 4, 0);
        pg8::Moe2Prob P{DE, 256, pg8::MoeSched{tb, 0, 65, 4, G, vcu, 0}, (const unsigned char*)act, (const unsigned char*)w2t, list, listw};
        pg8::EpiMoe2 E{(unsigned char*)y0, (unsigned char*)y1, ws + WS_YS, tb};
        pg8::gemm_phase_g<pg8::Moe2Prob, pg8::EpiMoe2, true>(lds, P, E);
        if (BOTH(9)) xcd_barrier(bar);
    }
    if (IN(10)) {
        const float* fw = args.in[22]; const unsigned char* yb0 = (const unsigned char*)y0; const unsigned char* yb1 = (const unsigned char*)y1;
        typedef float f32x2_ __attribute__((ext_vector_type(2)));
        f32x4 fwr[2][2];
#pragma unroll
        for (int j = 0; j < 2; ++j)
#pragma unroll
            for (int h2_ = 0; h2_ < 2; ++h2_) fwr[j][h2_] = ((const GAS f32x4*)fw)[2 * lane + 128 * j + h2_];
#define P10_LOAD(m_, yq_, xv_, g2v_) do { const int hf_ = (m_) >= T ? 1 : 0; const GAS f32x4* xr_ = (const GAS f32x4*)(args.out + (size_t)(m_) * D); \
            const GAS v2u* yr_ = (const GAS v2u*)(hf_ ? yb1 + (size_t)((m_) - T) * 8 * D : yb0 + (size_t)(m_) * 8 * D) + lane; const GAS v2u* ysr_ = (const GAS v2u*)(ws + WS_YS + (size_t)(m_) * D) + lane; \
            const GAS f32x4* g24_ = (const GAS f32x4*)(mod + hf_ * 6144 + 5120); \
            _Pragma("unroll") for (int j = 0; j < 2; ++j) { _Pragma("unroll") for (int h2_ = 0; h2_ < 2; ++h2_) { xv_[j][h2_] = xr_[2 * lane + 128 * j + h2_]; g2v_[j][h2_] = g24_[2 * lane + 128 * j + h2_]; } \
                _Pragma("unroll") for (int k = 0; k < 8; ++k) yq_[k][j] = yr_[k * 128 + 64 * j]; yq_[8][j] = ysr_[64 * j]; } } while (0)
        v2u yqn[9][2]; f32x4 xvn[2][2], g2n[2][2];
        if (gw < M) P10_LOAD(gw, yqn, xvn, g2n);
#pragma unroll 1
        for (int m = gw; m < M; m += NGW) {
            GAS f32x4* xr = (GAS f32x4*)(args.out + (size_t)m * D);
            v2u yq[9][2]; f32x4 xv[2][2], g2v[2][2];
#pragma unroll
            for (int j = 0; j < 2; ++j) {
#pragma unroll
                for (int k = 0; k < 9; ++k) yq[k][j] = yqn[k][j];
#pragma unroll
                for (int h2_ = 0; h2_ < 2; ++h2_) { xv[j][h2_] = xvn[j][h2_]; g2v[j][h2_] = g2n[j][h2_]; } }
            if (m + NGW < M) P10_LOAD(m + NGW, yqn, xvn, g2n);
            f32x4 v[2][2]; float ss = 0.f;
#pragma unroll
            for (int j = 0; j < 2; ++j) { f32x4 s0 = {0.f, 0.f, 0.f, 0.f}, s1 = {0.f, 0.f, 0.f, 0.f};
#pragma unroll
                for (int k = 0; k < 9; ++k) { const f32x2_ a = __builtin_amdgcn_cvt_pk_f32_fp8(yq[k][j].x, false), b = __builtin_amdgcn_cvt_pk_f32_fp8(yq[k][j].x, true), c = __builtin_amdgcn_cvt_pk_f32_fp8(yq[k][j].y, false), d = __builtin_amdgcn_cvt_pk_f32_fp8(yq[k][j].y, true);
                    s0.x += a.x; s0.y += a.y; s0.z += b.x; s0.w += b.y; s1.x += c.x; s1.y += c.y; s1.z += d.x; s1.w += d.y; }
                v[j][0] = xv[j][0] + g2v[j][0] * (s0 * 0.03125f); v[j][1] = xv[j][1] + g2v[j][1] * (s1 * 0.03125f);
#pragma unroll
                for (int h2_ = 0; h2_ < 2; ++h2_) ss += (v[j][h2_].x * v[j][h2_].x + v[j][h2_].y * v[j][h2_].y) + (v[j][h2_].z * v[j][h2_].z + v[j][h2_].w * v[j][h2_].w); }
            const float rstd = rsqrtf(wave_sum(ss) * (1.f / D) + 1e-6f);
#pragma unroll
            for (int j = 0; j < 2; ++j)
#pragma unroll
                for (int h2_ = 0; h2_ < 2; ++h2_) xr[2 * lane + 128 * j + h2_] = v[j][h2_] * rstd * fwr[j][h2_];
        }
#undef P10_LOAD
    }
#undef MOE_PREFIX
#undef IN
#undef BOTH
}

static void launch_mk(Args a, int lo, int hi, int li, int grid, hipStream_t stream) {
    a.ph_lo = lo; a.ph_hi = hi; a.li = li;
    hipLaunchKernelGGL(mk_fwd, dim3(grid), dim3(NWAVES * 64), LDS_BYTES, stream, a);
}
extern "C" void kernel_launch(void* const* d_in, const int* in_sizes, int n_in, void* d_out, int out_size, void* d_ws, size_t ws_size, hipStream_t stream) {
    static int grid = 0;
    if (grid == 0) {
        int dev = 0, cus = 0;
        if (hipGetDevice(&dev) != hipSuccess || hipDeviceGetAttribute(&cus, hipDeviceAttributeMultiprocessorCount, dev) != hipSuccess) { grid = -1; return; }
        if (hipFuncSetAttribute((const void*)mk_fwd, hipFuncAttributeMaxDynamicSharedMemorySize, LDS_BYTES) != hipSuccess) { grid = -1; return; }
        grid = cus;
    }
    if (grid < 0) return;
    unsigned char* ws = (unsigned char*)d_ws; float* out = (float*)d_out;
    (void)hipMemsetAsync(ws + WS_CTL, 0, CTL_ZERO_BYTES, stream);
    Args a{};
    for (int i = 0; i < 23; ++i) a.in[i] = (const float*)d_in[i];
    a.out = out; a.ws = ws;
    launch_mk(a, 0, 11, 0, grid, stream);
}
```

```cpp
#include <hip/hip_runtime.h>
#include <cstdio>
#include <cstdint>
namespace pg8 {
#define PG8_LAS __attribute__((address_space(3)))
typedef unsigned short bf16_t;
typedef short bf16x8 __attribute__((ext_vector_type(8)));
typedef float f32x4 __attribute__((ext_vector_type(4)));
typedef unsigned u32x4 __attribute__((ext_vector_type(4)));
constexpr int BM = 256, BK = 64, HALF = 128, HTB = HALF * BK * 2  , STAGE_BYTES = 8 * HTB, NXCD = 8, WGM = 8;

__host__ __device__ __forceinline__ int lds_byte(int r, int c) { const int st = (r >> 4) * 2 + (c >> 5), rr = r & 15, cc = c & 31, ob = rr * 64 + cc * 2; return st * 1024 + (ob ^ (((ob >> 9) & 1) << 5)); }
__host__ __device__ __forceinline__ void stage_rc(int b, int& R, int& C) { const int st = b / 1024, sb = b % 1024, swz = sb ^ (((sb >> 9) & 1) << 5); R = (st >> 1) * 16 + swz / 64; C = (st & 1) * 32 + (swz % 64) / 2; }
__host__ __device__ __forceinline__ int perm32(int rho) { const int n = rho >> 4, i = rho & 15; return 8 * (i >> 2) + 4 * n + (i & 3); }

struct Unit { int pm, pn; };
struct Gemm { const bf16_t* A; const bf16_t* Bt; int M, N, K; };

struct StaticOrder {
    int nM, nN, nwg, G, c;
    __host__ __device__ void init(int M, int N, int G_, int c_) { nM = M / BM; nN = N / BM; nwg = nM * nN; G = G_; c = c_; }
    __host__ __device__ bool next(int i, Unit& u) const {
        const long L = (long)i * G + c; if (L >= nwg) return false;
        int wgid = (int)L; { const int q = nwg / NXCD, r = nwg % NXCD, xcd = wgid % NXCD, off = wgid / NXCD; wgid = (xcd < r ? xcd * (q + 1) : r * (q + 1) + (xcd - r) * q) + off; }
        const int nig = WGM * nN, gid = wgid / nig, fm = gid * WGM, gsz = (nM - fm) < WGM ? (nM - fm) : WGM;
        u.pm = fm + ((wgid % nig) % gsz); u.pn = (wgid % nig) / gsz; return true;
    }
    __device__ __forceinline__ void a_ready(const Unit&) const {}
    __device__ __forceinline__ void done(const Unit&) const {}
};
__device__ __forceinline__ unsigned cvt_pk_bf16(float lo, float hi) { unsigned r; asm volatile("v_cvt_pk_bf16_f32 %0, %1, %2" : "=v"(r) : "v"(lo), "v"(hi)); return r; }
template <class Epi, class Sched, bool ALIGN_EPI = false, bool SP2 = false>
__device__ __forceinline__ void gemm_phase(PG8_LAS unsigned char* lds, const Gemm g, const Sched& S, const Epi& E) {
    const int tid = threadIdx.x, wid = __builtin_amdgcn_readfirstlane(tid >> 6), lane = tid & 63, wr = wid >> 2, wc = wid & 3, fr = lane & 15, fq = lane >> 4;
    const int K = g.K, nt = K / BK;
    unsigned voffA[2], voffB[2];
#pragma unroll
    for (int i = 0; i < 2; ++i) { int R, C; stage_rc(tid * 16 + i * 8192, R, C); const int Rb = Epi::PERM ? ((R & ~31) + perm32(R & 31)) : R;
        voffA[i] = (unsigned)(R * K + C) * 2u; voffB[i] = (unsigned)(Rb * K + C) * 2u; }
    const size_t kstep = (size_t)(BK * 2);
    const size_t hstep = (size_t)HALF * K * 2;
    const size_t tstep = 2 * hstep;
    const unsigned ldsw = (unsigned)wid * 1024u;
    const int aoff = lds_byte(wr * 64 + fr, fq * 8), boff = lds_byte(wc * 32 + fr, fq * 8);
#define PG8_SA(b, h) (((b) * 2 + (h)) * HTB)
#define PG8_SB(b, h) ((4 + (b) * 2 + (h)) * HTB)
#define PG8_STAGE(bufoff, gbase, voff) do { _Pragma("unroll") for (int _i = 0; _i < 2; ++_i) \
        __builtin_amdgcn_global_load_lds((const unsigned*)((const char*)(gbase) + (voff)[_i]), (PG8_LAS unsigned*)(lds + (bufoff) + ldsw + _i * 8192), 16, 0, 0); } while (0)
#define PG8_LDA(dst, b, h) do { _Pragma("unroll") for (int m = 0; m < 4; ++m) _Pragma("unroll") for (int k = 0; k < 2; ++k) dst[m][k] = *(const PG8_LAS bf16x8*)(lds + PG8_SA(b, h) + aoff + m * 2048 + k * 1024); } while (0)
#define PG8_LDB(dst, b, h) do { _Pragma("unroll") for (int n = 0; n < 2; ++n) _Pragma("unroll") for (int k = 0; k < 2; ++k) dst[n][k] = *(const PG8_LAS bf16x8*)(lds + PG8_SB(b, h) + boff + n * 2048 + k * 1024); } while (0)
#define PG8_MMA(ai, bj, At, Bt) do { __builtin_amdgcn_s_setprio(1); _Pragma("unroll") for (int m = 0; m < 4; ++m) _Pragma("unroll") for (int n = 0; n < 2; ++n) _Pragma("unroll") for (int k = 0; k < 2; ++k) \
        acc[ai][bj][m][n] = __builtin_amdgcn_mfma_f32_16x16x32_bf16(Bt[n][k], At[m][k], acc[ai][bj][m][n], 0, 0, 0); __builtin_amdgcn_s_setprio(0); } while (0)
#define PG8_WAIT_V(n) asm volatile("s_waitcnt vmcnt(" #n ")" ::: "memory")
#define PG8_WAIT_L(n) asm volatile("s_waitcnt lgkmcnt(" #n ")" ::: "memory")
#define PG8_BAR __builtin_amdgcn_s_barrier()
#define PG8_SCHED __builtin_amdgcn_sched_barrier(0)
    Unit cur, nxt; int ui = 0;
    if (!S.next(0, cur)) return;
    f32x4 acc[2][2][4][2];
#pragma unroll
    for (int a = 0; a < 2; ++a)
#pragma unroll
        for (int b = 0; b < 2; ++b)
#pragma unroll
            for (int m = 0; m < 4; ++m)
#pragma unroll
                for (int n = 0; n < 2; ++n) acc[a][b][m][n] = (f32x4){0.f, 0.f, 0.f, 0.f};
    bf16x8 At[4][2], B0[2][2], B1[2][2];
    const char* cA = (const char*)g.A + (size_t)cur.pm * tstep; const char* cB = (const char*)g.Bt + (size_t)cur.pn * tstep;
    S.a_ready(cur);
    if constexpr (SP2) {
        PG8_STAGE(PG8_SB(0, 0), cB, voffB); PG8_STAGE(PG8_SB(0, 1), cB + hstep, voffB); PG8_STAGE(PG8_SA(0, 0), cA, voffA); PG8_STAGE(PG8_SA(0, 1), cA + hstep, voffA);
        if (wr == 1) PG8_BAR;
        PG8_WAIT_V(2); PG8_BAR;
        PG8_STAGE(PG8_SB(1, 0), cB + kstep, voffB); PG8_STAGE(PG8_SA(1, 0), cA + kstep, voffA); PG8_STAGE(PG8_SB(1, 1), cB + hstep + kstep, voffB);
        PG8_WAIT_V(6); PG8_BAR;
    } else {
        PG8_STAGE(PG8_SB(0, 0), cB, voffB); PG8_STAGE(PG8_SA(0, 0), cA, voffA); PG8_STAGE(PG8_SB(0, 1), cB + hstep, voffB); PG8_STAGE(PG8_SA(0, 1), cA + hstep, voffA);
        if (wr == 1) PG8_BAR;
        PG8_WAIT_V(4); PG8_BAR;
        PG8_STAGE(PG8_SB(1, 0), cB + kstep, voffB); PG8_STAGE(PG8_SA(1, 0), cA + kstep, voffA); PG8_STAGE(PG8_SB(1, 1), cB + hstep + kstep, voffB);
        PG8_WAIT_V(6); PG8_BAR;
    }
    for (;;) {
        const bool has_next = S.next(ui + 1, nxt);
        const char* nA = has_next ? (const char*)g.A + (size_t)nxt.pm * tstep : cA; const char* nB = has_next ? (const char*)g.Bt + (size_t)nxt.pn * tstep : cB;
        for (int t = 0; t < nt; t += 2) {
            const bool last = (t == nt - 2);
            const char* a1 = cA + (size_t)(t + 1) * kstep;
            const char* a2 = last ? nA : cA + (size_t)(t + 2) * kstep; const char* b2 = last ? nB : cB + (size_t)(t + 2) * kstep;
            const char* a3 = a2 + kstep; const char* b3 = b2 + kstep;
            if (last && has_next) S.a_ready(nxt);
            if constexpr (SP2) {
            PG8_LDB(B0, 0, 0); PG8_LDB(B1, 0, 1); PG8_SCHED; PG8_LDA(At, 0, 0); PG8_STAGE(PG8_SA(1, 1), a1 + hstep, voffA);
            PG8_WAIT_V(8); PG8_WAIT_L(0); PG8_BAR; PG8_MMA(0, 0, At, B0); PG8_MMA(0, 1, At, B1); PG8_BAR; PG8_SCHED;
            PG8_LDA(At, 0, 1); PG8_STAGE(PG8_SB(0, 0), b2, voffB); PG8_STAGE(PG8_SB(0, 1), b2 + hstep, voffB); PG8_STAGE(PG8_SA(0, 0), a2, voffA);
            PG8_WAIT_V(8); PG8_WAIT_L(0); PG8_BAR; PG8_MMA(1, 0, At, B0); PG8_MMA(1, 1, At, B1); PG8_BAR; PG8_SCHED;
            PG8_LDB(B0, 1, 0); PG8_LDB(B1, 1, 1); PG8_SCHED; PG8_LDA(At, 1, 0); PG8_STAGE(PG8_SA(0, 1), a2 + hstep, voffA);
            PG8_WAIT_V(8); PG8_WAIT_L(0); PG8_BAR; PG8_MMA(0, 0, At, B0); PG8_MMA(0, 1, At, B1); PG8_BAR; PG8_SCHED;
            PG8_LDA(At, 1, 1); PG8_STAGE(PG8_SB(1, 0), b3, voffB); PG8_STAGE(PG8_SB(1, 1), b3 + hstep, voffB); PG8_STAGE(PG8_SA(1, 0), a3, voffA);
            PG8_WAIT_V(8); PG8_WAIT_L(0); PG8_BAR; PG8_MMA(1, 0, At, B0); PG8_MMA(1, 1, At, B1); PG8_BAR; PG8_SCHED;
            } else {
            PG8_LDB(B0, 0, 0); PG8_SCHED; PG8_LDA(At, 0, 0); PG8_STAGE(PG8_SA(1, 1), a1 + hstep, voffA);
            PG8_WAIT_L(8); PG8_BAR; PG8_WAIT_L(0); PG8_MMA(0, 0, At, B0); PG8_BAR; PG8_SCHED;
            PG8_LDB(B1, 0, 1); PG8_STAGE(PG8_SB(0, 0), b2, voffB);
            PG8_BAR; PG8_WAIT_L(0); PG8_MMA(0, 1, At, B1); PG8_BAR;
            PG8_LDA(At, 0, 1); PG8_STAGE(PG8_SA(0, 0), a2, voffA);
            PG8_BAR; PG8_WAIT_L(0); PG8_MMA(1, 0, At, B0); PG8_BAR; PG8_SCHED;
            PG8_STAGE(PG8_SB(0, 1), b2 + hstep, voffB);
            PG8_WAIT_V(6); PG8_BAR; PG8_MMA(1, 1, At, B1); PG8_BAR;
            PG8_LDB(B0, 1, 0); PG8_SCHED; PG8_LDA(At, 1, 0); PG8_STAGE(PG8_SA(0, 1), a2 + hstep, voffA);
            PG8_WAIT_L(8); PG8_BAR; PG8_WAIT_L(0); PG8_MMA(0, 0, At, B0); PG8_BAR; PG8_SCHED;
            PG8_LDB(B1, 1, 1); PG8_STAGE(PG8_SB(1, 0), b3, voffB);
            PG8_BAR; PG8_WAIT_L(0); PG8_MMA(0, 1, At, B1); PG8_BAR;
            PG8_LDA(At, 1, 1); PG8_STAGE(PG8_SA(1, 0), a3, voffA);
            PG8_BAR; PG8_WAIT_L(0); PG8_MMA(1, 0, At, B0); PG8_BAR; PG8_SCHED;
            PG8_STAGE(PG8_SB(1, 1), b3 + hstep, voffB);
            PG8_WAIT_V(6); PG8_BAR; PG8_MMA(1, 1, At, B1); PG8_BAR;
            }
        }
        if constexpr (ALIGN_EPI) { if (wr == 0) PG8_BAR; }
        if constexpr (!Epi::AFTER_DRAIN) { E(acc, cur, wr, wc, fr, fq); S.done(cur); }
        if (!has_next) break;
#pragma unroll
        for (int a = 0; a < 2; ++a)
#pragma unroll
            for (int b = 0; b < 2; ++b)
#pragma unroll
                for (int m = 0; m < 4; ++m)
#pragma unroll
                    for (int n = 0; n < 2; ++n) acc[a][b][m][n] = (f32x4){0.f, 0.f, 0.f, 0.f};
        cur = nxt; cA = nA; cB = nB; ++ui;
        if constexpr (ALIGN_EPI) { if (wr == 1) PG8_BAR; }
    }
    PG8_WAIT_V(0);
    if constexpr (!ALIGN_EPI) { if (wr == 0) PG8_BAR; }
    PG8_BAR;
    if constexpr (Epi::AFTER_DRAIN) { E.fused(acc, cur, wr, wc, fr, fq, lds, wid, lane); S.done(cur); }
#undef PG8_SA
#undef PG8_SB
#undef PG8_STAGE
#undef PG8_LDA
#undef PG8_LDB
#undef PG8_MMA
#undef PG8_WAIT_V
#undef PG8_WAIT_L
#undef PG8_BAR
#undef PG8_SCHED
}
}
#define GAS __attribute__((address_space(1)))
#define LAS __attribute__((address_space(3)))
typedef unsigned short bf16;
typedef unsigned v4u __attribute__((ext_vector_type(4)));
typedef float f32x4 __attribute__((ext_vector_type(4)));
typedef short bf16x8 __attribute__((ext_vector_type(8)));
typedef GAS unsigned gu32;
typedef GAS unsigned long long gu64;
#define RLX_AGENT __ATOMIC_RELAXED, __HIP_MEMORY_SCOPE_AGENT
#define LDS_WAIT() asm volatile("s_waitcnt lgkmcnt(0)" ::: "memory")
#define VM_WAIT() asm volatile("s_waitcnt vmcnt(0)" ::: "memory")
__device__ __forceinline__ unsigned long long rt() { return __builtin_amdgcn_s_memrealtime(); }
typedef __bf16 bf16x2_hw __attribute__((ext_vector_type(2)));
typedef float f32x2_hw __attribute__((ext_vector_type(2)));
__device__ __forceinline__ unsigned pk2(float lo, float hi) { const f32x2_hw v = {lo, hi}; return __builtin_bit_cast(unsigned, __builtin_convertvector(v, bf16x2_hw)); }
__device__ __forceinline__ unsigned f2bf(float f) { return (unsigned)__builtin_bit_cast(unsigned short, (__bf16)f); }
#define XB_TMO      128
#define XB_XCNT(j)  (256  + 64 * (j))
#define XB_XSUB(j)  (1280 + 64 * (j))
#define XB_XGEN(j)  (2304 + 64 * (j))
#define XB_TOP      3328
#define XB_TOPGEN   3392
#define XCD_BAR_WORDS 3456
#define XB_SPIN_CAP (1u << 18)

__device__ __forceinline__ unsigned xb_ld(unsigned* p)              { return __hip_atomic_load(p, __ATOMIC_RELAXED, __HIP_MEMORY_SCOPE_AGENT); }
__device__ __forceinline__ unsigned xb_add(unsigned* p, unsigned v) { return __hip_atomic_fetch_add(p, v, __ATOMIC_RELAXED, __HIP_MEMORY_SCOPE_AGENT); }
__device__ __forceinline__ unsigned xb_xcc_id() { return (unsigned)__builtin_amdgcn_s_getreg((3 << 11) | 20) & 0xFu; }
#define XB_SPIN(cond, bar) do { unsigned _sp = 0; while (cond) { __builtin_amdgcn_s_sleep(1); \
    if ((++_sp & 255u) == 0u) { if (xb_ld(&(bar)[XB_TMO])) break; if (_sp > XB_SPIN_CAP) { atomicAdd(&(bar)[XB_TMO], 1u); break; } } } } while (0)

struct XcdBarrier {
    unsigned* bar; unsigned x;
    volatile LAS unsigned* st;
};

__device__ __forceinline__ XcdBarrier xcd_barrier_post(unsigned* bar, volatile LAS unsigned* st) {
    XcdBarrier b; b.bar = bar; b.x = xb_xcc_id(); b.st = st;
    if (threadIdx.x == 0) (void)xb_add(&bar[XB_XCNT(b.x)], 1u);
    return b;
}
__device__ __forceinline__ void xcd_barrier_complete(unsigned* bar, unsigned x, unsigned& nloc, unsigned& nx) {
    const unsigned G = gridDim.x * gridDim.y * gridDim.z;
    unsigned sum, cnt, mine, sp = 0u;
    for (;;) {
        sum = 0u; cnt = 0u; mine = 0u;
#pragma unroll
        for (unsigned j = 0; j < 16; ++j) { const unsigned c = xb_ld(&bar[XB_XCNT(j)]); sum += c; cnt += (c > 0u) ? 1u : 0u; mine = (j == x) ? c : mine; }
        if (sum == G) break;
        __builtin_amdgcn_s_sleep(1);
        if ((++sp & 255u) == 0u) { if (xb_ld(&bar[XB_TMO])) break; if (sp > XB_SPIN_CAP) { atomicAdd(&bar[XB_TMO], 1u); break; } }
    }
    nloc = mine > 0u ? mine : 1u; nx = cnt > 0u ? cnt : 1u;
}

__device__ __forceinline__ void xcd_barrier(const XcdBarrier& b) {
    asm volatile("s_waitcnt vmcnt(0)" ::: "memory");
    __syncthreads();
    if (threadIdx.x == 0) {
        unsigned* bar = b.bar;
        __builtin_amdgcn_s_waitcnt(0);
        unsigned nloc = b.st[0], nx = b.st[1];
        if (nloc == 0u) { xcd_barrier_complete(bar, b.x, nloc, nx); b.st[0] = nloc; b.st[1] = nx; }
        const unsigned old = xb_add(&bar[XB_XSUB(b.x)], 1u);
        const unsigned gen = old / nloc;
        if (old + 1u == (gen + 1u) * nloc) {
            __builtin_amdgcn_fence(__ATOMIC_RELEASE, "agent");
            asm volatile("s_waitcnt vmcnt(0)" ::: "memory");
            const unsigned og = xb_add(&bar[XB_TOP], 1u);
            const unsigned tg = og / nx;
            if (og + 1u == (tg + 1u) * nx) xb_add(&bar[XB_TOPGEN], 1u);
            else XB_SPIN(xb_ld(&bar[XB_TOPGEN]) == tg, bar);
            __builtin_amdgcn_fence(__ATOMIC_ACQUIRE, "agent");
            xb_add(&bar[XB_XGEN(b.x)], 1u);
            asm volatile("s_waitcnt vmcnt(0)" ::: "memory");
        } else {
            XB_SPIN(xb_ld(&bar[XB_XGEN(b.x)]) == gen, bar);
            __builtin_amdgcn_fence(__ATOMIC_ACQUIRE, "agent");
            asm volatile("s_waitcnt vmcnt(0)" ::: "memory");
        }
    }
    __syncthreads();
}

namespace pg8 {
struct UnitG { int seg, mt, nt; };
template <class Prob, class Epi, bool FP8 = false>
__device__ __forceinline__ void gemm_phase_g(PG8_LAS unsigned char* lds, const Prob& P, const Epi& E) {
    const int tid = threadIdx.x, wid = __builtin_amdgcn_readfirstlane(tid >> 6), lane = tid & 63, wr = wid >> 2, wc = wid & 3, fr = lane & 15, fq = lane >> 4;
    constexpr int EB = FP8 ? 1 : 2;
    const int K = P.K, nt = K * EB / 128;
    unsigned voffB[2], cbA[2];
#pragma unroll
    for (int i = 0; i < 2; ++i) { int R, C; stage_rc(tid * 16 + i * 8192, R, C);
        const int Rb = Epi::PERM64 ? ((R >> 5) * 64 + 16 * ((R & 15) >> 2) + 4 * ((R >> 4) & 1) + (R & 3)) : (Epi::PERM ? ((R & ~31) + perm32(R & 31)) : R); voffB[i] = (unsigned)(Rb * K * EB + C * 2); cbA[i] = (unsigned)(C * 2); }
    const unsigned pitchA = (unsigned)P.pitchA;
    const size_t kstep = (size_t)(BK * 2);
    const size_t hstep = (size_t)(Epi::PERM64 ? 8 : HALF) * K * EB;
    const unsigned ldsw = (unsigned)wid * 1024u;
    const int aoff = lds_byte(wr * 64 + fr, fq * 8), boff = lds_byte(wc * 32 + fr, fq * 8);
#define PG8_SA(b, h) (((b) * 2 + (h)) * HTB)
#define PG8_SB(b, h) ((4 + (b) * 2 + (h)) * HTB)
#define PG8_STAGE(bufoff, gbase, voff) do { _Pragma("unroll") for (int _i = 0; _i < 2; ++_i) \
        __builtin_amdgcn_global_load_lds((const unsigned*)((const char*)(gbase) + (voff)[_i]), (PG8_LAS unsigned*)(lds + (bufoff) + ldsw + _i * 8192), 16, 0, 0); } while (0)
#define PG8_STAGE_A(bufoff, gbase, rp_) do { const unsigned o0_ = ((rp_) & 0xffffu) * pitchA + cbA[0], o1_ = ((rp_) >> 16) * pitchA + cbA[1]; \
        __builtin_amdgcn_global_load_lds((const unsigned*)((const char*)(gbase) + o0_), (PG8_LAS unsigned*)(lds + (bufoff) + ldsw), 16, 0, 0); \
        __builtin_amdgcn_global_load_lds((const unsigned*)((const char*)(gbase) + o1_), (PG8_LAS unsigned*)(lds + (bufoff) + ldsw + 8192), 16, 0, 0); } while (0)
#define PG8_LDA(dst, b, h) do { _Pragma("unroll") for (int m = 0; m < 4; ++m) { const v4i_ lo_ = *(const PG8_LAS v4i_*)(lds + PG8_SA(b, h) + aoff + m * 2048), hi_ = *(const PG8_LAS v4i_*)(lds + PG8_SA(b, h) + aoff + m * 2048 + 1024); dst[m] = __builtin_shufflevector(lo_, hi_, 0, 1, 2, 3, 4, 5, 6, 7); } } while (0)
#define PG8_LDB(dst, b, h) do { _Pragma("unroll") for (int n = 0; n < 2; ++n) { const v4i_ lo_ = *(const PG8_LAS v4i_*)(lds + PG8_SB(b, h) + boff + n * 2048), hi_ = *(const PG8_LAS v4i_*)(lds + PG8_SB(b, h) + boff + n * 2048 + 1024); dst[n] = __builtin_shufflevector(lo_, hi_, 0, 1, 2, 3, 4, 5, 6, 7); } } while (0)
#define PG8_HALF(v_, k_) __builtin_bit_cast(bf16x8, (v4i_)__builtin_shufflevector(v_, v_, 4 * (k_), 4 * (k_) + 1, 4 * (k_) + 2, 4 * (k_) + 3))
#define PG8_MMA(ai, bj, At, Bt) do { __builtin_amdgcn_s_setprio(1); _Pragma("unroll") for (int m = 0; m < 4; ++m) _Pragma("unroll") for (int n = 0; n < 2; ++n) { \
        acc[ai][bj][m][n] = __builtin_amdgcn_mfma_f32_16x16x32_bf16(PG8_HALF(Bt[n], 0), PG8_HALF(At[m], 0), acc[ai][bj][m][n], 0, 0, 0); \
        acc[ai][bj][m][n] = __builtin_amdgcn_mfma_f32_16x16x32_bf16(PG8_HALF(Bt[n], 1), PG8_HALF(At[m], 1), acc[ai][bj][m][n], 0, 0, 0); } __builtin_amdgcn_s_setprio(0); } while (0)
#define PG8_Q(v_, q_) __builtin_bit_cast(long, (v2i_){v_[2 * (q_)], v_[2 * (q_) + 1]})
#define PG8_MMA8Q(ai, bj, At, Bt, q_) _Pragma("unroll") for (int m = 0; m < 4; ++m) _Pragma("unroll") for (int n = 0; n < 2; ++n) \
            acc[ai][bj][m][n] = __builtin_amdgcn_mfma_f32_16x16x32_fp8_fp8(PG8_Q(Bt[n], q_), PG8_Q(At[m], q_), acc[ai][bj][m][n], 0, 0, 0)
#define PG8_MMA8(ai, bj, At, Bt) do { typedef int v2i_ __attribute__((ext_vector_type(2))); __builtin_amdgcn_s_setprio(1); \
        PG8_MMA8Q(ai, bj, At, Bt, 0); PG8_MMA8Q(ai, bj, At, Bt, 1); PG8_MMA8Q(ai, bj, At, Bt, 2); PG8_MMA8Q(ai, bj, At, Bt, 3); \
        __builtin_amdgcn_s_setprio(0); } while (0)
#define PG8_MM(ai, bj, At, Bt) do { if constexpr (FP8) PG8_MMA8(ai, bj, At, Bt); else PG8_MMA(ai, bj, At, Bt); } while (0)
#define PG8_WAIT_V(n) asm volatile("s_waitcnt vmcnt(" #n ")" ::: "memory")
#define PG8_WAIT_VR do { if constexpr (Epi::NST == 16) asm volatile("s_waitcnt vmcnt(24)" ::: "memory"); else asm volatile("s_waitcnt vmcnt(16)" ::: "memory"); } while (0)
#define PG8_WAIT_L(n) asm volatile("s_waitcnt lgkmcnt(" #n ")" ::: "memory")
#define PG8_BAR __builtin_amdgcn_s_barrier()
#define PG8_SCHED __builtin_amdgcn_sched_barrier(0)
    UnitG cur, nxt; int ui = 0;
    if (!P.next(0, cur)) return;
    f32x4 acc[2][2][4][2];
#pragma unroll
    for (int a = 0; a < 2; ++a)
#pragma unroll
        for (int b = 0; b < 2; ++b)
#pragma unroll
            for (int m = 0; m < 4; ++m)
#pragma unroll
                for (int n = 0; n < 2; ++n) acc[a][b][m][n] = (f32x4){0.f, 0.f, 0.f, 0.f};
    typedef int v4i_ __attribute__((ext_vector_type(4))); typedef int v8i_ __attribute__((ext_vector_type(8)));
    v8i_ At[4], B0[2], B1[2];
    unsigned rowp[2], rowpn[2];
    const char* cA; const char* cB;
    P.setup_base(cur, cA, cB);
    P.meta(cur, lds, 0, wid, lane);
    P.rows_first(cur, lds, 0, rowp);
    PG8_STAGE(PG8_SB(0, 0), cB, voffB); PG8_STAGE(PG8_SB(0, 1), cB + hstep, voffB); PG8_STAGE_A(PG8_SA(0, 0), cA, rowp[0]); PG8_STAGE_A(PG8_SA(0, 1), cA, rowp[1]);
    if (wr == 1) PG8_BAR;
    PG8_WAIT_V(2); PG8_BAR;
    PG8_STAGE(PG8_SB(1, 0), cB + kstep, voffB); PG8_STAGE_A(PG8_SA(1, 0), cA + kstep, rowp[0]); PG8_STAGE(PG8_SB(1, 1), cB + hstep + kstep, voffB);
    PG8_WAIT_V(6); PG8_BAR;
    for (;;) {
        const bool has_next = P.next(ui + 1, nxt);
        const char* nA = cA; const char* nB = cB;
        rowpn[0] = rowp[0]; rowpn[1] = rowp[1];
        if (has_next) { P.setup_base(nxt, nA, nB); P.meta(nxt, lds, (ui + 1) % 3, wid, lane); }
        for (int t = 0; t < nt; t += 2) {
            const bool last = (t == nt - 2);
            const char* a1 = cA + (size_t)(t + 1) * kstep;
            const char* a2 = last ? nA : cA + (size_t)(t + 2) * kstep; const char* b2 = last ? nB : cB + (size_t)(t + 2) * kstep;
            const char* a3 = a2 + kstep; const char* b3 = b2 + kstep;
            if (last && has_next) P.rows(nxt, lds, (ui + 1) % 3, rowpn);
            const unsigned o2_0 = last ? rowpn[0] : rowp[0], o2_1 = last ? rowpn[1] : rowp[1];
            const bool relax = (Epi::NST > 0 && t == 0 && ui > 0);
            PG8_LDB(B0, 0, 0); PG8_LDB(B1, 0, 1); PG8_SCHED; PG8_LDA(At, 0, 0); PG8_STAGE_A(PG8_SA(1, 1), a1, rowp[1]);
            if (relax) PG8_WAIT_VR; else PG8_WAIT_V(8);
            PG8_WAIT_L(0); PG8_BAR; PG8_MM(0, 0, At, B0); PG8_MM(0, 1, At, B1); PG8_BAR; PG8_SCHED;
            PG8_LDA(At, 0, 1); PG8_STAGE(PG8_SB(0, 0), b2, voffB); PG8_STAGE(PG8_SB(0, 1), b2 + hstep, voffB); PG8_STAGE_A(PG8_SA(0, 0), a2, o2_0);
            if (relax) PG8_WAIT_VR; else PG8_WAIT_V(8);
            PG8_WAIT_L(0); PG8_BAR; PG8_MM(1, 0, At, B0); PG8_MM(1, 1, At, B1); PG8_BAR; PG8_SCHED;
            PG8_LDB(B0, 1, 0); PG8_LDB(B1, 1, 1); PG8_SCHED; PG8_LDA(At, 1, 0); PG8_STAGE_A(PG8_SA(0, 1), a2, o2_1);
            PG8_WAIT_V(8); PG8_WAIT_L(0); PG8_BAR; PG8_MM(0, 0, At, B0); PG8_MM(0, 1, At, B1); PG8_BAR; PG8_SCHED;
            PG8_LDA(At, 1, 1); PG8_STAGE(PG8_SB(1, 0), b3, voffB); PG8_STAGE(PG8_SB(1, 1), b3 + hstep, voffB); PG8_STAGE_A(PG8_SA(1, 0), a3, o2_0);
            PG8_WAIT_V(8); PG8_WAIT_L(0); PG8_BAR; PG8_MM(1, 0, At, B0); PG8_MM(1, 1, At, B1); PG8_BAR; PG8_SCHED;
        }
        if (wr == 0) PG8_BAR;
        E(acc, cur, wr, wc, fr, fq, lds, ui % 3);
        if (!has_next) break;
#pragma unroll
        for (int a = 0; a < 2; ++a)
#pragma unroll
            for (int b = 0; b < 2; ++b)
#pragma unroll
                for (int m = 0; m < 4; ++m)
#pragma unroll
                    for (int n = 0; n < 2; ++n) acc[a][b][m][n] = (f32x4){0.f, 0.f, 0.f, 0.f};
        cur = nxt; cA = nA; cB = nB; ++ui;
        rowp[0] = rowpn[0]; rowp[1] = rowpn[1];
        if (wr == 1) PG8_BAR;
    }
    PG8_WAIT_V(0);
    PG8_BAR;
#undef PG8_SA
#undef PG8_SB
#undef PG8_STAGE
#undef PG8_STAGE_A
#undef PG8_LDA
#undef PG8_LDB
#undef PG8_MMA
#undef PG8_MMA8
#undef PG8_Q
#undef PG8_MMA8Q
#undef PG8_HALF
#undef PG8_MM
#undef PG8_WAIT_V
#undef PG8_WAIT_VR
#undef PG8_WAIT_L
#undef PG8_BAR
#undef PG8_SCHED
}
}

constexpr int NWAVES = 8;
constexpr int BATCH = 2, T = 8192, D = 1024, M = BATCH * T, DIN = 4104, PA = 3072;
constexpr int NE = 64, NEX = 65, DE = 256;
constexpr size_t MiB = 1u << 20;
constexpr size_t WS_CTL = 0, CTL_ZERO_BYTES = 256 * 1024;
constexpr size_t WS_WRHI = 512 * 1024, WS_WRLO = 640 * 1024;
constexpr size_t WS_MOD = 1 * MiB, WS_WAB = 1 * MiB + 256 * 1024, WS_AB = 1 * MiB + 512 * 1024;
constexpr size_t WS_WOUT_T = 2 * MiB, WS_WIN_T = 4 * MiB, WS_H1 = 12 * MiB, WS_PROJA = 44 * MiB, WS_GATES = 142 * MiB;
constexpr size_t WS_QP = 4 * MiB, WS_OI = 20 * MiB, WS_AH = 36 * MiB, WS_GL = 36 * MiB + 512 * 1024, WS_PG = 174 * MiB, WS_BG = 206 * MiB, WS_BH = 238 * MiB, WS_QE = 270 * MiB, WS_OIH = 286 * MiB;
constexpr size_t WS_OMIX = 174 * MiB;
constexpr size_t WS_H2 = 12 * MiB, WS_W1T = 44 * MiB, WS_W2T = 109 * MiB, WS_ACT = 142 * MiB, WS_LIST = 215 * MiB, WS_LISTW = 217 * MiB, WS_Y0 = 12 * MiB, WS_Y1 = 219 * MiB;
constexpr size_t WS_YS = 80 * MiB;
constexpr size_t WS_TRASH = 128 * MiB;
constexpr size_t WS_TOP = 302 * MiB;
constexpr int CAP = 8192;
constexpr int TB_PRE = 0, TB_CNT = 132, TB_OFF = 264;
constexpr int CW_CNT = 16384;
constexpr int CW_BAR = 4096;
constexpr int RING_BYTES = 131072, LDS_BYTES = 163840, LDSCTL_OFF = LDS_BYTES - 1024, MISC_OFF = LDSCTL_OFF + 320, SCR2_OFF = LDS_BYTES - 3072;

__device__ __forceinline__ float bf2f(bf16 v) { return __uint_as_float(((unsigned)v) << 16); }
__device__ __forceinline__ float frcp_(float x) { return __builtin_amdgcn_rcpf(x); }
__device__ __forceinline__ float sigmoidf_(float x) { return frcp_(1.f + __expf(-x)); }
__device__ __forceinline__ float siluf_(float x) { return x * frcp_(1.f + __expf(-x)); }
__device__ __forceinline__ float softplusf_(float x) { return x > 20.f ? x : log1pf(expf(x)); }
__device__ __forceinline__ float c8(float x) { return __builtin_amdgcn_fmed3f(x, -448.f, 448.f); }

template <int CTRL> __device__ __forceinline__ float dppf(float v) { return __int_as_float(__builtin_amdgcn_update_dpp(__float_as_int(v), __float_as_int(v), CTRL, 0xf, 0xf, false)); }
template <int CTRL> __device__ __forceinline__ float dpp_shr0(float v) { return __int_as_float(__builtin_amdgcn_update_dpp(0, __float_as_int(v), CTRL, 0xf, 0xf, false)); }
__device__ __forceinline__ float rdlane(float v, int l) { return __int_as_float(__builtin_amdgcn_readlane(__float_as_int(v), l)); }
__device__ __forceinline__ float wave_max(float v) {
    v = fmaxf(v, dppf<0xB1>(v)); v = fmaxf(v, dppf<0x4E>(v)); v = fmaxf(v, dppf<0x141>(v)); v = fmaxf(v, dppf<0x140>(v));
    return fmaxf(fmaxf(rdlane(v, 0), rdlane(v, 16)), fmaxf(rdlane(v, 32), rdlane(v, 48)));
}
__device__ __forceinline__ float wave_sum(float v) {
    v += dppf<0xB1>(v); v += dppf<0x4E>(v); v += dppf<0x141>(v); v += dppf<0x140>(v);
    return (rdlane(v, 0) + rdlane(v, 16)) + (rdlane(v, 32) + rdlane(v, 48));
}

namespace pg8 {
struct EpiProj {
    static constexpr bool PERM = true, AFTER_DRAIN = false;
    bf16_t* projA; bf16_t* gates;
    __device__ __forceinline__ void operator()(const f32x4 (&acc)[2][2][4][2], const Unit& u, int wr, int wc, int fr, int fq) const {
        const int row0 = u.pm * BM + wr * 64 + fr;
        bf16_t* base; int ldc, colt;
        if (u.pn < 12) { base = projA; ldc = 3072; colt = u.pn * BM; } else { base = gates; ldc = 1024; colt = (u.pn - 12) * BM; }
        const int col0 = colt + wc * 32 + 8 * fq;
#pragma unroll
        for (int ai = 0; ai < 2; ++ai)
#pragma unroll
            for (int m = 0; m < 4; ++m) { bf16_t* rowp = base + (size_t)(row0 + ai * HALF + m * 16) * ldc + col0;
#pragma unroll
                for (int bj = 0; bj < 2; ++bj) { const f32x4 v0 = acc[ai][bj][m][0], v1 = acc[ai][bj][m][1];
                    u32x4 w; w.x = cvt_pk_bf16(v0[0], v0[1]); w.y = cvt_pk_bf16(v0[2], v0[3]); w.z = cvt_pk_bf16(v1[0], v1[1]); w.w = cvt_pk_bf16(v1[2], v1[3]);
                    *(u32x4*)(rowp + bj * HALF) = w; } }
    }
};
struct EpiResid {
    static constexpr bool PERM = false, AFTER_DRAIN = false;
    const float* x; const float* mod; float* out;
    __device__ __forceinline__ void operator()(const f32x4 (&acc)[2][2][4][2], const Unit& u, int wr, int wc, int fr, int fq) const {
        const int col0 = u.pn * BM + wc * 32 + 4 * fq;
        const float* g1 = mod + (u.pm * BM >= 8192 ? 6144 : 0) + 2048;
        f32x4 gv[2][2];
#pragma unroll
        for (int bj = 0; bj < 2; ++bj)
#pragma unroll
            for (int n = 0; n < 2; ++n) gv[bj][n] = *(const f32x4*)(g1 + col0 + bj * HALF + n * 16);
#pragma unroll
        for (int ai = 0; ai < 2; ++ai)
#pragma unroll
            for (int mp = 0; mp < 4; mp += 2) { f32x4 xv[2][2][2];
#pragma unroll
                for (int q = 0; q < 2; ++q) { const size_t off = (size_t)(u.pm * BM + ai * HALF + wr * 64 + (mp + q) * 16 + fr) * 1024 + col0;
#pragma unroll
                    for (int bj = 0; bj < 2; ++bj)
#pragma unroll
                        for (int n = 0; n < 2; ++n) xv[q][bj][n] = *(const f32x4*)(x + off + bj * HALF + n * 16); }
#pragma unroll
                for (int q = 0; q < 2; ++q) { const size_t off = (size_t)(u.pm * BM + ai * HALF + wr * 64 + (mp + q) * 16 + fr) * 1024 + col0;
#pragma unroll
                    for (int bj = 0; bj < 2; ++bj)
#pragma unroll
                        for (int n = 0; n < 2; ++n) *(f32x4*)(out + off + bj * HALF + n * 16) = xv[q][bj][n] + gv[bj][n] * acc[ai][bj][mp + q][n]; }
            }
    }
};

struct MoeSched {
    const LAS unsigned* tb; int lo, hi, NT, G, c; int perm;
    __device__ __forceinline__ int segof(int p) const { return perm ? (p & 1) * 65 + (p >> 1) : p; }
    __device__ __forceinline__ bool next(int i, UnitG& u) const {
        const unsigned L = (unsigned)(i * G + c); if (L >= tb[TB_PRE + hi]) return false;
        int s = lo; { int hi_ = hi; while (hi_ - s > 1) { const int mid = (s + hi_) >> 1; if (L >= tb[TB_PRE + mid]) s = mid; else hi_ = mid; } }
        const int sg = segof(s);
        const unsigned loc = L - tb[TB_PRE + s], tiles = (tb[TB_CNT + sg] + 255u) >> 8;
        u.seg = __builtin_amdgcn_readfirstlane(sg); u.mt = __builtin_amdgcn_readfirstlane((int)(loc % tiles)); u.nt = __builtin_amdgcn_readfirstlane((int)(loc / tiles)); return true;
    }
};
struct Moe1Prob {
    int K; int pitchA; MoeSched S; const unsigned char* h2; const unsigned char* w1t; const int* list;
    __device__ __forceinline__ bool next(int i, UnitG& u) const { return S.next(i, u); }
    __device__ __forceinline__ void setup_base(const UnitG& u, const char*& cA, const char*& cB) const { cA = (const char*)h2; cB = (const char*)(w1t + ((size_t)u.seg * 512 + (size_t)u.nt * 256) * 1024); }
    __device__ __forceinline__ void meta(const UnitG& u, PG8_LAS unsigned char* lds, int slot, int wid, int lane) const {
        if (wid == 0 && u.seg < 64) __builtin_amdgcn_global_load_lds((const unsigned*)(list + (size_t)u.seg * CAP + 256u * (unsigned)u.mt + 4u * (unsigned)lane), (PG8_LAS unsigned*)(lds + STAGE_BYTES + slot * 2048), 16, 0, 0);
    }
    __device__ __forceinline__ void rows(const UnitG& u, PG8_LAS unsigned char* lds, int slot, unsigned (&rowp)[2]) const {
        int sR[2], sC[2];
#pragma unroll
        for (int i = 0; i < 2; ++i) stage_rc((int)threadIdx.x * 16 + i * 8192, sR[i], sC[i]);
        const int e = u.seg; const int cnt = (int)S.tb[TB_CNT + u.seg]; const PG8_LAS int* tbl = (const PG8_LAS int*)(lds + STAGE_BYTES + slot * 2048);
#pragma unroll
        for (int h = 0; h < 2; ++h) { unsigned tk[2];
#pragma unroll
            for (int i = 0; i < 2; ++i) { const int rl = 128 * h + sR[i], r = 256 * u.mt + rl;
                if (e < 64) { const int last_ = cnt - 1 - 256 * u.mt; tk[i] = (unsigned)tbl[rl < last_ ? rl : last_] >> 3; } else tk[i] = (unsigned)(r < M ? r : M - 1); }
            rowp[h] = tk[0] | (tk[1] << 16); }
    }
    __device__ __forceinline__ void rows_first(const UnitG& u, PG8_LAS unsigned char* lds, int slot, unsigned (&rowp)[2]) const {
        asm volatile("s_waitcnt vmcnt(0)" ::: "memory"); __builtin_amdgcn_s_barrier(); asm volatile("" ::: "memory");
        rows(u, lds, slot, rowp);
    }
};
struct Moe2Prob {
    int K; int pitchA; MoeSched S; const unsigned char* act; const unsigned char* w2t; const int* list; const float* listw;
    __device__ __forceinline__ bool next(int i, UnitG& u) const { return S.next(i, u); }
    __device__ __forceinline__ void meta(const UnitG& u, PG8_LAS unsigned char* lds, int par, int wid, int lane) const {
        if (wid == 0 && u.seg < 64) { const size_t o = (size_t)u.seg * CAP + 256u * (unsigned)u.mt + 4u * (unsigned)lane;
            __builtin_amdgcn_global_load_lds((const unsigned*)(list + o), (PG8_LAS unsigned*)(lds + STAGE_BYTES + par * 2048), 16, 0, 0);
            __builtin_amdgcn_global_load_lds((const unsigned*)(listw + o), (PG8_LAS unsigned*)(lds + STAGE_BYTES + par * 2048 + 1024), 16, 0, 0); }
    }
    __device__ __forceinline__ void setup_base(const UnitG& u, const char*& cA, const char*& cB) const {
        const size_t rowbase = (size_t)S.tb[TB_OFF + u.seg] + 256u * (unsigned)u.mt;
        cA = (const char*)(act + rowbase * 256); cB = (const char*)(w2t + ((size_t)u.seg * 1024 + (size_t)u.nt * 256) * 256);
    }
    __device__ __forceinline__ void rows(const UnitG&, PG8_LAS unsigned char*, int, unsigned (&rowp)[2]) const {
        int sR[2], sC[2];
#pragma unroll
        for (int i = 0; i < 2; ++i) stage_rc((int)threadIdx.x * 16 + i * 8192, sR[i], sC[i]);
#pragma unroll
        for (int h = 0; h < 2; ++h) rowp[h] = (unsigned)(128 * h + sR[0]) | ((unsigned)(128 * h + sR[1]) << 16);
    }
    __device__ __forceinline__ void rows_first(const UnitG& u, PG8_LAS unsigned char* lds, int slot, unsigned (&rowp)[2]) const { rows(u, lds, slot, rowp); }
};
struct EpiMoe1 {
    static constexpr bool PERM = true; static constexpr bool PERM64 = false; static constexpr int NST = 0;
    unsigned char* act; const LAS unsigned* tb;
    __device__ __forceinline__ void operator()(const f32x4 (&acc)[2][2][4][2], const UnitG& u, int wr, int wc, int fr_, int fq_, PG8_LAS unsigned char*, int) const {
        int t_ = (int)threadIdx.x; asm volatile("" : "+v"(t_));
        const int fr = t_ & 15, fq = (t_ >> 4) & 3;
        const int cnt = (int)tb[TB_CNT + u.seg]; const size_t rowbase = tb[TB_OFF + u.seg];
#pragma unroll
        for (int ai = 0; ai < 2; ++ai)
#pragma unroll
            for (int m = 0; m < 4; ++m) { const int r = 256 * u.mt + ai * HALF + wr * 64 + m * 16 + fr;
                if (r < cnt) { unsigned char* p = act + (rowbase + (size_t)r) * 256 + u.nt * 128 + wc * 32 + 8 * fq;
                    const f32x4 g0 = acc[ai][0][m][0], g1 = acc[ai][0][m][1], u0 = acc[ai][1][m][0], u1 = acc[ai][1][m][1]; f32x4 v0, v1;
#pragma unroll
                    for (int i = 0; i < 4; ++i) { const float ga = g0[i] * 0.03125f, gb = g1[i] * 0.03125f; v0[i] = ga * frcp_(1.f + __expf(-ga)) * (u0[i] * 0.25f); v1[i] = gb * frcp_(1.f + __expf(-gb)) * (u1[i] * 0.25f); }
                    unsigned o0 = __builtin_amdgcn_cvt_pk_fp8_f32(c8(v0[0]), c8(v0[1]), 0, false); o0 = __builtin_amdgcn_cvt_pk_fp8_f32(c8(v0[2]), c8(v0[3]), o0, true);
                    unsigned o1 = __builtin_amdgcn_cvt_pk_fp8_f32(c8(v1[0]), c8(v1[1]), 0, false); o1 = __builtin_amdgcn_cvt_pk_fp8_f32(c8(v1[2]), c8(v1[3]), o1, true);
                    typedef unsigned u32x2_ __attribute__((ext_vector_type(2)));
                    *(u32x2_*)p = (u32x2_){o0, o1}; } }
    }
};
struct EpiMoe2 {
    static constexpr bool PERM = true; static constexpr bool PERM64 = true; static constexpr int NST = 0;
    unsigned char* wsb; const LAS unsigned* tb;
    __device__ __forceinline__ void operator()(const f32x4 (&acc)[2][2][4][2], const UnitG& u, int wr, int wc, int fr_, int fq_, PG8_LAS unsigned char* lds, int par) const {
        int t_ = (int)threadIdx.x; asm volatile("" : "+v"(t_));
        const int fr = t_ & 15, fq = (t_ >> 4) & 3;
        const int cnt = (int)tb[TB_CNT + u.seg] - 256 * u.mt; const unsigned colt = (unsigned)(u.nt * 256 + wc * 64 + 16 * fq); const int rl0 = wr * 64 + fr;
        unsigned off[8]; float w[8];
        if (u.seg < 64) { const PG8_LAS unsigned* mslot = (const PG8_LAS unsigned*)(lds + STAGE_BYTES + par * 2048); const PG8_LAS float* mw = (const PG8_LAS float*)(lds + STAGE_BYTES + par * 2048 + 1024);
#pragma unroll
            for (int k = 0; k < 8; ++k) { const int rl = rl0 + (k >> 2) * HALF + (k & 3) * 16; const unsigned sl = mslot[rl]; w[k] = mw[rl] * 0.25f;
                off[k] = (sl < 65536u ? (unsigned)WS_Y0 : (unsigned)(WS_Y1 - (size_t)65536 * 1024)) + sl * 1024u + colt; }
        } else {
#pragma unroll
            for (int k = 0; k < 8; ++k) { const int rl = rl0 + (k >> 2) * HALF + (k & 3) * 16; w[k] = 0.25f; off[k] = (unsigned)WS_YS + (unsigned)(256 * u.mt + rl) * 1024u + colt; }
        }
#pragma unroll
        for (int k = 0; k < 8; ++k) { const int ai = k >> 2, m = k & 3, rl = rl0 + ai * HALF + m * 16;
            if (rl < cnt) { unsigned o[4];
#pragma unroll
                for (int bj = 0; bj < 2; ++bj) { const f32x4 v0 = acc[ai][bj][m][0] * w[k], v1 = acc[ai][bj][m][1] * w[k];
                    unsigned o0 = __builtin_amdgcn_cvt_pk_fp8_f32(v0[0], v0[1], 0, false); o0 = __builtin_amdgcn_cvt_pk_fp8_f32(v0[2], v0[3], o0, true);
                    unsigned o1 = __builtin_amdgcn_cvt_pk_fp8_f32(v1[0], v1[1], 0, false); o1 = __builtin_amdgcn_cvt_pk_fp8_f32(v1[2], v1[3], o1, true);
                    o[2 * bj] = o0; o[2 * bj + 1] = o1; }
                *(u32x4*)(wsb + off[k]) = (u32x4){o[0], o[1], o[2], o[3]}; } }
    }
};
}

struct TrItem { const float* W; int ldw, src_col; bf16* WT; int K, dst_row, k0; float f8scale; };
__device__ __forceinline__ void tr_load(const TrItem& t, int lane, f32x4 (&v)[8]) {
#pragma unroll
    for (int i = 0; i < 8; ++i) v[i] = *(const GAS f32x4*)(t.W + (size_t)(t.k0 + 8 * i + (lane >> 3)) * t.ldw + t.src_col + 4 * (lane & 7));
}
__device__ __forceinline__ void tr_finish(const TrItem& t, int lane, const f32x4 (&v)[8], LAS float* scr) {
#pragma unroll
    for (int i = 0; i < 8; ++i) { LAS float* p = scr + (8 * i + (lane >> 3)) * 33 + 4 * (lane & 7); p[0] = v[i][0]; p[1] = v[i][1]; p[2] = v[i][2]; p[3] = v[i][3]; }
    LDS_WAIT(); asm volatile("" ::: "memory");
    const int c = lane & 7;
#pragma unroll
    for (int j = 0; j < 4; ++j) { const int n = (lane >> 3) + 8 * j; const LAS float* s = scr + (8 * c) * 33 + n;
        if (t.f8scale != 0.f) { const float q = t.f8scale; typedef unsigned u32x2_ __attribute__((ext_vector_type(2)));
            unsigned o0 = __builtin_amdgcn_cvt_pk_fp8_f32(s[0 * 33] * q, s[1 * 33] * q, 0, false); o0 = __builtin_amdgcn_cvt_pk_fp8_f32(s[2 * 33] * q, s[3 * 33] * q, o0, true);
            unsigned o1 = __builtin_amdgcn_cvt_pk_fp8_f32(s[4 * 33] * q, s[5 * 33] * q, 0, false); o1 = __builtin_amdgcn_cvt_pk_fp8_f32(s[6 * 33] * q, s[7 * 33] * q, o1, true);
            *(GAS u32x2_*)((GAS unsigned char*)t.WT + (size_t)(t.dst_row + n) * t.K + t.k0 + 8 * c) = (u32x2_){o0, o1};
        } else {
        v4u o; o.x = pk2(s[0 * 33], s[1 * 33]); o.y = pk2(s[2 * 33], s[3 * 33]); o.z = pk2(s[4 * 33], s[5 * 33]); o.w = pk2(s[6 * 33], s[7 * 33]);
        *(GAS v4u*)(t.WT + (size_t)(t.dst_row + n) * t.K + t.k0 + 8 * c) = o; } }
    LDS_WAIT(); asm volatile("" ::: "memory");
}
#define TR_LOOP(it0, stride, nitems, MAKE) do { int it_ = (it0); if (it_ < (nitems)) { TrItem cur_ = MAKE(it_); f32x4 va_[8], vb_[8]; tr_load(cur_, lane, va_); \
    for (;;) { const int nx_ = it_ + (stride); const bool hn_ = nx_ < (nitems); TrItem nxt_ = cur_; if (hn_) { nxt_ = MAKE(nx_); tr_load(nxt_, lane, vb_); } \
        tr_finish(cur_, lane, va_, scr); if (!hn_) break; _Pragma("unroll") for (int q_ = 0; q_ < 8; ++q_) va_[q_] = vb_[q_]; cur_ = nxt_; it_ = nx_; } } } while (0)

#ifndef REP_PHASE
#define REP_PHASE -1
#endif
#ifndef REP_N
#define REP_N 1
#endif
#define REPN(k) ((k) == REP_PHASE ? REP_N : 1)

constexpr int UNITS = BATCH * 128 * 4;
constexpr int L_QN = 0, L_KN = 17408, L_VV = 34816, L_LM = 52224, L_ATT = 68608, L_UT = 77824, L_WT = 96256, L_KTT = 114688, L_GCS = 133120, L_EGS = 133376, L_BET = 133632, L_SCW = 133888, L_SKT = 134144, L_CW = 134400  , L_TM = L_KN, L_TB = L_VV;
constexpr int H_FR = 0, H_QR = 17408, H_QE = 34816, H_KD = 52224, H_KTT = 69632, H_VT = 88064, H_AM = 106496;
constexpr int RS = 272, TS = 144;

typedef unsigned v2u __attribute__((ext_vector_type(2)));
#define LBAR() do { asm volatile("s_waitcnt lgkmcnt(0)" ::: "memory"); __builtin_amdgcn_s_barrier(); asm volatile("" ::: "memory"); } while (0)
__device__ __forceinline__ f32x4 mfma16(bf16x8 a, bf16x8 b, f32x4 c) { return __builtin_amdgcn_mfma_f32_16x16x32_bf16(a, b, c, 0, 0, 0); }
__device__ __forceinline__ bf16x8 ldsfrag(const LAS unsigned char* base, int row, int stride, int kbyte) { return *(const LAS bf16x8*)(base + row * stride + kbyte); }
__device__ __forceinline__ void unpack8(const v4u q, float (&f)[8]) {
    f[0] = __uint_as_float(q.x << 16); f[1] = __uint_as_float(q.x & 0xffff0000u); f[2] = __uint_as_float(q.y << 16); f[3] = __uint_as_float(q.y & 0xffff0000u);
    f[4] = __uint_as_float(q.z << 16); f[5] = __uint_as_float(q.z & 0xffff0000u); f[6] = __uint_as_float(q.w << 16); f[7] = __uint_as_float(q.w & 0xffff0000u); }
__device__ __forceinline__ f32x4 unpack4(const v2u q) { return (f32x4){__uint_as_float(q.x << 16), __uint_as_float(q.x & 0xffff0000u), __uint_as_float(q.y << 16), __uint_as_float(q.y & 0xffff0000u)}; }
__device__ __forceinline__ v2u pack4(const f32x4 v) { v2u o; o.x = pk2(v[0], v[1]); o.y = pk2(v[2], v[3]); return o; }
__device__ __forceinline__ float ldsbf(const LAS unsigned char* base, int row, int stride, int col) { return __uint_as_float(((unsigned)*(const LAS unsigned short*)(base + row * stride + col * 2)) << 16); }

struct MixPtrs {
    const bf16* projA; const bf16* gates; const float* ab; const float* conv_w; const float* a_log; const float* dt_bias; const float* hg_lb; const float* gdn_nw; const float* hg_nw;
    bf16 *PG, *BG, *QP, *OI, *BH, *QE, *OIH, *SG, *SH, *omix; float *GL, *AH;
};

__device__ __forceinline__ void p3_stage_conv(LAS unsigned char* lds, const MixPtrs& X, int h, int tid) {
    for (int idx = tid; idx < 1536; idx += NWAVES * 64) { const int d = idx & 127, jt = idx >> 7, j = jt / 3, tz = jt % 3; *(LAS float*)(lds + L_CW + idx * 4) = X.conv_w[j * 1536 + tz * 512 + h * 128 + d]; }
}
__device__ __forceinline__ void p3_gdn_unit(LAS unsigned char* lds, const MixPtrs& X, int unit, int tid, int lane, int wave) {
    const int h = unit & 3, n = (unit >> 2) & 127, b = unit >> 9, r = lane & 15, g = lane >> 4;
    const size_t tok0 = (size_t)b * T + (size_t)n * 64;
    LAS float* gcs = (LAS float*)(lds + L_GCS); LAS float* egs = (LAS float*)(lds + L_EGS); LAS float* bet = (LAS float*)(lds + L_BET);
    {
        const int ch = tid & 15, p = tid >> 4;
        v4u raw[3][5];
#pragma unroll
        for (int tz = 0; tz < 3; ++tz)
#pragma unroll
            for (int j = 0; j < 5; ++j) { const int tl = n * 64 + 2 * p - 3 + j; raw[tz][j] = *(const GAS v4u*)(X.projA + ((size_t)b * T + (tl < 0 ? 0 : tl)) * PA + tz * 512 + h * 128 + ch * 8); }
        if (n == 0) {
#pragma unroll
            for (int tz = 0; tz < 3; ++tz)
#pragma unroll
                for (int j = 0; j < 3; ++j) if (2 * p - 3 + j < 0) { raw[tz][j].x = 0u; raw[tz][j].y = 0u; raw[tz][j].z = 0u; raw[tz][j].w = 0u; }
        }
        if (wave == 0) {
            const float araw = X.ab[(tok0 + lane) * 8 + 4 + h], braw = X.ab[(tok0 + lane) * 8 + h];
            const float xs = araw + X.dt_bias[h];
            float gv = -__expf(X.a_log[h]) * (fmaxf(xs, 0.f) + __logf(1.f + __expf(-fabsf(xs))));
            gv += dpp_shr0<0x111>(gv); gv += dpp_shr0<0x112>(gv); gv += dpp_shr0<0x114>(gv); gv += dpp_shr0<0x118>(gv);
            { const float t0 = rdlane(gv, 15), t1 = rdlane(gv, 31), t2 = rdlane(gv, 47); gv += (lane >= 16 ? t0 : 0.f) + (lane >= 32 ? t1 : 0.f) + (lane >= 48 ? t2 : 0.f); }
            { const float eg_ = __expf(gv), be_ = sigmoidf_(braw); gcs[lane] = gv; egs[lane] = eg_; bet[lane] = be_; *(LAS float*)(lds + L_SCW + lane * 4) = be_ * eg_; *(LAS float*)(lds + L_SKT + lane * 4) = __expf(rdlane(gv, 63) - gv); }
            if (lane == 63) X.GL[unit] = gv;
        }
#pragma unroll
        for (int tz = 0; tz < 3; ++tz) {
            f32x4 w0[4], w1[4];
#pragma unroll
            for (int j = 0; j < 4; ++j) { w0[j] = *(const LAS f32x4*)(lds + L_CW + ((j * 3 + tz) * 128 + ch * 8) * 4); w1[j] = *(const LAS f32x4*)(lds + L_CW + ((j * 3 + tz) * 128 + ch * 8 + 4) * 4); }
            float y[2][8];
#pragma unroll
            for (int o = 0; o < 2; ++o)
#pragma unroll
                for (int e = 0; e < 8; ++e) y[o][e] = 0.f;
#pragma unroll
            for (int j = 0; j < 5; ++j) { float xf[8]; unpack8(raw[tz][j], xf);
#pragma unroll
                for (int o = 0; o < 2; ++o) { const int tap = j - o; if (tap >= 0 && tap < 4) {
#pragma unroll
                    for (int e = 0; e < 4; ++e) { y[o][e] += w0[tap][e] * xf[e]; y[o][4 + e] += w1[tap][e] * xf[4 + e]; } } } }
#pragma unroll
            for (int o = 0; o < 2; ++o) { float ss = 0.f;
#pragma unroll
                for (int e = 0; e < 8; ++e) { y[o][e] = siluf_(y[o][e]); ss += y[o][e] * y[o][e]; }
                float rn = 1.f;
                if (tz < 2) { ss += dppf<0xB1>(ss); ss += dppf<0x4E>(ss); ss += dppf<0x141>(ss); ss += dppf<0x140>(ss); rn = __builtin_amdgcn_rsqf(ss + 1e-6f) * (tz == 0 ? 0.08838834764831845f : 1.f); }
                v4u ov; ov.x = pk2(y[o][0] * rn, y[o][1] * rn); ov.y = pk2(y[o][2] * rn, y[o][3] * rn); ov.z = pk2(y[o][4] * rn, y[o][5] * rn); ov.w = pk2(y[o][6] * rn, y[o][7] * rn);
                *(LAS v4u*)(lds + (tz == 0 ? L_QN : (tz == 1 ? L_KN : L_VV)) + (2 * p + o) * RS + ch * 16) = ov; }
        }
    }
    LBAR();
    {
        const int mt = wave >> 1;
#pragma unroll
        for (int q = 0; q < 2; ++q) { const int ntc = 2 * (wave & 1) + q; f32x4 akk = {0.f, 0.f, 0.f, 0.f}, aqk = {0.f, 0.f, 0.f, 0.f};
#pragma unroll
            for (int ks = 0; ks < 4; ++ks) { const bf16x8 ka = ldsfrag(lds + L_KN, 16 * mt + r, RS, 64 * ks + 16 * g), qa = ldsfrag(lds + L_QN, 16 * mt + r, RS, 64 * ks + 16 * g), kb = ldsfrag(lds + L_KN, 16 * ntc + r, RS, 64 * ks + 16 * g);
                akk = mfma16(ka, kb, akk); aqk = mfma16(qa, kb, aqk); }
            const int j = 16 * ntc + r; const float gj = gcs[j];
#pragma unroll
            for (int ii = 0; ii < 4; ++ii) { const int i = 16 * mt + 4 * g + ii; const float dec = (i >= j) ? __expf(gcs[i] - gj) : 0.f;
                *(LAS float*)(lds + L_LM + (i * 64 + j) * 4) = (i > j) ? bet[i] * akk[ii] * dec : 0.f;
                *(LAS unsigned short*)(lds + L_ATT + i * TS + j * 2) = (unsigned short)f2bf(aqk[ii] * dec); } }
    }
    LBAR();
#pragma unroll
    for (int i = 0; i < 2; ++i) { const int tsk = tid + 512 * i;
        if (tsk < 768) { const int a = tsk >> 8, hh = (tsk >> 7) & 1, d = tsk & 127;
            const LAS unsigned char* sp = lds + (a == 0 ? L_VV : L_KN) + d * 2; const LAS float* scl = (const LAS float*)(lds + (a == 0 ? L_BET : (a == 1 ? L_SCW : L_SKT)));
            LAS unsigned char* dp = lds + (a == 0 ? L_UT : (a == 1 ? L_WT : L_KTT)) + d * TS + 64 * hh;
#pragma unroll
            for (int q = 0; q < 4; ++q) { float kv[8];
#pragma unroll
                for (int e = 0; e < 8; ++e) { const int c = 32 * hh + 8 * q + e; kv[e] = __uint_as_float(((unsigned)*(const LAS unsigned short*)(sp + c * RS)) << 16) * scl[c]; }
                v4u o; o.x = pk2(kv[0], kv[1]); o.y = pk2(kv[2], kv[3]); o.z = pk2(kv[4], kv[5]); o.w = pk2(kv[6], kv[7]); *(LAS v4u*)(dp + 16 * q) = o; } } }
    LBAR();
    { const LAS float* Lm = (const LAS float*)(lds + L_LM); LAS float* Tm = (LAS float*)(lds + L_TM);
      if (tid < 64) { const int I = tid >> 4, j = tid & 15; float x[16];
#pragma unroll
          for (int i = 0; i < 16; ++i) { float s = (i == j) ? 1.f : 0.f;
#pragma unroll
              for (int kb = 0; kb < (i + 3) / 4; ++kb) { const f32x4 l = *(const LAS f32x4*)(Lm + (16 * I + i) * 64 + 16 * I + 4 * kb);
#pragma unroll
                  for (int e = 0; e < 4; ++e) if (4 * kb + e < i) s -= l[e] * x[4 * kb + e]; }
              x[i] = (i < j) ? 0.f : s; Tm[(16 * I + i) * 64 + 16 * I + j] = x[i]; } }
      LBAR();
      { const int r = lane & 15, g = lane >> 4;
#pragma unroll 1
      for (int lv = 1; lv < 4; ++lv) {
          if (wave < 4 - lv) { const int I = lv + wave, J = wave; f32x4 acc = {0.f, 0.f, 0.f, 0.f};
              for (int K = J; K < I; ++K) { const f32x4 a = *(const LAS f32x4*)(Lm + (16 * I + r) * 64 + 16 * K + 4 * g); float bq[4];
#pragma unroll
                  for (int s = 0; s < 4; ++s) bq[s] = Tm[(16 * K + 4 * g + s) * 64 + 16 * J + r];
#pragma unroll
                  for (int s = 0; s < 4; ++s) acc = __builtin_amdgcn_mfma_f32_16x16x4f32(a[s], bq[s], acc, 0, 0, 0); }
#pragma unroll
              for (int i = 0; i < 4; ++i) Tm[(16 * J + 4 * g + i) * 64 + 16 * I + r] = acc[i]; }
          LBAR();
          if (wave < 4 - lv) { const int I = lv + wave, J = wave; f32x4 acc = {0.f, 0.f, 0.f, 0.f};
              const f32x4 a = *(const LAS f32x4*)(Tm + (16 * I + r) * 64 + 16 * I + 4 * g); float bq[4];
#pragma unroll
              for (int s = 0; s < 4; ++s) bq[s] = Tm[(16 * J + 4 * g + s) * 64 + 16 * I + r];
#pragma unroll
              for (int s = 0; s < 4; ++s) acc = __builtin_amdgcn_mfma_f32_16x16x4f32(a[s], bq[s], acc, 0, 0, 0);
#pragma unroll
              for (int i = 0; i < 4; ++i) Tm[(16 * I + 4 * g + i) * 64 + 16 * J + r] = -acc[i]; }
          LBAR();
      } }
      { const int i = tid >> 3, j0 = (tid & 7) * 8; const f32x4 t0 = *(const LAS f32x4*)(Tm + i * 64 + j0), t1 = *(const LAS f32x4*)(Tm + i * 64 + j0 + 4); const bool keep = (i >> 4) >= (j0 >> 4);
        v4u o; o.x = keep ? pk2(t0[0], t0[1]) : 0u; o.y = keep ? pk2(t0[2], t0[3]) : 0u; o.z = keep ? pk2(t1[0], t1[1]) : 0u; o.w = keep ? pk2(t1[2], t1[3]) : 0u;
        *(LAS v4u*)(lds + L_TB + i * TS + j0 * 2) = o; }
      LBAR();
    }
    { bf16x8 af[4][2];
#pragma unroll
      for (int mt = 0; mt < 4; ++mt)
#pragma unroll
          for (int ks = 0; ks < 2; ++ks) af[mt][ks] = ldsfrag(lds + L_TB, 16 * mt + r, TS, 64 * ks + 16 * g);
#pragma unroll
      for (int q = 0; q < 2; ++q) { const int ng = 2 * wave + q; LAS unsigned char* base = lds + (ng >= 8 ? L_WT : L_UT) + (16 * (ng & 7) + r) * TS;
          const bf16x8 b0 = *(const LAS bf16x8*)(base + 16 * g), b1 = *(const LAS bf16x8*)(base + 64 + 16 * g);
          f32x4 acc[4];
#pragma unroll
          for (int mt = 0; mt < 4; ++mt) { acc[mt] = mfma16(af[mt][0], b0, (f32x4){0.f, 0.f, 0.f, 0.f}); acc[mt] = mfma16(af[mt][1], b1, acc[mt]); }
          asm volatile("s_waitcnt lgkmcnt(0)" ::: "memory");
#pragma unroll
          for (int mt = 0; mt < 4; ++mt) *(LAS v2u*)(base + (16 * mt + 4 * g) * 2) = pack4(acc[mt]); }
    }
    LBAR();
    {
        const size_t u16 = (size_t)unit * 16384, u8 = (size_t)unit * 8192;
        { const int kk = wave >> 1;
          bf16x8 af[2][2];
#pragma unroll
          for (int t2 = 0; t2 < 2; ++t2)
#pragma unroll
              for (int ks = 0; ks < 2; ++ks) af[t2][ks] = ldsfrag(lds + L_WT, 16 * (2 * kk + t2) + r, TS, 64 * ks + 16 * g);
#pragma unroll
          for (int q = 0; q < 4; ++q) { const int nt = 4 * (wave & 1) + q; f32x4 a0 = {0.f, 0.f, 0.f, 0.f}, a1 = {0.f, 0.f, 0.f, 0.f};
#pragma unroll
              for (int ks = 0; ks < 2; ++ks) { const bf16x8 bfr = ldsfrag(lds + L_KTT, 16 * nt + r, TS, 64 * ks + 16 * g); a0 = mfma16(af[0][ks], bfr, a0); a1 = mfma16(af[1][ks], bfr, a1); }
              v2u o; o.x = __builtin_amdgcn_cvt_pk_fp8_f32(-16.f * a0[0], -16.f * a0[1], 0, false); o.x = __builtin_amdgcn_cvt_pk_fp8_f32(-16.f * a0[2], -16.f * a0[3], o.x, true);
              o.y = __builtin_amdgcn_cvt_pk_fp8_f32(-16.f * a1[0], -16.f * a1[1], 0, false); o.y = __builtin_amdgcn_cvt_pk_fp8_f32(-16.f * a1[2], -16.f * a1[3], o.y, true);
              *(GAS v2u*)((GAS unsigned char*)X.PG + (size_t)unit * 16384 + ((size_t)(nt * 4 + kk) * 64 + lane) * 8) = o; } }
        { const int mt = wave; bf16x8 af[2];
#pragma unroll
          for (int ks = 0; ks < 2; ++ks) af[ks] = ldsfrag(lds + L_KTT, 16 * mt + r, TS, 64 * ks + 16 * g);
#pragma unroll
          for (int nt = 0; nt < 8; ++nt) { f32x4 a0 = {0.f, 0.f, 0.f, 0.f};
#pragma unroll
              for (int ks = 0; ks < 2; ++ks) a0 = mfma16(af[ks], ldsfrag(lds + L_UT, 16 * nt + r, TS, 64 * ks + 16 * g), a0);
              *(GAS v2u*)(X.BG + u16 + ((size_t)(nt * 8 + mt) * 64 + lane) * 4) = pack4(a0); } }
        { const int kk = wave >> 1;
#pragma unroll
          for (int q = 0; q < 2; ++q) { const int ct = 2 * (wave & 1) + q; f32x4 a0 = {0.f, 0.f, 0.f, 0.f}, a1 = {0.f, 0.f, 0.f, 0.f};
#pragma unroll
              for (int ks = 0; ks < 2; ++ks) { const bf16x8 bfr = ldsfrag(lds + L_ATT, 16 * ct + r, TS, 64 * ks + 16 * g);
                  a0 = mfma16(ldsfrag(lds + L_WT, 16 * (2 * kk) + r, TS, 64 * ks + 16 * g), bfr, a0); a1 = mfma16(ldsfrag(lds + L_WT, 16 * (2 * kk + 1) + r, TS, 64 * ks + 16 * g), bfr, a1); }
              const int c = 16 * ct + r; const float eg = egs[c];
              const f32x4 q0 = unpack4(*(const LAS v2u*)(lds + L_QN + c * RS + (32 * kk + 4 * g) * 2)), q1 = unpack4(*(const LAS v2u*)(lds + L_QN + c * RS + (32 * kk + 16 + 4 * g) * 2));
              v4u o; o.x = pk2(q0[0] * eg - a0[0], q0[1] * eg - a0[1]); o.y = pk2(q0[2] * eg - a0[2], q0[3] * eg - a0[3]); o.z = pk2(q1[0] * eg - a1[0], q1[1] * eg - a1[1]); o.w = pk2(q1[2] * eg - a1[2], q1[3] * eg - a1[3]);
              *(GAS v4u*)(X.QP + u8 + ((size_t)(ct * 4 + kk) * 64 + lane) * 8) = o; } }
        { const int vt = wave; bf16x8 af[2];
#pragma unroll
          for (int ks = 0; ks < 2; ++ks) af[ks] = ldsfrag(lds + L_UT, 16 * vt + r, TS, 64 * ks + 16 * g);
#pragma unroll
          for (int ct = 0; ct < 4; ++ct) { f32x4 a0 = {0.f, 0.f, 0.f, 0.f};
#pragma unroll
              for (int ks = 0; ks < 2; ++ks) a0 = mfma16(af[ks], ldsfrag(lds + L_ATT, 16 * ct + r, TS, 64 * ks + 16 * g), a0);
              *(GAS v2u*)(X.OI + u8 + ((size_t)(vt * 4 + ct) * 64 + lane) * 4) = pack4(a0); } }
    }
    LBAR();
}

__device__ __forceinline__ void p3_hgrn_unit(LAS unsigned char* lds, const MixPtrs& X, int unit, int tid, int lane, int wave) {
    const int h = unit & 3, n = (unit >> 2) & 127, b = unit >> 9, r = lane & 15, g = lane >> 4;
    const size_t tok0 = (size_t)b * T + (size_t)n * 64;
#pragma unroll
    for (int i = 0; i < 4; ++i) { const int pair = (tid >> 4) + 32 * i, tz = pair >> 6, c = pair & 63, ch = tid & 15;
        const v4u q = *(const GAS v4u*)(X.projA + (tok0 + c) * PA + (tz ? 2560 : 1536) + h * 128 + ch * 8);
        *(LAS v4u*)(lds + (tz ? H_QR : H_FR) + c * RS + ch * 16) = q; }
    {
        v4u rv[2];
#pragma unroll
        for (int i = 0; i < 2; ++i) { const int item = tid + 512 * i, c = item >> 4, ch = item & 15; rv[i] = *(const GAS v4u*)(X.projA + (tok0 + c) * PA + 2048 + h * 128 + ch * 8); }
#pragma unroll
        for (int i = 0; i < 2; ++i) { const int item = tid + 512 * i, c = item >> 4, ch = item & 15; const unsigned w[4] = {rv[i].x, rv[i].y, rv[i].z, rv[i].w};
#pragma unroll
            for (int e = 0; e < 4; ++e) { *(LAS unsigned short*)(lds + H_VT + (ch * 8 + 2 * e) * TS + c * 2) = (unsigned short)(w[e] & 0xffffu); *(LAS unsigned short*)(lds + H_VT + (ch * 8 + 2 * e + 1) * TS + c * 2) = (unsigned short)(w[e] >> 16); } }
    }
    LBAR();
    {
        const int d = tid & 127, seg = tid >> 7; LAS float* segt = (LAS float*)(lds + H_AM + 9216);
        const float l0 = X.hg_lb[h * 128 + d], l1 = X.hg_lb[512 + h * 128 + d]; const float mx = fmaxf(l0, l1); const float e0 = __expf(l0 - mx), e1 = __expf(l1 - mx); const float lb = e0 * frcp_(e0 + e1);
        float lc[16], kq[16]; float run = 0.f;
#pragma unroll
        for (int ci = 0; ci < 16; ++ci) { const float sg = sigmoidf_(ldsbf(lds + H_FR, 16 * seg + ci, RS, d)); run += __logf(lb + (1.f - lb) * sg); lc[ci] = run; kq[ci] = (1.f - lb) * (1.f - sg); }
        segt[seg * 128 + d] = run;
        LBAR();
        const float t0 = segt[d], t1 = segt[128 + d], t2 = segt[256 + d], t3 = segt[384 + d];
        const float off = (seg > 0 ? t0 : 0.f) + (seg > 1 ? t1 : 0.f) + (seg > 2 ? t2 : 0.f), btot = (t0 + t1) + (t2 + t3);
        float kv[16]; const float ebt = __expf(btot);
#pragma unroll
        for (int ci = 0; ci < 16; ++ci) { const int c = 16 * seg + ci; const float bb = off + lc[ci];
            const float eb = __expf(bb), kd = kq[ci] * frcp_(eb);
            *(LAS unsigned short*)(lds + H_QE + c * RS + d * 2) = (unsigned short)f2bf(siluf_(ldsbf(lds + H_QR, c, RS, d)) * eb);
            *(LAS unsigned short*)(lds + H_KD + c * RS + d * 2) = (unsigned short)f2bf(kd);
            kv[ci] = kd * ebt; }
        if (seg == 0) X.AH[(size_t)unit * 128 + d] = ebt;
#pragma unroll
        for (int q = 0; q < 2; ++q) { v4u o; o.x = pk2(kv[8 * q], kv[8 * q + 1]); o.y = pk2(kv[8 * q + 2], kv[8 * q + 3]); o.z = pk2(kv[8 * q + 4], kv[8 * q + 5]); o.w = pk2(kv[8 * q + 6], kv[8 * q + 7]);
            *(LAS v4u*)(lds + H_KTT + d * TS + (16 * seg + 8 * q) * 2) = o; }
    }
    LBAR();
    {
        const int mt = wave >> 1;
#pragma unroll
        for (int q = 0; q < 2; ++q) { const int ntc = 2 * (wave & 1) + q; f32x4 a0 = {0.f, 0.f, 0.f, 0.f};
#pragma unroll
            for (int ks = 0; ks < 4; ++ks) a0 = mfma16(ldsfrag(lds + H_QE, 16 * mt + r, RS, 64 * ks + 16 * g), ldsfrag(lds + H_KD, 16 * ntc + r, RS, 64 * ks + 16 * g), a0);
            const int j = 16 * ntc + r;
#pragma unroll
            for (int ii = 0; ii < 4; ++ii) { const int i = 16 * mt + 4 * g + ii; *(LAS unsigned short*)(lds + H_AM + i * TS + j * 2) = (unsigned short)f2bf((i >= j) ? a0[ii] : 0.f); } }
    }
    LBAR();
    {
        const size_t u16 = (size_t)unit * 16384, u8 = (size_t)unit * 8192;
        { const int mt = wave; bf16x8 af[2];
#pragma unroll
          for (int ks = 0; ks < 2; ++ks) af[ks] = ldsfrag(lds + H_KTT, 16 * mt + r, TS, 64 * ks + 16 * g);
#pragma unroll
          for (int nt = 0; nt < 8; ++nt) { f32x4 a0 = {0.f, 0.f, 0.f, 0.f};
#pragma unroll
              for (int ks = 0; ks < 2; ++ks) a0 = mfma16(af[ks], ldsfrag(lds + H_VT, 16 * nt + r, TS, 64 * ks + 16 * g), a0);
              *(GAS v2u*)(X.BH + u16 + ((size_t)(nt * 8 + mt) * 64 + lane) * 4) = pack4(a0); } }
        { const int vt = wave; bf16x8 af[2];
#pragma unroll
          for (int ks = 0; ks < 2; ++ks) af[ks] = ldsfrag(lds + H_VT, 16 * vt + r, TS, 64 * ks + 16 * g);
#pragma unroll
          for (int ct = 0; ct < 4; ++ct) { f32x4 a0 = {0.f, 0.f, 0.f, 0.f};
#pragma unroll
              for (int ks = 0; ks < 2; ++ks) a0 = mfma16(af[ks], ldsfrag(lds + H_AM, 16 * ct + r, TS, 64 * ks + 16 * g), a0);
              *(GAS v2u*)(X.OIH + u8 + ((size_t)(vt * 4 + ct) * 64 + lane) * 4) = pack4(a0); } }
#pragma unroll
        for (int q = 0; q < 2; ++q) { const int idx = wave * 2 + q, ct = idx >> 2, kk = idx & 3, c = 16 * ct + r;
            const v2u q0 = *(const LAS v2u*)(lds + H_QE + c * RS + (32 * kk + 4 * g) * 2), q1 = *(const LAS v2u*)(lds + H_QE + c * RS + (32 * kk + 16 + 4 * g) * 2);
            v4u o; o.x = q0.x; o.y = q0.y; o.z = q1.x; o.w = q1.y;
            *(GAS v4u*)(X.QE + u8 + ((size_t)(ct * 4 + kk) * 64 + lane) * 8) = o; }
    }
    LBAR();
}

__device__ __forceinline__ void p4_gdn_scan(LAS unsigned char* lds, const MixPtrs& X, int job, int lane, int wave) {
    const int s = job >> 3, h = job & 3, b = (job >> 2) & 1;
    const int unit0 = (b * 128) * 4 + h;
    constexpr int F8RING = 0, BRING = 131072, GLOFF = BRING + 6 * 4096;
    if (wave >= 4) {
        const int lw = wave - 4;
        const char* src0 = (const char*)X.PG + (size_t)unit0 * 16384 + lw * 4096 + lane * 16;
        const char* bsrc0 = (const char*)(X.BG + (size_t)unit0 * 16384 + (size_t)(s * 8) * 256) + lw * 1024 + lane * 16;
#define P4_ISSUE(n_) do { const char* s_ = src0 + (size_t)(n_) * (4 * 16384); _Pragma("unroll") for (int i_ = 0; i_ < 4; ++i_) \
        __builtin_amdgcn_global_load_lds((const unsigned*)(s_ + i_ * 1024), (LAS unsigned*)(lds + F8RING + ((n_) & 7) * 16384 + lw * 4096 + i_ * 1024), 16, 0, 2); \
        __builtin_amdgcn_global_load_lds((const unsigned*)(bsrc0 + (size_t)(n_) * (4 * 32768)), (LAS unsigned*)(lds + BRING + ((n_) % 6) * 4096 + lw * 1024), 16, 0, 0); } while (0)
        P4_ISSUE(0); P4_ISSUE(1); P4_ISSUE(2); P4_ISSUE(3); P4_ISSUE(4);
        asm volatile("s_waitcnt vmcnt(20)" ::: "memory");
#pragma unroll 1
        for (int n = 0; n < 128; ++n) {
            __builtin_amdgcn_s_barrier();
            asm volatile("" ::: "memory");
            if (n + 5 < 128) P4_ISSUE(n + 5);
            if (n + 1 < 128) {
                if (n + 5 < 128) asm volatile("s_waitcnt vmcnt(20)" ::: "memory"); else if (n + 4 < 128) asm volatile("s_waitcnt vmcnt(15)" ::: "memory"); else if (n + 3 < 128) asm volatile("s_waitcnt vmcnt(10)" ::: "memory");
                else if (n + 2 < 128) asm volatile("s_waitcnt vmcnt(5)" ::: "memory"); else asm volatile("s_waitcnt vmcnt(0)" ::: "memory");
            }
        }
#undef P4_ISSUE
    } else if (wave == 0) {
        f32x4 S[8]; v2u sb8[4];
#pragma unroll
        for (int mt = 0; mt < 8; ++mt) S[mt] = (f32x4){0.f, 0.f, 0.f, 0.f};
#pragma unroll
        for (int kk = 0; kk < 4; ++kk) { sb8[kk] = (v2u){0u, 0u}; v4u z; z.x = 0; z.y = 0; z.z = 0; z.w = 0; *(GAS v4u*)(X.SG + (size_t)unit0 * 16384 + ((size_t)(s * 4 + kk) * 64 + lane) * 8) = z; }
        { const float g0 = X.GL[unit0 + 4 * lane], g1 = X.GL[unit0 + 4 * (64 + lane)]; *(LAS float*)(lds + GLOFF + lane * 4) = g0; *(LAS float*)(lds + GLOFF + (64 + lane) * 4) = g1; }
        asm volatile("s_waitcnt vmcnt(0) lgkmcnt(0)" ::: "memory");
#pragma unroll 1
        for (int n = 0; n < 128; ++n) {
            const int unit = unit0 + 4 * n;
            __builtin_amdgcn_s_barrier();
            asm volatile("" ::: "memory");
            const float e = __expf(*(const LAS float*)(lds + GLOFF + n * 4));
            const LAS unsigned char* bb = lds + BRING + (n % 6) * 4096 + lane * 8;
            f32x4 acc[8];
#pragma unroll
            for (int mt = 0; mt < 8; ++mt) acc[mt] = (f32x4){0.f, 0.f, 0.f, 0.f};
            const LAS unsigned char* pb = lds + F8RING + (n & 7) * 16384 + lane * 8;
#pragma unroll
            for (int kk = 0; kk < 4; ++kk)
#pragma unroll
                for (int mt = 0; mt < 8; ++mt) acc[mt] = __builtin_amdgcn_mfma_f32_16x16x32_fp8_fp8(__builtin_bit_cast(long, *(const LAS v2u*)(pb + (mt * 4 + kk) * 512)), __builtin_bit_cast(long, sb8[kk]), acc[mt], 0, 0, 0);
#pragma unroll
            for (int mt = 0; mt < 8; ++mt) S[mt] = S[mt] * e + unpack4(*(const LAS v2u*)(bb + mt * 512)) + acc[mt] * 0.00390625f;
#pragma unroll
            for (int kk = 0; kk < 4; ++kk) { const f32x4 a = S[2 * kk], c = S[2 * kk + 1];
                unsigned w0 = __builtin_amdgcn_cvt_pk_fp8_f32(c8(a[0] * 16.f), c8(a[1] * 16.f), 0, false); w0 = __builtin_amdgcn_cvt_pk_fp8_f32(c8(a[2] * 16.f), c8(a[3] * 16.f), w0, true);
                unsigned w1 = __builtin_amdgcn_cvt_pk_fp8_f32(c8(c[0] * 16.f), c8(c[1] * 16.f), 0, false); w1 = __builtin_amdgcn_cvt_pk_fp8_f32(c8(c[2] * 16.f), c8(c[3] * 16.f), w1, true);
                sb8[kk] = (v2u){w0, w1};
                if (n < 127) { v4u o; o.x = pg8::cvt_pk_bf16(a[0], a[1]); o.y = pg8::cvt_pk_bf16(a[2], a[3]); o.z = pg8::cvt_pk_bf16(c[0], c[1]); o.w = pg8::cvt_pk_bf16(c[2], c[3]);
                    *(GAS v4u*)(X.SG + (size_t)(unit + 4) * 16384 + ((size_t)(s * 4 + kk) * 64 + lane) * 8) = o; } }
            asm volatile("s_waitcnt lgkmcnt(0)" ::: "memory");
        }
    } else {
#pragma unroll 1
        for (int n = 0; n < 128; ++n) { __builtin_amdgcn_s_barrier(); asm volatile("" ::: "memory"); }
    }
}
__device__ __forceinline__ void p4_hgrn_scan(const MixPtrs& X, int task, int lane) {
    const int mt = task & 7, s = (task >> 3) & 7, h = (task >> 6) & 3, b = task >> 8, g = lane >> 4;
    const int unit0 = (b * 128) * 4 + h;
    f32x4 s0 = {0.f, 0.f, 0.f, 0.f};
    const GAS f32x4* ap = (const GAS f32x4*)(X.AH + (size_t)unit0 * 128 + 16 * mt + 4 * g);
    const GAS v2u* bp = (const GAS v2u*)(X.BH + (size_t)unit0 * 16384 + ((size_t)(s * 8 + mt) * 64 + lane) * 4);
    GAS v2u* sp = (GAS v2u*)(X.SH + (size_t)unit0 * 16384 + ((size_t)(s * 4 + (mt >> 1)) * 64 + lane) * 8 + 4 * (mt & 1));
    { v2u z; z.x = 0; z.y = 0; sp[0] = z; }
    f32x4 ra[32]; v2u rb[32];
#pragma unroll
    for (int j = 0; j < 32; ++j) { ra[j] = ap[(size_t)j * 128]; rb[j] = bp[(size_t)j * 16384]; }
#pragma unroll 1
    for (int n0 = 0; n0 < 128; n0 += 32) {
#pragma unroll
        for (int j = 0; j < 32; ++j) { const int n = n0 + j;
            s0 = ra[j] * s0 + unpack4(rb[j]);
            if (n + 32 < 128) { ra[j] = ap[(size_t)(n + 32) * 128]; rb[j] = bp[(size_t)(n + 32) * 16384]; }
            if (n < 127) sp[(size_t)(n + 1) * 16384] = pack4(s0); }
    }
}
__device__ __forceinline__ void p5_unit(LAS unsigned char* lds, const MixPtrs& X, int bn, int lane, int wave) {
    const int hd = wave & 3, type = wave >> 2, r = lane & 15, g = lane >> 4;
    const int unit = bn * 4 + hd; const size_t tok0 = (size_t)bn * 64;
    const bf16* SX = type ? X.SH : X.SG; const bf16* QX = type ? X.QE : X.QP; const bf16* OX = type ? X.OIH : X.OI;
    const size_t u16 = (size_t)unit * 16384, u8 = (size_t)unit * 8192;
    LAS float* exch = (LAS float*)lds;
    const float* nw = type ? X.hg_nw + hd * 128 : X.gdn_nw;
    bf16x8 af[4][8];
#pragma unroll
    for (int kk = 0; kk < 4; ++kk)
#pragma unroll
        for (int vt = 0; vt < 8; ++vt) af[kk][vt] = *(const GAS bf16x8*)(SX + u16 + ((size_t)(vt * 4 + kk) * 64 + lane) * 8);
#pragma unroll 1
    for (int ct = 0; ct < 4; ++ct) {
        bf16x8 bfr[4]; v2u oq[8], gtq[8];
#pragma unroll
        for (int kk = 0; kk < 4; ++kk) bfr[kk] = *(const GAS bf16x8*)(QX + u8 + ((size_t)(ct * 4 + kk) * 64 + lane) * 8);
#pragma unroll
        for (int vt = 0; vt < 8; ++vt) { oq[vt] = *(const GAS v2u*)(OX + u8 + ((size_t)(vt * 4 + ct) * 64 + lane) * 4);
            gtq[vt] = *(const GAS v2u*)(X.gates + (tok0 + 16 * ct + r) * 1024 + type * 512 + hd * 128 + 16 * vt + 4 * g); }
        f32x4 acc[8];
#pragma unroll
        for (int vt = 0; vt < 8; ++vt) acc[vt] = unpack4(oq[vt]);
#pragma unroll
        for (int kk = 0; kk < 4; ++kk)
#pragma unroll
            for (int vt = 0; vt < 8; ++vt) acc[vt] = mfma16(af[kk][vt], bfr[kk], acc[vt]);
        float ssq = 0.f;
#pragma unroll
        for (int vt = 0; vt < 8; ++vt) ssq += (acc[vt][0] * acc[vt][0] + acc[vt][1] * acc[vt][1]) + (acc[vt][2] * acc[vt][2] + acc[vt][3] * acc[vt][3]);
        ssq += __shfl_xor(ssq, 16); ssq += __shfl_xor(ssq, 32);
        if (type == 1 && g == 0) exch[(ct & 1) * 64 + hd * 16 + r] = ssq;
        LBAR();
        float rstd;
        if (type == 1) { const LAS float* ex = exch + (ct & 1) * 64 + r; rstd = rsqrtf(((ex[0] + ex[16]) + (ex[32] + ex[48])) * (1.f / 512.f) + 1e-6f); } else rstd = rsqrtf(ssq * (1.f / 128.f) + 1e-6f);
#pragma unroll
        for (int vt = 0; vt < 8; ++vt) { const f32x4 w4 = *(const GAS f32x4*)(nw + 16 * vt + 4 * g); const size_t off = (tok0 + 16 * ct + r) * 1024 + type * 512 + hd * 128 + 16 * vt + 4 * g;
            const f32x4 gt = unpack4(gtq[vt]); f32x4 o;
#pragma unroll
            for (int e = 0; e < 4; ++e) o[e] = acc[vt][e] * rstd * w4[e] * siluf_(gt[e]);
            *(GAS v2u*)(X.omix + off) = pack4(o); }
    }
    LBAR();
}

struct Args { const float* in[23]; float* out; unsigned char* ws; int ph_lo, ph_hi, li, pad; };

__global__ void __launch_bounds__(NWAVES * 64, 2) mk_fwd(Args args) {
    extern __shared__ __attribute__((aligned(16))) unsigned char lds_raw[];
    LAS unsigned char* lds = (LAS unsigned char*)lds_raw;
    volatile LAS unsigned* MISC = (volatile LAS unsigned*)(lds + MISC_OFF);
    const int tid = threadIdx.x, lane = tid & 63, wave = __builtin_amdgcn_readfirstlane(tid >> 6);
    const int G = gridDim.x, bx = blockIdx.x, vcu = (G % 8 == 0) ? (bx % 8) * (G / 8) + bx / 8 : bx;
    const int gw = vcu * NWAVES + wave, NGW = G * NWAVES;
    unsigned char* ws = args.ws;
    gu32* ctl = (gu32*)(ws + WS_CTL);
    const float* x = args.in[0]; const float* cvec = args.in[1]; const float* w_ada = args.in[2]; const float* b_ada = args.in[3]; const float* norm1_w = args.in[4];
    const float* w_in = args.in[5]; const float* w_out = args.in[12];
    float* mod = (float*)(ws + WS_MOD); float* wab = (float*)(ws + WS_WAB); float* ab = (float*)(ws + WS_AB);
    bf16* wout_t = (bf16*)(ws + WS_WOUT_T); bf16* win_t = (bf16*)(ws + WS_WIN_T); bf16* h1 = (bf16*)(ws + WS_H1); bf16* projA = (bf16*)(ws + WS_PROJA); bf16* gates = (bf16*)(ws + WS_GATES);
    bf16* omix = (bf16*)(ws + WS_OMIX);
    bf16* h2 = (bf16*)(ws + WS_H2); bf16* w1t = (bf16*)(ws + WS_W1T); bf16* w2t = (bf16*)(ws + WS_W2T); bf16* act = (bf16*)(ws + WS_ACT); bf16* y0 = (bf16*)(ws + WS_Y0); bf16* y1 = (bf16*)(ws + WS_Y1);
    MixPtrs X; X.projA = projA; X.gates = gates; X.ab = ab; X.conv_w = args.in[6]; X.a_log = args.in[7]; X.dt_bias = args.in[8]; X.hg_lb = args.in[10]; X.gdn_nw = args.in[9]; X.hg_nw = args.in[11];
    X.PG = (bf16*)(ws + WS_PG); X.BG = (bf16*)(ws + WS_BG); X.QP = (bf16*)(ws + WS_QP); X.OI = (bf16*)(ws + WS_OI); X.BH = (bf16*)(ws + WS_BH); X.QE = (bf16*)(ws + WS_QE); X.OIH = (bf16*)(ws + WS_OIH);
    X.SG = (bf16*)args.out; X.SH = (bf16*)args.out + (size_t)UNITS * 16384; X.omix = omix; X.GL = (float*)(ws + WS_GL); X.AH = (float*)(ws + WS_AH);
    const int* list = (const int*)(ws + WS_LIST); const float* listw = (const float*)(ws + WS_LISTW);
    LAS unsigned* tb = (LAS unsigned*)(lds + SCR2_OFF);

    for (int u = tid; u < (LDS_BYTES - LDSCTL_OFF) / 4; u += NWAVES * 64) ((LAS unsigned*)(lds + LDSCTL_OFF))[u] = 0u;
    __syncthreads();
    XcdBarrier bar = xcd_barrier_post((unsigned*)(ctl + CW_BAR) + args.li * XCD_BAR_WORDS, MISC + 8);
    const int lo = args.ph_lo, hi = args.ph_hi;
#define IN(k) (lo <= (k) && (k) < hi)
#define BOTH(k) (IN(k) && IN((k) + 1))

    if (IN(0)) {
#define PH_BODY do { \
        if (bx < 96) { \
            LAS float* part = (LAS float*)(lds + RING_BYTES); \
            const int e = bx * 64 + lane; float a0 = 0.f, a1 = 0.f; \
_Pragma("unroll 32") \
            for (int d = wave * 128; d < wave * 128 + 128; ++d) { const float w = w_ada[(size_t)d * 6144 + e]; a0 += siluf_(cvec[d]) * w; a1 += siluf_(cvec[D + d]) * w; } \
            part[(wave * 2 + 0) * 64 + lane] = a0; part[(wave * 2 + 1) * 64 + lane] = a1; \
            __syncthreads(); \
            if (tid < 128) { const int bb = tid >> 6, l = tid & 63; float s = 0.f; \
_Pragma("unroll") \
                for (int w = 0; w < 8; ++w) s += part[(w * 2 + bb) * 64 + l]; \
                mod[bb * 6144 + bx * 64 + l] = s + b_ada[bx * 64 + l]; } \
        } else if (bx == 96) { \
            for (int idx = tid; idx < 8192; idx += NWAVES * 64) wab[idx] = w_in[(size_t)(idx >> 3) * DIN + 2048 + (idx & 7)]; \
        } \
        { const float* w_router = args.in[14]; bf16* wrhi = (bf16*)(ws + WS_WRHI); bf16* wrlo = (bf16*)(ws + WS_WRLO); \
          for (int k = gw; k < 1024; k += NGW) { const float w = w_router[k * 64 + lane]; const unsigned hi = f2bf(w); \
              wrhi[lane * 1024 + k] = (bf16)hi; wrlo[lane * 1024 + k] = (bf16)f2bf(w - __uint_as_float(hi << 16)); } } \
        LAS float* scr = (LAS float*)(lds + wave * 16384); \
        constexpr int I_IN = 16 * 128, I_OUT = 16 * 32; \
        auto mk0 = [&](int it) { TrItem t; if (it < I_IN) { const int kb = it / 128, n0 = 32 * (it % 128); const int sc_ = n0 < 1536 ? n0 : (n0 < 3072 ? n0 + 520 : (n0 < 3584 ? n0 - 1536 : n0 + 8)); \
                t.W = w_in; t.ldw = DIN; t.src_col = sc_; t.WT = win_t; t.K = D; t.dst_row = n0; t.k0 = 64 * kb; t.f8scale = 0.f; } \
            else { const int r = it - I_IN, kb = r / 32, n0 = 32 * (r % 32); t.W = w_out; t.ldw = D; t.src_col = n0; t.WT = wout_t; t.K = D; t.dst_row = n0; t.k0 = 64 * kb; t.f8scale = 0.f; } return t; }; \
        TR_LOOP(gw, NGW, I_IN + I_OUT, mk0); \
        if (BOTH(0)) xcd_barrier(bar); \
    } while (0)
        PH_BODY; if (REPN(0) > 1) { PH_BODY; PH_BODY; }
#undef PH_BODY
    }
    if (IN(1)) {
#define PH_BODY do { \
        { \
            const GAS f32x4* wab4 = (const GAS f32x4*)wab; \
            for (int idx = tid; idx < 2048; idx += NWAVES * 64) { const int d = idx >> 1, qh = idx & 1; *(LAS f32x4*)(lds + (((qh * 4 + (d & 3)) * 256 + (d >> 2)) * 16)) = wab4[idx]; } \
            __syncthreads(); \
            const int nrows = (M - gw + NGW - 1) / NGW; \
            f32x4 sclr[4], shfr[4]; int curb = -1; \
            f32x4 vn[2][4]; \
_Pragma("unroll") \
            for (int q = 0; q < 2; ++q) { const int m = gw + q * NGW; \
_Pragma("unroll") \
                for (int j = 0; j < 4; ++j) vn[q][j] = (q < nrows) ? ((const GAS f32x4*)(x + (size_t)m * D) + lane)[64 * j] : (f32x4){0.f, 0.f, 0.f, 0.f}; } \
_Pragma("unroll 1") \
            for (int p = 0; p < nrows; p += 2) { \
                f32x4 v[2][4]; \
_Pragma("unroll") \
                for (int q = 0; q < 2; ++q) \
_Pragma("unroll") \
                    for (int j = 0; j < 4; ++j) v[q][j] = vn[q][j]; \
_Pragma("unroll") \
                for (int q = 0; q < 2; ++q) { const int m = gw + (p + 2 + q) * NGW; \
                    if (p + 2 + q < nrows) { \
_Pragma("unroll") \
                        for (int j = 0; j < 4; ++j) vn[q][j] = ((const GAS f32x4*)(x + (size_t)m * D) + lane)[64 * j]; } } \
_Pragma("unroll") \
                for (int q = 0; q < 2; ++q) { const int m = gw + (p + q) * NGW; \
                    if (p + q < nrows) { \
                        float ss = 0.f; \
_Pragma("unroll") \
                        for (int j = 0; j < 4; ++j) ss += (v[q][j].x * v[q][j].x + v[q][j].y * v[q][j].y) + (v[q][j].z * v[q][j].z + v[q][j].w * v[q][j].w); \
                        const float rstd = __builtin_amdgcn_rsqf(wave_sum(ss) * (1.f / D) + 1e-6f); \
                        const int bsel = m >= T ? 1 : 0; \
                        if (bsel != curb) { curb = bsel; const GAS f32x4* sh4 = (const GAS f32x4*)(mod + bsel * 6144) + lane; \
_Pragma("unroll") \
                            for (int j = 0; j < 4; ++j) { sclr[j] = ((const GAS f32x4*)norm1_w + lane)[64 * j] * (sh4[256 + 64 * j] + 1.0f); shfr[j] = sh4[64 * j]; } } \
                        GAS unsigned long long* o8 = (GAS unsigned long long*)(h1 + (size_t)m * D) + lane; \
                        f32x4 a0 = {0.f, 0.f, 0.f, 0.f}, a1 = {0.f, 0.f, 0.f, 0.f}; \
_Pragma("unroll") \
                        for (int j = 0; j < 4; ++j) { __builtin_amdgcn_sched_barrier(0); const f32x4 h = v[q][j] * rstd * sclr[j] + shfr[j]; \
                            o8[64 * j] = (unsigned long long)pk2(h.x, h.y) | ((unsigned long long)pk2(h.z, h.w) << 32); \
_Pragma("unroll") \
                            for (int i = 0; i < 4; ++i) { a0 += *(const LAS f32x4*)(lds + ((i * 256 + lane + 64 * j) * 16)) * h[i]; a1 += *(const LAS f32x4*)(lds + (((4 + i) * 256 + lane + 64 * j) * 16)) * h[i]; } } \
 \
                        const bool up5 = (lane & 32) != 0, up4 = (lane & 16) != 0, up3 = (lane & 8) != 0; \
                        f32x4 k4; \
_Pragma("unroll") \
                        for (int e = 0; e < 4; ++e) { const float snd = up5 ? a0[e] : a1[e]; k4[e] = (up5 ? a1[e] : a0[e]) + __shfl_xor(snd, 32); } \
                        float k2[2]; \
_Pragma("unroll") \
                        for (int e = 0; e < 2; ++e) { const float snd = up4 ? k4[e] : k4[2 + e]; k2[e] = (up4 ? k4[2 + e] : k4[e]) + __shfl_xor(snd, 16); } \
                        float k1; { const float snd = up3 ? k2[0] : k2[1]; k1 = (up3 ? k2[1] : k2[0]) + __shfl_xor(snd, 8); } \
                        k1 += __shfl_xor(k1, 4); k1 += __shfl_xor(k1, 2); k1 += __shfl_xor(k1, 1); \
                        if ((lane & 7) == 0) ab[(size_t)m * 8 + 4 * (lane >> 5) + 2 * ((lane >> 4) & 1) + ((lane >> 3) & 1)] = k1; \
                    } } \
            } \
            __syncthreads(); \
        } \
        if (BOTH(1)) xcd_barrier(bar); \
    } while (0)
        PH_BODY; if (REPN(1) > 1) { PH_BODY; PH_BODY; }
#undef PH_BODY
    }
    if (IN(2)) {
#define PH_BODY do { \
        pg8::Gemm g{h1, win_t, M, 4096, D}; pg8::StaticOrder S; S.init(M, 4096, G, (int)blockIdx.x); \
        pg8::EpiProj E{projA, gates}; \
        pg8::gemm_phase<pg8::EpiProj, pg8::StaticOrder, true, true>(lds, g, S, E); \
        if (BOTH(2)) xcd_barrier(bar); \
    } while (0)
        PH_BODY; if (REPN(2) > 1) { PH_BODY; PH_BODY; }
#undef PH_BODY
    }

    if (IN(3)) {
#define PH_BODY do { \
        { int hst = -1; for (int u = vcu; u < UNITS; u += G) { if ((u & 3) != hst) { hst = u & 3; __syncthreads(); p3_stage_conv(lds, X, hst, tid); __syncthreads(); } p3_gdn_unit(lds, X, u, tid, lane, wave); } } \
        for (int u = vcu; u < UNITS; u += G) p3_hgrn_unit(lds, X, u, tid, lane, wave); \
        if (BOTH(3)) xcd_barrier(bar); \
    } while (0)
        PH_BODY; if (REPN(3) > 1) { PH_BODY; PH_BODY; }
#undef PH_BODY
    }
    if (IN(4)) {
#define PH_BODY do { \
        if (bx < 64) p4_gdn_scan(lds, X, bx, lane, wave); \
        else { \
            if (wave < 3 && (bx - 64) * 3 + wave < 512) p4_hgrn_scan(X, (bx - 64) * 3 + wave, lane); \
            LAS float* scr = (LAS float*)(lds + wave * 16384); \
            const float* w_gate = args.in[16]; const float* w_up = args.in[17]; const float* w_down = args.in[18]; const float* ws_gate = args.in[19]; const float* ws_up = args.in[20]; const float* ws_down = args.in[21]; \
            auto mk4 = [&](int it) { TrItem t; const int e = it / 384, r = it % 384; \
                if (r < 256) { const int up = r >> 7, q = r & 127, kb = q >> 3, n0 = 32 * (q & 7); \
                    t.W = e < NE ? (up ? w_up : w_gate) + (size_t)e * D * DE : (up ? ws_up : ws_gate); t.ldw = DE; t.src_col = n0; t.WT = (bf16*)((unsigned char*)w1t + (size_t)e * 512 * 1024); t.K = D; t.dst_row = (n0 >> 7) * 256 + up * 128 + (n0 & 127); t.k0 = 64 * kb; t.f8scale = 32.f; } \
                else { const int q = r - 256, kb = q >> 5, n0 = 32 * (q & 31); \
                    t.W = e < NE ? w_down + (size_t)e * DE * D : ws_down; t.ldw = D; t.src_col = n0; t.WT = (bf16*)((unsigned char*)w2t + (size_t)e * 1024 * 256); t.K = DE; t.dst_row = n0; t.k0 = 64 * kb; t.f8scale = 16.f; } return t; }; \
            TR_LOOP((bx - 64) * NWAVES + wave, (G - 64) * NWAVES, NEX * 384, mk4); \
        } \
        if (BOTH(4)) xcd_barrier(bar); \
    } while (0)
        PH_BODY; if (REPN(4) > 1) { PH_BODY; PH_BODY; }
#undef PH_BODY
    }
    if (IN(5)) {
#define PH_BODY do { \
        for (int bn = vcu; bn < BATCH * 128; bn += G) p5_unit(lds, X, bn, lane, wave); \
        if (BOTH(5)) xcd_barrier(bar); \
    } while (0)
        PH_BODY; if (REPN(5) > 1) { PH_BODY; PH_BODY; }
#undef PH_BODY
    }
    if (IN(6)) {
#define PH_BODY do { \
        pg8::Gemm g{omix, wout_t, M, D, D}; pg8::StaticOrder S; S.init(M, D, G, (int)blockIdx.x); \
        pg8::EpiResid E{x, mod, args.out}; \
        pg8::gemm_phase<pg8::EpiResid, pg8::StaticOrder, true, true>(lds, g, S, E); \
        if (BOTH(6)) xcd_barrier(bar); \
    } while (0)
        PH_BODY; if (REPN(6) > 1) { PH_BODY; PH_BODY; }
#undef PH_BODY
    }


    if (IN(7)) {
        constexpr int HS = 2064;
        constexpr int R_HI = 0, R_LO = 66048, R_PART = 0  , R_SC = 132096, R_SEL = 140288, R_CNT = 148480, R_BASE = 148736, R_ESE = 148992, R_ESL = 151040, R_EW = 153088, R_ELP = 155136;
        if (tid < 64) *(LAS unsigned*)(lds + R_CNT + tid * 4) = 0u;
        __syncthreads();
        int nu = 0;
        const float* norm2_w = args.in[13]; const float* rbias = args.in[15]; const bf16* wrhi = (const bf16*)(ws + WS_WRHI); const bf16* wrlo = (const bf16*)(ws + WS_WRLO);
        int* listo = (int*)(ws + WS_LIST); float* listwo = (float*)(ws + WS_LISTW);
        const int r = lane & 15, g = lane >> 4;
#pragma unroll 1
        for (int u = vcu; u < M / 32; u += G, ++nu) {
            const GAS f32x4* sh4 = (const GAS f32x4*)(mod + (32 * u >= T ? 6144 : 0) + 3072) + lane; const GAS f32x4* nw4 = (const GAS f32x4*)norm2_w + lane;
#pragma unroll 1
            for (int qp = 0; qp < 4; qp += 2) {
                f32x4 xrow[2][4];
#pragma unroll
                for (int q = 0; q < 2; ++q) { const GAS f32x4* xr = (const GAS f32x4*)(args.out + (size_t)(32 * u + 4 * wave + qp + q) * D) + lane;
#pragma unroll
                    for (int j = 0; j < 4; ++j) xrow[q][j] = xr[64 * j]; }
#pragma unroll
                for (int q = 0; q < 2; ++q) { const int rl = 4 * wave + qp + q, m = 32 * u + rl;
                    f32x4 v[4]; float ss = 0.f;
#pragma unroll
                    for (int j = 0; j < 4; ++j) { v[j] = xrow[q][j]; ss += (v[j].x * v[j].x + v[j].y * v[j].y) + (v[j].z * v[j].z + v[j].w * v[j].w); }
                    const float rstd = __builtin_amdgcn_rsqf(wave_sum(ss) * (1.f / D) + 1e-6f);
                    GAS unsigned* o4 = (GAS unsigned*)((unsigned char*)h2 + (size_t)m * D) + lane;
#pragma unroll
                    for (int j = 0; j < 4; ++j) { const f32x4 hv = v[j] * rstd * (nw4[64 * j] * (sh4[256 + 64 * j] + 1.0f)) + sh4[64 * j];
                        const unsigned h0 = f2bf(hv.x), h1_ = f2bf(hv.y), h2_ = f2bf(hv.z), h3 = f2bf(hv.w);
                        const unsigned long long hi = (unsigned long long)(h0 | (h1_ << 16)) | ((unsigned long long)(h2_ | (h3 << 16)) << 32);
                        { unsigned q8 = __builtin_amdgcn_cvt_pk_fp8_f32(hv.x, hv.y, 0, false); q8 = __builtin_amdgcn_cvt_pk_fp8_f32(hv.z, hv.w, q8, true); o4[64 * j] = q8; }
                        const unsigned long long lo = (unsigned long long)pk2(hv.x - __uint_as_float(h0 << 16), hv.y - __uint_as_float(h1_ << 16)) | ((unsigned long long)pk2(hv.z - __uint_as_float(h2_ << 16), hv.w - __uint_as_float(h3 << 16)) << 32);
                        *(LAS unsigned long long*)(lds + R_HI + rl * HS + (lane + 64 * j) * 8) = hi; *(LAS unsigned long long*)(lds + R_LO + rl * HS + (lane + 64 * j) * 8) = lo; } }
            }
            __syncthreads();
            f32x4 acc[2][4];
#pragma unroll
            for (int mt = 0; mt < 2; ++mt)
#pragma unroll
                for (int nt = 0; nt < 4; ++nt) acc[mt][nt] = (f32x4){0.f, 0.f, 0.f, 0.f};
#pragma unroll 2
            for (int ks = 0; ks < 4; ++ks) { const int kb = (128 * wave + 32 * ks + 8 * g) * 2;
                bf16x8 ahi[2], alo[2];
#pragma unroll
                for (int mt = 0; mt < 2; ++mt) { ahi[mt] = *(const LAS bf16x8*)(lds + R_HI + (16 * mt + r) * HS + kb); alo[mt] = *(const LAS bf16x8*)(lds + R_LO + (16 * mt + r) * HS + kb); }
#pragma unroll
                for (int nt = 0; nt < 4; ++nt) { const size_t o = (size_t)(16 * nt + r) * 1024 + 128 * wave + 32 * ks + 8 * g; const bf16x8 bh = *(const GAS bf16x8*)(wrhi + o), bl = *(const GAS bf16x8*)(wrlo + o);
#pragma unroll
                    for (int mt = 0; mt < 2; ++mt) { acc[mt][nt] = mfma16(ahi[mt], bh, acc[mt][nt]); acc[mt][nt] = mfma16(ahi[mt], bl, acc[mt][nt]); acc[mt][nt] = mfma16(alo[mt], bh, acc[mt][nt]); } } }
            __syncthreads();
#pragma unroll
            for (int mt = 0; mt < 2; ++mt)
#pragma unroll
                for (int nt = 0; nt < 4; ++nt)
#pragma unroll
                    for (int ii = 0; ii < 4; ++ii) *(LAS float*)(lds + R_PART + ((wave * 32 + 16 * mt + 4 * g + ii) * 64 + 16 * nt + r) * 4) = acc[mt][nt][ii];
            __syncthreads();
#pragma unroll
            for (int q = 0; q < 4; ++q) { const int idx = tid + 512 * q; float s = 0.f;
#pragma unroll
                for (int w = 0; w < 8; ++w) s += *(const LAS float*)(lds + R_PART + (w * 2048 + idx) * 4);
                const float sc = sigmoidf_(s); *(LAS float*)(lds + R_SC + idx * 4) = sc; *(LAS float*)(lds + R_SEL + idx * 4) = sc + rbias[idx & 63]; }
            __syncthreads();
#pragma unroll 2
            for (int q = 0; q < 4; ++q) { const int rl = 4 * wave + q, m = 32 * u + rl;
                const float sel = *(const LAS float*)(lds + R_SEL + (rl * 64 + lane) * 4), score = *(const LAS float*)(lds + R_SC + (rl * 64 + lane) * 4);
                float ga = sel, gb = -INFINITY;
                { const float a2 = dppf<0xB1>(ga), lo_ = fminf(ga, a2); ga = fmaxf(ga, a2); gb = lo_; }
                { const float a2 = dppf<0x4E>(ga), b2 = dppf<0x4E>(gb), lo_ = fminf(ga, a2); ga = fmaxf(ga, a2); gb = fmaxf(lo_, fmaxf(gb, b2)); }
                { const float a2 = dppf<0x141>(ga), b2 = dppf<0x141>(gb), lo_ = fminf(ga, a2); ga = fmaxf(ga, a2); gb = fmaxf(lo_, fmaxf(gb, b2)); }
                const float gs = ga + gb; const int mygrp = lane >> 3; int grank = 0;
#pragma unroll
                for (int gg = 0; gg < 8; ++gg) { const float o = rdlane(gs, 8 * gg); grank += (o > gs || (o == gs && gg < mygrp)) ? 1 : 0; }
                float msel = grank < 4 ? sel : -INFINITY; int erank = -1;
#pragma unroll
                for (int it = 0; it < 8; ++it) { const float mx = wave_max(msel);
                    const unsigned long long eq = __ballot(msel == mx); const int first = __builtin_amdgcn_readfirstlane(__ffsll((long long)eq) - 1);
                    const bool me = lane == first; msel = me ? -INFINITY : msel; erank = me ? it : erank; }
                const bool chosen = erank >= 0;
                const float wsum = wave_sum(chosen ? score : 0.f);
                if (chosen && nu < 2) { const int se = lane; const unsigned lp = __hip_atomic_fetch_add((LAS unsigned*)(lds + R_CNT + se * 4), 1u, __ATOMIC_RELAXED, __HIP_MEMORY_SCOPE_WORKGROUP);
                    const int ei = ((nu * 32 + rl) * 8 + erank) * 4;
                    *(LAS int*)(lds + R_ESE + ei) = se; *(LAS int*)(lds + R_ESL + ei) = m * 8 + erank; *(LAS float*)(lds + R_EW + ei) = score * frcp_(wsum) * 2.5f; *(LAS unsigned*)(lds + R_ELP + ei) = lp; } }
            __syncthreads();
            if (nu == 1 || u + G >= M / 32) {
                if (tid < 64) { const unsigned c = *(LAS unsigned*)(lds + R_CNT + tid * 4); *(LAS unsigned*)(lds + R_BASE + tid * 4) = c ? __hip_atomic_fetch_add(ctl + CW_CNT + 64 * tid, c, RLX_AGENT) : 0u; }
                __syncthreads();
                for (int idx = tid; idx < (nu + 1) * 256; idx += NWAVES * 64) { const int se = *(LAS int*)(lds + R_ESE + idx * 4); const unsigned pos = *(LAS unsigned*)(lds + R_BASE + se * 4) + *(LAS unsigned*)(lds + R_ELP + idx * 4);
                    if (pos < (unsigned)CAP) { listo[(size_t)se * CAP + pos] = *(LAS int*)(lds + R_ESL + idx * 4); listwo[(size_t)se * CAP + pos] = *(LAS float*)(lds + R_EW + idx * 4); } }
                __syncthreads();
                if (tid < 64) *(LAS unsigned*)(lds + R_CNT + tid * 4) = 0u;
                __syncthreads();
                nu = -1;
            }
        }
        if (BOTH(7)) xcd_barrier(bar);
    }
    if (lo <= 10 && hi > 8) {
        if (wave == 0) { unsigned c = __hip_atomic_load(ctl + CW_CNT + 64 * lane, RLX_AGENT); c = c < (unsigned)CAP ? c : (unsigned)CAP;
            unsigned inc = c;
#pragma unroll
            for (int o = 1; o < 64; o <<= 1) { const unsigned t = __shfl_up(inc, o); if (lane >= o) inc += t; }
            tb[TB_CNT + lane] = c; tb[TB_OFF + lane] = inc - c;
            if (lane == 63) { tb[TB_CNT + 64] = (unsigned)M; tb[TB_OFF + 64] = inc; } }
        __syncthreads();
    }
#define MOE_PREFIX(lo_, hi_, NT_, perm_) do { __syncthreads(); if (wave == 0) { const unsigned un_ = ((tb[TB_CNT + lane] + 255u) >> 8) * (NT_); unsigned inc_ = un_; \
        _Pragma("unroll") for (int o_ = 1; o_ < 64; o_ <<= 1) { const unsigned t_ = __shfl_up(inc_, o_); if (lane >= o_) inc_ += t_; } \
        tb[TB_PRE + lane] = inc_ - un_; if (lane == 63) { tb[TB_PRE + 64] = inc_; tb[TB_PRE + 65] = inc_ + ((tb[TB_CNT + 64] + 255u) >> 8) * (NT_); } } __syncthreads(); } while (0)
    if (IN(8)) {
#define PH_BODY do { \
        MOE_PREFIX(0, 65, 2, 0); \
        pg8::Moe1Prob P{D, 1024, pg8::MoeSched{tb, 0, 65, 2, G, vcu, 0}, (const unsigned char*)h2, (const unsigned char*)w1t, list}; \
        pg8::EpiMoe1 E{(unsigned char*)act, tb}; \
        pg8::gemm_phase_g<pg8::Moe1Prob, pg8::EpiMoe1, true>(lds, P, E); \
        if (BOTH(8)) xcd_barrier(bar); \
    } while (0)
        PH_BODY; if (REPN(8) > 1) { PH_BODY; PH_BODY; }
#undef PH_BODY
    }
    if (IN(9)) for (int rep_ = 0; rep_ < REPN(9); ++rep_) {
        MOE_PREFIX(0, 65, 4, 0);
        pg8::Moe2Prob P{DE, 256, pg8::MoeSched{tb, 0, 65, 4, G, vcu, 0}, (const unsigned char*)act, (const unsigned char*)w2t, list, listw};
        pg8::EpiMoe2 E{ws, tb};
        pg8::gemm_phase_g<pg8::Moe2Prob, pg8::EpiMoe2, true>(lds, P, E);
        if (BOTH(9)) xcd_barrier(bar);
    }
    if (IN(10)) {
        const float* fw = args.in[22]; const unsigned char* yb0 = (const unsigned char*)y0; const unsigned char* yb1 = (const unsigned char*)y1;
        typedef float f32x2_ __attribute__((ext_vector_type(2)));
        f32x4 fwr[2][2];
#pragma unroll
        for (int j = 0; j < 2; ++j)
#pragma unroll
            for (int h2_ = 0; h2_ < 2; ++h2_) fwr[j][h2_] = ((const GAS f32x4*)fw)[2 * lane + 128 * j + h2_];
#define P10_LOAD(m_, yq_, xv_, g2v_) do { const int hf_ = (m_) >= T ? 1 : 0; const GAS f32x4* xr_ = (const GAS f32x4*)(args.out + (size_t)(m_) * D); \
            const GAS v2u* yr_ = (const GAS v2u*)(hf_ ? yb1 + (size_t)((m_) - T) * 8 * D : yb0 + (size_t)(m_) * 8 * D) + lane; const GAS v2u* ysr_ = (const GAS v2u*)(ws + WS_YS + (size_t)(m_) * D) + lane; \
            const GAS f32x4* g24_ = (const GAS f32x4*)(mod + hf_ * 6144 + 5120); \
            _Pragma("unroll") for (int j = 0; j < 2; ++j) { _Pragma("unroll") for (int h2_ = 0; h2_ < 2; ++h2_) { xv_[j][h2_] = xr_[2 * lane + 128 * j + h2_]; g2v_[j][h2_] = g24_[2 * lane + 128 * j + h2_]; } \
                _Pragma("unroll") for (int k = 0; k < 8; ++k) yq_[k][j] = yr_[k * 128 + 64 * j]; yq_[8][j] = ysr_[64 * j]; } } while (0)
        v2u yqn[9][2]; f32x4 xvn[2][2], g2n[2][2];
        if (gw < M) P10_LOAD(gw, yqn, xvn, g2n);
#pragma unroll 1
        for (int m = gw; m < M; m += NGW) {
            GAS f32x4* xr = (GAS f32x4*)(args.out + (size_t)m * D);
            v2u yq[9][2]; f32x4 xv[2][2], g2v[2][2];
#pragma unroll
            for (int j = 0; j < 2; ++j) {
#pragma unroll
                for (int k = 0; k < 9; ++k) yq[k][j] = yqn[k][j];
#pragma unroll
                for (int h2_ = 0; h2_ < 2; ++h2_) { xv[j][h2_] = xvn[j][h2_]; g2v[j][h2_] = g2n[j][h2_]; } }
            if (m + NGW < M) P10_LOAD(m + NGW, yqn, xvn, g2n);
            f32x4 v[2][2]; float ss = 0.f;
#pragma unroll
            for (int j = 0; j < 2; ++j) { f32x4 s0 = {0.f, 0.f, 0.f, 0.f}, s1 = {0.f, 0.f, 0.f, 0.f};
#pragma unroll
                for (int k = 0; k < 9; ++k) { const f32x2_ a = __builtin_amdgcn_cvt_pk_f32_fp8(yq[k][j].x, false), b = __builtin_amdgcn_cvt_pk_f32_fp8(yq[k][j].x, true), c = __builtin_amdgcn_cvt_pk_f32_fp8(yq[k][j].y, false), d = __builtin_amdgcn_cvt_pk_f32_fp8(yq[k][j].y, true);
                    s0.x += a.x; s0.y += a.y; s0.z += b.x; s0.w += b.y; s1.x += c.x; s1.y += c.y; s1.z += d.x; s1.w += d.y; }
                v[j][0] = xv[j][0] + g2v[j][0] * (s0 * 0.03125f); v[j][1] = xv[j][1] + g2v[j][1] * (s1 * 0.03125f);
#pragma unroll
                for (int h2_ = 0; h2_ < 2; ++h2_) ss += (v[j][h2_].x * v[j][h2_].x + v[j][h2_].y * v[j][h2_].y) + (v[j][h2_].z * v[j][h2_].z + v[j][h2_].w * v[j][h2_].w); }
            const float rstd = __builtin_amdgcn_rsqf(wave_sum(ss) * (1.f / D) + 1e-6f);
#pragma unroll
            for (int j = 0; j < 2; ++j)
#pragma unroll
                for (int h2_ = 0; h2_ < 2; ++h2_) xr[2 * lane + 128 * j + h2_] = v[j][h2_] * rstd * fwr[j][h2_];
        }
#undef P10_LOAD
    }
#undef MOE_PREFIX
#undef IN
#undef BOTH
}

static void launch_mk(Args a, int lo, int hi, int li, int grid, hipStream_t stream) {
    a.ph_lo = lo; a.ph_hi = hi; a.li = li;
    hipLaunchKernelGGL(mk_fwd, dim3(grid), dim3(NWAVES * 64), LDS_BYTES, stream, a);
}
extern "C" void kernel_launch(void* const* d_in, const int* in_sizes, int n_in, void* d_out, int out_size, void* d_ws, size_t ws_size, hipStream_t stream) {
    static int grid = 0;
    if (grid == 0) {
        int dev = 0, cus = 0;
        if (hipGetDevice(&dev) != hipSuccess || hipDeviceGetAttribute(&cus, hipDeviceAttributeMultiprocessorCount, dev) != hipSuccess) { grid = -1; return; }
        if (hipFuncSetAttribute((const void*)mk_fwd, hipFuncAttributeMaxDynamicSharedMemorySize, LDS_BYTES) != hipSuccess) { grid = -1; return; }
        grid = cus;
    }
    if (grid < 0) return;
    unsigned char* ws = (unsigned char*)d_ws; float* out = (float*)d_out;
    (void)hipMemsetAsync(ws + WS_CTL, 0, CTL_ZERO_BYTES, stream);
    Args a{};
    for (int i = 0; i < 23; ++i) a.in[i] = (const float*)d_in[i];
    a.out = out; a.ws = ws;
    launch_mk(a, 0, 11, 0, grid, stream);
}
```
